# Optimizing an MI355X kernel written in HIP

```python
import math
import jax, jax.numpy as jnp
from jax import lax
import numpy as np

D_MODEL = 4096
BATCH = 2
SEQ = 8192
DEPTH = 1

ATT_HEADS = 16
HEAD_DIM = 128
ATT_WIDTH = ATT_HEADS * HEAD_DIM
DIL_PAIRS = ((128, 1), (512, 4), (2048, 16))
NUM_BUCKETS = 32
MAX_DISTANCE = 1024
POOL_WINDOWS = (2, 4, 8, 16)
POOL_WIDTH = D_MODEL - ATT_WIDTH
POOL_GROUP = POOL_WIDTH // len(POOL_WINDOWS)
MIX_WIDTH = ATT_WIDTH + POOL_WIDTH
IN_WIDTH = 3 * ATT_WIDTH + POOL_WIDTH
PEER_HEADS = 8
PEER_QDIM = 256
N_KEYS = 128
N_EXPERTS = N_KEYS * N_KEYS
PEER_TOPK = 16
PEER_CHUNK = 64
RMS_EPS = 1e-6
NEG_INF = -1e30

kernel_name = "hybrid_dilated_pool_peer_block"


def rmsnorm(x, gain):
    x32 = x.astype(jnp.float32)
    y = x32 * lax.rsqrt(jnp.mean(x32 * x32, axis=-1, keepdims=True) + RMS_EPS)
    return (y * gain.astype(jnp.float32)).astype(x.dtype)


def t5_bucket(rel):
    half = NUM_BUCKETS // 2
    n = -rel
    ret = jnp.where(n < 0, half, 0)
    n = jnp.abs(n)
    max_exact = half // 2
    nf = jnp.maximum(n, 1).astype(jnp.float32)
    large = max_exact + (jnp.log(nf / max_exact) / math.log(MAX_DISTANCE / max_exact)
                         * (half - max_exact)).astype(jnp.int32)
    large = jnp.minimum(large, half - 1)
    return ret + jnp.where(n < max_exact, n, large)


def dilated_window_branch(q, k, v, rel_bias, window, dil):
    B, S, H, Dh = q.shape
    side = window // (2 * dil)
    L = S // dil
    nb = -(-L // side)
    Lp = nb * side

    def to_res(t):
        t = t.reshape(B, L, dil, H, Dh).transpose(0, 2, 3, 1, 4)
        return jnp.pad(t, ((0, 0), (0, 0), (0, 0), (0, Lp - L), (0, 0)))

    def band(t):
        t = jnp.pad(to_res(t), ((0, 0), (0, 0), (0, 0), (side, side), (0, 0)))
        t = t.reshape(B, dil, H, nb + 2, side, Dh)
        return jnp.concatenate([t[:, :, :, :-2], t[:, :, :, 1:-1], t[:, :, :, 2:]], axis=4)

    qb = to_res(q).reshape(B, dil, H, nb, side, Dh)
    kb, vb = band(k), band(v)
    logits = jnp.einsum('brhnqd,brhnkd->brhnqk', qb, kb).astype(jnp.float32) * (Dh ** -0.5)

    t_q = jnp.arange(side)
    t_k = jnp.arange(3 * side)
    rel = t_k[None, :] - side - t_q[:, None]
    bias = rel_bias[t5_bucket(rel * dil)].transpose(2, 0, 1).astype(jnp.float32)
    kj = (jnp.arange(nb)[:, None] - 1) * side + t_k[None, :]
    valid = (jnp.abs(rel) <= side)[None] & ((kj >= 0) & (kj < L))[:, None, :]
    logits = jnp.where(valid[None, None, None], logits + bias[None, None, :, None], NEG_INF)

    lse = jax.nn.logsumexp(logits, axis=-1)
    p = jnp.exp(logits - lse[..., None]).astype(v.dtype)
    o = jnp.einsum('brhnqk,brhnkd->brhnqd', p, vb)
    o = o.reshape(B, dil, H, Lp, Dh)[:, :, :, :L].transpose(0, 3, 1, 2, 4).reshape(B, S, H, Dh)
    lse = lse.reshape(B, dil, H, Lp)[:, :, :, :L].transpose(0, 3, 1, 2).reshape(B, S, H)
    return o, lse


def dilated_attention(q, k, v, rel_bias):
    outs, lses = [], []
    for window, dil in DIL_PAIRS:
        o, lse = dilated_window_branch(q, k, v, rel_bias, window, dil)
        outs.append(o)
        lses.append(lse)
    w = jax.nn.softmax(jnp.stack(lses, axis=0), axis=0).astype(q.dtype)
    return jnp.einsum('gbsh,gbshd->bshd', w, jnp.stack(outs, axis=0))


def multiscale_pool(p, pool_w, pool_scale):
    B, S, C = p.shape
    G = len(POOL_WINDOWS)
    pg = p.reshape(B, S, G, POOL_GROUP).astype(jnp.float32)
    cs = jnp.pad(jnp.cumsum(pg, axis=1), ((0, 0), (1, 0), (0, 0), (0, 0)))
    pos = jnp.arange(S)
    means = []
    for gi, w in enumerate(POOL_WINDOWS):
        lo = jnp.clip(pos - w // 2, 0, S)
        hi = jnp.clip(pos + w // 2, 0, S)
        total = cs[:, hi, gi] - cs[:, lo, gi]
        means.append(total / (hi - lo).astype(jnp.float32)[None, :, None])
    pooled = (jnp.stack(means, axis=2) - pg).astype(p.dtype)
    mixed = jnp.einsum('bsgc,gcd->bsgd', pooled, pool_w)
    return mixed.reshape(B, S, C) * pool_scale


def peer_ffn(h, wq, subkeys, u_tab, v_tab):
    B, S, D = h.shape
    q = (h @ wq).reshape(B, S, PEER_HEADS, 2, PEER_QDIM // 2)
    s = jnp.einsum('bshpd,hpkd->bshpk', q, subkeys).astype(jnp.float32)
    s1, i1 = lax.top_k(s[..., 0, :], PEER_TOPK)
    s2, i2 = lax.top_k(s[..., 1, :], PEER_TOPK)
    cand = (s1[..., :, None] + s2[..., None, :]).reshape(B, S, PEER_HEADS, PEER_TOPK * PEER_TOPK)
    top, ci = lax.top_k(cand, PEER_TOPK)
    e1 = jnp.take_along_axis(i1, ci // PEER_TOPK, axis=-1)
    e2 = jnp.take_along_axis(i2, ci % PEER_TOPK, axis=-1)
    experts = e1 * N_KEYS + e2
    gates = jax.nn.softmax(top, axis=-1).astype(h.dtype)

    T = B * S
    HK = PEER_HEADS * PEER_TOPK
    nc = T // PEER_CHUNK

    def eval_chunk(args):
        hc, ec, gc = args
        a = jnp.einsum('cd,ckd->ck', hc, u_tab[ec])
        act = jax.nn.gelu(a) * gc
        return jnp.einsum('ck,ckd->cd', act, v_tab[ec])

    out = lax.map(eval_chunk, (h.reshape(nc, PEER_CHUNK, D),
                               experts.reshape(nc, PEER_CHUNK, HK),
                               gates.reshape(nc, PEER_CHUNK, HK)))
    return out.reshape(B, S, D)


def setup_inputs(seed: int = 0) -> dict:
    key = jax.random.key(seed)
    ks = jax.random.split(key, 16)
    nrm = jax.random.normal
    f32 = jnp.float32
    x = nrm(ks[0], (BATCH, SEQ, D_MODEL), f32)
    c = nrm(ks[1], (BATCH, D_MODEL), f32)
    w_ada = nrm(ks[2], (DEPTH, D_MODEL, 6 * D_MODEL), f32) * (0.5 * D_MODEL ** -0.5)
    b_ada = nrm(ks[3], (DEPTH, 6 * D_MODEL), f32) * 0.02
    g_mix = 1.0 + 0.05 * nrm(ks[4], (DEPTH, D_MODEL), f32)
    w_in = nrm(ks[5], (DEPTH, D_MODEL, IN_WIDTH), f32) * D_MODEL ** -0.5
    rel_bias = nrm(ks[6], (NUM_BUCKETS, ATT_HEADS), f32) * 0.5
    pool_w = nrm(ks[7], (DEPTH, len(POOL_WINDOWS), POOL_GROUP, POOL_GROUP), f32) * POOL_GROUP ** -0.5
    pool_scale = 1.0 + 0.1 * nrm(ks[8], (DEPTH, POOL_WIDTH), f32)
    w_out = nrm(ks[9], (DEPTH, MIX_WIDTH, D_MODEL), f32) * MIX_WIDTH ** -0.5
    g_ffn = 1.0 + 0.05 * nrm(ks[10], (DEPTH, D_MODEL), f32)
    peer_wq = nrm(ks[11], (DEPTH, D_MODEL, PEER_HEADS * PEER_QDIM), f32) * D_MODEL ** -0.5
    peer_subkeys = nrm(ks[12], (DEPTH, PEER_HEADS, 2, N_KEYS, PEER_QDIM // 2), f32) * (PEER_QDIM // 2) ** -0.5
    peer_u = nrm(ks[13], (DEPTH, N_EXPERTS, D_MODEL), f32) * D_MODEL ** -0.5
    peer_v = nrm(ks[14], (DEPTH, N_EXPERTS, D_MODEL), f32) * PEER_HEADS ** -0.5
    g_final = 1.0 + 0.05 * nrm(ks[15], (D_MODEL,), f32)
    return {"x": x, "c": c, "w_ada": w_ada, "b_ada": b_ada, "g_mix": g_mix, "w_in": w_in,
            "rel_bias": rel_bias, "pool_w": pool_w, "pool_scale": pool_scale, "w_out": w_out,
            "g_ffn": g_ffn, "peer_wq": peer_wq, "peer_subkeys": peer_subkeys,
            "peer_u": peer_u, "peer_v": peer_v, "g_final": g_final}


def reference(x, c, w_ada, b_ada, g_mix, w_in, rel_bias, pool_w, pool_scale, w_out,
              g_ffn, peer_wq, peer_subkeys, peer_u, peer_v, g_final):
    B, S, _ = x.shape
    for l in range(DEPTH):
        mod = jax.nn.silu(c) @ w_ada[l] + b_ada[l]
        sh1, sc1, gt1, sh2, sc2, gt2 = jnp.split(mod, 6, axis=-1)

        h = rmsnorm(x, g_mix[l]) * (1 + sc1[:, None]) + sh1[:, None]
        proj = h @ w_in[l]
        q = proj[..., :ATT_WIDTH].reshape(B, S, ATT_HEADS, HEAD_DIM)
        k = proj[..., ATT_WIDTH:2 * ATT_WIDTH].reshape(B, S, ATT_HEADS, HEAD_DIM)
        v = proj[..., 2 * ATT_WIDTH:3 * ATT_WIDTH].reshape(B, S, ATT_HEADS, HEAD_DIM)
        p_in = proj[..., 3 * ATT_WIDTH:]
        attn = dilated_attention(q, k, v, rel_bias).reshape(B, S, ATT_WIDTH)
        pooled = multiscale_pool(p_in, pool_w[l], pool_scale[l])
        mix = jnp.concatenate([attn, pooled], axis=-1) @ w_out[l]
        x = x + gt1[:, None] * mix

        h2 = rmsnorm(x, g_ffn[l]) * (1 + sc2[:, None]) + sh2[:, None]
        x = x + gt2[:, None] * peer_ffn(h2, peer_wq[l], peer_subkeys[l], peer_u[l], peer_v[l])
    return rmsnorm(x, g_final)
```

```cpp
#include <hip/hip_runtime.h>
#include <cstdio>
#include <cstdint>

#ifndef MK_N_LAUNCHES
#define MK_N_LAUNCHES 1
#endif

#define GAS __attribute__((address_space(1)))
#define LAS __attribute__((address_space(3)))
typedef unsigned short bf16;
typedef unsigned v4u __attribute__((ext_vector_type(4)));
typedef unsigned v2u __attribute__((ext_vector_type(2)));
typedef float f32x4 __attribute__((ext_vector_type(4)));
typedef float f32x2 __attribute__((ext_vector_type(2)));
typedef float f32x16 __attribute__((ext_vector_type(16)));
typedef short bf16x8 __attribute__((ext_vector_type(8)));
typedef short s16x4 __attribute__((ext_vector_type(4)));
typedef __bf16 bf2_t __attribute__((ext_vector_type(2)));

constexpr int BATCH = 2, SEQ = 8192, DM = 4096, M = BATCH * SEQ;
constexpr int NH = 16, HD = 128, ATTW = 2048, POOLW = 2048, INW = 8192;
constexpr int NMOD = 6 * DM;
constexpr int PQ = 2048;
constexpr int NEXP = 16384;
constexpr float RMS_EPS = 1e-6f;
constexpr float LOG2E = 1.4426950408889634f;
constexpr float QSCALE = 0.08838834764831845f * LOG2E;
constexpr int KS_ADA = 64;

constexpr size_t MiB = 1u << 20;
constexpr size_t WS_CTL = 0, CTL_ZERO_BYTES = 1 * MiB;
constexpr size_t WS_MODV = 1 * MiB;
constexpr size_t WS_MODP = 4 * MiB;
constexpr size_t WS_SKT = 20 * MiB;
constexpr size_t WS_POOLWT = 22 * MiB;
constexpr size_t WS_WQT = 24 * MiB;
constexpr size_t WS_WOUTT = 40 * MiB;
constexpr size_t WS_WINT = 72 * MiB;
constexpr size_t WS_UB = 136 * MiB;
constexpr size_t WS_VB = 264 * MiB;
constexpr size_t WS_H = 392 * MiB;
constexpr size_t WS_PROJ = 520 * MiB;
constexpr size_t WS_MIXIN = 776 * MiB;
constexpr size_t WS_POOLIN = 904 * MiB;
constexpr size_t WS_O0 = 968 * MiB, WS_O1 = 1032 * MiB;
constexpr size_t WS_LSE = 1096 * MiB;
constexpr size_t WS_QP = 1100 * MiB;
constexpr size_t WS_SC = 1164 * MiB;
constexpr size_t WS_END = 1292 * MiB;

constexpr int RING_OFF = 0, RING_BYTES = 131072;
constexpr int SHARED_OFF = 131072;
constexpr int LDSCTL_OFF = 131072 + 8192, MISC_OFF = LDSCTL_OFF + 320;
constexpr int LDS_BYTES = 147456;
constexpr int NWAVES = 8;
constexpr int CW_BAR = 4096;

#define LDS_WAIT() asm volatile("s_waitcnt lgkmcnt(0)" ::: "memory")
#define VM_WAIT() asm volatile("s_waitcnt vmcnt(0)" ::: "memory")

__device__ __forceinline__ unsigned cvt_pk_bf16(float lo, float hi) { unsigned r; asm volatile("v_cvt_pk_bf16_f32 %0, %1, %2" : "=v"(r) : "v"(lo), "v"(hi)); return r; }
__device__ __forceinline__ float bf_lo(unsigned u) { return __uint_as_float(u << 16); }
__device__ __forceinline__ float bf_hi(unsigned u) { return __uint_as_float(u & 0xffff0000u); }
__device__ __forceinline__ float wave_sum(float v) {
#pragma unroll
    for (int o = 1; o < 64; o <<= 1) v += __shfl_xor(v, o);
    return v;
}

namespace pg8 {
typedef unsigned short bf16_t;
constexpr int BM = 256, BK = 64, HALF = 128, HTB = HALF * BK * 2, STAGE_BYTES = 8 * HTB, NXCD = 8, WGM = 8;

__host__ __device__ __forceinline__ int lds_byte(int r, int c) { const int st = (r >> 4) * 2 + (c >> 5), rr = r & 15, cc = c & 31, ob = rr * 64 + cc * 2; return st * 1024 + (ob ^ (((ob >> 9) & 1) << 5)); }
__host__ __device__ __forceinline__ void stage_rc(int b, int& R, int& C) { const int st = b / 1024, sb = b % 1024, swz = sb ^ (((sb >> 9) & 1) << 5); R = (st >> 1) * 16 + swz / 64; C = (st & 1) * 32 + (swz % 64) / 2; }
__host__ __device__ __forceinline__ int perm32(int rho) { const int n = rho >> 4, i = rho & 15; return 8 * (i >> 2) + 4 * n + (i & 3); }

struct Unit { int pm, pn; };
struct Gemm { const bf16_t* A; const bf16_t* Bt; int M, N, K, lda, ldb, agrp_div, agrp_cols; };

struct StaticOrder {
    int nM, nN, nwg, G, c;
    __host__ __device__ void init(int M_, int N_, int G_, int c_) { nM = M_ / BM; nN = N_ / BM; nwg = nM * nN; G = G_; c = c_; }
    __host__ __device__ bool next(int i, Unit& u) const {
        const long L = (long)i * G + c; if (L >= nwg) return false;
        int wgid = (int)L; { const int q = nwg / NXCD, r = nwg % NXCD, xcd = wgid % NXCD, off = wgid / NXCD; wgid = (xcd < r ? xcd * (q + 1) : r * (q + 1) + (xcd - r) * q) + off; }
        const int nig = WGM * nN, gid = wgid / nig, fm = gid * WGM, gsz = (nM - fm) < WGM ? (nM - fm) : WGM;
        u.pm = fm + ((wgid % nig) % gsz); u.pn = (wgid % nig) / gsz; return true;
    }
    __device__ __forceinline__ void a_ready(const Unit&) const {}
    __device__ __forceinline__ void done(const Unit&) const {}
};

struct EpiBf16 {
    static constexpr bool PERM = true, AFTER_DRAIN = false;
    bf16_t* O; int ldc; int scale_cols; float scale0;
    __device__ __forceinline__ void operator()(const f32x4 (&acc)[2][2][4][2], const Unit& u, int wr, int wc, int fr, int fq) const {
        const int row0 = u.pm * BM + wr * 64 + fr; const int colt = u.pn * BM;
        const float sc = (colt < scale_cols) ? scale0 : 1.f;
        const int col0 = colt + wc * 32 + 8 * fq;
#pragma unroll
        for (int ai = 0; ai < 2; ++ai)
#pragma unroll
            for (int m = 0; m < 4; ++m) { bf16_t* rowp = O + (size_t)(row0 + ai * HALF + m * 16) * ldc + col0;
#pragma unroll
                for (int bj = 0; bj < 2; ++bj) { f32x4 v0 = acc[ai][bj][m][0] * sc, v1 = acc[ai][bj][m][1] * sc;
                    v4u w; w.x = cvt_pk_bf16(v0[0], v0[1]); w.y = cvt_pk_bf16(v0[2], v0[3]); w.z = cvt_pk_bf16(v1[0], v1[1]); w.w = cvt_pk_bf16(v1[2], v1[3]);
                    *(v4u*)(rowp + bj * HALF) = w; } }
    }
};
struct EpiBf16ColScale {
    static constexpr bool PERM = true, AFTER_DRAIN = false;
    bf16_t* O; int ldc; int coff; const float* cs;
    __device__ __forceinline__ void operator()(const f32x4 (&acc)[2][2][4][2], const Unit& u, int wr, int wc, int fr, int fq) const {
        const int row0 = u.pm * BM + wr * 64 + fr; const int col0 = u.pn * BM + wc * 32 + 8 * fq;
        f32x4 sv[2][2];
#pragma unroll
        for (int bj = 0; bj < 2; ++bj)
#pragma unroll
            for (int n = 0; n < 2; ++n) sv[bj][n] = *(const f32x4*)(cs + col0 + bj * HALF + 4 * n);
#pragma unroll
        for (int ai = 0; ai < 2; ++ai)
#pragma unroll
            for (int m = 0; m < 4; ++m) { bf16_t* rowp = O + (size_t)(row0 + ai * HALF + m * 16) * ldc + coff + col0;
#pragma unroll
                for (int bj = 0; bj < 2; ++bj) { f32x4 v0 = acc[ai][bj][m][0] * sv[bj][0], v1 = acc[ai][bj][m][1] * sv[bj][1];
                    v4u w; w.x = cvt_pk_bf16(v0[0], v0[1]); w.y = cvt_pk_bf16(v0[2], v0[3]); w.z = cvt_pk_bf16(v1[0], v1[1]); w.w = cvt_pk_bf16(v1[2], v1[3]);
                    *(v4u*)(rowp + bj * HALF) = w; } }
    }
};
struct EpiResF32 {
    static constexpr bool PERM = false, AFTER_DRAIN = false;
    const float* X; const float* gate; float* O; int ldc;
    __device__ __forceinline__ void operator()(const f32x4 (&acc)[2][2][4][2], const Unit& u, int wr, int wc, int fr, int fq) const {
        const int row0 = u.pm * BM + wr * 64 + fr; const int col0 = u.pn * BM + wc * 32 + 4 * fq; const int b = (u.pm * BM) / SEQ;
        f32x4 gv[2][2];
#pragma unroll
        for (int bj = 0; bj < 2; ++bj)
#pragma unroll
            for (int n = 0; n < 2; ++n) gv[bj][n] = *(const f32x4*)(gate + (size_t)b * DM + col0 + bj * HALF + n * 16);
#pragma unroll
        for (int ai = 0; ai < 2; ++ai)
#pragma unroll
            for (int m = 0; m < 4; ++m) { const size_t off = (size_t)(row0 + ai * HALF + m * 16) * ldc + col0;
#pragma unroll
                for (int bj = 0; bj < 2; ++bj)
#pragma unroll
                    for (int n = 0; n < 2; ++n) { const f32x4 xv = *(const f32x4*)(X + off + bj * HALF + n * 16);
                        *(f32x4*)(O + off + bj * HALF + n * 16) = xv + gv[bj][n] * acc[ai][bj][m][n]; } }
    }
};
struct EpiF32 {
    static constexpr bool PERM = false, AFTER_DRAIN = false;
    float* O; int ldc;
    __device__ __forceinline__ void operator()(const f32x4 (&acc)[2][2][4][2], const Unit& u, int wr, int wc, int fr, int fq) const {
        const int row0 = u.pm * BM + wr * 64 + fr; const int col0 = u.pn * BM + wc * 32 + 4 * fq;
#pragma unroll
        for (int ai = 0; ai < 2; ++ai)
#pragma unroll
            for (int m = 0; m < 4; ++m) { const size_t off = (size_t)(row0 + ai * HALF + m * 16) * ldc + col0;
#pragma unroll
                for (int bj = 0; bj < 2; ++bj)
#pragma unroll
                    for (int n = 0; n < 2; ++n) *(f32x4*)(O + off + bj * HALF + n * 16) = acc[ai][bj][m][n]; }
    }
};

template <class Epi, class Sched, bool ALIGN_EPI>
__device__ __forceinline__ void gemm_phase(LAS unsigned char* lds, const Gemm g, const Sched& S, const Epi& E) {
    const int tid = threadIdx.x, wid = __builtin_amdgcn_readfirstlane(tid >> 6), lane = tid & 63, wr = wid >> 2, wc = wid & 3, fr = lane & 15, fq = lane >> 4;
    const int K = g.K, nt = K / BK;
    unsigned voffA[2], voffB[2];
#pragma unroll
    for (int i = 0; i < 2; ++i) { int R, C; stage_rc(tid * 16 + i * 8192, R, C); const int Rb = Epi::PERM ? ((R & ~31) + perm32(R & 31)) : R;
        voffA[i] = (unsigned)(R * g.lda + C) * 2u; voffB[i] = (unsigned)(Rb * g.ldb + C) * 2u; }
    const size_t kstep = (size_t)(BK * 2);
    const size_t hstepA = (size_t)HALF * g.lda * 2, hstepB = (size_t)HALF * g.ldb * 2;
    const size_t tstepA = 2 * hstepA, tstepB = 2 * hstepB;
    const unsigned ldsw = (unsigned)wid * 1024u;
    const int aoff = lds_byte(wr * 64 + fr, fq * 8), boff = lds_byte(wc * 32 + fr, fq * 8);
#define PG8_SA(b, h) (((b) * 2 + (h)) * HTB)
#define PG8_SB(b, h) ((4 + (b) * 2 + (h)) * HTB)
#define PG8_STAGE(bufoff, gbase, voff) do { _Pragma("unroll") for (int _i = 0; _i < 2; ++_i) \
        __builtin_amdgcn_global_load_lds((const unsigned*)((const char*)(gbase) + (voff)[_i]), (LAS unsigned*)(lds + (bufoff) + ldsw + _i * 8192), 16, 0, 0); } while (0)
#define PG8_LDA(dst, b, h) do { _Pragma("unroll") for (int m = 0; m < 4; ++m) _Pragma("unroll") for (int k = 0; k < 2; ++k) dst[m][k] = *(const LAS bf16x8*)(lds + PG8_SA(b, h) + aoff + m * 2048 + k * 1024); } while (0)
#define PG8_LDB(dst, b, h) do { _Pragma("unroll") for (int n = 0; n < 2; ++n) _Pragma("unroll") for (int k = 0; k < 2; ++k) dst[n][k] = *(const LAS bf16x8*)(lds + PG8_SB(b, h) + boff + n * 2048 + k * 1024); } while (0)
#define PG8_MMA(ai, bj, At, Bt) do { __builtin_amdgcn_s_setprio(1); _Pragma("unroll") for (int m = 0; m < 4; ++m) _Pragma("unroll") for (int n = 0; n < 2; ++n) _Pragma("unroll") for (int k = 0; k < 2; ++k) \
        acc[ai][bj][m][n] = __builtin_amdgcn_mfma_f32_16x16x32_bf16(Bt[n][k], At[m][k], acc[ai][bj][m][n], 0, 0, 0); __builtin_amdgcn_s_setprio(0); } while (0)
#define PG8_WAIT_V(n) asm volatile("s_waitcnt vmcnt(" #n ")" ::: "memory")
#define PG8_WAIT_L(n) asm volatile("s_waitcnt lgkmcnt(" #n ")" ::: "memory")
#define PG8_BAR __builtin_amdgcn_s_barrier()
#define PG8_SCHED __builtin_amdgcn_sched_barrier(0)
#define PG8_ABASE(u) ((const char*)g.A + (size_t)(u).pm * tstepA + (size_t)((u).pn / g.agrp_div) * (size_t)g.agrp_cols * 2)
#define PG8_BBASE(u) ((const char*)g.Bt + (size_t)(u).pn * tstepB)
    Unit cur, nxt; int ui = 0;
    if (!S.next(0, cur)) return;
    f32x4 acc[2][2][4][2];
#pragma unroll
    for (int a = 0; a < 2; ++a)
#pragma unroll
        for (int b = 0; b < 2; ++b)
#pragma unroll
            for (int m = 0; m < 4; ++m)
#pragma unroll
                for (int n = 0; n < 2; ++n) acc[a][b][m][n] = (f32x4){0.f, 0.f, 0.f, 0.f};
    bf16x8 At[4][2], B0[2][2], B1[2][2];
    const char* cA = PG8_ABASE(cur); const char* cB = PG8_BBASE(cur);
    S.a_ready(cur);
    PG8_STAGE(PG8_SB(0, 0), cB, voffB); PG8_STAGE(PG8_SB(0, 1), cB + hstepB, voffB); PG8_STAGE(PG8_SA(0, 0), cA, voffA); PG8_STAGE(PG8_SA(0, 1), cA + hstepA, voffA);
    if (wr == 1) PG8_BAR;
    PG8_WAIT_V(2); PG8_BAR;
    PG8_STAGE(PG8_SB(1, 0), cB + kstep, voffB); PG8_STAGE(PG8_SA(1, 0), cA + kstep, voffA); PG8_STAGE(PG8_SB(1, 1), cB + hstepB + kstep, voffB);
    PG8_WAIT_V(6); PG8_BAR;
    for (;;) {
        const bool has_next = S.next(ui + 1, nxt);
        const char* nA = has_next ? PG8_ABASE(nxt) : cA; const char* nB = has_next ? PG8_BBASE(nxt) : cB;
        for (int t = 0; t < nt; t += 2) {
            const bool last = (t == nt - 2);
            const char* a1 = cA + (size_t)(t + 1) * kstep;
            const char* a2 = last ? nA : cA + (size_t)(t + 2) * kstep; const char* b2 = last ? nB : cB + (size_t)(t + 2) * kstep;
            const char* a3 = a2 + kstep; const char* b3 = b2 + kstep;
            if (last && has_next) S.a_ready(nxt);
            PG8_LDB(B0, 0, 0); PG8_LDB(B1, 0, 1); PG8_SCHED; PG8_LDA(At, 0, 0); PG8_STAGE(PG8_SA(1, 1), a1 + hstepA, voffA);
            PG8_WAIT_V(8); PG8_WAIT_L(0); PG8_BAR; PG8_MMA(0, 0, At, B0); PG8_MMA(0, 1, At, B1); PG8_BAR; PG8_SCHED;
            PG8_LDA(At, 0, 1); PG8_STAGE(PG8_SB(0, 0), b2, voffB); PG8_STAGE(PG8_SB(0, 1), b2 + hstepB, voffB); PG8_STAGE(PG8_SA(0, 0), a2, voffA);
            PG8_WAIT_V(8); PG8_WAIT_L(0); PG8_BAR; PG8_MMA(1, 0, At, B0); PG8_MMA(1, 1, At, B1); PG8_BAR; PG8_SCHED;
            PG8_LDB(B0, 1, 0); PG8_LDB(B1, 1, 1); PG8_SCHED; PG8_LDA(At, 1, 0); PG8_STAGE(PG8_SA(0, 1), a2 + hstepA, voffA);
            PG8_WAIT_V(8); PG8_WAIT_L(0); PG8_BAR; PG8_MMA(0, 0, At, B0); PG8_MMA(0, 1, At, B1); PG8_BAR; PG8_SCHED;
            PG8_LDA(At, 1, 1); PG8_STAGE(PG8_SB(1, 0), b3, voffB); PG8_STAGE(PG8_SB(1, 1), b3 + hstepB, voffB); PG8_STAGE(PG8_SA(1, 0), a3, voffA);
            PG8_WAIT_V(8); PG8_WAIT_L(0); PG8_BAR; PG8_MMA(1, 0, At, B0); PG8_MMA(1, 1, At, B1); PG8_BAR; PG8_SCHED;
        }
        if constexpr (ALIGN_EPI) { if (wr == 0) PG8_BAR; }
        E(acc, cur, wr, wc, fr, fq); S.done(cur);
        if (!has_next) break;
#pragma unroll
        for (int a = 0; a < 2; ++a)
#pragma unroll
            for (int b = 0; b < 2; ++b)
#pragma unroll
                for (int m = 0; m < 4; ++m)
#pragma unroll
                    for (int n = 0; n < 2; ++n) acc[a][b][m][n] = (f32x4){0.f, 0.f, 0.f, 0.f};
        cur = nxt; cA = nA; cB = nB; ++ui;
        if constexpr (ALIGN_EPI) { if (wr == 1) PG8_BAR; }
    }
    PG8_WAIT_V(0);
    if constexpr (!ALIGN_EPI) { if (wr == 0) PG8_BAR; }
    PG8_BAR;
#undef PG8_SA
#undef PG8_SB
#undef PG8_STAGE
#undef PG8_LDA
#undef PG8_LDB
#undef PG8_MMA
#undef PG8_WAIT_V
#undef PG8_WAIT_L
#undef PG8_BAR
#undef PG8_SCHED
#undef PG8_ABASE
#undef PG8_BBASE
}
}

#define XB_TMO      128
#define XB_XCNT(j)  (256  + 64 * (j))
#define XB_XSUB(j)  (1280 + 64 * (j))
#define XB_XGEN(j)  (2304 + 64 * (j))
#define XB_TOP      3328
#define XB_TOPGEN   3392
#define XCD_BAR_WORDS 3456
#define XB_SPIN_CAP (1u << 18)

__device__ __forceinline__ unsigned xb_ld(unsigned* p)              { return __hip_atomic_load(p, __ATOMIC_RELAXED, __HIP_MEMORY_SCOPE_AGENT); }
__device__ __forceinline__ unsigned xb_add(unsigned* p, unsigned v) { return __hip_atomic_fetch_add(p, v, __ATOMIC_RELAXED, __HIP_MEMORY_SCOPE_AGENT); }
__device__ __forceinline__ unsigned xb_xcc_id() { return (unsigned)__builtin_amdgcn_s_getreg((3 << 11) | 20) & 0xFu; }
#define XB_SPIN(cond, bar) do { unsigned _sp = 0; while (cond) { __builtin_amdgcn_s_sleep(1); \
    if ((++_sp & 255u) == 0u) { if (xb_ld(&(bar)[XB_TMO])) break; if (_sp > XB_SPIN_CAP) { atomicAdd(&(bar)[XB_TMO], 1u); break; } } } } while (0)

struct XcdBarrier { unsigned* bar; unsigned x; volatile LAS unsigned* st; };

__device__ __forceinline__ XcdBarrier xcd_barrier_post(unsigned* bar, volatile LAS unsigned* st) {
    XcdBarrier b; b.bar = bar; b.x = xb_xcc_id(); b.st = st;
    if (threadIdx.x == 0) (void)xb_add(&bar[XB_XCNT(b.x)], 1u);
    return b;
}
__device__ __forceinline__ void xcd_barrier_complete(unsigned* bar, unsigned x, unsigned& nloc, unsigned& nx) {
    const unsigned G = gridDim.x * gridDim.y * gridDim.z;
    unsigned sum, cnt, mine, sp = 0u;
    for (;;) {
        sum = 0u; cnt = 0u; mine = 0u;
#pragma unroll
        for (unsigned j = 0; j < 16; ++j) { const unsigned c = xb_ld(&bar[XB_XCNT(j)]); sum += c; cnt += (c > 0u) ? 1u : 0u; mine = (j == x) ? c : mine; }
        if (sum == G) break;
        __builtin_amdgcn_s_sleep(1);
        if ((++sp & 255u) == 0u) { if (xb_ld(&bar[XB_TMO])) break; if (sp > XB_SPIN_CAP) { atomicAdd(&bar[XB_TMO], 1u); break; } }
    }
    nloc = mine > 0u ? mine : 1u; nx = cnt > 0u ? cnt : 1u;
}
__device__ __forceinline__ void xcd_barrier(const XcdBarrier& b) {
    asm volatile("s_waitcnt vmcnt(0)" ::: "memory");
    __syncthreads();
    if (threadIdx.x == 0) {
        unsigned* bar = b.bar;
        __builtin_amdgcn_s_waitcnt(0);
        unsigned nloc = b.st[0], nx = b.st[1];
        if (nloc == 0u) { xcd_barrier_complete(bar, b.x, nloc, nx); b.st[0] = nloc; b.st[1] = nx; }
        const unsigned old = xb_add(&bar[XB_XSUB(b.x)], 1u);
        const unsigned gen = old / nloc;
        if (old + 1u == (gen + 1u) * nloc) {
            __builtin_amdgcn_fence(__ATOMIC_RELEASE, "agent");
            asm volatile("s_waitcnt vmcnt(0)" ::: "memory");
            const unsigned og = xb_add(&bar[XB_TOP], 1u);
            const unsigned tg = og / nx;
            if (og + 1u == (tg + 1u) * nx) xb_add(&bar[XB_TOPGEN], 1u);
            else XB_SPIN(xb_ld(&bar[XB_TOPGEN]) == tg, bar);
            __builtin_amdgcn_fence(__ATOMIC_ACQUIRE, "agent");
            xb_add(&bar[XB_XGEN(b.x)], 1u);
            asm volatile("s_waitcnt vmcnt(0)" ::: "memory");
        } else {
            XB_SPIN(xb_ld(&bar[XB_XGEN(b.x)]) == gen, bar);
            __builtin_amdgcn_fence(__ATOMIC_ACQUIRE, "agent");
            asm volatile("s_waitcnt vmcnt(0)" ::: "memory");
        }
    }
    __syncthreads();
}

__device__ __forceinline__ void p0_transpose_item(const float* W, int K, int N, bf16* WT, int row_off, LAS float* scr, int item, int lane) {
    const int nblk = N / 32, kb = item / nblk, nb = item % nblk, k0 = 64 * kb, n0 = 32 * nb;
#pragma unroll 8
    for (int i = 0; i < 32; ++i) { const int kk = 2 * i + (lane >> 5); scr[kk * 33 + (lane & 31)] = W[(size_t)(k0 + kk) * N + n0 + (lane & 31)]; }
    LDS_WAIT(); asm volatile("" ::: "memory");
    const int c = lane & 7;
#pragma unroll
    for (int j = 0; j < 4; ++j) { const int n = (lane >> 3) + 8 * j; const LAS float* s = scr + (8 * c) * 33 + n;
        v4u o; o.x = cvt_pk_bf16(s[0 * 33], s[1 * 33]); o.y = cvt_pk_bf16(s[2 * 33], s[3 * 33]); o.z = cvt_pk_bf16(s[4 * 33], s[5 * 33]); o.w = cvt_pk_bf16(s[6 * 33], s[7 * 33]);
        *(GAS v4u*)(WT + (size_t)(row_off + n0 + n) * K + k0 + 8 * c) = o; }
    LDS_WAIT(); asm volatile("" ::: "memory");
}

__device__ __forceinline__ int t5_bucket(int rel) {
    int n = -rel; const int ret = n < 0 ? 16 : 0; n = n < 0 ? -n : n;
    if (n < 8) return ret + n;
    const float v = logf((float)n / 8.0f) / logf(128.0f) * 8.0f;
    int large = 8 + (int)v; large = large < 15 ? large : 15;
    return ret + large;
}
__device__ __forceinline__ float gelu_tanh(float x) {
    const float z = 0.7978845608028654f * (x + 0.044715f * x * x * x);
    const float e = __expf(2.0f * z);
    const float t = 1.0f - 2.0f / (e + 1.0f);
    return 0.5f * x * (1.0f + t);
}
__device__ __forceinline__ unsigned fkey(float v) { const unsigned u = __float_as_uint(v); return (u >> 31) ? ~u : (u | 0x80000000u); }
__device__ __forceinline__ float dot2bf(unsigned a, unsigned b, float c) { return __builtin_amdgcn_fdot2_f32_bf16(__builtin_bit_cast(bf2_t, a), __builtin_bit_cast(bf2_t, b), c, false); }

constexpr int VPITCH = 320;
__device__ __forceinline__ int crow(int r, int hi) { return (r & 3) + 8 * (r >> 2) + 4 * hi; }

__device__ __forceinline__ void attn_task(const int G, const bf16* PROJ, bf16* O0, bf16* O1, float* LSE0, float* LSE1, bf16* MIXIN,
                                          const LAS float* btab, LAS unsigned char* vt, int b, int h, int mtile, int tk, int lane) {
    const int SH = 2 * G;
    const int L = SEQ >> SH, TPR = 32 >> SH;
    const int r32 = lane & 31, hi = lane >> 5;
    const int res = tk >> (5 - SH), l0 = ((mtile * 1024) >> SH) + 32 * (tk & (TPR - 1));
    const size_t rowbase = (size_t)b * SEQ;
    const size_t qrow = rowbase + ((size_t)(l0 + r32) << SH) + res;
    bf16x8 qr[8];
    { const bf16* qp = PROJ + qrow * INW + h * HD + hi * 8;
#pragma unroll
      for (int d0 = 0; d0 < 8; ++d0) qr[d0] = *(const bf16x8*)(qp + d0 * 16); }
    f32x16 p[5];
#pragma unroll
    for (int j = 0; j < 5; ++j) {
        int lk = l0 - 64 + 32 * j + r32; lk = lk < 0 ? 0 : (lk > L - 1 ? L - 1 : lk);
        const bf16* kp = PROJ + (rowbase + ((size_t)lk << SH) + res) * INW + ATTW + h * HD + hi * 8;
        f32x16 s = {};
#pragma unroll
        for (int d0 = 0; d0 < 8; ++d0) { const bf16x8 a = *(const bf16x8*)(kp + d0 * 16); s = __builtin_amdgcn_mfma_f32_32x32x16_bf16(a, qr[d0], s, 0, 0, 0); }
        p[j] = s;
        asm volatile("" ::: "memory");
    }
    float mx = -1e30f;
    const bool edge = (l0 - 64 < 0) || (l0 + 96 > L);
    const LAS float* bt = btab + G * 256 + 32 + 4 * hi - r32;
#pragma unroll
    for (int j = 0; j < 5; ++j) {
#pragma unroll
        for (int r = 0; r < 16; ++r) {
            const int kc = 32 * j + (r & 3) + 8 * (r >> 2);
            float v = p[j][r] + bt[kc];
            if (edge) { const int lk = l0 - 64 + kc + 4 * hi; v = (lk >= 0 && lk < L) ? v : -1e30f; }
            p[j][r] = v; mx = fmaxf(mx, v);
        }
        asm volatile("" ::: "memory");
    }
    mx = fmaxf(mx, __shfl_xor(mx, 32));
    float ls = 0.f;
    bf16x8 pb[5][2];
#pragma unroll
    for (int j = 0; j < 5; ++j) {
        float e[16];
#pragma unroll
        for (int r = 0; r < 16; ++r) { e[r] = __builtin_amdgcn_exp2f(p[j][r] - mx); ls += e[r]; }
#pragma unroll
        for (int s = 0; s < 2; ++s) { v4u w; w.x = cvt_pk_bf16(e[8 * s + 0], e[8 * s + 1]); w.y = cvt_pk_bf16(e[8 * s + 2], e[8 * s + 3]);
            w.z = cvt_pk_bf16(e[8 * s + 4], e[8 * s + 5]); w.w = cvt_pk_bf16(e[8 * s + 6], e[8 * s + 7]); pb[j][s] = __builtin_bit_cast(bf16x8, w); }
    }
    ls += __shfl_xor(ls, 32);
    asm volatile("" ::: "memory");
    f32x16 o[4] = {};
    const int i16 = lane & 15, g16 = lane >> 4;
    const unsigned vaddr = (unsigned)(uintptr_t)vt + (unsigned)((4 * hi + (i16 >> 2)) * VPITCH + (16 * (g16 & 1) + 4 * (i16 & 3)) * 2);
#pragma unroll
    for (int j = 0; j < 5; ++j) {
        v4u vv[8];
#pragma unroll
        for (int i = 0; i < 8; ++i) { const int kk = (lane >> 4) + 4 * i; int lk = l0 - 64 + 32 * j + kk; lk = lk < 0 ? 0 : (lk > L - 1 ? L - 1 : lk);
            vv[i] = *(const v4u*)(PROJ + (rowbase + ((size_t)lk << SH) + res) * INW + 2 * ATTW + h * HD + (lane & 15) * 8); }
        LDS_WAIT();
#pragma unroll
        for (int i = 0; i < 8; ++i) { const int kk = (lane >> 4) + 4 * i; *(LAS v4u*)(vt + kk * VPITCH + (lane & 15) * 16) = vv[i]; }
        LDS_WAIT();
#pragma unroll
        for (int dt = 0; dt < 4; ++dt) {
            s16x4 lo0, hi0, lo1, hi1;
            asm volatile("ds_read_b64_tr_b16 %0, %4 offset:%5\n\tds_read_b64_tr_b16 %1, %4 offset:%6\n\tds_read_b64_tr_b16 %2, %4 offset:%7\n\tds_read_b64_tr_b16 %3, %4 offset:%8\n\ts_waitcnt lgkmcnt(0)"
                         : "=&v"(lo0), "=&v"(hi0), "=&v"(lo1), "=&v"(hi1)
                         : "v"(vaddr), "i"(dt * 64), "i"(8 * VPITCH + dt * 64), "i"(16 * VPITCH + dt * 64), "i"(24 * VPITCH + dt * 64) : "memory");
            const bf16x8 af0 = (bf16x8){lo0[0], lo0[1], lo0[2], lo0[3], hi0[0], hi0[1], hi0[2], hi0[3]};
            const bf16x8 af1 = (bf16x8){lo1[0], lo1[1], lo1[2], lo1[3], hi1[0], hi1[1], hi1[2], hi1[3]};
            o[dt] = __builtin_amdgcn_mfma_f32_32x32x16_bf16(af0, pb[j][0], o[dt], 0, 0, 0);
            o[dt] = __builtin_amdgcn_mfma_f32_32x32x16_bf16(af1, pb[j][1], o[dt], 0, 0, 0);
        }
    }
    const float inv = 1.0f / ls;
    const float lse2 = mx + __builtin_amdgcn_logf(ls);
    const size_t orow = qrow;
    if (G < 2) {
        bf16* op = (G == 0 ? O0 : O1) + orow * ATTW + h * HD + 4 * hi;
#pragma unroll
        for (int dt = 0; dt < 4; ++dt)
#pragma unroll
            for (int rg = 0; rg < 4; ++rg) { v2u w; w.x = cvt_pk_bf16(o[dt][4 * rg] * inv, o[dt][4 * rg + 1] * inv); w.y = cvt_pk_bf16(o[dt][4 * rg + 2] * inv, o[dt][4 * rg + 3] * inv);
                *(v2u*)(op + 32 * dt + 8 * rg) = w; }
        if (hi == 0) (G == 0 ? LSE0 : LSE1)[orow * NH + h] = lse2;
    } else {
        const float l0v = LSE0[orow * NH + h], l1v = LSE1[orow * NH + h];
        const float mm = fmaxf(fmaxf(l0v, l1v), lse2);
        const float w0 = __builtin_amdgcn_exp2f(l0v - mm), w1 = __builtin_amdgcn_exp2f(l1v - mm), w2 = __builtin_amdgcn_exp2f(lse2 - mm);
        const float wi = 1.0f / (w0 + w1 + w2);
        const float c0 = w0 * wi, c1 = w1 * wi, c2 = w2 * wi * inv;
        const bf16* p0 = O0 + orow * ATTW + h * HD + 4 * hi; const bf16* p1 = O1 + orow * ATTW + h * HD + 4 * hi;
        bf16* op = MIXIN + orow * DM + h * HD + 4 * hi;
#pragma unroll
        for (int dt = 0; dt < 4; ++dt)
#pragma unroll
            for (int rg = 0; rg < 4; ++rg) { const v2u a = *(const v2u*)(p0 + 32 * dt + 8 * rg), c = *(const v2u*)(p1 + 32 * dt + 8 * rg);
                const float y0 = c0 * bf_lo(a.x) + c1 * bf_lo(c.x) + c2 * o[dt][4 * rg], y1 = c0 * bf_hi(a.x) + c1 * bf_hi(c.x) + c2 * o[dt][4 * rg + 1];
                const float y2 = c0 * bf_lo(a.y) + c1 * bf_lo(c.y) + c2 * o[dt][4 * rg + 2], y3 = c0 * bf_hi(a.y) + c1 * bf_hi(c.y) + c2 * o[dt][4 * rg + 3];
                v2u w; w.x = cvt_pk_bf16(y0, y1); w.y = cvt_pk_bf16(y2, y3); *(v2u*)(op + 32 * dt + 8 * rg) = w;
                if (rg == 3) asm volatile("" ::: "memory"); }
    }
}

constexpr int PER_PHASE = 11;
struct Args { const float* in[16]; float* out; unsigned char* ws; int ph_lo, ph_hi; };

__constant__ unsigned char CAND_I[64] = {0,0,0,0,0,0,0,0,0,0,0,0,0,0,0,0, 1,1,1,1,1,1,1,1, 2,2,2,2,2, 3,3,3,3, 4,4,4, 5,5, 6,6, 7,7, 8,9,10,11,12,13,14,15, 0,0,0,0,0,0,0,0,0,0,0,0,0,0};
__constant__ unsigned char CAND_J[64] = {0,1,2,3,4,5,6,7,8,9,10,11,12,13,14,15, 0,1,2,3,4,5,6,7, 0,1,2,3,4, 0,1,2,3, 0,1,2, 0,1, 0,1, 0,1, 0,0,0,0,0,0,0,0, 0,0,0,0,0,0,0,0,0,0,0,0,0,0};

__global__ void __launch_bounds__(NWAVES * 64, 2) fwd_kernel(Args args) {
    extern __shared__ __attribute__((aligned(16))) unsigned char lds_raw[];
    LAS unsigned char* lds = (LAS unsigned char*)lds_raw;
    volatile LAS unsigned* MISC = (volatile LAS unsigned*)(lds + MISC_OFF);
    const int tid = threadIdx.x, lane = tid & 63, wave = __builtin_amdgcn_readfirstlane(tid >> 6);
    const int G = gridDim.x; const int bx = blockIdx.x;
    const int vcu = (G % 8 == 0) ? (bx % 8) * (G / 8) + bx / 8 : bx;
    const int gw = vcu * NWAVES + wave, NGW = G * NWAVES;
    unsigned char* ws = args.ws;
    unsigned* ctl = (unsigned*)(ws + WS_CTL);
    const float* x = args.in[0]; const float* cvec = args.in[1]; const float* w_ada = args.in[2]; const float* b_ada = args.in[3]; const float* g_mix = args.in[4];
    const float* w_in = args.in[5]; const float* rel_bias = args.in[6]; const float* pool_w = args.in[7]; const float* pool_scale = args.in[8]; const float* w_out = args.in[9];
    const float* g_ffn = args.in[10]; const float* peer_wq = args.in[11]; const float* peer_sk = args.in[12]; const float* peer_u = args.in[13]; const float* peer_v = args.in[14];
    const float* g_final = args.in[15];
    float* out = args.out;
    float* MODV = (float*)(ws + WS_MODV); float* MODP = (float*)(ws + WS_MODP);
    bf16* SKT = (bf16*)(ws + WS_SKT); bf16* POOLWT = (bf16*)(ws + WS_POOLWT); bf16* WQT = (bf16*)(ws + WS_WQT); bf16* WOUTT = (bf16*)(ws + WS_WOUTT); bf16* WINT = (bf16*)(ws + WS_WINT);
    bf16* UB = (bf16*)(ws + WS_UB); bf16* VB = (bf16*)(ws + WS_VB); bf16* H = (bf16*)(ws + WS_H); bf16* PROJ = (bf16*)(ws + WS_PROJ); bf16* MIXIN = (bf16*)(ws + WS_MIXIN);
    bf16* POOLIN = (bf16*)(ws + WS_POOLIN); bf16* O0 = (bf16*)(ws + WS_O0); bf16* O1 = (bf16*)(ws + WS_O1); float* LSE = (float*)(ws + WS_LSE);
    bf16* QP = (bf16*)(ws + WS_QP); float* SC = (float*)(ws + WS_SC);

    for (int u = tid; u < (LDS_BYTES - LDSCTL_OFF) / 4; u += NWAVES * 64) ((LAS unsigned*)(lds + LDSCTL_OFF))[u] = 0u;
    __syncthreads();
    XcdBarrier bar; bar.bar = ctl + CW_BAR; bar.x = 0; bar.st = nullptr;
    if (MK_N_LAUNCHES != PER_PHASE) bar = xcd_barrier_post(ctl + CW_BAR, MISC + 8);
#define GRID_BAR() do { if (MK_N_LAUNCHES != PER_PHASE) xcd_barrier(bar); } while (0)
    const int lo = args.ph_lo, hi_ph = args.ph_hi;
#ifndef PH_MASK
#define PH_MASK 0x7ff
#endif
#define IN(k) ((((PH_MASK) >> (k)) & 1) && lo <= (k) && (k) < hi_ph)
#define BOTH(k) (IN(k) && IN((k) + 1))

    if (IN(0)) {
        LAS float* silu = (LAS float*)(lds + RING_OFF);
        for (int i = tid; i < BATCH * DM; i += NWAVES * 64) { const float v = cvec[i]; silu[i] = v / (1.0f + __expf(-v)); }
        __syncthreads();
        for (int task = gw; task < (NMOD / 256) * KS_ADA; task += NGW) {
            const int cg = task % (NMOD / 256), ks = task / (NMOD / 256); const int k0 = ks * (DM / KS_ADA), n0 = cg * 256 + 4 * lane;
            f32x4 a0 = {0.f, 0.f, 0.f, 0.f}, a1 = {0.f, 0.f, 0.f, 0.f};
            const float* wp = w_ada + (size_t)k0 * NMOD + n0;
#pragma unroll 8
            for (int kk = 0; kk < DM / KS_ADA; ++kk) { const f32x4 w4 = *(const f32x4*)(wp + (size_t)kk * NMOD); const float s0 = silu[k0 + kk], s1 = silu[DM + k0 + kk]; a0 += w4 * s0; a1 += w4 * s1; }
            *(f32x4*)(MODP + ((size_t)(ks * 2 + 0)) * NMOD + n0) = a0; *(f32x4*)(MODP + ((size_t)(ks * 2 + 1)) * NMOD + n0) = a1;
        }
        __syncthreads();
        {
            LAS float* scr = (LAS float*)(lds + RING_OFF + wave * 16384);
            constexpr int I_IN = (DM / 64) * (INW / 32), I_OUT = (DM / 64) * (DM / 32), I_Q = (DM / 64) * (PQ / 32), I_PG = (512 / 64) * (512 / 32);
            constexpr int NITEMS = I_IN + I_OUT + I_Q + 4 * I_PG;
            for (int it = gw; it < NITEMS; it += NGW) {
                int r = it;
                if (r < I_IN) { p0_transpose_item(w_in, DM, INW, WINT, 0, scr, r, lane); continue; } r -= I_IN;
                if (r < I_OUT) { p0_transpose_item(w_out, DM, DM, WOUTT, 0, scr, r, lane); continue; } r -= I_OUT;
                if (r < I_Q) { p0_transpose_item(peer_wq, DM, PQ, WQT, 0, scr, r, lane); continue; } r -= I_Q;
                const int gi = r / I_PG; p0_transpose_item(pool_w + (size_t)gi * 512 * 512, 512, 512, POOLWT, gi * 512, scr, r % I_PG, lane);
            }
        }
        {
            const size_t n8 = (size_t)NEXP * DM / 8;
            for (size_t i = (size_t)gw * 64 + lane; i < 2 * n8; i += (size_t)NGW * 64) {
                const bool isU = i < n8; const size_t j = isU ? i : i - n8;
                const float* src = (isU ? peer_u : peer_v) + j * 8; bf16* dst = (isU ? UB : VB) + j * 8;
                const f32x4 a = *(const f32x4*)src, c = *(const f32x4*)(src + 4);
                v4u w; w.x = cvt_pk_bf16(a[0], a[1]); w.y = cvt_pk_bf16(a[2], a[3]); w.z = cvt_pk_bf16(c[0], c[1]); w.w = cvt_pk_bf16(c[2], c[3]);
                *(v4u*)dst = w;
            }
        }
        for (int i = gw * 64 + lane; i < 2048 * 32; i += NGW * 64) {
            const int n = i >> 5, kc = (i & 31) * 8; const int p = (n >> 7) & 1, pp = kc >> 7;
            v4u w = {0u, 0u, 0u, 0u};
            if (p == pp) { const float* src = peer_sk + (size_t)n * 128 + (kc & 127); const f32x4 a = *(const f32x4*)src, c = *(const f32x4*)(src + 4);
                w.x = cvt_pk_bf16(a[0], a[1]); w.y = cvt_pk_bf16(a[2], a[3]); w.z = cvt_pk_bf16(c[0], c[1]); w.w = cvt_pk_bf16(c[2], c[3]); }
            *(v4u*)(SKT + (size_t)n * 256 + kc) = w;
        }
        if (BOTH(0)) GRID_BAR();
    }

    if (IN(1)) {
        for (int i = bx * (NWAVES * 64) + tid; i < BATCH * NMOD; i += G * NWAVES * 64) {
            const int b = i / NMOD, n = i % NMOD; float s = b_ada[n];
#pragma unroll 8
            for (int ks = 0; ks < KS_ADA; ++ks) s += MODP[(size_t)(ks * 2 + b) * NMOD + n];
            const int j = n / DM, c = n % DM;
            MODV[(size_t)(j * 2 + b) * DM + c] = s;
        }
        if (BOTH(1)) GRID_BAR();
    }

    if (IN(2)) {
        for (int row = gw; row < M; row += NGW) {
            const int b = row / SEQ;
            const f32x4* xr = (const f32x4*)(x + (size_t)row * DM) + lane;
            f32x4 v[16]; float ss = 0.f;
#pragma unroll
            for (int j = 0; j < 16; ++j) { v[j] = xr[64 * j]; ss += (v[j][0] * v[j][0] + v[j][1] * v[j][1]) + (v[j][2] * v[j][2] + v[j][3] * v[j][3]); }
            const float rstd = 1.0f / sqrtf(wave_sum(ss) * (1.0f / DM) + RMS_EPS);
            const f32x4* gp = (const f32x4*)g_mix + lane; const f32x4* shp = (const f32x4*)(MODV + (size_t)(0 * 2 + b) * DM) + lane; const f32x4* scp = (const f32x4*)(MODV + (size_t)(1 * 2 + b) * DM) + lane;
            v2u* op = (v2u*)(H + (size_t)row * DM) + lane;
#pragma unroll
            for (int j = 0; j < 16; ++j) { const f32x4 g4 = gp[64 * j], sh = shp[64 * j], sc = scp[64 * j];
                const f32x4 y = (v[j] * rstd) * g4 * (sc + 1.0f) + sh;
                v2u w; w.x = cvt_pk_bf16(y[0], y[1]); w.y = cvt_pk_bf16(y[2], y[3]); op[64 * j] = w; }
        }
        if (BOTH(2)) GRID_BAR();
    }

    if (IN(3)) {
        pg8::Gemm g{H, WINT, M, INW, DM, DM, DM, 1 << 30, 0}; pg8::StaticOrder S; S.init(M, INW, G, bx);
        pg8::EpiBf16 E{PROJ, INW, ATTW, QSCALE};
        pg8::gemm_phase<pg8::EpiBf16, pg8::StaticOrder, true>(lds + RING_OFF, g, S, E);
        if (BOTH(3)) GRID_BAR();
    }

    if (IN(4)) {
        LAS float* btab = (LAS float*)(lds + SHARED_OFF);
        LAS unsigned char* vt = lds + RING_OFF + wave * 16384;
        for (int unit = bx; unit < BATCH * NH * (SEQ / 1024); unit += G) {
            const int b = unit >> 7, h = (unit >> 3) & 15, mt = unit & 7;
            __syncthreads();
            for (int i = tid; i < 3 * 256; i += NWAVES * 64) { const int gi = i >> 8, ri = (i & 255) - 32; const int dil = gi == 0 ? 1 : (gi == 1 ? 4 : 16);
                btab[i] = (ri >= 0 && ri <= 128) ? rel_bias[t5_bucket((ri - 64) * dil) * NH + h] * LOG2E : -1e30f; }
            __syncthreads();
            for (int g = 0; g < 3; ++g) {
                if (g == 2) { VM_WAIT(); __syncthreads(); }
                for (int tk = wave; tk < 32; tk += NWAVES) attn_task(g, PROJ, O0, O1, LSE, LSE + (size_t)M * NH, MIXIN, btab, vt, b, h, mt, tk, lane);
            }
        }
        for (int i = bx * (NWAVES * 64) + tid; i < M * (POOLW / 8); i += G * NWAVES * 64) {
            const int token = i >> 8, cc = i & 255; const int gi = cc >> 6, half = 1 << gi;
            const int b = token / SEQ, pos = token % SEQ;
            const int plo = pos - half < 0 ? 0 : pos - half, phi = pos + half > SEQ ? SEQ : pos + half;
            float s[8] = {0.f, 0.f, 0.f, 0.f, 0.f, 0.f, 0.f, 0.f};
            const bf16* base = PROJ + (size_t)b * SEQ * INW + 3 * ATTW + cc * 8;
            for (int pp = plo; pp < phi; ++pp) { const v4u w = *(const v4u*)(base + (size_t)pp * INW);
                s[0] += bf_lo(w.x); s[1] += bf_hi(w.x); s[2] += bf_lo(w.y); s[3] += bf_hi(w.y); s[4] += bf_lo(w.z); s[5] += bf_hi(w.z); s[6] += bf_lo(w.w); s[7] += bf_hi(w.w); }
            const v4u me = *(const v4u*)(base + (size_t)pos * INW);
            const float inv = 1.0f / (float)(phi - plo);
            v4u w; w.x = cvt_pk_bf16(s[0] * inv - bf_lo(me.x), s[1] * inv - bf_hi(me.x)); w.y = cvt_pk_bf16(s[2] * inv - bf_lo(me.y), s[3] * inv - bf_hi(me.y));
            w.z = cvt_pk_bf16(s[4] * inv - bf_lo(me.z), s[5] * inv - bf_hi(me.z)); w.w = cvt_pk_bf16(s[6] * inv - bf_lo(me.w), s[7] * inv - bf_hi(me.w));
            *(v4u*)(POOLIN + (size_t)token * POOLW + cc * 8) = w;
        }
        if (BOTH(4)) GRID_BAR();
    }

    if (IN(5)) {
        pg8::Gemm g{POOLIN, POOLWT, M, POOLW, 512, POOLW, 512, 2, 512}; pg8::StaticOrder S; S.init(M, POOLW, G, bx);
        pg8::EpiBf16ColScale E{MIXIN, DM, ATTW, pool_scale};
        pg8::gemm_phase<pg8::EpiBf16ColScale, pg8::StaticOrder, true>(lds + RING_OFF, g, S, E);
        if (BOTH(5)) GRID_BAR();
    }

    if (IN(6)) {
        pg8::Gemm g{MIXIN, WOUTT, M, DM, DM, DM, DM, 1 << 30, 0}; pg8::StaticOrder S; S.init(M, DM, G, bx);
        pg8::EpiResF32 E{x, MODV + (size_t)(2 * 2) * DM, out, DM};
        pg8::gemm_phase<pg8::EpiResF32, pg8::StaticOrder, true>(lds + RING_OFF, g, S, E);
        if (BOTH(6)) GRID_BAR();
    }

    if (IN(7)) {
        for (int row = gw; row < M; row += NGW) {
            const int b = row / SEQ;
            const f32x4* xr = (const f32x4*)(out + (size_t)row * DM) + lane;
            f32x4 v[16]; float ss = 0.f;
#pragma unroll
            for (int j = 0; j < 16; ++j) { v[j] = xr[64 * j]; ss += (v[j][0] * v[j][0] + v[j][1] * v[j][1]) + (v[j][2] * v[j][2] + v[j][3] * v[j][3]); }
            const float rstd = 1.0f / sqrtf(wave_sum(ss) * (1.0f / DM) + RMS_EPS);
            const f32x4* gp = (const f32x4*)g_ffn + lane; const f32x4* shp = (const f32x4*)(MODV + (size_t)(3 * 2 + b) * DM) + lane; const f32x4* scp = (const f32x4*)(MODV + (size_t)(4 * 2 + b) * DM) + lane;
            v2u* op = (v2u*)(H + (size_t)row * DM) + lane;
#pragma unroll
            for (int j = 0; j < 16; ++j) { const f32x4 g4 = gp[64 * j], sh = shp[64 * j], sc = scp[64 * j];
                const f32x4 y = (v[j] * rstd) * g4 * (sc + 1.0f) + sh;
                v2u w; w.x = cvt_pk_bf16(y[0], y[1]); w.y = cvt_pk_bf16(y[2], y[3]); op[64 * j] = w; }
        }
        if (BOTH(7)) GRID_BAR();
    }

    if (IN(8)) {
        pg8::Gemm g{H, WQT, M, PQ, DM, DM, DM, 1 << 30, 0}; pg8::StaticOrder S; S.init(M, PQ, G, bx);
        pg8::EpiBf16 E{QP, PQ, 0, 1.0f};
        pg8::gemm_phase<pg8::EpiBf16, pg8::StaticOrder, true>(lds + RING_OFF, g, S, E);
        if (BOTH(8)) GRID_BAR();
    }

    if (IN(9)) {
        pg8::Gemm g{QP, SKT, M, PQ, 256, PQ, 256, 1, 256}; pg8::StaticOrder S; S.init(M, PQ, G, bx);
        pg8::EpiF32 E{SC, PQ};
        pg8::gemm_phase<pg8::EpiF32, pg8::StaticOrder, true>(lds + RING_OFF, g, S, E);
        if (BOTH(9)) GRID_BAR();
    }

    if (IN(10)) {
        LAS unsigned* W = (LAS unsigned*)(lds + RING_OFF + wave * 16384);
        LAS unsigned* K1 = W; LAS unsigned* K2 = W + 128;
        LAS float* TV1 = (LAS float*)(W + 256); LAS int* TI1 = (LAS int*)(W + 272); LAS float* TV2 = (LAS float*)(W + 288); LAS int* TI2 = (LAS int*)(W + 304);
        LAS unsigned* CK = W + 320; LAS float* SV = (LAS float*)(W + 384); LAS int* SE = (LAS int*)(W + 400);
        LAS int* EXP = (LAS int*)(W + 416); LAS float* GAT = (LAS float*)(W + 544); LAS float* ACT = (LAS float*)(W + 672);
        for (int t = gw; t < M; t += NGW) {
            const int b = t / SEQ;
            for (int h = 0; h < 8; ++h) {
                const float* sp = SC + (size_t)t * PQ + h * 256;
                const float a0 = sp[lane], a1 = sp[64 + lane], b0 = sp[128 + lane], b1 = sp[192 + lane];
                const unsigned ka0 = (fkey(a0) & ~127u) | (unsigned)(127 - lane), ka1 = (fkey(a1) & ~127u) | (unsigned)(63 - lane);
                const unsigned kb0 = (fkey(b0) & ~127u) | (unsigned)(127 - lane), kb1 = (fkey(b1) & ~127u) | (unsigned)(63 - lane);
                K1[lane] = ka0; K1[64 + lane] = ka1; K2[lane] = kb0; K2[64 + lane] = kb1;
                LDS_WAIT();
                int ra0 = 0, ra1 = 0, rb0 = 0, rb1 = 0;
#pragma unroll 8
                for (int kk = 0; kk < 32; ++kk) { const v4u q = ((const LAS v4u*)K1)[kk], r = ((const LAS v4u*)K2)[kk];
                    ra0 += (q.x > ka0) + (q.y > ka0) + (q.z > ka0) + (q.w > ka0); ra1 += (q.x > ka1) + (q.y > ka1) + (q.z > ka1) + (q.w > ka1);
                    rb0 += (r.x > kb0) + (r.y > kb0) + (r.z > kb0) + (r.w > kb0); rb1 += (r.x > kb1) + (r.y > kb1) + (r.z > kb1) + (r.w > kb1); }
                if (ra0 < 16) { TV1[ra0] = a0; TI1[ra0] = lane; } if (ra1 < 16) { TV1[ra1] = a1; TI1[ra1] = 64 + lane; }
                if (rb0 < 16) { TV2[rb0] = b0; TI2[rb0] = lane; } if (rb1 < 16) { TV2[rb1] = b1; TI2[rb1] = 64 + lane; }
                LDS_WAIT();
                const int ci_i = CAND_I[lane], ci_j = CAND_J[lane];
                const float cv = TV1[ci_i] + TV2[ci_j];
                const unsigned ck = lane < 50 ? ((fkey(cv) & ~255u) | (unsigned)(255 - (ci_i * 16 + ci_j))) : 0u;
                CK[lane] = ck;
                LDS_WAIT();
                int rc = 0;
#pragma unroll 8
                for (int kk = 0; kk < 16; ++kk) { const v4u q = ((const LAS v4u*)CK)[kk]; rc += (q.x > ck) + (q.y > ck) + (q.z > ck) + (q.w > ck); }
                if (lane < 50 && rc < 16) { SV[rc] = cv; SE[rc] = TI1[ci_i] * 128 + TI2[ci_j]; }
                LDS_WAIT();
                const float top0 = SV[0], myv = SV[lane & 15]; const int mye = SE[lane & 15];
                const float e = __expf(myv - top0);
                float ssum = e; ssum += __shfl_xor(ssum, 1); ssum += __shfl_xor(ssum, 2); ssum += __shfl_xor(ssum, 4); ssum += __shfl_xor(ssum, 8);
                if (lane < 16) { EXP[h * 16 + lane] = mye; GAT[h * 16 + lane] = e / ssum; }
                LDS_WAIT();
            }
            v4u hv[8];
            { const v4u* hp = (const v4u*)(H + (size_t)t * DM) + lane;
#pragma unroll
              for (int i = 0; i < 8; ++i) hv[i] = hp[64 * i]; }
#pragma unroll 2
            for (int k = 0; k < 128; ++k) {
                const int e = __builtin_amdgcn_readfirstlane(EXP[k]);
                const v4u* up = (const v4u*)(UB + (size_t)e * DM) + lane;
                float a = 0.f;
#pragma unroll
                for (int i = 0; i < 8; ++i) { const v4u uv = up[64 * i]; a = dot2bf(uv.x, hv[i].x, a); a = dot2bf(uv.y, hv[i].y, a); a = dot2bf(uv.z, hv[i].z, a); a = dot2bf(uv.w, hv[i].w, a); }
                a = wave_sum(a);
                if (lane == 0) ACT[k] = gelu_tanh(a) * GAT[k];
            }
            LDS_WAIT();
            float o[8][8];
#pragma unroll
            for (int i = 0; i < 8; ++i)
#pragma unroll
                for (int j = 0; j < 8; ++j) o[i][j] = 0.f;
#pragma unroll 2
            for (int k = 0; k < 128; ++k) {
                const int e = __builtin_amdgcn_readfirstlane(EXP[k]);
                const float av = ACT[k];
                const v4u* vp = (const v4u*)(VB + (size_t)e * DM) + lane;
#pragma unroll
                for (int i = 0; i < 8; ++i) { const v4u vv = vp[64 * i];
                    o[i][0] += av * bf_lo(vv.x); o[i][1] += av * bf_hi(vv.x); o[i][2] += av * bf_lo(vv.y); o[i][3] += av * bf_hi(vv.y);
                    o[i][4] += av * bf_lo(vv.z); o[i][5] += av * bf_hi(vv.z); o[i][6] += av * bf_lo(vv.w); o[i][7] += av * bf_hi(vv.w); }
            }
            float ss = 0.f;
            const float* gtp = MODV + (size_t)(5 * 2 + b) * DM;
#pragma unroll
            for (int i = 0; i < 8; ++i) { const int d = 8 * lane + 512 * i;
                const f32x4 x0 = *(const f32x4*)(out + (size_t)t * DM + d), x1v = *(const f32x4*)(out + (size_t)t * DM + d + 4);
                const f32x4 g0 = *(const f32x4*)(gtp + d), g1 = *(const f32x4*)(gtp + d + 4);
#pragma unroll
                for (int j = 0; j < 4; ++j) { o[i][j] = x0[j] + g0[j] * o[i][j]; o[i][4 + j] = x1v[j] + g1[j] * o[i][4 + j]; ss += o[i][j] * o[i][j] + o[i][4 + j] * o[i][4 + j]; } }
            const float rstd = 1.0f / sqrtf(wave_sum(ss) * (1.0f / DM) + RMS_EPS);
#pragma unroll
            for (int i = 0; i < 8; ++i) { const int d = 8 * lane + 512 * i;
                const f32x4 g0 = *(const f32x4*)(g_final + d), g1 = *(const f32x4*)(g_final + d + 4);
                f32x4 y0, y1;
#pragma unroll
                for (int j = 0; j < 4; ++j) { y0[j] = o[i][j] * rstd * g0[j]; y1[j] = o[i][4 + j] * rstd * g1[j]; }
                *(f32x4*)(out + (size_t)t * DM + d) = y0; *(f32x4*)(out + (size_t)t * DM + d + 4) = y1; }
        }
    }
#undef IN
#undef BOTH
#undef GRID_BAR
}

extern "C" void kernel_launch(void* const* d_in, const int* in_sizes, int n_in, void* d_out, int out_size, void* d_ws, size_t ws_size, hipStream_t stream) {
    static int grid = 0;
    if (grid == 0) {
        if (n_in != 16 || in_sizes[0] != M * DM || out_size != M * DM || ws_size < WS_END) {
            fprintf(stderr, "kernel_launch: shape/workspace mismatch: n_in %d in0 %d out %d ws %zu (need %zu)\n", n_in, n_in > 0 ? in_sizes[0] : -1, out_size, ws_size, (size_t)WS_END); grid = -1; return; }
        int dev = 0, cus = 0, per_cu = 0;
        if (hipGetDevice(&dev) != hipSuccess || hipDeviceGetAttribute(&cus, hipDeviceAttributeMultiprocessorCount, dev) != hipSuccess) { grid = -1; return; }
        if (hipFuncSetAttribute((const void*)fwd_kernel, hipFuncAttributeMaxDynamicSharedMemorySize, LDS_BYTES) != hipSuccess) { fprintf(stderr, "kernel_launch: hipFuncSetAttribute failed\n"); grid = -1; return; }
        if (hipOccupancyMaxActiveBlocksPerMultiprocessor(&per_cu, (const void*)fwd_kernel, NWAVES * 64, LDS_BYTES) != hipSuccess || per_cu < 1)
            fprintf(stderr, "kernel_launch: note: occupancy query reports %d workgroups per CU\n", per_cu);
        (void)hipGetLastError();
        grid = cus;
    }
    if (grid < 0) return;
    if (hipMemsetAsync((char*)d_ws + WS_CTL, 0, CTL_ZERO_BYTES, stream) != hipSuccess) { fprintf(stderr, "kernel_launch: memset failed\n"); return; }
    Args a{};
    for (int i = 0; i < 16; ++i) a.in[i] = (const float*)d_in[i];
    a.out = (float*)d_out; a.ws = (unsigned char*)d_ws;
    for (int li = 0; li < MK_N_LAUNCHES; ++li) {
        a.ph_lo = (MK_N_LAUNCHES == PER_PHASE) ? li : 0; a.ph_hi = (MK_N_LAUNCHES == PER_PHASE) ? li + 1 : PER_PHASE;
        hipLaunchKernelGGL(fwd_kernel, dim3(grid), dim3(NWAVES * 64), LDS_BYTES, stream, a);
        const hipError_t le = hipPeekAtLastError();
        if (le != hipSuccess) { fprintf(stderr, "kernel_launch: launch %d failed: %s\n", li, hipGetErrorName(le)); break; }
    }
}
```

```cpp
#include <hip/hip_runtime.h>
#include <cstdio>
#include <cstdint>

#ifndef MK_N_LAUNCHES
#define MK_N_LAUNCHES 1
#endif

#define GAS __attribute__((address_space(1)))
#define LAS __attribute__((address_space(3)))
typedef unsigned short bf16;
typedef unsigned v4u __attribute__((ext_vector_type(4)));
typedef unsigned v2u __attribute__((ext_vector_type(2)));
typedef float f32x4 __attribute__((ext_vector_type(4)));
typedef float f32x2 __attribute__((ext_vector_type(2)));
typedef float f32x16 __attribute__((ext_vector_type(16)));
typedef short bf16x8 __attribute__((ext_vector_type(8)));
typedef short s16x4 __attribute__((ext_vector_type(4)));
typedef __bf16 bf2_t __attribute__((ext_vector_type(2)));

constexpr int BATCH = 2, SEQ = 8192, DM = 4096, M = BATCH * SEQ;
constexpr int NH = 16, HD = 128, ATTW = 2048, POOLW = 2048, INW = 8192;
constexpr int NMOD = 6 * DM;
constexpr int PQ = 2048;
constexpr int NEXP = 16384;
constexpr float RMS_EPS = 1e-6f;
constexpr float LOG2E = 1.4426950408889634f;
constexpr float QSCALE = 0.08838834764831845f * LOG2E;
constexpr int KS_ADA = 64;

constexpr size_t MiB = 1u << 20;
constexpr size_t WS_CTL = 0, CTL_ZERO_BYTES = 1 * MiB;
constexpr size_t WS_MODV = 1 * MiB;
constexpr size_t WS_SCL = 2 * MiB;
constexpr size_t WS_MODP = 4 * MiB;
constexpr size_t WS_SKT = 20 * MiB;
constexpr size_t WS_POOLWT = 22 * MiB;
constexpr size_t WS_WQT = 24 * MiB;
constexpr size_t WS_WOUTT = 40 * MiB;
constexpr size_t WS_WINT = 72 * MiB;
constexpr size_t WS_UB = 136 * MiB;
constexpr size_t WS_VB = 264 * MiB;
constexpr size_t WS_H = 392 * MiB;
constexpr size_t WS_PROJ = 520 * MiB;
constexpr size_t WS_MIXIN = 776 * MiB;
constexpr size_t WS_POOLIN = 904 * MiB;
constexpr size_t WS_O0 = 968 * MiB, WS_O1 = 1032 * MiB;
constexpr size_t WS_LSE = 1096 * MiB;
constexpr size_t WS_QP = 1100 * MiB;
constexpr size_t WS_SC = 1164 * MiB;
constexpr size_t WS_END = 1292 * MiB;

constexpr int RING_OFF = 0, RING_BYTES = 131072;
constexpr int SHARED_OFF = 131072;
constexpr int LDSCTL_OFF = 131072 + 8192, MISC_OFF = LDSCTL_OFF + 320;
constexpr int LDS_BYTES = 147456;
constexpr int NWAVES = 8;
constexpr int CW_BAR = 4096;

#define LDS_WAIT() asm volatile("s_waitcnt lgkmcnt(0)" ::: "memory")
#define VM_WAIT() asm volatile("s_waitcnt vmcnt(0)" ::: "memory")

__device__ __forceinline__ unsigned cvt_pk_bf16(float lo, float hi) { unsigned r; asm volatile("v_cvt_pk_bf16_f32 %0, %1, %2" : "=v"(r) : "v"(lo), "v"(hi)); return r; }
__device__ __forceinline__ float bf_lo(unsigned u) { return __uint_as_float(u << 16); }
__device__ __forceinline__ float bf_hi(unsigned u) { return __uint_as_float(u & 0xffff0000u); }
__device__ __forceinline__ float wave_sum(float v) {
#pragma unroll
    for (int o = 1; o < 64; o <<= 1) v += __shfl_xor(v, o);
    return v;
}

namespace pg8 {
typedef unsigned short bf16_t;
constexpr int BM = 256, BK = 64, HALF = 128, HTB = HALF * BK * 2, STAGE_BYTES = 8 * HTB, NXCD = 8, WGM = 8;

__host__ __device__ __forceinline__ int lds_byte(int r, int c) { const int st = (r >> 4) * 2 + (c >> 5), rr = r & 15, cc = c & 31, ob = rr * 64 + cc * 2; return st * 1024 + (ob ^ (((ob >> 9) & 1) << 5)); }
__host__ __device__ __forceinline__ void stage_rc(int b, int& R, int& C) { const int st = b / 1024, sb = b % 1024, swz = sb ^ (((sb >> 9) & 1) << 5); R = (st >> 1) * 16 + swz / 64; C = (st & 1) * 32 + (swz % 64) / 2; }
__host__ __device__ __forceinline__ int perm32(int rho) { const int n = rho >> 4, i = rho & 15; return 8 * (i >> 2) + 4 * n + (i & 3); }

struct Unit { int pm, pn; };
struct Gemm { const bf16_t* A; const bf16_t* Bt; int M, N, K, lda, ldb, agrp_div, agrp_cols; };

struct StaticOrder {
    int nM, nN, nwg, G, c;
    __host__ __device__ void init(int M_, int N_, int G_, int c_) { nM = M_ / BM; nN = N_ / BM; nwg = nM * nN; G = G_; c = c_; }
    __host__ __device__ bool next(int i, Unit& u) const {
        const long L = (long)i * G + c; if (L >= nwg) return false;
        int wgid = (int)L; { const int q = nwg / NXCD, r = nwg % NXCD, xcd = wgid % NXCD, off = wgid / NXCD; wgid = (xcd < r ? xcd * (q + 1) : r * (q + 1) + (xcd - r) * q) + off; }
        const int nig = WGM * nN, gid = wgid / nig, fm = gid * WGM, gsz = (nM - fm) < WGM ? (nM - fm) : WGM;
        u.pm = fm + ((wgid % nig) % gsz); u.pn = (wgid % nig) / gsz; return true;
    }
    __device__ __forceinline__ void a_ready(const Unit&) const {}
    __device__ __forceinline__ void done(const Unit&) const {}
};

struct EpiBf16 {
    static constexpr bool PERM = true, AFTER_DRAIN = false;
    bf16_t* O; int ldc; int scale_cols; float scale0;
    __device__ __forceinline__ void operator()(const f32x4 (&acc)[2][2][4][2], const Unit& u, int wr, int wc, int fr, int fq) const {
        const int row0 = u.pm * BM + wr * 64 + fr; const int colt = u.pn * BM;
        const float sc = (colt < scale_cols) ? scale0 : 1.f;
        const int col0 = colt + wc * 32 + 8 * fq;
#pragma unroll
        for (int ai = 0; ai < 2; ++ai)
#pragma unroll
            for (int m = 0; m < 4; ++m) { bf16_t* rowp = O + (size_t)(row0 + ai * HALF + m * 16) * ldc + col0;
#pragma unroll
                for (int bj = 0; bj < 2; ++bj) { f32x4 v0 = acc[ai][bj][m][0] * sc, v1 = acc[ai][bj][m][1] * sc;
                    v4u w; w.x = cvt_pk_bf16(v0[0], v0[1]); w.y = cvt_pk_bf16(v0[2], v0[3]); w.z = cvt_pk_bf16(v1[0], v1[1]); w.w = cvt_pk_bf16(v1[2], v1[3]);
                    *(v4u*)(rowp + bj * HALF) = w; } }
    }
};
struct EpiBf16ColScale {
    static constexpr bool PERM = true, AFTER_DRAIN = false;
    bf16_t* O; int ldc; int coff; const float* cs;
    __device__ __forceinline__ void operator()(const f32x4 (&acc)[2][2][4][2], const Unit& u, int wr, int wc, int fr, int fq) const {
        const int row0 = u.pm * BM + wr * 64 + fr; const int col0 = u.pn * BM + wc * 32 + 8 * fq;
        f32x4 sv[2][2];
#pragma unroll
        for (int bj = 0; bj < 2; ++bj)
#pragma unroll
            for (int n = 0; n < 2; ++n) sv[bj][n] = *(const f32x4*)(cs + col0 + bj * HALF + 4 * n);
#pragma unroll
        for (int ai = 0; ai < 2; ++ai)
#pragma unroll
            for (int m = 0; m < 4; ++m) { bf16_t* rowp = O + (size_t)(row0 + ai * HALF + m * 16) * ldc + coff + col0;
#pragma unroll
                for (int bj = 0; bj < 2; ++bj) { f32x4 v0 = acc[ai][bj][m][0] * sv[bj][0], v1 = acc[ai][bj][m][1] * sv[bj][1];
                    v4u w; w.x = cvt_pk_bf16(v0[0], v0[1]); w.y = cvt_pk_bf16(v0[2], v0[3]); w.z = cvt_pk_bf16(v1[0], v1[1]); w.w = cvt_pk_bf16(v1[2], v1[3]);
                    *(v4u*)(rowp + bj * HALF) = w; } }
    }
};
struct EpiResF32 {
    static constexpr bool PERM = false, AFTER_DRAIN = false;
    const float* X; const float* gate; float* O; int ldc;
    __device__ __forceinline__ void operator()(const f32x4 (&acc)[2][2][4][2], const Unit& u, int wr, int wc, int fr, int fq) const {
        const int row0 = u.pm * BM + wr * 64 + fr; const int col0 = u.pn * BM + wc * 32 + 4 * fq; const int b = (u.pm * BM) / SEQ;
        f32x4 gv[2][2];
#pragma unroll
        for (int bj = 0; bj < 2; ++bj)
#pragma unroll
            for (int n = 0; n < 2; ++n) gv[bj][n] = *(const f32x4*)(gate + (size_t)b * DM + col0 + bj * HALF + n * 16);
#pragma unroll
        for (int ai = 0; ai < 2; ++ai)
#pragma unroll
            for (int m = 0; m < 4; ++m) { const size_t off = (size_t)(row0 + ai * HALF + m * 16) * ldc + col0;
#pragma unroll
                for (int bj = 0; bj < 2; ++bj)
#pragma unroll
                    for (int n = 0; n < 2; ++n) { const f32x4 xv = *(const f32x4*)(X + off + bj * HALF + n * 16);
                        *(f32x4*)(O + off + bj * HALF + n * 16) = xv + gv[bj][n] * acc[ai][bj][m][n]; } }
    }
};
struct EpiF32 {
    static constexpr bool PERM = false, AFTER_DRAIN = false;
    float* O; int ldc;
    __device__ __forceinline__ void operator()(const f32x4 (&acc)[2][2][4][2], const Unit& u, int wr, int wc, int fr, int fq) const {
        const int row0 = u.pm * BM + wr * 64 + fr; const int col0 = u.pn * BM + wc * 32 + 4 * fq;
#pragma unroll
        for (int ai = 0; ai < 2; ++ai)
#pragma unroll
            for (int m = 0; m < 4; ++m) { const size_t off = (size_t)(row0 + ai * HALF + m * 16) * ldc + col0;
#pragma unroll
                for (int bj = 0; bj < 2; ++bj)
#pragma unroll
                    for (int n = 0; n < 2; ++n) *(f32x4*)(O + off + bj * HALF + n * 16) = acc[ai][bj][m][n]; }
    }
};

template <class Epi, class Sched, bool ALIGN_EPI>
__device__ __forceinline__ void gemm_phase(LAS unsigned char* lds, const Gemm g, const Sched& S, const Epi& E) {
    const int tid = threadIdx.x, wid = __builtin_amdgcn_readfirstlane(tid >> 6), lane = tid & 63, wr = wid >> 2, wc = wid & 3, fr = lane & 15, fq = lane >> 4;
    const int K = g.K, nt = K / BK;
    unsigned voffA[2], voffB[2];
#pragma unroll
    for (int i = 0; i < 2; ++i) { int R, C; stage_rc(tid * 16 + i * 8192, R, C); const int Rb = Epi::PERM ? ((R & ~31) + perm32(R & 31)) : R;
        voffA[i] = (unsigned)(R * g.lda + C) * 2u; voffB[i] = (unsigned)(Rb * g.ldb + C) * 2u; }
    const size_t kstep = (size_t)(BK * 2);
    const size_t hstepA = (size_t)HALF * g.lda * 2, hstepB = (size_t)HALF * g.ldb * 2;
    const size_t tstepA = 2 * hstepA, tstepB = 2 * hstepB;
    const unsigned ldsw = (unsigned)wid * 1024u;
    const int aoff = lds_byte(wr * 64 + fr, fq * 8), boff = lds_byte(wc * 32 + fr, fq * 8);
#define PG8_SA(b, h) (((b) * 2 + (h)) * HTB)
#define PG8_SB(b, h) ((4 + (b) * 2 + (h)) * HTB)
#define PG8_STAGE(bufoff, gbase, voff) do { _Pragma("unroll") for (int _i = 0; _i < 2; ++_i) \
        __builtin_amdgcn_global_load_lds((const unsigned*)((const char*)(gbase) + (voff)[_i]), (LAS unsigned*)(lds + (bufoff) + ldsw + _i * 8192), 16, 0, 0); } while (0)
#define PG8_LDA(dst, b, h) do { _Pragma("unroll") for (int m = 0; m < 4; ++m) _Pragma("unroll") for (int k = 0; k < 2; ++k) dst[m][k] = *(const LAS bf16x8*)(lds + PG8_SA(b, h) + aoff + m * 2048 + k * 1024); } while (0)
#define PG8_LDB(dst, b, h) do { _Pragma("unroll") for (int n = 0; n < 2; ++n) _Pragma("unroll") for (int k = 0; k < 2; ++k) dst[n][k] = *(const LAS bf16x8*)(lds + PG8_SB(b, h) + boff + n * 2048 + k * 1024); } while (0)
#define PG8_MMA(ai, bj, At, Bt) do { __builtin_amdgcn_s_setprio(1); _Pragma("unroll") for (int m = 0; m < 4; ++m) _Pragma("unroll") for (int n = 0; n < 2; ++n) _Pragma("unroll") for (int k = 0; k < 2; ++k) \
        acc[ai][bj][m][n] = __builtin_amdgcn_mfma_f32_16x16x32_bf16(Bt[n][k], At[m][k], acc[ai][bj][m][n], 0, 0, 0); __builtin_amdgcn_s_setprio(0); } while (0)
#define PG8_WAIT_V(n) asm volatile("s_waitcnt vmcnt(" #n ")" ::: "memory")
#define PG8_WAIT_L(n) asm volatile("s_waitcnt lgkmcnt(" #n ")" ::: "memory")
#define PG8_BAR __builtin_amdgcn_s_barrier()
#define PG8_SCHED __builtin_amdgcn_sched_barrier(0)
#define PG8_ABASE(u) ((const char*)g.A + (size_t)(u).pm * tstepA + (size_t)((u).pn / g.agrp_div) * (size_t)g.agrp_cols * 2)
#define PG8_BBASE(u) ((const char*)g.Bt + (size_t)(u).pn * tstepB)
    Unit cur, nxt; int ui = 0;
    if (!S.next(0, cur)) return;
    f32x4 acc[2][2][4][2];
#pragma unroll
    for (int a = 0; a < 2; ++a)
#pragma unroll
        for (int b = 0; b < 2; ++b)
#pragma unroll
            for (int m = 0; m < 4; ++m)
#pragma unroll
                for (int n = 0; n < 2; ++n) acc[a][b][m][n] = (f32x4){0.f, 0.f, 0.f, 0.f};
    bf16x8 At[4][2], B0[2][2], B1[2][2];
    const char* cA = PG8_ABASE(cur); const char* cB = PG8_BBASE(cur);
    S.a_ready(cur);
    PG8_STAGE(PG8_SB(0, 0), cB, voffB); PG8_STAGE(PG8_SB(0, 1), cB + hstepB, voffB); PG8_STAGE(PG8_SA(0, 0), cA, voffA); PG8_STAGE(PG8_SA(0, 1), cA + hstepA, voffA);
    if (wr == 1) PG8_BAR;
    PG8_WAIT_V(2); PG8_BAR;
    PG8_STAGE(PG8_SB(1, 0), cB + kstep, voffB); PG8_STAGE(PG8_SA(1, 0), cA + kstep, voffA); PG8_STAGE(PG8_SB(1, 1), cB + hstepB + kstep, voffB);
    PG8_WAIT_V(6); PG8_BAR;
    for (;;) {
        const bool has_next = S.next(ui + 1, nxt);
        const char* nA = has_next ? PG8_ABASE(nxt) : cA; const char* nB = has_next ? PG8_BBASE(nxt) : cB;
        for (int t = 0; t < nt; t += 2) {
            const bool last = (t == nt - 2);
            const char* a1 = cA + (size_t)(t + 1) * kstep;
            const char* a2 = last ? nA : cA + (size_t)(t + 2) * kstep; const char* b2 = last ? nB : cB + (size_t)(t + 2) * kstep;
            const char* a3 = a2 + kstep; const char* b3 = b2 + kstep;
            if (last && has_next) S.a_ready(nxt);
            PG8_LDB(B0, 0, 0); PG8_LDB(B1, 0, 1); PG8_SCHED; PG8_LDA(At, 0, 0); PG8_STAGE(PG8_SA(1, 1), a1 + hstepA, voffA);
            PG8_WAIT_V(8); PG8_WAIT_L(0); PG8_BAR; PG8_MMA(0, 0, At, B0); PG8_MMA(0, 1, At, B1); PG8_BAR; PG8_SCHED;
            PG8_LDA(At, 0, 1); PG8_STAGE(PG8_SB(0, 0), b2, voffB); PG8_STAGE(PG8_SB(0, 1), b2 + hstepB, voffB); PG8_STAGE(PG8_SA(0, 0), a2, voffA);
            PG8_WAIT_V(8); PG8_WAIT_L(0); PG8_BAR; PG8_MMA(1, 0, At, B0); PG8_MMA(1, 1, At, B1); PG8_BAR; PG8_SCHED;
            PG8_LDB(B0, 1, 0); PG8_LDB(B1, 1, 1); PG8_SCHED; PG8_LDA(At, 1, 0); PG8_STAGE(PG8_SA(0, 1), a2 + hstepA, voffA);
            PG8_WAIT_V(8); PG8_WAIT_L(0); PG8_BAR; PG8_MMA(0, 0, At, B0); PG8_MMA(0, 1, At, B1); PG8_BAR; PG8_SCHED;
            PG8_LDA(At, 1, 1); PG8_STAGE(PG8_SB(1, 0), b3, voffB); PG8_STAGE(PG8_SB(1, 1), b3 + hstepB, voffB); PG8_STAGE(PG8_SA(1, 0), a3, voffA);
            PG8_WAIT_V(8); PG8_WAIT_L(0); PG8_BAR; PG8_MMA(1, 0, At, B0); PG8_MMA(1, 1, At, B1); PG8_BAR; PG8_SCHED;
        }
        if constexpr (ALIGN_EPI) { if (wr == 0) PG8_BAR; }
        E(acc, cur, wr, wc, fr, fq); S.done(cur);
        if (!has_next) break;
#pragma unroll
        for (int a = 0; a < 2; ++a)
#pragma unroll
            for (int b = 0; b < 2; ++b)
#pragma unroll
                for (int m = 0; m < 4; ++m)
#pragma unroll
                    for (int n = 0; n < 2; ++n) acc[a][b][m][n] = (f32x4){0.f, 0.f, 0.f, 0.f};
        cur = nxt; cA = nA; cB = nB; ++ui;
        if constexpr (ALIGN_EPI) { if (wr == 1) PG8_BAR; }
    }
    PG8_WAIT_V(0);
    if constexpr (!ALIGN_EPI) { if (wr == 0) PG8_BAR; }
    PG8_BAR;
#undef PG8_SA
#undef PG8_SB
#undef PG8_STAGE
#undef PG8_LDA
#undef PG8_LDB
#undef PG8_MMA
#undef PG8_WAIT_V
#undef PG8_WAIT_L
#undef PG8_BAR
#undef PG8_SCHED
#undef PG8_ABASE
#undef PG8_BBASE
}
}

#define XB_TMO      128
#define XB_XCNT(j)  (256  + 64 * (j))
#define XB_XSUB(j)  (1280 + 64 * (j))
#define XB_XGEN(j)  (2304 + 64 * (j))
#define XB_TOP      3328
#define XB_TOPGEN   3392
#define XCD_BAR_WORDS 3456
#define XB_SPIN_CAP (1u << 18)

__device__ __forceinline__ unsigned xb_ld(unsigned* p)              { return __hip_atomic_load(p, __ATOMIC_RELAXED, __HIP_MEMORY_SCOPE_AGENT); }
__device__ __forceinline__ unsigned xb_add(unsigned* p, unsigned v) { return __hip_atomic_fetch_add(p, v, __ATOMIC_RELAXED, __HIP_MEMORY_SCOPE_AGENT); }
__device__ __forceinline__ unsigned xb_xcc_id() { return (unsigned)__builtin_amdgcn_s_getreg((3 << 11) | 20) & 0xFu; }
#define XB_SPIN(cond, bar) do { unsigned _sp = 0; while (cond) { __builtin_amdgcn_s_sleep(1); \
    if ((++_sp & 255u) == 0u) { if (xb_ld(&(bar)[XB_TMO])) break; if (_sp > XB_SPIN_CAP) { atomicAdd(&(bar)[XB_TMO], 1u); break; } } } } while (0)

struct XcdBarrier { unsigned* bar; unsigned x; volatile LAS unsigned* st; };

__device__ __forceinline__ XcdBarrier xcd_barrier_post(unsigned* bar, volatile LAS unsigned* st) {
    XcdBarrier b; b.bar = bar; b.x = xb_xcc_id(); b.st = st;
    if (threadIdx.x == 0) (void)xb_add(&bar[XB_XCNT(b.x)], 1u);
    return b;
}
__device__ __forceinline__ void xcd_barrier_complete(unsigned* bar, unsigned x, unsigned& nloc, unsigned& nx) {
    const unsigned G = gridDim.x * gridDim.y * gridDim.z;
    unsigned sum, cnt, mine, sp = 0u;
    for (;;) {
        sum = 0u; cnt = 0u; mine = 0u;
#pragma unroll
        for (unsigned j = 0; j < 16; ++j) { const unsigned c = xb_ld(&bar[XB_XCNT(j)]); sum += c; cnt += (c > 0u) ? 1u : 0u; mine = (j == x) ? c : mine; }
        if (sum == G) break;
        __builtin_amdgcn_s_sleep(1);
        if ((++sp & 255u) == 0u) { if (xb_ld(&bar[XB_TMO])) break; if (sp > XB_SPIN_CAP) { atomicAdd(&bar[XB_TMO], 1u); break; } }
    }
    nloc = mine > 0u ? mine : 1u; nx = cnt > 0u ? cnt : 1u;
}
__device__ __forceinline__ void xcd_barrier(const XcdBarrier& b) {
    asm volatile("s_waitcnt vmcnt(0)" ::: "memory");
    __syncthreads();
    if (threadIdx.x == 0) {
        unsigned* bar = b.bar;
        __builtin_amdgcn_s_waitcnt(0);
        unsigned nloc = b.st[0], nx = b.st[1];
        if (nloc == 0u) { xcd_barrier_complete(bar, b.x, nloc, nx); b.st[0] = nloc; b.st[1] = nx; }
        const unsigned old = xb_add(&bar[XB_XSUB(b.x)], 1u);
        const unsigned gen = old / nloc;
        if (old + 1u == (gen + 1u) * nloc) {
            __builtin_amdgcn_fence(__ATOMIC_RELEASE, "agent");
            asm volatile("s_waitcnt vmcnt(0)" ::: "memory");
            const unsigned og = xb_add(&bar[XB_TOP], 1u);
            const unsigned tg = og / nx;
            if (og + 1u == (tg + 1u) * nx) xb_add(&bar[XB_TOPGEN], 1u);
            else XB_SPIN(xb_ld(&bar[XB_TOPGEN]) == tg, bar);
            __builtin_amdgcn_fence(__ATOMIC_ACQUIRE, "agent");
            xb_add(&bar[XB_XGEN(b.x)], 1u);
            asm volatile("s_waitcnt vmcnt(0)" ::: "memory");
        } else {
            XB_SPIN(xb_ld(&bar[XB_XGEN(b.x)]) == gen, bar);
            __builtin_amdgcn_fence(__ATOMIC_ACQUIRE, "agent");
            asm volatile("s_waitcnt vmcnt(0)" ::: "memory");
        }
    }
    __syncthreads();
}

__device__ __forceinline__ void p0_transpose_item(const float* W, int K, int N, bf16* WT, int row_off, LAS float* scr, int item, int lane) {
    const int nblk = N / 32, kb = item / nblk, nb = item % nblk, k0 = 64 * kb, n0 = 32 * nb;
#pragma unroll 8
    for (int i = 0; i < 32; ++i) { const int kk = 2 * i + (lane >> 5); scr[kk * 33 + (lane & 31)] = W[(size_t)(k0 + kk) * N + n0 + (lane & 31)]; }
    LDS_WAIT(); asm volatile("" ::: "memory");
    const int c = lane & 7;
#pragma unroll
    for (int j = 0; j < 4; ++j) { const int n = (lane >> 3) + 8 * j; const LAS float* s = scr + (8 * c) * 33 + n;
        v4u o; o.x = cvt_pk_bf16(s[0 * 33], s[1 * 33]); o.y = cvt_pk_bf16(s[2 * 33], s[3 * 33]); o.z = cvt_pk_bf16(s[4 * 33], s[5 * 33]); o.w = cvt_pk_bf16(s[6 * 33], s[7 * 33]);
        *(GAS v4u*)(WT + (size_t)(row_off + n0 + n) * K + k0 + 8 * c) = o; }
    LDS_WAIT(); asm volatile("" ::: "memory");
}

__device__ __forceinline__ int t5_bucket(int rel) {
    int n = -rel; const int ret = n < 0 ? 16 : 0; n = n < 0 ? -n : n;
    if (n < 8) return ret + n;
    const float v = logf((float)n / 8.0f) / logf(128.0f) * 8.0f;
    int large = 8 + (int)v; large = large < 15 ? large : 15;
    return ret + large;
}
__device__ __forceinline__ float gelu_tanh(float x) {
    const float z = 0.7978845608028654f * (x + 0.044715f * x * x * x);
    const float e = __expf(2.0f * z);
    const float t = 1.0f - 2.0f / (e + 1.0f);
    return 0.5f * x * (1.0f + t);
}
__device__ __forceinline__ unsigned fkey(float v) { const unsigned u = __float_as_uint(v); return (u >> 31) ? ~u : (u | 0x80000000u); }
__device__ __forceinline__ float dot2bf(unsigned a, unsigned b, float c) { return __builtin_amdgcn_fdot2_f32_bf16(__builtin_bit_cast(bf2_t, a), __builtin_bit_cast(bf2_t, b), c, false); }

constexpr int VPITCH = 320;
__device__ __forceinline__ int crow(int r, int hi) { return (r & 3) + 8 * (r >> 2) + 4 * hi; }

__device__ __forceinline__ void attn_task(const int G, const bf16* PROJ, bf16* O0, bf16* O1, float* LSE0, float* LSE1, bf16* MIXIN,
                                          const LAS float* btab, LAS unsigned char* vt, int b, int h, int mtile, int tk, int lane) {
    const int SH = 2 * G;
    const int L = SEQ >> SH, TPR = 32 >> SH;
    const int r32 = lane & 31, hi = lane >> 5;
    const int res = tk >> (5 - SH), l0 = ((mtile * 1024) >> SH) + 32 * (tk & (TPR - 1));
    const size_t rowbase = (size_t)b * SEQ;
    const size_t qrow = rowbase + ((size_t)(l0 + r32) << SH) + res;
    bf16x8 qr[8];
    { const bf16* qp = PROJ + qrow * INW + h * HD + hi * 8;
#pragma unroll
      for (int d0 = 0; d0 < 8; ++d0) qr[d0] = *(const bf16x8*)(qp + d0 * 16); }
    f32x16 p[5];
#pragma unroll
    for (int j = 0; j < 5; ++j) {
        int lk = l0 - 64 + 32 * j + r32; lk = lk < 0 ? 0 : (lk > L - 1 ? L - 1 : lk);
        const bf16* kp = PROJ + (rowbase + ((size_t)lk << SH) + res) * INW + ATTW + h * HD + hi * 8;
        f32x16 s = {};
#pragma unroll
        for (int d0 = 0; d0 < 8; ++d0) { const bf16x8 a = *(const bf16x8*)(kp + d0 * 16); s = __builtin_amdgcn_mfma_f32_32x32x16_bf16(a, qr[d0], s, 0, 0, 0); }
        p[j] = s;
        asm volatile("" ::: "memory");
    }
    float mx = -1e30f;
    const bool edge = (l0 - 64 < 0) || (l0 + 96 > L);
    const LAS float* bt = btab + G * 256 + 32 + 4 * hi - r32;
#pragma unroll
    for (int j = 0; j < 5; ++j) {
#pragma unroll
        for (int r = 0; r < 16; ++r) {
            const int kc = 32 * j + (r & 3) + 8 * (r >> 2);
            float v = p[j][r] + bt[kc];
            if (edge) { const int lk = l0 - 64 + kc + 4 * hi; v = (lk >= 0 && lk < L) ? v : -1e30f; }
            p[j][r] = v; mx = fmaxf(mx, v);
        }
        asm volatile("" ::: "memory");
    }
    mx = fmaxf(mx, __shfl_xor(mx, 32));
    float ls = 0.f;
    bf16x8 pb[5][2];
#pragma unroll
    for (int j = 0; j < 5; ++j) {
        float e[16];
#pragma unroll
        for (int r = 0; r < 16; ++r) { e[r] = __builtin_amdgcn_exp2f(p[j][r] - mx); ls += e[r]; }
#pragma unroll
        for (int s = 0; s < 2; ++s) { v4u w; w.x = cvt_pk_bf16(e[8 * s + 0], e[8 * s + 1]); w.y = cvt_pk_bf16(e[8 * s + 2], e[8 * s + 3]);
            w.z = cvt_pk_bf16(e[8 * s + 4], e[8 * s + 5]); w.w = cvt_pk_bf16(e[8 * s + 6], e[8 * s + 7]); pb[j][s] = __builtin_bit_cast(bf16x8, w); }
    }
    ls += __shfl_xor(ls, 32);
    asm volatile("" ::: "memory");
    f32x16 o[4] = {};
    const int i16 = lane & 15, g16 = lane >> 4;
    const unsigned vaddr = (unsigned)(uintptr_t)vt + (unsigned)((4 * hi + (i16 >> 2)) * VPITCH + (16 * (g16 & 1) + 4 * (i16 & 3)) * 2);
#pragma unroll
    for (int j = 0; j < 5; ++j) {
        v4u vv[8];
#pragma unroll
        for (int i = 0; i < 8; ++i) { const int kk = (lane >> 4) + 4 * i; int lk = l0 - 64 + 32 * j + kk; lk = lk < 0 ? 0 : (lk > L - 1 ? L - 1 : lk);
            vv[i] = *(const v4u*)(PROJ + (rowbase + ((size_t)lk << SH) + res) * INW + 2 * ATTW + h * HD + (lane & 15) * 8); }
        LDS_WAIT();
#pragma unroll
        for (int i = 0; i < 8; ++i) { const int kk = (lane >> 4) + 4 * i; *(LAS v4u*)(vt + kk * VPITCH + (lane & 15) * 16) = vv[i]; }
        LDS_WAIT();
#pragma unroll
        for (int dt = 0; dt < 4; ++dt) {
            s16x4 lo0, hi0, lo1, hi1;
            asm volatile("ds_read_b64_tr_b16 %0, %4 offset:%5\n\tds_read_b64_tr_b16 %1, %4 offset:%6\n\tds_read_b64_tr_b16 %2, %4 offset:%7\n\tds_read_b64_tr_b16 %3, %4 offset:%8\n\ts_waitcnt lgkmcnt(0)"
                         : "=&v"(lo0), "=&v"(hi0), "=&v"(lo1), "=&v"(hi1)
                         : "v"(vaddr), "i"(dt * 64), "i"(8 * VPITCH + dt * 64), "i"(16 * VPITCH + dt * 64), "i"(24 * VPITCH + dt * 64) : "memory");
            const bf16x8 af0 = (bf16x8){lo0[0], lo0[1], lo0[2], lo0[3], hi0[0], hi0[1], hi0[2], hi0[3]};
            const bf16x8 af1 = (bf16x8){lo1[0], lo1[1], lo1[2], lo1[3], hi1[0], hi1[1], hi1[2], hi1[3]};
            o[dt] = __builtin_amdgcn_mfma_f32_32x32x16_bf16(af0, pb[j][0], o[dt], 0, 0, 0);
            o[dt] = __builtin_amdgcn_mfma_f32_32x32x16_bf16(af1, pb[j][1], o[dt], 0, 0, 0);
        }
    }
    const float inv = 1.0f / ls;
    const float lse2 = mx + __builtin_amdgcn_logf(ls);
    const size_t orow = qrow;
    if (G < 2) {
        bf16* op = (G == 0 ? O0 : O1) + orow * ATTW + h * HD + 4 * hi;
#pragma unroll
        for (int dt = 0; dt < 4; ++dt)
#pragma unroll
            for (int rg = 0; rg < 4; ++rg) { v2u w; w.x = cvt_pk_bf16(o[dt][4 * rg] * inv, o[dt][4 * rg + 1] * inv); w.y = cvt_pk_bf16(o[dt][4 * rg + 2] * inv, o[dt][4 * rg + 3] * inv);
                *(v2u*)(op + 32 * dt + 8 * rg) = w; }
        if (hi == 0) (G == 0 ? LSE0 : LSE1)[orow * NH + h] = lse2;
    } else {
        const float l0v = LSE0[orow * NH + h], l1v = LSE1[orow * NH + h];
        const float mm = fmaxf(fmaxf(l0v, l1v), lse2);
        const float w0 = __builtin_amdgcn_exp2f(l0v - mm), w1 = __builtin_amdgcn_exp2f(l1v - mm), w2 = __builtin_amdgcn_exp2f(lse2 - mm);
        const float wi = 1.0f / (w0 + w1 + w2);
        const float c0 = w0 * wi, c1 = w1 * wi, c2 = w2 * wi * inv;
        const bf16* p0 = O0 + orow * ATTW + h * HD + 4 * hi; const bf16* p1 = O1 + orow * ATTW + h * HD + 4 * hi;
        bf16* op = MIXIN + orow * DM + h * HD + 4 * hi;
#pragma unroll
        for (int dt = 0; dt < 4; ++dt)
#pragma unroll
            for (int rg = 0; rg < 4; ++rg) { const v2u a = *(const v2u*)(p0 + 32 * dt + 8 * rg), c = *(const v2u*)(p1 + 32 * dt + 8 * rg);
                const float y0 = c0 * bf_lo(a.x) + c1 * bf_lo(c.x) + c2 * o[dt][4 * rg], y1 = c0 * bf_hi(a.x) + c1 * bf_hi(c.x) + c2 * o[dt][4 * rg + 1];
                const float y2 = c0 * bf_lo(a.y) + c1 * bf_lo(c.y) + c2 * o[dt][4 * rg + 2], y3 = c0 * bf_hi(a.y) + c1 * bf_hi(c.y) + c2 * o[dt][4 * rg + 3];
                v2u w; w.x = cvt_pk_bf16(y0, y1); w.y = cvt_pk_bf16(y2, y3); *(v2u*)(op + 32 * dt + 8 * rg) = w;
                if (rg == 3) asm volatile("" ::: "memory"); }
    }
}

constexpr int PER_PHASE = 11;
struct Args { const float* in[16]; float* out; unsigned char* ws; int ph_lo, ph_hi; };

__constant__ unsigned char CAND_I[64] = {0,0,0,0,0,0,0,0,0,0,0,0,0,0,0,0, 1,1,1,1,1,1,1,1, 2,2,2,2,2, 3,3,3,3, 4,4,4, 5,5, 6,6, 7,7, 8,9,10,11,12,13,14,15, 0,0,0,0,0,0,0,0,0,0,0,0,0,0};
__constant__ unsigned char CAND_J[64] = {0,1,2,3,4,5,6,7,8,9,10,11,12,13,14,15, 0,1,2,3,4,5,6,7, 0,1,2,3,4, 0,1,2,3, 0,1,2, 0,1, 0,1, 0,1, 0,0,0,0,0,0,0,0, 0,0,0,0,0,0,0,0,0,0,0,0,0,0};

__global__ void __launch_bounds__(NWAVES * 64, 2) fwd_kernel(Args args) {
    extern __shared__ __attribute__((aligned(16))) unsigned char lds_raw[];
    LAS unsigned char* lds = (LAS unsigned char*)lds_raw;
    volatile LAS unsigned* MISC = (volatile LAS unsigned*)(lds + MISC_OFF);
    const int tid = threadIdx.x, lane = tid & 63, wave = __builtin_amdgcn_readfirstlane(tid >> 6);
    const int G = gridDim.x; const int bx = blockIdx.x;
    const int vcu = (G % 8 == 0) ? (bx % 8) * (G / 8) + bx / 8 : bx;
    const int gw = vcu * NWAVES + wave, NGW = G * NWAVES;
    unsigned char* ws = args.ws;
    unsigned* ctl = (unsigned*)(ws + WS_CTL);
    const float* x = args.in[0]; const float* cvec = args.in[1]; const float* w_ada = args.in[2]; const float* b_ada = args.in[3]; const float* g_mix = args.in[4];
    const float* w_in = args.in[5]; const float* rel_bias = args.in[6]; const float* pool_w = args.in[7]; const float* pool_scale = args.in[8]; const float* w_out = args.in[9];
    const float* g_ffn = args.in[10]; const float* peer_wq = args.in[11]; const float* peer_sk = args.in[12]; const float* peer_u = args.in[13]; const float* peer_v = args.in[14];
    const float* g_final = args.in[15];
    float* out = args.out;
    float* MODV = (float*)(ws + WS_MODV); float* MODP = (float*)(ws + WS_MODP);
    bf16* SKT = (bf16*)(ws + WS_SKT); bf16* POOLWT = (bf16*)(ws + WS_POOLWT); bf16* WQT = (bf16*)(ws + WS_WQT); bf16* WOUTT = (bf16*)(ws + WS_WOUTT); bf16* WINT = (bf16*)(ws + WS_WINT);
    unsigned char* UB = ws + WS_UB; unsigned char* VB = ws + WS_VB; float* SCL = (float*)(ws + WS_SCL); bf16* H = (bf16*)(ws + WS_H); bf16* PROJ = (bf16*)(ws + WS_PROJ); bf16* MIXIN = (bf16*)(ws + WS_MIXIN);
    bf16* POOLIN = (bf16*)(ws + WS_POOLIN); bf16* O0 = (bf16*)(ws + WS_O0); bf16* O1 = (bf16*)(ws + WS_O1); float* LSE = (float*)(ws + WS_LSE);
    bf16* QP = (bf16*)(ws + WS_QP); float* SC = (float*)(ws + WS_SC);

    for (int u = tid; u < (LDS_BYTES - LDSCTL_OFF) / 4; u += NWAVES * 64) ((LAS unsigned*)(lds + LDSCTL_OFF))[u] = 0u;
    __syncthreads();
    XcdBarrier bar; bar.bar = ctl + CW_BAR; bar.x = 0; bar.st = nullptr;
    if (MK_N_LAUNCHES != PER_PHASE) bar = xcd_barrier_post(ctl + CW_BAR, MISC + 8);
#define GRID_BAR() do { if (MK_N_LAUNCHES != PER_PHASE) xcd_barrier(bar); } while (0)
    const int lo = args.ph_lo, hi_ph = args.ph_hi;
#ifndef PH_MASK
#define PH_MASK 0x7ff
#endif
#define IN(k) ((((PH_MASK) >> (k)) & 1) && lo <= (k) && (k) < hi_ph)
#define BOTH(k) (IN(k) && IN((k) + 1))

    if (IN(0)) {
        LAS float* silu = (LAS float*)(lds + RING_OFF);
        for (int i = tid; i < BATCH * DM; i += NWAVES * 64) { const float v = cvec[i]; silu[i] = v / (1.0f + __expf(-v)); }
        __syncthreads();
        for (int task = gw; task < (NMOD / 256) * KS_ADA; task += NGW) {
            const int cg = task % (NMOD / 256), ks = task / (NMOD / 256); const int k0 = ks * (DM / KS_ADA), n0 = cg * 256 + 4 * lane;
            f32x4 a0 = {0.f, 0.f, 0.f, 0.f}, a1 = {0.f, 0.f, 0.f, 0.f};
            const float* wp = w_ada + (size_t)k0 * NMOD + n0;
#pragma unroll 8
            for (int kk = 0; kk < DM / KS_ADA; ++kk) { const f32x4 w4 = *(const f32x4*)(wp + (size_t)kk * NMOD); const float s0 = silu[k0 + kk], s1 = silu[DM + k0 + kk]; a0 += w4 * s0; a1 += w4 * s1; }
            *(f32x4*)(MODP + ((size_t)(ks * 2 + 0)) * NMOD + n0) = a0; *(f32x4*)(MODP + ((size_t)(ks * 2 + 1)) * NMOD + n0) = a1;
        }
        __syncthreads();
        {
            LAS float* scr = (LAS float*)(lds + RING_OFF + wave * 16384);
            constexpr int I_IN = (DM / 64) * (INW / 32), I_OUT = (DM / 64) * (DM / 32), I_Q = (DM / 64) * (PQ / 32), I_PG = (512 / 64) * (512 / 32);
            constexpr int NITEMS = I_IN + I_OUT + I_Q + 4 * I_PG;
            for (int it = gw; it < NITEMS; it += NGW) {
                int r = it;
                if (r < I_IN) { p0_transpose_item(w_in, DM, INW, WINT, 0, scr, r, lane); continue; } r -= I_IN;
                if (r < I_OUT) { p0_transpose_item(w_out, DM, DM, WOUTT, 0, scr, r, lane); continue; } r -= I_OUT;
                if (r < I_Q) { p0_transpose_item(peer_wq, DM, PQ, WQT, 0, scr, r, lane); continue; } r -= I_Q;
                const int gi = r / I_PG; p0_transpose_item(pool_w + (size_t)gi * 512 * 512, 512, 512, POOLWT, gi * 512, scr, r % I_PG, lane);
            }
        }
        for (int r = gw; r < 2 * NEXP; r += NGW) {
            const bool isU = r < NEXP; const int e = isU ? r : r - NEXP;
            const float* src = (isU ? peer_u : peer_v) + (size_t)e * DM + 16 * lane;
            f32x4 v[4][4]; float mx = 0.f;
#pragma unroll
            for (int i = 0; i < 4; ++i)
#pragma unroll
                for (int q = 0; q < 4; ++q) { v[i][q] = *(const f32x4*)(src + 1024 * i + 4 * q);
                    mx = fmaxf(mx, fmaxf(fmaxf(fabsf(v[i][q][0]), fabsf(v[i][q][1])), fmaxf(fabsf(v[i][q][2]), fabsf(v[i][q][3])))); }
#pragma unroll
            for (int o = 1; o < 64; o <<= 1) mx = fmaxf(mx, __shfl_xor(mx, o));
            const int ex = (int)((__float_as_uint(mx) >> 23) & 0xffu);
            float scale = 1.0f, inv = 1.0f;
            if (ex >= 32 && ex <= 230) { scale = __uint_as_float((unsigned)(261 - ex) << 23); inv = __uint_as_float((unsigned)(ex - 7) << 23); }
            unsigned char* dst = (isU ? UB : VB) + (size_t)e * DM + 16 * lane;
#pragma unroll
            for (int i = 0; i < 4; ++i) { v4u w;
#pragma unroll
                for (int q = 0; q < 4; ++q) { int pk = 0; pk = __builtin_amdgcn_cvt_pk_fp8_f32(v[i][q][0] * scale, v[i][q][1] * scale, pk, false);
                    pk = __builtin_amdgcn_cvt_pk_fp8_f32(v[i][q][2] * scale, v[i][q][3] * scale, pk, true); w[q] = (unsigned)pk; }
                *(v4u*)(dst + 1024 * i) = w; }
            if (lane == 0) SCL[r] = inv;
        }
        for (int i = gw * 64 + lane; i < 2048 * 32; i += NGW * 64) {
            const int n = i >> 5, kc = (i & 31) * 8; const int p = (n >> 7) & 1, pp = kc >> 7;
            v4u w = {0u, 0u, 0u, 0u};
            if (p == pp) { const float* src = peer_sk + (size_t)n * 128 + (kc & 127); const f32x4 a = *(const f32x4*)src, c = *(const f32x4*)(src + 4);
                w.x = cvt_pk_bf16(a[0], a[1]); w.y = cvt_pk_bf16(a[2], a[3]); w.z = cvt_pk_bf16(c[0], c[1]); w.w = cvt_pk_bf16(c[2], c[3]); }
            *(v4u*)(SKT + (size_t)n * 256 + kc) = w;
        }
        if (BOTH(0)) GRID_BAR();
    }

    if (IN(1)) {
        for (int i = bx * (NWAVES * 64) + tid; i < BATCH * NMOD; i += G * NWAVES * 64) {
            const int b = i / NMOD, n = i % NMOD; float s = b_ada[n];
#pragma unroll 8
            for (int ks = 0; ks < KS_ADA; ++ks) s += MODP[(size_t)(ks * 2 + b) * NMOD + n];
            const int j = n / DM, c = n % DM;
            MODV[(size_t)(j * 2 + b) * DM + c] = s;
        }
        if (BOTH(1)) GRID_BAR();
    }

    if (IN(2)) {
        for (int row = gw; row < M; row += NGW) {
            const int b = row / SEQ;
            const f32x4* xr = (const f32x4*)(x + (size_t)row * DM) + lane;
            f32x4 v[16]; float ss = 0.f;
#pragma unroll
            for (int j = 0; j < 16; ++j) { v[j] = xr[64 * j]; ss += (v[j][0] * v[j][0] + v[j][1] * v[j][1]) + (v[j][2] * v[j][2] + v[j][3] * v[j][3]); }
            const float rstd = 1.0f / sqrtf(wave_sum(ss) * (1.0f / DM) + RMS_EPS);
            const f32x4* gp = (const f32x4*)g_mix + lane; const f32x4* shp = (const f32x4*)(MODV + (size_t)(0 * 2 + b) * DM) + lane; const f32x4* scp = (const f32x4*)(MODV + (size_t)(1 * 2 + b) * DM) + lane;
            v2u* op = (v2u*)(H + (size_t)row * DM) + lane;
#pragma unroll
            for (int j = 0; j < 16; ++j) { const f32x4 g4 = gp[64 * j], sh = shp[64 * j], sc = scp[64 * j];
                const f32x4 y = (v[j] * rstd) * g4 * (sc + 1.0f) + sh;
                v2u w; w.x = cvt_pk_bf16(y[0], y[1]); w.y = cvt_pk_bf16(y[2], y[3]); op[64 * j] = w; }
        }
        if (BOTH(2)) GRID_BAR();
    }

    if (IN(3)) {
        pg8::Gemm g{H, WINT, M, INW, DM, DM, DM, 1 << 30, 0}; pg8::StaticOrder S; S.init(M, INW, G, bx);
        pg8::EpiBf16 E{PROJ, INW, ATTW, QSCALE};
        pg8::gemm_phase<pg8::EpiBf16, pg8::StaticOrder, true>(lds + RING_OFF, g, S, E);
        if (BOTH(3)) GRID_BAR();
    }

    if (IN(4)) {
        LAS float* btab = (LAS float*)(lds + SHARED_OFF);
        LAS unsigned char* vt = lds + RING_OFF + wave * 16384;
        for (int unit = bx; unit < BATCH * NH * (SEQ / 1024); unit += G) {
            const int b = unit >> 7, h = (unit >> 3) & 15, mt = unit & 7;
            __syncthreads();
            for (int i = tid; i < 3 * 256; i += NWAVES * 64) { const int gi = i >> 8, ri = (i & 255) - 32; const int dil = gi == 0 ? 1 : (gi == 1 ? 4 : 16);
                btab[i] = (ri >= 0 && ri <= 128) ? rel_bias[t5_bucket((ri - 64) * dil) * NH + h] * LOG2E : -1e30f; }
            __syncthreads();
            for (int g = 0; g < 3; ++g) {
                if (g == 2) { VM_WAIT(); __syncthreads(); }
                for (int tk = wave; tk < 32; tk += NWAVES) attn_task(g, PROJ, O0, O1, LSE, LSE + (size_t)M * NH, MIXIN, btab, vt, b, h, mt, tk, lane);
            }
        }
        for (int i = bx * (NWAVES * 64) + tid; i < M * (POOLW / 8); i += G * NWAVES * 64) {
            const int token = i >> 8, cc = i & 255; const int gi = cc >> 6, half = 1 << gi;
            const int b = token / SEQ, pos = token % SEQ;
            const int plo = pos - half < 0 ? 0 : pos - half, phi = pos + half > SEQ ? SEQ : pos + half;
            float s[8] = {0.f, 0.f, 0.f, 0.f, 0.f, 0.f, 0.f, 0.f};
            const bf16* base = PROJ + (size_t)b * SEQ * INW + 3 * ATTW + cc * 8;
            for (int pp = plo; pp < phi; ++pp) { const v4u w = *(const v4u*)(base + (size_t)pp * INW);
                s[0] += bf_lo(w.x); s[1] += bf_hi(w.x); s[2] += bf_lo(w.y); s[3] += bf_hi(w.y); s[4] += bf_lo(w.z); s[5] += bf_hi(w.z); s[6] += bf_lo(w.w); s[7] += bf_hi(w.w); }
            const v4u me = *(const v4u*)(base + (size_t)pos * INW);
            const float inv = 1.0f / (float)(phi - plo);
            v4u w; w.x = cvt_pk_bf16(s[0] * inv - bf_lo(me.x), s[1] * inv - bf_hi(me.x)); w.y = cvt_pk_bf16(s[2] * inv - bf_lo(me.y), s[3] * inv - bf_hi(me.y));
            w.z = cvt_pk_bf16(s[4] * inv - bf_lo(me.z), s[5] * inv - bf_hi(me.z)); w.w = cvt_pk_bf16(s[6] * inv - bf_lo(me.w), s[7] * inv - bf_hi(me.w));
            *(v4u*)(POOLIN + (size_t)token * POOLW + cc * 8) = w;
        }
        if (BOTH(4)) GRID_BAR();
    }

    if (IN(5)) {
        pg8::Gemm g{POOLIN, POOLWT, M, POOLW, 512, POOLW, 512, 2, 512}; pg8::StaticOrder S; S.init(M, POOLW, G, bx);
        pg8::EpiBf16ColScale E{MIXIN, DM, ATTW, pool_scale};
        pg8::gemm_phase<pg8::EpiBf16ColScale, pg8::StaticOrder, true>(lds + RING_OFF, g, S, E);
        if (BOTH(5)) GRID_BAR();
    }

    if (IN(6)) {
        pg8::Gemm g{MIXIN, WOUTT, M, DM, DM, DM, DM, 1 << 30, 0}; pg8::StaticOrder S; S.init(M, DM, G, bx);
        pg8::EpiResF32 E{x, MODV + (size_t)(2 * 2) * DM, out, DM};
        pg8::gemm_phase<pg8::EpiResF32, pg8::StaticOrder, true>(lds + RING_OFF, g, S, E);
        if (BOTH(6)) GRID_BAR();
    }

    if (IN(7)) {
        for (int row = gw; row < M; row += NGW) {
            const int b = row / SEQ;
            const f32x4* xr = (const f32x4*)(out + (size_t)row * DM) + lane;
            f32x4 v[16]; float ss = 0.f;
#pragma unroll
            for (int j = 0; j < 16; ++j) { v[j] = xr[64 * j]; ss += (v[j][0] * v[j][0] + v[j][1] * v[j][1]) + (v[j][2] * v[j][2] + v[j][3] * v[j][3]); }
            const float rstd = 1.0f / sqrtf(wave_sum(ss) * (1.0f / DM) + RMS_EPS);
            const f32x4* gp = (const f32x4*)g_ffn + lane; const f32x4* shp = (const f32x4*)(MODV + (size_t)(3 * 2 + b) * DM) + lane; const f32x4* scp = (const f32x4*)(MODV + (size_t)(4 * 2 + b) * DM) + lane;
            v2u* op = (v2u*)(H + (size_t)row * DM) + lane;
#pragma unroll
            for (int j = 0; j < 16; ++j) { const f32x4 g4 = gp[64 * j], sh = shp[64 * j], sc = scp[64 * j];
                const f32x4 y = (v[j] * rstd) * g4 * (sc + 1.0f) + sh;
                v2u w; w.x = cvt_pk_bf16(y[0], y[1]); w.y = cvt_pk_bf16(y[2], y[3]); op[64 * j] = w; }
        }
        if (BOTH(7)) GRID_BAR();
    }

    if (IN(8)) {
        pg8::Gemm g{H, WQT, M, PQ, DM, DM, DM, 1 << 30, 0}; pg8::StaticOrder S; S.init(M, PQ, G, bx);
        pg8::EpiBf16 E{QP, PQ, 0, 1.0f};
        pg8::gemm_phase<pg8::EpiBf16, pg8::StaticOrder, true>(lds + RING_OFF, g, S, E);
        if (BOTH(8)) GRID_BAR();
    }

    if (IN(9)) {
        pg8::Gemm g{QP, SKT, M, PQ, 256, PQ, 256, 1, 256}; pg8::StaticOrder S; S.init(M, PQ, G, bx);
        pg8::EpiF32 E{SC, PQ};
        pg8::gemm_phase<pg8::EpiF32, pg8::StaticOrder, true>(lds + RING_OFF, g, S, E);
        if (BOTH(9)) GRID_BAR();
    }

    if (IN(10)) {
        LAS unsigned* W = (LAS unsigned*)(lds + RING_OFF + wave * 16384);
        LAS unsigned* K1 = W; LAS unsigned* K2 = W + 128;
        LAS float* TV1 = (LAS float*)(W + 256); LAS int* TI1 = (LAS int*)(W + 272); LAS float* TV2 = (LAS float*)(W + 288); LAS int* TI2 = (LAS int*)(W + 304);
        LAS unsigned* CK = W + 320; LAS float* SV = (LAS float*)(W + 384); LAS int* SE = (LAS int*)(W + 400);
        LAS int* EXP = (LAS int*)(W + 416); LAS float* GAT = (LAS float*)(W + 544); LAS float* ACT = (LAS float*)(W + 672);
        for (int t = gw; t < M; t += NGW) {
            const int b = t / SEQ;
            for (int h = 0; h < 8; ++h) {
                const float* sp = SC + (size_t)t * PQ + h * 256;
                const float a0 = sp[lane], a1 = sp[64 + lane], b0 = sp[128 + lane], b1 = sp[192 + lane];
                const unsigned ka0 = (fkey(a0) & ~127u) | (unsigned)(127 - lane), ka1 = (fkey(a1) & ~127u) | (unsigned)(63 - lane);
                const unsigned kb0 = (fkey(b0) & ~127u) | (unsigned)(127 - lane), kb1 = (fkey(b1) & ~127u) | (unsigned)(63 - lane);
                K1[lane] = ka0; K1[64 + lane] = ka1; K2[lane] = kb0; K2[64 + lane] = kb1;
                LDS_WAIT();
                int ra0 = 0, ra1 = 0, rb0 = 0, rb1 = 0;
#pragma unroll 8
                for (int kk = 0; kk < 32; ++kk) { const v4u q = ((const LAS v4u*)K1)[kk], r = ((const LAS v4u*)K2)[kk];
                    ra0 += (q.x > ka0) + (q.y > ka0) + (q.z > ka0) + (q.w > ka0); ra1 += (q.x > ka1) + (q.y > ka1) + (q.z > ka1) + (q.w > ka1);
                    rb0 += (r.x > kb0) + (r.y > kb0) + (r.z > kb0) + (r.w > kb0); rb1 += (r.x > kb1) + (r.y > kb1) + (r.z > kb1) + (r.w > kb1); }
                if (ra0 < 16) { TV1[ra0] = a0; TI1[ra0] = lane; } if (ra1 < 16) { TV1[ra1] = a1; TI1[ra1] = 64 + lane; }
                if (rb0 < 16) { TV2[rb0] = b0; TI2[rb0] = lane; } if (rb1 < 16) { TV2[rb1] = b1; TI2[rb1] = 64 + lane; }
                LDS_WAIT();
                const int ci_i = CAND_I[lane], ci_j = CAND_J[lane];
                const float cv = TV1[ci_i] + TV2[ci_j];
                const unsigned ck = lane < 50 ? ((fkey(cv) & ~255u) | (unsigned)(255 - (ci_i * 16 + ci_j))) : 0u;
                CK[lane] = ck;
                LDS_WAIT();
                int rc = 0;
#pragma unroll 8
                for (int kk = 0; kk < 16; ++kk) { const v4u q = ((const LAS v4u*)CK)[kk]; rc += (q.x > ck) + (q.y > ck) + (q.z > ck) + (q.w > ck); }
                if (lane < 50 && rc < 16) { SV[rc] = cv; SE[rc] = TI1[ci_i] * 128 + TI2[ci_j]; }
                LDS_WAIT();
                const float top0 = SV[0], myv = SV[lane & 15]; const int mye = SE[lane & 15];
                const float e = __expf(myv - top0);
                float ssum = e; ssum += __shfl_xor(ssum, 1); ssum += __shfl_xor(ssum, 2); ssum += __shfl_xor(ssum, 4); ssum += __shfl_xor(ssum, 8);
                if (lane < 16) { EXP[h * 16 + lane] = mye; GAT[h * 16 + lane] = e / ssum; }
                LDS_WAIT();
            }
            f32x2 hf[4][8];
#pragma unroll
            for (int i = 0; i < 4; ++i) { const v4u* hp = (const v4u*)(H + (size_t)t * DM + 16 * lane + 1024 * i); const v4u a = hp[0], c = hp[1];
                hf[i][0] = (f32x2){bf_lo(a.x), bf_hi(a.x)}; hf[i][1] = (f32x2){bf_lo(a.y), bf_hi(a.y)}; hf[i][2] = (f32x2){bf_lo(a.z), bf_hi(a.z)}; hf[i][3] = (f32x2){bf_lo(a.w), bf_hi(a.w)};
                hf[i][4] = (f32x2){bf_lo(c.x), bf_hi(c.x)}; hf[i][5] = (f32x2){bf_lo(c.y), bf_hi(c.y)}; hf[i][6] = (f32x2){bf_lo(c.z), bf_hi(c.z)}; hf[i][7] = (f32x2){bf_lo(c.w), bf_hi(c.w)}; }
#pragma unroll 2
            for (int k = 0; k < 128; ++k) {
                const int e = __builtin_amdgcn_readfirstlane(EXP[k]);
                const v4u* up = (const v4u*)(UB + (size_t)e * DM) + lane;
                f32x2 a2 = {0.f, 0.f};
#pragma unroll
                for (int i = 0; i < 4; ++i) { const v4u uv = up[64 * i];
#pragma unroll
                    for (int q = 0; q < 4; ++q) { a2 += __builtin_amdgcn_cvt_pk_f32_fp8((int)uv[q], false) * hf[i][2 * q]; a2 += __builtin_amdgcn_cvt_pk_f32_fp8((int)uv[q], true) * hf[i][2 * q + 1]; } }
                const float a = wave_sum(a2.x + a2.y) * SCL[e];
                if (lane == 0) ACT[k] = gelu_tanh(a) * GAT[k] * SCL[NEXP + e];
            }
            LDS_WAIT();
            f32x2 o[4][8];
#pragma unroll
            for (int i = 0; i < 4; ++i)
#pragma unroll
                for (int j = 0; j < 8; ++j) o[i][j] = (f32x2){0.f, 0.f};
#pragma unroll 2
            for (int k = 0; k < 128; ++k) {
                const int e = __builtin_amdgcn_readfirstlane(EXP[k]);
                const float av = ACT[k];
                const v4u* vp = (const v4u*)(VB + (size_t)e * DM) + lane;
#pragma unroll
                for (int i = 0; i < 4; ++i) { const v4u vv = vp[64 * i];
#pragma unroll
                    for (int q = 0; q < 4; ++q) { o[i][2 * q] += __builtin_amdgcn_cvt_pk_f32_fp8((int)vv[q], false) * av; o[i][2 * q + 1] += __builtin_amdgcn_cvt_pk_f32_fp8((int)vv[q], true) * av; } }
            }
            float ss = 0.f;
            const float* gtp = MODV + (size_t)(5 * 2 + b) * DM;
#pragma unroll
            for (int i = 0; i < 4; ++i) { const int d = 16 * lane + 1024 * i;
#pragma unroll
                for (int q = 0; q < 4; ++q) { const f32x4 xv = *(const f32x4*)(out + (size_t)t * DM + d + 4 * q), gv = *(const f32x4*)(gtp + d + 4 * q);
                    o[i][2 * q].x = xv[0] + gv[0] * o[i][2 * q].x; o[i][2 * q].y = xv[1] + gv[1] * o[i][2 * q].y; o[i][2 * q + 1].x = xv[2] + gv[2] * o[i][2 * q + 1].x; o[i][2 * q + 1].y = xv[3] + gv[3] * o[i][2 * q + 1].y;
                    ss += (o[i][2 * q].x * o[i][2 * q].x + o[i][2 * q].y * o[i][2 * q].y) + (o[i][2 * q + 1].x * o[i][2 * q + 1].x + o[i][2 * q + 1].y * o[i][2 * q + 1].y); } }
            const float rstd = 1.0f / sqrtf(wave_sum(ss) * (1.0f / DM) + RMS_EPS);
#pragma unroll
            for (int i = 0; i < 4; ++i) { const int d = 16 * lane + 1024 * i;
#pragma unroll
                for (int q = 0; q < 4; ++q) { const f32x4 gv = *(const f32x4*)(g_final + d + 4 * q);
                    f32x4 y; y[0] = o[i][2 * q].x * rstd * gv[0]; y[1] = o[i][2 * q].y * rstd * gv[1]; y[2] = o[i][2 * q + 1].x * rstd * gv[2]; y[3] = o[i][2 * q + 1].y * rstd * gv[3];
                    *(f32x4*)(out + (size_t)t * DM + d + 4 * q) = y; } }
        }
    }
#undef IN
#undef BOTH
#undef GRID_BAR
}

extern "C" void kernel_launch(void* const* d_in, const int* in_sizes, int n_in, void* d_out, int out_size, void* d_ws, size_t ws_size, hipStream_t stream) {
    static int grid = 0;
    if (grid == 0) {
        if (n_in != 16 || in_sizes[0] != M * DM || out_size != M * DM || ws_size < WS_END) {
            fprintf(stderr, "kernel_launch: shape/workspace mismatch: n_in %d in0 %d out %d ws %zu (need %zu)\n", n_in, n_in > 0 ? in_sizes[0] : -1, out_size, ws_size, (size_t)WS_END); grid = -1; return; }
        int dev = 0, cus = 0, per_cu = 0;
        if (hipGetDevice(&dev) != hipSuccess || hipDeviceGetAttribute(&cus, hipDeviceAttributeMultiprocessorCount, dev) != hipSuccess) { grid = -1; return; }
        if (hipFuncSetAttribute((const void*)fwd_kernel, hipFuncAttributeMaxDynamicSharedMemorySize, LDS_BYTES) != hipSuccess) { fprintf(stderr, "kernel_launch: hipFuncSetAttribute failed\n"); grid = -1; return; }
        if (hipOccupancyMaxActiveBlocksPerMultiprocessor(&per_cu, (const void*)fwd_kernel, NWAVES * 64, LDS_BYTES) != hipSuccess || per_cu < 1)
            fprintf(stderr, "kernel_launch: note: occupancy query reports %d workgroups per CU\n", per_cu);
        (void)hipGetLastError();
        grid = cus;
    }
    if (grid < 0) return;
    if (hipMemsetAsync((char*)d_ws + WS_CTL, 0, CTL_ZERO_BYTES, stream) != hipSuccess) { fprintf(stderr, "kernel_launch: memset failed\n"); return; }
    Args a{};
    for (int i = 0; i < 16; ++i) a.in[i] = (const float*)d_in[i];
    a.out = (float*)d_out; a.ws = (unsigned char*)d_ws;
    for (int li = 0; li < MK_N_LAUNCHES; ++li) {
        a.ph_lo = (MK_N_LAUNCHES == PER_PHASE) ? li : 0; a.ph_hi = (MK_N_LAUNCHES == PER_PHASE) ? li + 1 : PER_PHASE;
        hipLaunchKernelGGL(fwd_kernel, dim3(grid), dim3(NWAVES * 64), LDS_BYTES, stream, a);
        const hipError_t le = hipPeekAtLastError();
        if (le != hipSuccess) { fprintf(stderr, "kernel_launch: launch %d failed: %s\n", li, hipGetErrorName(le)); break; }
    }
}
```

```cpp
#include <hip/hip_runtime.h>
#include <cstdio>
#include <cstdint>

#ifndef MK_N_LAUNCHES
#define MK_N_LAUNCHES 1
#endif

#define GAS __attribute__((address_space(1)))
#define LAS __attribute__((address_space(3)))
typedef unsigned short bf16;
typedef unsigned v4u __attribute__((ext_vector_type(4)));
typedef unsigned v2u __attribute__((ext_vector_type(2)));
typedef float f32x4 __attribute__((ext_vector_type(4)));
typedef float f32x2 __attribute__((ext_vector_type(2)));
typedef float f32x16 __attribute__((ext_vector_type(16)));
typedef short bf16x8 __attribute__((ext_vector_type(8)));
typedef short s16x4 __attribute__((ext_vector_type(4)));
typedef __bf16 bf2_t __attribute__((ext_vector_type(2)));

constexpr int BATCH = 2, SEQ = 8192, DM = 4096, M = BATCH * SEQ;
constexpr int NH = 16, HD = 128, ATTW = 2048, POOLW = 2048, INW = 8192;
constexpr int NMOD = 6 * DM;
constexpr int PQ = 2048;
constexpr int NEXP = 16384;
constexpr float RMS_EPS = 1e-6f;
constexpr float LOG2E = 1.4426950408889634f;
constexpr float QSCALE = 0.08838834764831845f * LOG2E;
constexpr int KS_ADA = 64;

constexpr size_t MiB = 1u << 20;
constexpr size_t WS_CTL = 0, CTL_ZERO_BYTES = 1 * MiB;
constexpr size_t WS_MODV = 1 * MiB;
constexpr size_t WS_SCL = 2 * MiB;
constexpr size_t WS_MODP = 4 * MiB;
constexpr size_t WS_SKT = 20 * MiB;
constexpr size_t WS_POOLWT = 22 * MiB;
constexpr size_t WS_WQT = 24 * MiB;
constexpr size_t WS_WOUTT = 40 * MiB;
constexpr size_t WS_WINT = 72 * MiB;
constexpr size_t WS_UB = 136 * MiB;
constexpr size_t WS_VB = 264 * MiB;
constexpr size_t WS_H = 392 * MiB;
constexpr size_t WS_PROJ = 520 * MiB;
constexpr size_t WS_MIXIN = 776 * MiB;
constexpr size_t WS_POOLIN = 904 * MiB;
constexpr size_t WS_O0 = 968 * MiB, WS_O1 = 1032 * MiB;
constexpr size_t WS_LSE = 1096 * MiB;
constexpr size_t WS_QP = 1100 * MiB;
constexpr size_t WS_SC = 1164 * MiB;
constexpr size_t WS_END = 1292 * MiB;

constexpr int RING_OFF = 0, RING_BYTES = 131072;
constexpr int SHARED_OFF = 131072;
constexpr int LDSCTL_OFF = 131072 + 8192, MISC_OFF = LDSCTL_OFF + 320;
constexpr int LDS_BYTES = 147456;
constexpr int NWAVES = 8;
constexpr int CW_BAR = 4096;

#define LDS_WAIT() asm volatile("s_waitcnt lgkmcnt(0)" ::: "memory")
#define VM_WAIT() asm volatile("s_waitcnt vmcnt(0)" ::: "memory")

__device__ __forceinline__ unsigned cvt_pk_bf16(float lo, float hi) { unsigned r; asm volatile("v_cvt_pk_bf16_f32 %0, %1, %2" : "=v"(r) : "v"(lo), "v"(hi)); return r; }
__device__ __forceinline__ float bf_lo(unsigned u) { return __uint_as_float(u << 16); }
__device__ __forceinline__ float bf_hi(unsigned u) { return __uint_as_float(u & 0xffff0000u); }
__device__ __forceinline__ float wave_sum(float v) {
#pragma unroll
    for (int o = 1; o < 64; o <<= 1) v += __shfl_xor(v, o);
    return v;
}

namespace pg8 {
typedef unsigned short bf16_t;
constexpr int BM = 256, BK = 64, HALF = 128, HTB = HALF * BK * 2, STAGE_BYTES = 8 * HTB, NXCD = 8, WGM = 8;

__host__ __device__ __forceinline__ int lds_byte(int r, int c) { const int st = (r >> 4) * 2 + (c >> 5), rr = r & 15, cc = c & 31, ob = rr * 64 + cc * 2; return st * 1024 + (ob ^ (((ob >> 9) & 1) << 5)); }
__host__ __device__ __forceinline__ void stage_rc(int b, int& R, int& C) { const int st = b / 1024, sb = b % 1024, swz = sb ^ (((sb >> 9) & 1) << 5); R = (st >> 1) * 16 + swz / 64; C = (st & 1) * 32 + (swz % 64) / 2; }
__host__ __device__ __forceinline__ int perm32(int rho) { const int n = rho >> 4, i = rho & 15; return 8 * (i >> 2) + 4 * n + (i & 3); }

struct Unit { int pm, pn; };
struct Gemm { const bf16_t* A; const bf16_t* Bt; int M, N, K, lda, ldb, agrp_div, agrp_cols; };

struct StaticOrder {
    int nM, nN, nwg, G, c;
    __host__ __device__ void init(int M_, int N_, int G_, int c_) { nM = M_ / BM; nN = N_ / BM; nwg = nM * nN; G = G_; c = c_; }
    __host__ __device__ bool next(int i, Unit& u) const {
        const long L = (long)i * G + c; if (L >= nwg) return false;
        int wgid = (int)L; { const int q = nwg / NXCD, r = nwg % NXCD, xcd = wgid % NXCD, off = wgid / NXCD; wgid = (xcd < r ? xcd * (q + 1) : r * (q + 1) + (xcd - r) * q) + off; }
        const int nig = WGM * nN, gid = wgid / nig, fm = gid * WGM, gsz = (nM - fm) < WGM ? (nM - fm) : WGM;
        u.pm = fm + ((wgid % nig) % gsz); u.pn = (wgid % nig) / gsz; return true;
    }
    __device__ __forceinline__ void a_ready(const Unit&) const {}
    __device__ __forceinline__ void done(const Unit&) const {}
};

struct EpiBf16 {
    static constexpr bool PERM = true, AFTER_DRAIN = false;
    bf16_t* O; int ldc; int scale_cols; float scale0;
    __device__ __forceinline__ void operator()(const f32x4 (&acc)[2][2][4][2], const Unit& u, int wr, int wc, int fr, int fq) const {
        const int row0 = u.pm * BM + wr * 64 + fr; const int colt = u.pn * BM;
        const float sc = (colt < scale_cols) ? scale0 : 1.f;
        const int col0 = colt + wc * 32 + 8 * fq;
#pragma unroll
        for (int ai = 0; ai < 2; ++ai)
#pragma unroll
            for (int m = 0; m < 4; ++m) { bf16_t* rowp = O + (size_t)(row0 + ai * HALF + m * 16) * ldc + col0;
#pragma unroll
                for (int bj = 0; bj < 2; ++bj) { f32x4 v0 = acc[ai][bj][m][0] * sc, v1 = acc[ai][bj][m][1] * sc;
                    v4u w; w.x = cvt_pk_bf16(v0[0], v0[1]); w.y = cvt_pk_bf16(v0[2], v0[3]); w.z = cvt_pk_bf16(v1[0], v1[1]); w.w = cvt_pk_bf16(v1[2], v1[3]);
                    *(v4u*)(rowp + bj * HALF) = w; } }
    }
};
struct EpiBf16ColScale {
    static constexpr bool PERM = true, AFTER_DRAIN = false;
    bf16_t* O; int ldc; int coff; const float* cs;
    __device__ __forceinline__ void operator()(const f32x4 (&acc)[2][2][4][2], const Unit& u, int wr, int wc, int fr, int fq) const {
        const int row0 = u.pm * BM + wr * 64 + fr; const int col0 = u.pn * BM + wc * 32 + 8 * fq;
        f32x4 sv[2][2];
#pragma unroll
        for (int bj = 0; bj < 2; ++bj)
#pragma unroll
            for (int n = 0; n < 2; ++n) sv[bj][n] = *(const f32x4*)(cs + col0 + bj * HALF + 4 * n);
#pragma unroll
        for (int ai = 0; ai < 2; ++ai)
#pragma unroll
            for (int m = 0; m < 4; ++m) { bf16_t* rowp = O + (size_t)(row0 + ai * HALF + m * 16) * ldc + coff + col0;
#pragma unroll
                for (int bj = 0; bj < 2; ++bj) { f32x4 v0 = acc[ai][bj][m][0] * sv[bj][0], v1 = acc[ai][bj][m][1] * sv[bj][1];
                    v4u w; w.x = cvt_pk_bf16(v0[0], v0[1]); w.y = cvt_pk_bf16(v0[2], v0[3]); w.z = cvt_pk_bf16(v1[0], v1[1]); w.w = cvt_pk_bf16(v1[2], v1[3]);
                    *(v4u*)(rowp + bj * HALF) = w; } }
    }
};
struct EpiResF32 {
    static constexpr bool PERM = false, AFTER_DRAIN = false;
    const float* X; const float* gate; float* O; int ldc;
    __device__ __forceinline__ void operator()(const f32x4 (&acc)[2][2][4][2], const Unit& u, int wr, int wc, int fr, int fq) const {
        const int row0 = u.pm * BM + wr * 64 + fr; const int col0 = u.pn * BM + wc * 32 + 4 * fq; const int b = (u.pm * BM) / SEQ;
        f32x4 gv[2][2];
#pragma unroll
        for (int bj = 0; bj < 2; ++bj)
#pragma unroll
            for (int n = 0; n < 2; ++n) gv[bj][n] = *(const f32x4*)(gate + (size_t)b * DM + col0 + bj * HALF + n * 16);
#pragma unroll
        for (int ai = 0; ai < 2; ++ai)
#pragma unroll
            for (int m = 0; m < 4; ++m) { const size_t off = (size_t)(row0 + ai * HALF + m * 16) * ldc + col0;
#pragma unroll
                for (int bj = 0; bj < 2; ++bj)
#pragma unroll
                    for (int n = 0; n < 2; ++n) { const f32x4 xv = *(const f32x4*)(X + off + bj * HALF + n * 16);
                        *(f32x4*)(O + off + bj * HALF + n * 16) = xv + gv[bj][n] * acc[ai][bj][m][n]; } }
    }
};
struct EpiF32 {
    static constexpr bool PERM = false, AFTER_DRAIN = false;
    float* O; int ldc;
    __device__ __forceinline__ void operator()(const f32x4 (&acc)[2][2][4][2], const Unit& u, int wr, int wc, int fr, int fq) const {
        const int row0 = u.pm * BM + wr * 64 + fr; const int col0 = u.pn * BM + wc * 32 + 4 * fq;
#pragma unroll
        for (int ai = 0; ai < 2; ++ai)
#pragma unroll
            for (int m = 0; m < 4; ++m) { const size_t off = (size_t)(row0 + ai * HALF + m * 16) * ldc + col0;
#pragma unroll
                for (int bj = 0; bj < 2; ++bj)
#pragma unroll
                    for (int n = 0; n < 2; ++n) *(f32x4*)(O + off + bj * HALF + n * 16) = acc[ai][bj][m][n]; }
    }
};

template <class Epi, class Sched, bool ALIGN_EPI>
__device__ __forceinline__ void gemm_phase(LAS unsigned char* lds, const Gemm g, const Sched& S, const Epi& E) {
    const int tid = threadIdx.x, wid = __builtin_amdgcn_readfirstlane(tid >> 6), lane = tid & 63, wr = wid >> 2, wc = wid & 3, fr = lane & 15, fq = lane >> 4;
    const int K = g.K, nt = K / BK;
    unsigned voffA[2], voffB[2];
#pragma unroll
    for (int i = 0; i < 2; ++i) { int R, C; stage_rc(tid * 16 + i * 8192, R, C); const int Rb = Epi::PERM ? ((R & ~31) + perm32(R & 31)) : R;
        voffA[i] = (unsigned)(R * g.lda + C) * 2u; voffB[i] = (unsigned)(Rb * g.ldb + C) * 2u; }
    const size_t kstep = (size_t)(BK * 2);
    const size_t hstepA = (size_t)HALF * g.lda * 2, hstepB = (size_t)HALF * g.ldb * 2;
    const size_t tstepA = 2 * hstepA, tstepB = 2 * hstepB;
    const unsigned ldsw = (unsigned)wid * 1024u;
    const int aoff = lds_byte(wr * 64 + fr, fq * 8), boff = lds_byte(wc * 32 + fr, fq * 8);
#define PG8_SA(b, h) (((b) * 2 + (h)) * HTB)
#define PG8_SB(b, h) ((4 + (b) * 2 + (h)) * HTB)
#define PG8_STAGE(bufoff, gbase, voff) do { _Pragma("unroll") for (int _i = 0; _i < 2; ++_i) \
        __builtin_amdgcn_global_load_lds((const unsigned*)((const char*)(gbase) + (voff)[_i]), (LAS unsigned*)(lds + (bufoff) + ldsw + _i * 8192), 16, 0, 0); } while (0)
#define PG8_LDA(dst, b, h) do { _Pragma("unroll") for (int m = 0; m < 4; ++m) _Pragma("unroll") for (int k = 0; k < 2; ++k) dst[m][k] = *(const LAS bf16x8*)(lds + PG8_SA(b, h) + aoff + m * 2048 + k * 1024); } while (0)
#define PG8_LDB(dst, b, h) do { _Pragma("unroll") for (int n = 0; n < 2; ++n) _Pragma("unroll") for (int k = 0; k < 2; ++k) dst[n][k] = *(const LAS bf16x8*)(lds + PG8_SB(b, h) + boff + n * 2048 + k * 1024); } while (0)
#define PG8_MMA(ai, bj, At, Bt) do { __builtin_amdgcn_s_setprio(1); _Pragma("unroll") for (int m = 0; m < 4; ++m) _Pragma("unroll") for (int n = 0; n < 2; ++n) _Pragma("unroll") for (int k = 0; k < 2; ++k) \
        acc[ai][bj][m][n] = __builtin_amdgcn_mfma_f32_16x16x32_bf16(Bt[n][k], At[m][k], acc[ai][bj][m][n], 0, 0, 0); __builtin_amdgcn_s_setprio(0); } while (0)
#define PG8_WAIT_V(n) asm volatile("s_waitcnt vmcnt(" #n ")" ::: "memory")
#define PG8_WAIT_L(n) asm volatile("s_waitcnt lgkmcnt(" #n ")" ::: "memory")
#define PG8_BAR __builtin_amdgcn_s_barrier()
#define PG8_SCHED __builtin_amdgcn_sched_barrier(0)
#define PG8_ABASE(u) ((const char*)g.A + (size_t)(u).pm * tstepA + (size_t)((u).pn / g.agrp_div) * (size_t)g.agrp_cols * 2)
#define PG8_BBASE(u) ((const char*)g.Bt + (size_t)(u).pn * tstepB)
    Unit cur, nxt; int ui = 0;
    if (!S.next(0, cur)) return;
    f32x4 acc[2][2][4][2];
#pragma unroll
    for (int a = 0; a < 2; ++a)
#pragma unroll
        for (int b = 0; b < 2; ++b)
#pragma unroll
            for (int m = 0; m < 4; ++m)
#pragma unroll
                for (int n = 0; n < 2; ++n) acc[a][b][m][n] = (f32x4){0.f, 0.f, 0.f, 0.f};
    bf16x8 At[4][2], B0[2][2], B1[2][2];
    const char* cA = PG8_ABASE(cur); const char* cB = PG8_BBASE(cur);
    S.a_ready(cur);
    PG8_STAGE(PG8_SB(0, 0), cB, voffB); PG8_STAGE(PG8_SB(0, 1), cB + hstepB, voffB); PG8_STAGE(PG8_SA(0, 0), cA, voffA); PG8_STAGE(PG8_SA(0, 1), cA + hstepA, voffA);
    if (wr == 1) PG8_BAR;
    PG8_WAIT_V(2); PG8_BAR;
    PG8_STAGE(PG8_SB(1, 0), cB + kstep, voffB); PG8_STAGE(PG8_SA(1, 0), cA + kstep, voffA); PG8_STAGE(PG8_SB(1, 1), cB + hstepB + kstep, voffB);
    PG8_WAIT_V(6); PG8_BAR;
    for (;;) {
        const bool has_next = S.next(ui + 1, nxt);
        const char* nA = has_next ? PG8_ABASE(nxt) : cA; const char* nB = has_next ? PG8_BBASE(nxt) : cB;
        for (int t = 0; t < nt; t += 2) {
            const bool last = (t == nt - 2);
            const char* a1 = cA + (size_t)(t + 1) * kstep;
            const char* a2 = last ? nA : cA + (size_t)(t + 2) * kstep; const char* b2 = last ? nB : cB + (size_t)(t + 2) * kstep;
            const char* a3 = a2 + kstep; const char* b3 = b2 + kstep;
            if (last && has_next) S.a_ready(nxt);
            PG8_LDB(B0, 0, 0); PG8_LDB(B1, 0, 1); PG8_SCHED; PG8_LDA(At, 0, 0); PG8_STAGE(PG8_SA(1, 1), a1 + hstepA, voffA);
            PG8_WAIT_V(8); PG8_WAIT_L(0); PG8_BAR; PG8_MMA(0, 0, At, B0); PG8_MMA(0, 1, At, B1); PG8_BAR; PG8_SCHED;
            PG8_LDA(At, 0, 1); PG8_STAGE(PG8_SB(0, 0), b2, voffB); PG8_STAGE(PG8_SB(0, 1), b2 + hstepB, voffB); PG8_STAGE(PG8_SA(0, 0), a2, voffA);
            PG8_WAIT_V(8); PG8_WAIT_L(0); PG8_BAR; PG8_MMA(1, 0, At, B0); PG8_MMA(1, 1, At, B1); PG8_BAR; PG8_SCHED;
            PG8_LDB(B0, 1, 0); PG8_LDB(B1, 1, 1); PG8_SCHED; PG8_LDA(At, 1, 0); PG8_STAGE(PG8_SA(0, 1), a2 + hstepA, voffA);
            PG8_WAIT_V(8); PG8_WAIT_L(0); PG8_BAR; PG8_MMA(0, 0, At, B0); PG8_MMA(0, 1, At, B1); PG8_BAR; PG8_SCHED;
            PG8_LDA(At, 1, 1); PG8_STAGE(PG8_SB(1, 0), b3, voffB); PG8_STAGE(PG8_SB(1, 1), b3 + hstepB, voffB); PG8_STAGE(PG8_SA(1, 0), a3, voffA);
            PG8_WAIT_V(8); PG8_WAIT_L(0); PG8_BAR; PG8_MMA(1, 0, At, B0); PG8_MMA(1, 1, At, B1); PG8_BAR; PG8_SCHED;
        }
        if constexpr (ALIGN_EPI) { if (wr == 0) PG8_BAR; }
        E(acc, cur, wr, wc, fr, fq); S.done(cur);
        if (!has_next) break;
#pragma unroll
        for (int a = 0; a < 2; ++a)
#pragma unroll
            for (int b = 0; b < 2; ++b)
#pragma unroll
                for (int m = 0; m < 4; ++m)
#pragma unroll
                    for (int n = 0; n < 2; ++n) acc[a][b][m][n] = (f32x4){0.f, 0.f, 0.f, 0.f};
        cur = nxt; cA = nA; cB = nB; ++ui;
        if constexpr (ALIGN_EPI) { if (wr == 1) PG8_BAR; }
    }
    PG8_WAIT_V(0);
    if constexpr (!ALIGN_EPI) { if (wr == 0) PG8_BAR; }
    PG8_BAR;
#undef PG8_SA
#undef PG8_SB
#undef PG8_STAGE
#undef PG8_LDA
#undef PG8_LDB
#undef PG8_MMA
#undef PG8_WAIT_V
#undef PG8_WAIT_L
#undef PG8_BAR
#undef PG8_SCHED
#undef PG8_ABASE
#undef PG8_BBASE
}
}

#define XB_TMO      128
#define XB_XCNT(j)  (256  + 64 * (j))
#define XB_XSUB(j)  (1280 + 64 * (j))
#define XB_XGEN(j)  (2304 + 64 * (j))
#define XB_TOP      3328
#define XB_TOPGEN   3392
#define XCD_BAR_WORDS 3456
#define XB_SPIN_CAP (1u << 18)

__device__ __forceinline__ unsigned xb_ld(unsigned* p)              { return __hip_atomic_load(p, __ATOMIC_RELAXED, __HIP_MEMORY_SCOPE_AGENT); }
__device__ __forceinline__ unsigned xb_add(unsigned* p, unsigned v) { return __hip_atomic_fetch_add(p, v, __ATOMIC_RELAXED, __HIP_MEMORY_SCOPE_AGENT); }
__device__ __forceinline__ unsigned xb_xcc_id() { return (unsigned)__builtin_amdgcn_s_getreg((3 << 11) | 20) & 0xFu; }
#define XB_SPIN(cond, bar) do { unsigned _sp = 0; while (cond) { __builtin_amdgcn_s_sleep(1); \
    if ((++_sp & 255u) == 0u) { if (xb_ld(&(bar)[XB_TMO])) break; if (_sp > XB_SPIN_CAP) { atomicAdd(&(bar)[XB_TMO], 1u); break; } } } } while (0)

struct XcdBarrier { unsigned* bar; unsigned x; volatile LAS unsigned* st; };

__device__ __forceinline__ XcdBarrier xcd_barrier_post(unsigned* bar, volatile LAS unsigned* st) {
    XcdBarrier b; b.bar = bar; b.x = xb_xcc_id(); b.st = st;
    if (threadIdx.x == 0) (void)xb_add(&bar[XB_XCNT(b.x)], 1u);
    return b;
}
__device__ __forceinline__ void xcd_barrier_complete(unsigned* bar, unsigned x, unsigned& nloc, unsigned& nx) {
    const unsigned G = gridDim.x * gridDim.y * gridDim.z;
    unsigned sum, cnt, mine, sp = 0u;
    for (;;) {
        sum = 0u; cnt = 0u; mine = 0u;
#pragma unroll
        for (unsigned j = 0; j < 16; ++j) { const unsigned c = xb_ld(&bar[XB_XCNT(j)]); sum += c; cnt += (c > 0u) ? 1u : 0u; mine = (j == x) ? c : mine; }
        if (sum == G) break;
        __builtin_amdgcn_s_sleep(1);
        if ((++sp & 255u) == 0u) { if (xb_ld(&bar[XB_TMO])) break; if (sp > XB_SPIN_CAP) { atomicAdd(&bar[XB_TMO], 1u); break; } }
    }
    nloc = mine > 0u ? mine : 1u; nx = cnt > 0u ? cnt : 1u;
}
__device__ __forceinline__ void xcd_barrier(const XcdBarrier& b) {
    asm volatile("s_waitcnt vmcnt(0)" ::: "memory");
    __syncthreads();
    if (threadIdx.x == 0) {
        unsigned* bar = b.bar;
        __builtin_amdgcn_s_waitcnt(0);
        unsigned nloc = b.st[0], nx = b.st[1];
        if (nloc == 0u) { xcd_barrier_complete(bar, b.x, nloc, nx); b.st[0] = nloc; b.st[1] = nx; }
        const unsigned old = xb_add(&bar[XB_XSUB(b.x)], 1u);
        const unsigned gen = old / nloc;
        if (old + 1u == (gen + 1u) * nloc) {
            __builtin_amdgcn_fence(__ATOMIC_RELEASE, "agent");
            asm volatile("s_waitcnt vmcnt(0)" ::: "memory");
            const unsigned og = xb_add(&bar[XB_TOP], 1u);
            const unsigned tg = og / nx;
            if (og + 1u == (tg + 1u) * nx) xb_add(&bar[XB_TOPGEN], 1u);
            else XB_SPIN(xb_ld(&bar[XB_TOPGEN]) == tg, bar);
            __builtin_amdgcn_fence(__ATOMIC_ACQUIRE, "agent");
            xb_add(&bar[XB_XGEN(b.x)], 1u);
            asm volatile("s_waitcnt vmcnt(0)" ::: "memory");
        } else {
            XB_SPIN(xb_ld(&bar[XB_XGEN(b.x)]) == gen, bar);
            __builtin_amdgcn_fence(__ATOMIC_ACQUIRE, "agent");
            asm volatile("s_waitcnt vmcnt(0)" ::: "memory");
        }
    }
    __syncthreads();
}

__device__ __forceinline__ void p0_transpose_item(const float* W, int K, int N, bf16* WT, int row_off, LAS float* scr, int item, int lane) {
    const int nblk = N / 32, kb = item / nblk, nb = item % nblk, k0 = 64 * kb, n0 = 32 * nb;
#pragma unroll 8
    for (int i = 0; i < 32; ++i) { const int kk = 2 * i + (lane >> 5); scr[kk * 33 + (lane & 31)] = W[(size_t)(k0 + kk) * N + n0 + (lane & 31)]; }
    LDS_WAIT(); asm volatile("" ::: "memory");
    const int c = lane & 7;
#pragma unroll
    for (int j = 0; j < 4; ++j) { const int n = (lane >> 3) + 8 * j; const LAS float* s = scr + (8 * c) * 33 + n;
        v4u o; o.x = cvt_pk_bf16(s[0 * 33], s[1 * 33]); o.y = cvt_pk_bf16(s[2 * 33], s[3 * 33]); o.z = cvt_pk_bf16(s[4 * 33], s[5 * 33]); o.w = cvt_pk_bf16(s[6 * 33], s[7 * 33]);
        *(GAS v4u*)(WT + (size_t)(row_off + n0 + n) * K + k0 + 8 * c) = o; }
    LDS_WAIT(); asm volatile("" ::: "memory");
}

__device__ __forceinline__ int t5_bucket(int rel) {
    int n = -rel; const int ret = n < 0 ? 16 : 0; n = n < 0 ? -n : n;
    if (n < 8) return ret + n;
    const float v = logf((float)n / 8.0f) / logf(128.0f) * 8.0f;
    int large = 8 + (int)v; large = large < 15 ? large : 15;
    return ret + large;
}
__device__ __forceinline__ float gelu_tanh(float x) {
    const float z = 0.7978845608028654f * (x + 0.044715f * x * x * x);
    const float e = __expf(2.0f * z);
    const float t = 1.0f - 2.0f / (e + 1.0f);
    return 0.5f * x * (1.0f + t);
}
__device__ __forceinline__ unsigned fkey(float v) { const unsigned u = __float_as_uint(v); return (u >> 31) ? ~u : (u | 0x80000000u); }
__device__ __forceinline__ float dot2bf(unsigned a, unsigned b, float c) { return __builtin_amdgcn_fdot2_f32_bf16(__builtin_bit_cast(bf2_t, a), __builtin_bit_cast(bf2_t, b), c, false); }

constexpr int VPITCH = 320;
__device__ __forceinline__ int crow(int r, int hi) { return (r & 3) + 8 * (r >> 2) + 4 * hi; }

__device__ __forceinline__ void attn_task(const int G, const bf16* PROJ, bf16* O0, bf16* O1, float* LSE0, float* LSE1, bf16* MIXIN,
                                          const LAS float* btab, LAS unsigned char* vt, int b, int h, int mtile, int tk, int lane) {
    const int SH = 2 * G;
    const int L = SEQ >> SH, TPR = 32 >> SH;
    const int r32 = lane & 31, hi = lane >> 5;
    const int res = tk >> (5 - SH), l0 = ((mtile * 1024) >> SH) + 32 * (tk & (TPR - 1));
    const size_t rowbase = (size_t)b * SEQ;
    const size_t qrow = rowbase + ((size_t)(l0 + r32) << SH) + res;
    bf16x8 qr[8];
    { const bf16* qp = PROJ + qrow * INW + h * HD + hi * 8;
#pragma unroll
      for (int d0 = 0; d0 < 8; ++d0) qr[d0] = *(const bf16x8*)(qp + d0 * 16); }
    f32x16 p[5];
#pragma unroll
    for (int j = 0; j < 5; ++j) {
        int lk = l0 - 64 + 32 * j + r32; lk = lk < 0 ? 0 : (lk > L - 1 ? L - 1 : lk);
        const bf16* kp = PROJ + (rowbase + ((size_t)lk << SH) + res) * INW + ATTW + h * HD + hi * 8;
        f32x16 s = {};
#pragma unroll
        for (int d0 = 0; d0 < 8; ++d0) { const bf16x8 a = *(const bf16x8*)(kp + d0 * 16); s = __builtin_amdgcn_mfma_f32_32x32x16_bf16(a, qr[d0], s, 0, 0, 0); }
        p[j] = s;
        asm volatile("" ::: "memory");
    }
    float mx = -1e30f;
    const bool edge = (l0 - 64 < 0) || (l0 + 96 > L);
    const LAS float* bt = btab + G * 256 + 32 + 4 * hi - r32;
#pragma unroll
    for (int j = 0; j < 5; ++j) {
#pragma unroll
        for (int r = 0; r < 16; ++r) {
            const int kc = 32 * j + (r & 3) + 8 * (r >> 2);
            float v = p[j][r] + bt[kc];
            if (edge) { const int lk = l0 - 64 + kc + 4 * hi; v = (lk >= 0 && lk < L) ? v : -1e30f; }
            p[j][r] = v; mx = fmaxf(mx, v);
        }
        asm volatile("" ::: "memory");
    }
    mx = fmaxf(mx, __shfl_xor(mx, 32));
    float ls = 0.f;
    bf16x8 pb[5][2];
#pragma unroll
    for (int j = 0; j < 5; ++j) {
        float e[16];
#pragma unroll
        for (int r = 0; r < 16; ++r) { e[r] = __builtin_amdgcn_exp2f(p[j][r] - mx); ls += e[r]; }
#pragma unroll
        for (int s = 0; s < 2; ++s) { v4u w; w.x = cvt_pk_bf16(e[8 * s + 0], e[8 * s + 1]); w.y = cvt_pk_bf16(e[8 * s + 2], e[8 * s + 3]);
            w.z = cvt_pk_bf16(e[8 * s + 4], e[8 * s + 5]); w.w = cvt_pk_bf16(e[8 * s + 6], e[8 * s + 7]); pb[j][s] = __builtin_bit_cast(bf16x8, w); }
    }
    ls += __shfl_xor(ls, 32);
    asm volatile("" ::: "memory");
    f32x16 o[4] = {};
    const int i16 = lane & 15, g16 = lane >> 4;
    const unsigned vaddr = (unsigned)(uintptr_t)vt + (unsigned)((4 * hi + (i16 >> 2)) * VPITCH + (16 * (g16 & 1) + 4 * (i16 & 3)) * 2);
#pragma unroll
    for (int j = 0; j < 5; ++j) {
        v4u vv[8];
#pragma unroll
        for (int i = 0; i < 8; ++i) { const int kk = (lane >> 4) + 4 * i; int lk = l0 - 64 + 32 * j + kk; lk = lk < 0 ? 0 : (lk > L - 1 ? L - 1 : lk);
            vv[i] = *(const v4u*)(PROJ + (rowbase + ((size_t)lk << SH) + res) * INW + 2 * ATTW + h * HD + (lane & 15) * 8); }
        LDS_WAIT();
#pragma unroll
        for (int i = 0; i < 8; ++i) { const int kk = (lane >> 4) + 4 * i; *(LAS v4u*)(vt + kk * VPITCH + (lane & 15) * 16) = vv[i]; }
        LDS_WAIT();
#pragma unroll
        for (int dt = 0; dt < 4; ++dt) {
            s16x4 lo0, hi0, lo1, hi1;
            asm volatile("ds_read_b64_tr_b16 %0, %4 offset:%5\n\tds_read_b64_tr_b16 %1, %4 offset:%6\n\tds_read_b64_tr_b16 %2, %4 offset:%7\n\tds_read_b64_tr_b16 %3, %4 offset:%8\n\ts_waitcnt lgkmcnt(0)"
                         : "=&v"(lo0), "=&v"(hi0), "=&v"(lo1), "=&v"(hi1)
                         : "v"(vaddr), "i"(dt * 64), "i"(8 * VPITCH + dt * 64), "i"(16 * VPITCH + dt * 64), "i"(24 * VPITCH + dt * 64) : "memory");
            const bf16x8 af0 = (bf16x8){lo0[0], lo0[1], lo0[2], lo0[3], hi0[0], hi0[1], hi0[2], hi0[3]};
            const bf16x8 af1 = (bf16x8){lo1[0], lo1[1], lo1[2], lo1[3], hi1[0], hi1[1], hi1[2], hi1[3]};
            o[dt] = __builtin_amdgcn_mfma_f32_32x32x16_bf16(af0, pb[j][0], o[dt], 0, 0, 0);
            o[dt] = __builtin_amdgcn_mfma_f32_32x32x16_bf16(af1, pb[j][1], o[dt], 0, 0, 0);
        }
    }
    const float inv = 1.0f / ls;
    const float lse2 = mx + __builtin_amdgcn_logf(ls);
    const size_t orow = qrow;
    if (G < 2) {
        bf16* op = (G == 0 ? O0 : O1) + orow * ATTW + h * HD + 4 * hi;
#pragma unroll
        for (int dt = 0; dt < 4; ++dt)
#pragma unroll
            for (int rg = 0; rg < 4; ++rg) { v2u w; w.x = cvt_pk_bf16(o[dt][4 * rg] * inv, o[dt][4 * rg + 1] * inv); w.y = cvt_pk_bf16(o[dt][4 * rg + 2] * inv, o[dt][4 * rg + 3] * inv);
                *(v2u*)(op + 32 * dt + 8 * rg) = w; }
        if (hi == 0) (G == 0 ? LSE0 : LSE1)[orow * NH + h] = lse2;
    } else {
        const float l0v = LSE0[orow * NH + h], l1v = LSE1[orow * NH + h];
        const float mm = fmaxf(fmaxf(l0v, l1v), lse2);
        const float w0 = __builtin_amdgcn_exp2f(l0v - mm), w1 = __builtin_amdgcn_exp2f(l1v - mm), w2 = __builtin_amdgcn_exp2f(lse2 - mm);
        const float wi = 1.0f / (w0 + w1 + w2);
        const float c0 = w0 * wi, c1 = w1 * wi, c2 = w2 * wi * inv;
        const bf16* p0 = O0 + orow * ATTW + h * HD + 4 * hi; const bf16* p1 = O1 + orow * ATTW + h * HD + 4 * hi;
        bf16* op = MIXIN + orow * DM + h * HD + 4 * hi;
#pragma unroll
        for (int dt = 0; dt < 4; ++dt)
#pragma unroll
            for (int rg = 0; rg < 4; ++rg) { const v2u a = *(const v2u*)(p0 + 32 * dt + 8 * rg), c = *(const v2u*)(p1 + 32 * dt + 8 * rg);
                const float y0 = c0 * bf_lo(a.x) + c1 * bf_lo(c.x) + c2 * o[dt][4 * rg], y1 = c0 * bf_hi(a.x) + c1 * bf_hi(c.x) + c2 * o[dt][4 * rg + 1];
                const float y2 = c0 * bf_lo(a.y) + c1 * bf_lo(c.y) + c2 * o[dt][4 * rg + 2], y3 = c0 * bf_hi(a.y) + c1 * bf_hi(c.y) + c2 * o[dt][4 * rg + 3];
                v2u w; w.x = cvt_pk_bf16(y0, y1); w.y = cvt_pk_bf16(y2, y3); *(v2u*)(op + 32 * dt + 8 * rg) = w;
                if (rg == 3) asm volatile("" ::: "memory"); }
    }
}

constexpr int PER_PHASE = 11;
struct Args { const float* in[16]; float* out; unsigned char* ws; unsigned mask; unsigned pad; };

__constant__ unsigned char CAND_I[64] = {0,0,0,0,0,0,0,0,0,0,0,0,0,0,0,0, 1,1,1,1,1,1,1,1, 2,2,2,2,2, 3,3,3,3, 4,4,4, 5,5, 6,6, 7,7, 8,9,10,11,12,13,14,15, 0,0,0,0,0,0,0,0,0,0,0,0,0,0};
__constant__ unsigned char CAND_J[64] = {0,1,2,3,4,5,6,7,8,9,10,11,12,13,14,15, 0,1,2,3,4,5,6,7, 0,1,2,3,4, 0,1,2,3, 0,1,2, 0,1, 0,1, 0,1, 0,0,0,0,0,0,0,0, 0,0,0,0,0,0,0,0,0,0,0,0,0,0};

__global__ void __launch_bounds__(NWAVES * 64, 2) fwd_kernel(Args args) {
    extern __shared__ __attribute__((aligned(16))) unsigned char lds_raw[];
    LAS unsigned char* lds = (LAS unsigned char*)lds_raw;
    volatile LAS unsigned* MISC = (volatile LAS unsigned*)(lds + MISC_OFF);
    const int tid = threadIdx.x, lane = tid & 63, wave = __builtin_amdgcn_readfirstlane(tid >> 6);
    const int G = gridDim.x; const int bx = blockIdx.x;
    const int vcu = (G % 8 == 0) ? (bx % 8) * (G / 8) + bx / 8 : bx;
    const int gw = vcu * NWAVES + wave, NGW = G * NWAVES;
    unsigned char* ws = args.ws;
    unsigned* ctl = (unsigned*)(ws + WS_CTL);
    const float* x = args.in[0]; const float* cvec = args.in[1]; const float* w_ada = args.in[2]; const float* b_ada = args.in[3]; const float* g_mix = args.in[4];
    const float* w_in = args.in[5]; const float* rel_bias = args.in[6]; const float* pool_w = args.in[7]; const float* pool_scale = args.in[8]; const float* w_out = args.in[9];
    const float* g_ffn = args.in[10]; const float* peer_wq = args.in[11]; const float* peer_sk = args.in[12]; const float* peer_u = args.in[13]; const float* peer_v = args.in[14];
    const float* g_final = args.in[15];
    float* out = args.out;
    float* MODV = (float*)(ws + WS_MODV); float* MODP = (float*)(ws + WS_MODP);
    bf16* SKT = (bf16*)(ws + WS_SKT); bf16* POOLWT = (bf16*)(ws + WS_POOLWT); bf16* WQT = (bf16*)(ws + WS_WQT); bf16* WOUTT = (bf16*)(ws + WS_WOUTT); bf16* WINT = (bf16*)(ws + WS_WINT);
    unsigned char* UB = ws + WS_UB; unsigned char* VB = ws + WS_VB; float* SCL = (float*)(ws + WS_SCL); bf16* H = (bf16*)(ws + WS_H); bf16* PROJ = (bf16*)(ws + WS_PROJ); bf16* MIXIN = (bf16*)(ws + WS_MIXIN);
    bf16* POOLIN = (bf16*)(ws + WS_POOLIN); bf16* O0 = (bf16*)(ws + WS_O0); bf16* O1 = (bf16*)(ws + WS_O1); float* LSE = (float*)(ws + WS_LSE);
    bf16* QP = (bf16*)(ws + WS_QP); float* SC = (float*)(ws + WS_SC);

    for (int u = tid; u < (LDS_BYTES - LDSCTL_OFF) / 4; u += NWAVES * 64) ((LAS unsigned*)(lds + LDSCTL_OFF))[u] = 0u;
    __syncthreads();
    XcdBarrier bar; bar.bar = ctl + CW_BAR; bar.x = 0; bar.st = nullptr;
    if (MK_N_LAUNCHES != PER_PHASE) bar = xcd_barrier_post(ctl + CW_BAR, MISC + 8);
#define GRID_BAR() do { if (MK_N_LAUNCHES != PER_PHASE) xcd_barrier(bar); } while (0)
    const unsigned phmask = args.mask;
#ifndef PH_MASK
#define PH_MASK 0x7ff
#endif
#define IN(k) ((((PH_MASK) >> (k)) & 1) && ((phmask >> (k)) & 1u))
#define BOTH(k) (IN(k) && IN((k) + 1))

    if (IN(0)) {
        LAS float* silu = (LAS float*)(lds + RING_OFF);
        for (int i = tid; i < BATCH * DM; i += NWAVES * 64) { const float v = cvec[i]; silu[i] = v / (1.0f + __expf(-v)); }
        __syncthreads();
        for (int task = gw; task < (NMOD / 256) * KS_ADA; task += NGW) {
            const int cg = task % (NMOD / 256), ks = task / (NMOD / 256); const int k0 = ks * (DM / KS_ADA), n0 = cg * 256 + 4 * lane;
            f32x4 a0 = {0.f, 0.f, 0.f, 0.f}, a1 = {0.f, 0.f, 0.f, 0.f};
            const float* wp = w_ada + (size_t)k0 * NMOD + n0;
#pragma unroll 8
            for (int kk = 0; kk < DM / KS_ADA; ++kk) { const f32x4 w4 = *(const f32x4*)(wp + (size_t)kk * NMOD); const float s0 = silu[k0 + kk], s1 = silu[DM + k0 + kk]; a0 += w4 * s0; a1 += w4 * s1; }
            *(f32x4*)(MODP + ((size_t)(ks * 2 + 0)) * NMOD + n0) = a0; *(f32x4*)(MODP + ((size_t)(ks * 2 + 1)) * NMOD + n0) = a1;
        }
        __syncthreads();
        {
            LAS float* scr = (LAS float*)(lds + RING_OFF + wave * 16384);
            constexpr int I_IN = (DM / 64) * (INW / 32), I_OUT = (DM / 64) * (DM / 32), I_Q = (DM / 64) * (PQ / 32), I_PG = (512 / 64) * (512 / 32);
            constexpr int NITEMS = I_IN + I_OUT + I_Q + 4 * I_PG;
            for (int it = gw; it < NITEMS; it += NGW) {
                int r = it;
                if (r < I_IN) { p0_transpose_item(w_in, DM, INW, WINT, 0, scr, r, lane); continue; } r -= I_IN;
                if (r < I_OUT) { p0_transpose_item(w_out, DM, DM, WOUTT, 0, scr, r, lane); continue; } r -= I_OUT;
                if (r < I_Q) { p0_transpose_item(peer_wq, DM, PQ, WQT, 0, scr, r, lane); continue; } r -= I_Q;
                const int gi = r / I_PG; p0_transpose_item(pool_w + (size_t)gi * 512 * 512, 512, 512, POOLWT, gi * 512, scr, r % I_PG, lane);
            }
        }
        for (int r = gw; r < 2 * NEXP; r += NGW) {
            const bool isU = r < NEXP; const int e = isU ? r : r - NEXP;
            const float* src = (isU ? peer_u : peer_v) + (size_t)e * DM + 16 * lane;
            f32x4 v[4][4]; float mx = 0.f;
#pragma unroll
            for (int i = 0; i < 4; ++i)
#pragma unroll
                for (int q = 0; q < 4; ++q) { v[i][q] = *(const f32x4*)(src + 1024 * i + 4 * q);
                    mx = fmaxf(mx, fmaxf(fmaxf(fabsf(v[i][q][0]), fabsf(v[i][q][1])), fmaxf(fabsf(v[i][q][2]), fabsf(v[i][q][3])))); }
#pragma unroll
            for (int o = 1; o < 64; o <<= 1) mx = fmaxf(mx, __shfl_xor(mx, o));
            const int ex = (int)((__float_as_uint(mx) >> 23) & 0xffu);
            float scale = 1.0f, inv = 1.0f;
            if (ex >= 32 && ex <= 230) { scale = __uint_as_float((unsigned)(261 - ex) << 23); inv = __uint_as_float((unsigned)(ex - 7) << 23); }
            unsigned char* dst = (isU ? UB : VB) + ((size_t)(lane >> 3) * NEXP + e) * 128 + 16 * (lane & 7);
#pragma unroll
            for (int i = 0; i < 4; ++i) { v4u w;
#pragma unroll
                for (int q = 0; q < 4; ++q) { int pk = 0; pk = __builtin_amdgcn_cvt_pk_fp8_f32(v[i][q][0] * scale, v[i][q][1] * scale, pk, false);
                    pk = __builtin_amdgcn_cvt_pk_fp8_f32(v[i][q][2] * scale, v[i][q][3] * scale, pk, true); w[q] = (unsigned)pk; }
                *(v4u*)(dst + (size_t)(8 * i) * NEXP * 128) = w; }
            if (lane == 0) SCL[r] = inv;
        }
        for (int i = gw * 64 + lane; i < 2048 * 32; i += NGW * 64) {
            const int n = i >> 5, kc = (i & 31) * 8; const int p = (n >> 7) & 1, pp = kc >> 7;
            v4u w = {0u, 0u, 0u, 0u};
            if (p == pp) { const float* src = peer_sk + (size_t)n * 128 + (kc & 127); const f32x4 a = *(const f32x4*)src, c = *(const f32x4*)(src + 4);
                w.x = cvt_pk_bf16(a[0], a[1]); w.y = cvt_pk_bf16(a[2], a[3]); w.z = cvt_pk_bf16(c[0], c[1]); w.w = cvt_pk_bf16(c[2], c[3]); }
            *(v4u*)(SKT + (size_t)n * 256 + kc) = w;
        }
        if (BOTH(0)) GRID_BAR();
    }

    if (IN(1)) {
        for (int i = bx * (NWAVES * 64) + tid; i < BATCH * NMOD; i += G * NWAVES * 64) {
            const int b = i / NMOD, n = i % NMOD; float s = b_ada[n];
#pragma unroll 8
            for (int ks = 0; ks < KS_ADA; ++ks) s += MODP[(size_t)(ks * 2 + b) * NMOD + n];
            const int j = n / DM, c = n % DM;
            MODV[(size_t)(j * 2 + b) * DM + c] = s;
        }
        if (BOTH(1)) GRID_BAR();
    }

    if (IN(2)) {
        for (int row = gw; row < M; row += NGW) {
            const int b = row / SEQ;
            const f32x4* xr = (const f32x4*)(x + (size_t)row * DM) + lane;
            f32x4 v[16]; float ss = 0.f;
#pragma unroll
            for (int j = 0; j < 16; ++j) { v[j] = xr[64 * j]; ss += (v[j][0] * v[j][0] + v[j][1] * v[j][1]) + (v[j][2] * v[j][2] + v[j][3] * v[j][3]); }
            const float rstd = 1.0f / sqrtf(wave_sum(ss) * (1.0f / DM) + RMS_EPS);
            const f32x4* gp = (const f32x4*)g_mix + lane; const f32x4* shp = (const f32x4*)(MODV + (size_t)(0 * 2 + b) * DM) + lane; const f32x4* scp = (const f32x4*)(MODV + (size_t)(1 * 2 + b) * DM) + lane;
            v2u* op = (v2u*)(H + (size_t)row * DM) + lane;
#pragma unroll
            for (int j = 0; j < 16; ++j) { const f32x4 g4 = gp[64 * j], sh = shp[64 * j], sc = scp[64 * j];
                const f32x4 y = (v[j] * rstd) * g4 * (sc + 1.0f) + sh;
                v2u w; w.x = cvt_pk_bf16(y[0], y[1]); w.y = cvt_pk_bf16(y[2], y[3]); op[64 * j] = w; }
        }
        if (BOTH(2)) GRID_BAR();
    }

    if (IN(3)) {
        pg8::Gemm g{H, WINT, M, INW, DM, DM, DM, 1 << 30, 0}; pg8::StaticOrder S; S.init(M, INW, G, bx);
        pg8::EpiBf16 E{PROJ, INW, ATTW, QSCALE};
        pg8::gemm_phase<pg8::EpiBf16, pg8::StaticOrder, true>(lds + RING_OFF, g, S, E);
        if (BOTH(3)) GRID_BAR();
    }

    if (IN(4)) {
        LAS float* btab = (LAS float*)(lds + SHARED_OFF);
        LAS unsigned char* vt = lds + RING_OFF + wave * 16384;
        for (int unit = bx; unit < BATCH * NH * (SEQ / 1024); unit += G) {
            const int b = unit >> 7, h = (unit >> 3) & 15, mt = unit & 7;
            __syncthreads();
            for (int i = tid; i < 3 * 256; i += NWAVES * 64) { const int gi = i >> 8, ri = (i & 255) - 32; const int dil = gi == 0 ? 1 : (gi == 1 ? 4 : 16);
                btab[i] = (ri >= 0 && ri <= 128) ? rel_bias[t5_bucket((ri - 64) * dil) * NH + h] * LOG2E : -1e30f; }
            __syncthreads();
            for (int g = 0; g < 3; ++g) {
                if (g == 2) { VM_WAIT(); __syncthreads(); }
                for (int tk = wave; tk < 32; tk += NWAVES) attn_task(g, PROJ, O0, O1, LSE, LSE + (size_t)M * NH, MIXIN, btab, vt, b, h, mt, tk, lane);
            }
        }
        for (int i = bx * (NWAVES * 64) + tid; i < M * (POOLW / 8); i += G * NWAVES * 64) {
            const int token = i >> 8, cc = i & 255; const int gi = cc >> 6, half = 1 << gi;
            const int b = token / SEQ, pos = token % SEQ;
            const int plo = pos - half < 0 ? 0 : pos - half, phi = pos + half > SEQ ? SEQ : pos + half;
            float s[8] = {0.f, 0.f, 0.f, 0.f, 0.f, 0.f, 0.f, 0.f};
            const bf16* base = PROJ + (size_t)b * SEQ * INW + 3 * ATTW + cc * 8;
            for (int pp = plo; pp < phi; ++pp) { const v4u w = *(const v4u*)(base + (size_t)pp * INW);
                s[0] += bf_lo(w.x); s[1] += bf_hi(w.x); s[2] += bf_lo(w.y); s[3] += bf_hi(w.y); s[4] += bf_lo(w.z); s[5] += bf_hi(w.z); s[6] += bf_lo(w.w); s[7] += bf_hi(w.w); }
            const v4u me = *(const v4u*)(base + (size_t)pos * INW);
            const float inv = 1.0f / (float)(phi - plo);
            v4u w; w.x = cvt_pk_bf16(s[0] * inv - bf_lo(me.x), s[1] * inv - bf_hi(me.x)); w.y = cvt_pk_bf16(s[2] * inv - bf_lo(me.y), s[3] * inv - bf_hi(me.y));
            w.z = cvt_pk_bf16(s[4] * inv - bf_lo(me.z), s[5] * inv - bf_hi(me.z)); w.w = cvt_pk_bf16(s[6] * inv - bf_lo(me.w), s[7] * inv - bf_hi(me.w));
            *(v4u*)(POOLIN + (size_t)token * POOLW + cc * 8) = w;
        }
        if (BOTH(4)) GRID_BAR();
    }

    if (IN(5)) {
        pg8::Gemm g{POOLIN, POOLWT, M, POOLW, 512, POOLW, 512, 2, 512}; pg8::StaticOrder S; S.init(M, POOLW, G, bx);
        pg8::EpiBf16ColScale E{MIXIN, DM, ATTW, pool_scale};
        pg8::gemm_phase<pg8::EpiBf16ColScale, pg8::StaticOrder, true>(lds + RING_OFF, g, S, E);
        if (BOTH(5)) GRID_BAR();
    }

    if (IN(6)) {
        pg8::Gemm g{MIXIN, WOUTT, M, DM, DM, DM, DM, 1 << 30, 0}; pg8::StaticOrder S; S.init(M, DM, G, bx);
        pg8::EpiResF32 E{x, MODV + (size_t)(2 * 2) * DM, out, DM};
        pg8::gemm_phase<pg8::EpiResF32, pg8::StaticOrder, true>(lds + RING_OFF, g, S, E);
        if (BOTH(6)) GRID_BAR();
    }

    if (IN(7)) {
        for (int row = gw; row < M; row += NGW) {
            const int b = row / SEQ;
            const f32x4* xr = (const f32x4*)(out + (size_t)row * DM) + lane;
            f32x4 v[16]; float ss = 0.f;
#pragma unroll
            for (int j = 0; j < 16; ++j) { v[j] = xr[64 * j]; ss += (v[j][0] * v[j][0] + v[j][1] * v[j][1]) + (v[j][2] * v[j][2] + v[j][3] * v[j][3]); }
            const float rstd = 1.0f / sqrtf(wave_sum(ss) * (1.0f / DM) + RMS_EPS);
            const f32x4* gp = (const f32x4*)g_ffn + lane; const f32x4* shp = (const f32x4*)(MODV + (size_t)(3 * 2 + b) * DM) + lane; const f32x4* scp = (const f32x4*)(MODV + (size_t)(4 * 2 + b) * DM) + lane;
            v2u* op = (v2u*)(H + (size_t)row * DM) + lane;
#pragma unroll
            for (int j = 0; j < 16; ++j) { const f32x4 g4 = gp[64 * j], sh = shp[64 * j], sc = scp[64 * j];
                const f32x4 y = (v[j] * rstd) * g4 * (sc + 1.0f) + sh;
                v2u w; w.x = cvt_pk_bf16(y[0], y[1]); w.y = cvt_pk_bf16(y[2], y[3]); op[64 * j] = w; }
        }
        if (BOTH(7)) GRID_BAR();
    }

    if (IN(8)) {
        pg8::Gemm g{H, WQT, M, PQ, DM, DM, DM, 1 << 30, 0}; pg8::StaticOrder S; S.init(M, PQ, G, bx);
        pg8::EpiBf16 E{QP, PQ, 0, 1.0f};
        pg8::gemm_phase<pg8::EpiBf16, pg8::StaticOrder, true>(lds + RING_OFF, g, S, E);
        if (BOTH(8)) GRID_BAR();
    }

    if (IN(9)) {
        pg8::Gemm g{QP, SKT, M, PQ, 256, PQ, 256, 1, 256}; pg8::StaticOrder S; S.init(M, PQ, G, bx);
        pg8::EpiF32 E{SC, PQ};
        pg8::gemm_phase<pg8::EpiF32, pg8::StaticOrder, true>(lds + RING_OFF, g, S, E);
        if (BOTH(9)) GRID_BAR();
    }

    if (IN(10)) {
        LAS unsigned short* EXPW = (LAS unsigned short*)(lds + RING_OFF);
        LAS float* GACT = (LAS float*)(lds + RING_OFF + 16384);
        LAS unsigned* W = (LAS unsigned*)(lds + RING_OFF + 49152 + wave * 4096);
        LAS unsigned* K1 = W; LAS unsigned* K2 = W + 128;
        LAS float* TV1 = (LAS float*)(W + 256); LAS int* TI1 = (LAS int*)(W + 272); LAS float* TV2 = (LAS float*)(W + 288); LAS int* TI2 = (LAS int*)(W + 304);
        LAS unsigned* CK = W + 320; LAS float* SV = (LAS float*)(W + 384); LAS int* SE = (LAS int*)(W + 400);
        const int c8 = lane & 7, r8 = lane >> 3;
        for (int blk = vcu; blk < M / 64; blk += G) {
            const int tok0 = blk * 64; const int b = tok0 / SEQ;
            for (int j = 0; j < 8; ++j) {
                const int tl = wave * 8 + j; const int t = tok0 + tl;
#ifndef TOPK_REP
#define TOPK_REP 1
#endif
                for (int hh = 0; hh < 8 * TOPK_REP; ++hh) { const int h = hh & 7;
                    const float* sp = SC + (size_t)t * PQ + h * 256;
                    const float a0 = sp[lane], a1 = sp[64 + lane], b0 = sp[128 + lane], b1 = sp[192 + lane];
                    const unsigned ka0 = (fkey(a0) & ~127u) | (unsigned)(127 - lane), ka1 = (fkey(a1) & ~127u) | (unsigned)(63 - lane);
                    const unsigned kb0 = (fkey(b0) & ~127u) | (unsigned)(127 - lane), kb1 = (fkey(b1) & ~127u) | (unsigned)(63 - lane);
                    K1[lane] = ka0; K1[64 + lane] = ka1; K2[lane] = kb0; K2[64 + lane] = kb1;
                    LDS_WAIT();
                    int ra0 = 0, ra1 = 0, rb0 = 0, rb1 = 0;
#pragma unroll 8
                    for (int kk = 0; kk < 32; ++kk) { const v4u q = ((const LAS v4u*)K1)[kk], r = ((const LAS v4u*)K2)[kk];
                        ra0 += (q.x > ka0) + (q.y > ka0) + (q.z > ka0) + (q.w > ka0); ra1 += (q.x > ka1) + (q.y > ka1) + (q.z > ka1) + (q.w > ka1);
                        rb0 += (r.x > kb0) + (r.y > kb0) + (r.z > kb0) + (r.w > kb0); rb1 += (r.x > kb1) + (r.y > kb1) + (r.z > kb1) + (r.w > kb1); }
                    if (ra0 < 16) { TV1[ra0] = a0; TI1[ra0] = lane; } if (ra1 < 16) { TV1[ra1] = a1; TI1[ra1] = 64 + lane; }
                    if (rb0 < 16) { TV2[rb0] = b0; TI2[rb0] = lane; } if (rb1 < 16) { TV2[rb1] = b1; TI2[rb1] = 64 + lane; }
                    LDS_WAIT();
                    const int ci_i = CAND_I[lane], ci_j = CAND_J[lane];
                    const float cv = TV1[ci_i] + TV2[ci_j];
                    const unsigned ck = lane < 50 ? ((fkey(cv) & ~255u) | (unsigned)(255 - (ci_i * 16 + ci_j))) : 0u;
                    CK[lane] = ck;
                    LDS_WAIT();
                    int rc = 0;
#pragma unroll 8
                    for (int kk = 0; kk < 16; ++kk) { const v4u q = ((const LAS v4u*)CK)[kk]; rc += (q.x > ck) + (q.y > ck) + (q.z > ck) + (q.w > ck); }
                    if (lane < 50 && rc < 16) { SV[rc] = cv; SE[rc] = TI1[ci_i] * 128 + TI2[ci_j]; }
                    LDS_WAIT();
                    const float top0 = SV[0], myv = SV[lane & 15]; const int mye = SE[lane & 15];
                    const float e = __expf(myv - top0);
                    float ssum = e; ssum += __shfl_xor(ssum, 1); ssum += __shfl_xor(ssum, 2); ssum += __shfl_xor(ssum, 4); ssum += __shfl_xor(ssum, 8);
                    if (lane < 16) { EXPW[tl * 128 + h * 16 + lane] = (unsigned short)mye; GACT[tl * 128 + h * 16 + lane] = e / ssum; }
                    LDS_WAIT();
                }
            }
            LAS float* ACC = (LAS float*)(lds + RING_OFF + 81920);
            for (int i = lane; i < 8 * 128; i += 64) ACC[wave * 1024 + i] = 0.f;
            LDS_WAIT();
            {
                v4u gn[16]; v4u hna, hnb;
#define P10_LOADU(idx) do { const int s_ = (idx) >> 3, j_ = (idx) & 7; const int tl_ = wave * 8 + j_; \
                    const unsigned char* tb_ = UB + (size_t)s_ * NEXP * 128 + 16 * c8; \
                    const v4u* hp_ = (const v4u*)(H + (size_t)(tok0 + tl_) * DM + 128 * s_ + 16 * c8); hna = hp_[0]; hnb = hp_[1]; \
                    _Pragma("unroll") for (int i = 0; i < 16; ++i) { const unsigned e_ = EXPW[tl_ * 128 + r8 + 8 * i]; gn[i] = *(const v4u*)(tb_ + (size_t)e_ * 128); } } while (0)
                P10_LOADU(0);
#pragma unroll 1
                for (int idx = 0; idx < 256; ++idx) {
                    v4u g[16]; const v4u ha = hna, hb = hnb;
#pragma unroll
                    for (int i = 0; i < 16; ++i) g[i] = gn[i];
                    if (idx + 1 < 256) P10_LOADU(idx + 1);
                    const int tl = wave * 8 + (idx & 7);
                    f32x2 hs[8];
                    hs[0] = (f32x2){bf_lo(ha.x), bf_hi(ha.x)}; hs[1] = (f32x2){bf_lo(ha.y), bf_hi(ha.y)}; hs[2] = (f32x2){bf_lo(ha.z), bf_hi(ha.z)}; hs[3] = (f32x2){bf_lo(ha.w), bf_hi(ha.w)};
                    hs[4] = (f32x2){bf_lo(hb.x), bf_hi(hb.x)}; hs[5] = (f32x2){bf_lo(hb.y), bf_hi(hb.y)}; hs[6] = (f32x2){bf_lo(hb.z), bf_hi(hb.z)}; hs[7] = (f32x2){bf_lo(hb.w), bf_hi(hb.w)};
                    float p[16];
#pragma unroll
                    for (int i = 0; i < 16; ++i) { f32x2 a2 = {0.f, 0.f};
#pragma unroll
                        for (int q = 0; q < 4; ++q) { a2 += __builtin_amdgcn_cvt_pk_f32_fp8((int)g[i][q], false) * hs[2 * q]; a2 += __builtin_amdgcn_cvt_pk_f32_fp8((int)g[i][q], true) * hs[2 * q + 1]; }
                        p[i] = a2.x + a2.y; }
                    float q8[8], q4[4], q2[2];
#pragma unroll
                    for (int m = 0; m < 8; ++m) { const float snd = (c8 & 4) ? p[m] : p[m + 8], kp = (c8 & 4) ? p[m + 8] : p[m]; q8[m] = kp + __shfl_xor(snd, 4); }
#pragma unroll
                    for (int m = 0; m < 4; ++m) { const float snd = (c8 & 2) ? q8[m] : q8[m + 4], kp = (c8 & 2) ? q8[m + 4] : q8[m]; q4[m] = kp + __shfl_xor(snd, 2); }
#pragma unroll
                    for (int m = 0; m < 2; ++m) { const float snd = (c8 & 1) ? q4[m] : q4[m + 2], kp = (c8 & 1) ? q4[m + 2] : q4[m]; q2[m] = kp + __shfl_xor(snd, 1); }
                    LAS float* ap = ACC + tl * 128 + r8 + 16 * c8;
                    ap[0] += q2[0]; ap[8] += q2[1];
                }
#undef P10_LOADU
            }
            LDS_WAIT();
            for (int i = lane; i < 8 * 128; i += 64) { const int o_ = wave * 1024 + i; const unsigned e = EXPW[o_];
                const float a = ACC[o_] * SCL[e]; GACT[o_] = gelu_tanh(a) * GACT[o_] * SCL[NEXP + e]; }
            LDS_WAIT();
            LAS float* SSQ = ACC;
            for (int j = 0; j < 8; ++j) SSQ[(wave * 8 + j) * 128 + lane] = 0.f;
            LDS_WAIT();
            const float* gtp = MODV + (size_t)(5 * 2 + b) * DM;
            {
                v4u gn[16]; float avn[16];
#define P10_LOADV(idx) do { const int s_ = (idx) >> 3, j_ = (idx) & 7; const int tl_ = wave * 8 + j_; \
                    const unsigned char* tb_ = VB + (size_t)s_ * NEXP * 128 + 16 * c8; \
                    _Pragma("unroll") for (int i = 0; i < 16; ++i) { const int k_ = tl_ * 128 + r8 + 8 * i; const unsigned e_ = EXPW[k_]; avn[i] = GACT[k_]; gn[i] = *(const v4u*)(tb_ + (size_t)e_ * 128); } } while (0)
                P10_LOADV(0);
#pragma unroll 1
                for (int idx = 0; idx < 256; ++idx) {
                    v4u g[16]; float av[16];
#pragma unroll
                    for (int i = 0; i < 16; ++i) { g[i] = gn[i]; av[i] = avn[i]; }
                    if (idx + 1 < 256) P10_LOADV(idx + 1);
                    const int s_c = idx >> 3; const int tl = wave * 8 + (idx & 7); const int t = tok0 + tl;
                    f32x2 o8[8];
#pragma unroll
                    for (int q = 0; q < 8; ++q) o8[q] = (f32x2){0.f, 0.f};
#pragma unroll
                    for (int i = 0; i < 16; ++i)
#pragma unroll
                        for (int q = 0; q < 4; ++q) { o8[2 * q] += __builtin_amdgcn_cvt_pk_f32_fp8((int)g[i][q], false) * av[i]; o8[2 * q + 1] += __builtin_amdgcn_cvt_pk_f32_fp8((int)g[i][q], true) * av[i]; }
                    float p[16], q8[8], q4[4], q2[2];
#pragma unroll
                    for (int q = 0; q < 8; ++q) { p[2 * q] = o8[q].x; p[2 * q + 1] = o8[q].y; }
#pragma unroll
                    for (int m = 0; m < 8; ++m) { const float snd = (r8 & 4) ? p[m] : p[m + 8], kp = (r8 & 4) ? p[m + 8] : p[m]; q8[m] = kp + __shfl_xor(snd, 32); }
#pragma unroll
                    for (int m = 0; m < 4; ++m) { const float snd = (r8 & 2) ? q8[m] : q8[m + 4], kp = (r8 & 2) ? q8[m + 4] : q8[m]; q4[m] = kp + __shfl_xor(snd, 16); }
#pragma unroll
                    for (int m = 0; m < 2; ++m) { const float snd = (r8 & 1) ? q4[m] : q4[m + 2], kp = (r8 & 1) ? q4[m + 2] : q4[m]; q2[m] = kp + __shfl_xor(snd, 8); }
                    const int d = 128 * s_c + 16 * c8 + 2 * r8;
                    const f32x2 xv = *(const f32x2*)(out + (size_t)t * DM + d), gv = *(const f32x2*)(gtp + d);
                    f32x2 y; y.x = xv.x + gv.x * q2[0]; y.y = xv.y + gv.y * q2[1];
                    *(f32x2*)(out + (size_t)t * DM + d) = y;
                    SSQ[tl * 128 + lane] += y.x * y.x + y.y * y.y;
                }
#undef P10_LOADV
            }
            VM_WAIT(); LDS_WAIT();
            __builtin_amdgcn_fence(__ATOMIC_ACQUIRE, "agent");
            VM_WAIT();
            for (int j = 0; j < 8; ++j) {
                const int tl = wave * 8 + j; const int t = tok0 + tl;
                const float rstd = 1.0f / sqrtf(wave_sum(SSQ[tl * 128 + lane]) * (1.0f / DM) + RMS_EPS);
                f32x4* op = (f32x4*)(out + (size_t)t * DM) + lane; const f32x4* gp = (const f32x4*)g_final + lane;
#pragma unroll 4
                for (int i = 0; i < 16; ++i) { const f32x4 y = op[64 * i]; op[64 * i] = y * rstd * gp[64 * i]; }
            }
            LDS_WAIT();
        }
    }
#undef IN
#undef BOTH
#undef GRID_BAR
}

extern "C" void kernel_launch(void* const* d_in, const int* in_sizes, int n_in, void* d_out, int out_size, void* d_ws, size_t ws_size, hipStream_t stream) {
    static int grid = 0;
    if (grid == 0) {
        if (n_in != 16 || in_sizes[0] != M * DM || out_size != M * DM || ws_size < WS_END) {
            fprintf(stderr, "kernel_launch: shape/workspace mismatch: n_in %d in0 %d out %d ws %zu (need %zu)\n", n_in, n_in > 0 ? in_sizes[0] : -1, out_size, ws_size, (size_t)WS_END); grid = -1; return; }
        int dev = 0, cus = 0, per_cu = 0;
        if (hipGetDevice(&dev) != hipSuccess || hipDeviceGetAttribute(&cus, hipDeviceAttributeMultiprocessorCount, dev) != hipSuccess) { grid = -1; return; }
        if (hipFuncSetAttribute((const void*)fwd_kernel, hipFuncAttributeMaxDynamicSharedMemorySize, LDS_BYTES) != hipSuccess) { fprintf(stderr, "kernel_launch: hipFuncSetAttribute failed\n"); grid = -1; return; }
        if (hipOccupancyMaxActiveBlocksPerMultiprocessor(&per_cu, (const void*)fwd_kernel, NWAVES * 64, LDS_BYTES) != hipSuccess || per_cu < 1)
            fprintf(stderr, "kernel_launch: note: occupancy query reports %d workgroups per CU\n", per_cu);
        (void)hipGetLastError();
        grid = cus;
    }
    if (grid < 0) return;
    if (hipMemsetAsync((char*)d_ws + WS_CTL, 0, CTL_ZERO_BYTES, stream) != hipSuccess) { fprintf(stderr, "kernel_launch: memset failed\n"); return; }
    Args a{};
    for (int i = 0; i < 16; ++i) a.in[i] = (const float*)d_in[i];
    a.out = (float*)d_out; a.ws = (unsigned char*)d_ws;
#ifdef PROBE_MASK
    {
        a.mask = PROBE_MASK; a.pad = 0;
        hipLaunchKernelGGL(fwd_kernel, dim3(grid), dim3(NWAVES * 64), LDS_BYTES, stream, a);
        (void)hipMemsetAsync((char*)d_ws + WS_CTL, 0, CTL_ZERO_BYTES, stream);
    }
#endif
    for (int li = 0; li < MK_N_LAUNCHES; ++li) {
        a.mask = (MK_N_LAUNCHES == PER_PHASE) ? (1u << li) : ((1u << PER_PHASE) - 1u); a.pad = 0;
        hipLaunchKernelGGL(fwd_kernel, dim3(grid), dim3(NWAVES * 64), LDS_BYTES, stream, a);
        const hipError_t le = hipPeekAtLastError();
        if (le != hipSuccess) { fprintf(stderr, "kernel_launch: launch %d failed: %s\n", li, hipGetErrorName(le)); break; }
    }
}
```

```cpp
#include <hip/hip_runtime.h>
#include <cstdio>
#include <cstdint>

#ifndef MK_N_LAUNCHES
#define MK_N_LAUNCHES 1
#endif

#define GAS __attribute__((address_space(1)))
#define LAS __attribute__((address_space(3)))
typedef unsigned short bf16;
typedef unsigned v4u __attribute__((ext_vector_type(4)));
typedef unsigned v2u __attribute__((ext_vector_type(2)));
typedef float f32x4 __attribute__((ext_vector_type(4)));
typedef float f32x2 __attribute__((ext_vector_type(2)));
typedef float f32x16 __attribute__((ext_vector_type(16)));
typedef short bf16x8 __attribute__((ext_vector_type(8)));
typedef short s16x4 __attribute__((ext_vector_type(4)));
typedef __bf16 bf2_t __attribute__((ext_vector_type(2)));

constexpr int BATCH = 2, SEQ = 8192, DM = 4096, M = BATCH * SEQ;
constexpr int NH = 16, HD = 128, ATTW = 2048, POOLW = 2048, INW = 8192;
constexpr int NMOD = 6 * DM;
constexpr int PQ = 2048;
constexpr int NEXP = 16384;
constexpr float RMS_EPS = 1e-6f;
constexpr float LOG2E = 1.4426950408889634f;
constexpr float QSCALE = 0.08838834764831845f * LOG2E;
constexpr int KS_ADA = 64;

constexpr size_t MiB = 1u << 20;
constexpr size_t WS_CTL = 0, CTL_ZERO_BYTES = 1 * MiB;
constexpr size_t WS_MODV = 1 * MiB;
constexpr size_t WS_SCL = 2 * MiB;
constexpr size_t WS_MODP = 4 * MiB;
constexpr size_t WS_SKT = 20 * MiB;
constexpr size_t WS_POOLWT = 22 * MiB;
constexpr size_t WS_WQT = 24 * MiB;
constexpr size_t WS_WOUTT = 40 * MiB;
constexpr size_t WS_WINT = 72 * MiB;
constexpr size_t WS_UB = 136 * MiB;
constexpr size_t WS_VB = 264 * MiB;
constexpr size_t WS_H = 392 * MiB;
constexpr size_t WS_PROJ = 520 * MiB;
constexpr size_t WS_MIXIN = 776 * MiB;
constexpr size_t WS_POOLIN = 904 * MiB;
constexpr size_t WS_O0 = 968 * MiB, WS_O1 = 1032 * MiB;
constexpr size_t WS_LSE = 1096 * MiB;
constexpr size_t WS_QP = 1100 * MiB;
constexpr size_t WS_SC = 1164 * MiB;
constexpr size_t WS_END = 1292 * MiB;

constexpr int RING_OFF = 0, RING_BYTES = 131072;
constexpr int ATT_WAVE_BYTES = 17408;
constexpr int SHARED_OFF = 139264;
constexpr int LDSCTL_OFF = 139264 + 4096, MISC_OFF = LDSCTL_OFF + 320;
constexpr int LDS_BYTES = 147456;
constexpr int NWAVES = 8;
constexpr int CW_BAR = 4096;

#define LDS_WAIT() asm volatile("s_waitcnt lgkmcnt(0)" ::: "memory")
#define VM_WAIT() asm volatile("s_waitcnt vmcnt(0)" ::: "memory")

__device__ __forceinline__ unsigned cvt_pk_bf16(float lo, float hi) { unsigned r; asm volatile("v_cvt_pk_bf16_f32 %0, %1, %2" : "=v"(r) : "v"(lo), "v"(hi)); return r; }
__device__ __forceinline__ float bf_lo(unsigned u) { return __uint_as_float(u << 16); }
__device__ __forceinline__ float bf_hi(unsigned u) { return __uint_as_float(u & 0xffff0000u); }
__device__ __forceinline__ float wave_sum(float v) {
#pragma unroll
    for (int o = 1; o < 64; o <<= 1) v += __shfl_xor(v, o);
    return v;
}

namespace pg8 {
typedef unsigned short bf16_t;
constexpr int BM = 256, BK = 64, HALF = 128, HTB = HALF * BK * 2, STAGE_BYTES = 8 * HTB, NXCD = 8, WGM = 8;

__host__ __device__ __forceinline__ int lds_byte(int r, int c) { const int st = (r >> 4) * 2 + (c >> 5), rr = r & 15, cc = c & 31, ob = rr * 64 + cc * 2; return st * 1024 + (ob ^ (((ob >> 9) & 1) << 5)); }
__host__ __device__ __forceinline__ void stage_rc(int b, int& R, int& C) { const int st = b / 1024, sb = b % 1024, swz = sb ^ (((sb >> 9) & 1) << 5); R = (st >> 1) * 16 + swz / 64; C = (st & 1) * 32 + (swz % 64) / 2; }
__host__ __device__ __forceinline__ int perm32(int rho) { const int n = rho >> 4, i = rho & 15; return 8 * (i >> 2) + 4 * n + (i & 3); }

struct Unit { int pm, pn; };
struct Gemm { const bf16_t* A; const bf16_t* Bt; int M, N, K, lda, ldb, agrp_div, agrp_cols; };

struct StaticOrder {
    int nM, nN, nwg, G, c;
    __host__ __device__ void init(int M_, int N_, int G_, int c_) { nM = M_ / BM; nN = N_ / BM; nwg = nM * nN; G = G_; c = c_; }
    __host__ __device__ bool next(int i, Unit& u) const {
        const long L = (long)i * G + c; if (L >= nwg) return false;
        int wgid = (int)L; { const int q = nwg / NXCD, r = nwg % NXCD, xcd = wgid % NXCD, off = wgid / NXCD; wgid = (xcd < r ? xcd * (q + 1) : r * (q + 1) + (xcd - r) * q) + off; }
        const int nig = WGM * nN, gid = wgid / nig, fm = gid * WGM, gsz = (nM - fm) < WGM ? (nM - fm) : WGM;
        u.pm = fm + ((wgid % nig) % gsz); u.pn = (wgid % nig) / gsz; return true;
    }
    __device__ __forceinline__ void a_ready(const Unit&) const {}
    __device__ __forceinline__ void done(const Unit&) const {}
};

struct EpiBf16 {
    static constexpr bool PERM = true, AFTER_DRAIN = false;
    bf16_t* O; int ldc; int scale_cols; float scale0;
    __device__ __forceinline__ void operator()(const f32x4 (&acc)[2][2][4][2], const Unit& u, int wr, int wc, int fr, int fq) const {
        const int row0 = u.pm * BM + wr * 64 + fr; const int colt = u.pn * BM;
        const float sc = (colt < scale_cols) ? scale0 : 1.f;
        const int col0 = colt + wc * 32 + 8 * fq;
#pragma unroll
        for (int ai = 0; ai < 2; ++ai)
#pragma unroll
            for (int m = 0; m < 4; ++m) { bf16_t* rowp = O + (size_t)(row0 + ai * HALF + m * 16) * ldc + col0;
#pragma unroll
                for (int bj = 0; bj < 2; ++bj) { f32x4 v0 = acc[ai][bj][m][0] * sc, v1 = acc[ai][bj][m][1] * sc;
                    v4u w; w.x = cvt_pk_bf16(v0[0], v0[1]); w.y = cvt_pk_bf16(v0[2], v0[3]); w.z = cvt_pk_bf16(v1[0], v1[1]); w.w = cvt_pk_bf16(v1[2], v1[3]);
                    *(v4u*)(rowp + bj * HALF) = w; } }
    }
};
struct EpiBf16ColScale {
    static constexpr bool PERM = true, AFTER_DRAIN = false;
    bf16_t* O; int ldc; int coff; const float* cs;
    __device__ __forceinline__ void operator()(const f32x4 (&acc)[2][2][4][2], const Unit& u, int wr, int wc, int fr, int fq) const {
        const int row0 = u.pm * BM + wr * 64 + fr; const int col0 = u.pn * BM + wc * 32 + 8 * fq;
        f32x4 sv[2][2];
#pragma unroll
        for (int bj = 0; bj < 2; ++bj)
#pragma unroll
            for (int n = 0; n < 2; ++n) sv[bj][n] = *(const f32x4*)(cs + col0 + bj * HALF + 4 * n);
#pragma unroll
        for (int ai = 0; ai < 2; ++ai)
#pragma unroll
            for (int m = 0; m < 4; ++m) { bf16_t* rowp = O + (size_t)(row0 + ai * HALF + m * 16) * ldc + coff + col0;
#pragma unroll
                for (int bj = 0; bj < 2; ++bj) { f32x4 v0 = acc[ai][bj][m][0] * sv[bj][0], v1 = acc[ai][bj][m][1] * sv[bj][1];
                    v4u w; w.x = cvt_pk_bf16(v0[0], v0[1]); w.y = cvt_pk_bf16(v0[2], v0[3]); w.z = cvt_pk_bf16(v1[0], v1[1]); w.w = cvt_pk_bf16(v1[2], v1[3]);
                    *(v4u*)(rowp + bj * HALF) = w; } }
    }
};
struct EpiResF32 {
    static constexpr bool PERM = false, AFTER_DRAIN = false;
    const float* X; const float* gate; float* O; int ldc;
    __device__ __forceinline__ void operator()(const f32x4 (&acc)[2][2][4][2], const Unit& u, int wr, int wc, int fr, int fq) const {
        const int row0 = u.pm * BM + wr * 64 + fr; const int col0 = u.pn * BM + wc * 32 + 4 * fq; const int b = (u.pm * BM) / SEQ;
        f32x4 gv[2][2];
#pragma unroll
        for (int bj = 0; bj < 2; ++bj)
#pragma unroll
            for (int n = 0; n < 2; ++n) gv[bj][n] = *(const f32x4*)(gate + (size_t)b * DM + col0 + bj * HALF + n * 16);
#pragma unroll
        for (int ai = 0; ai < 2; ++ai)
#pragma unroll
            for (int m = 0; m < 4; ++m) { const size_t off = (size_t)(row0 + ai * HALF + m * 16) * ldc + col0;
#pragma unroll
                for (int bj = 0; bj < 2; ++bj)
#pragma unroll
                    for (int n = 0; n < 2; ++n) { const f32x4 xv = *(const f32x4*)(X + off + bj * HALF + n * 16);
                        *(f32x4*)(O + off + bj * HALF + n * 16) = xv + gv[bj][n] * acc[ai][bj][m][n]; } }
    }
};
struct EpiF32 {
    static constexpr bool PERM = false, AFTER_DRAIN = false;
    float* O; int ldc;
    __device__ __forceinline__ void operator()(const f32x4 (&acc)[2][2][4][2], const Unit& u, int wr, int wc, int fr, int fq) const {
        const int row0 = u.pm * BM + wr * 64 + fr; const int col0 = u.pn * BM + wc * 32 + 4 * fq;
#pragma unroll
        for (int ai = 0; ai < 2; ++ai)
#pragma unroll
            for (int m = 0; m < 4; ++m) { const size_t off = (size_t)(row0 + ai * HALF + m * 16) * ldc + col0;
#pragma unroll
                for (int bj = 0; bj < 2; ++bj)
#pragma unroll
                    for (int n = 0; n < 2; ++n) *(f32x4*)(O + off + bj * HALF + n * 16) = acc[ai][bj][m][n]; }
    }
};

template <class Epi, class Sched, bool ALIGN_EPI>
__device__ __forceinline__ void gemm_phase(LAS unsigned char* lds, const Gemm g, const Sched& S, const Epi& E) {
    const int tid = threadIdx.x, wid = __builtin_amdgcn_readfirstlane(tid >> 6), lane = tid & 63, wr = wid >> 2, wc = wid & 3, fr = lane & 15, fq = lane >> 4;
    const int K = g.K, nt = K / BK;
    unsigned voffA[2], voffB[2];
#pragma unroll
    for (int i = 0; i < 2; ++i) { int R, C; stage_rc(tid * 16 + i * 8192, R, C); const int Rb = Epi::PERM ? ((R & ~31) + perm32(R & 31)) : R;
        voffA[i] = (unsigned)(R * g.lda + C) * 2u; voffB[i] = (unsigned)(Rb * g.ldb + C) * 2u; }
    const size_t kstep = (size_t)(BK * 2);
    const size_t hstepA = (size_t)HALF * g.lda * 2, hstepB = (size_t)HALF * g.ldb * 2;
    const size_t tstepA = 2 * hstepA, tstepB = 2 * hstepB;
    const unsigned ldsw = (unsigned)wid * 1024u;
    const int aoff = lds_byte(wr * 64 + fr, fq * 8), boff = lds_byte(wc * 32 + fr, fq * 8);
#define PG8_SA(b, h) (((b) * 2 + (h)) * HTB)
#define PG8_SB(b, h) ((4 + (b) * 2 + (h)) * HTB)
#define PG8_STAGE(bufoff, gbase, voff) do { _Pragma("unroll") for (int _i = 0; _i < 2; ++_i) \
        __builtin_amdgcn_global_load_lds((const unsigned*)((const char*)(gbase) + (voff)[_i]), (LAS unsigned*)(lds + (bufoff) + ldsw + _i * 8192), 16, 0, 0); } while (0)
#define PG8_LDA(dst, b, h) do { _Pragma("unroll") for (int m = 0; m < 4; ++m) _Pragma("unroll") for (int k = 0; k < 2; ++k) dst[m][k] = *(const LAS bf16x8*)(lds + PG8_SA(b, h) + aoff + m * 2048 + k * 1024); } while (0)
#define PG8_LDB(dst, b, h) do { _Pragma("unroll") for (int n = 0; n < 2; ++n) _Pragma("unroll") for (int k = 0; k < 2; ++k) dst[n][k] = *(const LAS bf16x8*)(lds + PG8_SB(b, h) + boff + n * 2048 + k * 1024); } while (0)
#define PG8_MMA(ai, bj, At, Bt) do { __builtin_amdgcn_s_setprio(1); _Pragma("unroll") for (int m = 0; m < 4; ++m) _Pragma("unroll") for (int n = 0; n < 2; ++n) _Pragma("unroll") for (int k = 0; k < 2; ++k) \
        acc[ai][bj][m][n] = __builtin_amdgcn_mfma_f32_16x16x32_bf16(Bt[n][k], At[m][k], acc[ai][bj][m][n], 0, 0, 0); __builtin_amdgcn_s_setprio(0); } while (0)
#define PG8_WAIT_V(n) asm volatile("s_waitcnt vmcnt(" #n ")" ::: "memory")
#define PG8_WAIT_L(n) asm volatile("s_waitcnt lgkmcnt(" #n ")" ::: "memory")
#define PG8_BAR __builtin_amdgcn_s_barrier()
#define PG8_SCHED __builtin_amdgcn_sched_barrier(0)
#define PG8_ABASE(u) ((const char*)g.A + (size_t)(u).pm * tstepA + (size_t)((u).pn / g.agrp_div) * (size_t)g.agrp_cols * 2)
#define PG8_BBASE(u) ((const char*)g.Bt + (size_t)(u).pn * tstepB)
    Unit cur, nxt; int ui = 0;
    if (!S.next(0, cur)) return;
    f32x4 acc[2][2][4][2];
#pragma unroll
    for (int a = 0; a < 2; ++a)
#pragma unroll
        for (int b = 0; b < 2; ++b)
#pragma unroll
            for (int m = 0; m < 4; ++m)
#pragma unroll
                for (int n = 0; n < 2; ++n) acc[a][b][m][n] = (f32x4){0.f, 0.f, 0.f, 0.f};
    bf16x8 At[4][2], B0[2][2], B1[2][2];
    const char* cA = PG8_ABASE(cur); const char* cB = PG8_BBASE(cur);
    S.a_ready(cur);
    PG8_STAGE(PG8_SB(0, 0), cB, voffB); PG8_STAGE(PG8_SB(0, 1), cB + hstepB, voffB); PG8_STAGE(PG8_SA(0, 0), cA, voffA); PG8_STAGE(PG8_SA(0, 1), cA + hstepA, voffA);
    if (wr == 1) PG8_BAR;
    PG8_WAIT_V(2); PG8_BAR;
    PG8_STAGE(PG8_SB(1, 0), cB + kstep, voffB); PG8_STAGE(PG8_SA(1, 0), cA + kstep, voffA); PG8_STAGE(PG8_SB(1, 1), cB + hstepB + kstep, voffB);
    PG8_WAIT_V(6); PG8_BAR;
    for (;;) {
        const bool has_next = S.next(ui + 1, nxt);
        const char* nA = has_next ? PG8_ABASE(nxt) : cA; const char* nB = has_next ? PG8_BBASE(nxt) : cB;
        for (int t = 0; t < nt; t += 2) {
            const bool last = (t == nt - 2);
            const char* a1 = cA + (size_t)(t + 1) * kstep;
            const char* a2 = last ? nA : cA + (size_t)(t + 2) * kstep; const char* b2 = last ? nB : cB + (size_t)(t + 2) * kstep;
            const char* a3 = a2 + kstep; const char* b3 = b2 + kstep;
            if (last && has_next) S.a_ready(nxt);
            PG8_LDB(B0, 0, 0); PG8_LDB(B1, 0, 1); PG8_SCHED; PG8_LDA(At, 0, 0); PG8_STAGE(PG8_SA(1, 1), a1 + hstepA, voffA);
            PG8_WAIT_V(8); PG8_WAIT_L(0); PG8_BAR; PG8_MMA(0, 0, At, B0); PG8_MMA(0, 1, At, B1); PG8_BAR; PG8_SCHED;
            PG8_LDA(At, 0, 1); PG8_STAGE(PG8_SB(0, 0), b2, voffB); PG8_STAGE(PG8_SB(0, 1), b2 + hstepB, voffB); PG8_STAGE(PG8_SA(0, 0), a2, voffA);
            PG8_WAIT_V(8); PG8_WAIT_L(0); PG8_BAR; PG8_MMA(1, 0, At, B0); PG8_MMA(1, 1, At, B1); PG8_BAR; PG8_SCHED;
            PG8_LDB(B0, 1, 0); PG8_LDB(B1, 1, 1); PG8_SCHED; PG8_LDA(At, 1, 0); PG8_STAGE(PG8_SA(0, 1), a2 + hstepA, voffA);
            PG8_WAIT_V(8); PG8_WAIT_L(0); PG8_BAR; PG8_MMA(0, 0, At, B0); PG8_MMA(0, 1, At, B1); PG8_BAR; PG8_SCHED;
            PG8_LDA(At, 1, 1); PG8_STAGE(PG8_SB(1, 0), b3, voffB); PG8_STAGE(PG8_SB(1, 1), b3 + hstepB, voffB); PG8_STAGE(PG8_SA(1, 0), a3, voffA);
            PG8_WAIT_V(8); PG8_WAIT_L(0); PG8_BAR; PG8_MMA(1, 0, At, B0); PG8_MMA(1, 1, At, B1); PG8_BAR; PG8_SCHED;
        }
        if constexpr (ALIGN_EPI) { if (wr == 0) PG8_BAR; }
        E(acc, cur, wr, wc, fr, fq); S.done(cur);
        if (!has_next) break;
#pragma unroll
        for (int a = 0; a < 2; ++a)
#pragma unroll
            for (int b = 0; b < 2; ++b)
#pragma unroll
                for (int m = 0; m < 4; ++m)
#pragma unroll
                    for (int n = 0; n < 2; ++n) acc[a][b][m][n] = (f32x4){0.f, 0.f, 0.f, 0.f};
        cur = nxt; cA = nA; cB = nB; ++ui;
        if constexpr (ALIGN_EPI) { if (wr == 1) PG8_BAR; }
    }
    PG8_WAIT_V(0);
    if constexpr (!ALIGN_EPI) { if (wr == 0) PG8_BAR; }
    PG8_BAR;
#undef PG8_SA
#undef PG8_SB
#undef PG8_STAGE
#undef PG8_LDA
#undef PG8_LDB
#undef PG8_MMA
#undef PG8_WAIT_V
#undef PG8_WAIT_L
#undef PG8_BAR
#undef PG8_SCHED
#undef PG8_ABASE
#undef PG8_BBASE
}
}

#define XB_TMO      128
#define XB_XCNT(j)  (256  + 64 * (j))
#define XB_XSUB(j)  (1280 + 64 * (j))
#define XB_XGEN(j)  (2304 + 64 * (j))
#define XB_TOP      3328
#define XB_TOPGEN   3392
#define XCD_BAR_WORDS 3456
#define XB_SPIN_CAP (1u << 18)

__device__ __forceinline__ unsigned xb_ld(unsigned* p)              { return __hip_atomic_load(p, __ATOMIC_RELAXED, __HIP_MEMORY_SCOPE_AGENT); }
__device__ __forceinline__ unsigned xb_add(unsigned* p, unsigned v) { return __hip_atomic_fetch_add(p, v, __ATOMIC_RELAXED, __HIP_MEMORY_SCOPE_AGENT); }
__device__ __forceinline__ unsigned xb_xcc_id() { return (unsigned)__builtin_amdgcn_s_getreg((3 << 11) | 20) & 0xFu; }
#define XB_SPIN(cond, bar) do { unsigned _sp = 0; while (cond) { __builtin_amdgcn_s_sleep(1); \
    if ((++_sp & 255u) == 0u) { if (xb_ld(&(bar)[XB_TMO])) break; if (_sp > XB_SPIN_CAP) { atomicAdd(&(bar)[XB_TMO], 1u); break; } } } } while (0)

struct XcdBarrier { unsigned* bar; unsigned x; volatile LAS unsigned* st; };

__device__ __forceinline__ XcdBarrier xcd_barrier_post(unsigned* bar, volatile LAS unsigned* st) {
    XcdBarrier b; b.bar = bar; b.x = xb_xcc_id(); b.st = st;
    if (threadIdx.x == 0) (void)xb_add(&bar[XB_XCNT(b.x)], 1u);
    return b;
}
__device__ __forceinline__ void xcd_barrier_complete(unsigned* bar, unsigned x, unsigned& nloc, unsigned& nx) {
    const unsigned G = gridDim.x * gridDim.y * gridDim.z;
    unsigned sum, cnt, mine, sp = 0u;
    for (;;) {
        sum = 0u; cnt = 0u; mine = 0u;
#pragma unroll
        for (unsigned j = 0; j < 16; ++j) { const unsigned c = xb_ld(&bar[XB_XCNT(j)]); sum += c; cnt += (c > 0u) ? 1u : 0u; mine = (j == x) ? c : mine; }
        if (sum == G) break;
        __builtin_amdgcn_s_sleep(1);
        if ((++sp & 255u) == 0u) { if (xb_ld(&bar[XB_TMO])) break; if (sp > XB_SPIN_CAP) { atomicAdd(&bar[XB_TMO], 1u); break; } }
    }
    nloc = mine > 0u ? mine : 1u; nx = cnt > 0u ? cnt : 1u;
}
__device__ __forceinline__ void xcd_barrier(const XcdBarrier& b) {
    asm volatile("s_waitcnt vmcnt(0)" ::: "memory");
    __syncthreads();
    if (threadIdx.x == 0) {
        unsigned* bar = b.bar;
        __builtin_amdgcn_s_waitcnt(0);
        unsigned nloc = b.st[0], nx = b.st[1];
        if (nloc == 0u) { xcd_barrier_complete(bar, b.x, nloc, nx); b.st[0] = nloc; b.st[1] = nx; }
        const unsigned old = xb_add(&bar[XB_XSUB(b.x)], 1u);
        const unsigned gen = old / nloc;
        if (old + 1u == (gen + 1u) * nloc) {
            __builtin_amdgcn_fence(__ATOMIC_RELEASE, "agent");
            asm volatile("s_waitcnt vmcnt(0)" ::: "memory");
            const unsigned og = xb_add(&bar[XB_TOP], 1u);
            const unsigned tg = og / nx;
            if (og + 1u == (tg + 1u) * nx) xb_add(&bar[XB_TOPGEN], 1u);
            else XB_SPIN(xb_ld(&bar[XB_TOPGEN]) == tg, bar);
            __builtin_amdgcn_fence(__ATOMIC_ACQUIRE, "agent");
            xb_add(&bar[XB_XGEN(b.x)], 1u);
            asm volatile("s_waitcnt vmcnt(0)" ::: "memory");
        } else {
            XB_SPIN(xb_ld(&bar[XB_XGEN(b.x)]) == gen, bar);
            __builtin_amdgcn_fence(__ATOMIC_ACQUIRE, "agent");
            asm volatile("s_waitcnt vmcnt(0)" ::: "memory");
        }
    }
    __syncthreads();
}

__device__ __forceinline__ void p0_transpose_item(const float* W, int K, int N, bf16* WT, int row_off, LAS float* scr, int item, int lane) {
    const int nblk = N / 32, kb = item / nblk, nb = item % nblk, k0 = 64 * kb, n0 = 32 * nb;
#pragma unroll 8
    for (int i = 0; i < 32; ++i) { const int kk = 2 * i + (lane >> 5); scr[kk * 33 + (lane & 31)] = W[(size_t)(k0 + kk) * N + n0 + (lane & 31)]; }
    LDS_WAIT(); asm volatile("" ::: "memory");
    const int c = lane & 7;
#pragma unroll
    for (int j = 0; j < 4; ++j) { const int n = (lane >> 3) + 8 * j; const LAS float* s = scr + (8 * c) * 33 + n;
        v4u o; o.x = cvt_pk_bf16(s[0 * 33], s[1 * 33]); o.y = cvt_pk_bf16(s[2 * 33], s[3 * 33]); o.z = cvt_pk_bf16(s[4 * 33], s[5 * 33]); o.w = cvt_pk_bf16(s[6 * 33], s[7 * 33]);
        *(GAS v4u*)(WT + (size_t)(row_off + n0 + n) * K + k0 + 8 * c) = o; }
    LDS_WAIT(); asm volatile("" ::: "memory");
}

__device__ __forceinline__ int t5_bucket(int rel) {
    int n = -rel; const int ret = n < 0 ? 16 : 0; n = n < 0 ? -n : n;
    if (n < 8) return ret + n;
    const float v = logf((float)n / 8.0f) / logf(128.0f) * 8.0f;
    int large = 8 + (int)v; large = large < 15 ? large : 15;
    return ret + large;
}
__device__ __forceinline__ float gelu_tanh(float x) {
    const float z = 0.7978845608028654f * (x + 0.044715f * x * x * x);
    const float e = __expf(2.0f * z);
    const float t = 1.0f - 2.0f / (e + 1.0f);
    return 0.5f * x * (1.0f + t);
}
__device__ __forceinline__ unsigned fkey(float v) { const unsigned u = __float_as_uint(v); return (u >> 31) ? ~u : (u | 0x80000000u); }
__device__ __forceinline__ float fdec(unsigned key) { const unsigned k2 = key & ~127u; const unsigned u = (k2 >> 31) ? (k2 & 0x7fffffffu) : (~k2 & ~127u); return __uint_as_float(u); }
template <int LJ> __device__ __forceinline__ unsigned xshfl(unsigned x, const int lane) {
    if constexpr (LJ == 1) return (unsigned)__builtin_amdgcn_update_dpp(0, (int)x, 0xB1, 0xF, 0xF, false);
    else if constexpr (LJ == 2) return (unsigned)__builtin_amdgcn_update_dpp(0, (int)x, 0x4E, 0xF, 0xF, false);
    else if constexpr (LJ == 4) { const int y = __builtin_amdgcn_update_dpp(0, (int)x, 0x141, 0xF, 0xF, false); return (unsigned)__builtin_amdgcn_update_dpp(0, y, 0x1B, 0xF, 0xF, false); }
    else if constexpr (LJ == 8) { const int y = __builtin_amdgcn_update_dpp(0, (int)x, 0x140, 0xF, 0xF, false); return (unsigned)__builtin_amdgcn_update_dpp(0, y, 0x141, 0xF, 0xF, false); }
    else if constexpr (LJ == 16) return (unsigned)__builtin_amdgcn_ds_swizzle((int)x, 0x401F);
    else { const auto rr = __builtin_amdgcn_permlane32_swap(x, x, false, false); return lane < 32 ? rr[1] : rr[0]; }
}
template <int K, int J> __device__ __forceinline__ void bitonic_step(unsigned& a0, unsigned& a1, unsigned& b0, unsigned& b1, const int lane) {
    const bool asc = (K == 128) ? true : ((lane & (K >> 1)) == 0);
    if constexpr (J == 1) {
        const unsigned la = a0 < a1 ? a0 : a1, ha = a0 < a1 ? a1 : a0, lb = b0 < b1 ? b0 : b1, hb = b0 < b1 ? b1 : b0;
        a0 = asc ? la : ha; a1 = asc ? ha : la; b0 = asc ? lb : hb; b1 = asc ? hb : lb;
    } else {
        constexpr int LJ = J >> 1; const bool tmin = (((lane & LJ) == 0) == asc);
        const unsigned pa0 = xshfl<LJ>(a0, lane), pa1 = xshfl<LJ>(a1, lane), pb0 = xshfl<LJ>(b0, lane), pb1 = xshfl<LJ>(b1, lane);
        a0 = tmin ? (a0 < pa0 ? a0 : pa0) : (a0 < pa0 ? pa0 : a0); a1 = tmin ? (a1 < pa1 ? a1 : pa1) : (a1 < pa1 ? pa1 : a1);
        b0 = tmin ? (b0 < pb0 ? b0 : pb0) : (b0 < pb0 ? pb0 : b0); b1 = tmin ? (b1 < pb1 ? b1 : pb1) : (b1 < pb1 ? pb1 : b1);
    }
    if constexpr (J > 1) bitonic_step<K, (J >> 1)>(a0, a1, b0, b1, lane);
}
template <int K> __device__ __forceinline__ void bitonic_stage(unsigned& a0, unsigned& a1, unsigned& b0, unsigned& b1, const int lane) {
    bitonic_step<K, (K >> 1)>(a0, a1, b0, b1, lane);
    if constexpr (K < 128) bitonic_stage<(K << 1)>(a0, a1, b0, b1, lane);
}
__device__ __forceinline__ void bitonic128x2(unsigned& a0, unsigned& a1, unsigned& b0, unsigned& b1, const int lane) { bitonic_stage<2>(a0, a1, b0, b1, lane); }
__device__ __forceinline__ float dot2bf(unsigned a, unsigned b, float c) { return __builtin_amdgcn_fdot2_f32_bf16(__builtin_bit_cast(bf2_t, a), __builtin_bit_cast(bf2_t, b), c, false); }

constexpr int ATT_SLOT = 8704;
__device__ __forceinline__ int crow(int r, int hi) { return (r & 3) + 8 * (r >> 2) + 4 * hi; }

__device__ __forceinline__ void attn_task(const int G, const bf16* PROJ, bf16* O0, bf16* O1, float* LSE0, float* LSE1, bf16* MIXIN,
                                          const LAS float* btab, LAS unsigned char* wl, int b, int h, int mtile, int tk, int lane) {
    const int SH = 2 * G;
    const int L = SEQ >> SH, TPR = 32 >> SH;
    const int r32 = lane & 31, hi = lane >> 5;
    const int res = tk >> (5 - SH), l0 = ((mtile * 1024) >> SH) + 32 * (tk & (TPR - 1));
    const size_t rowbase = (size_t)b * SEQ;
    const int srow = lane >> 4, sch = lane & 15;
#define ATT_WAITV(n) asm volatile("s_waitcnt vmcnt(" #n ")" ::: "memory")
#define ATT_ISSUE(n) do { LAS unsigned char* sl_ = wl + ((n) & 1) * ATT_SLOT; const int jt_ = (n) < 5 ? (n) : (n) - 5; \
        _Pragma("unroll") for (int i_ = 0; i_ < 8; ++i_) { \
            const int key_ = (n) < 5 ? (4 * i_ + srow) : ((i_ & 3) + 4 * srow + 16 * (i_ >> 2)); \
            int lk_ = l0 - 64 + 32 * jt_ + key_; lk_ = lk_ < 0 ? 0 : (lk_ > L - 1 ? L - 1 : lk_); \
            const int ch_ = (n) < 5 ? (sch ^ (key_ & 7)) : sch; \
            const bf16* src_ = PROJ + (rowbase + ((size_t)lk_ << SH) + res) * INW + ((n) < 5 ? ATTW : 2 * ATTW) + h * HD + ch_ * 8; \
            __builtin_amdgcn_global_load_lds((const unsigned*)src_, (LAS unsigned*)(sl_ + i_ * ((n) < 5 ? 1024 : 1088)), 16, 0, 0); } } while (0)
    const size_t qrow = rowbase + ((size_t)(l0 + r32) << SH) + res;
    bf16x8 qr[8];
    { const bf16* qp = PROJ + qrow * INW + h * HD + hi * 8;
#pragma unroll
      for (int d0 = 0; d0 < 8; ++d0) qr[d0] = *(const bf16x8*)(qp + d0 * 16); }
    ATT_ISSUE(0); ATT_ISSUE(1);
    f32x16 p[5];
#define ATT_KTILE(n) do { LAS unsigned char* sl_ = wl + ((n) & 1) * ATT_SLOT + r32 * 256; f32x16 s_ = {}; \
        _Pragma("unroll") for (int d0 = 0; d0 < 8; ++d0) { const bf16x8 a_ = *(const LAS bf16x8*)(sl_ + (((2 * d0 + hi) ^ (r32 & 7)) << 4)); s_ = __builtin_amdgcn_mfma_f32_32x32x16_bf16(a_, qr[d0], s_, 0, 0, 0); } \
        p[n] = s_; asm volatile("" ::: "memory"); } while (0)
    ATT_WAITV(8); ATT_KTILE(0); ATT_ISSUE(2);
    ATT_WAITV(8); ATT_KTILE(1); ATT_ISSUE(3);
    ATT_WAITV(8); ATT_KTILE(2); ATT_ISSUE(4);
    ATT_WAITV(8); ATT_KTILE(3); ATT_ISSUE(5);
    ATT_WAITV(8); ATT_KTILE(4); ATT_ISSUE(6);
    float mx = -1e30f;
    const bool edge = (l0 - 64 < 0) || (l0 + 96 > L);
    const LAS float* bt = btab + G * 256 + 32 + 4 * hi - r32;
#pragma unroll
    for (int j = 0; j < 5; ++j) {
#pragma unroll
        for (int r = 0; r < 16; ++r) {
            const int kc = 32 * j + (r & 3) + 8 * (r >> 2);
            float v = p[j][r] + bt[kc];
            if (edge) { const int lk = l0 - 64 + kc + 4 * hi; v = (lk >= 0 && lk < L) ? v : -1e30f; }
            p[j][r] = v; mx = fmaxf(mx, v);
        }
        asm volatile("" ::: "memory");
    }
    mx = fmaxf(mx, __shfl_xor(mx, 32));
    float ls = 0.f;
    bf16x8 pb[5][2];
#pragma unroll
    for (int j = 0; j < 5; ++j) {
        float e[16];
#pragma unroll
        for (int r = 0; r < 16; ++r) { e[r] = __builtin_amdgcn_exp2f(p[j][r] - mx); ls += e[r]; }
#pragma unroll
        for (int s = 0; s < 2; ++s) { v4u w; w.x = cvt_pk_bf16(e[8 * s + 0], e[8 * s + 1]); w.y = cvt_pk_bf16(e[8 * s + 2], e[8 * s + 3]);
            w.z = cvt_pk_bf16(e[8 * s + 4], e[8 * s + 5]); w.w = cvt_pk_bf16(e[8 * s + 6], e[8 * s + 7]); pb[j][s] = __builtin_bit_cast(bf16x8, w); }
    }
    ls += __shfl_xor(ls, 32);
    asm volatile("" ::: "memory");
    f32x16 o[4] = {};
    const int i16 = lane & 15, g16 = lane >> 4;
    const unsigned vbase = (unsigned)(uintptr_t)wl + (unsigned)((i16 >> 2) * 1088 + hi * 256 + (16 * (g16 & 1) + 4 * (i16 & 3)) * 2);
#define ATT_VTILE(n) do { const unsigned va_ = vbase + ((n) & 1) * ATT_SLOT; \
        _Pragma("unroll") for (int dt = 0; dt < 4; ++dt) { s16x4 lo0, hi0, lo1, hi1; \
            asm volatile("ds_read_b64_tr_b16 %0, %4 offset:%5\n\tds_read_b64_tr_b16 %1, %4 offset:%6\n\tds_read_b64_tr_b16 %2, %4 offset:%7\n\tds_read_b64_tr_b16 %3, %4 offset:%8\n\ts_waitcnt lgkmcnt(0)" \
                         : "=&v"(lo0), "=&v"(hi0), "=&v"(lo1), "=&v"(hi1) : "v"(va_), "i"(dt * 64), "i"(512 + dt * 64), "i"(4 * 1088 + dt * 64), "i"(4 * 1088 + 512 + dt * 64) : "memory"); \
            const bf16x8 af0 = (bf16x8){lo0[0], lo0[1], lo0[2], lo0[3], hi0[0], hi0[1], hi0[2], hi0[3]}; \
            const bf16x8 af1 = (bf16x8){lo1[0], lo1[1], lo1[2], lo1[3], hi1[0], hi1[1], hi1[2], hi1[3]}; \
            o[dt] = __builtin_amdgcn_mfma_f32_32x32x16_bf16(af0, pb[(n) - 5][0], o[dt], 0, 0, 0); \
            o[dt] = __builtin_amdgcn_mfma_f32_32x32x16_bf16(af1, pb[(n) - 5][1], o[dt], 0, 0, 0); } } while (0)
    ATT_WAITV(8); ATT_VTILE(5); ATT_ISSUE(7);
    ATT_WAITV(8); ATT_VTILE(6); ATT_ISSUE(8);
    ATT_WAITV(8); ATT_VTILE(7); ATT_ISSUE(9);
    ATT_WAITV(8); ATT_VTILE(8);
    ATT_WAITV(0); ATT_VTILE(9);
#undef ATT_WAITV
#undef ATT_ISSUE
#undef ATT_KTILE
#undef ATT_VTILE
    const float inv = 1.0f / ls;
    const float lse2 = mx + __builtin_amdgcn_logf(ls);
    const size_t orow = qrow;
    if (G < 2) {
        bf16* op = (G == 0 ? O0 : O1) + orow * ATTW + h * HD + 4 * hi;
#pragma unroll
        for (int dt = 0; dt < 4; ++dt)
#pragma unroll
            for (int rg = 0; rg < 4; ++rg) { v2u w; w.x = cvt_pk_bf16(o[dt][4 * rg] * inv, o[dt][4 * rg + 1] * inv); w.y = cvt_pk_bf16(o[dt][4 * rg + 2] * inv, o[dt][4 * rg + 3] * inv);
                *(v2u*)(op + 32 * dt + 8 * rg) = w; }
        if (hi == 0) (G == 0 ? LSE0 : LSE1)[orow * NH + h] = lse2;
    } else {
        const float l0v = LSE0[orow * NH + h], l1v = LSE1[orow * NH + h];
        const float mm = fmaxf(fmaxf(l0v, l1v), lse2);
        const float w0 = __builtin_amdgcn_exp2f(l0v - mm), w1 = __builtin_amdgcn_exp2f(l1v - mm), w2 = __builtin_amdgcn_exp2f(lse2 - mm);
        const float wi = 1.0f / (w0 + w1 + w2);
        const float c0 = w0 * wi, c1 = w1 * wi, c2 = w2 * wi * inv;
        const bf16* p0 = O0 + orow * ATTW + h * HD + 4 * hi; const bf16* p1 = O1 + orow * ATTW + h * HD + 4 * hi;
        bf16* op = MIXIN + orow * DM + h * HD + 4 * hi;
#pragma unroll
        for (int dt = 0; dt < 4; ++dt) {
            v2u a[4], c[4];
#pragma unroll
            for (int rg = 0; rg < 4; ++rg) { a[rg] = *(const v2u*)(p0 + 32 * dt + 8 * rg); c[rg] = *(const v2u*)(p1 + 32 * dt + 8 * rg); }
#pragma unroll
            for (int rg = 0; rg < 4; ++rg) {
                const float y0 = c0 * bf_lo(a[rg].x) + c1 * bf_lo(c[rg].x) + c2 * o[dt][4 * rg], y1 = c0 * bf_hi(a[rg].x) + c1 * bf_hi(c[rg].x) + c2 * o[dt][4 * rg + 1];
                const float y2 = c0 * bf_lo(a[rg].y) + c1 * bf_lo(c[rg].y) + c2 * o[dt][4 * rg + 2], y3 = c0 * bf_hi(a[rg].y) + c1 * bf_hi(c[rg].y) + c2 * o[dt][4 * rg + 3];
                v2u w; w.x = cvt_pk_bf16(y0, y1); w.y = cvt_pk_bf16(y2, y3); *(v2u*)(op + 32 * dt + 8 * rg) = w; }
        }
    }
}

constexpr int PER_PHASE = 11;
struct Args { const float* in[16]; float* out; unsigned char* ws; unsigned mask; unsigned pad; };

__constant__ unsigned char CAND_I[64] = {0,0,0,0,0,0,0,0,0,0,0,0,0,0,0,0, 1,1,1,1,1,1,1,1, 2,2,2,2,2, 3,3,3,3, 4,4,4, 5,5, 6,6, 7,7, 8,9,10,11,12,13,14,15, 0,0,0,0,0,0,0,0,0,0,0,0,0,0};
__constant__ unsigned char CAND_J[64] = {0,1,2,3,4,5,6,7,8,9,10,11,12,13,14,15, 0,1,2,3,4,5,6,7, 0,1,2,3,4, 0,1,2,3, 0,1,2, 0,1, 0,1, 0,1, 0,0,0,0,0,0,0,0, 0,0,0,0,0,0,0,0,0,0,0,0,0,0};

__global__ void __launch_bounds__(NWAVES * 64, 2) fwd_kernel(Args args) {
    extern __shared__ __attribute__((aligned(16))) unsigned char lds_raw[];
    LAS unsigned char* lds = (LAS unsigned char*)lds_raw;
    volatile LAS unsigned* MISC = (volatile LAS unsigned*)(lds + MISC_OFF);
    const int tid = threadIdx.x, lane = tid & 63, wave = __builtin_amdgcn_readfirstlane(tid >> 6);
    const int G = gridDim.x; const int bx = blockIdx.x;
    const int vcu = (G % 8 == 0) ? (bx % 8) * (G / 8) + bx / 8 : bx;
    const int gw = vcu * NWAVES + wave, NGW = G * NWAVES;
    unsigned char* ws = args.ws;
    unsigned* ctl = (unsigned*)(ws + WS_CTL);
    const float* x = args.in[0]; const float* cvec = args.in[1]; const float* w_ada = args.in[2]; const float* b_ada = args.in[3]; const float* g_mix = args.in[4];
    const float* w_in = args.in[5]; const float* rel_bias = args.in[6]; const float* pool_w = args.in[7]; const float* pool_scale = args.in[8]; const float* w_out = args.in[9];
    const float* g_ffn = args.in[10]; const float* peer_wq = args.in[11]; const float* peer_sk = args.in[12]; const float* peer_u = args.in[13]; const float* peer_v = args.in[14];
    const float* g_final = args.in[15];
    float* out = args.out;
    float* MODV = (float*)(ws + WS_MODV); float* MODP = (float*)(ws + WS_MODP);
    bf16* SKT = (bf16*)(ws + WS_SKT); bf16* POOLWT = (bf16*)(ws + WS_POOLWT); bf16* WQT = (bf16*)(ws + WS_WQT); bf16* WOUTT = (bf16*)(ws + WS_WOUTT); bf16* WINT = (bf16*)(ws + WS_WINT);
    unsigned char* UB = ws + WS_UB; unsigned char* VB = ws + WS_VB; float* SCL = (float*)(ws + WS_SCL); bf16* H = (bf16*)(ws + WS_H); bf16* PROJ = (bf16*)(ws + WS_PROJ); bf16* MIXIN = (bf16*)(ws + WS_MIXIN);
    bf16* POOLIN = (bf16*)(ws + WS_POOLIN); bf16* O0 = (bf16*)(ws + WS_O0); bf16* O1 = (bf16*)(ws + WS_O1); float* LSE = (float*)(ws + WS_LSE);
    bf16* QP = (bf16*)(ws + WS_QP); float* SC = (float*)(ws + WS_SC);

    for (int u = tid; u < (LDS_BYTES - LDSCTL_OFF) / 4; u += NWAVES * 64) ((LAS unsigned*)(lds + LDSCTL_OFF))[u] = 0u;
    __syncthreads();
    XcdBarrier bar; bar.bar = ctl + CW_BAR; bar.x = 0; bar.st = nullptr;
    if (MK_N_LAUNCHES != PER_PHASE) bar = xcd_barrier_post(ctl + CW_BAR, MISC + 8);
#define GRID_BAR() do { if (MK_N_LAUNCHES != PER_PHASE) xcd_barrier(bar); } while (0)
    const unsigned phmask = args.mask;
#ifndef PH_MASK
#define PH_MASK 0x7ff
#endif
#define IN(k) ((((PH_MASK) >> (k)) & 1) && ((phmask >> (k)) & 1u))
#define BOTH(k) (IN(k) && IN((k) + 1))

    if (IN(0)) {
        LAS float* silu = (LAS float*)(lds + RING_OFF);
        for (int i = tid; i < BATCH * DM; i += NWAVES * 64) { const float v = cvec[i]; silu[i] = v / (1.0f + __expf(-v)); }
        __syncthreads();
        for (int task = gw; task < (NMOD / 256) * KS_ADA; task += NGW) {
            const int cg = task % (NMOD / 256), ks = task / (NMOD / 256); const int k0 = ks * (DM / KS_ADA), n0 = cg * 256 + 4 * lane;
            f32x4 a0 = {0.f, 0.f, 0.f, 0.f}, a1 = {0.f, 0.f, 0.f, 0.f};
            const float* wp = w_ada + (size_t)k0 * NMOD + n0;
#pragma unroll 8
            for (int kk = 0; kk < DM / KS_ADA; ++kk) { const f32x4 w4 = *(const f32x4*)(wp + (size_t)kk * NMOD); const float s0 = silu[k0 + kk], s1 = silu[DM + k0 + kk]; a0 += w4 * s0; a1 += w4 * s1; }
            *(f32x4*)(MODP + ((size_t)(ks * 2 + 0)) * NMOD + n0) = a0; *(f32x4*)(MODP + ((size_t)(ks * 2 + 1)) * NMOD + n0) = a1;
        }
        __syncthreads();
        {
            LAS float* scr = (LAS float*)(lds + RING_OFF + wave * 16384);
            constexpr int I_IN = (DM / 64) * (INW / 32), I_OUT = (DM / 64) * (DM / 32), I_Q = (DM / 64) * (PQ / 32), I_PG = (512 / 64) * (512 / 32);
            constexpr int NITEMS = I_IN + I_OUT + I_Q + 4 * I_PG;
            for (int it = gw; it < NITEMS; it += NGW) {
                int r = it;
                if (r < I_IN) { p0_transpose_item(w_in, DM, INW, WINT, 0, scr, r, lane); continue; } r -= I_IN;
                if (r < I_OUT) { p0_transpose_item(w_out, DM, DM, WOUTT, 0, scr, r, lane); continue; } r -= I_OUT;
                if (r < I_Q) { p0_transpose_item(peer_wq, DM, PQ, WQT, 0, scr, r, lane); continue; } r -= I_Q;
                const int gi = r / I_PG; p0_transpose_item(pool_w + (size_t)gi * 512 * 512, 512, 512, POOLWT, gi * 512, scr, r % I_PG, lane);
            }
        }
        for (int r = gw; r < 2 * NEXP; r += NGW) {
            const bool isU = r < NEXP; const int e = isU ? r : r - NEXP;
            const float* src = (isU ? peer_u : peer_v) + (size_t)e * DM + 16 * lane;
            f32x4 v[4][4]; float mx = 0.f;
#pragma unroll
            for (int i = 0; i < 4; ++i)
#pragma unroll
                for (int q = 0; q < 4; ++q) { v[i][q] = *(const f32x4*)(src + 1024 * i + 4 * q);
                    mx = fmaxf(mx, fmaxf(fmaxf(fabsf(v[i][q][0]), fabsf(v[i][q][1])), fmaxf(fabsf(v[i][q][2]), fabsf(v[i][q][3])))); }
#pragma unroll
            for (int o = 1; o < 64; o <<= 1) mx = fmaxf(mx, __shfl_xor(mx, o));
            const int ex = (int)((__float_as_uint(mx) >> 23) & 0xffu);
            float scale = 1.0f, inv = 1.0f;
            if (ex >= 32 && ex <= 230) { scale = __uint_as_float((unsigned)(261 - ex) << 23); inv = __uint_as_float((unsigned)(ex - 7) << 23); }
            unsigned char* dst = (isU ? UB : VB) + ((size_t)(lane >> 3) * NEXP + e) * 128 + 16 * (lane & 7);
#pragma unroll
            for (int i = 0; i < 4; ++i) { v4u w;
#pragma unroll
                for (int q = 0; q < 4; ++q) { int pk = 0; pk = __builtin_amdgcn_cvt_pk_fp8_f32(v[i][q][0] * scale, v[i][q][1] * scale, pk, false);
                    pk = __builtin_amdgcn_cvt_pk_fp8_f32(v[i][q][2] * scale, v[i][q][3] * scale, pk, true); w[q] = (unsigned)pk; }
                *(v4u*)(dst + (size_t)(8 * i) * NEXP * 128) = w; }
            if (lane == 0) SCL[r] = inv;
        }
        for (int i = gw * 64 + lane; i < 2048 * 32; i += NGW * 64) {
            const int n = i >> 5, kc = (i & 31) * 8; const int p = (n >> 7) & 1, pp = kc >> 7;
            v4u w = {0u, 0u, 0u, 0u};
            if (p == pp) { const float* src = peer_sk + (size_t)n * 128 + (kc & 127); const f32x4 a = *(const f32x4*)src, c = *(const f32x4*)(src + 4);
                w.x = cvt_pk_bf16(a[0], a[1]); w.y = cvt_pk_bf16(a[2], a[3]); w.z = cvt_pk_bf16(c[0], c[1]); w.w = cvt_pk_bf16(c[2], c[3]); }
            *(v4u*)(SKT + (size_t)n * 256 + kc) = w;
        }
        if (BOTH(0)) GRID_BAR();
    }

    if (IN(1)) {
        for (int i = bx * (NWAVES * 64) + tid; i < BATCH * NMOD; i += G * NWAVES * 64) {
            const int b = i / NMOD, n = i % NMOD; float s = b_ada[n];
#pragma unroll 8
            for (int ks = 0; ks < KS_ADA; ++ks) s += MODP[(size_t)(ks * 2 + b) * NMOD + n];
            const int j = n / DM, c = n % DM;
            MODV[(size_t)(j * 2 + b) * DM + c] = s;
        }
        if (BOTH(1)) GRID_BAR();
    }

    if (IN(2)) {
        for (int row = gw; row < M; row += NGW) {
            const int b = row / SEQ;
            const f32x4* xr = (const f32x4*)(x + (size_t)row * DM) + lane;
            f32x4 v[16]; float ss = 0.f;
#pragma unroll
            for (int j = 0; j < 16; ++j) { v[j] = xr[64 * j]; ss += (v[j][0] * v[j][0] + v[j][1] * v[j][1]) + (v[j][2] * v[j][2] + v[j][3] * v[j][3]); }
            const float rstd = 1.0f / sqrtf(wave_sum(ss) * (1.0f / DM) + RMS_EPS);
            const f32x4* gp = (const f32x4*)g_mix + lane; const f32x4* shp = (const f32x4*)(MODV + (size_t)(0 * 2 + b) * DM) + lane; const f32x4* scp = (const f32x4*)(MODV + (size_t)(1 * 2 + b) * DM) + lane;
            v2u* op = (v2u*)(H + (size_t)row * DM) + lane;
#pragma unroll
            for (int j = 0; j < 16; ++j) { const f32x4 g4 = gp[64 * j], sh = shp[64 * j], sc = scp[64 * j];
                const f32x4 y = (v[j] * rstd) * g4 * (sc + 1.0f) + sh;
                v2u w; w.x = cvt_pk_bf16(y[0], y[1]); w.y = cvt_pk_bf16(y[2], y[3]); op[64 * j] = w; }
        }
        if (BOTH(2)) GRID_BAR();
    }

    if (IN(3)) {
        pg8::Gemm g{H, WINT, M, INW, DM, DM, DM, 1 << 30, 0}; pg8::StaticOrder S; S.init(M, INW, G, bx);
        pg8::EpiBf16 E{PROJ, INW, ATTW, QSCALE};
        pg8::gemm_phase<pg8::EpiBf16, pg8::StaticOrder, true>(lds + RING_OFF, g, S, E);
        if (BOTH(3)) GRID_BAR();
    }

    if (IN(4)) {
        LAS float* btab = (LAS float*)(lds + SHARED_OFF);
        LAS unsigned char* vt = lds + RING_OFF + wave * ATT_WAVE_BYTES;
        if (!(args.pad & 1u))
        for (int unit = bx; unit < BATCH * NH * (SEQ / 1024); unit += G) {
            const int b = unit >> 7, h = (unit >> 3) & 15, mt = unit & 7;
            __syncthreads();
            for (int i = tid; i < 3 * 256; i += NWAVES * 64) { const int gi = i >> 8, ri = (i & 255) - 32; const int dil = gi == 0 ? 1 : (gi == 1 ? 4 : 16);
                btab[i] = (ri >= 0 && ri <= 128) ? rel_bias[t5_bucket((ri - 64) * dil) * NH + h] * LOG2E : -1e30f; }
            __syncthreads();
            for (int g = 0; g < 3; ++g) {
                if (g == 2) { VM_WAIT(); __syncthreads(); }
                for (int tk = wave; tk < 32; tk += NWAVES) attn_task(g, PROJ, O0, O1, LSE, LSE + (size_t)M * NH, MIXIN, btab, vt, b, h, mt, tk, lane);
            }
        }
        if (!(args.pad & 2u))
        for (int i = bx * (NWAVES * 64) + tid; i < BATCH * (SEQ / 8) * (POOLW / 8); i += G * NWAVES * 64) {
            const int cc = i & 255, run = (i >> 8) & (SEQ / 8 - 1), b = i >> 18; const int gi = __builtin_amdgcn_readfirstlane(cc >> 6);
            const int pos0 = run * 8;
            const bf16* base = PROJ + (size_t)b * SEQ * INW + 3 * ATTW + cc * 8;
            bf16* obase = POOLIN + ((size_t)b * SEQ + pos0) * POOLW + cc * 8;
#define POOL_RUN(HW) do { constexpr int NR = 8 + 2 * (HW) - 1; v4u w_[NR]; \
                _Pragma("unroll") for (int q = 0; q < NR; ++q) { const int pp = pos0 - (HW) + q; const int pc = pp < 0 ? 0 : (pp > SEQ - 1 ? SEQ - 1 : pp); w_[q] = *(const v4u*)(base + (size_t)pc * INW); } \
                _Pragma("unroll") for (int q = 0; q < NR; ++q) { const int pp = pos0 - (HW) + q; if (pp < 0 || pp >= SEQ) w_[q] = (v4u){0u, 0u, 0u, 0u}; } \
                float s_[8] = {0.f, 0.f, 0.f, 0.f, 0.f, 0.f, 0.f, 0.f}; \
                _Pragma("unroll") for (int q = 0; q < 2 * (HW) - 1; ++q) { s_[0] += bf_lo(w_[q].x); s_[1] += bf_hi(w_[q].x); s_[2] += bf_lo(w_[q].y); s_[3] += bf_hi(w_[q].y); s_[4] += bf_lo(w_[q].z); s_[5] += bf_hi(w_[q].z); s_[6] += bf_lo(w_[q].w); s_[7] += bf_hi(w_[q].w); } \
                _Pragma("unroll") for (int k = 0; k < 8; ++k) { const v4u in_ = w_[k + 2 * (HW) - 1]; \
                    s_[0] += bf_lo(in_.x); s_[1] += bf_hi(in_.x); s_[2] += bf_lo(in_.y); s_[3] += bf_hi(in_.y); s_[4] += bf_lo(in_.z); s_[5] += bf_hi(in_.z); s_[6] += bf_lo(in_.w); s_[7] += bf_hi(in_.w); \
                    const int pos = pos0 + k; const int lo_ = pos - (HW) < 0 ? 0 : pos - (HW), hi_ = pos + (HW) > SEQ ? SEQ : pos + (HW); const float inv = 1.0f / (float)(hi_ - lo_); \
                    const v4u me = w_[k + (HW)]; v4u o_; \
                    o_.x = cvt_pk_bf16(s_[0] * inv - bf_lo(me.x), s_[1] * inv - bf_hi(me.x)); o_.y = cvt_pk_bf16(s_[2] * inv - bf_lo(me.y), s_[3] * inv - bf_hi(me.y)); \
                    o_.z = cvt_pk_bf16(s_[4] * inv - bf_lo(me.z), s_[5] * inv - bf_hi(me.z)); o_.w = cvt_pk_bf16(s_[6] * inv - bf_lo(me.w), s_[7] * inv - bf_hi(me.w)); \
                    *(v4u*)(obase + (size_t)k * POOLW) = o_; \
                    const v4u out_ = w_[k]; \
                    s_[0] -= bf_lo(out_.x); s_[1] -= bf_hi(out_.x); s_[2] -= bf_lo(out_.y); s_[3] -= bf_hi(out_.y); s_[4] -= bf_lo(out_.z); s_[5] -= bf_hi(out_.z); s_[6] -= bf_lo(out_.w); s_[7] -= bf_hi(out_.w); } } while (0)
            if (gi == 0) POOL_RUN(1); else if (gi == 1) POOL_RUN(2); else if (gi == 2) POOL_RUN(4); else POOL_RUN(8);
#undef POOL_RUN
        }
        if (BOTH(4)) GRID_BAR();
    }

    if (IN(5)) {
        pg8::Gemm g{POOLIN, POOLWT, M, POOLW, 512, POOLW, 512, 2, 512}; pg8::StaticOrder S; S.init(M, POOLW, G, bx);
        pg8::EpiBf16ColScale E{MIXIN, DM, ATTW, pool_scale};
        pg8::gemm_phase<pg8::EpiBf16ColScale, pg8::StaticOrder, true>(lds + RING_OFF, g, S, E);
        if (BOTH(5)) GRID_BAR();
    }

    if (IN(6)) {
        pg8::Gemm g{MIXIN, WOUTT, M, DM, DM, DM, DM, 1 << 30, 0}; pg8::StaticOrder S; S.init(M, DM, G, bx);
        pg8::EpiResF32 E{x, MODV + (size_t)(2 * 2) * DM, out, DM};
        pg8::gemm_phase<pg8::EpiResF32, pg8::StaticOrder, true>(lds + RING_OFF, g, S, E);
        if (BOTH(6)) GRID_BAR();
    }

    if (IN(7)) {
        for (int row = gw; row < M; row += NGW) {
            const int b = row / SEQ;
            const f32x4* xr = (const f32x4*)(out + (size_t)row * DM) + lane;
            f32x4 v[16]; float ss = 0.f;
#pragma unroll
            for (int j = 0; j < 16; ++j) { v[j] = xr[64 * j]; ss += (v[j][0] * v[j][0] + v[j][1] * v[j][1]) + (v[j][2] * v[j][2] + v[j][3] * v[j][3]); }
            const float rstd = 1.0f / sqrtf(wave_sum(ss) * (1.0f / DM) + RMS_EPS);
            const f32x4* gp = (const f32x4*)g_ffn + lane; const f32x4* shp = (const f32x4*)(MODV + (size_t)(3 * 2 + b) * DM) + lane; const f32x4* scp = (const f32x4*)(MODV + (size_t)(4 * 2 + b) * DM) + lane;
            v2u* op = (v2u*)(H + (size_t)row * DM) + lane;
#pragma unroll
            for (int j = 0; j < 16; ++j) { const f32x4 g4 = gp[64 * j], sh = shp[64 * j], sc = scp[64 * j];
                const f32x4 y = (v[j] * rstd) * g4 * (sc + 1.0f) + sh;
                v2u w; w.x = cvt_pk_bf16(y[0], y[1]); w.y = cvt_pk_bf16(y[2], y[3]); op[64 * j] = w; }
        }
        if (BOTH(7)) GRID_BAR();
    }

    if (IN(8)) {
        pg8::Gemm g{H, WQT, M, PQ, DM, DM, DM, 1 << 30, 0}; pg8::StaticOrder S; S.init(M, PQ, G, bx);
        pg8::EpiBf16 E{QP, PQ, 0, 1.0f};
        pg8::gemm_phase<pg8::EpiBf16, pg8::StaticOrder, true>(lds + RING_OFF, g, S, E);
        if (BOTH(8)) GRID_BAR();
    }

    if (IN(9)) {
        pg8::Gemm g{QP, SKT, M, PQ, 256, PQ, 256, 1, 256}; pg8::StaticOrder S; S.init(M, PQ, G, bx);
        pg8::EpiF32 E{SC, PQ};
        pg8::gemm_phase<pg8::EpiF32, pg8::StaticOrder, true>(lds + RING_OFF, g, S, E);
        if (BOTH(9)) GRID_BAR();
    }

    if (IN(10)) {
        LAS unsigned short* EXPW = (LAS unsigned short*)(lds + RING_OFF);
        LAS float* GACT = (LAS float*)(lds + RING_OFF + 16384);
        LAS unsigned* W = (LAS unsigned*)(lds + RING_OFF + 49152 + wave * 4096);
        LAS unsigned* K1 = W; LAS unsigned* K2 = W + 128;
        LAS float* TV1 = (LAS float*)(W + 256); LAS int* TI1 = (LAS int*)(W + 272); LAS float* TV2 = (LAS float*)(W + 288); LAS int* TI2 = (LAS int*)(W + 304);
        LAS unsigned* CK = W + 320; LAS float* SV = (LAS float*)(W + 384); LAS int* SE = (LAS int*)(W + 400);
        const int c8 = lane & 7, r8 = lane >> 3;
        for (int blk = vcu; blk < M / 64; blk += G) {
            const int tok0 = blk * 64; const int b = tok0 / SEQ;
            for (int j = 0; j < 8; ++j) {
                const int tl = wave * 8 + j; const int t = tok0 + tl;
#ifndef TOPK_REP
#define TOPK_REP 1
#endif
                for (int hh = 0; hh < 8 * TOPK_REP; ++hh) { const int h = hh & 7;
                    const float* sp = SC + (size_t)t * PQ + h * 256;
                    const float a0 = sp[lane], a1 = sp[64 + lane], b0 = sp[128 + lane], b1 = sp[192 + lane];
                    unsigned ka0 = (fkey(a0) & ~127u) | (unsigned)(127 - lane), ka1 = (fkey(a1) & ~127u) | (unsigned)(63 - lane);
                    unsigned kb0 = (fkey(b0) & ~127u) | (unsigned)(127 - lane), kb1 = (fkey(b1) & ~127u) | (unsigned)(63 - lane);
                    bitonic128x2(ka0, ka1, kb0, kb1, lane);
                    if (lane >= 56) { K1[127 - 2 * lane] = ka0; K1[126 - 2 * lane] = ka1; K2[127 - 2 * lane] = kb0; K2[126 - 2 * lane] = kb1; }
                    LDS_WAIT();
                    const int ci_i = CAND_I[lane], ci_j = CAND_J[lane];
                    const unsigned kA = K1[ci_i], kB = K2[ci_j];
                    const float cv = fdec(kA) + fdec(kB);
                    const unsigned ck = lane < 50 ? ((fkey(cv) & ~255u) | (unsigned)(255 - (ci_i * 16 + ci_j))) : 0u;
                    CK[lane] = ck;
                    LDS_WAIT();
                    int rc = 0;
#pragma unroll 8
                    for (int kk = 0; kk < 16; ++kk) { const v4u q = ((const LAS v4u*)CK)[kk]; rc += (q.x > ck) + (q.y > ck) + (q.z > ck) + (q.w > ck); }
                    if (lane < 50 && rc < 16) { SV[rc] = cv; SE[rc] = (int)((127u - (kA & 127u)) * 128u + (127u - (kB & 127u))); }
                    LDS_WAIT();
                    const float top0 = SV[0], myv = SV[lane & 15]; const int mye = SE[lane & 15];
                    const float e = __expf(myv - top0);
                    float ssum = e; ssum += __shfl_xor(ssum, 1); ssum += __shfl_xor(ssum, 2); ssum += __shfl_xor(ssum, 4); ssum += __shfl_xor(ssum, 8);
                    if (lane < 16) { EXPW[tl * 128 + h * 16 + lane] = (unsigned short)mye; GACT[tl * 128 + h * 16 + lane] = e / ssum; }
                    LDS_WAIT();
                }
            }
            LAS float* ACC = (LAS float*)(lds + RING_OFF + 81920);
            for (int i = lane; i < 8 * 128; i += 64) ACC[wave * 1024 + i] = 0.f;
            LDS_WAIT();
            {
                v4u gn[16]; v4u hna, hnb;
#define P10_LOADU(idx) do { const int s_ = (idx) >> 3, j_ = (idx) & 7; const int tl_ = wave * 8 + j_; \
                    const unsigned char* tb_ = UB + (size_t)s_ * NEXP * 128 + 16 * c8; \
                    const v4u* hp_ = (const v4u*)(H + (size_t)(tok0 + tl_) * DM + 128 * s_ + 16 * c8); hna = hp_[0]; hnb = hp_[1]; \
                    _Pragma("unroll") for (int i = 0; i < 16; ++i) { const unsigned e_ = EXPW[tl_ * 128 + r8 + 8 * i]; gn[i] = *(const v4u*)(tb_ + (size_t)e_ * 128); } } while (0)
                P10_LOADU(0);
#pragma unroll 1
                for (int idx = 0; idx < 256; ++idx) {
                    v4u g[16]; const v4u ha = hna, hb = hnb;
#pragma unroll
                    for (int i = 0; i < 16; ++i) g[i] = gn[i];
                    if (idx + 1 < 256) P10_LOADU(idx + 1);
                    const int tl = wave * 8 + (idx & 7);
                    f32x2 hs[8];
                    hs[0] = (f32x2){bf_lo(ha.x), bf_hi(ha.x)}; hs[1] = (f32x2){bf_lo(ha.y), bf_hi(ha.y)}; hs[2] = (f32x2){bf_lo(ha.z), bf_hi(ha.z)}; hs[3] = (f32x2){bf_lo(ha.w), bf_hi(ha.w)};
                    hs[4] = (f32x2){bf_lo(hb.x), bf_hi(hb.x)}; hs[5] = (f32x2){bf_lo(hb.y), bf_hi(hb.y)}; hs[6] = (f32x2){bf_lo(hb.z), bf_hi(hb.z)}; hs[7] = (f32x2){bf_lo(hb.w), bf_hi(hb.w)};
                    float p[16];
#pragma unroll
                    for (int i = 0; i < 16; ++i) { f32x2 a2 = {0.f, 0.f};
#pragma unroll
                        for (int q = 0; q < 4; ++q) { a2 += __builtin_amdgcn_cvt_pk_f32_fp8((int)g[i][q], false) * hs[2 * q]; a2 += __builtin_amdgcn_cvt_pk_f32_fp8((int)g[i][q], true) * hs[2 * q + 1]; }
                        p[i] = a2.x + a2.y; }
                    float q8[8], q4[4], q2[2];
#pragma unroll
                    for (int m = 0; m < 8; ++m) { const float snd = (c8 & 4) ? p[m] : p[m + 8], kp = (c8 & 4) ? p[m + 8] : p[m]; q8[m] = kp + __shfl_xor(snd, 4); }
#pragma unroll
                    for (int m = 0; m < 4; ++m) { const float snd = (c8 & 2) ? q8[m] : q8[m + 4], kp = (c8 & 2) ? q8[m + 4] : q8[m]; q4[m] = kp + __shfl_xor(snd, 2); }
#pragma unroll
                    for (int m = 0; m < 2; ++m) { const float snd = (c8 & 1) ? q4[m] : q4[m + 2], kp = (c8 & 1) ? q4[m + 2] : q4[m]; q2[m] = kp + __shfl_xor(snd, 1); }
                    LAS float* ap = ACC + tl * 128 + r8 + 16 * c8;
                    ap[0] += q2[0]; ap[8] += q2[1];
                }
#undef P10_LOADU
            }
            LDS_WAIT();
            for (int i = lane; i < 8 * 128; i += 64) { const int o_ = wave * 1024 + i; const unsigned e = EXPW[o_];
                const float a = ACC[o_] * SCL[e]; GACT[o_] = gelu_tanh(a) * GACT[o_] * SCL[NEXP + e]; }
            LDS_WAIT();
            LAS float* SSQ = ACC;
            for (int j = 0; j < 8; ++j) SSQ[(wave * 8 + j) * 128 + lane] = 0.f;
            LDS_WAIT();
            const float* gtp = MODV + (size_t)(5 * 2 + b) * DM;
            {
                v4u gn[16]; float avn[16];
#define P10_LOADV(idx) do { const int s_ = (idx) >> 3, j_ = (idx) & 7; const int tl_ = wave * 8 + j_; \
                    const unsigned char* tb_ = VB + (size_t)s_ * NEXP * 128 + 16 * c8; \
                    _Pragma("unroll") for (int i = 0; i < 16; ++i) { const int k_ = tl_ * 128 + r8 + 8 * i; const unsigned e_ = EXPW[k_]; avn[i] = GACT[k_]; gn[i] = *(const v4u*)(tb_ + (size_t)e_ * 128); } } while (0)
                P10_LOADV(0);
#pragma unroll 1
                for (int idx = 0; idx < 256; ++idx) {
                    v4u g[16]; float av[16];
#pragma unroll
                    for (int i = 0; i < 16; ++i) { g[i] = gn[i]; av[i] = avn[i]; }
                    if (idx + 1 < 256) P10_LOADV(idx + 1);
                    const int s_c = idx >> 3; const int tl = wave * 8 + (idx & 7); const int t = tok0 + tl;
                    f32x2 o8[8];
#pragma unroll
                    for (int q = 0; q < 8; ++q) o8[q] = (f32x2){0.f, 0.f};
#pragma unroll
                    for (int i = 0; i < 16; ++i)
#pragma unroll
                        for (int q = 0; q < 4; ++q) { o8[2 * q] += __builtin_amdgcn_cvt_pk_f32_fp8((int)g[i][q], false) * av[i]; o8[2 * q + 1] += __builtin_amdgcn_cvt_pk_f32_fp8((int)g[i][q], true) * av[i]; }
                    float p[16], q8[8], q4[4], q2[2];
#pragma unroll
                    for (int q = 0; q < 8; ++q) { p[2 * q] = o8[q].x; p[2 * q + 1] = o8[q].y; }
#pragma unroll
                    for (int m = 0; m < 8; ++m) { const float snd = (r8 & 4) ? p[m] : p[m + 8], kp = (r8 & 4) ? p[m + 8] : p[m]; q8[m] = kp + __shfl_xor(snd, 32); }
#pragma unroll
                    for (int m = 0; m < 4; ++m) { const float snd = (r8 & 2) ? q8[m] : q8[m + 4], kp = (r8 & 2) ? q8[m + 4] : q8[m]; q4[m] = kp + __shfl_xor(snd, 16); }
#pragma unroll
                    for (int m = 0; m < 2; ++m) { const float snd = (r8 & 1) ? q4[m] : q4[m + 2], kp = (r8 & 1) ? q4[m + 2] : q4[m]; q2[m] = kp + __shfl_xor(snd, 8); }
                    const int d = 128 * s_c + 16 * c8 + 2 * r8;
                    const f32x2 xv = *(const f32x2*)(out + (size_t)t * DM + d), gv = *(const f32x2*)(gtp + d);
                    f32x2 y; y.x = xv.x + gv.x * q2[0]; y.y = xv.y + gv.y * q2[1];
                    *(f32x2*)(out + (size_t)t * DM + d) = y;
                    SSQ[tl * 128 + lane] += y.x * y.x + y.y * y.y;
                }
#undef P10_LOADV
            }
            VM_WAIT(); LDS_WAIT();
            __builtin_amdgcn_fence(__ATOMIC_ACQUIRE, "agent");
            VM_WAIT();
            for (int j = 0; j < 8; ++j) {
                const int tl = wave * 8 + j; const int t = tok0 + tl;
                const float rstd = 1.0f / sqrtf(wave_sum(SSQ[tl * 128 + lane]) * (1.0f / DM) + RMS_EPS);
                f32x4* op = (f32x4*)(out + (size_t)t * DM) + lane; const f32x4* gp = (const f32x4*)g_final + lane;
#pragma unroll 4
                for (int i = 0; i < 16; ++i) { const f32x4 y = op[64 * i]; op[64 * i] = y * rstd * gp[64 * i]; }
            }
            LDS_WAIT();
        }
    }
#undef IN
#undef BOTH
#undef GRID_BAR
}

extern "C" void kernel_launch(void* const* d_in, const int* in_sizes, int n_in, void* d_out, int out_size, void* d_ws, size_t ws_size, hipStream_t stream) {
    static int grid = 0;
    if (grid == 0) {
        if (n_in != 16 || in_sizes[0] != M * DM || out_size != M * DM || ws_size < WS_END) {
            fprintf(stderr, "kernel_launch: shape/workspace mismatch: n_in %d in0 %d out %d ws %zu (need %zu)\n", n_in, n_in > 0 ? in_sizes[0] : -1, out_size, ws_size, (size_t)WS_END); grid = -1; return; }
        int dev = 0, cus = 0, per_cu = 0;
        if (hipGetDevice(&dev) != hipSuccess || hipDeviceGetAttribute(&cus, hipDeviceAttributeMultiprocessorCount, dev) != hipSuccess) { grid = -1; return; }
        if (hipFuncSetAttribute((const void*)fwd_kernel, hipFuncAttributeMaxDynamicSharedMemorySize, LDS_BYTES) != hipSuccess) { fprintf(stderr, "kernel_launch: hipFuncSetAttribute failed\n"); grid = -1; return; }
        if (hipOccupancyMaxActiveBlocksPerMultiprocessor(&per_cu, (const void*)fwd_kernel, NWAVES * 64, LDS_BYTES) != hipSuccess || per_cu < 1)
            fprintf(stderr, "kernel_launch: note: occupancy query reports %d workgroups per CU\n", per_cu);
        (void)hipGetLastError();
        grid = cus;
    }
    if (grid < 0) return;
    if (hipMemsetAsync((char*)d_ws + WS_CTL, 0, CTL_ZERO_BYTES, stream) != hipSuccess) { fprintf(stderr, "kernel_launch: memset failed\n"); return; }
    Args a{};
    for (int i = 0; i < 16; ++i) a.in[i] = (const float*)d_in[i];
    a.out = (float*)d_out; a.ws = (unsigned char*)d_ws;
#ifdef PROBE_MASK
    {
#ifndef PROBE_PAD
#define PROBE_PAD 0
#endif
        a.mask = PROBE_MASK; a.pad = PROBE_PAD;
        hipLaunchKernelGGL(fwd_kernel, dim3(grid), dim3(NWAVES * 64), LDS_BYTES, stream, a);
        (void)hipMemsetAsync((char*)d_ws + WS_CTL, 0, CTL_ZERO_BYTES, stream);
    }
#endif
    for (int li = 0; li < MK_N_LAUNCHES; ++li) {
        a.mask = (MK_N_LAUNCHES == PER_PHASE) ? (1u << li) : ((1u << PER_PHASE) - 1u); a.pad = 0;
        hipLaunchKernelGGL(fwd_kernel, dim3(grid), dim3(NWAVES * 64), LDS_BYTES, stream, a);
        const hipError_t le = hipPeekAtLastError();
        if (le != hipSuccess) { fprintf(stderr, "kernel_launch: launch %d failed: %s\n", li, hipGetErrorName(le)); break; }
    }
}
```

```cpp
#include <hip/hip_runtime.h>
#include <cstdio>
#include <cstdint>

#ifndef MK_N_LAUNCHES
#define MK_N_LAUNCHES 1
#endif

#define GAS __attribute__((address_space(1)))
#define LAS __attribute__((address_space(3)))
typedef unsigned short bf16;
typedef unsigned v4u __attribute__((ext_vector_type(4)));
typedef unsigned v2u __attribute__((ext_vector_type(2)));
typedef float f32x4 __attribute__((ext_vector_type(4)));
typedef float f32x2 __attribute__((ext_vector_type(2)));
typedef float f32x16 __attribute__((ext_vector_type(16)));
typedef short bf16x8 __attribute__((ext_vector_type(8)));
typedef short s16x4 __attribute__((ext_vector_type(4)));
typedef __bf16 bf2_t __attribute__((ext_vector_type(2)));

constexpr int BATCH = 2, SEQ = 8192, DM = 4096, M = BATCH * SEQ;
constexpr int NH = 16, HD = 128, ATTW = 2048, POOLW = 2048, INW = 8192;
constexpr int NMOD = 6 * DM;
constexpr int PQ = 2048;
constexpr int NEXP = 16384;
constexpr float RMS_EPS = 1e-6f;
constexpr float LOG2E = 1.4426950408889634f;
constexpr float QSCALE = 0.08838834764831845f * LOG2E;
constexpr int KS_ADA = 64;

constexpr size_t MiB = 1u << 20;
constexpr size_t WS_CTL = 0, CTL_ZERO_BYTES = 1 * MiB;
constexpr size_t WS_MODV = 1 * MiB;
constexpr size_t WS_SCL = 2 * MiB;
constexpr size_t WS_MODP = 4 * MiB;
constexpr size_t WS_SKT = 20 * MiB;
constexpr size_t WS_PWS = 22 * MiB;
constexpr size_t WS_WQST = 24 * MiB;
constexpr size_t WS_WOUT2 = 40 * MiB;
constexpr size_t WS_WINT = 72 * MiB;
constexpr size_t WS_UB = 136 * MiB;
constexpr size_t WS_VB = 264 * MiB;
constexpr size_t WS_H = 392 * MiB;
constexpr size_t WS_PROJ = 520 * MiB;
constexpr size_t WS_MIXIN = 776 * MiB;
constexpr size_t WS_WOPT = 904 * MiB;
constexpr size_t WS_WQB = 936 * MiB;
constexpr size_t WS_O0 = 968 * MiB, WS_O1 = 1032 * MiB;
constexpr size_t WS_LSE = 1096 * MiB;
constexpr size_t WS_SC = 1164 * MiB;
constexpr size_t WS_END = 1292 * MiB;

constexpr int RING_OFF = 0, RING_BYTES = 131072;
constexpr int ATT_WAVE_BYTES = 17408;
constexpr int SHARED_OFF = 139264;
constexpr int LDSCTL_OFF = 139264 + 4096, MISC_OFF = LDSCTL_OFF + 320;
constexpr int LDS_BYTES = 147456;
constexpr int NWAVES = 8;
constexpr int CW_BAR = 4096;

#define LDS_WAIT() asm volatile("s_waitcnt lgkmcnt(0)" ::: "memory")
#define VM_WAIT() asm volatile("s_waitcnt vmcnt(0)" ::: "memory")

__device__ __forceinline__ unsigned cvt_pk_bf16(float lo, float hi) { unsigned r; asm volatile("v_cvt_pk_bf16_f32 %0, %1, %2" : "=v"(r) : "v"(lo), "v"(hi)); return r; }
__device__ __forceinline__ float bf_lo(unsigned u) { return __uint_as_float(u << 16); }
__device__ __forceinline__ float bf_hi(unsigned u) { return __uint_as_float(u & 0xffff0000u); }
__device__ __forceinline__ float wave_sum(float v) {
#pragma unroll
    for (int o = 1; o < 64; o <<= 1) v += __shfl_xor(v, o);
    return v;
}

namespace pg8 {
typedef unsigned short bf16_t;
constexpr int BM = 256, BK = 64, HALF = 128, HTB = HALF * BK * 2, STAGE_BYTES = 8 * HTB, NXCD = 8, WGM = 8;

__host__ __device__ __forceinline__ int lds_byte(int r, int c) { const int st = (r >> 4) * 2 + (c >> 5), rr = r & 15, cc = c & 31, ob = rr * 64 + cc * 2; return st * 1024 + (ob ^ (((ob >> 9) & 1) << 5)); }
__host__ __device__ __forceinline__ void stage_rc(int b, int& R, int& C) { const int st = b / 1024, sb = b % 1024, swz = sb ^ (((sb >> 9) & 1) << 5); R = (st >> 1) * 16 + swz / 64; C = (st & 1) * 32 + (swz % 64) / 2; }
__host__ __device__ __forceinline__ int perm32(int rho) { const int n = rho >> 4, i = rho & 15; return 8 * (i >> 2) + 4 * n + (i & 3); }

struct Unit { int pm, pn; };
struct Gemm { const bf16_t* A; const bf16_t* Bt; int M, N, K, lda, ldb, agrp_div, agrp_cols, bgrp_div, bgrp_cols; };

struct StaticOrder {
    int nM, nN, nwg, G, c;
    __host__ __device__ void init(int M_, int N_, int G_, int c_) { nM = M_ / BM; nN = N_ / BM; nwg = nM * nN; G = G_; c = c_; }
    __host__ __device__ bool next(int i, Unit& u) const {
        const long L = (long)i * G + c; if (L >= nwg) return false;
        int wgid = (int)L; { const int q = nwg / NXCD, r = nwg % NXCD, xcd = wgid % NXCD, off = wgid / NXCD; wgid = (xcd < r ? xcd * (q + 1) : r * (q + 1) + (xcd - r) * q) + off; }
        const int nig = WGM * nN, gid = wgid / nig, fm = gid * WGM, gsz = (nM - fm) < WGM ? (nM - fm) : WGM;
        u.pm = fm + ((wgid % nig) % gsz); u.pn = (wgid % nig) / gsz; return true;
    }
    __device__ __forceinline__ void a_ready(const Unit&) const {}
    __device__ __forceinline__ void done(const Unit&) const {}
};

struct EpiBf16 {
    static constexpr bool PERM = true, AFTER_DRAIN = false;
    bf16_t* O; int ldc; int scale_cols; float scale0;
    __device__ __forceinline__ void operator()(const f32x4 (&acc)[2][2][4][2], const Unit& u, int wr, int wc, int fr, int fq) const {
        const int row0 = u.pm * BM + wr * 64 + fr; const int colt = u.pn * BM;
        const float sc = (colt < scale_cols) ? scale0 : 1.f;
        const int col0 = colt + wc * 32 + 8 * fq;
#pragma unroll
        for (int ai = 0; ai < 2; ++ai)
#pragma unroll
            for (int m = 0; m < 4; ++m) { bf16_t* rowp = O + (size_t)(row0 + ai * HALF + m * 16) * ldc + col0;
#pragma unroll
                for (int bj = 0; bj < 2; ++bj) { f32x4 v0 = acc[ai][bj][m][0] * sc, v1 = acc[ai][bj][m][1] * sc;
                    v4u w; w.x = cvt_pk_bf16(v0[0], v0[1]); w.y = cvt_pk_bf16(v0[2], v0[3]); w.z = cvt_pk_bf16(v1[0], v1[1]); w.w = cvt_pk_bf16(v1[2], v1[3]);
                    *(v4u*)(rowp + bj * HALF) = w; } }
    }
};
struct EpiBf16ColScale {
    static constexpr bool PERM = true, AFTER_DRAIN = false;
    bf16_t* O; int ldc; int coff; const float* cs;
    __device__ __forceinline__ void operator()(const f32x4 (&acc)[2][2][4][2], const Unit& u, int wr, int wc, int fr, int fq) const {
        const int row0 = u.pm * BM + wr * 64 + fr; const int col0 = u.pn * BM + wc * 32 + 8 * fq;
        f32x4 sv[2][2];
#pragma unroll
        for (int bj = 0; bj < 2; ++bj)
#pragma unroll
            for (int n = 0; n < 2; ++n) sv[bj][n] = *(const f32x4*)(cs + col0 + bj * HALF + 4 * n);
#pragma unroll
        for (int ai = 0; ai < 2; ++ai)
#pragma unroll
            for (int m = 0; m < 4; ++m) { bf16_t* rowp = O + (size_t)(row0 + ai * HALF + m * 16) * ldc + coff + col0;
#pragma unroll
                for (int bj = 0; bj < 2; ++bj) { f32x4 v0 = acc[ai][bj][m][0] * sv[bj][0], v1 = acc[ai][bj][m][1] * sv[bj][1];
                    v4u w; w.x = cvt_pk_bf16(v0[0], v0[1]); w.y = cvt_pk_bf16(v0[2], v0[3]); w.z = cvt_pk_bf16(v1[0], v1[1]); w.w = cvt_pk_bf16(v1[2], v1[3]);
                    *(v4u*)(rowp + bj * HALF) = w; } }
    }
};
struct EpiResBf16 {
    static constexpr bool PERM = true, AFTER_DRAIN = false;
    const float* X; const float* gate; bf16_t* O; int ldc;
    __device__ __forceinline__ void operator()(const f32x4 (&acc)[2][2][4][2], const Unit& u, int wr, int wc, int fr, int fq) const {
        const int row0 = u.pm * BM + wr * 64 + fr; const int col0 = u.pn * BM + wc * 32 + 8 * fq; const int b = (u.pm * BM) / SEQ;
        f32x4 gv[2][2];
#pragma unroll
        for (int bj = 0; bj < 2; ++bj)
#pragma unroll
            for (int n = 0; n < 2; ++n) gv[bj][n] = *(const f32x4*)(gate + (size_t)b * DM + col0 + bj * HALF + 4 * n);
#pragma unroll
        for (int ai = 0; ai < 2; ++ai)
#pragma unroll
            for (int m = 0; m < 4; ++m) { const size_t off = (size_t)(row0 + ai * HALF + m * 16) * ldc + col0;
#pragma unroll
                for (int bj = 0; bj < 2; ++bj) { const f32x4 x0 = *(const f32x4*)(X + off + bj * HALF), x1 = *(const f32x4*)(X + off + bj * HALF + 4);
                    const f32x4 v0 = x0 + gv[bj][0] * acc[ai][bj][m][0], v1 = x1 + gv[bj][1] * acc[ai][bj][m][1];
                    v4u w; w.x = cvt_pk_bf16(v0[0], v0[1]); w.y = cvt_pk_bf16(v0[2], v0[3]); w.z = cvt_pk_bf16(v1[0], v1[1]); w.w = cvt_pk_bf16(v1[2], v1[3]);
                    *(v4u*)(O + off + bj * HALF) = w; } }
    }
};
struct EpiResF32 {
    static constexpr bool PERM = false, AFTER_DRAIN = false;
    const float* X; const float* gate; float* O; int ldc;
    __device__ __forceinline__ void operator()(const f32x4 (&acc)[2][2][4][2], const Unit& u, int wr, int wc, int fr, int fq) const {
        const int row0 = u.pm * BM + wr * 64 + fr; const int col0 = u.pn * BM + wc * 32 + 4 * fq; const int b = (u.pm * BM) / SEQ;
        f32x4 gv[2][2];
#pragma unroll
        for (int bj = 0; bj < 2; ++bj)
#pragma unroll
            for (int n = 0; n < 2; ++n) gv[bj][n] = *(const f32x4*)(gate + (size_t)b * DM + col0 + bj * HALF + n * 16);
#pragma unroll
        for (int ai = 0; ai < 2; ++ai)
#pragma unroll
            for (int m = 0; m < 4; ++m) { const size_t off = (size_t)(row0 + ai * HALF + m * 16) * ldc + col0;
#pragma unroll
                for (int bj = 0; bj < 2; ++bj)
#pragma unroll
                    for (int n = 0; n < 2; ++n) { const f32x4 xv = *(const f32x4*)(X + off + bj * HALF + n * 16);
                        *(f32x4*)(O + off + bj * HALF + n * 16) = xv + gv[bj][n] * acc[ai][bj][m][n]; } }
    }
};
struct EpiF32 {
    static constexpr bool PERM = false, AFTER_DRAIN = false;
    float* O; int ldc;
    __device__ __forceinline__ void operator()(const f32x4 (&acc)[2][2][4][2], const Unit& u, int wr, int wc, int fr, int fq) const {
        const int row0 = u.pm * BM + wr * 64 + fr; const int col0 = u.pn * BM + wc * 32 + 4 * fq;
#pragma unroll
        for (int ai = 0; ai < 2; ++ai)
#pragma unroll
            for (int m = 0; m < 4; ++m) { const size_t off = (size_t)(row0 + ai * HALF + m * 16) * ldc + col0;
#pragma unroll
                for (int bj = 0; bj < 2; ++bj)
#pragma unroll
                    for (int n = 0; n < 2; ++n) *(f32x4*)(O + off + bj * HALF + n * 16) = acc[ai][bj][m][n]; }
    }
};

template <class Epi, class Sched, bool ALIGN_EPI>
__device__ __forceinline__ void gemm_phase(LAS unsigned char* lds, const Gemm g, const Sched& S, const Epi& E) {
    const int tid = threadIdx.x, wid = __builtin_amdgcn_readfirstlane(tid >> 6), lane = tid & 63, wr = wid >> 2, wc = wid & 3, fr = lane & 15, fq = lane >> 4;
    const int K = g.K, nt = K / BK;
    unsigned voffA[2], voffB[2];
#pragma unroll
    for (int i = 0; i < 2; ++i) { int R, C; stage_rc(tid * 16 + i * 8192, R, C); const int Rb = Epi::PERM ? ((R & ~31) + perm32(R & 31)) : R;
        voffA[i] = (unsigned)(R * g.lda + C) * 2u; voffB[i] = (unsigned)(Rb * g.ldb + C) * 2u; }
    const size_t kstep = (size_t)(BK * 2);
    const size_t hstepA = (size_t)HALF * g.lda * 2, hstepB = (size_t)HALF * g.ldb * 2;
    const size_t tstepA = 2 * hstepA, tstepB = 2 * hstepB;
    const unsigned ldsw = (unsigned)wid * 1024u;
    const int aoff = lds_byte(wr * 64 + fr, fq * 8), boff = lds_byte(wc * 32 + fr, fq * 8);
#define PG8_SA(b, h) (((b) * 2 + (h)) * HTB)
#define PG8_SB(b, h) ((4 + (b) * 2 + (h)) * HTB)
#define PG8_STAGE(bufoff, gbase, voff) do { _Pragma("unroll") for (int _i = 0; _i < 2; ++_i) \
        __builtin_amdgcn_global_load_lds((const unsigned*)((const char*)(gbase) + (voff)[_i]), (LAS unsigned*)(lds + (bufoff) + ldsw + _i * 8192), 16, 0, 0); } while (0)
#define PG8_LDA(dst, b, h) do { _Pragma("unroll") for (int m = 0; m < 4; ++m) _Pragma("unroll") for (int k = 0; k < 2; ++k) dst[m][k] = *(const LAS bf16x8*)(lds + PG8_SA(b, h) + aoff + m * 2048 + k * 1024); } while (0)
#define PG8_LDB(dst, b, h) do { _Pragma("unroll") for (int n = 0; n < 2; ++n) _Pragma("unroll") for (int k = 0; k < 2; ++k) dst[n][k] = *(const LAS bf16x8*)(lds + PG8_SB(b, h) + boff + n * 2048 + k * 1024); } while (0)
#define PG8_MMA(ai, bj, At, Bt) do { __builtin_amdgcn_s_setprio(1); _Pragma("unroll") for (int m = 0; m < 4; ++m) _Pragma("unroll") for (int n = 0; n < 2; ++n) _Pragma("unroll") for (int k = 0; k < 2; ++k) \
        acc[ai][bj][m][n] = __builtin_amdgcn_mfma_f32_16x16x32_bf16(Bt[n][k], At[m][k], acc[ai][bj][m][n], 0, 0, 0); __builtin_amdgcn_s_setprio(0); } while (0)
#define PG8_WAIT_V(n) asm volatile("s_waitcnt vmcnt(" #n ")" ::: "memory")
#define PG8_WAIT_L(n) asm volatile("s_waitcnt lgkmcnt(" #n ")" ::: "memory")
#define PG8_BAR __builtin_amdgcn_s_barrier()
#define PG8_SCHED __builtin_amdgcn_sched_barrier(0)
#define PG8_ABASE(u) ((const char*)g.A + (size_t)(u).pm * tstepA + (size_t)((u).pn / g.agrp_div) * (size_t)g.agrp_cols * 2)
#define PG8_BBASE(u) ((const char*)g.Bt + (size_t)(u).pn * tstepB + (size_t)((u).pm / g.bgrp_div) * (size_t)g.bgrp_cols * 2)
    Unit cur, nxt; int ui = 0;
    if (!S.next(0, cur)) return;
    f32x4 acc[2][2][4][2];
#pragma unroll
    for (int a = 0; a < 2; ++a)
#pragma unroll
        for (int b = 0; b < 2; ++b)
#pragma unroll
            for (int m = 0; m < 4; ++m)
#pragma unroll
                for (int n = 0; n < 2; ++n) acc[a][b][m][n] = (f32x4){0.f, 0.f, 0.f, 0.f};
    bf16x8 At[4][2], B0[2][2], B1[2][2];
    const char* cA = PG8_ABASE(cur); const char* cB = PG8_BBASE(cur);
    S.a_ready(cur);
    PG8_STAGE(PG8_SB(0, 0), cB, voffB); PG8_STAGE(PG8_SB(0, 1), cB + hstepB, voffB); PG8_STAGE(PG8_SA(0, 0), cA, voffA); PG8_STAGE(PG8_SA(0, 1), cA + hstepA, voffA);
    if (wr == 1) PG8_BAR;
    PG8_WAIT_V(2); PG8_BAR;
    PG8_STAGE(PG8_SB(1, 0), cB + kstep, voffB); PG8_STAGE(PG8_SA(1, 0), cA + kstep, voffA); PG8_STAGE(PG8_SB(1, 1), cB + hstepB + kstep, voffB);
    PG8_WAIT_V(6); PG8_BAR;
    for (;;) {
        const bool has_next = S.next(ui + 1, nxt);
        const char* nA = has_next ? PG8_ABASE(nxt) : cA; const char* nB = has_next ? PG8_BBASE(nxt) : cB;
        for (int t = 0; t < nt; t += 2) {
            const bool last = (t == nt - 2);
            const char* a1 = cA + (size_t)(t + 1) * kstep;
            const char* a2 = last ? nA : cA + (size_t)(t + 2) * kstep; const char* b2 = last ? nB : cB + (size_t)(t + 2) * kstep;
            const char* a3 = a2 + kstep; const char* b3 = b2 + kstep;
            if (last && has_next) S.a_ready(nxt);
            PG8_LDB(B0, 0, 0); PG8_LDB(B1, 0, 1); PG8_SCHED; PG8_LDA(At, 0, 0); PG8_STAGE(PG8_SA(1, 1), a1 + hstepA, voffA);
            PG8_WAIT_V(8); PG8_WAIT_L(0); PG8_BAR; PG8_MMA(0, 0, At, B0); PG8_MMA(0, 1, At, B1); PG8_BAR; PG8_SCHED;
            PG8_LDA(At, 0, 1); PG8_STAGE(PG8_SB(0, 0), b2, voffB); PG8_STAGE(PG8_SB(0, 1), b2 + hstepB, voffB); PG8_STAGE(PG8_SA(0, 0), a2, voffA);
            PG8_WAIT_V(8); PG8_WAIT_L(0); PG8_BAR; PG8_MMA(1, 0, At, B0); PG8_MMA(1, 1, At, B1); PG8_BAR; PG8_SCHED;
            PG8_LDB(B0, 1, 0); PG8_LDB(B1, 1, 1); PG8_SCHED; PG8_LDA(At, 1, 0); PG8_STAGE(PG8_SA(0, 1), a2 + hstepA, voffA);
            PG8_WAIT_V(8); PG8_WAIT_L(0); PG8_BAR; PG8_MMA(0, 0, At, B0); PG8_MMA(0, 1, At, B1); PG8_BAR; PG8_SCHED;
            PG8_LDA(At, 1, 1); PG8_STAGE(PG8_SB(1, 0), b3, voffB); PG8_STAGE(PG8_SB(1, 1), b3 + hstepB, voffB); PG8_STAGE(PG8_SA(1, 0), a3, voffA);
            PG8_WAIT_V(8); PG8_WAIT_L(0); PG8_BAR; PG8_MMA(1, 0, At, B0); PG8_MMA(1, 1, At, B1); PG8_BAR; PG8_SCHED;
        }
        if constexpr (ALIGN_EPI) { if (wr == 0) PG8_BAR; }
        E(acc, cur, wr, wc, fr, fq); S.done(cur);
        if (!has_next) break;
#pragma unroll
        for (int a = 0; a < 2; ++a)
#pragma unroll
            for (int b = 0; b < 2; ++b)
#pragma unroll
                for (int m = 0; m < 4; ++m)
#pragma unroll
                    for (int n = 0; n < 2; ++n) acc[a][b][m][n] = (f32x4){0.f, 0.f, 0.f, 0.f};
        cur = nxt; cA = nA; cB = nB; ++ui;
        if constexpr (ALIGN_EPI) { if (wr == 1) PG8_BAR; }
    }
    PG8_WAIT_V(0);
    if constexpr (!ALIGN_EPI) { if (wr == 0) PG8_BAR; }
    PG8_BAR;
#undef PG8_SA
#undef PG8_SB
#undef PG8_STAGE
#undef PG8_LDA
#undef PG8_LDB
#undef PG8_MMA
#undef PG8_WAIT_V
#undef PG8_WAIT_L
#undef PG8_BAR
#undef PG8_SCHED
#undef PG8_ABASE
#undef PG8_BBASE
}
}

#define XB_TMO      128
#define XB_XCNT(j)  (256  + 64 * (j))
#define XB_XSUB(j)  (1280 + 64 * (j))
#define XB_XGEN(j)  (2304 + 64 * (j))
#define XB_TOP      3328
#define XB_TOPGEN   3392
#define XCD_BAR_WORDS 3456
#define XB_SPIN_CAP (1u << 18)

__device__ __forceinline__ unsigned xb_ld(unsigned* p)              { return __hip_atomic_load(p, __ATOMIC_RELAXED, __HIP_MEMORY_SCOPE_AGENT); }
__device__ __forceinline__ unsigned xb_add(unsigned* p, unsigned v) { return __hip_atomic_fetch_add(p, v, __ATOMIC_RELAXED, __HIP_MEMORY_SCOPE_AGENT); }
__device__ __forceinline__ unsigned xb_xcc_id() { return (unsigned)__builtin_amdgcn_s_getreg((3 << 11) | 20) & 0xFu; }
#define XB_SPIN(cond, bar) do { unsigned _sp = 0; while (cond) { __builtin_amdgcn_s_sleep(1); \
    if ((++_sp & 255u) == 0u) { if (xb_ld(&(bar)[XB_TMO])) break; if (_sp > XB_SPIN_CAP) { atomicAdd(&(bar)[XB_TMO], 1u); break; } } } } while (0)

struct XcdBarrier { unsigned* bar; unsigned x; volatile LAS unsigned* st; };

__device__ __forceinline__ XcdBarrier xcd_barrier_post(unsigned* bar, volatile LAS unsigned* st) {
    XcdBarrier b; b.bar = bar; b.x = xb_xcc_id(); b.st = st;
    if (threadIdx.x == 0) (void)xb_add(&bar[XB_XCNT(b.x)], 1u);
    return b;
}
__device__ __forceinline__ void xcd_barrier_complete(unsigned* bar, unsigned x, unsigned& nloc, unsigned& nx) {
    const unsigned G = gridDim.x * gridDim.y * gridDim.z;
    unsigned sum, cnt, mine, sp = 0u;
    for (;;) {
        sum = 0u; cnt = 0u; mine = 0u;
#pragma unroll
        for (unsigned j = 0; j < 16; ++j) { const unsigned c = xb_ld(&bar[XB_XCNT(j)]); sum += c; cnt += (c > 0u) ? 1u : 0u; mine = (j == x) ? c : mine; }
        if (sum == G) break;
        __builtin_amdgcn_s_sleep(1);
        if ((++sp & 255u) == 0u) { if (xb_ld(&bar[XB_TMO])) break; if (sp > XB_SPIN_CAP) { atomicAdd(&bar[XB_TMO], 1u); break; } }
    }
    nloc = mine > 0u ? mine : 1u; nx = cnt > 0u ? cnt : 1u;
}
__device__ __forceinline__ void xcd_barrier(const XcdBarrier& b) {
    asm volatile("s_waitcnt vmcnt(0)" ::: "memory");
    __syncthreads();
    if (threadIdx.x == 0) {
        unsigned* bar = b.bar;
        __builtin_amdgcn_s_waitcnt(0);
        unsigned nloc = b.st[0], nx = b.st[1];
        if (nloc == 0u) { xcd_barrier_complete(bar, b.x, nloc, nx); b.st[0] = nloc; b.st[1] = nx; }
        const unsigned old = xb_add(&bar[XB_XSUB(b.x)], 1u);
        const unsigned gen = old / nloc;
        if (old + 1u == (gen + 1u) * nloc) {
            __builtin_amdgcn_fence(__ATOMIC_RELEASE, "agent");
            asm volatile("s_waitcnt vmcnt(0)" ::: "memory");
            const unsigned og = xb_add(&bar[XB_TOP], 1u);
            const unsigned tg = og / nx;
            if (og + 1u == (tg + 1u) * nx) xb_add(&bar[XB_TOPGEN], 1u);
            else XB_SPIN(xb_ld(&bar[XB_TOPGEN]) == tg, bar);
            __builtin_amdgcn_fence(__ATOMIC_ACQUIRE, "agent");
            xb_add(&bar[XB_XGEN(b.x)], 1u);
            asm volatile("s_waitcnt vmcnt(0)" ::: "memory");
        } else {
            XB_SPIN(xb_ld(&bar[XB_XGEN(b.x)]) == gen, bar);
            __builtin_amdgcn_fence(__ATOMIC_ACQUIRE, "agent");
            asm volatile("s_waitcnt vmcnt(0)" ::: "memory");
        }
    }
    __syncthreads();
}

__device__ __forceinline__ void p0_transpose_item(const float* W, int K, int N, bf16* WT, int ldt, LAS float* scr, int item, int lane) {
    const int nblk = N / 32, kb = item / nblk, nb = item % nblk, k0 = 64 * kb, n0 = 32 * nb;
#pragma unroll 8
    for (int i = 0; i < 32; ++i) { const int kk = 2 * i + (lane >> 5); scr[kk * 33 + (lane & 31)] = W[(size_t)(k0 + kk) * N + n0 + (lane & 31)]; }
    LDS_WAIT(); asm volatile("" ::: "memory");
    const int c = lane & 7;
#pragma unroll
    for (int j = 0; j < 4; ++j) { const int n = (lane >> 3) + 8 * j; const LAS float* s = scr + (8 * c) * 33 + n;
        v4u o; o.x = cvt_pk_bf16(s[0 * 33], s[1 * 33]); o.y = cvt_pk_bf16(s[2 * 33], s[3 * 33]); o.z = cvt_pk_bf16(s[4 * 33], s[5 * 33]); o.w = cvt_pk_bf16(s[6 * 33], s[7 * 33]);
        *(GAS v4u*)(WT + (size_t)(n0 + n) * ldt + k0 + 8 * c) = o; }
    LDS_WAIT(); asm volatile("" ::: "memory");
}

__device__ __forceinline__ int t5_bucket(int rel) {
    int n = -rel; const int ret = n < 0 ? 16 : 0; n = n < 0 ? -n : n;
    if (n < 8) return ret + n;
    const float v = logf((float)n / 8.0f) / logf(128.0f) * 8.0f;
    int large = 8 + (int)v; large = large < 15 ? large : 15;
    return ret + large;
}
__device__ __forceinline__ float gelu_tanh(float x) {
    const float z = 0.7978845608028654f * (x + 0.044715f * x * x * x);
    const float e = __expf(2.0f * z);
    const float t = 1.0f - 2.0f / (e + 1.0f);
    return 0.5f * x * (1.0f + t);
}
__device__ __forceinline__ unsigned fkey(float v) { const unsigned u = __float_as_uint(v); return (u >> 31) ? ~u : (u | 0x80000000u); }
__device__ __forceinline__ float fdec(unsigned key) { const unsigned k2 = key & ~127u; const unsigned u = (k2 >> 31) ? (k2 & 0x7fffffffu) : (~k2 & ~127u); return __uint_as_float(u); }
template <int LJ> __device__ __forceinline__ unsigned xshfl(unsigned x, const int lane) {
    if constexpr (LJ == 1) return (unsigned)__builtin_amdgcn_update_dpp(0, (int)x, 0xB1, 0xF, 0xF, false);
    else if constexpr (LJ == 2) return (unsigned)__builtin_amdgcn_update_dpp(0, (int)x, 0x4E, 0xF, 0xF, false);
    else if constexpr (LJ == 4) { const int y = __builtin_amdgcn_update_dpp(0, (int)x, 0x141, 0xF, 0xF, false); return (unsigned)__builtin_amdgcn_update_dpp(0, y, 0x1B, 0xF, 0xF, false); }
    else if constexpr (LJ == 8) { const int y = __builtin_amdgcn_update_dpp(0, (int)x, 0x140, 0xF, 0xF, false); return (unsigned)__builtin_amdgcn_update_dpp(0, y, 0x141, 0xF, 0xF, false); }
    else if constexpr (LJ == 16) return (unsigned)__builtin_amdgcn_ds_swizzle((int)x, 0x401F);
    else { const auto rr = __builtin_amdgcn_permlane32_swap(x, x, false, false); return lane < 32 ? rr[1] : rr[0]; }
}
template <int K, int J> __device__ __forceinline__ void bitonic_step(unsigned& a0, unsigned& a1, unsigned& b0, unsigned& b1, const int lane) {
    const bool asc = (K == 128) ? true : ((lane & (K >> 1)) == 0);
    if constexpr (J == 1) {
        const unsigned la = a0 < a1 ? a0 : a1, ha = a0 < a1 ? a1 : a0, lb = b0 < b1 ? b0 : b1, hb = b0 < b1 ? b1 : b0;
        a0 = asc ? la : ha; a1 = asc ? ha : la; b0 = asc ? lb : hb; b1 = asc ? hb : lb;
    } else {
        constexpr int LJ = J >> 1; const bool tmin = (((lane & LJ) == 0) == asc);
        const unsigned pa0 = xshfl<LJ>(a0, lane), pa1 = xshfl<LJ>(a1, lane), pb0 = xshfl<LJ>(b0, lane), pb1 = xshfl<LJ>(b1, lane);
        a0 = tmin ? (a0 < pa0 ? a0 : pa0) : (a0 < pa0 ? pa0 : a0); a1 = tmin ? (a1 < pa1 ? a1 : pa1) : (a1 < pa1 ? pa1 : a1);
        b0 = tmin ? (b0 < pb0 ? b0 : pb0) : (b0 < pb0 ? pb0 : b0); b1 = tmin ? (b1 < pb1 ? b1 : pb1) : (b1 < pb1 ? pb1 : b1);
    }
    if constexpr (J > 1) bitonic_step<K, (J >> 1)>(a0, a1, b0, b1, lane);
}
template <int K> __device__ __forceinline__ void bitonic_stage(unsigned& a0, unsigned& a1, unsigned& b0, unsigned& b1, const int lane) {
    bitonic_step<K, (K >> 1)>(a0, a1, b0, b1, lane);
    if constexpr (K < 128) bitonic_stage<(K << 1)>(a0, a1, b0, b1, lane);
}
__device__ __forceinline__ void bitonic128x2(unsigned& a0, unsigned& a1, unsigned& b0, unsigned& b1, const int lane) { bitonic_stage<2>(a0, a1, b0, b1, lane); }
__device__ __forceinline__ float dot2bf(unsigned a, unsigned b, float c) { return __builtin_amdgcn_fdot2_f32_bf16(__builtin_bit_cast(bf2_t, a), __builtin_bit_cast(bf2_t, b), c, false); }

constexpr int ATT_SLOT = 8704;
__device__ __forceinline__ int crow(int r, int hi) { return (r & 3) + 8 * (r >> 2) + 4 * hi; }

__device__ __forceinline__ void attn_task(const int G, const bf16* PROJ, bf16* O0, bf16* O1, float* LSE0, float* LSE1, bf16* MIXIN,
                                          const LAS float* btab, LAS unsigned char* wl, int b, int h, int mtile, int tk, int lane) {
    const int SH = 2 * G;
    const int L = SEQ >> SH, TPR = 32 >> SH;
    const int r32 = lane & 31, hi = lane >> 5;
    const int res = tk >> (5 - SH), l0 = ((mtile * 1024) >> SH) + 32 * (tk & (TPR - 1));
    const size_t rowbase = (size_t)b * SEQ;
    const int srow = lane >> 4, sch = lane & 15;
#define ATT_WAITV(n) asm volatile("s_waitcnt vmcnt(" #n ")" ::: "memory")
#define ATT_ISSUE(n) do { LAS unsigned char* sl_ = wl + ((n) & 1) * ATT_SLOT; const int jt_ = (n) < 5 ? (n) : (n) - 5; \
        _Pragma("unroll") for (int i_ = 0; i_ < 8; ++i_) { \
            const int key_ = (n) < 5 ? (4 * i_ + srow) : ((i_ & 3) + 4 * srow + 16 * (i_ >> 2)); \
            int lk_ = l0 - 64 + 32 * jt_ + key_; lk_ = lk_ < 0 ? 0 : (lk_ > L - 1 ? L - 1 : lk_); \
            const int ch_ = (n) < 5 ? (sch ^ (key_ & 7)) : sch; \
            const bf16* src_ = PROJ + (rowbase + ((size_t)lk_ << SH) + res) * INW + ((n) < 5 ? ATTW : 2 * ATTW) + h * HD + ch_ * 8; \
            __builtin_amdgcn_global_load_lds((const unsigned*)src_, (LAS unsigned*)(sl_ + i_ * ((n) < 5 ? 1024 : 1088)), 16, 0, 0); } } while (0)
    const size_t qrow = rowbase + ((size_t)(l0 + r32) << SH) + res;
    bf16x8 qr[8];
    { const bf16* qp = PROJ + qrow * INW + h * HD + hi * 8;
#pragma unroll
      for (int d0 = 0; d0 < 8; ++d0) qr[d0] = *(const bf16x8*)(qp + d0 * 16); }
    ATT_ISSUE(0); ATT_ISSUE(1);
    f32x16 p[5];
#define ATT_KTILE(n) do { LAS unsigned char* sl_ = wl + ((n) & 1) * ATT_SLOT + r32 * 256; f32x16 s_ = {}; \
        _Pragma("unroll") for (int d0 = 0; d0 < 8; ++d0) { const bf16x8 a_ = *(const LAS bf16x8*)(sl_ + (((2 * d0 + hi) ^ (r32 & 7)) << 4)); s_ = __builtin_amdgcn_mfma_f32_32x32x16_bf16(a_, qr[d0], s_, 0, 0, 0); } \
        p[n] = s_; asm volatile("" ::: "memory"); } while (0)
    ATT_WAITV(8); ATT_KTILE(0); ATT_ISSUE(2);
    ATT_WAITV(8); ATT_KTILE(1); ATT_ISSUE(3);
    ATT_WAITV(8); ATT_KTILE(2); ATT_ISSUE(4);
    ATT_WAITV(8); ATT_KTILE(3); ATT_ISSUE(5);
    ATT_WAITV(8); ATT_KTILE(4); ATT_ISSUE(6);
    float mx = -1e30f;
    const bool edge = (l0 - 64 < 0) || (l0 + 96 > L);
    const LAS float* bt = btab + G * 256 + 32 + 4 * hi - r32;
#pragma unroll
    for (int j = 0; j < 5; ++j) {
#pragma unroll
        for (int r = 0; r < 16; ++r) {
            const int kc = 32 * j + (r & 3) + 8 * (r >> 2);
            float v = p[j][r] + bt[kc];
            if (edge) { const int lk = l0 - 64 + kc + 4 * hi; v = (lk >= 0 && lk < L) ? v : -1e30f; }
            p[j][r] = v; mx = fmaxf(mx, v);
        }
        asm volatile("" ::: "memory");
    }
    mx = fmaxf(mx, __shfl_xor(mx, 32));
    float ls = 0.f;
    bf16x8 pb[5][2];
#pragma unroll
    for (int j = 0; j < 5; ++j) {
        float e[16];
#pragma unroll
        for (int r = 0; r < 16; ++r) { e[r] = __builtin_amdgcn_exp2f(p[j][r] - mx); ls += e[r]; }
#pragma unroll
        for (int s = 0; s < 2; ++s) { v4u w; w.x = cvt_pk_bf16(e[8 * s + 0], e[8 * s + 1]); w.y = cvt_pk_bf16(e[8 * s + 2], e[8 * s + 3]);
            w.z = cvt_pk_bf16(e[8 * s + 4], e[8 * s + 5]); w.w = cvt_pk_bf16(e[8 * s + 6], e[8 * s + 7]); pb[j][s] = __builtin_bit_cast(bf16x8, w); }
    }
    ls += __shfl_xor(ls, 32);
    asm volatile("" ::: "memory");
    f32x16 o[4] = {};
    const int i16 = lane & 15, g16 = lane >> 4;
    const unsigned vbase = (unsigned)(uintptr_t)wl + (unsigned)((i16 >> 2) * 1088 + hi * 256 + (16 * (g16 & 1) + 4 * (i16 & 3)) * 2);
#define ATT_VTILE(n) do { const unsigned va_ = vbase + ((n) & 1) * ATT_SLOT; \
        _Pragma("unroll") for (int dt = 0; dt < 4; ++dt) { s16x4 lo0, hi0, lo1, hi1; \
            asm volatile("ds_read_b64_tr_b16 %0, %4 offset:%5\n\tds_read_b64_tr_b16 %1, %4 offset:%6\n\tds_read_b64_tr_b16 %2, %4 offset:%7\n\tds_read_b64_tr_b16 %3, %4 offset:%8\n\ts_waitcnt lgkmcnt(0)" \
                         : "=&v"(lo0), "=&v"(hi0), "=&v"(lo1), "=&v"(hi1) : "v"(va_), "i"(dt * 64), "i"(512 + dt * 64), "i"(4 * 1088 + dt * 64), "i"(4 * 1088 + 512 + dt * 64) : "memory"); \
            const bf16x8 af0 = (bf16x8){lo0[0], lo0[1], lo0[2], lo0[3], hi0[0], hi0[1], hi0[2], hi0[3]}; \
            const bf16x8 af1 = (bf16x8){lo1[0], lo1[1], lo1[2], lo1[3], hi1[0], hi1[1], hi1[2], hi1[3]}; \
            o[dt] = __builtin_amdgcn_mfma_f32_32x32x16_bf16(af0, pb[(n) - 5][0], o[dt], 0, 0, 0); \
            o[dt] = __builtin_amdgcn_mfma_f32_32x32x16_bf16(af1, pb[(n) - 5][1], o[dt], 0, 0, 0); } } while (0)
    ATT_WAITV(8); ATT_VTILE(5); ATT_ISSUE(7);
    ATT_WAITV(8); ATT_VTILE(6); ATT_ISSUE(8);
    ATT_WAITV(8); ATT_VTILE(7); ATT_ISSUE(9);
    ATT_WAITV(8); ATT_VTILE(8);
    ATT_WAITV(0); ATT_VTILE(9);
#undef ATT_WAITV
#undef ATT_ISSUE
#undef ATT_KTILE
#undef ATT_VTILE
    const float inv = 1.0f / ls;
    const float lse2 = mx + __builtin_amdgcn_logf(ls);
    const size_t orow = qrow;
    if (G < 2) {
        bf16* op = (G == 0 ? O0 : O1) + orow * ATTW + h * HD + 4 * hi;
#pragma unroll
        for (int dt = 0; dt < 4; ++dt)
#pragma unroll
            for (int rg = 0; rg < 4; ++rg) { v2u w; w.x = cvt_pk_bf16(o[dt][4 * rg] * inv, o[dt][4 * rg + 1] * inv); w.y = cvt_pk_bf16(o[dt][4 * rg + 2] * inv, o[dt][4 * rg + 3] * inv);
                *(v2u*)(op + 32 * dt + 8 * rg) = w; }
        if (hi == 0) (G == 0 ? LSE0 : LSE1)[orow * NH + h] = lse2;
    } else {
        const float l0v = LSE0[orow * NH + h], l1v = LSE1[orow * NH + h];
        const float mm = fmaxf(fmaxf(l0v, l1v), lse2);
        const float w0 = __builtin_amdgcn_exp2f(l0v - mm), w1 = __builtin_amdgcn_exp2f(l1v - mm), w2 = __builtin_amdgcn_exp2f(lse2 - mm);
        const float wi = 1.0f / (w0 + w1 + w2);
        const float c0 = w0 * wi, c1 = w1 * wi, c2 = w2 * wi * inv;
        const bf16* p0 = O0 + orow * ATTW + h * HD + 4 * hi; const bf16* p1 = O1 + orow * ATTW + h * HD + 4 * hi;
        bf16* op = MIXIN + orow * DM + h * HD + 4 * hi;
#pragma unroll
        for (int dt = 0; dt < 4; ++dt) {
            v2u a[4], c[4];
#pragma unroll
            for (int rg = 0; rg < 4; ++rg) { a[rg] = *(const v2u*)(p0 + 32 * dt + 8 * rg); c[rg] = *(const v2u*)(p1 + 32 * dt + 8 * rg); }
#pragma unroll
            for (int rg = 0; rg < 4; ++rg) {
                const float y0 = c0 * bf_lo(a[rg].x) + c1 * bf_lo(c[rg].x) + c2 * o[dt][4 * rg], y1 = c0 * bf_hi(a[rg].x) + c1 * bf_hi(c[rg].x) + c2 * o[dt][4 * rg + 1];
                const float y2 = c0 * bf_lo(a[rg].y) + c1 * bf_lo(c[rg].y) + c2 * o[dt][4 * rg + 2], y3 = c0 * bf_hi(a[rg].y) + c1 * bf_hi(c[rg].y) + c2 * o[dt][4 * rg + 3];
                v2u w; w.x = cvt_pk_bf16(y0, y1); w.y = cvt_pk_bf16(y2, y3); *(v2u*)(op + 32 * dt + 8 * rg) = w; }
        }
    }
}

constexpr int PER_PHASE = 9;
struct Args { const float* in[16]; float* out; unsigned char* ws; unsigned mask; unsigned pad; };

__constant__ unsigned char CAND_I[64] = {0,0,0,0,0,0,0,0,0,0,0,0,0,0,0,0, 1,1,1,1,1,1,1,1, 2,2,2,2,2, 3,3,3,3, 4,4,4, 5,5, 6,6, 7,7, 8,9,10,11,12,13,14,15, 0,0,0,0,0,0,0,0,0,0,0,0,0,0};
__constant__ unsigned char CAND_J[64] = {0,1,2,3,4,5,6,7,8,9,10,11,12,13,14,15, 0,1,2,3,4,5,6,7, 0,1,2,3,4, 0,1,2,3, 0,1,2, 0,1, 0,1, 0,1, 0,0,0,0,0,0,0,0, 0,0,0,0,0,0,0,0,0,0,0,0,0,0};

__global__ void __launch_bounds__(NWAVES * 64, 2) fwd_kernel(Args args) {
    extern __shared__ __attribute__((aligned(16))) unsigned char lds_raw[];
    LAS unsigned char* lds = (LAS unsigned char*)lds_raw;
    volatile LAS unsigned* MISC = (volatile LAS unsigned*)(lds + MISC_OFF);
    const int tid = threadIdx.x, lane = tid & 63, wave = __builtin_amdgcn_readfirstlane(tid >> 6);
    const int G = gridDim.x; const int bx = blockIdx.x;
    const int vcu = (G % 8 == 0) ? (bx % 8) * (G / 8) + bx / 8 : bx;
    const int gw = vcu * NWAVES + wave, NGW = G * NWAVES;
    unsigned char* ws = args.ws;
    unsigned* ctl = (unsigned*)(ws + WS_CTL);
    const float* x = args.in[0]; const float* cvec = args.in[1]; const float* w_ada = args.in[2]; const float* b_ada = args.in[3]; const float* g_mix = args.in[4];
    const float* w_in = args.in[5]; const float* rel_bias = args.in[6]; const float* pool_w = args.in[7]; const float* pool_scale = args.in[8]; const float* w_out = args.in[9];
    const float* g_ffn = args.in[10]; const float* peer_wq = args.in[11]; const float* peer_sk = args.in[12]; const float* peer_u = args.in[13]; const float* peer_v = args.in[14];
    const float* g_final = args.in[15];
    float* out = args.out;
    float* MODV = (float*)(ws + WS_MODV); float* MODP = (float*)(ws + WS_MODP);
    bf16* SKT = (bf16*)(ws + WS_SKT); bf16* PWS = (bf16*)(ws + WS_PWS); bf16* WQST = (bf16*)(ws + WS_WQST); bf16* WOUT2 = (bf16*)(ws + WS_WOUT2); bf16* WINT = (bf16*)(ws + WS_WINT);
    bf16* WOPT = (bf16*)(ws + WS_WOPT); bf16* WQB = (bf16*)(ws + WS_WQB);
    unsigned char* UB = ws + WS_UB; unsigned char* VB = ws + WS_VB; float* SCL = (float*)(ws + WS_SCL); bf16* H = (bf16*)(ws + WS_H); bf16* PROJ = (bf16*)(ws + WS_PROJ); bf16* MIXIN = (bf16*)(ws + WS_MIXIN);
    bf16* O0 = (bf16*)(ws + WS_O0); bf16* O1 = (bf16*)(ws + WS_O1); float* LSE = (float*)(ws + WS_LSE);
    float* SC = (float*)(ws + WS_SC);
    bf16* X1B = (bf16*)(ws + WS_O0);
    bf16* YB = (bf16*)(ws + WS_PROJ);

    for (int u = tid; u < (LDS_BYTES - LDSCTL_OFF) / 4; u += NWAVES * 64) ((LAS unsigned*)(lds + LDSCTL_OFF))[u] = 0u;
    __syncthreads();
    XcdBarrier bar; bar.bar = ctl + CW_BAR; bar.x = 0; bar.st = nullptr;
    if (MK_N_LAUNCHES != PER_PHASE) bar = xcd_barrier_post(ctl + CW_BAR, MISC + 8);
#define GRID_BAR() do { if (MK_N_LAUNCHES != PER_PHASE) xcd_barrier(bar); } while (0)
    const unsigned phmask = args.mask;
#ifndef PH_MASK
#define PH_MASK 0x1ff
#endif
#define IN(k) ((((PH_MASK) >> (k)) & 1) && ((phmask >> (k)) & 1u))
#define BOTH(k) (IN(k) && IN((k) + 1))

    if (IN(0)) {
        LAS float* silu = (LAS float*)(lds + RING_OFF);
        for (int i = tid; i < BATCH * DM; i += NWAVES * 64) { const float v = cvec[i]; silu[i] = v / (1.0f + __expf(-v)); }
        __syncthreads();
        for (int task = gw; task < (NMOD / 256) * KS_ADA; task += NGW) {
            const int cg = task % (NMOD / 256), ks = task / (NMOD / 256); const int k0 = ks * (DM / KS_ADA), n0 = cg * 256 + 4 * lane;
            f32x4 a0 = {0.f, 0.f, 0.f, 0.f}, a1 = {0.f, 0.f, 0.f, 0.f};
            const float* wp = w_ada + (size_t)k0 * NMOD + n0;
#pragma unroll 8
            for (int kk = 0; kk < DM / KS_ADA; ++kk) { const f32x4 w4 = *(const f32x4*)(wp + (size_t)kk * NMOD); const float s0 = silu[k0 + kk], s1 = silu[DM + k0 + kk]; a0 += w4 * s0; a1 += w4 * s1; }
            *(f32x4*)(MODP + ((size_t)(ks * 2 + 0)) * NMOD + n0) = a0; *(f32x4*)(MODP + ((size_t)(ks * 2 + 1)) * NMOD + n0) = a1;
        }
        __syncthreads();
        {
            LAS float* scr = (LAS float*)(lds + RING_OFF + wave * 16384);
            constexpr int I_IN = (DM / 64) * (INW / 32), I_OUTH = (ATTW / 64) * (DM / 32);
            constexpr int NITEMS = I_IN + 2 * I_OUTH;
            for (int it = gw; it < NITEMS; it += NGW) {
                int r = it;
                if (r < I_IN) { p0_transpose_item(w_in, DM, INW, WINT, DM, scr, r, lane); continue; } r -= I_IN;
                if (r < I_OUTH) { p0_transpose_item(w_out, ATTW, DM, WOUT2, DM, scr, r, lane); continue; } r -= I_OUTH;
                p0_transpose_item(w_out + (size_t)ATTW * DM, POOLW, DM, WOPT, POOLW, scr, r, lane);
            }
        }
        for (int i = gw * 64 + lane; i < (DM * PQ + 4 * 512 * 512) / 8; i += NGW * 64) {
            const bool isQ = i < DM * PQ / 8; const int j = isQ ? i : i - DM * PQ / 8;
            const float* src = (isQ ? peer_wq : pool_w) + (size_t)j * 8;
            f32x4 a = *(const f32x4*)src, c = *(const f32x4*)(src + 4);
            if (!isQ) { const int e0 = j * 8; const int gi = e0 >> 18, d0 = e0 & 511; const float* ps = pool_scale + gi * 512 + d0; a = a * *(const f32x4*)ps; c = c * *(const f32x4*)(ps + 4); }
            v4u w; w.x = cvt_pk_bf16(a[0], a[1]); w.y = cvt_pk_bf16(a[2], a[3]); w.z = cvt_pk_bf16(c[0], c[1]); w.w = cvt_pk_bf16(c[2], c[3]);
            *(v4u*)((isQ ? WQB : PWS) + (size_t)j * 8) = w;
        }
        for (int r = gw; r < 2 * NEXP; r += NGW) {
            const bool isU = r < NEXP; const int e = isU ? r : r - NEXP;
            const float* src = (isU ? peer_u : peer_v) + (size_t)e * DM + 16 * lane;
            f32x4 v[4][4]; float mx = 0.f;
#pragma unroll
            for (int i = 0; i < 4; ++i)
#pragma unroll
                for (int q = 0; q < 4; ++q) { v[i][q] = *(const f32x4*)(src + 1024 * i + 4 * q);
                    mx = fmaxf(mx, fmaxf(fmaxf(fabsf(v[i][q][0]), fabsf(v[i][q][1])), fmaxf(fabsf(v[i][q][2]), fabsf(v[i][q][3])))); }
#pragma unroll
            for (int o = 1; o < 64; o <<= 1) mx = fmaxf(mx, __shfl_xor(mx, o));
            const int ex = (int)((__float_as_uint(mx) >> 23) & 0xffu);
            float scale = 1.0f, inv = 1.0f;
            if (ex >= 32 && ex <= 230) { scale = __uint_as_float((unsigned)(261 - ex) << 23); inv = __uint_as_float((unsigned)(ex - 7) << 23); }
            unsigned char* dst = (isU ? UB : VB) + ((size_t)(lane >> 3) * NEXP + e) * 128 + 16 * (lane & 7);
#pragma unroll
            for (int i = 0; i < 4; ++i) { v4u w;
#pragma unroll
                for (int q = 0; q < 4; ++q) { int pk = 0; pk = __builtin_amdgcn_cvt_pk_fp8_f32(v[i][q][0] * scale, v[i][q][1] * scale, pk, false);
                    pk = __builtin_amdgcn_cvt_pk_fp8_f32(v[i][q][2] * scale, v[i][q][3] * scale, pk, true); w[q] = (unsigned)pk; }
                *(v4u*)(dst + (size_t)(8 * i) * NEXP * 128) = w; }
            if (lane == 0) SCL[r] = inv;
        }
        for (int i = gw * 64 + lane; i < 2048 * 32; i += NGW * 64) {
            const int n = i >> 5, kc = (i & 31) * 8; const int p = (n >> 7) & 1, pp = kc >> 7;
            v4u w = {0u, 0u, 0u, 0u};
            if (p == pp) { const float* src = peer_sk + (size_t)n * 128 + (kc & 127); const f32x4 a = *(const f32x4*)src, c = *(const f32x4*)(src + 4);
                w.x = cvt_pk_bf16(a[0], a[1]); w.y = cvt_pk_bf16(a[2], a[3]); w.z = cvt_pk_bf16(c[0], c[1]); w.w = cvt_pk_bf16(c[2], c[3]); }
            *(v4u*)(SKT + (size_t)n * 256 + kc) = w;
        }
        if (BOTH(0)) GRID_BAR();
    }

    if (IN(1)) {
        for (int i = bx * (NWAVES * 64) + tid; i < BATCH * NMOD; i += G * NWAVES * 64) {
            const int b = i / NMOD, n = i % NMOD; float s = b_ada[n];
#pragma unroll 8
            for (int ks = 0; ks < KS_ADA; ++ks) s += MODP[(size_t)(ks * 2 + b) * NMOD + n];
            const int j = n / DM, c = n % DM;
            MODV[(size_t)(j * 2 + b) * DM + c] = s;
        }
        if (bx < G / 2) {
            pg8::Gemm g{WOPT, PWS, DM, POOLW, 512, POOLW, 512, 2, 512, 1 << 30, 0}; pg8::StaticOrder S; S.init(DM, POOLW, G / 2, bx);
            pg8::EpiBf16 E{WOUT2 + ATTW, DM, 0, 1.0f};
            pg8::gemm_phase<pg8::EpiBf16, pg8::StaticOrder, true>(lds + RING_OFF, g, S, E);
        }
        else {
            pg8::Gemm g{SKT, WQB, PQ, DM, 256, 256, PQ, 1 << 30, 0, 1, 256}; pg8::StaticOrder S; S.init(PQ, DM, G - G / 2, bx - G / 2);
            pg8::EpiBf16 E{WQST, DM, 0, 1.0f};
            pg8::gemm_phase<pg8::EpiBf16, pg8::StaticOrder, true>(lds + RING_OFF, g, S, E);
        }
        if (BOTH(1)) GRID_BAR();
    }

    if (IN(2)) {
        for (int row = gw; row < M; row += NGW) {
            const int b = row / SEQ;
            const f32x4* xr = (const f32x4*)(x + (size_t)row * DM) + lane;
            f32x4 v[16]; float ss = 0.f;
#pragma unroll
            for (int j = 0; j < 16; ++j) { v[j] = xr[64 * j]; ss += (v[j][0] * v[j][0] + v[j][1] * v[j][1]) + (v[j][2] * v[j][2] + v[j][3] * v[j][3]); }
            const float rstd = 1.0f / sqrtf(wave_sum(ss) * (1.0f / DM) + RMS_EPS);
            const f32x4* gp = (const f32x4*)g_mix + lane; const f32x4* shp = (const f32x4*)(MODV + (size_t)(0 * 2 + b) * DM) + lane; const f32x4* scp = (const f32x4*)(MODV + (size_t)(1 * 2 + b) * DM) + lane;
            v2u* op = (v2u*)(H + (size_t)row * DM) + lane;
#pragma unroll
            for (int j = 0; j < 16; ++j) { const f32x4 g4 = gp[64 * j], sh = shp[64 * j], sc = scp[64 * j];
                const f32x4 y = (v[j] * rstd) * g4 * (sc + 1.0f) + sh;
                v2u w; w.x = cvt_pk_bf16(y[0], y[1]); w.y = cvt_pk_bf16(y[2], y[3]); op[64 * j] = w; }
        }
        if (BOTH(2)) GRID_BAR();
    }

    if (IN(3)) {
        pg8::Gemm g{H, WINT, M, INW, DM, DM, DM, 1 << 30, 0, 1 << 30, 0}; pg8::StaticOrder S; S.init(M, INW, G, bx);
        pg8::EpiBf16 E{PROJ, INW, ATTW, QSCALE};
        pg8::gemm_phase<pg8::EpiBf16, pg8::StaticOrder, true>(lds + RING_OFF, g, S, E);
        if (BOTH(3)) GRID_BAR();
    }

    if (IN(4)) {
        LAS float* btab = (LAS float*)(lds + SHARED_OFF);
        LAS unsigned char* vt = lds + RING_OFF + wave * ATT_WAVE_BYTES;
        if (!(args.pad & 1u))
        for (int unit = bx; unit < BATCH * NH * (SEQ / 1024); unit += G) {
            const int b = unit >> 7, h = (unit >> 3) & 15, mt = unit & 7;
            __syncthreads();
            for (int i = tid; i < 3 * 256; i += NWAVES * 64) { const int gi = i >> 8, ri = (i & 255) - 32; const int dil = gi == 0 ? 1 : (gi == 1 ? 4 : 16);
                btab[i] = (ri >= 0 && ri <= 128) ? rel_bias[t5_bucket((ri - 64) * dil) * NH + h] * LOG2E : -1e30f; }
            __syncthreads();
            for (int g = 0; g < 3; ++g) {
                if (g == 2) { VM_WAIT(); __syncthreads(); }
                for (int tk = wave; tk < 32; tk += NWAVES) attn_task(g, PROJ, O0, O1, LSE, LSE + (size_t)M * NH, MIXIN, btab, vt, b, h, mt, tk, lane);
            }
        }
        if (!(args.pad & 2u))
        for (int i = bx * (NWAVES * 64) + tid; i < BATCH * (SEQ / 8) * (POOLW / 8); i += G * NWAVES * 64) {
            const int cc = i & 255, run = (i >> 8) & (SEQ / 8 - 1), b = i >> 18; const int gi = __builtin_amdgcn_readfirstlane(cc >> 6);
            const int pos0 = run * 8;
            const bf16* base = PROJ + (size_t)b * SEQ * INW + 3 * ATTW + cc * 8;
            bf16* obase = MIXIN + ((size_t)b * SEQ + pos0) * DM + ATTW + cc * 8;
#define POOL_RUN(HW) do { constexpr int NR = 8 + 2 * (HW) - 1; v4u w_[NR]; \
                _Pragma("unroll") for (int q = 0; q < NR; ++q) { const int pp = pos0 - (HW) + q; const int pc = pp < 0 ? 0 : (pp > SEQ - 1 ? SEQ - 1 : pp); w_[q] = *(const v4u*)(base + (size_t)pc * INW); } \
                _Pragma("unroll") for (int q = 0; q < NR; ++q) { const int pp = pos0 - (HW) + q; if (pp < 0 || pp >= SEQ) w_[q] = (v4u){0u, 0u, 0u, 0u}; } \
                float s_[8] = {0.f, 0.f, 0.f, 0.f, 0.f, 0.f, 0.f, 0.f}; \
                _Pragma("unroll") for (int q = 0; q < 2 * (HW) - 1; ++q) { s_[0] += bf_lo(w_[q].x); s_[1] += bf_hi(w_[q].x); s_[2] += bf_lo(w_[q].y); s_[3] += bf_hi(w_[q].y); s_[4] += bf_lo(w_[q].z); s_[5] += bf_hi(w_[q].z); s_[6] += bf_lo(w_[q].w); s_[7] += bf_hi(w_[q].w); } \
                _Pragma("unroll") for (int k = 0; k < 8; ++k) { const v4u in_ = w_[k + 2 * (HW) - 1]; \
                    s_[0] += bf_lo(in_.x); s_[1] += bf_hi(in_.x); s_[2] += bf_lo(in_.y); s_[3] += bf_hi(in_.y); s_[4] += bf_lo(in_.z); s_[5] += bf_hi(in_.z); s_[6] += bf_lo(in_.w); s_[7] += bf_hi(in_.w); \
                    const int pos = pos0 + k; const int lo_ = pos - (HW) < 0 ? 0 : pos - (HW), hi_ = pos + (HW) > SEQ ? SEQ : pos + (HW); const float inv = 1.0f / (float)(hi_ - lo_); \
                    const v4u me = w_[k + (HW)]; v4u o_; \
                    o_.x = cvt_pk_bf16(s_[0] * inv - bf_lo(me.x), s_[1] * inv - bf_hi(me.x)); o_.y = cvt_pk_bf16(s_[2] * inv - bf_lo(me.y), s_[3] * inv - bf_hi(me.y)); \
                    o_.z = cvt_pk_bf16(s_[4] * inv - bf_lo(me.z), s_[5] * inv - bf_hi(me.z)); o_.w = cvt_pk_bf16(s_[6] * inv - bf_lo(me.w), s_[7] * inv - bf_hi(me.w)); \
                    *(v4u*)(obase + (size_t)k * DM) = o_; \
                    const v4u out_ = w_[k]; \
                    s_[0] -= bf_lo(out_.x); s_[1] -= bf_hi(out_.x); s_[2] -= bf_lo(out_.y); s_[3] -= bf_hi(out_.y); s_[4] -= bf_lo(out_.z); s_[5] -= bf_hi(out_.z); s_[6] -= bf_lo(out_.w); s_[7] -= bf_hi(out_.w); } } while (0)
            if (gi == 0) POOL_RUN(1); else if (gi == 1) POOL_RUN(2); else if (gi == 2) POOL_RUN(4); else POOL_RUN(8);
#undef POOL_RUN
        }
        if (BOTH(4)) GRID_BAR();
    }

    if (IN(5)) {
        pg8::Gemm g{MIXIN, WOUT2, M, DM, DM, DM, DM, 1 << 30, 0, 1 << 30, 0}; pg8::StaticOrder S; S.init(M, DM, G, bx);
        pg8::EpiResBf16 E{x, MODV + (size_t)(2 * 2) * DM, X1B, DM};
        pg8::gemm_phase<pg8::EpiResBf16, pg8::StaticOrder, true>(lds + RING_OFF, g, S, E);
        if (BOTH(5)) GRID_BAR();
    }

    if (IN(6)) {
        for (int row = gw; row < M; row += NGW) {
            const int b = row / SEQ;
            const v2u* xr = (const v2u*)(X1B + (size_t)row * DM) + lane;
            f32x4 v[16]; float ss = 0.f;
#pragma unroll
            for (int j = 0; j < 16; ++j) { const v2u xw = xr[64 * j]; v[j] = (f32x4){bf_lo(xw.x), bf_hi(xw.x), bf_lo(xw.y), bf_hi(xw.y)}; ss += (v[j][0] * v[j][0] + v[j][1] * v[j][1]) + (v[j][2] * v[j][2] + v[j][3] * v[j][3]); }
            const float rstd = 1.0f / sqrtf(wave_sum(ss) * (1.0f / DM) + RMS_EPS);
            const f32x4* gp = (const f32x4*)g_ffn + lane; const f32x4* shp = (const f32x4*)(MODV + (size_t)(3 * 2 + b) * DM) + lane; const f32x4* scp = (const f32x4*)(MODV + (size_t)(4 * 2 + b) * DM) + lane;
            v2u* op = (v2u*)(H + (size_t)row * DM) + lane;
#pragma unroll
            for (int j = 0; j < 16; ++j) { const f32x4 g4 = gp[64 * j], sh = shp[64 * j], sc = scp[64 * j];
                const f32x4 y = (v[j] * rstd) * g4 * (sc + 1.0f) + sh;
                v2u w; w.x = cvt_pk_bf16(y[0], y[1]); w.y = cvt_pk_bf16(y[2], y[3]); op[64 * j] = w; }
        }
        if (BOTH(6)) GRID_BAR();
    }

    if (IN(7)) {
        pg8::Gemm g{H, WQST, M, PQ, DM, DM, DM, 1 << 30, 0, 1 << 30, 0}; pg8::StaticOrder S; S.init(M, PQ, G, bx);
        pg8::EpiF32 E{SC, PQ};
        pg8::gemm_phase<pg8::EpiF32, pg8::StaticOrder, true>(lds + RING_OFF, g, S, E);
        if (BOTH(7)) GRID_BAR();
    }

    if (IN(8)) {
        LAS unsigned short* EXPW = (LAS unsigned short*)(lds + RING_OFF);
        LAS float* GACT = (LAS float*)(lds + RING_OFF + 16384);
        LAS unsigned* W = (LAS unsigned*)(lds + RING_OFF + 49152 + wave * 4096);
        LAS unsigned* K1 = W; LAS unsigned* K2 = W + 128;
        LAS float* TV1 = (LAS float*)(W + 256); LAS int* TI1 = (LAS int*)(W + 272); LAS float* TV2 = (LAS float*)(W + 288); LAS int* TI2 = (LAS int*)(W + 304);
        LAS unsigned* CK = W + 320; LAS float* SV = (LAS float*)(W + 384); LAS int* SE = (LAS int*)(W + 400);
        const int c8 = lane & 7, r8 = lane >> 3;
        for (int blk = vcu; blk < M / 64; blk += G) {
            const int tok0 = blk * 64; const int b = tok0 / SEQ;
            for (int j = 0; j < 8; ++j) {
                const int tl = wave * 8 + j; const int t = tok0 + tl;
#ifndef TOPK_REP
#define TOPK_REP 1
#endif
                for (int hh = 0; hh < 8 * TOPK_REP; ++hh) { const int h = hh & 7;
                    const float* sp = SC + (size_t)t * PQ + h * 256;
                    const float a0 = sp[lane], a1 = sp[64 + lane], b0 = sp[128 + lane], b1 = sp[192 + lane];
                    unsigned ka0 = (fkey(a0) & ~127u) | (unsigned)(127 - lane), ka1 = (fkey(a1) & ~127u) | (unsigned)(63 - lane);
                    unsigned kb0 = (fkey(b0) & ~127u) | (unsigned)(127 - lane), kb1 = (fkey(b1) & ~127u) | (unsigned)(63 - lane);
                    bitonic128x2(ka0, ka1, kb0, kb1, lane);
                    if (lane >= 56) { K1[127 - 2 * lane] = ka0; K1[126 - 2 * lane] = ka1; K2[127 - 2 * lane] = kb0; K2[126 - 2 * lane] = kb1; }
                    LDS_WAIT();
                    const int ci_i = CAND_I[lane], ci_j = CAND_J[lane];
                    const unsigned kA = K1[ci_i], kB = K2[ci_j];
                    const float cv = fdec(kA) + fdec(kB);
                    const unsigned ck = lane < 50 ? ((fkey(cv) & ~255u) | (unsigned)(255 - (ci_i * 16 + ci_j))) : 0u;
                    CK[lane] = ck;
                    LDS_WAIT();
                    int rc = 0;
#pragma unroll 8
                    for (int kk = 0; kk < 16; ++kk) { const v4u q = ((const LAS v4u*)CK)[kk]; rc += (q.x > ck) + (q.y > ck) + (q.z > ck) + (q.w > ck); }
                    if (lane < 50 && rc < 16) { SV[rc] = cv; SE[rc] = (int)((127u - (kA & 127u)) * 128u + (127u - (kB & 127u))); }
                    LDS_WAIT();
                    const float top0 = SV[0], myv = SV[lane & 15]; const int mye = SE[lane & 15];
                    const float e = __expf(myv - top0);
                    float ssum = e; ssum += __shfl_xor(ssum, 1); ssum += __shfl_xor(ssum, 2); ssum += __shfl_xor(ssum, 4); ssum += __shfl_xor(ssum, 8);
                    if (lane < 16) { EXPW[tl * 128 + h * 16 + lane] = (unsigned short)mye; GACT[tl * 128 + h * 16 + lane] = e / ssum; }
                    LDS_WAIT();
                }
            }
            LAS float* ACC = (LAS float*)(lds + RING_OFF + 81920);
            for (int i = lane; i < 8 * 128; i += 64) ACC[wave * 1024 + i] = 0.f;
            LDS_WAIT();
            {
                v4u gn[16]; v4u hna, hnb;
#define P10_LOADU(idx) do { const int s_ = (idx) >> 3, j_ = (idx) & 7; const int tl_ = wave * 8 + j_; \
                    const unsigned char* tb_ = UB + (size_t)s_ * NEXP * 128 + 16 * c8; \
                    const v4u* hp_ = (const v4u*)(H + (size_t)(tok0 + tl_) * DM + 128 * s_ + 16 * c8); hna = hp_[0]; hnb = hp_[1]; \
                    _Pragma("unroll") for (int i = 0; i < 16; ++i) { const unsigned e_ = EXPW[tl_ * 128 + r8 + 8 * i]; gn[i] = *(const v4u*)(tb_ + (size_t)e_ * 128); } } while (0)
                P10_LOADU(0);
#pragma unroll 1
                for (int idx = 0; idx < 256; ++idx) {
                    v4u g[16]; const v4u ha = hna, hb = hnb;
#pragma unroll
                    for (int i = 0; i < 16; ++i) g[i] = gn[i];
                    if (idx + 1 < 256) P10_LOADU(idx + 1);
                    const int tl = wave * 8 + (idx & 7);
                    f32x2 hs[8];
                    hs[0] = (f32x2){bf_lo(ha.x), bf_hi(ha.x)}; hs[1] = (f32x2){bf_lo(ha.y), bf_hi(ha.y)}; hs[2] = (f32x2){bf_lo(ha.z), bf_hi(ha.z)}; hs[3] = (f32x2){bf_lo(ha.w), bf_hi(ha.w)};
                    hs[4] = (f32x2){bf_lo(hb.x), bf_hi(hb.x)}; hs[5] = (f32x2){bf_lo(hb.y), bf_hi(hb.y)}; hs[6] = (f32x2){bf_lo(hb.z), bf_hi(hb.z)}; hs[7] = (f32x2){bf_lo(hb.w), bf_hi(hb.w)};
                    float p[16];
#pragma unroll
                    for (int i = 0; i < 16; ++i) { f32x2 a2 = {0.f, 0.f};
#pragma unroll
                        for (int q = 0; q < 4; ++q) { a2 += __builtin_amdgcn_cvt_pk_f32_fp8((int)g[i][q], false) * hs[2 * q]; a2 += __builtin_amdgcn_cvt_pk_f32_fp8((int)g[i][q], true) * hs[2 * q + 1]; }
                        p[i] = a2.x + a2.y; }
                    float q8[8], q4[4], q2[2];
#pragma unroll
                    for (int m = 0; m < 8; ++m) { const float snd = (c8 & 4) ? p[m] : p[m + 8], kp = (c8 & 4) ? p[m + 8] : p[m]; q8[m] = kp + __shfl_xor(snd, 4); }
#pragma unroll
                    for (int m = 0; m < 4; ++m) { const float snd = (c8 & 2) ? q8[m] : q8[m + 4], kp = (c8 & 2) ? q8[m + 4] : q8[m]; q4[m] = kp + __shfl_xor(snd, 2); }
#pragma unroll
                    for (int m = 0; m < 2; ++m) { const float snd = (c8 & 1) ? q4[m] : q4[m + 2], kp = (c8 & 1) ? q4[m + 2] : q4[m]; q2[m] = kp + __shfl_xor(snd, 1); }
                    LAS float* ap = ACC + tl * 128 + r8 + 16 * c8;
                    ap[0] += q2[0]; ap[8] += q2[1];
                }
#undef P10_LOADU
            }
            LDS_WAIT();
            for (int i = lane; i < 8 * 128; i += 64) { const int o_ = wave * 1024 + i; const unsigned e = EXPW[o_];
                const float a = ACC[o_] * SCL[e]; GACT[o_] = gelu_tanh(a) * GACT[o_] * SCL[NEXP + e]; }
            LDS_WAIT();
            LAS float* SSQ = ACC;
            for (int j = 0; j < 8; ++j) SSQ[(wave * 8 + j) * 128 + lane] = 0.f;
            LDS_WAIT();
            const float* gtp = MODV + (size_t)(5 * 2 + b) * DM;
            {
                v4u gn[16]; float avn[16];
#define P10_LOADV(idx) do { const int s_ = (idx) >> 3, j_ = (idx) & 7; const int tl_ = wave * 8 + j_; \
                    const unsigned char* tb_ = VB + (size_t)s_ * NEXP * 128 + 16 * c8; \
                    _Pragma("unroll") for (int i = 0; i < 16; ++i) { const int k_ = tl_ * 128 + r8 + 8 * i; const unsigned e_ = EXPW[k_]; avn[i] = GACT[k_]; gn[i] = *(const v4u*)(tb_ + (size_t)e_ * 128); } } while (0)
                P10_LOADV(0);
#pragma unroll 1
                for (int idx = 0; idx < 256; ++idx) {
                    v4u g[16]; float av[16];
#pragma unroll
                    for (int i = 0; i < 16; ++i) { g[i] = gn[i]; av[i] = avn[i]; }
                    if (idx + 1 < 256) P10_LOADV(idx + 1);
                    const int s_c = idx >> 3; const int tl = wave * 8 + (idx & 7); const int t = tok0 + tl;
                    f32x2 o8[8];
#pragma unroll
                    for (int q = 0; q < 8; ++q) o8[q] = (f32x2){0.f, 0.f};
#pragma unroll
                    for (int i = 0; i < 16; ++i)
#pragma unroll
                        for (int q = 0; q < 4; ++q) { o8[2 * q] += __builtin_amdgcn_cvt_pk_f32_fp8((int)g[i][q], false) * av[i]; o8[2 * q + 1] += __builtin_amdgcn_cvt_pk_f32_fp8((int)g[i][q], true) * av[i]; }
                    float p[16], q8[8], q4[4], q2[2];
#pragma unroll
                    for (int q = 0; q < 8; ++q) { p[2 * q] = o8[q].x; p[2 * q + 1] = o8[q].y; }
#pragma unroll
                    for (int m = 0; m < 8; ++m) { const float snd = (r8 & 4) ? p[m] : p[m + 8], kp = (r8 & 4) ? p[m + 8] : p[m]; q8[m] = kp + __shfl_xor(snd, 32); }
#pragma unroll
                    for (int m = 0; m < 4; ++m) { const float snd = (r8 & 2) ? q8[m] : q8[m + 4], kp = (r8 & 2) ? q8[m + 4] : q8[m]; q4[m] = kp + __shfl_xor(snd, 16); }
#pragma unroll
                    for (int m = 0; m < 2; ++m) { const float snd = (r8 & 1) ? q4[m] : q4[m + 2], kp = (r8 & 1) ? q4[m + 2] : q4[m]; q2[m] = kp + __shfl_xor(snd, 8); }
                    const int d = 128 * s_c + 16 * c8 + 2 * r8;
                    const unsigned xw = __builtin_nontemporal_load((const unsigned*)(X1B + (size_t)t * DM + d)); const f32x2 gv = *(const f32x2*)(gtp + d);
                    f32x2 y; y.x = bf_lo(xw) + gv.x * q2[0]; y.y = bf_hi(xw) + gv.y * q2[1];
                    __builtin_nontemporal_store(cvt_pk_bf16(y.x, y.y), (unsigned*)(YB + (size_t)t * DM + d));
                    SSQ[tl * 128 + lane] += y.x * y.x + y.y * y.y;
                }
#undef P10_LOADV
            }
            VM_WAIT(); LDS_WAIT();
            __builtin_amdgcn_fence(__ATOMIC_ACQUIRE, "agent");
            VM_WAIT();
            for (int j = 0; j < 8; ++j) {
                const int tl = wave * 8 + j; const int t = tok0 + tl;
                const float rstd = 1.0f / sqrtf(wave_sum(SSQ[tl * 128 + lane]) * (1.0f / DM) + RMS_EPS);
                f32x4* op = (f32x4*)(out + (size_t)t * DM) + lane; const f32x4* gp = (const f32x4*)g_final + lane; const v2u* yp = (const v2u*)(YB + (size_t)t * DM) + lane;
#pragma unroll 4
                for (int i = 0; i < 16; ++i) { const v2u yw = __builtin_nontemporal_load(yp + 64 * i); const f32x4 y = {bf_lo(yw.x), bf_hi(yw.x), bf_lo(yw.y), bf_hi(yw.y)}; __builtin_nontemporal_store(y * rstd * gp[64 * i], op + 64 * i); }
            }
            LDS_WAIT();
        }
    }
#undef IN
#undef BOTH
#undef GRID_BAR
}

extern "C" void kernel_launch(void* const* d_in, const int* in_sizes, int n_in, void* d_out, int out_size, void* d_ws, size_t ws_size, hipStream_t stream) {
    static int grid = 0;
    if (grid == 0) {
        if (n_in != 16 || in_sizes[0] != M * DM || out_size != M * DM || ws_size < WS_END) {
            fprintf(stderr, "kernel_launch: shape/workspace mismatch: n_in %d in0 %d out %d ws %zu (need %zu)\n", n_in, n_in > 0 ? in_sizes[0] : -1, out_size, ws_size, (size_t)WS_END); grid = -1; return; }
        int dev = 0, cus = 0, per_cu = 0;
        if (hipGetDevice(&dev) != hipSuccess || hipDeviceGetAttribute(&cus, hipDeviceAttributeMultiprocessorCount, dev) != hipSuccess) { grid = -1; return; }
        if (hipFuncSetAttribute((const void*)fwd_kernel, hipFuncAttributeMaxDynamicSharedMemorySize, LDS_BYTES) != hipSuccess) { fprintf(stderr, "kernel_launch: hipFuncSetAttribute failed\n"); grid = -1; return; }
        if (hipOccupancyMaxActiveBlocksPerMultiprocessor(&per_cu, (const void*)fwd_kernel, NWAVES * 64, LDS_BYTES) != hipSuccess || per_cu < 1)
            fprintf(stderr, "kernel_launch: note: occupancy query reports %d workgroups per CU\n", per_cu);
        (void)hipGetLastError();
        grid = cus;
    }
    if (grid < 0) return;
    if (hipMemsetAsync((char*)d_ws + WS_CTL, 0, CTL_ZERO_BYTES, stream) != hipSuccess) { fprintf(stderr, "kernel_launch: memset failed\n"); return; }
    Args a{};
    for (int i = 0; i < 16; ++i) a.in[i] = (const float*)d_in[i];
    a.out = (float*)d_out; a.ws = (unsigned char*)d_ws;
#ifdef PROBE_MASK
    {
#ifndef PROBE_PAD
#define PROBE_PAD 0
#endif
        a.mask = PROBE_MASK; a.pad = PROBE_PAD;
        hipLaunchKernelGGL(fwd_kernel, dim3(grid), dim3(NWAVES * 64), LDS_BYTES, stream, a);
        (void)hipMemsetAsync((char*)d_ws + WS_CTL, 0, CTL_ZERO_BYTES, stream);
    }
#endif
    for (int li = 0; li < MK_N_LAUNCHES; ++li) {
        a.mask = (MK_N_LAUNCHES == PER_PHASE) ? (1u << li) : ((1u << PER_PHASE) - 1u); a.pad = 0;
        hipLaunchKernelGGL(fwd_kernel, dim3(grid), dim3(NWAVES * 64), LDS_BYTES, stream, a);
        const hipError_t le = hipPeekAtLastError();
        if (le != hipSuccess) { fprintf(stderr, "kernel_launch: launch %d failed: %s\n", li, hipGetErrorName(le)); break; }
    }
}
```

```cpp
#include <hip/hip_runtime.h>
#include <cstdio>
#include <cstdint>

#ifndef MK_N_LAUNCHES
#define MK_N_LAUNCHES 1
#endif

#define GAS __attribute__((address_space(1)))
#define LAS __attribute__((address_space(3)))
typedef unsigned short bf16;
typedef unsigned v4u __attribute__((ext_vector_type(4)));
typedef unsigned v2u __attribute__((ext_vector_type(2)));
typedef float f32x4 __attribute__((ext_vector_type(4)));
typedef float f32x2 __attribute__((ext_vector_type(2)));
typedef float f32x16 __attribute__((ext_vector_type(16)));
typedef short bf16x8 __attribute__((ext_vector_type(8)));
typedef short s16x4 __attribute__((ext_vector_type(4)));
typedef __bf16 bf2_t __attribute__((ext_vector_type(2)));

constexpr int BATCH = 2, SEQ = 8192, DM = 4096, M = BATCH * SEQ;
constexpr int NH = 16, HD = 128, ATTW = 2048, POOLW = 2048, INW = 8192;
constexpr int NMOD = 6 * DM;
constexpr int PQ = 2048;
constexpr int NEXP = 16384;
constexpr float RMS_EPS = 1e-6f;
constexpr float LOG2E = 1.4426950408889634f;
constexpr float QSCALE = 0.08838834764831845f * LOG2E;
constexpr float H8SCALE = 16.f, W8SCALE = 64.f;
constexpr int KS_ADA = 64;

constexpr size_t MiB = 1u << 20;
constexpr size_t WS_CTL = 0, CTL_ZERO_BYTES = 1 * MiB;
constexpr size_t WS_MODV = 1 * MiB;
constexpr size_t WS_SCL = 2 * MiB;
constexpr size_t WS_MODP = 4 * MiB;
constexpr size_t WS_SKT = 20 * MiB;
constexpr size_t WS_PWS = 22 * MiB;
constexpr size_t WS_WQST = 24 * MiB;
constexpr size_t WS_WOUT2 = 40 * MiB;
constexpr size_t WS_WINT = 72 * MiB;
constexpr size_t WS_WIN8 = 88 * MiB;
constexpr size_t WS_H8 = 1100 * MiB;
constexpr size_t WS_UB = 136 * MiB;
constexpr size_t WS_VB = 264 * MiB;
constexpr size_t WS_H = 392 * MiB;
constexpr size_t WS_PROJ = 520 * MiB;
constexpr size_t WS_QKVH = 1292 * MiB;
constexpr size_t WS_MIXIN = 776 * MiB;
constexpr size_t WS_WOPT = 904 * MiB;
constexpr size_t WS_WQB = 936 * MiB;
constexpr size_t WS_O0 = 968 * MiB, WS_O1 = 1032 * MiB;
constexpr size_t WS_LSE = 1096 * MiB;
constexpr size_t WS_SC = 1164 * MiB;
constexpr size_t WS_END = 1484 * MiB;

constexpr int RING_OFF = 0, RING_BYTES = 131072;
constexpr int ATT_WAVE_BYTES = 17408;
constexpr int SHARED_OFF = 139264;
constexpr int LDSCTL_OFF = 139264 + 4096, MISC_OFF = LDSCTL_OFF + 320;
constexpr int LDS_BYTES = 147456;
constexpr int NWAVES = 8;
constexpr int CW_BAR = 4096;

#define LDS_WAIT() asm volatile("s_waitcnt lgkmcnt(0)" ::: "memory")
#define VM_WAIT() asm volatile("s_waitcnt vmcnt(0)" ::: "memory")

__device__ __forceinline__ unsigned cvt_pk_bf16(float lo, float hi) { unsigned r; asm volatile("v_cvt_pk_bf16_f32 %0, %1, %2" : "=v"(r) : "v"(lo), "v"(hi)); return r; }
__device__ __forceinline__ float bf_lo(unsigned u) { return __uint_as_float(u << 16); }
__device__ __forceinline__ float bf_hi(unsigned u) { return __uint_as_float(u & 0xffff0000u); }
__device__ __forceinline__ float wave_sum(float v) {
#pragma unroll
    for (int o = 1; o < 64; o <<= 1) v += __shfl_xor(v, o);
    return v;
}

namespace pg8 {
typedef unsigned short bf16_t;
typedef int v4i_t __attribute__((ext_vector_type(4)));
typedef int v8i_t __attribute__((ext_vector_type(8)));
constexpr int BM = 256, BK = 64, HALF = 128, HTB = HALF * BK * 2, STAGE_BYTES = 8 * HTB, NXCD = 8, WGM = 8;

__host__ __device__ __forceinline__ int lds_byte(int r, int c) { const int st = (r >> 4) * 2 + (c >> 5), rr = r & 15, cc = c & 31, ob = rr * 64 + cc * 2; return st * 1024 + (ob ^ (((ob >> 9) & 1) << 5)); }
__host__ __device__ __forceinline__ void stage_rc(int b, int& R, int& C) { const int st = b / 1024, sb = b % 1024, swz = sb ^ (((sb >> 9) & 1) << 5); R = (st >> 1) * 16 + swz / 64; C = (st & 1) * 32 + (swz % 64) / 2; }
__host__ __device__ __forceinline__ int perm32(int rho) { const int n = rho >> 4, i = rho & 15; return 8 * (i >> 2) + 4 * n + (i & 3); }

template <int NF> __device__ __forceinline__ void pg8_ldfrag16(bf16x8 (&dst)[NF][2], const LAS unsigned char* base, int off) {
#pragma unroll
    for (int m = 0; m < NF; ++m)
#pragma unroll
        for (int k = 0; k < 2; ++k) dst[m][k] = *(const LAS bf16x8*)(base + off + m * 2048 + k * 1024);
}
template <int NF> __device__ __forceinline__ void pg8_ldfrag8(v8i_t (&dst)[NF], const LAS unsigned char* base, int off1, int off2) {
#pragma unroll
    for (int m = 0; m < NF; ++m) { const v4i_t lo = *(const LAS v4i_t*)(base + off1 + m * 2048), hi = *(const LAS v4i_t*)(base + off2 + m * 2048); dst[m] = __builtin_shufflevector(lo, hi, 0, 1, 2, 3, 4, 5, 6, 7); }
}
__device__ __forceinline__ void pg8_mma16(f32x4 (&acc)[4][2], const bf16x8 (&At)[4][2], const bf16x8 (&Bt)[2][2]) {
#pragma unroll
    for (int m = 0; m < 4; ++m)
#pragma unroll
        for (int n = 0; n < 2; ++n)
#pragma unroll
            for (int k = 0; k < 2; ++k) acc[m][n] = __builtin_amdgcn_mfma_f32_16x16x32_bf16(Bt[n][k], At[m][k], acc[m][n], 0, 0, 0);
}
__device__ __forceinline__ void pg8_mma8(f32x4 (&acc)[4][2], const v8i_t (&At)[4], const v8i_t (&Bt)[2]) {
    int sc = 0x7F7F7F7F;
#pragma unroll
    for (int m = 0; m < 4; ++m)
#pragma unroll
        for (int n = 0; n < 2; ++n) asm volatile("v_mfma_scale_f32_16x16x128_f8f6f4 %0, %1, %2, %0, %3, %3 op_sel_hi:[0,0,0]" : "+v"(acc[m][n]) : "v"(Bt[n]), "v"(At[m]), "v"(sc));
}
struct Unit { int pm, pn; };
struct Gemm { const bf16_t* A; const bf16_t* Bt; int M, N, K, lda, ldb, agrp_div, agrp_cols, bgrp_div, bgrp_cols; };

struct StaticOrder {
    int nM, nN, nwg, G, c;
    __host__ __device__ void init(int M_, int N_, int G_, int c_) { nM = M_ / BM; nN = N_ / BM; nwg = nM * nN; G = G_; c = c_; }
    __host__ __device__ bool next(int i, Unit& u) const {
        const long L = (long)i * G + c; if (L >= nwg) return false;
        int wgid = (int)L; { const int q = nwg / NXCD, r = nwg % NXCD, xcd = wgid % NXCD, off = wgid / NXCD; wgid = (xcd < r ? xcd * (q + 1) : r * (q + 1) + (xcd - r) * q) + off; }
        const int nig = WGM * nN, gid = wgid / nig, fm = gid * WGM, gsz = (nM - fm) < WGM ? (nM - fm) : WGM;
        u.pm = fm + ((wgid % nig) % gsz); u.pn = (wgid % nig) / gsz; return true;
    }
    __device__ __forceinline__ void a_ready(const Unit&) const {}
    __device__ __forceinline__ void done(const Unit&) const {}
};

struct EpiBf16 {
    static constexpr bool PERM = true, AFTER_DRAIN = false;
    bf16_t* O; int ldc; int scale_cols; float scale0; bf16_t* HM; int hm_cols; int hm_rows; float scale1 = 1.0f;
    __device__ __forceinline__ void operator()(const f32x4 (&acc)[2][2][4][2], const Unit& u, int wr, int wc, int fr, int fq) const {
        const int row0 = u.pm * BM + wr * 64 + fr; const int colt = u.pn * BM;
        const float sc = (colt < scale_cols) ? scale0 : scale1;
        const bool hm = colt < hm_cols;
        const int cw = wc * 32 + 8 * fq;
        bf16_t* base = hm ? HM + (size_t)(colt / HALF) * hm_rows * HALF + cw : O + (colt - hm_cols) + cw;
        const size_t rpitch = hm ? (size_t)HALF : (size_t)ldc, hstep = hm ? (size_t)hm_rows * HALF : (size_t)HALF;
#pragma unroll
        for (int ai = 0; ai < 2; ++ai)
#pragma unroll
            for (int m = 0; m < 4; ++m) { bf16_t* rowp = base + (size_t)(row0 + ai * HALF + m * 16) * rpitch;
#pragma unroll
                for (int bj = 0; bj < 2; ++bj) { f32x4 v0 = acc[ai][bj][m][0] * sc, v1 = acc[ai][bj][m][1] * sc;
                    v4u w; w.x = cvt_pk_bf16(v0[0], v0[1]); w.y = cvt_pk_bf16(v0[2], v0[3]); w.z = cvt_pk_bf16(v1[0], v1[1]); w.w = cvt_pk_bf16(v1[2], v1[3]);
                    *(v4u*)(rowp + bj * hstep) = w; } }
    }
};
struct EpiBf16ColScale {
    static constexpr bool PERM = true, AFTER_DRAIN = false;
    bf16_t* O; int ldc; int coff; const float* cs;
    __device__ __forceinline__ void operator()(const f32x4 (&acc)[2][2][4][2], const Unit& u, int wr, int wc, int fr, int fq) const {
        const int row0 = u.pm * BM + wr * 64 + fr; const int col0 = u.pn * BM + wc * 32 + 8 * fq;
        f32x4 sv[2][2];
#pragma unroll
        for (int bj = 0; bj < 2; ++bj)
#pragma unroll
            for (int n = 0; n < 2; ++n) sv[bj][n] = *(const f32x4*)(cs + col0 + bj * HALF + 4 * n);
#pragma unroll
        for (int ai = 0; ai < 2; ++ai)
#pragma unroll
            for (int m = 0; m < 4; ++m) { bf16_t* rowp = O + (size_t)(row0 + ai * HALF + m * 16) * ldc + coff + col0;
#pragma unroll
                for (int bj = 0; bj < 2; ++bj) { f32x4 v0 = acc[ai][bj][m][0] * sv[bj][0], v1 = acc[ai][bj][m][1] * sv[bj][1];
                    v4u w; w.x = cvt_pk_bf16(v0[0], v0[1]); w.y = cvt_pk_bf16(v0[2], v0[3]); w.z = cvt_pk_bf16(v1[0], v1[1]); w.w = cvt_pk_bf16(v1[2], v1[3]);
                    *(v4u*)(rowp + bj * HALF) = w; } }
    }
};
struct EpiResBf16 {
    static constexpr bool PERM = true, AFTER_DRAIN = false;
    const float* X; const float* gate; bf16_t* O; int ldc;
    __device__ __forceinline__ void operator()(const f32x4 (&acc)[2][2][4][2], const Unit& u, int wr, int wc, int fr, int fq) const {
        const int row0 = u.pm * BM + wr * 64 + fr; const int col0 = u.pn * BM + wc * 32 + 8 * fq; const int b = (u.pm * BM) / SEQ;
        f32x4 gv[2][2];
#pragma unroll
        for (int bj = 0; bj < 2; ++bj)
#pragma unroll
            for (int n = 0; n < 2; ++n) gv[bj][n] = *(const f32x4*)(gate + (size_t)b * DM + col0 + bj * HALF + 4 * n);
#pragma unroll
        for (int ai = 0; ai < 2; ++ai)
#pragma unroll
            for (int m = 0; m < 4; ++m) { const size_t off = (size_t)(row0 + ai * HALF + m * 16) * ldc + col0;
#pragma unroll
                for (int bj = 0; bj < 2; ++bj) { const f32x4 x0 = *(const f32x4*)(X + off + bj * HALF), x1 = *(const f32x4*)(X + off + bj * HALF + 4);
                    const f32x4 v0 = x0 + gv[bj][0] * acc[ai][bj][m][0], v1 = x1 + gv[bj][1] * acc[ai][bj][m][1];
                    v4u w; w.x = cvt_pk_bf16(v0[0], v0[1]); w.y = cvt_pk_bf16(v0[2], v0[3]); w.z = cvt_pk_bf16(v1[0], v1[1]); w.w = cvt_pk_bf16(v1[2], v1[3]);
                    *(v4u*)(O + off + bj * HALF) = w; } }
    }
};
struct EpiResF32 {
    static constexpr bool PERM = false, AFTER_DRAIN = false;
    const float* X; const float* gate; float* O; int ldc;
    __device__ __forceinline__ void operator()(const f32x4 (&acc)[2][2][4][2], const Unit& u, int wr, int wc, int fr, int fq) const {
        const int row0 = u.pm * BM + wr * 64 + fr; const int col0 = u.pn * BM + wc * 32 + 4 * fq; const int b = (u.pm * BM) / SEQ;
        f32x4 gv[2][2];
#pragma unroll
        for (int bj = 0; bj < 2; ++bj)
#pragma unroll
            for (int n = 0; n < 2; ++n) gv[bj][n] = *(const f32x4*)(gate + (size_t)b * DM + col0 + bj * HALF + n * 16);
#pragma unroll
        for (int ai = 0; ai < 2; ++ai)
#pragma unroll
            for (int m = 0; m < 4; ++m) { const size_t off = (size_t)(row0 + ai * HALF + m * 16) * ldc + col0;
#pragma unroll
                for (int bj = 0; bj < 2; ++bj)
#pragma unroll
                    for (int n = 0; n < 2; ++n) { const f32x4 xv = *(const f32x4*)(X + off + bj * HALF + n * 16);
                        *(f32x4*)(O + off + bj * HALF + n * 16) = xv + gv[bj][n] * acc[ai][bj][m][n]; } }
    }
};
struct EpiF32 {
    static constexpr bool PERM = false, AFTER_DRAIN = false;
    float* O; int ldc;
    __device__ __forceinline__ void operator()(const f32x4 (&acc)[2][2][4][2], const Unit& u, int wr, int wc, int fr, int fq) const {
        const int row0 = u.pm * BM + wr * 64 + fr; const int col0 = u.pn * BM + wc * 32 + 4 * fq;
#pragma unroll
        for (int ai = 0; ai < 2; ++ai)
#pragma unroll
            for (int m = 0; m < 4; ++m) { const size_t off = (size_t)(row0 + ai * HALF + m * 16) * ldc + col0;
#pragma unroll
                for (int bj = 0; bj < 2; ++bj)
#pragma unroll
                    for (int n = 0; n < 2; ++n) *(f32x4*)(O + off + bj * HALF + n * 16) = acc[ai][bj][m][n]; }
    }
};

template <class Epi, class Sched, bool ALIGN_EPI, bool FP8 = false>
__device__ __forceinline__ void gemm_phase(LAS unsigned char* lds, const Gemm g, const Sched& S, const Epi& E) {
    int tid_ = threadIdx.x; asm volatile("" : "+v"(tid_));
    const int tid = tid_, wid = __builtin_amdgcn_readfirstlane(tid >> 6), lane = tid & 63, wr = wid >> 2, wc = wid & 3, fr = lane & 15, fq = lane >> 4;
    const int K = g.K, nt = K / BK;
    unsigned voffA, voffB;
    { int R, C; stage_rc(tid * 16, R, C); const int Rb = Epi::PERM ? ((R & ~31) + perm32(R & 31)) : R;
      voffA = (unsigned)(R * g.lda + C) * 2u; voffB = (unsigned)(Rb * g.ldb + C) * 2u; }
    const size_t pstepA = (size_t)64 * g.lda * 2, pstepB = (size_t)64 * g.ldb * 2;
    const size_t kstep = (size_t)(BK * 2);
    const size_t hstepA = (size_t)HALF * g.lda * 2, hstepB = (size_t)HALF * g.ldb * 2;
    const size_t tstepA = 2 * hstepA, tstepB = 2 * hstepB;
    const unsigned ldsw = (unsigned)wid * 1024u;
    const int aoff = lds_byte(wr * 64 + fr, fq * 8), boff = lds_byte(wc * 32 + fr, fq * 8);
    const int h8 = (fq >> 1) & 1;
    const int aoff1 = lds_byte(wr * 64 + fr, fq * 16 + h8 * 8), aoff2 = lds_byte(wr * 64 + fr, fq * 16 + (1 - h8) * 8);
    const int boff1 = lds_byte(wc * 32 + fr, fq * 16 + h8 * 8), boff2 = lds_byte(wc * 32 + fr, fq * 16 + (1 - h8) * 8);
#define PG8_SA(b, h) (((b) * 2 + (h)) * HTB)
#define PG8_SB(b, h) ((4 + (b) * 2 + (h)) * HTB)
#define PG8_STAGE(bufoff, gbase, voff) do { _Pragma("unroll") for (int _i = 0; _i < 2; ++_i) \
        __builtin_amdgcn_global_load_lds((const unsigned*)((const char*)(gbase) + (size_t)_i * pstep_##voff + (voff)), (LAS unsigned*)(lds + (bufoff) + ldsw + _i * 8192), 16, 0, 0); } while (0)
#define pstep_voffA pstepA
#define pstep_voffB pstepB
#define PG8_LDA(dst, b, h) do { if constexpr (FP8) pg8_ldfrag8<4>(dst##8, lds + PG8_SA(b, h), aoff1, aoff2); else pg8_ldfrag16<4>(dst, lds + PG8_SA(b, h), aoff); } while (0)
#define PG8_LDB(dst, b, h) do { if constexpr (FP8) pg8_ldfrag8<2>(dst##8, lds + PG8_SB(b, h), boff1, boff2); else pg8_ldfrag16<2>(dst, lds + PG8_SB(b, h), boff); } while (0)
#define PG8_MMA(ai, bj, At, Bt) do { __builtin_amdgcn_s_setprio(1); if constexpr (FP8) pg8_mma8(acc[ai][bj], At##8, Bt##8); else pg8_mma16(acc[ai][bj], At, Bt); __builtin_amdgcn_s_setprio(0); } while (0)
#define PG8_WAIT_V(n) asm volatile("s_waitcnt vmcnt(" #n ")" ::: "memory")
#define PG8_WAIT_L(n) asm volatile("s_waitcnt lgkmcnt(" #n ")" ::: "memory")
#define PG8_BAR __builtin_amdgcn_s_barrier()
#define PG8_SCHED __builtin_amdgcn_sched_barrier(0)
#define PG8_ABASE(u) ((const char*)g.A + (size_t)(u).pm * tstepA + (size_t)((u).pn / g.agrp_div) * (size_t)g.agrp_cols * 2)
#define PG8_BBASE(u) ((const char*)g.Bt + (size_t)(u).pn * tstepB + (size_t)((u).pm / g.bgrp_div) * (size_t)g.bgrp_cols * 2)
    Unit cur, nxt; int ui = 0;
    if (!S.next(0, cur)) return;
    f32x4 acc[2][2][4][2];
#pragma unroll
    for (int a = 0; a < 2; ++a)
#pragma unroll
        for (int b = 0; b < 2; ++b)
#pragma unroll
            for (int m = 0; m < 4; ++m)
#pragma unroll
                for (int n = 0; n < 2; ++n) acc[a][b][m][n] = (f32x4){0.f, 0.f, 0.f, 0.f};
    bf16x8 At[4][2], B0[2][2], B1[2][2]; v8i_t At8[4], B08[2], B18[2];
    const char* cA = PG8_ABASE(cur); const char* cB = PG8_BBASE(cur);
    S.a_ready(cur);
    PG8_STAGE(PG8_SB(0, 0), cB, voffB); PG8_STAGE(PG8_SB(0, 1), cB + hstepB, voffB); PG8_STAGE(PG8_SA(0, 0), cA, voffA); PG8_STAGE(PG8_SA(0, 1), cA + hstepA, voffA);
    if (wr == 1) PG8_BAR;
    PG8_WAIT_V(2); PG8_BAR;
    PG8_STAGE(PG8_SB(1, 0), cB + kstep, voffB); PG8_STAGE(PG8_SA(1, 0), cA + kstep, voffA); PG8_STAGE(PG8_SB(1, 1), cB + hstepB + kstep, voffB);
    PG8_WAIT_V(6); PG8_BAR;
    for (;;) {
        const bool has_next = S.next(ui + 1, nxt);
        const char* nA = has_next ? PG8_ABASE(nxt) : cA; const char* nB = has_next ? PG8_BBASE(nxt) : cB;
        for (int t = 0; t < nt; t += 2) {
            const bool last = (t == nt - 2);
            const char* a1 = cA + (size_t)(t + 1) * kstep;
            const char* a2 = last ? nA : cA + (size_t)(t + 2) * kstep; const char* b2 = last ? nB : cB + (size_t)(t + 2) * kstep;
            const char* a3 = a2 + kstep; const char* b3 = b2 + kstep;
            if (last && has_next) S.a_ready(nxt);
            PG8_LDB(B0, 0, 0); PG8_LDB(B1, 0, 1); PG8_SCHED; PG8_LDA(At, 0, 0); PG8_STAGE(PG8_SA(1, 1), a1 + hstepA, voffA);
            PG8_WAIT_V(8); PG8_WAIT_L(0); PG8_BAR; PG8_MMA(0, 0, At, B0); PG8_MMA(0, 1, At, B1); PG8_BAR; PG8_SCHED;
            PG8_LDA(At, 0, 1); PG8_STAGE(PG8_SB(0, 0), b2, voffB); PG8_STAGE(PG8_SB(0, 1), b2 + hstepB, voffB); PG8_STAGE(PG8_SA(0, 0), a2, voffA);
            PG8_WAIT_V(8); PG8_WAIT_L(0); PG8_BAR; PG8_MMA(1, 0, At, B0); PG8_MMA(1, 1, At, B1); PG8_BAR; PG8_SCHED;
            PG8_LDB(B0, 1, 0); PG8_LDB(B1, 1, 1); PG8_SCHED; PG8_LDA(At, 1, 0); PG8_STAGE(PG8_SA(0, 1), a2 + hstepA, voffA);
            PG8_WAIT_V(8); PG8_WAIT_L(0); PG8_BAR; PG8_MMA(0, 0, At, B0); PG8_MMA(0, 1, At, B1); PG8_BAR; PG8_SCHED;
            PG8_LDA(At, 1, 1); PG8_STAGE(PG8_SB(1, 0), b3, voffB); PG8_STAGE(PG8_SB(1, 1), b3 + hstepB, voffB); PG8_STAGE(PG8_SA(1, 0), a3, voffA);
            PG8_WAIT_V(8); PG8_WAIT_L(0); PG8_BAR; PG8_MMA(1, 0, At, B0); PG8_MMA(1, 1, At, B1); PG8_BAR; PG8_SCHED;
        }
        if constexpr (ALIGN_EPI) { if (wr == 0) PG8_BAR; }
        if constexpr (FP8) asm volatile("s_nop 15\n\ts_nop 15" ::: "memory");
        if constexpr (FP8) { int ln_ = lane; asm volatile("" : "+v"(ln_));
          E(acc, cur, wr, wc, ln_ & 15, ln_ >> 4); } else E(acc, cur, wr, wc, fr, fq);
        S.done(cur);
        if (!has_next) break;
#pragma unroll
        for (int a = 0; a < 2; ++a)
#pragma unroll
            for (int b = 0; b < 2; ++b)
#pragma unroll
                for (int m = 0; m < 4; ++m)
#pragma unroll
                    for (int n = 0; n < 2; ++n) acc[a][b][m][n] = (f32x4){0.f, 0.f, 0.f, 0.f};
        cur = nxt; cA = nA; cB = nB; ++ui;
        if constexpr (ALIGN_EPI) { if (wr == 1) PG8_BAR; }
    }
    PG8_WAIT_V(0);
    if constexpr (!ALIGN_EPI) { if (wr == 0) PG8_BAR; }
    PG8_BAR;
#undef PG8_SA
#undef PG8_SB
#undef PG8_STAGE
#undef pstep_voffA
#undef pstep_voffB
#undef PG8_LDA
#undef PG8_LDB
#undef PG8_MMA
#undef PG8_WAIT_V
#undef PG8_WAIT_L
#undef PG8_BAR
#undef PG8_SCHED
#undef PG8_ABASE
#undef PG8_BBASE
}
}

#define XB_TMO      128
#define XB_XCNT(j)  (256  + 64 * (j))
#define XB_XSUB(j)  (1280 + 64 * (j))
#define XB_XGEN(j)  (2304 + 64 * (j))
#define XB_TOP      3328
#define XB_TOPGEN   3392
#define XCD_BAR_WORDS 3456
#define XB_SPIN_CAP (1u << 18)

__device__ __forceinline__ unsigned xb_ld(unsigned* p)              { return __hip_atomic_load(p, __ATOMIC_RELAXED, __HIP_MEMORY_SCOPE_AGENT); }
__device__ __forceinline__ unsigned xb_add(unsigned* p, unsigned v) { return __hip_atomic_fetch_add(p, v, __ATOMIC_RELAXED, __HIP_MEMORY_SCOPE_AGENT); }
__device__ __forceinline__ unsigned xb_xcc_id() { return (unsigned)__builtin_amdgcn_s_getreg((3 << 11) | 20) & 0xFu; }
#define XB_SPIN(cond, bar) do { unsigned _sp = 0; while (cond) { __builtin_amdgcn_s_sleep(1); \
    if ((++_sp & 255u) == 0u) { if (xb_ld(&(bar)[XB_TMO])) break; if (_sp > XB_SPIN_CAP) { atomicAdd(&(bar)[XB_TMO], 1u); break; } } } } while (0)

struct XcdBarrier { unsigned* bar; unsigned x; volatile LAS unsigned* st; };

__device__ __forceinline__ XcdBarrier xcd_barrier_post(unsigned* bar, volatile LAS unsigned* st) {
    XcdBarrier b; b.bar = bar; b.x = xb_xcc_id(); b.st = st;
    if (threadIdx.x == 0) (void)xb_add(&bar[XB_XCNT(b.x)], 1u);
    return b;
}
__device__ __forceinline__ void xcd_barrier_complete(unsigned* bar, unsigned x, unsigned& nloc, unsigned& nx) {
    const unsigned G = gridDim.x * gridDim.y * gridDim.z;
    unsigned sum, cnt, mine, sp = 0u;
    for (;;) {
        sum = 0u; cnt = 0u; mine = 0u;
#pragma unroll
        for (unsigned j = 0; j < 16; ++j) { const unsigned c = xb_ld(&bar[XB_XCNT(j)]); sum += c; cnt += (c > 0u) ? 1u : 0u; mine = (j == x) ? c : mine; }
        if (sum == G) break;
        __builtin_amdgcn_s_sleep(1);
        if ((++sp & 255u) == 0u) { if (xb_ld(&bar[XB_TMO])) break; if (sp > XB_SPIN_CAP) { atomicAdd(&bar[XB_TMO], 1u); break; } }
    }
    nloc = mine > 0u ? mine : 1u; nx = cnt > 0u ? cnt : 1u;
}
__device__ __forceinline__ void xcd_barrier(const XcdBarrier& b) {
    asm volatile("s_waitcnt vmcnt(0)" ::: "memory");
    __syncthreads();
    if (threadIdx.x == 0) {
        unsigned* bar = b.bar;
        __builtin_amdgcn_s_waitcnt(0);
        unsigned nloc = b.st[0], nx = b.st[1];
        if (nloc == 0u) { xcd_barrier_complete(bar, b.x, nloc, nx); b.st[0] = nloc; b.st[1] = nx; }
        const unsigned old = xb_add(&bar[XB_XSUB(b.x)], 1u);
        const unsigned gen = old / nloc;
        if (old + 1u == (gen + 1u) * nloc) {
            __builtin_amdgcn_fence(__ATOMIC_RELEASE, "agent");
            asm volatile("s_waitcnt vmcnt(0)" ::: "memory");
            const unsigned og = xb_add(&bar[XB_TOP], 1u);
            const unsigned tg = og / nx;
            if (og + 1u == (tg + 1u) * nx) xb_add(&bar[XB_TOPGEN], 1u);
            else XB_SPIN(xb_ld(&bar[XB_TOPGEN]) == tg, bar);
            __builtin_amdgcn_fence(__ATOMIC_ACQUIRE, "agent");
            xb_add(&bar[XB_XGEN(b.x)], 1u);
            asm volatile("s_waitcnt vmcnt(0)" ::: "memory");
        } else {
            XB_SPIN(xb_ld(&bar[XB_XGEN(b.x)]) == gen, bar);
            __builtin_amdgcn_fence(__ATOMIC_ACQUIRE, "agent");
            asm volatile("s_waitcnt vmcnt(0)" ::: "memory");
        }
    }
    __syncthreads();
}

template <bool F8>
__device__ __forceinline__ void p0_transpose_item(const float* W, int ldw, int N, void* WTv, int ldt, float scale, LAS float* scr, int item, int lane) {
    const int nblk = N / 32, kb = item / nblk, nb = item % nblk, k0 = 64 * kb, n0 = 32 * nb;
#pragma unroll 8
    for (int i = 0; i < 32; ++i) { const int kk = 2 * i + (lane >> 5); scr[kk * 33 + (lane & 31)] = W[(size_t)(k0 + kk) * ldw + n0 + (lane & 31)]; }
    LDS_WAIT(); asm volatile("" ::: "memory");
    const int c = lane & 7;
#pragma unroll
    for (int j = 0; j < 4; ++j) { const int n = (lane >> 3) + 8 * j; const LAS float* s = scr + (8 * c) * 33 + n;
        if constexpr (F8) { int lo = 0, hi = 0;
            lo = __builtin_amdgcn_cvt_pk_fp8_f32(s[0 * 33] * scale, s[1 * 33] * scale, lo, false); lo = __builtin_amdgcn_cvt_pk_fp8_f32(s[2 * 33] * scale, s[3 * 33] * scale, lo, true);
            hi = __builtin_amdgcn_cvt_pk_fp8_f32(s[4 * 33] * scale, s[5 * 33] * scale, hi, false); hi = __builtin_amdgcn_cvt_pk_fp8_f32(s[6 * 33] * scale, s[7 * 33] * scale, hi, true);
            *(GAS v2u*)((unsigned char*)WTv + (size_t)(n0 + n) * ldt + k0 + 8 * c) = (v2u){(unsigned)lo, (unsigned)hi};
        } else {
            v4u o; o.x = cvt_pk_bf16(s[0 * 33], s[1 * 33]); o.y = cvt_pk_bf16(s[2 * 33], s[3 * 33]); o.z = cvt_pk_bf16(s[4 * 33], s[5 * 33]); o.w = cvt_pk_bf16(s[6 * 33], s[7 * 33]);
            *(GAS v4u*)((bf16*)WTv + (size_t)(n0 + n) * ldt + k0 + 8 * c) = o; } }
    LDS_WAIT(); asm volatile("" ::: "memory");
}

__device__ __forceinline__ int t5_bucket(int rel) {
    int n = -rel; const int ret = n < 0 ? 16 : 0; n = n < 0 ? -n : n;
    if (n < 8) return ret + n;
    const float v = logf((float)n / 8.0f) / logf(128.0f) * 8.0f;
    int large = 8 + (int)v; large = large < 15 ? large : 15;
    return ret + large;
}
__device__ __forceinline__ float gelu_tanh(float x) {
    const float z = 0.7978845608028654f * (x + 0.044715f * x * x * x);
    const float e = __expf(2.0f * z);
    const float t = 1.0f - 2.0f / (e + 1.0f);
    return 0.5f * x * (1.0f + t);
}
__device__ __forceinline__ unsigned fkey(float v) { const unsigned u = __float_as_uint(v); return (u >> 31) ? ~u : (u | 0x80000000u); }
__device__ __forceinline__ float fdec(unsigned key) { const unsigned k2 = key & ~127u; const unsigned u = (k2 >> 31) ? (k2 & 0x7fffffffu) : (~k2 & ~127u); return __uint_as_float(u); }
template <int LJ> __device__ __forceinline__ unsigned xshfl(unsigned x, const int lane) {
    if constexpr (LJ == 1) return (unsigned)__builtin_amdgcn_update_dpp(0, (int)x, 0xB1, 0xF, 0xF, false);
    else if constexpr (LJ == 2) return (unsigned)__builtin_amdgcn_update_dpp(0, (int)x, 0x4E, 0xF, 0xF, false);
    else if constexpr (LJ == 4) { const int y = __builtin_amdgcn_update_dpp(0, (int)x, 0x141, 0xF, 0xF, false); return (unsigned)__builtin_amdgcn_update_dpp(0, y, 0x1B, 0xF, 0xF, false); }
    else if constexpr (LJ == 8) { const int y = __builtin_amdgcn_update_dpp(0, (int)x, 0x140, 0xF, 0xF, false); return (unsigned)__builtin_amdgcn_update_dpp(0, y, 0x141, 0xF, 0xF, false); }
    else if constexpr (LJ == 16) return (unsigned)__builtin_amdgcn_ds_swizzle((int)x, 0x401F);
    else { const auto rr = __builtin_amdgcn_permlane32_swap(x, x, false, false); return lane < 32 ? rr[1] : rr[0]; }
}
template <int K, int J> __device__ __forceinline__ void bitonic_step(unsigned& a0, unsigned& a1, unsigned& b0, unsigned& b1, const int lane) {
    const bool asc = (K == 128) ? true : ((lane & (K >> 1)) == 0);
    if constexpr (J == 1) {
        const unsigned la = a0 < a1 ? a0 : a1, ha = a0 < a1 ? a1 : a0, lb = b0 < b1 ? b0 : b1, hb = b0 < b1 ? b1 : b0;
        a0 = asc ? la : ha; a1 = asc ? ha : la; b0 = asc ? lb : hb; b1 = asc ? hb : lb;
    } else {
        constexpr int LJ = J >> 1; const bool tmin = (((lane & LJ) == 0) == asc);
        const unsigned pa0 = xshfl<LJ>(a0, lane), pa1 = xshfl<LJ>(a1, lane), pb0 = xshfl<LJ>(b0, lane), pb1 = xshfl<LJ>(b1, lane);
        a0 = tmin ? (a0 < pa0 ? a0 : pa0) : (a0 < pa0 ? pa0 : a0); a1 = tmin ? (a1 < pa1 ? a1 : pa1) : (a1 < pa1 ? pa1 : a1);
        b0 = tmin ? (b0 < pb0 ? b0 : pb0) : (b0 < pb0 ? pb0 : b0); b1 = tmin ? (b1 < pb1 ? b1 : pb1) : (b1 < pb1 ? pb1 : b1);
    }
    if constexpr (J > 1) bitonic_step<K, (J >> 1)>(a0, a1, b0, b1, lane);
}
template <int K> __device__ __forceinline__ void bitonic_stage(unsigned& a0, unsigned& a1, unsigned& b0, unsigned& b1, const int lane) {
    bitonic_step<K, (K >> 1)>(a0, a1, b0, b1, lane);
    if constexpr (K < 128) bitonic_stage<(K << 1)>(a0, a1, b0, b1, lane);
}
__device__ __forceinline__ void bitonic128x2(unsigned& a0, unsigned& a1, unsigned& b0, unsigned& b1, const int lane) { bitonic_stage<2>(a0, a1, b0, b1, lane); }
__device__ __forceinline__ float dot2bf(unsigned a, unsigned b, float c) { return __builtin_amdgcn_fdot2_f32_bf16(__builtin_bit_cast(bf2_t, a), __builtin_bit_cast(bf2_t, b), c, false); }

constexpr int ATT_SLOT = 8704;
__device__ __forceinline__ int crow(int r, int hi) { return (r & 3) + 8 * (r >> 2) + 4 * hi; }

__device__ __forceinline__ void attn_task(const int G, const bf16* QKVH, bf16* O0, bf16* O1, float* LSE0, float* LSE1, bf16* MIXIN,
                                          const LAS float* btab, LAS unsigned char* wl, int b, int h, int mtile, int tk, int lane) {
    const int SH = 2 * G;
    const int L = SEQ >> SH, TPR = 32 >> SH;
    const int r32 = lane & 31, hi = lane >> 5;
    const int res = tk >> (5 - SH), l0 = ((mtile * 1024) >> SH) + 32 * (tk & (TPR - 1));
    const size_t rowbase = (size_t)b * SEQ;
    const int srow = lane >> 4, sch = lane & 15;
    const int rot = (tk & 1) ? 4 : 0;
#define ATT_JR(j) (((j) + rot) >= 5 ? ((j) + rot - 5) : ((j) + rot))
#define ATT_WAITV(n) asm volatile("s_waitcnt vmcnt(" #n ")" ::: "memory")
#define ATT_ISSUE(n) do { LAS unsigned char* sl_ = wl + ((n) & 1) * ATT_SLOT; const int jt_ = ATT_JR((n) < 5 ? (n) : (n) - 5); \
        _Pragma("unroll") for (int i_ = 0; i_ < 8; ++i_) { \
            const int key_ = (n) < 5 ? (4 * i_ + srow) : ((i_ & 3) + 4 * srow + 16 * (i_ >> 2)); \
            int lk_ = l0 - 64 + 32 * jt_ + key_; lk_ = lk_ < 0 ? 0 : (lk_ > L - 1 ? L - 1 : lk_); \
            const int ch_ = (n) < 5 ? (sch ^ (key_ & 7)) : sch; \
            const bf16* src_ = QKVH + ((size_t)(((n) < 5 ? NH : 2 * NH) + h) * M + rowbase + ((size_t)lk_ << SH) + res) * HD + ch_ * 8; \
            __builtin_amdgcn_global_load_lds((const unsigned*)src_, (LAS unsigned*)(sl_ + i_ * ((n) < 5 ? 1024 : 1088)), 16, 0, 0); } } while (0)
    const size_t qrow = rowbase + ((size_t)(l0 + r32) << SH) + res;
    bf16x8 qr[8];
    { const bf16* qp = QKVH + ((size_t)h * M + qrow) * HD + hi * 8;
#pragma unroll
      for (int d0 = 0; d0 < 8; ++d0) qr[d0] = *(const bf16x8*)(qp + d0 * 16); }
    ATT_ISSUE(0); ATT_ISSUE(1);
    f32x16 p[5];
#define ATT_KTILE(n) do { LAS unsigned char* sl_ = wl + ((n) & 1) * ATT_SLOT + r32 * 256; f32x16 s_ = {}; \
        _Pragma("unroll") for (int d0 = 0; d0 < 8; ++d0) { const bf16x8 a_ = *(const LAS bf16x8*)(sl_ + (((2 * d0 + hi) ^ (r32 & 7)) << 4)); s_ = __builtin_amdgcn_mfma_f32_32x32x16_bf16(a_, qr[d0], s_, 0, 0, 0); } \
        p[n] = s_; asm volatile("" ::: "memory"); } while (0)
    ATT_WAITV(8); ATT_KTILE(0); ATT_ISSUE(2);
    ATT_WAITV(8); ATT_KTILE(1); ATT_ISSUE(3);
    ATT_WAITV(8); ATT_KTILE(2); ATT_ISSUE(4);
    ATT_WAITV(8); ATT_KTILE(3); ATT_ISSUE(5);
    ATT_WAITV(8); ATT_KTILE(4); ATT_ISSUE(6);
    float mx = -1e30f;
    const bool edge = (l0 - 64 < 0) || (l0 + 96 > L);
    const LAS float* bt = btab + G * 256 + 32 + 4 * hi - r32;
#pragma unroll
    for (int j = 0; j < 5; ++j) {
        const int jr = ATT_JR(j); const LAS float* btj = bt + 32 * jr;
#pragma unroll
        for (int r = 0; r < 16; ++r) {
            const int kc = 32 * jr + (r & 3) + 8 * (r >> 2);
            float v = p[j][r] + btj[(r & 3) + 8 * (r >> 2)];
            if (edge) { const int lk = l0 - 64 + kc + 4 * hi; v = (lk >= 0 && lk < L) ? v : -1e30f; }
            p[j][r] = v; mx = fmaxf(mx, v);
        }
        asm volatile("" ::: "memory");
    }
    mx = fmaxf(mx, __shfl_xor(mx, 32));
    float ls = 0.f;
    bf16x8 pb[5][2];
#pragma unroll
    for (int j = 0; j < 5; ++j) {
        float e[16];
#pragma unroll
        for (int r = 0; r < 16; ++r) { e[r] = __builtin_amdgcn_exp2f(p[j][r] - mx); ls += e[r]; }
#pragma unroll
        for (int s = 0; s < 2; ++s) { v4u w; w.x = cvt_pk_bf16(e[8 * s + 0], e[8 * s + 1]); w.y = cvt_pk_bf16(e[8 * s + 2], e[8 * s + 3]);
            w.z = cvt_pk_bf16(e[8 * s + 4], e[8 * s + 5]); w.w = cvt_pk_bf16(e[8 * s + 6], e[8 * s + 7]); pb[j][s] = __builtin_bit_cast(bf16x8, w); }
    }
    ls += __shfl_xor(ls, 32);
    asm volatile("" ::: "memory");
    f32x16 o[4] = {};
    const int i16 = lane & 15, g16 = lane >> 4;
    const unsigned vbase = (unsigned)(uintptr_t)wl + (unsigned)((i16 >> 2) * 1088 + hi * 256 + (16 * (g16 & 1) + 4 * (i16 & 3)) * 2);
#define ATT_VTILE(n) do { const unsigned va_ = vbase + ((n) & 1) * ATT_SLOT; \
        _Pragma("unroll") for (int dt = 0; dt < 4; ++dt) { s16x4 lo0, hi0, lo1, hi1; \
            asm volatile("ds_read_b64_tr_b16 %0, %4 offset:%5\n\tds_read_b64_tr_b16 %1, %4 offset:%6\n\tds_read_b64_tr_b16 %2, %4 offset:%7\n\tds_read_b64_tr_b16 %3, %4 offset:%8\n\ts_waitcnt lgkmcnt(0)" \
                         : "=&v"(lo0), "=&v"(hi0), "=&v"(lo1), "=&v"(hi1) : "v"(va_), "i"(dt * 64), "i"(512 + dt * 64), "i"(4 * 1088 + dt * 64), "i"(4 * 1088 + 512 + dt * 64) : "memory"); \
            const bf16x8 af0 = (bf16x8){lo0[0], lo0[1], lo0[2], lo0[3], hi0[0], hi0[1], hi0[2], hi0[3]}; \
            const bf16x8 af1 = (bf16x8){lo1[0], lo1[1], lo1[2], lo1[3], hi1[0], hi1[1], hi1[2], hi1[3]}; \
            o[dt] = __builtin_amdgcn_mfma_f32_32x32x16_bf16(af0, pb[(n) - 5][0], o[dt], 0, 0, 0); \
            o[dt] = __builtin_amdgcn_mfma_f32_32x32x16_bf16(af1, pb[(n) - 5][1], o[dt], 0, 0, 0); } } while (0)
    ATT_WAITV(8); ATT_VTILE(5); ATT_ISSUE(7);
    ATT_WAITV(8); ATT_VTILE(6); ATT_ISSUE(8);
    ATT_WAITV(8); ATT_VTILE(7); ATT_ISSUE(9);
    ATT_WAITV(8); ATT_VTILE(8);
    ATT_WAITV(0); ATT_VTILE(9);
#undef ATT_WAITV
#undef ATT_ISSUE
#undef ATT_KTILE
#undef ATT_VTILE
#undef ATT_JR
    const float inv = 1.0f / ls;
    const float lse2 = mx + __builtin_amdgcn_logf(ls);
    const size_t orow = qrow;
    if (G < 2) {
        bf16* op = (G == 0 ? O0 : O1) + orow * ATTW + h * HD + 4 * hi;
#pragma unroll
        for (int dt = 0; dt < 4; ++dt)
#pragma unroll
            for (int rg = 0; rg < 4; ++rg) { v2u w; w.x = cvt_pk_bf16(o[dt][4 * rg] * inv, o[dt][4 * rg + 1] * inv); w.y = cvt_pk_bf16(o[dt][4 * rg + 2] * inv, o[dt][4 * rg + 3] * inv);
                *(v2u*)(op + 32 * dt + 8 * rg) = w; }
        if (hi == 0) (G == 0 ? LSE0 : LSE1)[orow * NH + h] = lse2;
    } else {
        const float l0v = LSE0[orow * NH + h], l1v = LSE1[orow * NH + h];
        const float mm = fmaxf(fmaxf(l0v, l1v), lse2);
        const float w0 = __builtin_amdgcn_exp2f(l0v - mm), w1 = __builtin_amdgcn_exp2f(l1v - mm), w2 = __builtin_amdgcn_exp2f(lse2 - mm);
        const float wi = 1.0f / (w0 + w1 + w2);
        const float c0 = w0 * wi, c1 = w1 * wi, c2 = w2 * wi * inv;
        const bf16* p0 = O0 + orow * ATTW + h * HD + 4 * hi; const bf16* p1 = O1 + orow * ATTW + h * HD + 4 * hi;
        bf16* op = MIXIN + orow * DM + h * HD + 4 * hi;
#pragma unroll
        for (int dt = 0; dt < 4; ++dt) {
            v2u a[4], c[4];
#pragma unroll
            for (int rg = 0; rg < 4; ++rg) { a[rg] = *(const v2u*)(p0 + 32 * dt + 8 * rg); c[rg] = *(const v2u*)(p1 + 32 * dt + 8 * rg); }
#pragma unroll
            for (int rg = 0; rg < 4; ++rg) {
                const float y0 = c0 * bf_lo(a[rg].x) + c1 * bf_lo(c[rg].x) + c2 * o[dt][4 * rg], y1 = c0 * bf_hi(a[rg].x) + c1 * bf_hi(c[rg].x) + c2 * o[dt][4 * rg + 1];
                const float y2 = c0 * bf_lo(a[rg].y) + c1 * bf_lo(c[rg].y) + c2 * o[dt][4 * rg + 2], y3 = c0 * bf_hi(a[rg].y) + c1 * bf_hi(c[rg].y) + c2 * o[dt][4 * rg + 3];
                v2u w; w.x = cvt_pk_bf16(y0, y1); w.y = cvt_pk_bf16(y2, y3); *(v2u*)(op + 32 * dt + 8 * rg) = w; }
        }
    }
}

constexpr int PER_PHASE = 9;
struct Args { const float* in[16]; float* out; unsigned char* ws; unsigned mask; unsigned pad; };

__constant__ unsigned char CAND_I[64] = {0,0,0,0,0,0,0,0,0,0,0,0,0,0,0,0, 1,1,1,1,1,1,1,1, 2,2,2,2,2, 3,3,3,3, 4,4,4, 5,5, 6,6, 7,7, 8,9,10,11,12,13,14,15, 0,0,0,0,0,0,0,0,0,0,0,0,0,0};
__constant__ unsigned char CAND_J[64] = {0,1,2,3,4,5,6,7,8,9,10,11,12,13,14,15, 0,1,2,3,4,5,6,7, 0,1,2,3,4, 0,1,2,3, 0,1,2, 0,1, 0,1, 0,1, 0,0,0,0,0,0,0,0, 0,0,0,0,0,0,0,0,0,0,0,0,0,0};

__global__ void __launch_bounds__(NWAVES * 64, 2) fwd_kernel(Args args) {
    extern __shared__ __attribute__((aligned(16))) unsigned char lds_raw[];
    LAS unsigned char* lds = (LAS unsigned char*)lds_raw;
    volatile LAS unsigned* MISC = (volatile LAS unsigned*)(lds + MISC_OFF);
    const int tid0 = threadIdx.x, lane0 = tid0 & 63, wave = __builtin_amdgcn_readfirstlane(tid0 >> 6);
#define PHASE_LANES() int tid = tid0; asm volatile("" : "+v"(tid)); const int lane = tid & 63
    const int G = gridDim.x; const int bx = blockIdx.x;
    const int vcu = (G % 8 == 0) ? (bx % 8) * (G / 8) + bx / 8 : bx;
    const int gw = vcu * NWAVES + wave, NGW = G * NWAVES;
    unsigned char* ws = args.ws;
    unsigned* ctl = (unsigned*)(ws + WS_CTL);
    const float* x = args.in[0]; const float* cvec = args.in[1]; const float* w_ada = args.in[2]; const float* b_ada = args.in[3]; const float* g_mix = args.in[4];
    const float* w_in = args.in[5]; const float* rel_bias = args.in[6]; const float* pool_w = args.in[7]; const float* pool_scale = args.in[8]; const float* w_out = args.in[9];
    const float* g_ffn = args.in[10]; const float* peer_wq = args.in[11]; const float* peer_sk = args.in[12]; const float* peer_u = args.in[13]; const float* peer_v = args.in[14];
    const float* g_final = args.in[15];
    float* out = args.out;
    float* MODV = (float*)(ws + WS_MODV); float* MODP = (float*)(ws + WS_MODP);
    bf16* SKT = (bf16*)(ws + WS_SKT); bf16* PWS = (bf16*)(ws + WS_PWS); bf16* WQST = (bf16*)(ws + WS_WQST); bf16* WOUT2 = (bf16*)(ws + WS_WOUT2); bf16* WINT = (bf16*)(ws + WS_WINT); unsigned char* WIN8 = ws + WS_WIN8; unsigned char* H8 = ws + WS_H8;
    bf16* WOPT = (bf16*)(ws + WS_WOPT); bf16* WQB = (bf16*)(ws + WS_WQB);
    unsigned char* UB = ws + WS_UB; unsigned char* VB = ws + WS_VB; float* SCL = (float*)(ws + WS_SCL); bf16* H = (bf16*)(ws + WS_H); bf16* PIN = (bf16*)(ws + WS_PROJ); bf16* QKVH = (bf16*)(ws + WS_QKVH); bf16* MIXIN = (bf16*)(ws + WS_MIXIN);
    bf16* O0 = (bf16*)(ws + WS_O0); bf16* O1 = (bf16*)(ws + WS_O1); float* LSE = (float*)(ws + WS_LSE);
    float* SC = (float*)(ws + WS_SC);
    bf16* X1B = (bf16*)(ws + WS_O0);
    bf16* YB = (bf16*)(ws + WS_PROJ + 64 * MiB);

    for (int u = tid0; u < (LDS_BYTES - LDSCTL_OFF) / 4; u += NWAVES * 64) ((LAS unsigned*)(lds + LDSCTL_OFF))[u] = 0u;
    __syncthreads();
    XcdBarrier bar; bar.bar = ctl + CW_BAR; bar.x = 0; bar.st = nullptr;
    if (MK_N_LAUNCHES != PER_PHASE) bar = xcd_barrier_post(ctl + CW_BAR, MISC + 8);
#define GRID_BAR() do { if (MK_N_LAUNCHES != PER_PHASE) xcd_barrier(bar); } while (0)
    const unsigned phmask = args.mask;
#ifndef PH_MASK
#define PH_MASK 0x1ff
#endif
#define IN(k) ((((PH_MASK) >> (k)) & 1) && ((phmask >> (k)) & 1u))
#define BOTH(k) (IN(k) && IN((k) + 1))

    if (IN(0)) {
        PHASE_LANES();
        LAS float* silu = (LAS float*)(lds + RING_OFF);
        for (int i = tid; i < BATCH * DM; i += NWAVES * 64) { const float v = cvec[i]; silu[i] = v / (1.0f + __expf(-v)); }
        __syncthreads();
        for (int task = gw; task < (NMOD / 256) * KS_ADA; task += NGW) {
            const int cg = task % (NMOD / 256), ks = task / (NMOD / 256); const int k0 = ks * (DM / KS_ADA), n0 = cg * 256 + 4 * lane;
            f32x4 a0 = {0.f, 0.f, 0.f, 0.f}, a1 = {0.f, 0.f, 0.f, 0.f};
            const float* wp = w_ada + (size_t)k0 * NMOD + n0;
#pragma unroll 8
            for (int kk = 0; kk < DM / KS_ADA; ++kk) { const f32x4 w4 = *(const f32x4*)(wp + (size_t)kk * NMOD); const float s0 = silu[k0 + kk], s1 = silu[DM + k0 + kk]; a0 += w4 * s0; a1 += w4 * s1; }
            *(f32x4*)(MODP + ((size_t)(ks * 2 + 0)) * NMOD + n0) = a0; *(f32x4*)(MODP + ((size_t)(ks * 2 + 1)) * NMOD + n0) = a1;
        }
        __syncthreads();
        {
            LAS float* scr = (LAS float*)(lds + RING_OFF + wave * 16384);
            constexpr int I_QKV = (DM / 64) * (3 * ATTW / 32), I_PIN = (DM / 64) * (POOLW / 32), I_OUTH = (ATTW / 64) * (DM / 32);
            constexpr int NITEMS = I_QKV + I_PIN + 2 * I_OUTH;
            for (int it = gw; it < NITEMS; it += NGW) {
                int r = it;
                if (r < I_QKV) { p0_transpose_item<true>(w_in, INW, 3 * ATTW, WIN8, DM, W8SCALE, scr, r, lane); continue; } r -= I_QKV;
                if (r < I_PIN) { p0_transpose_item<false>(w_in + 3 * ATTW, INW, POOLW, WINT, DM, 1.f, scr, r, lane); continue; } r -= I_PIN;
                if (r < I_OUTH) { p0_transpose_item<false>(w_out, DM, DM, WOUT2, DM, 1.f, scr, r, lane); continue; } r -= I_OUTH;
                p0_transpose_item<false>(w_out + (size_t)ATTW * DM, DM, DM, WOPT, POOLW, 1.f, scr, r, lane);
            }
        }
        for (int i = gw * 64 + lane; i < (DM * PQ + 4 * 512 * 512) / 8; i += NGW * 64) {
            const bool isQ = i < DM * PQ / 8; const int j = isQ ? i : i - DM * PQ / 8;
            const float* src = (isQ ? peer_wq : pool_w) + (size_t)j * 8;
            f32x4 a = *(const f32x4*)src, c = *(const f32x4*)(src + 4);
            if (!isQ) { const int e0 = j * 8; const int gi = e0 >> 18, d0 = e0 & 511; const float* ps = pool_scale + gi * 512 + d0; a = a * *(const f32x4*)ps; c = c * *(const f32x4*)(ps + 4); }
            v4u w; w.x = cvt_pk_bf16(a[0], a[1]); w.y = cvt_pk_bf16(a[2], a[3]); w.z = cvt_pk_bf16(c[0], c[1]); w.w = cvt_pk_bf16(c[2], c[3]);
            *(v4u*)((isQ ? WQB : PWS) + (size_t)j * 8) = w;
        }
        for (int r = gw; r < 2 * NEXP; r += NGW) {
            const bool isU = r < NEXP; const int e = isU ? r : r - NEXP;
            const float* src = (isU ? peer_u : peer_v) + (size_t)e * DM + 16 * lane;
            f32x4 v[4][4]; float mx = 0.f;
#pragma unroll
            for (int i = 0; i < 4; ++i)
#pragma unroll
                for (int q = 0; q < 4; ++q) { v[i][q] = *(const f32x4*)(src + 1024 * i + 4 * q);
                    mx = fmaxf(mx, fmaxf(fmaxf(fabsf(v[i][q][0]), fabsf(v[i][q][1])), fmaxf(fabsf(v[i][q][2]), fabsf(v[i][q][3])))); }
#pragma unroll
            for (int o = 1; o < 64; o <<= 1) mx = fmaxf(mx, __shfl_xor(mx, o));
            const int ex = (int)((__float_as_uint(mx) >> 23) & 0xffu);
            float scale = 1.0f, inv = 1.0f;
            if (ex >= 32 && ex <= 230) { scale = __uint_as_float((unsigned)(261 - ex) << 23); inv = __uint_as_float((unsigned)(ex - 7) << 23); }
            unsigned char* dst = (isU ? UB : VB) + ((size_t)(lane >> 3) * NEXP + e) * 128 + 16 * (lane & 7);
#pragma unroll
            for (int i = 0; i < 4; ++i) { v4u w;
#pragma unroll
                for (int q = 0; q < 4; ++q) { int pk = 0; pk = __builtin_amdgcn_cvt_pk_fp8_f32(v[i][q][0] * scale, v[i][q][1] * scale, pk, false);
                    pk = __builtin_amdgcn_cvt_pk_fp8_f32(v[i][q][2] * scale, v[i][q][3] * scale, pk, true); w[q] = (unsigned)pk; }
                *(v4u*)(dst + (size_t)(8 * i) * NEXP * 128) = w; }
            if (lane == 0) SCL[r] = inv;
        }
        for (int i = gw * 64 + lane; i < 2048 * 32; i += NGW * 64) {
            const int n = i >> 5, kc = (i & 31) * 8; const int p = (n >> 7) & 1, pp = kc >> 7;
            v4u w = {0u, 0u, 0u, 0u};
            if (p == pp) { const float* src = peer_sk + (size_t)n * 128 + (kc & 127); const f32x4 a = *(const f32x4*)src, c = *(const f32x4*)(src + 4);
                w.x = cvt_pk_bf16(a[0], a[1]); w.y = cvt_pk_bf16(a[2], a[3]); w.z = cvt_pk_bf16(c[0], c[1]); w.w = cvt_pk_bf16(c[2], c[3]); }
            *(v4u*)(SKT + (size_t)n * 256 + kc) = w;
        }
        if (BOTH(0)) GRID_BAR();
    }

    if (IN(1)) {
        PHASE_LANES();
        for (int i = bx * (NWAVES * 64) + tid; i < BATCH * NMOD; i += G * NWAVES * 64) {
            const int b = i / NMOD, n = i % NMOD; float s = b_ada[n];
#pragma unroll 8
            for (int ks = 0; ks < KS_ADA; ++ks) s += MODP[(size_t)(ks * 2 + b) * NMOD + n];
            const int j = n / DM, c = n % DM;
            MODV[(size_t)(j * 2 + b) * DM + c] = s;
        }
        if (bx < G / 2) {
            pg8::Gemm g{WOPT, PWS, DM, POOLW, 512, POOLW, 512, 2, 512, 1 << 30, 0}; pg8::StaticOrder S; S.init(DM, POOLW, G / 2, bx);
            pg8::EpiBf16 E{WOUT2 + ATTW, DM, 0, 1.0f, nullptr, 0, 0};
            pg8::gemm_phase<pg8::EpiBf16, pg8::StaticOrder, true>(lds + RING_OFF, g, S, E);
        }
        else {
            pg8::Gemm g{SKT, WQB, PQ, DM, 256, 256, PQ, 1 << 30, 0, 1, 256}; pg8::StaticOrder S; S.init(PQ, DM, G - G / 2, bx - G / 2);
            pg8::EpiBf16 E{WQST, DM, 0, 1.0f, nullptr, 0, 0};
            pg8::gemm_phase<pg8::EpiBf16, pg8::StaticOrder, true>(lds + RING_OFF, g, S, E);
        }
        if (BOTH(1)) GRID_BAR();
    }

    if (IN(2)) {
        PHASE_LANES();
        for (int row = gw; row < M; row += NGW) {
            const int b = row / SEQ;
            const f32x4* xr = (const f32x4*)(x + (size_t)row * DM) + lane;
            f32x4 v[16]; float ss = 0.f;
#pragma unroll
            for (int j = 0; j < 16; ++j) { v[j] = xr[64 * j]; ss += (v[j][0] * v[j][0] + v[j][1] * v[j][1]) + (v[j][2] * v[j][2] + v[j][3] * v[j][3]); }
            const float rstd = 1.0f / sqrtf(wave_sum(ss) * (1.0f / DM) + RMS_EPS);
            const f32x4* gp = (const f32x4*)g_mix + lane; const f32x4* shp = (const f32x4*)(MODV + (size_t)(0 * 2 + b) * DM) + lane; const f32x4* scp = (const f32x4*)(MODV + (size_t)(1 * 2 + b) * DM) + lane;
            v2u* op = (v2u*)(H + (size_t)row * DM) + lane; unsigned* op8 = (unsigned*)(H8 + (size_t)row * DM) + lane;
#pragma unroll
            for (int j = 0; j < 16; ++j) { const f32x4 g4 = gp[64 * j], sh = shp[64 * j], sc = scp[64 * j];
                const f32x4 y = (v[j] * rstd) * g4 * (sc + 1.0f) + sh;
                v2u w; w.x = cvt_pk_bf16(y[0], y[1]); w.y = cvt_pk_bf16(y[2], y[3]); op[64 * j] = w;
                int p8 = 0; p8 = __builtin_amdgcn_cvt_pk_fp8_f32(y[0] * H8SCALE, y[1] * H8SCALE, p8, false); p8 = __builtin_amdgcn_cvt_pk_fp8_f32(y[2] * H8SCALE, y[3] * H8SCALE, p8, true); op8[64 * j] = (unsigned)p8; }
        }
        if (BOTH(2)) GRID_BAR();
    }

    if (IN(3)) {
        PHASE_LANES();
        {
            pg8::Gemm g{(const bf16*)H8, (const bf16*)WIN8, M, 3 * ATTW, DM / 2, DM / 2, DM / 2, 1 << 30, 0, 1 << 30, 0}; pg8::StaticOrder S; S.init(M, 3 * ATTW, G, bx);
            pg8::EpiBf16 E{PIN, POOLW, ATTW, QSCALE / (H8SCALE * W8SCALE), QKVH, 3 * ATTW, M, 1.0f / (H8SCALE * W8SCALE)};
            pg8::gemm_phase<pg8::EpiBf16, pg8::StaticOrder, true, true>(lds + RING_OFF, g, S, E);
        }
        {
            pg8::Gemm g{H, WINT, M, POOLW, DM, DM, DM, 1 << 30, 0, 1 << 30, 0}; pg8::StaticOrder S; S.init(M, POOLW, G, bx);
            pg8::EpiBf16 E{PIN, POOLW, 0, 1.0f, nullptr, 0, 0};
            pg8::gemm_phase<pg8::EpiBf16, pg8::StaticOrder, true>(lds + RING_OFF, g, S, E);
        }
        if (BOTH(3)) GRID_BAR();
    }

    if (IN(4)) {
        PHASE_LANES();
        LAS float* btab = (LAS float*)(lds + SHARED_OFF);
        LAS unsigned char* vt = lds + RING_OFF + wave * ATT_WAVE_BYTES;
        if (!(args.pad & 1u))
        for (int unit = bx; unit < BATCH * NH * (SEQ / 1024); unit += G) {
            const int b = unit >> 7, h = (unit >> 3) & 15, mt = unit & 7;
            __syncthreads();
            for (int i = tid; i < 3 * 256; i += NWAVES * 64) { const int gi = i >> 8, ri = (i & 255) - 32; const int dil = gi == 0 ? 1 : (gi == 1 ? 4 : 16);
                btab[i] = (ri >= 0 && ri <= 128) ? rel_bias[t5_bucket((ri - 64) * dil) * NH + h] * LOG2E : -1e30f; }
            __syncthreads();
            for (int g = 0; g < 3; ++g) {
                if (g == 2) { VM_WAIT(); __syncthreads(); }
                for (int tk = wave; tk < 32; tk += NWAVES) attn_task(g, QKVH, O0, O1, LSE, LSE + (size_t)M * NH, MIXIN, btab, vt, b, h, mt, tk, lane);
            }
        }
        if (!(args.pad & 2u))
        for (int i = bx * (NWAVES * 64) + tid; i < BATCH * (SEQ / 8) * (POOLW / 8); i += G * NWAVES * 64) {
            const int cc = i & 255, run = (i >> 8) & (SEQ / 8 - 1), b = i >> 18; const int gi = __builtin_amdgcn_readfirstlane(cc >> 6);
            const int pos0 = run * 8;
            const bf16* base = PIN + (size_t)b * SEQ * POOLW + cc * 8;
            bf16* obase = MIXIN + ((size_t)b * SEQ + pos0) * DM + ATTW + cc * 8;
#define POOL_RUN(HW) do { constexpr int NR = 8 + 2 * (HW) - 1; v4u w_[NR]; \
                _Pragma("unroll") for (int q = 0; q < NR; ++q) { const int pp = pos0 - (HW) + q; const int pc = pp < 0 ? 0 : (pp > SEQ - 1 ? SEQ - 1 : pp); w_[q] = *(const v4u*)(base + (size_t)pc * POOLW); } \
                _Pragma("unroll") for (int q = 0; q < NR; ++q) { const int pp = pos0 - (HW) + q; if (pp < 0 || pp >= SEQ) w_[q] = (v4u){0u, 0u, 0u, 0u}; } \
                float s_[8] = {0.f, 0.f, 0.f, 0.f, 0.f, 0.f, 0.f, 0.f}; \
                _Pragma("unroll") for (int q = 0; q < 2 * (HW) - 1; ++q) { s_[0] += bf_lo(w_[q].x); s_[1] += bf_hi(w_[q].x); s_[2] += bf_lo(w_[q].y); s_[3] += bf_hi(w_[q].y); s_[4] += bf_lo(w_[q].z); s_[5] += bf_hi(w_[q].z); s_[6] += bf_lo(w_[q].w); s_[7] += bf_hi(w_[q].w); } \
                _Pragma("unroll") for (int k = 0; k < 8; ++k) { const v4u in_ = w_[k + 2 * (HW) - 1]; \
                    s_[0] += bf_lo(in_.x); s_[1] += bf_hi(in_.x); s_[2] += bf_lo(in_.y); s_[3] += bf_hi(in_.y); s_[4] += bf_lo(in_.z); s_[5] += bf_hi(in_.z); s_[6] += bf_lo(in_.w); s_[7] += bf_hi(in_.w); \
                    const int pos = pos0 + k; const int lo_ = pos - (HW) < 0 ? 0 : pos - (HW), hi_ = pos + (HW) > SEQ ? SEQ : pos + (HW); const float inv = 1.0f / (float)(hi_ - lo_); \
                    const v4u me = w_[k + (HW)]; v4u o_; \
                    o_.x = cvt_pk_bf16(s_[0] * inv - bf_lo(me.x), s_[1] * inv - bf_hi(me.x)); o_.y = cvt_pk_bf16(s_[2] * inv - bf_lo(me.y), s_[3] * inv - bf_hi(me.y)); \
                    o_.z = cvt_pk_bf16(s_[4] * inv - bf_lo(me.z), s_[5] * inv - bf_hi(me.z)); o_.w = cvt_pk_bf16(s_[6] * inv - bf_lo(me.w), s_[7] * inv - bf_hi(me.w)); \
                    *(v4u*)(obase + (size_t)k * DM) = o_; \
                    const v4u out_ = w_[k]; \
                    s_[0] -= bf_lo(out_.x); s_[1] -= bf_hi(out_.x); s_[2] -= bf_lo(out_.y); s_[3] -= bf_hi(out_.y); s_[4] -= bf_lo(out_.z); s_[5] -= bf_hi(out_.z); s_[6] -= bf_lo(out_.w); s_[7] -= bf_hi(out_.w); } } while (0)
            if (gi == 0) POOL_RUN(1); else if (gi == 1) POOL_RUN(2); else if (gi == 2) POOL_RUN(4); else POOL_RUN(8);
#undef POOL_RUN
        }
        if (BOTH(4)) GRID_BAR();
    }

    if (IN(5)) {
        PHASE_LANES();
        pg8::Gemm g{MIXIN, WOUT2, M, DM, DM, DM, DM, 1 << 30, 0, 1 << 30, 0}; pg8::StaticOrder S; S.init(M, DM, G, bx);
        pg8::EpiResBf16 E{x, MODV + (size_t)(2 * 2) * DM, X1B, DM};
        pg8::gemm_phase<pg8::EpiResBf16, pg8::StaticOrder, true>(lds + RING_OFF, g, S, E);
        if (BOTH(5)) GRID_BAR();
    }

    if (IN(6)) {
        PHASE_LANES();
        for (int row = gw; row < M; row += NGW) {
            const int b = row / SEQ;
            const v2u* xr = (const v2u*)(X1B + (size_t)row * DM) + lane;
            f32x4 v[16]; float ss = 0.f;
#pragma unroll
            for (int j = 0; j < 16; ++j) { const v2u xw = xr[64 * j]; v[j] = (f32x4){bf_lo(xw.x), bf_hi(xw.x), bf_lo(xw.y), bf_hi(xw.y)}; ss += (v[j][0] * v[j][0] + v[j][1] * v[j][1]) + (v[j][2] * v[j][2] + v[j][3] * v[j][3]); }
            const float rstd = 1.0f / sqrtf(wave_sum(ss) * (1.0f / DM) + RMS_EPS);
            const f32x4* gp = (const f32x4*)g_ffn + lane; const f32x4* shp = (const f32x4*)(MODV + (size_t)(3 * 2 + b) * DM) + lane; const f32x4* scp = (const f32x4*)(MODV + (size_t)(4 * 2 + b) * DM) + lane;
            v2u* op = (v2u*)(H + (size_t)row * DM) + lane;
#pragma unroll
            for (int j = 0; j < 16; ++j) { const f32x4 g4 = gp[64 * j], sh = shp[64 * j], sc = scp[64 * j];
                const f32x4 y = (v[j] * rstd) * g4 * (sc + 1.0f) + sh;
                v2u w; w.x = cvt_pk_bf16(y[0], y[1]); w.y = cvt_pk_bf16(y[2], y[3]); op[64 * j] = w; }
        }
        if (BOTH(6)) GRID_BAR();
    }

    if (IN(7)) {
        PHASE_LANES();
        pg8::Gemm g{H, WQST, M, PQ, DM, DM, DM, 1 << 30, 0, 1 << 30, 0}; pg8::StaticOrder S; S.init(M, PQ, G, bx);
        pg8::EpiF32 E{SC, PQ};
        pg8::gemm_phase<pg8::EpiF32, pg8::StaticOrder, true>(lds + RING_OFF, g, S, E);
        if (BOTH(7)) GRID_BAR();
    }

    if (IN(8)) {
        PHASE_LANES();
        LAS unsigned short* EXPW = (LAS unsigned short*)(lds + RING_OFF);
        LAS float* GACT = (LAS float*)(lds + RING_OFF + 16384);
        LAS unsigned* W = (LAS unsigned*)(lds + RING_OFF + 49152 + wave * 4096);
        LAS unsigned* K1 = W; LAS unsigned* K2 = W + 128;
        LAS float* TV1 = (LAS float*)(W + 256); LAS int* TI1 = (LAS int*)(W + 272); LAS float* TV2 = (LAS float*)(W + 288); LAS int* TI2 = (LAS int*)(W + 304);
        LAS unsigned* CK = W + 320; LAS float* SV = (LAS float*)(W + 384); LAS int* SE = (LAS int*)(W + 400);
        const int c8 = lane & 7, r8 = lane >> 3;
        for (int blk = vcu; blk < M / 64; blk += G) {
            const int tok0 = blk * 64; const int b = tok0 / SEQ;
            for (int j = 0; j < 8; ++j) {
                const int tl = wave * 8 + j; const int t = tok0 + tl;
#ifndef TOPK_REP
#define TOPK_REP 1
#endif
                for (int hh = 0; hh < 8 * TOPK_REP; ++hh) { const int h = hh & 7;
                    const float* sp = SC + (size_t)t * PQ + h * 256;
                    const float a0 = sp[lane], a1 = sp[64 + lane], b0 = sp[128 + lane], b1 = sp[192 + lane];
                    unsigned ka0 = (fkey(a0) & ~127u) | (unsigned)(127 - lane), ka1 = (fkey(a1) & ~127u) | (unsigned)(63 - lane);
                    unsigned kb0 = (fkey(b0) & ~127u) | (unsigned)(127 - lane), kb1 = (fkey(b1) & ~127u) | (unsigned)(63 - lane);
                    bitonic128x2(ka0, ka1, kb0, kb1, lane);
                    if (lane >= 56) { K1[127 - 2 * lane] = ka0; K1[126 - 2 * lane] = ka1; K2[127 - 2 * lane] = kb0; K2[126 - 2 * lane] = kb1; }
                    LDS_WAIT();
                    const int ci_i = CAND_I[lane], ci_j = CAND_J[lane];
                    const unsigned kA = K1[ci_i], kB = K2[ci_j];
                    const float cv = fdec(kA) + fdec(kB);
                    const unsigned ck = lane < 50 ? ((fkey(cv) & ~255u) | (unsigned)(255 - (ci_i * 16 + ci_j))) : 0u;
                    CK[lane] = ck;
                    LDS_WAIT();
                    int rc = 0;
#pragma unroll 8
                    for (int kk = 0; kk < 16; ++kk) { const v4u q = ((const LAS v4u*)CK)[kk]; rc += (q.x > ck) + (q.y > ck) + (q.z > ck) + (q.w > ck); }
                    if (lane < 50 && rc < 16) { SV[rc] = cv; SE[rc] = (int)((127u - (kA & 127u)) * 128u + (127u - (kB & 127u))); }
                    LDS_WAIT();
                    const float top0 = SV[0], myv = SV[lane & 15]; const int mye = SE[lane & 15];
                    const float e = __expf(myv - top0);
                    float ssum = e; ssum += __shfl_xor(ssum, 1); ssum += __shfl_xor(ssum, 2); ssum += __shfl_xor(ssum, 4); ssum += __shfl_xor(ssum, 8);
                    if (lane < 16) { EXPW[tl * 128 + h * 16 + lane] = (unsigned short)mye; GACT[tl * 128 + h * 16 + lane] = e / ssum; }
                    LDS_WAIT();
                }
            }
            LAS float* ACC = (LAS float*)(lds + RING_OFF + 81920);
            for (int i = lane; i < 8 * 128; i += 64) ACC[wave * 1024 + i] = 0.f;
            LDS_WAIT();
            {
                v4u gn[16]; v4u hna, hnb;
#define P10_LOADU(idx) do { const int s_ = (idx) >> 3, j_ = (idx) & 7; const int tl_ = wave * 8 + j_; \
                    const unsigned char* tb_ = UB + (size_t)s_ * NEXP * 128 + 16 * c8; \
                    const v4u* hp_ = (const v4u*)(H + (size_t)(tok0 + tl_) * DM + 128 * s_ + 16 * c8); hna = hp_[0]; hnb = hp_[1]; \
                    _Pragma("unroll") for (int i = 0; i < 16; ++i) { const unsigned e_ = EXPW[tl_ * 128 + r8 + 8 * i]; gn[i] = *(const v4u*)(tb_ + (size_t)e_ * 128); } } while (0)
                P10_LOADU(0);
#pragma unroll 1
                for (int idx = 0; idx < 256; ++idx) {
                    v4u g[16]; const v4u ha = hna, hb = hnb;
#pragma unroll
                    for (int i = 0; i < 16; ++i) g[i] = gn[i];
                    if (idx + 1 < 256) P10_LOADU(idx + 1);
                    const int tl = wave * 8 + (idx & 7);
                    f32x2 hs[8];
                    hs[0] = (f32x2){bf_lo(ha.x), bf_hi(ha.x)}; hs[1] = (f32x2){bf_lo(ha.y), bf_hi(ha.y)}; hs[2] = (f32x2){bf_lo(ha.z), bf_hi(ha.z)}; hs[3] = (f32x2){bf_lo(ha.w), bf_hi(ha.w)};
                    hs[4] = (f32x2){bf_lo(hb.x), bf_hi(hb.x)}; hs[5] = (f32x2){bf_lo(hb.y), bf_hi(hb.y)}; hs[6] = (f32x2){bf_lo(hb.z), bf_hi(hb.z)}; hs[7] = (f32x2){bf_lo(hb.w), bf_hi(hb.w)};
                    float p[16];
#pragma unroll
                    for (int i = 0; i < 16; ++i) { f32x2 a2 = {0.f, 0.f};
#pragma unroll
                        for (int q = 0; q < 4; ++q) { a2 += __builtin_amdgcn_cvt_pk_f32_fp8((int)g[i][q], false) * hs[2 * q]; a2 += __builtin_amdgcn_cvt_pk_f32_fp8((int)g[i][q], true) * hs[2 * q + 1]; }
                        p[i] = a2.x + a2.y; }
                    float q8[8], q4[4], q2[2];
#pragma unroll
                    for (int m = 0; m < 8; ++m) { const float snd = (c8 & 4) ? p[m] : p[m + 8], kp = (c8 & 4) ? p[m + 8] : p[m]; q8[m] = kp + __shfl_xor(snd, 4); }
#pragma unroll
                    for (int m = 0; m < 4; ++m) { const float snd = (c8 & 2) ? q8[m] : q8[m + 4], kp = (c8 & 2) ? q8[m + 4] : q8[m]; q4[m] = kp + __shfl_xor(snd, 2); }
#pragma unroll
                    for (int m = 0; m < 2; ++m) { const float snd = (c8 & 1) ? q4[m] : q4[m + 2], kp = (c8 & 1) ? q4[m + 2] : q4[m]; q2[m] = kp + __shfl_xor(snd, 1); }
                    LAS float* ap = ACC + tl * 128 + r8 + 16 * c8;
                    ap[0] += q2[0]; ap[8] += q2[1];
                }
#undef P10_LOADU
            }
            LDS_WAIT();
            for (int i = lane; i < 8 * 128; i += 64) { const int o_ = wave * 1024 + i; const unsigned e = EXPW[o_];
                const float a = ACC[o_] * SCL[e]; GACT[o_] = gelu_tanh(a) * GACT[o_] * SCL[NEXP + e]; }
            LDS_WAIT();
            LAS float* SSQ = ACC;
            for (int j = 0; j < 8; ++j) SSQ[(wave * 8 + j) * 128 + lane] = 0.f;
            LDS_WAIT();
            const float* gtp = MODV + (size_t)(5 * 2 + b) * DM;
            {
                v4u gn[16]; float avn[16];
#define P10_LOADV(idx) do { const int s_ = (idx) >> 3, j_ = (idx) & 7; const int tl_ = wave * 8 + j_; \
                    const unsigned char* tb_ = VB + (size_t)s_ * NEXP * 128 + 16 * c8; \
                    _Pragma("unroll") for (int i = 0; i < 16; ++i) { const int k_ = tl_ * 128 + r8 + 8 * i; const unsigned e_ = EXPW[k_]; avn[i] = GACT[k_]; gn[i] = *(const v4u*)(tb_ + (size_t)e_ * 128); } } while (0)
                P10_LOADV(0);
#pragma unroll 1
                for (int idx = 0; idx < 256; ++idx) {
                    v4u g[16]; float av[16];
#pragma unroll
                    for (int i = 0; i < 16; ++i) { g[i] = gn[i]; av[i] = avn[i]; }
                    if (idx + 1 < 256) P10_LOADV(idx + 1);
                    const int s_c = idx >> 3; const int tl = wave * 8 + (idx & 7); const int t = tok0 + tl;
                    const int d = 128 * s_c + 16 * c8 + 2 * r8;
                    const unsigned xw = __builtin_nontemporal_load((const unsigned*)(X1B + (size_t)t * DM + d)); const f32x2 gv = *(const f32x2*)(gtp + d);
                    const float ssq_old = SSQ[tl * 128 + lane];
                    f32x2 o8[8];
#pragma unroll
                    for (int q = 0; q < 8; ++q) o8[q] = (f32x2){0.f, 0.f};
#pragma unroll
                    for (int i = 0; i < 16; ++i)
#pragma unroll
                        for (int q = 0; q < 4; ++q) { o8[2 * q] += __builtin_amdgcn_cvt_pk_f32_fp8((int)g[i][q], false) * av[i]; o8[2 * q + 1] += __builtin_amdgcn_cvt_pk_f32_fp8((int)g[i][q], true) * av[i]; }
                    float p[16], q8[8], q4[4], q2[2];
#pragma unroll
                    for (int q = 0; q < 8; ++q) { p[2 * q] = o8[q].x; p[2 * q + 1] = o8[q].y; }
#pragma unroll
                    for (int m = 0; m < 8; ++m) { const float snd = (r8 & 4) ? p[m] : p[m + 8], kp = (r8 & 4) ? p[m + 8] : p[m]; q8[m] = kp + __shfl_xor(snd, 32); }
#pragma unroll
                    for (int m = 0; m < 4; ++m) { const float snd = (r8 & 2) ? q8[m] : q8[m + 4], kp = (r8 & 2) ? q8[m + 4] : q8[m]; q4[m] = kp + __shfl_xor(snd, 16); }
#pragma unroll
                    for (int m = 0; m < 2; ++m) { const float snd = (r8 & 1) ? q4[m] : q4[m + 2], kp = (r8 & 1) ? q4[m + 2] : q4[m]; q2[m] = kp + __shfl_xor(snd, 8); }
                    f32x2 y; y.x = bf_lo(xw) + gv.x * q2[0]; y.y = bf_hi(xw) + gv.y * q2[1];
                    __builtin_nontemporal_store(cvt_pk_bf16(y.x, y.y), (unsigned*)(YB + (size_t)t * DM + d));
                    SSQ[tl * 128 + lane] = ssq_old + (y.x * y.x + y.y * y.y);
                }
#undef P10_LOADV
            }
            VM_WAIT(); LDS_WAIT();
            __builtin_amdgcn_fence(__ATOMIC_ACQUIRE, "agent");
            VM_WAIT();
            for (int j = 0; j < 8; ++j) {
                const int tl = wave * 8 + j; const int t = tok0 + tl;
                const float rstd = 1.0f / sqrtf(wave_sum(SSQ[tl * 128 + lane]) * (1.0f / DM) + RMS_EPS);
                f32x4* op = (f32x4*)(out + (size_t)t * DM) + lane; const f32x4* gp = (const f32x4*)g_final + lane; const v2u* yp = (const v2u*)(YB + (size_t)t * DM) + lane;
#pragma unroll 4
                for (int i = 0; i < 16; ++i) { const v2u yw = __builtin_nontemporal_load(yp + 64 * i); const f32x4 y = {bf_lo(yw.x), bf_hi(yw.x), bf_lo(yw.y), bf_hi(yw.y)}; __builtin_nontemporal_store(y * rstd * gp[64 * i], op + 64 * i); }
            }
            LDS_WAIT();
        }
    }
#undef IN
#undef BOTH
#undef GRID_BAR
}

extern "C" void kernel_launch(void* const* d_in, const int* in_sizes, int n_in, void* d_out, int out_size, void* d_ws, size_t ws_size, hipStream_t stream) {
    static int grid = 0;
    if (grid == 0) {
        if (n_in != 16 || in_sizes[0] != M * DM || out_size != M * DM || ws_size < WS_END) {
            fprintf(stderr, "kernel_launch: shape/workspace mismatch: n_in %d in0 %d out %d ws %zu (need %zu)\n", n_in, n_in > 0 ? in_sizes[0] : -1, out_size, ws_size, (size_t)WS_END); grid = -1; return; }
        int dev = 0, cus = 0, per_cu = 0;
        if (hipGetDevice(&dev) != hipSuccess || hipDeviceGetAttribute(&cus, hipDeviceAttributeMultiprocessorCount, dev) != hipSuccess) { grid = -1; return; }
        if (hipFuncSetAttribute((const void*)fwd_kernel, hipFuncAttributeMaxDynamicSharedMemorySize, LDS_BYTES) != hipSuccess) { fprintf(stderr, "kernel_launch: hipFuncSetAttribute failed\n"); grid = -1; return; }
        if (hipOccupancyMaxActiveBlocksPerMultiprocessor(&per_cu, (const void*)fwd_kernel, NWAVES * 64, LDS_BYTES) != hipSuccess || per_cu < 1)
            fprintf(stderr, "kernel_launch: note: occupancy query reports %d workgroups per CU\n", per_cu);
        (void)hipGetLastError();
        grid = cus;
    }
    if (grid < 0) return;
    if (hipMemsetAsync((char*)d_ws + WS_CTL, 0, CTL_ZERO_BYTES, stream) != hipSuccess) { fprintf(stderr, "kernel_launch: memset failed\n"); return; }
    Args a{};
    for (int i = 0; i < 16; ++i) a.in[i] = (const float*)d_in[i];
    a.out = (float*)d_out; a.ws = (unsigned char*)d_ws;
#ifdef PROBE_MASK
    {
#ifndef PROBE_PAD
#define PROBE_PAD 0
#endif
        a.mask = PROBE_MASK; a.pad = PROBE_PAD;
        hipLaunchKernelGGL(fwd_kernel, dim3(grid), dim3(NWAVES * 64), LDS_BYTES, stream, a);
        (void)hipMemsetAsync((char*)d_ws + WS_CTL, 0, CTL_ZERO_BYTES, stream);
    }
#endif
    for (int li = 0; li < MK_N_LAUNCHES; ++li) {
        a.mask = (MK_N_LAUNCHES == PER_PHASE) ? (1u << li) : ((1u << PER_PHASE) - 1u); a.pad = 0;
        hipLaunchKernelGGL(fwd_kernel, dim3(grid), dim3(NWAVES * 64), LDS_BYTES, stream, a);
        const hipError_t le = hipPeekAtLastError();
        if (le != hipSuccess) { fprintf(stderr, "kernel_launch: launch %d failed: %s\n", li, hipGetErrorName(le)); break; }
    }
}
```

```cpp
#include <hip/hip_runtime.h>
#include <cstdio>
#include <cstdint>

#ifndef MK_N_LAUNCHES
#define MK_N_LAUNCHES 1
#endif

#define GAS __attribute__((address_space(1)))
#define LAS __attribute__((address_space(3)))
typedef unsigned short bf16;
typedef unsigned v4u __attribute__((ext_vector_type(4)));
typedef unsigned v2u __attribute__((ext_vector_type(2)));
typedef float f32x4 __attribute__((ext_vector_type(4)));
typedef float f32x2 __attribute__((ext_vector_type(2)));
typedef float f32x16 __attribute__((ext_vector_type(16)));
typedef short bf16x8 __attribute__((ext_vector_type(8)));
typedef short s16x4 __attribute__((ext_vector_type(4)));
typedef __bf16 bf2_t __attribute__((ext_vector_type(2)));

constexpr int BATCH = 2, SEQ = 8192, DM = 4096, M = BATCH * SEQ;
constexpr int NH = 16, HD = 128, ATTW = 2048, POOLW = 2048, INW = 8192;
constexpr int NMOD = 6 * DM;
constexpr int PQ = 2048;
constexpr int NEXP = 16384;
constexpr float RMS_EPS = 1e-6f;
constexpr float LOG2E = 1.4426950408889634f;
constexpr float QSCALE = 0.08838834764831845f * LOG2E;
constexpr float H8SCALE = 16.f, W8SCALE = 64.f;
constexpr float A8SCALE = 64.f, P8SCALE = 16.f, WO8SCALE = 64.f;
constexpr int KS_ADA = 64;

constexpr size_t MiB = 1u << 20;
constexpr size_t WS_CTL = 0, CTL_ZERO_BYTES = 1 * MiB;
constexpr size_t WS_MODV = 1 * MiB;
constexpr size_t WS_SCL = 2 * MiB;
constexpr size_t WS_MODP = 4 * MiB;
constexpr size_t WS_SKT = 20 * MiB;
constexpr size_t WS_PWS = 22 * MiB;
constexpr size_t WS_WQST = 24 * MiB;
constexpr size_t WS_WOUT2 = 40 * MiB;
constexpr size_t WS_WINT = 72 * MiB;
constexpr size_t WS_WIN8 = 88 * MiB;
constexpr size_t WS_H8 = 1100 * MiB;
constexpr size_t WS_UB = 136 * MiB;
constexpr size_t WS_VB = 264 * MiB;
constexpr size_t WS_H = 392 * MiB;
constexpr size_t WS_PROJ = 520 * MiB;
constexpr size_t WS_QKVH = 1292 * MiB;
constexpr size_t WS_MIXIN = 776 * MiB;
constexpr size_t WS_WOPT = 904 * MiB;
constexpr size_t WS_WQB = 936 * MiB;
constexpr size_t WS_O0 = 968 * MiB, WS_O1 = 1032 * MiB;
constexpr size_t WS_LSE = 1096 * MiB;
constexpr size_t WS_SC = 1164 * MiB;
constexpr size_t WS_END = 1484 * MiB;

constexpr int RING_OFF = 0, RING_BYTES = 131072;
constexpr int ATT_WAVE_BYTES = 17408;
constexpr int SHARED_OFF = 139264;
constexpr int LDSCTL_OFF = 139264 + 4096, MISC_OFF = LDSCTL_OFF + 320;
constexpr int LDS_BYTES = 147456;
constexpr int NWAVES = 8;
constexpr int CW_BAR = 4096;

#define LDS_WAIT() asm volatile("s_waitcnt lgkmcnt(0)" ::: "memory")
#define VM_WAIT() asm volatile("s_waitcnt vmcnt(0)" ::: "memory")

__device__ __forceinline__ unsigned cvt_pk_bf16(float lo, float hi) { unsigned r; asm volatile("v_cvt_pk_bf16_f32 %0, %1, %2" : "=v"(r) : "v"(lo), "v"(hi)); return r; }
__device__ __forceinline__ float bf_lo(unsigned u) { return __uint_as_float(u << 16); }
__device__ __forceinline__ float bf_hi(unsigned u) { return __uint_as_float(u & 0xffff0000u); }
__device__ __forceinline__ float wave_sum(float v) {
#pragma unroll
    for (int o = 1; o < 64; o <<= 1) v += __shfl_xor(v, o);
    return v;
}

namespace pg8 {
typedef unsigned short bf16_t;
typedef int v4i_t __attribute__((ext_vector_type(4)));
typedef int v8i_t __attribute__((ext_vector_type(8)));
constexpr int BM = 256, BK = 64, HALF = 128, HTB = HALF * BK * 2, STAGE_BYTES = 8 * HTB, NXCD = 8, WGM = 8;

__host__ __device__ __forceinline__ int lds_byte(int r, int c) { const int st = (r >> 4) * 2 + (c >> 5), rr = r & 15, cc = c & 31, ob = rr * 64 + cc * 2; return st * 1024 + (ob ^ (((ob >> 9) & 1) << 5)); }
__host__ __device__ __forceinline__ void stage_rc(int b, int& R, int& C) { const int st = b / 1024, sb = b % 1024, swz = sb ^ (((sb >> 9) & 1) << 5); R = (st >> 1) * 16 + swz / 64; C = (st & 1) * 32 + (swz % 64) / 2; }
__host__ __device__ __forceinline__ int perm32(int rho) { const int n = rho >> 4, i = rho & 15; return 8 * (i >> 2) + 4 * n + (i & 3); }

template <int NF> __device__ __forceinline__ void pg8_ldfrag16(bf16x8 (&dst)[NF][2], const LAS unsigned char* base, int off) {
#pragma unroll
    for (int m = 0; m < NF; ++m)
#pragma unroll
        for (int k = 0; k < 2; ++k) dst[m][k] = *(const LAS bf16x8*)(base + off + m * 2048 + k * 1024);
}
template <int NF> __device__ __forceinline__ void pg8_ldfrag8(v8i_t (&dst)[NF], const LAS unsigned char* base, int off1, int off2) {
#pragma unroll
    for (int m = 0; m < NF; ++m) { const v4i_t lo = *(const LAS v4i_t*)(base + off1 + m * 2048), hi = *(const LAS v4i_t*)(base + off2 + m * 2048); dst[m] = __builtin_shufflevector(lo, hi, 0, 1, 2, 3, 4, 5, 6, 7); }
}
__device__ __forceinline__ void pg8_mma16(f32x4 (&acc)[4][2], const bf16x8 (&At)[4][2], const bf16x8 (&Bt)[2][2]) {
#pragma unroll
    for (int m = 0; m < 4; ++m)
#pragma unroll
        for (int n = 0; n < 2; ++n)
#pragma unroll
            for (int k = 0; k < 2; ++k) acc[m][n] = __builtin_amdgcn_mfma_f32_16x16x32_bf16(Bt[n][k], At[m][k], acc[m][n], 0, 0, 0);
}
__device__ __forceinline__ void pg8_mma8(f32x4 (&acc)[4][2], const v8i_t (&At)[4], const v8i_t (&Bt)[2]) {
    int sc = 0x7F7F7F7F;
#pragma unroll
    for (int m = 0; m < 4; ++m)
#pragma unroll
        for (int n = 0; n < 2; ++n) asm volatile("v_mfma_scale_f32_16x16x128_f8f6f4 %0, %1, %2, %0, %3, %3 op_sel_hi:[0,0,0]" : "+v"(acc[m][n]) : "v"(Bt[n]), "v"(At[m]), "v"(sc));
}
struct Unit { int pm, pn; };
struct Gemm { const bf16_t* A; const bf16_t* Bt; int M, N, K, lda, ldb, agrp_div, agrp_cols, bgrp_div, bgrp_cols; };

struct StaticOrder {
    int nM, nN, nwg, G, c;
    __host__ __device__ void init(int M_, int N_, int G_, int c_) { nM = M_ / BM; nN = N_ / BM; nwg = nM * nN; G = G_; c = c_; }
    __host__ __device__ bool next(int i, Unit& u) const {
        const long L = (long)i * G + c; if (L >= nwg) return false;
        int wgid = (int)L; { const int q = nwg / NXCD, r = nwg % NXCD, xcd = wgid % NXCD, off = wgid / NXCD; wgid = (xcd < r ? xcd * (q + 1) : r * (q + 1) + (xcd - r) * q) + off; }
        const int nig = WGM * nN, gid = wgid / nig, fm = gid * WGM, gsz = (nM - fm) < WGM ? (nM - fm) : WGM;
        u.pm = fm + ((wgid % nig) % gsz); u.pn = (wgid % nig) / gsz; return true;
    }
    __device__ __forceinline__ void a_ready(const Unit&) const {}
    __device__ __forceinline__ void done(const Unit&) const {}
};

struct EpiBf16 {
    static constexpr bool PERM = true, AFTER_DRAIN = false;
    bf16_t* O; int ldc; int scale_cols; float scale0; bf16_t* HM; int hm_cols; int hm_rows; float scale1 = 1.0f;
    __device__ __forceinline__ void operator()(const f32x4 (&acc)[2][2][4][2], const Unit& u, int wr, int wc, int fr, int fq) const {
        const int row0 = u.pm * BM + wr * 64 + fr; const int colt = u.pn * BM;
        const float sc = (colt < scale_cols) ? scale0 : scale1;
        const bool hm = colt < hm_cols;
        const int cw = wc * 32 + 8 * fq;
        bf16_t* base = hm ? HM + (size_t)(colt / HALF) * hm_rows * HALF + cw : O + (colt - hm_cols) + cw;
        const size_t rpitch = hm ? (size_t)HALF : (size_t)ldc, hstep = hm ? (size_t)hm_rows * HALF : (size_t)HALF;
#pragma unroll
        for (int ai = 0; ai < 2; ++ai)
#pragma unroll
            for (int m = 0; m < 4; ++m) { bf16_t* rowp = base + (size_t)(row0 + ai * HALF + m * 16) * rpitch;
#pragma unroll
                for (int bj = 0; bj < 2; ++bj) { f32x4 v0 = acc[ai][bj][m][0] * sc, v1 = acc[ai][bj][m][1] * sc;
                    v4u w; w.x = cvt_pk_bf16(v0[0], v0[1]); w.y = cvt_pk_bf16(v0[2], v0[3]); w.z = cvt_pk_bf16(v1[0], v1[1]); w.w = cvt_pk_bf16(v1[2], v1[3]);
                    *(v4u*)(rowp + bj * hstep) = w; } }
    }
};
struct EpiBf16ColScale {
    static constexpr bool PERM = true, AFTER_DRAIN = false;
    bf16_t* O; int ldc; int coff; const float* cs;
    __device__ __forceinline__ void operator()(const f32x4 (&acc)[2][2][4][2], const Unit& u, int wr, int wc, int fr, int fq) const {
        const int row0 = u.pm * BM + wr * 64 + fr; const int col0 = u.pn * BM + wc * 32 + 8 * fq;
        f32x4 sv[2][2];
#pragma unroll
        for (int bj = 0; bj < 2; ++bj)
#pragma unroll
            for (int n = 0; n < 2; ++n) sv[bj][n] = *(const f32x4*)(cs + col0 + bj * HALF + 4 * n);
#pragma unroll
        for (int ai = 0; ai < 2; ++ai)
#pragma unroll
            for (int m = 0; m < 4; ++m) { bf16_t* rowp = O + (size_t)(row0 + ai * HALF + m * 16) * ldc + coff + col0;
#pragma unroll
                for (int bj = 0; bj < 2; ++bj) { f32x4 v0 = acc[ai][bj][m][0] * sv[bj][0], v1 = acc[ai][bj][m][1] * sv[bj][1];
                    v4u w; w.x = cvt_pk_bf16(v0[0], v0[1]); w.y = cvt_pk_bf16(v0[2], v0[3]); w.z = cvt_pk_bf16(v1[0], v1[1]); w.w = cvt_pk_bf16(v1[2], v1[3]);
                    *(v4u*)(rowp + bj * HALF) = w; } }
    }
};
struct EpiFp8 {
    static constexpr bool PERM = true, AFTER_DRAIN = false;
    unsigned char* O; int ldc; int coff; float scale;
    __device__ __forceinline__ void operator()(const f32x4 (&acc)[2][2][4][2], const Unit& u, int wr, int wc, int fr, int fq) const {
        const int row0 = u.pm * BM + wr * 64 + fr; const int col0 = u.pn * BM + wc * 32 + 8 * fq;
#pragma unroll
        for (int ai = 0; ai < 2; ++ai)
#pragma unroll
            for (int m = 0; m < 4; ++m) { unsigned char* rowp = O + (size_t)(row0 + ai * HALF + m * 16) * ldc + coff + col0;
#pragma unroll
                for (int bj = 0; bj < 2; ++bj) { const f32x4 v0 = acc[ai][bj][m][0] * scale, v1 = acc[ai][bj][m][1] * scale; int lo = 0, hi = 0;
                    lo = __builtin_amdgcn_cvt_pk_fp8_f32(v0[0], v0[1], lo, false); lo = __builtin_amdgcn_cvt_pk_fp8_f32(v0[2], v0[3], lo, true);
                    hi = __builtin_amdgcn_cvt_pk_fp8_f32(v1[0], v1[1], hi, false); hi = __builtin_amdgcn_cvt_pk_fp8_f32(v1[2], v1[3], hi, true);
                    *(v2u*)(rowp + bj * HALF) = (v2u){(unsigned)lo, (unsigned)hi}; } }
    }
};
struct EpiResBf16 {
    static constexpr bool PERM = true, AFTER_DRAIN = false;
    const float* X; const float* gate; bf16_t* O; int ldc; float ascale;
    __device__ __forceinline__ void operator()(const f32x4 (&acc)[2][2][4][2], const Unit& u, int wr, int wc, int fr, int fq) const {
        const int row0 = u.pm * BM + wr * 64 + fr; const int col0 = u.pn * BM + wc * 32 + 8 * fq; const int b = (u.pm * BM) / SEQ;
        f32x4 gv[2][2];
#pragma unroll
        for (int bj = 0; bj < 2; ++bj)
#pragma unroll
            for (int n = 0; n < 2; ++n) gv[bj][n] = *(const f32x4*)(gate + (size_t)b * DM + col0 + bj * HALF + 4 * n) * ascale;
#pragma unroll
        for (int ai = 0; ai < 2; ++ai)
#pragma unroll
            for (int m = 0; m < 4; ++m) { const size_t off = (size_t)(row0 + ai * HALF + m * 16) * ldc + col0;
#pragma unroll
                for (int bj = 0; bj < 2; ++bj) { const f32x4 x0 = *(const f32x4*)(X + off + bj * HALF), x1 = *(const f32x4*)(X + off + bj * HALF + 4);
                    const f32x4 v0 = x0 + gv[bj][0] * acc[ai][bj][m][0], v1 = x1 + gv[bj][1] * acc[ai][bj][m][1];
                    v4u w; w.x = cvt_pk_bf16(v0[0], v0[1]); w.y = cvt_pk_bf16(v0[2], v0[3]); w.z = cvt_pk_bf16(v1[0], v1[1]); w.w = cvt_pk_bf16(v1[2], v1[3]);
                    *(v4u*)(O + off + bj * HALF) = w; } }
    }
};
struct EpiResF32 {
    static constexpr bool PERM = false, AFTER_DRAIN = false;
    const float* X; const float* gate; float* O; int ldc;
    __device__ __forceinline__ void operator()(const f32x4 (&acc)[2][2][4][2], const Unit& u, int wr, int wc, int fr, int fq) const {
        const int row0 = u.pm * BM + wr * 64 + fr; const int col0 = u.pn * BM + wc * 32 + 4 * fq; const int b = (u.pm * BM) / SEQ;
        f32x4 gv[2][2];
#pragma unroll
        for (int bj = 0; bj < 2; ++bj)
#pragma unroll
            for (int n = 0; n < 2; ++n) gv[bj][n] = *(const f32x4*)(gate + (size_t)b * DM + col0 + bj * HALF + n * 16);
#pragma unroll
        for (int ai = 0; ai < 2; ++ai)
#pragma unroll
            for (int m = 0; m < 4; ++m) { const size_t off = (size_t)(row0 + ai * HALF + m * 16) * ldc + col0;
#pragma unroll
                for (int bj = 0; bj < 2; ++bj)
#pragma unroll
                    for (int n = 0; n < 2; ++n) { const f32x4 xv = *(const f32x4*)(X + off + bj * HALF + n * 16);
                        *(f32x4*)(O + off + bj * HALF + n * 16) = xv + gv[bj][n] * acc[ai][bj][m][n]; } }
    }
};
struct EpiF32 {
    static constexpr bool PERM = false, AFTER_DRAIN = false;
    float* O; int ldc;
    __device__ __forceinline__ void operator()(const f32x4 (&acc)[2][2][4][2], const Unit& u, int wr, int wc, int fr, int fq) const {
        const int row0 = u.pm * BM + wr * 64 + fr; const int col0 = u.pn * BM + wc * 32 + 4 * fq;
#pragma unroll
        for (int ai = 0; ai < 2; ++ai)
#pragma unroll
            for (int m = 0; m < 4; ++m) { const size_t off = (size_t)(row0 + ai * HALF + m * 16) * ldc + col0;
#pragma unroll
                for (int bj = 0; bj < 2; ++bj)
#pragma unroll
                    for (int n = 0; n < 2; ++n) *(f32x4*)(O + off + bj * HALF + n * 16) = acc[ai][bj][m][n]; }
    }
};

template <class Epi, class Sched, bool ALIGN_EPI, bool FP8 = false>
__device__ __forceinline__ void gemm_phase(LAS unsigned char* lds, const Gemm g, const Sched& S, const Epi& E) {
    int tid_ = threadIdx.x; asm volatile("" : "+v"(tid_));
    const int tid = tid_, wid = __builtin_amdgcn_readfirstlane(tid >> 6), lane = tid & 63, wr = wid >> 2, wc = wid & 3, fr = lane & 15, fq = lane >> 4;
    const int K = g.K, nt = K / BK;
    unsigned voffA, voffB;
    { int R, C; stage_rc(tid * 16, R, C); const int Rb = Epi::PERM ? ((R & ~31) + perm32(R & 31)) : R;
      voffA = (unsigned)(R * g.lda + C) * 2u; voffB = (unsigned)(Rb * g.ldb + C) * 2u; }
    const size_t pstepA = (size_t)64 * g.lda * 2, pstepB = (size_t)64 * g.ldb * 2;
    const size_t kstep = (size_t)(BK * 2);
    const size_t hstepA = (size_t)HALF * g.lda * 2, hstepB = (size_t)HALF * g.ldb * 2;
    const size_t tstepA = 2 * hstepA, tstepB = 2 * hstepB;
    const unsigned ldsw = (unsigned)wid * 1024u;
    const int aoff = lds_byte(wr * 64 + fr, fq * 8), boff = lds_byte(wc * 32 + fr, fq * 8);
    const int h8 = (fq >> 1) & 1;
    const int aoff1 = lds_byte(wr * 64 + fr, fq * 16 + h8 * 8), aoff2 = lds_byte(wr * 64 + fr, fq * 16 + (1 - h8) * 8);
    const int boff1 = lds_byte(wc * 32 + fr, fq * 16 + h8 * 8), boff2 = lds_byte(wc * 32 + fr, fq * 16 + (1 - h8) * 8);
#define PG8_SA(b, h) (((b) * 2 + (h)) * HTB)
#define PG8_SB(b, h) ((4 + (b) * 2 + (h)) * HTB)
#define PG8_STAGE(bufoff, gbase, voff) do { _Pragma("unroll") for (int _i = 0; _i < 2; ++_i) \
        __builtin_amdgcn_global_load_lds((const unsigned*)((const char*)(gbase) + (size_t)_i * pstep_##voff + (voff)), (LAS unsigned*)(lds + (bufoff) + ldsw + _i * 8192), 16, 0, 0); } while (0)
#define pstep_voffA pstepA
#define pstep_voffB pstepB
#define PG8_LDA(dst, b, h) do { if constexpr (FP8) pg8_ldfrag8<4>(dst##8, lds + PG8_SA(b, h), aoff1, aoff2); else pg8_ldfrag16<4>(dst, lds + PG8_SA(b, h), aoff); } while (0)
#define PG8_LDB(dst, b, h) do { if constexpr (FP8) pg8_ldfrag8<2>(dst##8, lds + PG8_SB(b, h), boff1, boff2); else pg8_ldfrag16<2>(dst, lds + PG8_SB(b, h), boff); } while (0)
#define PG8_MMA(ai, bj, At, Bt) do { __builtin_amdgcn_s_setprio(1); if constexpr (FP8) pg8_mma8(acc[ai][bj], At##8, Bt##8); else pg8_mma16(acc[ai][bj], At, Bt); __builtin_amdgcn_s_setprio(0); } while (0)
#define PG8_WAIT_V(n) asm volatile("s_waitcnt vmcnt(" #n ")" ::: "memory")
#define PG8_WAIT_L(n) asm volatile("s_waitcnt lgkmcnt(" #n ")" ::: "memory")
#define PG8_BAR __builtin_amdgcn_s_barrier()
#define PG8_SCHED __builtin_amdgcn_sched_barrier(0)
#define PG8_ABASE(u) ((const char*)g.A + (size_t)(u).pm * tstepA + (size_t)((u).pn / g.agrp_div) * (size_t)g.agrp_cols * 2)
#define PG8_BBASE(u) ((const char*)g.Bt + (size_t)(u).pn * tstepB + (size_t)((u).pm / g.bgrp_div) * (size_t)g.bgrp_cols * 2)
    Unit cur, nxt; int ui = 0;
    if (!S.next(0, cur)) return;
    f32x4 acc[2][2][4][2];
#pragma unroll
    for (int a = 0; a < 2; ++a)
#pragma unroll
        for (int b = 0; b < 2; ++b)
#pragma unroll
            for (int m = 0; m < 4; ++m)
#pragma unroll
                for (int n = 0; n < 2; ++n) acc[a][b][m][n] = (f32x4){0.f, 0.f, 0.f, 0.f};
    bf16x8 At[4][2], B0[2][2], B1[2][2]; v8i_t At8[4], B08[2], B18[2];
    const char* cA = PG8_ABASE(cur); const char* cB = PG8_BBASE(cur);
    S.a_ready(cur);
    PG8_STAGE(PG8_SB(0, 0), cB, voffB); PG8_STAGE(PG8_SB(0, 1), cB + hstepB, voffB); PG8_STAGE(PG8_SA(0, 0), cA, voffA); PG8_STAGE(PG8_SA(0, 1), cA + hstepA, voffA);
    if (wr == 1) PG8_BAR;
    PG8_WAIT_V(2); PG8_BAR;
    PG8_STAGE(PG8_SB(1, 0), cB + kstep, voffB); PG8_STAGE(PG8_SA(1, 0), cA + kstep, voffA); PG8_STAGE(PG8_SB(1, 1), cB + hstepB + kstep, voffB);
    PG8_WAIT_V(6); PG8_BAR;
    for (;;) {
        const bool has_next = S.next(ui + 1, nxt);
        const char* nA = has_next ? PG8_ABASE(nxt) : cA; const char* nB = has_next ? PG8_BBASE(nxt) : cB;
        for (int t = 0; t < nt; t += 2) {
            const bool last = (t == nt - 2);
            const char* a1 = cA + (size_t)(t + 1) * kstep;
            const char* a2 = last ? nA : cA + (size_t)(t + 2) * kstep; const char* b2 = last ? nB : cB + (size_t)(t + 2) * kstep;
            const char* a3 = a2 + kstep; const char* b3 = b2 + kstep;
            if (last && has_next) S.a_ready(nxt);
            PG8_LDB(B0, 0, 0); PG8_LDB(B1, 0, 1); PG8_SCHED; PG8_LDA(At, 0, 0); PG8_STAGE(PG8_SA(1, 1), a1 + hstepA, voffA);
            PG8_WAIT_V(8); PG8_WAIT_L(0); PG8_BAR; PG8_MMA(0, 0, At, B0); PG8_MMA(0, 1, At, B1); PG8_BAR; PG8_SCHED;
            PG8_LDA(At, 0, 1); PG8_STAGE(PG8_SB(0, 0), b2, voffB); PG8_STAGE(PG8_SB(0, 1), b2 + hstepB, voffB); PG8_STAGE(PG8_SA(0, 0), a2, voffA);
            PG8_WAIT_V(8); PG8_WAIT_L(0); PG8_BAR; PG8_MMA(1, 0, At, B0); PG8_MMA(1, 1, At, B1); PG8_BAR; PG8_SCHED;
            PG8_LDB(B0, 1, 0); PG8_LDB(B1, 1, 1); PG8_SCHED; PG8_LDA(At, 1, 0); PG8_STAGE(PG8_SA(0, 1), a2 + hstepA, voffA);
            PG8_WAIT_V(8); PG8_WAIT_L(0); PG8_BAR; PG8_MMA(0, 0, At, B0); PG8_MMA(0, 1, At, B1); PG8_BAR; PG8_SCHED;
            PG8_LDA(At, 1, 1); PG8_STAGE(PG8_SB(1, 0), b3, voffB); PG8_STAGE(PG8_SB(1, 1), b3 + hstepB, voffB); PG8_STAGE(PG8_SA(1, 0), a3, voffA);
            PG8_WAIT_V(8); PG8_WAIT_L(0); PG8_BAR; PG8_MMA(1, 0, At, B0); PG8_MMA(1, 1, At, B1); PG8_BAR; PG8_SCHED;
        }
        if constexpr (ALIGN_EPI) { if (wr == 0) PG8_BAR; }
        if constexpr (FP8) asm volatile("s_nop 15\n\ts_nop 15" ::: "memory");
        if constexpr (FP8) { int ln_ = lane; asm volatile("" : "+v"(ln_));
          E(acc, cur, wr, wc, ln_ & 15, ln_ >> 4); } else E(acc, cur, wr, wc, fr, fq);
        S.done(cur);
        if (!has_next) break;
#pragma unroll
        for (int a = 0; a < 2; ++a)
#pragma unroll
            for (int b = 0; b < 2; ++b)
#pragma unroll
                for (int m = 0; m < 4; ++m)
#pragma unroll
                    for (int n = 0; n < 2; ++n) acc[a][b][m][n] = (f32x4){0.f, 0.f, 0.f, 0.f};
        cur = nxt; cA = nA; cB = nB; ++ui;
        if constexpr (ALIGN_EPI) { if (wr == 1) PG8_BAR; }
    }
    PG8_WAIT_V(0);
    if constexpr (!ALIGN_EPI) { if (wr == 0) PG8_BAR; }
    PG8_BAR;
#undef PG8_SA
#undef PG8_SB
#undef PG8_STAGE
#undef pstep_voffA
#undef pstep_voffB
#undef PG8_LDA
#undef PG8_LDB
#undef PG8_MMA
#undef PG8_WAIT_V
#undef PG8_WAIT_L
#undef PG8_BAR
#undef PG8_SCHED
#undef PG8_ABASE
#undef PG8_BBASE
}
}

#define XB_TMO      128
#define XB_XCNT(j)  (256  + 64 * (j))
#define XB_XSUB(j)  (1280 + 64 * (j))
#define XB_XGEN(j)  (2304 + 64 * (j))
#define XB_TOP      3328
#define XB_TOPGEN   3392
#define XCD_BAR_WORDS 3456
#define XB_SPIN_CAP (1u << 18)

__device__ __forceinline__ unsigned xb_ld(unsigned* p)              { return __hip_atomic_load(p, __ATOMIC_RELAXED, __HIP_MEMORY_SCOPE_AGENT); }
__device__ __forceinline__ unsigned xb_add(unsigned* p, unsigned v) { return __hip_atomic_fetch_add(p, v, __ATOMIC_RELAXED, __HIP_MEMORY_SCOPE_AGENT); }
__device__ __forceinline__ unsigned xb_xcc_id() { return (unsigned)__builtin_amdgcn_s_getreg((3 << 11) | 20) & 0xFu; }
#define XB_SPIN(cond, bar) do { unsigned _sp = 0; while (cond) { __builtin_amdgcn_s_sleep(1); \
    if ((++_sp & 255u) == 0u) { if (xb_ld(&(bar)[XB_TMO])) break; if (_sp > XB_SPIN_CAP) { atomicAdd(&(bar)[XB_TMO], 1u); break; } } } } while (0)

struct XcdBarrier { unsigned* bar; unsigned x; volatile LAS unsigned* st; };

__device__ __forceinline__ XcdBarrier xcd_barrier_post(unsigned* bar, volatile LAS unsigned* st) {
    XcdBarrier b; b.bar = bar; b.x = xb_xcc_id(); b.st = st;
    if (threadIdx.x == 0) (void)xb_add(&bar[XB_XCNT(b.x)], 1u);
    return b;
}
__device__ __forceinline__ void xcd_barrier_complete(unsigned* bar, unsigned x, unsigned& nloc, unsigned& nx) {
    const unsigned G = gridDim.x * gridDim.y * gridDim.z;
    unsigned sum, cnt, mine, sp = 0u;
    for (;;) {
        sum = 0u; cnt = 0u; mine = 0u;
#pragma unroll
        for (unsigned j = 0; j < 16; ++j) { const unsigned c = xb_ld(&bar[XB_XCNT(j)]); sum += c; cnt += (c > 0u) ? 1u : 0u; mine = (j == x) ? c : mine; }
        if (sum == G) break;
        __builtin_amdgcn_s_sleep(1);
        if ((++sp & 255u) == 0u) { if (xb_ld(&bar[XB_TMO])) break; if (sp > XB_SPIN_CAP) { atomicAdd(&bar[XB_TMO], 1u); break; } }
    }
    nloc = mine > 0u ? mine : 1u; nx = cnt > 0u ? cnt : 1u;
}
__device__ __forceinline__ void xcd_barrier(const XcdBarrier& b) {
    asm volatile("s_waitcnt vmcnt(0)" ::: "memory");
    __syncthreads();
    if (threadIdx.x == 0) {
        unsigned* bar = b.bar;
        __builtin_amdgcn_s_waitcnt(0);
        unsigned nloc = b.st[0], nx = b.st[1];
        if (nloc == 0u) { xcd_barrier_complete(bar, b.x, nloc, nx); b.st[0] = nloc; b.st[1] = nx; }
        const unsigned old = xb_add(&bar[XB_XSUB(b.x)], 1u);
        const unsigned gen = old / nloc;
        if (old + 1u == (gen + 1u) * nloc) {
            __builtin_amdgcn_fence(__ATOMIC_RELEASE, "agent");
            asm volatile("s_waitcnt vmcnt(0)" ::: "memory");
            const unsigned og = xb_add(&bar[XB_TOP], 1u);
            const unsigned tg = og / nx;
            if (og + 1u == (tg + 1u) * nx) xb_add(&bar[XB_TOPGEN], 1u);
            else XB_SPIN(xb_ld(&bar[XB_TOPGEN]) == tg, bar);
            __builtin_amdgcn_fence(__ATOMIC_ACQUIRE, "agent");
            xb_add(&bar[XB_XGEN(b.x)], 1u);
            asm volatile("s_waitcnt vmcnt(0)" ::: "memory");
        } else {
            XB_SPIN(xb_ld(&bar[XB_XGEN(b.x)]) == gen, bar);
            __builtin_amdgcn_fence(__ATOMIC_ACQUIRE, "agent");
            asm volatile("s_waitcnt vmcnt(0)" ::: "memory");
        }
    }
    __syncthreads();
}

template <bool F8>
__device__ __forceinline__ void p0_transpose_item(const float* W, int ldw, int N, void* WTv, int ldt, float scale, LAS float* scr, int item, int lane) {
    const int nblk = N / 32, kb = item / nblk, nb = item % nblk, k0 = 64 * kb, n0 = 32 * nb;
#pragma unroll 8
    for (int i = 0; i < 32; ++i) { const int kk = 2 * i + (lane >> 5); scr[kk * 33 + (lane & 31)] = W[(size_t)(k0 + kk) * ldw + n0 + (lane & 31)]; }
    LDS_WAIT(); asm volatile("" ::: "memory");
    const int c = lane & 7;
#pragma unroll
    for (int j = 0; j < 4; ++j) { const int n = (lane >> 3) + 8 * j; const LAS float* s = scr + (8 * c) * 33 + n;
        if constexpr (F8) { int lo = 0, hi = 0;
            lo = __builtin_amdgcn_cvt_pk_fp8_f32(s[0 * 33] * scale, s[1 * 33] * scale, lo, false); lo = __builtin_amdgcn_cvt_pk_fp8_f32(s[2 * 33] * scale, s[3 * 33] * scale, lo, true);
            hi = __builtin_amdgcn_cvt_pk_fp8_f32(s[4 * 33] * scale, s[5 * 33] * scale, hi, false); hi = __builtin_amdgcn_cvt_pk_fp8_f32(s[6 * 33] * scale, s[7 * 33] * scale, hi, true);
            *(GAS v2u*)((unsigned char*)WTv + (size_t)(n0 + n) * ldt + k0 + 8 * c) = (v2u){(unsigned)lo, (unsigned)hi};
        } else {
            v4u o; o.x = cvt_pk_bf16(s[0 * 33], s[1 * 33]); o.y = cvt_pk_bf16(s[2 * 33], s[3 * 33]); o.z = cvt_pk_bf16(s[4 * 33], s[5 * 33]); o.w = cvt_pk_bf16(s[6 * 33], s[7 * 33]);
            *(GAS v4u*)((bf16*)WTv + (size_t)(n0 + n) * ldt + k0 + 8 * c) = o; } }
    LDS_WAIT(); asm volatile("" ::: "memory");
}

__device__ __forceinline__ int t5_bucket(int rel) {
    int n = -rel; const int ret = n < 0 ? 16 : 0; n = n < 0 ? -n : n;
    if (n < 8) return ret + n;
    const float v = logf((float)n / 8.0f) / logf(128.0f) * 8.0f;
    int large = 8 + (int)v; large = large < 15 ? large : 15;
    return ret + large;
}
__device__ __forceinline__ float gelu_tanh(float x) {
    const float z = 0.7978845608028654f * (x + 0.044715f * x * x * x);
    const float e = __expf(2.0f * z);
    const float t = 1.0f - 2.0f / (e + 1.0f);
    return 0.5f * x * (1.0f + t);
}
__device__ __forceinline__ unsigned fkey(float v) { const unsigned u = __float_as_uint(v); return (u >> 31) ? ~u : (u | 0x80000000u); }
__device__ __forceinline__ float fdec(unsigned key) { const unsigned k2 = key & ~127u; const unsigned u = (k2 >> 31) ? (k2 & 0x7fffffffu) : (~k2 & ~127u); return __uint_as_float(u); }
template <int LJ> __device__ __forceinline__ unsigned xshfl(unsigned x, const int lane) {
    if constexpr (LJ == 1) return (unsigned)__builtin_amdgcn_update_dpp(0, (int)x, 0xB1, 0xF, 0xF, false);
    else if constexpr (LJ == 2) return (unsigned)__builtin_amdgcn_update_dpp(0, (int)x, 0x4E, 0xF, 0xF, false);
    else if constexpr (LJ == 4) { const int y = __builtin_amdgcn_update_dpp(0, (int)x, 0x141, 0xF, 0xF, false); return (unsigned)__builtin_amdgcn_update_dpp(0, y, 0x1B, 0xF, 0xF, false); }
    else if constexpr (LJ == 8) { const int y = __builtin_amdgcn_update_dpp(0, (int)x, 0x140, 0xF, 0xF, false); return (unsigned)__builtin_amdgcn_update_dpp(0, y, 0x141, 0xF, 0xF, false); }
    else if constexpr (LJ == 16) return (unsigned)__builtin_amdgcn_ds_swizzle((int)x, 0x401F);
    else { const auto rr = __builtin_amdgcn_permlane32_swap(x, x, false, false); return lane < 32 ? rr[1] : rr[0]; }
}
template <int K, int J> __device__ __forceinline__ void bitonic_step(unsigned& a0, unsigned& a1, unsigned& b0, unsigned& b1, const int lane) {
    const bool asc = (K == 128) ? true : ((lane & (K >> 1)) == 0);
    if constexpr (J == 1) {
        const unsigned la = a0 < a1 ? a0 : a1, ha = a0 < a1 ? a1 : a0, lb = b0 < b1 ? b0 : b1, hb = b0 < b1 ? b1 : b0;
        a0 = asc ? la : ha; a1 = asc ? ha : la; b0 = asc ? lb : hb; b1 = asc ? hb : lb;
    } else {
        constexpr int LJ = J >> 1; const bool tmin = (((lane & LJ) == 0) == asc);
        const unsigned pa0 = xshfl<LJ>(a0, lane), pa1 = xshfl<LJ>(a1, lane), pb0 = xshfl<LJ>(b0, lane), pb1 = xshfl<LJ>(b1, lane);
        a0 = tmin ? (a0 < pa0 ? a0 : pa0) : (a0 < pa0 ? pa0 : a0); a1 = tmin ? (a1 < pa1 ? a1 : pa1) : (a1 < pa1 ? pa1 : a1);
        b0 = tmin ? (b0 < pb0 ? b0 : pb0) : (b0 < pb0 ? pb0 : b0); b1 = tmin ? (b1 < pb1 ? b1 : pb1) : (b1 < pb1 ? pb1 : b1);
    }
    if constexpr (J > 1) bitonic_step<K, (J >> 1)>(a0, a1, b0, b1, lane);
}
template <int K> __device__ __forceinline__ void bitonic_stage(unsigned& a0, unsigned& a1, unsigned& b0, unsigned& b1, const int lane) {
    bitonic_step<K, (K >> 1)>(a0, a1, b0, b1, lane);
    if constexpr (K < 128) bitonic_stage<(K << 1)>(a0, a1, b0, b1, lane);
}
__device__ __forceinline__ void bitonic128x2(unsigned& a0, unsigned& a1, unsigned& b0, unsigned& b1, const int lane) { bitonic_stage<2>(a0, a1, b0, b1, lane); }
__device__ __forceinline__ float dot2bf(unsigned a, unsigned b, float c) { return __builtin_amdgcn_fdot2_f32_bf16(__builtin_bit_cast(bf2_t, a), __builtin_bit_cast(bf2_t, b), c, false); }

constexpr int ATT_SLOT = 8704;
__device__ __forceinline__ int crow(int r, int hi) { return (r & 3) + 8 * (r >> 2) + 4 * hi; }

__device__ __forceinline__ void attn_task(const int G, const bf16* QKVH, bf16* O0, bf16* O1, float* LSE0, float* LSE1, unsigned char* MIX8,
                                          const LAS float* btab, LAS unsigned char* wl, int b, int h, int mtile, int tk, int lane) {
    const int SH = 2 * G;
    const int L = SEQ >> SH, TPR = 32 >> SH;
    const int r32 = lane & 31, hi = lane >> 5;
    const int res = tk >> (5 - SH), l0 = ((mtile * 1024) >> SH) + 32 * (tk & (TPR - 1));
    const size_t rowbase = (size_t)b * SEQ;
    const int srow = lane >> 4, sch = lane & 15;
    const int rot = (tk & 1) ? 4 : 0;
#define ATT_JR(j) (((j) + rot) >= 5 ? ((j) + rot - 5) : ((j) + rot))
#define ATT_WAITV(n) asm volatile("s_waitcnt vmcnt(" #n ")" ::: "memory")
#define ATT_ISSUE(n) do { LAS unsigned char* sl_ = wl + ((n) & 1) * ATT_SLOT; const int jt_ = ATT_JR((n) < 5 ? (n) : (n) - 5); \
        _Pragma("unroll") for (int i_ = 0; i_ < 8; ++i_) { \
            const int key_ = (n) < 5 ? (4 * i_ + srow) : ((i_ & 3) + 4 * srow + 16 * (i_ >> 2)); \
            int lk_ = l0 - 64 + 32 * jt_ + key_; lk_ = lk_ < 0 ? 0 : (lk_ > L - 1 ? L - 1 : lk_); \
            const int ch_ = (n) < 5 ? (sch ^ (key_ & 7)) : sch; \
            const bf16* src_ = QKVH + ((size_t)(((n) < 5 ? NH : 2 * NH) + h) * M + rowbase + ((size_t)lk_ << SH) + res) * HD + ch_ * 8; \
            __builtin_amdgcn_global_load_lds((const unsigned*)src_, (LAS unsigned*)(sl_ + i_ * ((n) < 5 ? 1024 : 1088)), 16, 0, 0); } } while (0)
    const size_t qrow = rowbase + ((size_t)(l0 + r32) << SH) + res;
    bf16x8 qr[8];
    { const bf16* qp = QKVH + ((size_t)h * M + qrow) * HD + hi * 8;
#pragma unroll
      for (int d0 = 0; d0 < 8; ++d0) qr[d0] = *(const bf16x8*)(qp + d0 * 16); }
    ATT_ISSUE(0); ATT_ISSUE(1);
    f32x16 p[5];
#define ATT_KTILE(n) do { LAS unsigned char* sl_ = wl + ((n) & 1) * ATT_SLOT + r32 * 256; f32x16 s_ = {}; \
        _Pragma("unroll") for (int d0 = 0; d0 < 8; ++d0) { const bf16x8 a_ = *(const LAS bf16x8*)(sl_ + (((2 * d0 + hi) ^ (r32 & 7)) << 4)); s_ = __builtin_amdgcn_mfma_f32_32x32x16_bf16(a_, qr[d0], s_, 0, 0, 0); } \
        p[n] = s_; asm volatile("" ::: "memory"); } while (0)
    ATT_WAITV(8); ATT_KTILE(0); ATT_ISSUE(2);
    ATT_WAITV(8); ATT_KTILE(1); ATT_ISSUE(3);
    ATT_WAITV(8); ATT_KTILE(2); ATT_ISSUE(4);
    ATT_WAITV(8); ATT_KTILE(3); ATT_ISSUE(5);
    ATT_WAITV(8); ATT_KTILE(4); ATT_ISSUE(6);
    float mx = -1e30f;
    const bool edge = (l0 - 64 < 0) || (l0 + 96 > L);
    const LAS float* bt = btab + G * 256 + 32 + 4 * hi - r32;
#pragma unroll
    for (int j = 0; j < 5; ++j) {
        const int jr = ATT_JR(j); const LAS float* btj = bt + 32 * jr;
#pragma unroll
        for (int r = 0; r < 16; ++r) {
            const int kc = 32 * jr + (r & 3) + 8 * (r >> 2);
            float v = p[j][r] + btj[(r & 3) + 8 * (r >> 2)];
            if (edge) { const int lk = l0 - 64 + kc + 4 * hi; v = (lk >= 0 && lk < L) ? v : -1e30f; }
            p[j][r] = v; mx = fmaxf(mx, v);
        }
        asm volatile("" ::: "memory");
    }
    mx = fmaxf(mx, __shfl_xor(mx, 32));
    float ls = 0.f;
    bf16x8 pb[5][2];
#pragma unroll
    for (int j = 0; j < 5; ++j) {
        float e[16];
#pragma unroll
        for (int r = 0; r < 16; ++r) { e[r] = __builtin_amdgcn_exp2f(p[j][r] - mx); ls += e[r]; }
#pragma unroll
        for (int s = 0; s < 2; ++s) { v4u w; w.x = cvt_pk_bf16(e[8 * s + 0], e[8 * s + 1]); w.y = cvt_pk_bf16(e[8 * s + 2], e[8 * s + 3]);
            w.z = cvt_pk_bf16(e[8 * s + 4], e[8 * s + 5]); w.w = cvt_pk_bf16(e[8 * s + 6], e[8 * s + 7]); pb[j][s] = __builtin_bit_cast(bf16x8, w); }
    }
    ls += __shfl_xor(ls, 32);
    asm volatile("" ::: "memory");
    f32x16 o[4] = {};
    const int i16 = lane & 15, g16 = lane >> 4;
    const unsigned vbase = (unsigned)(uintptr_t)wl + (unsigned)((i16 >> 2) * 1088 + hi * 256 + (16 * (g16 & 1) + 4 * (i16 & 3)) * 2);
#define ATT_VTILE(n) do { const unsigned va_ = vbase + ((n) & 1) * ATT_SLOT; \
        _Pragma("unroll") for (int dt = 0; dt < 4; ++dt) { s16x4 lo0, hi0, lo1, hi1; \
            asm volatile("ds_read_b64_tr_b16 %0, %4 offset:%5\n\tds_read_b64_tr_b16 %1, %4 offset:%6\n\tds_read_b64_tr_b16 %2, %4 offset:%7\n\tds_read_b64_tr_b16 %3, %4 offset:%8\n\ts_waitcnt lgkmcnt(0)" \
                         : "=&v"(lo0), "=&v"(hi0), "=&v"(lo1), "=&v"(hi1) : "v"(va_), "i"(dt * 64), "i"(512 + dt * 64), "i"(4 * 1088 + dt * 64), "i"(4 * 1088 + 512 + dt * 64) : "memory"); \
            const bf16x8 af0 = (bf16x8){lo0[0], lo0[1], lo0[2], lo0[3], hi0[0], hi0[1], hi0[2], hi0[3]}; \
            const bf16x8 af1 = (bf16x8){lo1[0], lo1[1], lo1[2], lo1[3], hi1[0], hi1[1], hi1[2], hi1[3]}; \
            o[dt] = __builtin_amdgcn_mfma_f32_32x32x16_bf16(af0, pb[(n) - 5][0], o[dt], 0, 0, 0); \
            o[dt] = __builtin_amdgcn_mfma_f32_32x32x16_bf16(af1, pb[(n) - 5][1], o[dt], 0, 0, 0); } } while (0)
    ATT_WAITV(8); ATT_VTILE(5); ATT_ISSUE(7);
    ATT_WAITV(8); ATT_VTILE(6); ATT_ISSUE(8);
    ATT_WAITV(8); ATT_VTILE(7); ATT_ISSUE(9);
    ATT_WAITV(8); ATT_VTILE(8);
    ATT_WAITV(0); ATT_VTILE(9);
#undef ATT_WAITV
#undef ATT_ISSUE
#undef ATT_KTILE
#undef ATT_VTILE
#undef ATT_JR
    const float inv = 1.0f / ls;
    const float lse2 = mx + __builtin_amdgcn_logf(ls);
    const size_t orow = qrow;
    if (G < 2) {
        bf16* op = (G == 0 ? O0 : O1) + orow * ATTW + h * HD + 4 * hi;
#pragma unroll
        for (int dt = 0; dt < 4; ++dt)
#pragma unroll
            for (int rg = 0; rg < 4; ++rg) { v2u w; w.x = cvt_pk_bf16(o[dt][4 * rg] * inv, o[dt][4 * rg + 1] * inv); w.y = cvt_pk_bf16(o[dt][4 * rg + 2] * inv, o[dt][4 * rg + 3] * inv);
                *(v2u*)(op + 32 * dt + 8 * rg) = w; }
        if (hi == 0) (G == 0 ? LSE0 : LSE1)[orow * NH + h] = lse2;
    } else {
        const float l0v = LSE0[orow * NH + h], l1v = LSE1[orow * NH + h];
        const float mm = fmaxf(fmaxf(l0v, l1v), lse2);
        const float w0 = __builtin_amdgcn_exp2f(l0v - mm), w1 = __builtin_amdgcn_exp2f(l1v - mm), w2 = __builtin_amdgcn_exp2f(lse2 - mm);
        const float wi = 1.0f / (w0 + w1 + w2);
        const float c0 = w0 * wi, c1 = w1 * wi, c2 = w2 * wi * inv;
        const bf16* p0 = O0 + orow * ATTW + h * HD + 4 * hi; const bf16* p1 = O1 + orow * ATTW + h * HD + 4 * hi;
        unsigned char* op = MIX8 + orow * DM + h * HD + 4 * hi;
#pragma unroll
        for (int dt = 0; dt < 4; ++dt) {
            v2u a[4], c[4];
#pragma unroll
            for (int rg = 0; rg < 4; ++rg) { a[rg] = *(const v2u*)(p0 + 32 * dt + 8 * rg); c[rg] = *(const v2u*)(p1 + 32 * dt + 8 * rg); }
#pragma unroll
            for (int rg = 0; rg < 4; ++rg) {
                const float y0 = c0 * bf_lo(a[rg].x) + c1 * bf_lo(c[rg].x) + c2 * o[dt][4 * rg], y1 = c0 * bf_hi(a[rg].x) + c1 * bf_hi(c[rg].x) + c2 * o[dt][4 * rg + 1];
                const float y2 = c0 * bf_lo(a[rg].y) + c1 * bf_lo(c[rg].y) + c2 * o[dt][4 * rg + 2], y3 = c0 * bf_hi(a[rg].y) + c1 * bf_hi(c[rg].y) + c2 * o[dt][4 * rg + 3];
                int w = 0; w = __builtin_amdgcn_cvt_pk_fp8_f32(y0 * A8SCALE, y1 * A8SCALE, w, false); w = __builtin_amdgcn_cvt_pk_fp8_f32(y2 * A8SCALE, y3 * A8SCALE, w, true); *(unsigned*)(op + 32 * dt + 8 * rg) = (unsigned)w; }
        }
    }
}

constexpr int PER_PHASE = 9;
struct Args { const float* in[16]; float* out; unsigned char* ws; unsigned mask; unsigned pad; };

__constant__ unsigned char CAND_I[64] = {0,0,0,0,0,0,0,0,0,0,0,0,0,0,0,0, 1,1,1,1,1,1,1,1, 2,2,2,2,2, 3,3,3,3, 4,4,4, 5,5, 6,6, 7,7, 8,9,10,11,12,13,14,15, 0,0,0,0,0,0,0,0,0,0,0,0,0,0};
__constant__ unsigned char CAND_J[64] = {0,1,2,3,4,5,6,7,8,9,10,11,12,13,14,15, 0,1,2,3,4,5,6,7, 0,1,2,3,4, 0,1,2,3, 0,1,2, 0,1, 0,1, 0,1, 0,0,0,0,0,0,0,0, 0,0,0,0,0,0,0,0,0,0,0,0,0,0};

__global__ void __launch_bounds__(NWAVES * 64, 2) fwd_kernel(Args args) {
    extern __shared__ __attribute__((aligned(16))) unsigned char lds_raw[];
    LAS unsigned char* lds = (LAS unsigned char*)lds_raw;
    volatile LAS unsigned* MISC = (volatile LAS unsigned*)(lds + MISC_OFF);
    const int tid0 = threadIdx.x, lane0 = tid0 & 63, wave = __builtin_amdgcn_readfirstlane(tid0 >> 6);
#define PHASE_LANES() int tid = tid0; asm volatile("" : "+v"(tid)); const int lane = tid & 63
    const int G = gridDim.x; const int bx = blockIdx.x;
    const int vcu = (G % 8 == 0) ? (bx % 8) * (G / 8) + bx / 8 : bx;
    const int gw = vcu * NWAVES + wave, NGW = G * NWAVES;
    unsigned char* ws = args.ws;
    unsigned* ctl = (unsigned*)(ws + WS_CTL);
    const float* x = args.in[0]; const float* cvec = args.in[1]; const float* w_ada = args.in[2]; const float* b_ada = args.in[3]; const float* g_mix = args.in[4];
    const float* w_in = args.in[5]; const float* rel_bias = args.in[6]; const float* pool_w = args.in[7]; const float* pool_scale = args.in[8]; const float* w_out = args.in[9];
    const float* g_ffn = args.in[10]; const float* peer_wq = args.in[11]; const float* peer_sk = args.in[12]; const float* peer_u = args.in[13]; const float* peer_v = args.in[14];
    const float* g_final = args.in[15];
    float* out = args.out;
    float* MODV = (float*)(ws + WS_MODV); float* MODP = (float*)(ws + WS_MODP);
    bf16* SKT = (bf16*)(ws + WS_SKT); bf16* PWS = (bf16*)(ws + WS_PWS); bf16* WQST = (bf16*)(ws + WS_WQST); unsigned char* WOUT8 = ws + WS_WOUT2;     bf16* WINT = (bf16*)(ws + WS_WINT); unsigned char* WIN8 = ws + WS_WIN8; unsigned char* H8 = ws + WS_H8;
    bf16* WOPT = (bf16*)(ws + WS_WOPT); bf16* WQB = (bf16*)(ws + WS_WQB);
    unsigned char* UB = ws + WS_UB; unsigned char* VB = ws + WS_VB; float* SCL = (float*)(ws + WS_SCL); bf16* H = (bf16*)(ws + WS_H); bf16* PIN = (bf16*)(ws + WS_PROJ); bf16* QKVH = (bf16*)(ws + WS_QKVH); unsigned char* MIX8 = ws + WS_MIXIN;
    bf16* O0 = (bf16*)(ws + WS_O0); bf16* O1 = (bf16*)(ws + WS_O1); float* LSE = (float*)(ws + WS_LSE);
    float* SC = (float*)(ws + WS_SC);
    bf16* X1B = (bf16*)(ws + WS_O0);
    bf16* YB = (bf16*)(ws + WS_PROJ + 64 * MiB);

    for (int u = tid0; u < (LDS_BYTES - LDSCTL_OFF) / 4; u += NWAVES * 64) ((LAS unsigned*)(lds + LDSCTL_OFF))[u] = 0u;
    __syncthreads();
    XcdBarrier bar; bar.bar = ctl + CW_BAR; bar.x = 0; bar.st = nullptr;
    if (MK_N_LAUNCHES != PER_PHASE) bar = xcd_barrier_post(ctl + CW_BAR, MISC + 8);
#define GRID_BAR() do { if (MK_N_LAUNCHES != PER_PHASE) xcd_barrier(bar); } while (0)
    const unsigned phmask = args.mask;
#ifndef PH_MASK
#define PH_MASK 0x1ff
#endif
#define IN(k) ((((PH_MASK) >> (k)) & 1) && ((phmask >> (k)) & 1u))
#define BOTH(k) (IN(k) && IN((k) + 1))

    if (IN(0)) {
        PHASE_LANES();
        LAS float* silu = (LAS float*)(lds + RING_OFF);
        for (int i = tid; i < BATCH * DM; i += NWAVES * 64) { const float v = cvec[i]; silu[i] = v / (1.0f + __expf(-v)); }
        __syncthreads();
        for (int task = gw; task < (NMOD / 256) * KS_ADA; task += NGW) {
            const int cg = task % (NMOD / 256), ks = task / (NMOD / 256); const int k0 = ks * (DM / KS_ADA), n0 = cg * 256 + 4 * lane;
            f32x4 a0 = {0.f, 0.f, 0.f, 0.f}, a1 = {0.f, 0.f, 0.f, 0.f};
            const float* wp = w_ada + (size_t)k0 * NMOD + n0;
#pragma unroll 8
            for (int kk = 0; kk < DM / KS_ADA; ++kk) { const f32x4 w4 = *(const f32x4*)(wp + (size_t)kk * NMOD); const float s0 = silu[k0 + kk], s1 = silu[DM + k0 + kk]; a0 += w4 * s0; a1 += w4 * s1; }
            *(f32x4*)(MODP + ((size_t)(ks * 2 + 0)) * NMOD + n0) = a0; *(f32x4*)(MODP + ((size_t)(ks * 2 + 1)) * NMOD + n0) = a1;
        }
        __syncthreads();
        {
            LAS float* scr = (LAS float*)(lds + RING_OFF + wave * 16384);
            constexpr int I_QKV = (DM / 64) * (3 * ATTW / 32), I_PIN = (DM / 64) * (POOLW / 32), I_OUTH = (ATTW / 64) * (DM / 32);
            constexpr int NITEMS = I_QKV + I_PIN + 2 * I_OUTH;
            for (int it = gw; it < NITEMS; it += NGW) {
                int r = it;
                if (r < I_QKV) { p0_transpose_item<true>(w_in, INW, 3 * ATTW, WIN8, DM, W8SCALE, scr, r, lane); continue; } r -= I_QKV;
                if (r < I_PIN) { p0_transpose_item<false>(w_in + 3 * ATTW, INW, POOLW, WINT, DM, 1.f, scr, r, lane); continue; } r -= I_PIN;
                if (r < I_OUTH) { p0_transpose_item<true>(w_out, DM, DM, WOUT8, DM, WO8SCALE, scr, r, lane); continue; } r -= I_OUTH;
                p0_transpose_item<false>(w_out + (size_t)ATTW * DM, DM, DM, WOPT, POOLW, 1.f, scr, r, lane);
            }
        }
        for (int i = gw * 64 + lane; i < (DM * PQ + 4 * 512 * 512) / 8; i += NGW * 64) {
            const bool isQ = i < DM * PQ / 8; const int j = isQ ? i : i - DM * PQ / 8;
            const float* src = (isQ ? peer_wq : pool_w) + (size_t)j * 8;
            f32x4 a = *(const f32x4*)src, c = *(const f32x4*)(src + 4);
            if (!isQ) { const int e0 = j * 8; const int gi = e0 >> 18, d0 = e0 & 511; const float* ps = pool_scale + gi * 512 + d0; a = a * *(const f32x4*)ps; c = c * *(const f32x4*)(ps + 4); }
            v4u w; w.x = cvt_pk_bf16(a[0], a[1]); w.y = cvt_pk_bf16(a[2], a[3]); w.z = cvt_pk_bf16(c[0], c[1]); w.w = cvt_pk_bf16(c[2], c[3]);
            *(v4u*)((isQ ? WQB : PWS) + (size_t)j * 8) = w;
        }
        for (int r = gw; r < 2 * NEXP; r += NGW) {
            const bool isU = r < NEXP; const int e = isU ? r : r - NEXP;
            const float* src = (isU ? peer_u : peer_v) + (size_t)e * DM + 16 * lane;
            f32x4 v[4][4]; float mx = 0.f;
#pragma unroll
            for (int i = 0; i < 4; ++i)
#pragma unroll
                for (int q = 0; q < 4; ++q) { v[i][q] = *(const f32x4*)(src + 1024 * i + 4 * q);
                    mx = fmaxf(mx, fmaxf(fmaxf(fabsf(v[i][q][0]), fabsf(v[i][q][1])), fmaxf(fabsf(v[i][q][2]), fabsf(v[i][q][3])))); }
#pragma unroll
            for (int o = 1; o < 64; o <<= 1) mx = fmaxf(mx, __shfl_xor(mx, o));
            const int ex = (int)((__float_as_uint(mx) >> 23) & 0xffu);
            float scale = 1.0f, inv = 1.0f;
            if (ex >= 32 && ex <= 230) { scale = __uint_as_float((unsigned)(261 - ex) << 23); inv = __uint_as_float((unsigned)(ex - 7) << 23); }
            unsigned char* dst = (isU ? UB : VB) + ((size_t)(lane >> 3) * NEXP + e) * 128 + 16 * (lane & 7);
#pragma unroll
            for (int i = 0; i < 4; ++i) { v4u w;
#pragma unroll
                for (int q = 0; q < 4; ++q) { int pk = 0; pk = __builtin_amdgcn_cvt_pk_fp8_f32(v[i][q][0] * scale, v[i][q][1] * scale, pk, false);
                    pk = __builtin_amdgcn_cvt_pk_fp8_f32(v[i][q][2] * scale, v[i][q][3] * scale, pk, true); w[q] = (unsigned)pk; }
                *(v4u*)(dst + (size_t)(8 * i) * NEXP * 128) = w; }
            if (lane == 0) SCL[r] = inv;
        }
        for (int i = gw * 64 + lane; i < 2048 * 32; i += NGW * 64) {
            const int n = i >> 5, kc = (i & 31) * 8; const int p = (n >> 7) & 1, pp = kc >> 7;
            v4u w = {0u, 0u, 0u, 0u};
            if (p == pp) { const float* src = peer_sk + (size_t)n * 128 + (kc & 127); const f32x4 a = *(const f32x4*)src, c = *(const f32x4*)(src + 4);
                w.x = cvt_pk_bf16(a[0], a[1]); w.y = cvt_pk_bf16(a[2], a[3]); w.z = cvt_pk_bf16(c[0], c[1]); w.w = cvt_pk_bf16(c[2], c[3]); }
            *(v4u*)(SKT + (size_t)n * 256 + kc) = w;
        }
        if (BOTH(0)) GRID_BAR();
    }

    if (IN(1)) {
        PHASE_LANES();
        for (int i = bx * (NWAVES * 64) + tid; i < BATCH * NMOD; i += G * NWAVES * 64) {
            const int b = i / NMOD, n = i % NMOD; float s = b_ada[n];
#pragma unroll 8
            for (int ks = 0; ks < KS_ADA; ++ks) s += MODP[(size_t)(ks * 2 + b) * NMOD + n];
            const int j = n / DM, c = n % DM;
            MODV[(size_t)(j * 2 + b) * DM + c] = s;
        }
        if (bx < G / 2) {
            pg8::Gemm g{WOPT, PWS, DM, POOLW, 512, POOLW, 512, 2, 512, 1 << 30, 0}; pg8::StaticOrder S; S.init(DM, POOLW, G / 2, bx);
            pg8::EpiFp8 E{WOUT8, DM, ATTW, (A8SCALE * WO8SCALE) / P8SCALE};
            pg8::gemm_phase<pg8::EpiFp8, pg8::StaticOrder, true>(lds + RING_OFF, g, S, E);
        }
        else {
            pg8::Gemm g{SKT, WQB, PQ, DM, 256, 256, PQ, 1 << 30, 0, 1, 256}; pg8::StaticOrder S; S.init(PQ, DM, G - G / 2, bx - G / 2);
            pg8::EpiBf16 E{WQST, DM, 0, 1.0f, nullptr, 0, 0};
            pg8::gemm_phase<pg8::EpiBf16, pg8::StaticOrder, true>(lds + RING_OFF, g, S, E);
        }
        if (BOTH(1)) GRID_BAR();
    }

    if (IN(2)) {
        PHASE_LANES();
        for (int row = gw; row < M; row += NGW) {
            const int b = row / SEQ;
            const f32x4* xr = (const f32x4*)(x + (size_t)row * DM) + lane;
            f32x4 v[16]; float ss = 0.f;
#pragma unroll
            for (int j = 0; j < 16; ++j) { v[j] = xr[64 * j]; ss += (v[j][0] * v[j][0] + v[j][1] * v[j][1]) + (v[j][2] * v[j][2] + v[j][3] * v[j][3]); }
            const float rstd = 1.0f / sqrtf(wave_sum(ss) * (1.0f / DM) + RMS_EPS);
            const f32x4* gp = (const f32x4*)g_mix + lane; const f32x4* shp = (const f32x4*)(MODV + (size_t)(0 * 2 + b) * DM) + lane; const f32x4* scp = (const f32x4*)(MODV + (size_t)(1 * 2 + b) * DM) + lane;
            v2u* op = (v2u*)(H + (size_t)row * DM) + lane; unsigned* op8 = (unsigned*)(H8 + (size_t)row * DM) + lane;
#pragma unroll
            for (int j = 0; j < 16; ++j) { const f32x4 g4 = gp[64 * j], sh = shp[64 * j], sc = scp[64 * j];
                const f32x4 y = (v[j] * rstd) * g4 * (sc + 1.0f) + sh;
                v2u w; w.x = cvt_pk_bf16(y[0], y[1]); w.y = cvt_pk_bf16(y[2], y[3]); op[64 * j] = w;
                int p8 = 0; p8 = __builtin_amdgcn_cvt_pk_fp8_f32(y[0] * H8SCALE, y[1] * H8SCALE, p8, false); p8 = __builtin_amdgcn_cvt_pk_fp8_f32(y[2] * H8SCALE, y[3] * H8SCALE, p8, true); op8[64 * j] = (unsigned)p8; }
        }
        if (BOTH(2)) GRID_BAR();
    }

    if (IN(3)) {
        PHASE_LANES();
        {
            pg8::Gemm g{(const bf16*)H8, (const bf16*)WIN8, M, 3 * ATTW, DM / 2, DM / 2, DM / 2, 1 << 30, 0, 1 << 30, 0}; pg8::StaticOrder S; S.init(M, 3 * ATTW, G, bx);
            pg8::EpiBf16 E{PIN, POOLW, ATTW, QSCALE / (H8SCALE * W8SCALE), QKVH, 3 * ATTW, M, 1.0f / (H8SCALE * W8SCALE)};
            pg8::gemm_phase<pg8::EpiBf16, pg8::StaticOrder, true, true>(lds + RING_OFF, g, S, E);
        }
        {
            pg8::Gemm g{H, WINT, M, POOLW, DM, DM, DM, 1 << 30, 0, 1 << 30, 0}; pg8::StaticOrder S; S.init(M, POOLW, G, bx);
            pg8::EpiBf16 E{PIN, POOLW, 0, 1.0f, nullptr, 0, 0};
            pg8::gemm_phase<pg8::EpiBf16, pg8::StaticOrder, true>(lds + RING_OFF, g, S, E);
        }
        if (BOTH(3)) GRID_BAR();
    }

    if (IN(4)) {
        PHASE_LANES();
        LAS float* btab = (LAS float*)(lds + SHARED_OFF);
        LAS unsigned char* vt = lds + RING_OFF + wave * ATT_WAVE_BYTES;
        if (!(args.pad & 1u))
        for (int unit = bx; unit < BATCH * NH * (SEQ / 1024); unit += G) {
            const int b = unit >> 7, h = (unit >> 3) & 15, mt = unit & 7;
            __syncthreads();
            for (int i = tid; i < 3 * 256; i += NWAVES * 64) { const int gi = i >> 8, ri = (i & 255) - 32; const int dil = gi == 0 ? 1 : (gi == 1 ? 4 : 16);
                btab[i] = (ri >= 0 && ri <= 128) ? rel_bias[t5_bucket((ri - 64) * dil) * NH + h] * LOG2E : -1e30f; }
            __syncthreads();
            for (int g = 0; g < 3; ++g) {
                if (g == 2) { VM_WAIT(); __syncthreads(); }
                for (int tk = wave; tk < 32; tk += NWAVES) attn_task(g, QKVH, O0, O1, LSE, LSE + (size_t)M * NH, MIX8, btab, vt, b, h, mt, tk, lane);
            }
        }
        if (!(args.pad & 2u))
        for (int i = bx * (NWAVES * 64) + tid; i < BATCH * (SEQ / 8) * (POOLW / 8); i += G * NWAVES * 64) {
            const int cc = i & 255, run = (i >> 8) & (SEQ / 8 - 1), b = i >> 18; const int gi = __builtin_amdgcn_readfirstlane(cc >> 6);
            const int pos0 = run * 8;
            const bf16* base = PIN + (size_t)b * SEQ * POOLW + cc * 8;
            unsigned char* obase = MIX8 + ((size_t)b * SEQ + pos0) * DM + ATTW + cc * 8;
#define POOL_RUN(HW) do { constexpr int NR = 8 + 2 * (HW) - 1; v4u w_[NR]; \
                _Pragma("unroll") for (int q = 0; q < NR; ++q) { const int pp = pos0 - (HW) + q; const int pc = pp < 0 ? 0 : (pp > SEQ - 1 ? SEQ - 1 : pp); w_[q] = *(const v4u*)(base + (size_t)pc * POOLW); } \
                _Pragma("unroll") for (int q = 0; q < NR; ++q) { const int pp = pos0 - (HW) + q; if (pp < 0 || pp >= SEQ) w_[q] = (v4u){0u, 0u, 0u, 0u}; } \
                float s_[8] = {0.f, 0.f, 0.f, 0.f, 0.f, 0.f, 0.f, 0.f}; \
                _Pragma("unroll") for (int q = 0; q < 2 * (HW) - 1; ++q) { s_[0] += bf_lo(w_[q].x); s_[1] += bf_hi(w_[q].x); s_[2] += bf_lo(w_[q].y); s_[3] += bf_hi(w_[q].y); s_[4] += bf_lo(w_[q].z); s_[5] += bf_hi(w_[q].z); s_[6] += bf_lo(w_[q].w); s_[7] += bf_hi(w_[q].w); } \
                _Pragma("unroll") for (int k = 0; k < 8; ++k) { const v4u in_ = w_[k + 2 * (HW) - 1]; \
                    s_[0] += bf_lo(in_.x); s_[1] += bf_hi(in_.x); s_[2] += bf_lo(in_.y); s_[3] += bf_hi(in_.y); s_[4] += bf_lo(in_.z); s_[5] += bf_hi(in_.z); s_[6] += bf_lo(in_.w); s_[7] += bf_hi(in_.w); \
                    const int pos = pos0 + k; const int lo_ = pos - (HW) < 0 ? 0 : pos - (HW), hi_ = pos + (HW) > SEQ ? SEQ : pos + (HW); const float inv = 1.0f / (float)(hi_ - lo_); \
                    const v4u me = w_[k + (HW)]; int lo8_ = 0, hi8_ = 0; const float i8_ = inv * P8SCALE; \
                    lo8_ = __builtin_amdgcn_cvt_pk_fp8_f32(s_[0] * i8_ - bf_lo(me.x) * P8SCALE, s_[1] * i8_ - bf_hi(me.x) * P8SCALE, lo8_, false); lo8_ = __builtin_amdgcn_cvt_pk_fp8_f32(s_[2] * i8_ - bf_lo(me.y) * P8SCALE, s_[3] * i8_ - bf_hi(me.y) * P8SCALE, lo8_, true); \
                    hi8_ = __builtin_amdgcn_cvt_pk_fp8_f32(s_[4] * i8_ - bf_lo(me.z) * P8SCALE, s_[5] * i8_ - bf_hi(me.z) * P8SCALE, hi8_, false); hi8_ = __builtin_amdgcn_cvt_pk_fp8_f32(s_[6] * i8_ - bf_lo(me.w) * P8SCALE, s_[7] * i8_ - bf_hi(me.w) * P8SCALE, hi8_, true); \
                    *(v2u*)(obase + (size_t)k * DM) = (v2u){(unsigned)lo8_, (unsigned)hi8_}; \
                    const v4u out_ = w_[k]; \
                    s_[0] -= bf_lo(out_.x); s_[1] -= bf_hi(out_.x); s_[2] -= bf_lo(out_.y); s_[3] -= bf_hi(out_.y); s_[4] -= bf_lo(out_.z); s_[5] -= bf_hi(out_.z); s_[6] -= bf_lo(out_.w); s_[7] -= bf_hi(out_.w); } } while (0)
            if (gi == 0) POOL_RUN(1); else if (gi == 1) POOL_RUN(2); else if (gi == 2) POOL_RUN(4); else POOL_RUN(8);
#undef POOL_RUN
        }
        if (BOTH(4)) GRID_BAR();
    }

    if (IN(5)) {
        PHASE_LANES();
        pg8::Gemm g{(const bf16*)MIX8, (const bf16*)WOUT8, M, DM, DM / 2, DM / 2, DM / 2, 1 << 30, 0, 1 << 30, 0}; pg8::StaticOrder S; S.init(M, DM, G, bx);
        pg8::EpiResBf16 E{x, MODV + (size_t)(2 * 2) * DM, X1B, DM, 1.0f / (A8SCALE * WO8SCALE)};
        pg8::gemm_phase<pg8::EpiResBf16, pg8::StaticOrder, true, true>(lds + RING_OFF, g, S, E);
        if (BOTH(5)) GRID_BAR();
    }

    if (IN(6)) {
        PHASE_LANES();
        for (int row = gw; row < M; row += NGW) {
            const int b = row / SEQ;
            const v2u* xr = (const v2u*)(X1B + (size_t)row * DM) + lane;
            f32x4 v[16]; float ss = 0.f;
#pragma unroll
            for (int j = 0; j < 16; ++j) { const v2u xw = xr[64 * j]; v[j] = (f32x4){bf_lo(xw.x), bf_hi(xw.x), bf_lo(xw.y), bf_hi(xw.y)}; ss += (v[j][0] * v[j][0] + v[j][1] * v[j][1]) + (v[j][2] * v[j][2] + v[j][3] * v[j][3]); }
            const float rstd = 1.0f / sqrtf(wave_sum(ss) * (1.0f / DM) + RMS_EPS);
            const f32x4* gp = (const f32x4*)g_ffn + lane; const f32x4* shp = (const f32x4*)(MODV + (size_t)(3 * 2 + b) * DM) + lane; const f32x4* scp = (const f32x4*)(MODV + (size_t)(4 * 2 + b) * DM) + lane;
            v2u* op = (v2u*)(H + (size_t)row * DM) + lane;
#pragma unroll
            for (int j = 0; j < 16; ++j) { const f32x4 g4 = gp[64 * j], sh = shp[64 * j], sc = scp[64 * j];
                const f32x4 y = (v[j] * rstd) * g4 * (sc + 1.0f) + sh;
                v2u w; w.x = cvt_pk_bf16(y[0], y[1]); w.y = cvt_pk_bf16(y[2], y[3]); op[64 * j] = w; }
        }
        if (BOTH(6)) GRID_BAR();
    }

    if (IN(7)) {
        PHASE_LANES();
        pg8::Gemm g{H, WQST, M, PQ, DM, DM, DM, 1 << 30, 0, 1 << 30, 0}; pg8::StaticOrder S; S.init(M, PQ, G, bx);
        pg8::EpiF32 E{SC, PQ};
        pg8::gemm_phase<pg8::EpiF32, pg8::StaticOrder, true>(lds + RING_OFF, g, S, E);
        if (BOTH(7)) GRID_BAR();
    }

    if (IN(8)) {
        PHASE_LANES();
        LAS unsigned short* EXPW = (LAS unsigned short*)(lds + RING_OFF);
        LAS float* GACT = (LAS float*)(lds + RING_OFF + 16384);
        LAS unsigned* W = (LAS unsigned*)(lds + RING_OFF + 49152 + wave * 4096);
        LAS unsigned* K1 = W; LAS unsigned* K2 = W + 128;
        LAS float* TV1 = (LAS float*)(W + 256); LAS int* TI1 = (LAS int*)(W + 272); LAS float* TV2 = (LAS float*)(W + 288); LAS int* TI2 = (LAS int*)(W + 304);
        LAS unsigned* CK = W + 320; LAS float* SV = (LAS float*)(W + 384); LAS int* SE = (LAS int*)(W + 400);
        const int c8 = lane & 7, r8 = lane >> 3;
        for (int blk = vcu; blk < M / 64; blk += G) {
            const int tok0 = blk * 64; const int b = tok0 / SEQ;
            for (int j = 0; j < 8; ++j) {
                const int tl = wave * 8 + j; const int t = tok0 + tl;
#ifndef TOPK_REP
#define TOPK_REP 1
#endif
                for (int hh = 0; hh < 8 * TOPK_REP; ++hh) { const int h = hh & 7;
                    const float* sp = SC + (size_t)t * PQ + h * 256;
                    const float a0 = sp[lane], a1 = sp[64 + lane], b0 = sp[128 + lane], b1 = sp[192 + lane];
                    unsigned ka0 = (fkey(a0) & ~127u) | (unsigned)(127 - lane), ka1 = (fkey(a1) & ~127u) | (unsigned)(63 - lane);
                    unsigned kb0 = (fkey(b0) & ~127u) | (unsigned)(127 - lane), kb1 = (fkey(b1) & ~127u) | (unsigned)(63 - lane);
                    bitonic128x2(ka0, ka1, kb0, kb1, lane);
                    if (lane >= 56) { K1[127 - 2 * lane] = ka0; K1[126 - 2 * lane] = ka1; K2[127 - 2 * lane] = kb0; K2[126 - 2 * lane] = kb1; }
                    LDS_WAIT();
                    const int ci_i = CAND_I[lane], ci_j = CAND_J[lane];
                    const unsigned kA = K1[ci_i], kB = K2[ci_j];
                    const float cv = fdec(kA) + fdec(kB);
                    const unsigned ck = lane < 50 ? ((fkey(cv) & ~255u) | (unsigned)(255 - (ci_i * 16 + ci_j))) : 0u;
                    CK[lane] = ck;
                    LDS_WAIT();
                    int rc = 0;
#pragma unroll 8
                    for (int kk = 0; kk < 16; ++kk) { const v4u q = ((const LAS v4u*)CK)[kk]; rc += (q.x > ck) + (q.y > ck) + (q.z > ck) + (q.w > ck); }
                    if (lane < 50 && rc < 16) { SV[rc] = cv; SE[rc] = (int)((127u - (kA & 127u)) * 128u + (127u - (kB & 127u))); }
                    LDS_WAIT();
                    const float top0 = SV[0], myv = SV[lane & 15]; const int mye = SE[lane & 15];
                    const float e = __expf(myv - top0);
                    float ssum = e; ssum += __shfl_xor(ssum, 1); ssum += __shfl_xor(ssum, 2); ssum += __shfl_xor(ssum, 4); ssum += __shfl_xor(ssum, 8);
                    if (lane < 16) { EXPW[tl * 128 + h * 16 + lane] = (unsigned short)mye; GACT[tl * 128 + h * 16 + lane] = e / ssum; }
                    LDS_WAIT();
                }
            }
            LAS float* ACC = (LAS float*)(lds + RING_OFF + 81920);
            for (int i = lane; i < 8 * 128; i += 64) ACC[wave * 1024 + i] = 0.f;
            LDS_WAIT();
            {
                v4u gn[16]; v4u hna, hnb;
#define P10_LOADU(idx) do { const int s_ = (idx) >> 3, j_ = (idx) & 7; const int tl_ = wave * 8 + j_; \
                    const unsigned char* tb_ = UB + (size_t)s_ * NEXP * 128 + 16 * c8; \
                    const v4u* hp_ = (const v4u*)(H + (size_t)(tok0 + tl_) * DM + 128 * s_ + 16 * c8); hna = hp_[0]; hnb = hp_[1]; \
                    _Pragma("unroll") for (int i = 0; i < 16; ++i) { const unsigned e_ = EXPW[tl_ * 128 + r8 + 8 * i]; gn[i] = *(const v4u*)(tb_ + (size_t)e_ * 128); } } while (0)
                P10_LOADU(0);
#pragma unroll 1
                for (int idx = 0; idx < 256; ++idx) {
                    v4u g[16]; const v4u ha = hna, hb = hnb;
#pragma unroll
                    for (int i = 0; i < 16; ++i) g[i] = gn[i];
                    if (idx + 1 < 256) P10_LOADU(idx + 1);
                    const int tl = wave * 8 + (idx & 7);
                    f32x2 hs[8];
                    hs[0] = (f32x2){bf_lo(ha.x), bf_hi(ha.x)}; hs[1] = (f32x2){bf_lo(ha.y), bf_hi(ha.y)}; hs[2] = (f32x2){bf_lo(ha.z), bf_hi(ha.z)}; hs[3] = (f32x2){bf_lo(ha.w), bf_hi(ha.w)};
                    hs[4] = (f32x2){bf_lo(hb.x), bf_hi(hb.x)}; hs[5] = (f32x2){bf_lo(hb.y), bf_hi(hb.y)}; hs[6] = (f32x2){bf_lo(hb.z), bf_hi(hb.z)}; hs[7] = (f32x2){bf_lo(hb.w), bf_hi(hb.w)};
                    float p[16];
#pragma unroll
                    for (int i = 0; i < 16; ++i) { f32x2 a2 = {0.f, 0.f};
#pragma unroll
                        for (int q = 0; q < 4; ++q) { a2 += __builtin_amdgcn_cvt_pk_f32_fp8((int)g[i][q], false) * hs[2 * q]; a2 += __builtin_amdgcn_cvt_pk_f32_fp8((int)g[i][q], true) * hs[2 * q + 1]; }
                        p[i] = a2.x + a2.y; }
                    float q8[8], q4[4], q2[2];
#pragma unroll
                    for (int m = 0; m < 8; ++m) { const float snd = (c8 & 4) ? p[m] : p[m + 8], kp = (c8 & 4) ? p[m + 8] : p[m]; q8[m] = kp + __shfl_xor(snd, 4); }
#pragma unroll
                    for (int m = 0; m < 4; ++m) { const float snd = (c8 & 2) ? q8[m] : q8[m + 4], kp = (c8 & 2) ? q8[m + 4] : q8[m]; q4[m] = kp + __shfl_xor(snd, 2); }
#pragma unroll
                    for (int m = 0; m < 2; ++m) { const float snd = (c8 & 1) ? q4[m] : q4[m + 2], kp = (c8 & 1) ? q4[m + 2] : q4[m]; q2[m] = kp + __shfl_xor(snd, 1); }
                    LAS float* ap = ACC + tl * 128 + r8 + 16 * c8;
                    ap[0] += q2[0]; ap[8] += q2[1];
                }
#undef P10_LOADU
            }
            LDS_WAIT();
            for (int i = lane; i < 8 * 128; i += 64) { const int o_ = wave * 1024 + i; const unsigned e = EXPW[o_];
                const float a = ACC[o_] * SCL[e]; GACT[o_] = gelu_tanh(a) * GACT[o_] * SCL[NEXP + e]; }
            LDS_WAIT();
            LAS float* SSQ = ACC;
            for (int j = 0; j < 8; ++j) SSQ[(wave * 8 + j) * 128 + lane] = 0.f;
            LDS_WAIT();
            const float* gtp = MODV + (size_t)(5 * 2 + b) * DM;
            {
                v4u gn[16]; float avn[16];
#define P10_LOADV(idx) do { const int s_ = (idx) >> 3, j_ = (idx) & 7; const int tl_ = wave * 8 + j_; \
                    const unsigned char* tb_ = VB + (size_t)s_ * NEXP * 128 + 16 * c8; \
                    _Pragma("unroll") for (int i = 0; i < 16; ++i) { const int k_ = tl_ * 128 + r8 + 8 * i; const unsigned e_ = EXPW[k_]; avn[i] = GACT[k_]; gn[i] = *(const v4u*)(tb_ + (size_t)e_ * 128); } } while (0)
                P10_LOADV(0);
#pragma unroll 1
                for (int idx = 0; idx < 256; ++idx) {
                    v4u g[16]; float av[16];
#pragma unroll
                    for (int i = 0; i < 16; ++i) { g[i] = gn[i]; av[i] = avn[i]; }
                    if (idx + 1 < 256) P10_LOADV(idx + 1);
                    const int s_c = idx >> 3; const int tl = wave * 8 + (idx & 7); const int t = tok0 + tl;
                    const int d = 128 * s_c + 16 * c8 + 2 * r8;
                    const unsigned xw = __builtin_nontemporal_load((const unsigned*)(X1B + (size_t)t * DM + d)); const f32x2 gv = *(const f32x2*)(gtp + d);
                    const float ssq_old = SSQ[tl * 128 + lane];
                    f32x2 o8[8];
#pragma unroll
                    for (int q = 0; q < 8; ++q) o8[q] = (f32x2){0.f, 0.f};
#pragma unroll
                    for (int i = 0; i < 16; ++i)
#pragma unroll
                        for (int q = 0; q < 4; ++q) { o8[2 * q] += __builtin_amdgcn_cvt_pk_f32_fp8((int)g[i][q], false) * av[i]; o8[2 * q + 1] += __builtin_amdgcn_cvt_pk_f32_fp8((int)g[i][q], true) * av[i]; }
                    float p[16], q8[8], q4[4], q2[2];
#pragma unroll
                    for (int q = 0; q < 8; ++q) { p[2 * q] = o8[q].x; p[2 * q + 1] = o8[q].y; }
#pragma unroll
                    for (int m = 0; m < 8; ++m) { const float snd = (r8 & 4) ? p[m] : p[m + 8], kp = (r8 & 4) ? p[m + 8] : p[m]; q8[m] = kp + __shfl_xor(snd, 32); }
#pragma unroll
                    for (int m = 0; m < 4; ++m) { const float snd = (r8 & 2) ? q8[m] : q8[m + 4], kp = (r8 & 2) ? q8[m + 4] : q8[m]; q4[m] = kp + __shfl_xor(snd, 16); }
#pragma unroll
                    for (int m = 0; m < 2; ++m) { const float snd = (r8 & 1) ? q4[m] : q4[m + 2], kp = (r8 & 1) ? q4[m + 2] : q4[m]; q2[m] = kp + __shfl_xor(snd, 8); }
                    f32x2 y; y.x = bf_lo(xw) + gv.x * q2[0]; y.y = bf_hi(xw) + gv.y * q2[1];
                    __builtin_nontemporal_store(cvt_pk_bf16(y.x, y.y), (unsigned*)(YB + (size_t)t * DM + d));
                    SSQ[tl * 128 + lane] = ssq_old + (y.x * y.x + y.y * y.y);
                }
#undef P10_LOADV
            }
            VM_WAIT(); LDS_WAIT();
            __builtin_amdgcn_fence(__ATOMIC_ACQUIRE, "agent");
            VM_WAIT();
            for (int j = 0; j < 8; ++j) {
                const int tl = wave * 8 + j; const int t = tok0 + tl;
                const float rstd = 1.0f / sqrtf(wave_sum(SSQ[tl * 128 + lane]) * (1.0f / DM) + RMS_EPS);
                f32x4* op = (f32x4*)(out + (size_t)t * DM) + lane; const f32x4* gp = (const f32x4*)g_final + lane; const v2u* yp = (const v2u*)(YB + (size_t)t * DM) + lane;
#pragma unroll 4
                for (int i = 0; i < 16; ++i) { const v2u yw = __builtin_nontemporal_load(yp + 64 * i); const f32x4 y = {bf_lo(yw.x), bf_hi(yw.x), bf_lo(yw.y), bf_hi(yw.y)}; __builtin_nontemporal_store(y * rstd * gp[64 * i], op + 64 * i); }
            }
            LDS_WAIT();
        }
    }
#undef IN
#undef BOTH
#undef GRID_BAR
}

extern "C" void kernel_launch(void* const* d_in, const int* in_sizes, int n_in, void* d_out, int out_size, void* d_ws, size_t ws_size, hipStream_t stream) {
    static int grid = 0;
    if (grid == 0) {
        if (n_in != 16 || in_sizes[0] != M * DM || out_size != M * DM || ws_size < WS_END) {
            fprintf(stderr, "kernel_launch: shape/workspace mismatch: n_in %d in0 %d out %d ws %zu (need %zu)\n", n_in, n_in > 0 ? in_sizes[0] : -1, out_size, ws_size, (size_t)WS_END); grid = -1; return; }
        int dev = 0, cus = 0, per_cu = 0;
        if (hipGetDevice(&dev) != hipSuccess || hipDeviceGetAttribute(&cus, hipDeviceAttributeMultiprocessorCount, dev) != hipSuccess) { grid = -1; return; }
        if (hipFuncSetAttribute((const void*)fwd_kernel, hipFuncAttributeMaxDynamicSharedMemorySize, LDS_BYTES) != hipSuccess) { fprintf(stderr, "kernel_launch: hipFuncSetAttribute failed\n"); grid = -1; return; }
        if (hipOccupancyMaxActiveBlocksPerMultiprocessor(&per_cu, (const void*)fwd_kernel, NWAVES * 64, LDS_BYTES) != hipSuccess || per_cu < 1)
            fprintf(stderr, "kernel_launch: note: occupancy query reports %d workgroups per CU\n", per_cu);
        (void)hipGetLastError();
        grid = cus;
    }
    if (grid < 0) return;
    if (hipMemsetAsync((char*)d_ws + WS_CTL, 0, CTL_ZERO_BYTES, stream) != hipSuccess) { fprintf(stderr, "kernel_launch: memset failed\n"); return; }
    Args a{};
    for (int i = 0; i < 16; ++i) a.in[i] = (const float*)d_in[i];
    a.out = (float*)d_out; a.ws = (unsigned char*)d_ws;
#ifdef PROBE_MASK
    {
#ifndef PROBE_PAD
#define PROBE_PAD 0
#endif
        a.mask = PROBE_MASK; a.pad = PROBE_PAD;
        hipLaunchKernelGGL(fwd_kernel, dim3(grid), dim3(NWAVES * 64), LDS_BYTES, stream, a);
        (void)hipMemsetAsync((char*)d_ws + WS_CTL, 0, CTL_ZERO_BYTES, stream);
    }
#endif
    for (int li = 0; li < MK_N_LAUNCHES; ++li) {
        a.mask = (MK_N_LAUNCHES == PER_PHASE) ? (1u << li) : ((1u << PER_PHASE) - 1u); a.pad = 0;
        hipLaunchKernelGGL(fwd_kernel, dim3(grid), dim3(NWAVES * 64), LDS_BYTES, stream, a);
        const hipError_t le = hipPeekAtLastError();
        if (le != hipSuccess) { fprintf(stderr, "kernel_launch: launch %d failed: %s\n", li, hipGetErrorName(le)); break; }
    }
}
```

```cpp
#include <hip/hip_runtime.h>
#include <cstdio>
#include <cstdint>

#ifndef MK_N_LAUNCHES
#define MK_N_LAUNCHES 1
#endif

#define GAS __attribute__((address_space(1)))
#define LAS __attribute__((address_space(3)))
typedef unsigned short bf16;
typedef unsigned v4u __attribute__((ext_vector_type(4)));
typedef unsigned v2u __attribute__((ext_vector_type(2)));
typedef float f32x4 __attribute__((ext_vector_type(4)));
typedef float f32x2 __attribute__((ext_vector_type(2)));
typedef float f32x16 __attribute__((ext_vector_type(16)));
typedef short bf16x8 __attribute__((ext_vector_type(8)));
typedef short s16x4 __attribute__((ext_vector_type(4)));
typedef __bf16 bf2_t __attribute__((ext_vector_type(2)));

constexpr int BATCH = 2, SEQ = 8192, DM = 4096, M = BATCH * SEQ;
constexpr int NH = 16, HD = 128, ATTW = 2048, POOLW = 2048, INW = 8192;
constexpr int NMOD = 6 * DM;
constexpr int PQ = 2048;
constexpr int NEXP = 16384;
constexpr float RMS_EPS = 1e-6f;
constexpr float LOG2E = 1.4426950408889634f;
constexpr float QSCALE = 0.08838834764831845f * LOG2E;
constexpr float H8SCALE = 16.f, W8SCALE = 64.f;
constexpr float A8SCALE = 64.f, P8SCALE = 16.f, WO8SCALE = 64.f;
constexpr int KS_ADA = 64;

constexpr size_t MiB = 1u << 20;
constexpr size_t WS_CTL = 0, CTL_ZERO_BYTES = 1 * MiB;
constexpr size_t WS_MODV = 1 * MiB;
constexpr size_t WS_SCL = 2 * MiB;
constexpr size_t WS_MODP = 4 * MiB;
constexpr size_t WS_SKT = 20 * MiB;
constexpr size_t WS_PWS = 22 * MiB;
constexpr size_t WS_WQST = 24 * MiB;
constexpr size_t WS_WOUT2 = 40 * MiB;
constexpr size_t WS_WINT = 72 * MiB;
constexpr size_t WS_WIN8 = 88 * MiB;
constexpr size_t WS_H8 = 1100 * MiB;
constexpr size_t WS_UB = 136 * MiB;
constexpr size_t WS_VB = 264 * MiB;
constexpr size_t WS_H = 392 * MiB;
constexpr size_t WS_PROJ = 520 * MiB;
constexpr size_t WS_QKVH = 1292 * MiB;
constexpr size_t WS_MIXIN = 776 * MiB;
constexpr size_t WS_WOPT = 904 * MiB;
constexpr size_t WS_WQB = 936 * MiB;
constexpr size_t WS_O0 = 968 * MiB, WS_O1 = 1032 * MiB;
constexpr size_t WS_LSE = 1096 * MiB;
constexpr size_t WS_SC = 1164 * MiB;
constexpr size_t WS_END = 1484 * MiB;

constexpr int RING_OFF = 0, RING_BYTES = 131072;
constexpr int ATT_WAVE_BYTES = 17408;
constexpr int SHARED_OFF = 139264;
constexpr int LDSCTL_OFF = 139264 + 4096, MISC_OFF = LDSCTL_OFF + 320;
constexpr int LDS_BYTES = 147456;
constexpr int NWAVES = 8;
constexpr int CW_BAR = 4096;

#define LDS_WAIT() asm volatile("s_waitcnt lgkmcnt(0)" ::: "memory")
#define VM_WAIT() asm volatile("s_waitcnt vmcnt(0)" ::: "memory")

__device__ __forceinline__ unsigned cvt_pk_bf16(float lo, float hi) { unsigned r; asm volatile("v_cvt_pk_bf16_f32 %0, %1, %2" : "=v"(r) : "v"(lo), "v"(hi)); return r; }
__device__ __forceinline__ float bf_lo(unsigned u) { return __uint_as_float(u << 16); }
__device__ __forceinline__ float bf_hi(unsigned u) { return __uint_as_float(u & 0xffff0000u); }
__device__ __forceinline__ float wave_sum(float v) {
#pragma unroll
    for (int o = 1; o < 64; o <<= 1) v += __shfl_xor(v, o);
    return v;
}

namespace pg8 {
typedef unsigned short bf16_t;
typedef int v4i_t __attribute__((ext_vector_type(4)));
typedef int v8i_t __attribute__((ext_vector_type(8)));
constexpr int BM = 256, BK = 64, HALF = 128, HTB = HALF * BK * 2, STAGE_BYTES = 8 * HTB, NXCD = 8, WGM = 8;

__host__ __device__ __forceinline__ int lds_byte(int r, int c) { const int st = (r >> 4) * 2 + (c >> 5), rr = r & 15, cc = c & 31, ob = rr * 64 + cc * 2; return st * 1024 + (ob ^ (((ob >> 9) & 1) << 5)); }
__host__ __device__ __forceinline__ void stage_rc(int b, int& R, int& C) { const int st = b / 1024, sb = b % 1024, swz = sb ^ (((sb >> 9) & 1) << 5); R = (st >> 1) * 16 + swz / 64; C = (st & 1) * 32 + (swz % 64) / 2; }
__host__ __device__ __forceinline__ int perm32(int rho) { const int n = rho >> 4, i = rho & 15; return 8 * (i >> 2) + 4 * n + (i & 3); }

template <int NF> __device__ __forceinline__ void pg8_ldfrag16(bf16x8 (&dst)[NF][2], const LAS unsigned char* base, int off) {
#pragma unroll
    for (int m = 0; m < NF; ++m)
#pragma unroll
        for (int k = 0; k < 2; ++k) dst[m][k] = *(const LAS bf16x8*)(base + off + m * 2048 + k * 1024);
}
template <int NF> __device__ __forceinline__ void pg8_ldfrag8(v8i_t (&dst)[NF], const LAS unsigned char* base, int off1, int off2) {
#pragma unroll
    for (int m = 0; m < NF; ++m) { const v4i_t lo = *(const LAS v4i_t*)(base + off1 + m * 2048), hi = *(const LAS v4i_t*)(base + off2 + m * 2048); dst[m] = __builtin_shufflevector(lo, hi, 0, 1, 2, 3, 4, 5, 6, 7); }
}
__device__ __forceinline__ void pg8_mma16(f32x4 (&acc)[4][2], const bf16x8 (&At)[4][2], const bf16x8 (&Bt)[2][2]) {
#pragma unroll
    for (int m = 0; m < 4; ++m)
#pragma unroll
        for (int n = 0; n < 2; ++n)
#pragma unroll
            for (int k = 0; k < 2; ++k) acc[m][n] = __builtin_amdgcn_mfma_f32_16x16x32_bf16(Bt[n][k], At[m][k], acc[m][n], 0, 0, 0);
}
__device__ __forceinline__ void pg8_mma8(f32x4 (&acc)[4][2], const v8i_t (&At)[4], const v8i_t (&Bt)[2]) {
    int sc = 0x7F7F7F7F;
#pragma unroll
    for (int m = 0; m < 4; ++m)
#pragma unroll
        for (int n = 0; n < 2; ++n) asm volatile("v_mfma_scale_f32_16x16x128_f8f6f4 %0, %1, %2, %0, %3, %3 op_sel_hi:[0,0,0]" : "+v"(acc[m][n]) : "v"(Bt[n]), "v"(At[m]), "v"(sc));
}
struct Unit { int pm, pn; };
struct Gemm { const bf16_t* A; const bf16_t* Bt; int M, N, K, lda, ldb, agrp_div, agrp_cols, bgrp_div, bgrp_cols; };

struct StaticOrder {
    int nM, nN, nwg, G, c;
    __host__ __device__ void init(int M_, int N_, int G_, int c_) { nM = M_ / BM; nN = N_ / BM; nwg = nM * nN; G = G_; c = c_; }
    __host__ __device__ bool next(int i, Unit& u) const {
        const long L = (long)i * G + c; if (L >= nwg) return false;
        int wgid = (int)L; { const int q = nwg / NXCD, r = nwg % NXCD, xcd = wgid % NXCD, off = wgid / NXCD; wgid = (xcd < r ? xcd * (q + 1) : r * (q + 1) + (xcd - r) * q) + off; }
        const int nig = WGM * nN, gid = wgid / nig, fm = gid * WGM, gsz = (nM - fm) < WGM ? (nM - fm) : WGM;
        u.pm = fm + ((wgid % nig) % gsz); u.pn = (wgid % nig) / gsz; return true;
    }
    __device__ __forceinline__ void a_ready(const Unit&) const {}
    __device__ __forceinline__ void done(const Unit&) const {}
};

struct EpiBf16 {
    static constexpr bool PERM = true, AFTER_DRAIN = false;
    bf16_t* O; int ldc; int scale_cols; float scale0; bf16_t* HM; int hm_cols; int hm_rows; float scale1 = 1.0f;
    __device__ __forceinline__ void operator()(const f32x4 (&acc)[2][2][4][2], const Unit& u, int wr, int wc, int fr, int fq) const {
        const int row0 = u.pm * BM + wr * 64 + fr; const int colt = u.pn * BM;
        const float sc = (colt < scale_cols) ? scale0 : scale1;
        const bool hm = colt < hm_cols;
        const int cw = wc * 32 + 8 * fq;
        bf16_t* base = hm ? HM + (size_t)(colt / HALF) * hm_rows * HALF + cw : O + (colt - hm_cols) + cw;
        const size_t rpitch = hm ? (size_t)HALF : (size_t)ldc, hstep = hm ? (size_t)hm_rows * HALF : (size_t)HALF;
#pragma unroll
        for (int ai = 0; ai < 2; ++ai)
#pragma unroll
            for (int m = 0; m < 4; ++m) { bf16_t* rowp = base + (size_t)(row0 + ai * HALF + m * 16) * rpitch;
#pragma unroll
                for (int bj = 0; bj < 2; ++bj) { f32x4 v0 = acc[ai][bj][m][0] * sc, v1 = acc[ai][bj][m][1] * sc;
                    v4u w; w.x = cvt_pk_bf16(v0[0], v0[1]); w.y = cvt_pk_bf16(v0[2], v0[3]); w.z = cvt_pk_bf16(v1[0], v1[1]); w.w = cvt_pk_bf16(v1[2], v1[3]);
                    *(v4u*)(rowp + bj * hstep) = w; } }
    }
};
struct EpiBf16ColScale {
    static constexpr bool PERM = true, AFTER_DRAIN = false;
    bf16_t* O; int ldc; int coff; const float* cs;
    __device__ __forceinline__ void operator()(const f32x4 (&acc)[2][2][4][2], const Unit& u, int wr, int wc, int fr, int fq) const {
        const int row0 = u.pm * BM + wr * 64 + fr; const int col0 = u.pn * BM + wc * 32 + 8 * fq;
        f32x4 sv[2][2];
#pragma unroll
        for (int bj = 0; bj < 2; ++bj)
#pragma unroll
            for (int n = 0; n < 2; ++n) sv[bj][n] = *(const f32x4*)(cs + col0 + bj * HALF + 4 * n);
#pragma unroll
        for (int ai = 0; ai < 2; ++ai)
#pragma unroll
            for (int m = 0; m < 4; ++m) { bf16_t* rowp = O + (size_t)(row0 + ai * HALF + m * 16) * ldc + coff + col0;
#pragma unroll
                for (int bj = 0; bj < 2; ++bj) { f32x4 v0 = acc[ai][bj][m][0] * sv[bj][0], v1 = acc[ai][bj][m][1] * sv[bj][1];
                    v4u w; w.x = cvt_pk_bf16(v0[0], v0[1]); w.y = cvt_pk_bf16(v0[2], v0[3]); w.z = cvt_pk_bf16(v1[0], v1[1]); w.w = cvt_pk_bf16(v1[2], v1[3]);
                    *(v4u*)(rowp + bj * HALF) = w; } }
    }
};
struct EpiFp8 {
    static constexpr bool PERM = true, AFTER_DRAIN = false;
    unsigned char* O; int ldc; int coff; float scale;
    __device__ __forceinline__ void operator()(const f32x4 (&acc)[2][2][4][2], const Unit& u, int wr, int wc, int fr, int fq) const {
        const int row0 = u.pm * BM + wr * 64 + fr; const int col0 = u.pn * BM + wc * 32 + 8 * fq;
#pragma unroll
        for (int ai = 0; ai < 2; ++ai)
#pragma unroll
            for (int m = 0; m < 4; ++m) { unsigned char* rowp = O + (size_t)(row0 + ai * HALF + m * 16) * ldc + coff + col0;
#pragma unroll
                for (int bj = 0; bj < 2; ++bj) { const f32x4 v0 = acc[ai][bj][m][0] * scale, v1 = acc[ai][bj][m][1] * scale; int lo = 0, hi = 0;
                    lo = __builtin_amdgcn_cvt_pk_fp8_f32(v0[0], v0[1], lo, false); lo = __builtin_amdgcn_cvt_pk_fp8_f32(v0[2], v0[3], lo, true);
                    hi = __builtin_amdgcn_cvt_pk_fp8_f32(v1[0], v1[1], hi, false); hi = __builtin_amdgcn_cvt_pk_fp8_f32(v1[2], v1[3], hi, true);
                    *(v2u*)(rowp + bj * HALF) = (v2u){(unsigned)lo, (unsigned)hi}; } }
    }
};
struct EpiResBf16 {
    static constexpr bool PERM = true, AFTER_DRAIN = false;
    const float* X; const float* gate; bf16_t* O; int ldc; float ascale;
    __device__ __forceinline__ void operator()(const f32x4 (&acc)[2][2][4][2], const Unit& u, int wr, int wc, int fr, int fq) const {
        const int row0 = u.pm * BM + wr * 64 + fr; const int col0 = u.pn * BM + wc * 32 + 8 * fq; const int b = (u.pm * BM) / SEQ;
        f32x4 gv[2][2];
#pragma unroll
        for (int bj = 0; bj < 2; ++bj)
#pragma unroll
            for (int n = 0; n < 2; ++n) gv[bj][n] = *(const f32x4*)(gate + (size_t)b * DM + col0 + bj * HALF + 4 * n) * ascale;
#pragma unroll
        for (int ai = 0; ai < 2; ++ai)
#pragma unroll
            for (int m = 0; m < 4; ++m) { const size_t off = (size_t)(row0 + ai * HALF + m * 16) * ldc + col0;
#pragma unroll
                for (int bj = 0; bj < 2; ++bj) { const f32x4 x0 = *(const f32x4*)(X + off + bj * HALF), x1 = *(const f32x4*)(X + off + bj * HALF + 4);
                    const f32x4 v0 = x0 + gv[bj][0] * acc[ai][bj][m][0], v1 = x1 + gv[bj][1] * acc[ai][bj][m][1];
                    v4u w; w.x = cvt_pk_bf16(v0[0], v0[1]); w.y = cvt_pk_bf16(v0[2], v0[3]); w.z = cvt_pk_bf16(v1[0], v1[1]); w.w = cvt_pk_bf16(v1[2], v1[3]);
                    *(v4u*)(O + off + bj * HALF) = w; } }
    }
};
struct EpiResF32 {
    static constexpr bool PERM = false, AFTER_DRAIN = false;
    const float* X; const float* gate; float* O; int ldc;
    __device__ __forceinline__ void operator()(const f32x4 (&acc)[2][2][4][2], const Unit& u, int wr, int wc, int fr, int fq) const {
        const int row0 = u.pm * BM + wr * 64 + fr; const int col0 = u.pn * BM + wc * 32 + 4 * fq; const int b = (u.pm * BM) / SEQ;
        f32x4 gv[2][2];
#pragma unroll
        for (int bj = 0; bj < 2; ++bj)
#pragma unroll
            for (int n = 0; n < 2; ++n) gv[bj][n] = *(const f32x4*)(gate + (size_t)b * DM + col0 + bj * HALF + n * 16);
#pragma unroll
        for (int ai = 0; ai < 2; ++ai)
#pragma unroll
            for (int m = 0; m < 4; ++m) { const size_t off = (size_t)(row0 + ai * HALF + m * 16) * ldc + col0;
#pragma unroll
                for (int bj = 0; bj < 2; ++bj)
#pragma unroll
                    for (int n = 0; n < 2; ++n) { const f32x4 xv = *(const f32x4*)(X + off + bj * HALF + n * 16);
                        *(f32x4*)(O + off + bj * HALF + n * 16) = xv + gv[bj][n] * acc[ai][bj][m][n]; } }
    }
};
struct EpiF32 {
    static constexpr bool PERM = false, AFTER_DRAIN = false;
    float* O; int ldc;
    __device__ __forceinline__ void operator()(const f32x4 (&acc)[2][2][4][2], const Unit& u, int wr, int wc, int fr, int fq) const {
        const int row0 = u.pm * BM + wr * 64 + fr; const int col0 = u.pn * BM + wc * 32 + 4 * fq;
#pragma unroll
        for (int ai = 0; ai < 2; ++ai)
#pragma unroll
            for (int m = 0; m < 4; ++m) { const size_t off = (size_t)(row0 + ai * HALF + m * 16) * ldc + col0;
#pragma unroll
                for (int bj = 0; bj < 2; ++bj)
#pragma unroll
                    for (int n = 0; n < 2; ++n) *(f32x4*)(O + off + bj * HALF + n * 16) = acc[ai][bj][m][n]; }
    }
};

template <class Epi, class Sched, bool ALIGN_EPI, bool FP8 = false>
__device__ __forceinline__ void gemm_phase(LAS unsigned char* lds, const Gemm g, const Sched& S, const Epi& E) {
    int tid_ = threadIdx.x; asm volatile("" : "+v"(tid_));
    const int tid = tid_, wid = __builtin_amdgcn_readfirstlane(tid >> 6), lane = tid & 63, wr = wid >> 2, wc = wid & 3, fr = lane & 15, fq = lane >> 4;
    const int K = g.K, nt = K / BK;
    unsigned voffA, voffB;
    { int R, C; stage_rc(tid * 16, R, C); const int Rb = Epi::PERM ? ((R & ~31) + perm32(R & 31)) : R;
      voffA = (unsigned)(R * g.lda + C) * 2u; voffB = (unsigned)(Rb * g.ldb + C) * 2u; }
    const size_t pstepA = (size_t)64 * g.lda * 2, pstepB = (size_t)64 * g.ldb * 2;
    const size_t kstep = (size_t)(BK * 2);
    const size_t hstepA = (size_t)HALF * g.lda * 2, hstepB = (size_t)HALF * g.ldb * 2;
    const size_t tstepA = 2 * hstepA, tstepB = 2 * hstepB;
    const unsigned ldsw = (unsigned)wid * 1024u;
    const int aoff = lds_byte(wr * 64 + fr, fq * 8), boff = lds_byte(wc * 32 + fr, fq * 8);
    const int h8 = (fq >> 1) & 1;
    const int aoff1 = lds_byte(wr * 64 + fr, fq * 16 + h8 * 8), aoff2 = lds_byte(wr * 64 + fr, fq * 16 + (1 - h8) * 8);
    const int boff1 = lds_byte(wc * 32 + fr, fq * 16 + h8 * 8), boff2 = lds_byte(wc * 32 + fr, fq * 16 + (1 - h8) * 8);
#define PG8_SA(b, h) (((b) * 2 + (h)) * HTB)
#define PG8_SB(b, h) ((4 + (b) * 2 + (h)) * HTB)
#define PG8_STAGE(bufoff, gbase, voff) do { _Pragma("unroll") for (int _i = 0; _i < 2; ++_i) \
        __builtin_amdgcn_global_load_lds((const unsigned*)((const char*)(gbase) + (size_t)_i * pstep_##voff + (voff)), (LAS unsigned*)(lds + (bufoff) + ldsw + _i * 8192), 16, 0, 0); } while (0)
#define pstep_voffA pstepA
#define pstep_voffB pstepB
#define PG8_LDA(dst, b, h) do { if constexpr (FP8) pg8_ldfrag8<4>(dst##8, lds + PG8_SA(b, h), aoff1, aoff2); else pg8_ldfrag16<4>(dst, lds + PG8_SA(b, h), aoff); } while (0)
#define PG8_LDB(dst, b, h) do { if constexpr (FP8) pg8_ldfrag8<2>(dst##8, lds + PG8_SB(b, h), boff1, boff2); else pg8_ldfrag16<2>(dst, lds + PG8_SB(b, h), boff); } while (0)
#define PG8_MMA(ai, bj, At, Bt) do { __builtin_amdgcn_s_setprio(1); if constexpr (FP8) pg8_mma8(acc[ai][bj], At##8, Bt##8); else pg8_mma16(acc[ai][bj], At, Bt); __builtin_amdgcn_s_setprio(0); } while (0)
#define PG8_WAIT_V(n) asm volatile("s_waitcnt vmcnt(" #n ")" ::: "memory")
#define PG8_WAIT_L(n) asm volatile("s_waitcnt lgkmcnt(" #n ")" ::: "memory")
#define PG8_BAR __builtin_amdgcn_s_barrier()
#define PG8_SCHED __builtin_amdgcn_sched_barrier(0)
#define PG8_ABASE(u) ((const char*)g.A + (size_t)(u).pm * tstepA + (size_t)((u).pn / g.agrp_div) * (size_t)g.agrp_cols * 2)
#define PG8_BBASE(u) ((const char*)g.Bt + (size_t)(u).pn * tstepB + (size_t)((u).pm / g.bgrp_div) * (size_t)g.bgrp_cols * 2)
    Unit cur, nxt; int ui = 0;
    if (!S.next(0, cur)) return;
    f32x4 acc[2][2][4][2];
#pragma unroll
    for (int a = 0; a < 2; ++a)
#pragma unroll
        for (int b = 0; b < 2; ++b)
#pragma unroll
            for (int m = 0; m < 4; ++m)
#pragma unroll
                for (int n = 0; n < 2; ++n) acc[a][b][m][n] = (f32x4){0.f, 0.f, 0.f, 0.f};
    bf16x8 At[4][2], B0[2][2], B1[2][2]; v8i_t At8[4], B08[2], B18[2];
    const char* cA = PG8_ABASE(cur); const char* cB = PG8_BBASE(cur);
    S.a_ready(cur);
    PG8_STAGE(PG8_SB(0, 0), cB, voffB); PG8_STAGE(PG8_SB(0, 1), cB + hstepB, voffB); PG8_STAGE(PG8_SA(0, 0), cA, voffA); PG8_STAGE(PG8_SA(0, 1), cA + hstepA, voffA);
    if (wr == 1) PG8_BAR;
    PG8_WAIT_V(2); PG8_BAR;
    PG8_STAGE(PG8_SB(1, 0), cB + kstep, voffB); PG8_STAGE(PG8_SA(1, 0), cA + kstep, voffA); PG8_STAGE(PG8_SB(1, 1), cB + hstepB + kstep, voffB);
    PG8_WAIT_V(6); PG8_BAR;
    for (;;) {
        const bool has_next = S.next(ui + 1, nxt);
        const char* nA = has_next ? PG8_ABASE(nxt) : cA; const char* nB = has_next ? PG8_BBASE(nxt) : cB;
        for (int t = 0; t < nt; t += 2) {
            const bool last = (t == nt - 2);
            const char* a1 = cA + (size_t)(t + 1) * kstep;
            const char* a2 = last ? nA : cA + (size_t)(t + 2) * kstep; const char* b2 = last ? nB : cB + (size_t)(t + 2) * kstep;
            const char* a3 = a2 + kstep; const char* b3 = b2 + kstep;
            if (last && has_next) S.a_ready(nxt);
            PG8_LDB(B0, 0, 0); PG8_LDB(B1, 0, 1); PG8_SCHED; PG8_LDA(At, 0, 0); PG8_STAGE(PG8_SA(1, 1), a1 + hstepA, voffA);
            PG8_WAIT_V(8); PG8_WAIT_L(0); PG8_BAR; PG8_MMA(0, 0, At, B0); PG8_MMA(0, 1, At, B1); PG8_BAR; PG8_SCHED;
            PG8_LDA(At, 0, 1); PG8_STAGE(PG8_SB(0, 0), b2, voffB); PG8_STAGE(PG8_SB(0, 1), b2 + hstepB, voffB); PG8_STAGE(PG8_SA(0, 0), a2, voffA);
            PG8_WAIT_V(8); PG8_WAIT_L(0); PG8_BAR; PG8_MMA(1, 0, At, B0); PG8_MMA(1, 1, At, B1); PG8_BAR; PG8_SCHED;
            PG8_LDB(B0, 1, 0); PG8_LDB(B1, 1, 1); PG8_SCHED; PG8_LDA(At, 1, 0); PG8_STAGE(PG8_SA(0, 1), a2 + hstepA, voffA);
            PG8_WAIT_V(8); PG8_WAIT_L(0); PG8_BAR; PG8_MMA(0, 0, At, B0); PG8_MMA(0, 1, At, B1); PG8_BAR; PG8_SCHED;
            PG8_LDA(At, 1, 1); PG8_STAGE(PG8_SB(1, 0), b3, voffB); PG8_STAGE(PG8_SB(1, 1), b3 + hstepB, voffB); PG8_STAGE(PG8_SA(1, 0), a3, voffA);
            PG8_WAIT_V(8); PG8_WAIT_L(0); PG8_BAR; PG8_MMA(1, 0, At, B0); PG8_MMA(1, 1, At, B1); PG8_BAR; PG8_SCHED;
        }
        if constexpr (ALIGN_EPI) { if (wr == 0) PG8_BAR; }
        if constexpr (FP8) asm volatile("s_nop 15\n\ts_nop 15" ::: "memory");
        if constexpr (FP8) { int ln_ = lane; asm volatile("" : "+v"(ln_));
          E(acc, cur, wr, wc, ln_ & 15, ln_ >> 4); } else E(acc, cur, wr, wc, fr, fq);
        S.done(cur);
        if (!has_next) break;
#pragma unroll
        for (int a = 0; a < 2; ++a)
#pragma unroll
            for (int b = 0; b < 2; ++b)
#pragma unroll
                for (int m = 0; m < 4; ++m)
#pragma unroll
                    for (int n = 0; n < 2; ++n) acc[a][b][m][n] = (f32x4){0.f, 0.f, 0.f, 0.f};
        cur = nxt; cA = nA; cB = nB; ++ui;
        if constexpr (ALIGN_EPI) { if (wr == 1) PG8_BAR; }
    }
    PG8_WAIT_V(0);
    if constexpr (!ALIGN_EPI) { if (wr == 0) PG8_BAR; }
    PG8_BAR;
#undef PG8_SA
#undef PG8_SB
#undef PG8_STAGE
#undef pstep_voffA
#undef pstep_voffB
#undef PG8_LDA
#undef PG8_LDB
#undef PG8_MMA
#undef PG8_WAIT_V
#undef PG8_WAIT_L
#undef PG8_BAR
#undef PG8_SCHED
#undef PG8_ABASE
#undef PG8_BBASE
}
}

#define XB_TMO      128
#define XB_XCNT(j)  (256  + 64 * (j))
#define XB_XSUB(j)  (1280 + 64 * (j))
#define XB_XGEN(j)  (2304 + 64 * (j))
#define XB_TOP      3328
#define XB_TOPGEN   3392
#define XCD_BAR_WORDS 3456
#define XB_SPIN_CAP (1u << 18)

__device__ __forceinline__ unsigned xb_ld(unsigned* p)              { return __hip_atomic_load(p, __ATOMIC_RELAXED, __HIP_MEMORY_SCOPE_AGENT); }
__device__ __forceinline__ unsigned xb_add(unsigned* p, unsigned v) { return __hip_atomic_fetch_add(p, v, __ATOMIC_RELAXED, __HIP_MEMORY_SCOPE_AGENT); }
__device__ __forceinline__ unsigned xb_xcc_id() { return (unsigned)__builtin_amdgcn_s_getreg((3 << 11) | 20) & 0xFu; }
#define XB_SPIN(cond, bar) do { unsigned _sp = 0; while (cond) { __builtin_amdgcn_s_sleep(1); \
    if ((++_sp & 255u) == 0u) { if (xb_ld(&(bar)[XB_TMO])) break; if (_sp > XB_SPIN_CAP) { atomicAdd(&(bar)[XB_TMO], 1u); break; } } } } while (0)

struct XcdBarrier { unsigned* bar; unsigned x; volatile LAS unsigned* st; };

__device__ __forceinline__ XcdBarrier xcd_barrier_post(unsigned* bar, volatile LAS unsigned* st) {
    XcdBarrier b; b.bar = bar; b.x = xb_xcc_id(); b.st = st;
    if (threadIdx.x == 0) (void)xb_add(&bar[XB_XCNT(b.x)], 1u);
    return b;
}
__device__ __forceinline__ void xcd_barrier_complete(unsigned* bar, unsigned x, unsigned& nloc, unsigned& nx) {
    const unsigned G = gridDim.x * gridDim.y * gridDim.z;
    unsigned sum, cnt, mine, sp = 0u;
    for (;;) {
        sum = 0u; cnt = 0u; mine = 0u;
#pragma unroll
        for (unsigned j = 0; j < 16; ++j) { const unsigned c = xb_ld(&bar[XB_XCNT(j)]); sum += c; cnt += (c > 0u) ? 1u : 0u; mine = (j == x) ? c : mine; }
        if (sum == G) break;
        __builtin_amdgcn_s_sleep(1);
        if ((++sp & 255u) == 0u) { if (xb_ld(&bar[XB_TMO])) break; if (sp > XB_SPIN_CAP) { atomicAdd(&bar[XB_TMO], 1u); break; } }
    }
    nloc = mine > 0u ? mine : 1u; nx = cnt > 0u ? cnt : 1u;
}
__device__ __forceinline__ void xcd_barrier(const XcdBarrier& b) {
    asm volatile("s_waitcnt vmcnt(0)" ::: "memory");
    __syncthreads();
    if (threadIdx.x == 0) {
        unsigned* bar = b.bar;
        __builtin_amdgcn_s_waitcnt(0);
        unsigned nloc = b.st[0], nx = b.st[1];
        if (nloc == 0u) { xcd_barrier_complete(bar, b.x, nloc, nx); b.st[0] = nloc; b.st[1] = nx; }
        const unsigned old = xb_add(&bar[XB_XSUB(b.x)], 1u);
        const unsigned gen = old / nloc;
        if (old + 1u == (gen + 1u) * nloc) {
            __builtin_amdgcn_fence(__ATOMIC_RELEASE, "agent");
            asm volatile("s_waitcnt vmcnt(0)" ::: "memory");
            const unsigned og = xb_add(&bar[XB_TOP], 1u);
            const unsigned tg = og / nx;
            if (og + 1u == (tg + 1u) * nx) xb_add(&bar[XB_TOPGEN], 1u);
            else XB_SPIN(xb_ld(&bar[XB_TOPGEN]) == tg, bar);
            __builtin_amdgcn_fence(__ATOMIC_ACQUIRE, "agent");
            xb_add(&bar[XB_XGEN(b.x)], 1u);
            asm volatile("s_waitcnt vmcnt(0)" ::: "memory");
        } else {
            XB_SPIN(xb_ld(&bar[XB_XGEN(b.x)]) == gen, bar);
            __builtin_amdgcn_fence(__ATOMIC_ACQUIRE, "agent");
            asm volatile("s_waitcnt vmcnt(0)" ::: "memory");
        }
    }
    __syncthreads();
}

template <bool F8>
__device__ __forceinline__ void p0_transpose_item(const float* W, int ldw, int N, void* WTv, int ldt, float scale, LAS float* scr, int item, int lane) {
    const int nblk = N / 32, kb = item / nblk, nb = item % nblk, k0 = 64 * kb, n0 = 32 * nb;
#pragma unroll 8
    for (int i = 0; i < 32; ++i) { const int kk = 2 * i + (lane >> 5); scr[kk * 33 + (lane & 31)] = W[(size_t)(k0 + kk) * ldw + n0 + (lane & 31)]; }
    LDS_WAIT(); asm volatile("" ::: "memory");
    const int c = lane & 7;
#pragma unroll
    for (int j = 0; j < 4; ++j) { const int n = (lane >> 3) + 8 * j; const LAS float* s = scr + (8 * c) * 33 + n;
        if constexpr (F8) { int lo = 0, hi = 0;
            lo = __builtin_amdgcn_cvt_pk_fp8_f32(s[0 * 33] * scale, s[1 * 33] * scale, lo, false); lo = __builtin_amdgcn_cvt_pk_fp8_f32(s[2 * 33] * scale, s[3 * 33] * scale, lo, true);
            hi = __builtin_amdgcn_cvt_pk_fp8_f32(s[4 * 33] * scale, s[5 * 33] * scale, hi, false); hi = __builtin_amdgcn_cvt_pk_fp8_f32(s[6 * 33] * scale, s[7 * 33] * scale, hi, true);
            *(GAS v2u*)((unsigned char*)WTv + (size_t)(n0 + n) * ldt + k0 + 8 * c) = (v2u){(unsigned)lo, (unsigned)hi};
        } else {
            v4u o; o.x = cvt_pk_bf16(s[0 * 33], s[1 * 33]); o.y = cvt_pk_bf16(s[2 * 33], s[3 * 33]); o.z = cvt_pk_bf16(s[4 * 33], s[5 * 33]); o.w = cvt_pk_bf16(s[6 * 33], s[7 * 33]);
            *(GAS v4u*)((bf16*)WTv + (size_t)(n0 + n) * ldt + k0 + 8 * c) = o; } }
    LDS_WAIT(); asm volatile("" ::: "memory");
}

__device__ __forceinline__ int t5_bucket(int rel) {
    int n = -rel; const int ret = n < 0 ? 16 : 0; n = n < 0 ? -n : n;
    if (n < 8) return ret + n;
    const float v = logf((float)n / 8.0f) / logf(128.0f) * 8.0f;
    int large = 8 + (int)v; large = large < 15 ? large : 15;
    return ret + large;
}
__device__ __forceinline__ float gelu_tanh(float x) {
    const float z = 0.7978845608028654f * (x + 0.044715f * x * x * x);
    const float e = __expf(2.0f * z);
    const float t = 1.0f - 2.0f / (e + 1.0f);
    return 0.5f * x * (1.0f + t);
}
__device__ __forceinline__ unsigned fkey(float v) { const unsigned u = __float_as_uint(v); return (u >> 31) ? ~u : (u | 0x80000000u); }
__device__ __forceinline__ float fdec(unsigned key) { const unsigned k2 = key & ~127u; const unsigned u = (k2 >> 31) ? (k2 & 0x7fffffffu) : (~k2 & ~127u); return __uint_as_float(u); }
template <int LJ> __device__ __forceinline__ unsigned xshfl(unsigned x, const int lane) {
    if constexpr (LJ == 1) return (unsigned)__builtin_amdgcn_update_dpp(0, (int)x, 0xB1, 0xF, 0xF, false);
    else if constexpr (LJ == 2) return (unsigned)__builtin_amdgcn_update_dpp(0, (int)x, 0x4E, 0xF, 0xF, false);
    else if constexpr (LJ == 4) { const int y = __builtin_amdgcn_update_dpp(0, (int)x, 0x141, 0xF, 0xF, false); return (unsigned)__builtin_amdgcn_update_dpp(0, y, 0x1B, 0xF, 0xF, false); }
    else if constexpr (LJ == 8) { const int y = __builtin_amdgcn_update_dpp(0, (int)x, 0x140, 0xF, 0xF, false); return (unsigned)__builtin_amdgcn_update_dpp(0, y, 0x141, 0xF, 0xF, false); }
    else if constexpr (LJ == 16) return (unsigned)__builtin_amdgcn_ds_swizzle((int)x, 0x401F);
    else { const auto rr = __builtin_amdgcn_permlane32_swap(x, x, false, false); return lane < 32 ? rr[1] : rr[0]; }
}
template <int K, int J> __device__ __forceinline__ void bitonic_step(unsigned& a0, unsigned& a1, unsigned& b0, unsigned& b1, const int lane) {
    const bool asc = (K == 128) ? true : ((lane & (K >> 1)) == 0);
    if constexpr (J == 1) {
        const unsigned la = a0 < a1 ? a0 : a1, ha = a0 < a1 ? a1 : a0, lb = b0 < b1 ? b0 : b1, hb = b0 < b1 ? b1 : b0;
        a0 = asc ? la : ha; a1 = asc ? ha : la; b0 = asc ? lb : hb; b1 = asc ? hb : lb;
    } else {
        constexpr int LJ = J >> 1; const bool tmin = (((lane & LJ) == 0) == asc);
        const unsigned pa0 = xshfl<LJ>(a0, lane), pa1 = xshfl<LJ>(a1, lane), pb0 = xshfl<LJ>(b0, lane), pb1 = xshfl<LJ>(b1, lane);
        a0 = tmin ? (a0 < pa0 ? a0 : pa0) : (a0 < pa0 ? pa0 : a0); a1 = tmin ? (a1 < pa1 ? a1 : pa1) : (a1 < pa1 ? pa1 : a1);
        b0 = tmin ? (b0 < pb0 ? b0 : pb0) : (b0 < pb0 ? pb0 : b0); b1 = tmin ? (b1 < pb1 ? b1 : pb1) : (b1 < pb1 ? pb1 : b1);
    }
    if constexpr (J > 1) bitonic_step<K, (J >> 1)>(a0, a1, b0, b1, lane);
}
template <int K> __device__ __forceinline__ void bitonic_stage(unsigned& a0, unsigned& a1, unsigned& b0, unsigned& b1, const int lane) {
    bitonic_step<K, (K >> 1)>(a0, a1, b0, b1, lane);
    if constexpr (K < 128) bitonic_stage<(K << 1)>(a0, a1, b0, b1, lane);
}
__device__ __forceinline__ void bitonic128x2(unsigned& a0, unsigned& a1, unsigned& b0, unsigned& b1, const int lane) { bitonic_stage<2>(a0, a1, b0, b1, lane); }
__device__ __forceinline__ float dot2bf(unsigned a, unsigned b, float c) { return __builtin_amdgcn_fdot2_f32_bf16(__builtin_bit_cast(bf2_t, a), __builtin_bit_cast(bf2_t, b), c, false); }

constexpr int ATT_SLOT = 8704;
__device__ __forceinline__ int crow(int r, int hi) { return (r & 3) + 8 * (r >> 2) + 4 * hi; }

__device__ __forceinline__ void attn_task(const int G, const bf16* QKVH, bf16* O0, bf16* O1, float* LSE0, float* LSE1, unsigned char* MIX8,
                                          const LAS float* btab, LAS unsigned char* wl, int b, int h, int mtile, int tk, int lane) {
    const int SH = 2 * G;
    const int L = SEQ >> SH, TPR = 32 >> SH;
    const int r32 = lane & 31, hi = lane >> 5;
    const int res = tk >> (5 - SH), l0 = ((mtile * 1024) >> SH) + 32 * (tk & (TPR - 1));
    const size_t rowbase = (size_t)b * SEQ;
    const int srow = lane >> 4, sch = lane & 15;
    const int rot = (tk & 1) ? 4 : 0;
#define ATT_JR(j) (((j) + rot) >= 5 ? ((j) + rot - 5) : ((j) + rot))
#define ATT_WAITV(n) asm volatile("s_waitcnt vmcnt(" #n ")" ::: "memory")
#define ATT_ISSUE(n) do { LAS unsigned char* sl_ = wl + ((n) & 1) * ATT_SLOT; const int jt_ = ATT_JR((n) < 5 ? (n) : (n) - 5); \
        _Pragma("unroll") for (int i_ = 0; i_ < 8; ++i_) { \
            const int key_ = (n) < 5 ? (4 * i_ + srow) : ((i_ & 3) + 4 * srow + 16 * (i_ >> 2)); \
            int lk_ = l0 - 64 + 32 * jt_ + key_; lk_ = lk_ < 0 ? 0 : (lk_ > L - 1 ? L - 1 : lk_); \
            const int ch_ = (n) < 5 ? (sch ^ (key_ & 7)) : sch; \
            const bf16* src_ = QKVH + ((size_t)(((n) < 5 ? NH : 2 * NH) + h) * M + rowbase + ((size_t)lk_ << SH) + res) * HD + ch_ * 8; \
            __builtin_amdgcn_global_load_lds((const unsigned*)src_, (LAS unsigned*)(sl_ + i_ * ((n) < 5 ? 1024 : 1088)), 16, 0, 0); } } while (0)
    const size_t qrow = rowbase + ((size_t)(l0 + r32) << SH) + res;
    bf16x8 qr[8];
    { const bf16* qp = QKVH + ((size_t)h * M + qrow) * HD + hi * 8;
#pragma unroll
      for (int d0 = 0; d0 < 8; ++d0) qr[d0] = *(const bf16x8*)(qp + d0 * 16); }
    ATT_ISSUE(0); ATT_ISSUE(1);
    f32x16 p[5];
#define ATT_KTILE(n) do { LAS unsigned char* sl_ = wl + ((n) & 1) * ATT_SLOT + r32 * 256; f32x16 s_ = {}; \
        _Pragma("unroll") for (int d0 = 0; d0 < 8; ++d0) { const bf16x8 a_ = *(const LAS bf16x8*)(sl_ + (((2 * d0 + hi) ^ (r32 & 7)) << 4)); s_ = __builtin_amdgcn_mfma_f32_32x32x16_bf16(a_, qr[d0], s_, 0, 0, 0); } \
        p[n] = s_; asm volatile("" ::: "memory"); } while (0)
    ATT_WAITV(8); ATT_KTILE(0); ATT_ISSUE(2);
    ATT_WAITV(8); ATT_KTILE(1); ATT_ISSUE(3);
    ATT_WAITV(8); ATT_KTILE(2); ATT_ISSUE(4);
    ATT_WAITV(8); ATT_KTILE(3); ATT_ISSUE(5);
    ATT_WAITV(8); ATT_KTILE(4); ATT_ISSUE(6);
    float mx = -1e30f;
    const bool edge = (l0 - 64 < 0) || (l0 + 96 > L);
    const LAS float* bt = btab + G * 256 + 32 + 4 * hi - r32;
#pragma unroll
    for (int j = 0; j < 5; ++j) {
        const int jr = ATT_JR(j); const LAS float* btj = bt + 32 * jr;
#pragma unroll
        for (int r = 0; r < 16; ++r) {
            const int kc = 32 * jr + (r & 3) + 8 * (r >> 2);
            float v = p[j][r] + btj[(r & 3) + 8 * (r >> 2)];
            if (edge) { const int lk = l0 - 64 + kc + 4 * hi; v = (lk >= 0 && lk < L) ? v : -1e30f; }
            p[j][r] = v; mx = fmaxf(mx, v);
        }
        asm volatile("" ::: "memory");
    }
    mx = fmaxf(mx, __shfl_xor(mx, 32));
    float ls = 0.f;
    bf16x8 pb[5][2];
#pragma unroll
    for (int j = 0; j < 5; ++j) {
        float e[16];
#pragma unroll
        for (int r = 0; r < 16; ++r) { e[r] = __builtin_amdgcn_exp2f(p[j][r] - mx); ls += e[r]; }
#pragma unroll
        for (int s = 0; s < 2; ++s) { v4u w; w.x = cvt_pk_bf16(e[8 * s + 0], e[8 * s + 1]); w.y = cvt_pk_bf16(e[8 * s + 2], e[8 * s + 3]);
            w.z = cvt_pk_bf16(e[8 * s + 4], e[8 * s + 5]); w.w = cvt_pk_bf16(e[8 * s + 6], e[8 * s + 7]); pb[j][s] = __builtin_bit_cast(bf16x8, w); }
    }
    ls += __shfl_xor(ls, 32);
    asm volatile("" ::: "memory");
    f32x16 o[4] = {};
    const int i16 = lane & 15, g16 = lane >> 4;
    const unsigned vbase = (unsigned)(uintptr_t)wl + (unsigned)((i16 >> 2) * 1088 + hi * 256 + (16 * (g16 & 1) + 4 * (i16 & 3)) * 2);
#define ATT_VTILE(n) do { const unsigned va_ = vbase + ((n) & 1) * ATT_SLOT; \
        _Pragma("unroll") for (int dt = 0; dt < 4; ++dt) { s16x4 lo0, hi0, lo1, hi1; \
            asm volatile("ds_read_b64_tr_b16 %0, %4 offset:%5\n\tds_read_b64_tr_b16 %1, %4 offset:%6\n\tds_read_b64_tr_b16 %2, %4 offset:%7\n\tds_read_b64_tr_b16 %3, %4 offset:%8\n\ts_waitcnt lgkmcnt(0)" \
                         : "=&v"(lo0), "=&v"(hi0), "=&v"(lo1), "=&v"(hi1) : "v"(va_), "i"(dt * 64), "i"(512 + dt * 64), "i"(4 * 1088 + dt * 64), "i"(4 * 1088 + 512 + dt * 64) : "memory"); \
            const bf16x8 af0 = (bf16x8){lo0[0], lo0[1], lo0[2], lo0[3], hi0[0], hi0[1], hi0[2], hi0[3]}; \
            const bf16x8 af1 = (bf16x8){lo1[0], lo1[1], lo1[2], lo1[3], hi1[0], hi1[1], hi1[2], hi1[3]}; \
            o[dt] = __builtin_amdgcn_mfma_f32_32x32x16_bf16(af0, pb[(n) - 5][0], o[dt], 0, 0, 0); \
            o[dt] = __builtin_amdgcn_mfma_f32_32x32x16_bf16(af1, pb[(n) - 5][1], o[dt], 0, 0, 0); } } while (0)
    ATT_WAITV(8); ATT_VTILE(5); ATT_ISSUE(7);
    ATT_WAITV(8); ATT_VTILE(6); ATT_ISSUE(8);
    ATT_WAITV(8); ATT_VTILE(7); ATT_ISSUE(9);
    ATT_WAITV(8); ATT_VTILE(8);
    ATT_WAITV(0); ATT_VTILE(9);
#undef ATT_WAITV
#undef ATT_ISSUE
#undef ATT_KTILE
#undef ATT_VTILE
#undef ATT_JR
    const float inv = 1.0f / ls;
    const float lse2 = mx + __builtin_amdgcn_logf(ls);
    const size_t orow = qrow;
    LAS unsigned char* T0 = wl;
    LAS unsigned char* T1 = T0 + ATT_SLOT;
    int ln_ = lane; asm volatile("" : "+v"(ln_));
    const int erow = ln_ >> 4, echk = ln_ & 15;
    const unsigned pofs = (unsigned)(r32 * 272 + 8 * hi);
    if (G < 2) {
#pragma unroll
        for (int dt = 0; dt < 4; ++dt)
#pragma unroll
            for (int rg = 0; rg < 4; ++rg) { v2u w; w.x = cvt_pk_bf16(o[dt][4 * rg] * inv, o[dt][4 * rg + 1] * inv); w.y = cvt_pk_bf16(o[dt][4 * rg + 2] * inv, o[dt][4 * rg + 3] * inv);
                *(LAS v2u*)(T0 + pofs + 64 * dt + 16 * rg) = w; }
        LDS_WAIT();
        bf16* ob = (G == 0 ? O0 : O1) + ((size_t)h * M + rowbase) * HD + echk * 8;
#pragma unroll
        for (int i = 0; i < 8; ++i) { const int qi = erow + 4 * i; const v4u w = *(const LAS v4u*)(T0 + qi * 272 + echk * 16);
            *(v4u*)(ob + (((size_t)(l0 + qi) << SH) + res) * HD) = w; }
        if (hi == 0) (G == 0 ? LSE0 : LSE1)[orow * NH + h] = lse2;
    } else {
        const float l0v = LSE0[orow * NH + h], l1v = LSE1[orow * NH + h];
        const bf16* ib0 = O0 + ((size_t)h * M + rowbase) * HD + echk * 8; const bf16* ib1 = O1 + ((size_t)h * M + rowbase) * HD + echk * 8;
#pragma unroll
        for (int hh = 0; hh < 2; ++hh) {
            v4u t0[4], t1[4];
#pragma unroll
            for (int i = 0; i < 4; ++i) { const size_t ro = (((size_t)(l0 + erow + 4 * (4 * hh + i)) << SH) + res) * HD; t0[i] = *(const v4u*)(ib0 + ro); t1[i] = *(const v4u*)(ib1 + ro); }
#pragma unroll
            for (int i = 0; i < 4; ++i) { const int qi = erow + 4 * (4 * hh + i); *(LAS v4u*)(T0 + qi * 272 + echk * 16) = t0[i]; *(LAS v4u*)(T1 + qi * 272 + echk * 16) = t1[i]; }
            asm volatile("" ::: "memory");
        }
        const float mm = fmaxf(fmaxf(l0v, l1v), lse2);
        const float w0 = __builtin_amdgcn_exp2f(l0v - mm), w1 = __builtin_amdgcn_exp2f(l1v - mm), w2 = __builtin_amdgcn_exp2f(lse2 - mm);
        const float wi = 1.0f / (w0 + w1 + w2);
        const float c0 = w0 * wi, c1 = w1 * wi, c2 = w2 * wi * inv;
        LDS_WAIT();
        unsigned y8[16];
#pragma unroll
        for (int dt = 0; dt < 4; ++dt)
#pragma unroll
            for (int rg = 0; rg < 4; ++rg) { const v2u a = *(const LAS v2u*)(T0 + pofs + 64 * dt + 16 * rg), c = *(const LAS v2u*)(T1 + pofs + 64 * dt + 16 * rg);
                const float y0 = c0 * bf_lo(a.x) + c1 * bf_lo(c.x) + c2 * o[dt][4 * rg], y1 = c0 * bf_hi(a.x) + c1 * bf_hi(c.x) + c2 * o[dt][4 * rg + 1];
                const float y2 = c0 * bf_lo(a.y) + c1 * bf_lo(c.y) + c2 * o[dt][4 * rg + 2], y3 = c0 * bf_hi(a.y) + c1 * bf_hi(c.y) + c2 * o[dt][4 * rg + 3];
                int w = 0; w = __builtin_amdgcn_cvt_pk_fp8_f32(y0 * A8SCALE, y1 * A8SCALE, w, false); w = __builtin_amdgcn_cvt_pk_fp8_f32(y2 * A8SCALE, y3 * A8SCALE, w, true); y8[4 * dt + rg] = (unsigned)w; }
        LDS_WAIT();
#pragma unroll
        for (int dt = 0; dt < 4; ++dt)
#pragma unroll
            for (int rg = 0; rg < 4; ++rg) *(LAS unsigned*)(T0 + r32 * 144 + 4 * hi + 32 * dt + 8 * rg) = y8[4 * dt + rg];
        LDS_WAIT();
        unsigned char* ob = MIX8 + rowbase * DM + h * HD + (ln_ & 7) * 16;
#pragma unroll
        for (int i = 0; i < 4; ++i) { const int qi = (ln_ >> 3) + 8 * i; const v4u w = *(const LAS v4u*)(T0 + qi * 144 + (ln_ & 7) * 16);
            *(v4u*)(ob + (((size_t)(l0 + qi) << SH) + res) * DM) = w; }
    }
    LDS_WAIT();
}

constexpr int PER_PHASE = 9;
struct Args { const float* in[16]; float* out; unsigned char* ws; unsigned mask; unsigned pad; };

__constant__ unsigned char CAND_I[64] = {0,0,0,0,0,0,0,0,0,0,0,0,0,0,0,0, 1,1,1,1,1,1,1,1, 2,2,2,2,2, 3,3,3,3, 4,4,4, 5,5, 6,6, 7,7, 8,9,10,11,12,13,14,15, 0,0,0,0,0,0,0,0,0,0,0,0,0,0};
__constant__ unsigned char CAND_J[64] = {0,1,2,3,4,5,6,7,8,9,10,11,12,13,14,15, 0,1,2,3,4,5,6,7, 0,1,2,3,4, 0,1,2,3, 0,1,2, 0,1, 0,1, 0,1, 0,0,0,0,0,0,0,0, 0,0,0,0,0,0,0,0,0,0,0,0,0,0};

__global__ void __launch_bounds__(NWAVES * 64, 2) fwd_kernel(Args args) {
    extern __shared__ __attribute__((aligned(16))) unsigned char lds_raw[];
    LAS unsigned char* lds = (LAS unsigned char*)lds_raw;
    volatile LAS unsigned* MISC = (volatile LAS unsigned*)(lds + MISC_OFF);
    const int tid0 = threadIdx.x, lane0 = tid0 & 63, wave = __builtin_amdgcn_readfirstlane(tid0 >> 6);
#define PHASE_LANES() int tid = tid0; asm volatile("" : "+v"(tid)); const int lane = tid & 63
    const int G = gridDim.x; const int bx = blockIdx.x;
    const int vcu = (G % 8 == 0) ? (bx % 8) * (G / 8) + bx / 8 : bx;
    const int gw = vcu * NWAVES + wave, NGW = G * NWAVES;
    unsigned char* ws = args.ws;
    unsigned* ctl = (unsigned*)(ws + WS_CTL);
    const float* x = args.in[0]; const float* cvec = args.in[1]; const float* w_ada = args.in[2]; const float* b_ada = args.in[3]; const float* g_mix = args.in[4];
    const float* w_in = args.in[5]; const float* rel_bias = args.in[6]; const float* pool_w = args.in[7]; const float* pool_scale = args.in[8]; const float* w_out = args.in[9];
    const float* g_ffn = args.in[10]; const float* peer_wq = args.in[11]; const float* peer_sk = args.in[12]; const float* peer_u = args.in[13]; const float* peer_v = args.in[14];
    const float* g_final = args.in[15];
    float* out = args.out;
    float* MODV = (float*)(ws + WS_MODV); float* MODP = (float*)(ws + WS_MODP);
    bf16* SKT = (bf16*)(ws + WS_SKT); bf16* PWS = (bf16*)(ws + WS_PWS); bf16* WQST = (bf16*)(ws + WS_WQST); unsigned char* WOUT8 = ws + WS_WOUT2;     bf16* WINT = (bf16*)(ws + WS_WINT); unsigned char* WIN8 = ws + WS_WIN8; unsigned char* H8 = ws + WS_H8;
    bf16* WOPT = (bf16*)(ws + WS_WOPT); bf16* WQB = (bf16*)(ws + WS_WQB);
    unsigned char* UB = ws + WS_UB; unsigned char* VB = ws + WS_VB; float* SCL = (float*)(ws + WS_SCL); bf16* H = (bf16*)(ws + WS_H); bf16* PIN = (bf16*)(ws + WS_PROJ); bf16* QKVH = (bf16*)(ws + WS_QKVH); unsigned char* MIX8 = ws + WS_MIXIN;
    bf16* O0 = (bf16*)(ws + WS_O0); bf16* O1 = (bf16*)(ws + WS_O1); float* LSE = (float*)(ws + WS_LSE);
    float* SC = (float*)(ws + WS_SC);
    bf16* X1B = (bf16*)(ws + WS_O0);
    bf16* YB = (bf16*)(ws + WS_PROJ + 64 * MiB);

    for (int u = tid0; u < (LDS_BYTES - LDSCTL_OFF) / 4; u += NWAVES * 64) ((LAS unsigned*)(lds + LDSCTL_OFF))[u] = 0u;
    __syncthreads();
    XcdBarrier bar; bar.bar = ctl + CW_BAR; bar.x = 0; bar.st = nullptr;
    if (MK_N_LAUNCHES != PER_PHASE) bar = xcd_barrier_post(ctl + CW_BAR, MISC + 8);
#define GRID_BAR() do { if (MK_N_LAUNCHES != PER_PHASE) xcd_barrier(bar); } while (0)
    const unsigned phmask = args.mask;
#ifndef PH_MASK
#define PH_MASK 0x1ff
#endif
#define IN(k) ((((PH_MASK) >> (k)) & 1) && ((phmask >> (k)) & 1u))
#define BOTH(k) (IN(k) && IN((k) + 1))

    if (IN(0)) {
        PHASE_LANES();
        LAS float* silu = (LAS float*)(lds + RING_OFF);
        for (int i = tid; i < BATCH * DM; i += NWAVES * 64) { const float v = cvec[i]; silu[i] = v / (1.0f + __expf(-v)); }
        __syncthreads();
        for (int task = gw; task < (NMOD / 256) * KS_ADA; task += NGW) {
            const int cg = task % (NMOD / 256), ks = task / (NMOD / 256); const int k0 = ks * (DM / KS_ADA), n0 = cg * 256 + 4 * lane;
            f32x4 a0 = {0.f, 0.f, 0.f, 0.f}, a1 = {0.f, 0.f, 0.f, 0.f};
            const float* wp = w_ada + (size_t)k0 * NMOD + n0;
#pragma unroll 8
            for (int kk = 0; kk < DM / KS_ADA; ++kk) { const f32x4 w4 = *(const f32x4*)(wp + (size_t)kk * NMOD); const float s0 = silu[k0 + kk], s1 = silu[DM + k0 + kk]; a0 += w4 * s0; a1 += w4 * s1; }
            *(f32x4*)(MODP + ((size_t)(ks * 2 + 0)) * NMOD + n0) = a0; *(f32x4*)(MODP + ((size_t)(ks * 2 + 1)) * NMOD + n0) = a1;
        }
        __syncthreads();
        {
            LAS float* scr = (LAS float*)(lds + RING_OFF + wave * 16384);
            constexpr int I_QKV = (DM / 64) * (3 * ATTW / 32), I_PIN = (DM / 64) * (POOLW / 32), I_OUTH = (ATTW / 64) * (DM / 32);
            constexpr int NITEMS = I_QKV + I_PIN + 2 * I_OUTH;
            for (int it = gw; it < NITEMS; it += NGW) {
                int r = it;
                if (r < I_QKV) { p0_transpose_item<true>(w_in, INW, 3 * ATTW, WIN8, DM, W8SCALE, scr, r, lane); continue; } r -= I_QKV;
                if (r < I_PIN) { p0_transpose_item<false>(w_in + 3 * ATTW, INW, POOLW, WINT, DM, 1.f, scr, r, lane); continue; } r -= I_PIN;
                if (r < I_OUTH) { p0_transpose_item<true>(w_out, DM, DM, WOUT8, DM, WO8SCALE, scr, r, lane); continue; } r -= I_OUTH;
                p0_transpose_item<false>(w_out + (size_t)ATTW * DM, DM, DM, WOPT, POOLW, 1.f, scr, r, lane);
            }
        }
        for (int i = gw * 64 + lane; i < (DM * PQ + 4 * 512 * 512) / 8; i += NGW * 64) {
            const bool isQ = i < DM * PQ / 8; const int j = isQ ? i : i - DM * PQ / 8;
            const float* src = (isQ ? peer_wq : pool_w) + (size_t)j * 8;
            f32x4 a = *(const f32x4*)src, c = *(const f32x4*)(src + 4);
            if (!isQ) { const int e0 = j * 8; const int gi = e0 >> 18, d0 = e0 & 511; const float* ps = pool_scale + gi * 512 + d0; a = a * *(const f32x4*)ps; c = c * *(const f32x4*)(ps + 4); }
            v4u w; w.x = cvt_pk_bf16(a[0], a[1]); w.y = cvt_pk_bf16(a[2], a[3]); w.z = cvt_pk_bf16(c[0], c[1]); w.w = cvt_pk_bf16(c[2], c[3]);
            *(v4u*)((isQ ? WQB : PWS) + (size_t)j * 8) = w;
        }
        for (int r = gw; r < 2 * NEXP; r += NGW) {
            const bool isU = r < NEXP; const int e = isU ? r : r - NEXP;
            const float* src = (isU ? peer_u : peer_v) + (size_t)e * DM + 16 * lane;
            f32x4 v[4][4]; float mx = 0.f;
#pragma unroll
            for (int i = 0; i < 4; ++i)
#pragma unroll
                for (int q = 0; q < 4; ++q) { v[i][q] = *(const f32x4*)(src + 1024 * i + 4 * q);
                    mx = fmaxf(mx, fmaxf(fmaxf(fabsf(v[i][q][0]), fabsf(v[i][q][1])), fmaxf(fabsf(v[i][q][2]), fabsf(v[i][q][3])))); }
#pragma unroll
            for (int o = 1; o < 64; o <<= 1) mx = fmaxf(mx, __shfl_xor(mx, o));
            const int ex = (int)((__float_as_uint(mx) >> 23) & 0xffu);
            float scale = 1.0f, inv = 1.0f;
            if (ex >= 32 && ex <= 230) { scale = __uint_as_float((unsigned)(261 - ex) << 23); inv = __uint_as_float((unsigned)(ex - 7) << 23); }
            unsigned char* dst = (isU ? UB : VB) + ((size_t)(lane >> 3) * NEXP + e) * 128 + 16 * (lane & 7);
#pragma unroll
            for (int i = 0; i < 4; ++i) { v4u w;
#pragma unroll
                for (int q = 0; q < 4; ++q) { int pk = 0; pk = __builtin_amdgcn_cvt_pk_fp8_f32(v[i][q][0] * scale, v[i][q][1] * scale, pk, false);
                    pk = __builtin_amdgcn_cvt_pk_fp8_f32(v[i][q][2] * scale, v[i][q][3] * scale, pk, true); w[q] = (unsigned)pk; }
                *(v4u*)(dst + (size_t)(8 * i) * NEXP * 128) = w; }
            if (lane == 0) SCL[r] = inv;
        }
        for (int i = gw * 64 + lane; i < 2048 * 32; i += NGW * 64) {
            const int n = i >> 5, kc = (i & 31) * 8; const int p = (n >> 7) & 1, pp = kc >> 7;
            v4u w = {0u, 0u, 0u, 0u};
            if (p == pp) { const float* src = peer_sk + (size_t)n * 128 + (kc & 127); const f32x4 a = *(const f32x4*)src, c = *(const f32x4*)(src + 4);
                w.x = cvt_pk_bf16(a[0], a[1]); w.y = cvt_pk_bf16(a[2], a[3]); w.z = cvt_pk_bf16(c[0], c[1]); w.w = cvt_pk_bf16(c[2], c[3]); }
            *(v4u*)(SKT + (size_t)n * 256 + kc) = w;
        }
        if (BOTH(0)) GRID_BAR();
    }

    if (IN(1)) {
        PHASE_LANES();
        for (int i = bx * (NWAVES * 64) + tid; i < BATCH * NMOD; i += G * NWAVES * 64) {
            const int b = i / NMOD, n = i % NMOD; float s = b_ada[n];
#pragma unroll 8
            for (int ks = 0; ks < KS_ADA; ++ks) s += MODP[(size_t)(ks * 2 + b) * NMOD + n];
            const int j = n / DM, c = n % DM;
            MODV[(size_t)(j * 2 + b) * DM + c] = s;
        }
        if (bx < G / 2) {
            pg8::Gemm g{WOPT, PWS, DM, POOLW, 512, POOLW, 512, 2, 512, 1 << 30, 0}; pg8::StaticOrder S; S.init(DM, POOLW, G / 2, bx);
            pg8::EpiFp8 E{WOUT8, DM, ATTW, (A8SCALE * WO8SCALE) / P8SCALE};
            pg8::gemm_phase<pg8::EpiFp8, pg8::StaticOrder, true>(lds + RING_OFF, g, S, E);
        }
        else {
            pg8::Gemm g{SKT, WQB, PQ, DM, 256, 256, PQ, 1 << 30, 0, 1, 256}; pg8::StaticOrder S; S.init(PQ, DM, G - G / 2, bx - G / 2);
            pg8::EpiBf16 E{WQST, DM, 0, 1.0f, nullptr, 0, 0};
            pg8::gemm_phase<pg8::EpiBf16, pg8::StaticOrder, true>(lds + RING_OFF, g, S, E);
        }
        if (BOTH(1)) GRID_BAR();
    }

    if (IN(2)) {
        PHASE_LANES();
        for (int row = gw; row < M; row += NGW) {
            const int b = row / SEQ;
            const f32x4* xr = (const f32x4*)(x + (size_t)row * DM) + lane;
            f32x4 v[16]; float ss = 0.f;
#pragma unroll
            for (int j = 0; j < 16; ++j) { v[j] = xr[64 * j]; ss += (v[j][0] * v[j][0] + v[j][1] * v[j][1]) + (v[j][2] * v[j][2] + v[j][3] * v[j][3]); }
            const float rstd = 1.0f / sqrtf(wave_sum(ss) * (1.0f / DM) + RMS_EPS);
            const f32x4* gp = (const f32x4*)g_mix + lane; const f32x4* shp = (const f32x4*)(MODV + (size_t)(0 * 2 + b) * DM) + lane; const f32x4* scp = (const f32x4*)(MODV + (size_t)(1 * 2 + b) * DM) + lane;
            v2u* op = (v2u*)(H + (size_t)row * DM) + lane; unsigned* op8 = (unsigned*)(H8 + (size_t)row * DM) + lane;
#pragma unroll
            for (int j = 0; j < 16; ++j) { const f32x4 g4 = gp[64 * j], sh = shp[64 * j], sc = scp[64 * j];
                const f32x4 y = (v[j] * rstd) * g4 * (sc + 1.0f) + sh;
                v2u w; w.x = cvt_pk_bf16(y[0], y[1]); w.y = cvt_pk_bf16(y[2], y[3]); op[64 * j] = w;
                int p8 = 0; p8 = __builtin_amdgcn_cvt_pk_fp8_f32(y[0] * H8SCALE, y[1] * H8SCALE, p8, false); p8 = __builtin_amdgcn_cvt_pk_fp8_f32(y[2] * H8SCALE, y[3] * H8SCALE, p8, true); op8[64 * j] = (unsigned)p8; }
        }
        if (BOTH(2)) GRID_BAR();
    }

    if (IN(3)) {
        PHASE_LANES();
        {
            pg8::Gemm g{(const bf16*)H8, (const bf16*)WIN8, M, 3 * ATTW, DM / 2, DM / 2, DM / 2, 1 << 30, 0, 1 << 30, 0}; pg8::StaticOrder S; S.init(M, 3 * ATTW, G, bx);
            pg8::EpiBf16 E{PIN, POOLW, ATTW, QSCALE / (H8SCALE * W8SCALE), QKVH, 3 * ATTW, M, 1.0f / (H8SCALE * W8SCALE)};
            pg8::gemm_phase<pg8::EpiBf16, pg8::StaticOrder, true, true>(lds + RING_OFF, g, S, E);
        }
        {
            pg8::Gemm g{H, WINT, M, POOLW, DM, DM, DM, 1 << 30, 0, 1 << 30, 0}; pg8::StaticOrder S; S.init(M, POOLW, G, bx);
            pg8::EpiBf16 E{PIN, POOLW, 0, 1.0f, nullptr, 0, 0};
            pg8::gemm_phase<pg8::EpiBf16, pg8::StaticOrder, true>(lds + RING_OFF, g, S, E);
        }
        if (BOTH(3)) GRID_BAR();
    }

    if (IN(4)) {
        PHASE_LANES();
        LAS float* btab = (LAS float*)(lds + SHARED_OFF);
        LAS unsigned char* vt = lds + RING_OFF + wave * ATT_WAVE_BYTES;
        if (!(args.pad & 1u))
        for (int unit = bx; unit < BATCH * NH * (SEQ / 1024); unit += G) {
            const int b = unit >> 7, h = (unit >> 3) & 15, mt = unit & 7;
            __syncthreads();
            for (int i = tid; i < 3 * 256; i += NWAVES * 64) { const int gi = i >> 8, ri = (i & 255) - 32; const int dil = gi == 0 ? 1 : (gi == 1 ? 4 : 16);
                btab[i] = (ri >= 0 && ri <= 128) ? rel_bias[t5_bucket((ri - 64) * dil) * NH + h] * LOG2E : -1e30f; }
            __syncthreads();
            for (int g = 0; g < 3; ++g) {
                if (g == 2) { VM_WAIT(); __syncthreads(); }
                for (int tk = wave; tk < 32; tk += NWAVES) attn_task(g, QKVH, O0, O1, LSE, LSE + (size_t)M * NH, MIX8, btab, vt, b, h, mt, tk, lane);
            }
        }
        if (!(args.pad & 2u))
        for (int i = bx * (NWAVES * 64) + tid; i < BATCH * (SEQ / 8) * (POOLW / 8); i += G * NWAVES * 64) {
            const int cc = i & 255, run = (i >> 8) & (SEQ / 8 - 1), b = i >> 18; const int gi = __builtin_amdgcn_readfirstlane(cc >> 6);
            const int pos0 = run * 8;
            const bf16* base = PIN + (size_t)b * SEQ * POOLW + cc * 8;
            unsigned char* obase = MIX8 + ((size_t)b * SEQ + pos0) * DM + ATTW + cc * 8;
#define POOL_RUN(HW) do { constexpr int NR = 8 + 2 * (HW) - 1; v4u w_[NR]; \
                _Pragma("unroll") for (int q = 0; q < NR; ++q) { const int pp = pos0 - (HW) + q; const int pc = pp < 0 ? 0 : (pp > SEQ - 1 ? SEQ - 1 : pp); w_[q] = *(const v4u*)(base + (size_t)pc * POOLW); } \
                _Pragma("unroll") for (int q = 0; q < NR; ++q) { const int pp = pos0 - (HW) + q; if (pp < 0 || pp >= SEQ) w_[q] = (v4u){0u, 0u, 0u, 0u}; } \
                float s_[8] = {0.f, 0.f, 0.f, 0.f, 0.f, 0.f, 0.f, 0.f}; \
                _Pragma("unroll") for (int q = 0; q < 2 * (HW) - 1; ++q) { s_[0] += bf_lo(w_[q].x); s_[1] += bf_hi(w_[q].x); s_[2] += bf_lo(w_[q].y); s_[3] += bf_hi(w_[q].y); s_[4] += bf_lo(w_[q].z); s_[5] += bf_hi(w_[q].z); s_[6] += bf_lo(w_[q].w); s_[7] += bf_hi(w_[q].w); } \
                _Pragma("unroll") for (int k = 0; k < 8; ++k) { const v4u in_ = w_[k + 2 * (HW) - 1]; \
                    s_[0] += bf_lo(in_.x); s_[1] += bf_hi(in_.x); s_[2] += bf_lo(in_.y); s_[3] += bf_hi(in_.y); s_[4] += bf_lo(in_.z); s_[5] += bf_hi(in_.z); s_[6] += bf_lo(in_.w); s_[7] += bf_hi(in_.w); \
                    const int pos = pos0 + k; const int lo_ = pos - (HW) < 0 ? 0 : pos - (HW), hi_ = pos + (HW) > SEQ ? SEQ : pos + (HW); const float inv = 1.0f / (float)(hi_ - lo_); \
                    const v4u me = w_[k + (HW)]; int lo8_ = 0, hi8_ = 0; const float i8_ = inv * P8SCALE; \
                    lo8_ = __builtin_amdgcn_cvt_pk_fp8_f32(s_[0] * i8_ - bf_lo(me.x) * P8SCALE, s_[1] * i8_ - bf_hi(me.x) * P8SCALE, lo8_, false); lo8_ = __builtin_amdgcn_cvt_pk_fp8_f32(s_[2] * i8_ - bf_lo(me.y) * P8SCALE, s_[3] * i8_ - bf_hi(me.y) * P8SCALE, lo8_, true); \
                    hi8_ = __builtin_amdgcn_cvt_pk_fp8_f32(s_[4] * i8_ - bf_lo(me.z) * P8SCALE, s_[5] * i8_ - bf_hi(me.z) * P8SCALE, hi8_, false); hi8_ = __builtin_amdgcn_cvt_pk_fp8_f32(s_[6] * i8_ - bf_lo(me.w) * P8SCALE, s_[7] * i8_ - bf_hi(me.w) * P8SCALE, hi8_, true); \
                    *(v2u*)(obase + (size_t)k * DM) = (v2u){(unsigned)lo8_, (unsigned)hi8_}; \
                    const v4u out_ = w_[k]; \
                    s_[0] -= bf_lo(out_.x); s_[1] -= bf_hi(out_.x); s_[2] -= bf_lo(out_.y); s_[3] -= bf_hi(out_.y); s_[4] -= bf_lo(out_.z); s_[5] -= bf_hi(out_.z); s_[6] -= bf_lo(out_.w); s_[7] -= bf_hi(out_.w); } } while (0)
            if (gi == 0) POOL_RUN(1); else if (gi == 1) POOL_RUN(2); else if (gi == 2) POOL_RUN(4); else POOL_RUN(8);
#undef POOL_RUN
        }
        if (BOTH(4)) GRID_BAR();
    }

    if (IN(5)) {
        PHASE_LANES();
        pg8::Gemm g{(const bf16*)MIX8, (const bf16*)WOUT8, M, DM, DM / 2, DM / 2, DM / 2, 1 << 30, 0, 1 << 30, 0}; pg8::StaticOrder S; S.init(M, DM, G, bx);
        pg8::EpiResBf16 E{x, MODV + (size_t)(2 * 2) * DM, X1B, DM, 1.0f / (A8SCALE * WO8SCALE)};
        pg8::gemm_phase<pg8::EpiResBf16, pg8::StaticOrder, true, true>(lds + RING_OFF, g, S, E);
        if (BOTH(5)) GRID_BAR();
    }

    if (IN(6)) {
        PHASE_LANES();
        for (int row = gw; row < M; row += NGW) {
            const int b = row / SEQ;
            const v2u* xr = (const v2u*)(X1B + (size_t)row * DM) + lane;
            f32x4 v[16]; float ss = 0.f;
#pragma unroll
            for (int j = 0; j < 16; ++j) { const v2u xw = xr[64 * j]; v[j] = (f32x4){bf_lo(xw.x), bf_hi(xw.x), bf_lo(xw.y), bf_hi(xw.y)}; ss += (v[j][0] * v[j][0] + v[j][1] * v[j][1]) + (v[j][2] * v[j][2] + v[j][3] * v[j][3]); }
            const float rstd = 1.0f / sqrtf(wave_sum(ss) * (1.0f / DM) + RMS_EPS);
            const f32x4* gp = (const f32x4*)g_ffn + lane; const f32x4* shp = (const f32x4*)(MODV + (size_t)(3 * 2 + b) * DM) + lane; const f32x4* scp = (const f32x4*)(MODV + (size_t)(4 * 2 + b) * DM) + lane;
            v2u* op = (v2u*)(H + (size_t)row * DM) + lane;
#pragma unroll
            for (int j = 0; j < 16; ++j) { const f32x4 g4 = gp[64 * j], sh = shp[64 * j], sc = scp[64 * j];
                const f32x4 y = (v[j] * rstd) * g4 * (sc + 1.0f) + sh;
                v2u w; w.x = cvt_pk_bf16(y[0], y[1]); w.y = cvt_pk_bf16(y[2], y[3]); op[64 * j] = w; }
        }
        if (BOTH(6)) GRID_BAR();
    }

    if (IN(7)) {
        PHASE_LANES();
        pg8::Gemm g{H, WQST, M, PQ, DM, DM, DM, 1 << 30, 0, 1 << 30, 0}; pg8::StaticOrder S; S.init(M, PQ, G, bx);
        pg8::EpiF32 E{SC, PQ};
        pg8::gemm_phase<pg8::EpiF32, pg8::StaticOrder, true>(lds + RING_OFF, g, S, E);
        if (BOTH(7)) GRID_BAR();
    }

    if (IN(8)) {
        PHASE_LANES();
        LAS unsigned short* EXPW = (LAS unsigned short*)(lds + RING_OFF);
        LAS float* GACT = (LAS float*)(lds + RING_OFF + 16384);
        LAS unsigned* W = (LAS unsigned*)(lds + RING_OFF + 49152 + wave * 4096);
        LAS unsigned* K1 = W; LAS unsigned* K2 = W + 128;
        LAS float* TV1 = (LAS float*)(W + 256); LAS int* TI1 = (LAS int*)(W + 272); LAS float* TV2 = (LAS float*)(W + 288); LAS int* TI2 = (LAS int*)(W + 304);
        LAS unsigned* CK = W + 320; LAS float* SV = (LAS float*)(W + 384); LAS int* SE = (LAS int*)(W + 400);
        const int c8 = lane & 7, r8 = lane >> 3;
        for (int blk = vcu; blk < M / 64; blk += G) {
            const int tok0 = blk * 64; const int b = tok0 / SEQ;
            for (int j = 0; j < 8; ++j) {
                const int tl = wave * 8 + j; const int t = tok0 + tl;
#ifndef TOPK_REP
#define TOPK_REP 1
#endif
                for (int hh = 0; hh < 8 * TOPK_REP; ++hh) { const int h = hh & 7;
                    const float* sp = SC + (size_t)t * PQ + h * 256;
                    const float a0 = sp[lane], a1 = sp[64 + lane], b0 = sp[128 + lane], b1 = sp[192 + lane];
                    unsigned ka0 = (fkey(a0) & ~127u) | (unsigned)(127 - lane), ka1 = (fkey(a1) & ~127u) | (unsigned)(63 - lane);
                    unsigned kb0 = (fkey(b0) & ~127u) | (unsigned)(127 - lane), kb1 = (fkey(b1) & ~127u) | (unsigned)(63 - lane);
                    bitonic128x2(ka0, ka1, kb0, kb1, lane);
                    if (lane >= 56) { K1[127 - 2 * lane] = ka0; K1[126 - 2 * lane] = ka1; K2[127 - 2 * lane] = kb0; K2[126 - 2 * lane] = kb1; }
                    LDS_WAIT();
                    const int ci_i = CAND_I[lane], ci_j = CAND_J[lane];
                    const unsigned kA = K1[ci_i], kB = K2[ci_j];
                    const float cv = fdec(kA) + fdec(kB);
                    const unsigned ck = lane < 50 ? ((fkey(cv) & ~255u) | (unsigned)(255 - (ci_i * 16 + ci_j))) : 0u;
                    CK[lane] = ck;
                    LDS_WAIT();
                    int rc = 0;
#pragma unroll 8
                    for (int kk = 0; kk < 16; ++kk) { const v4u q = ((const LAS v4u*)CK)[kk]; rc += (q.x > ck) + (q.y > ck) + (q.z > ck) + (q.w > ck); }
                    if (lane < 50 && rc < 16) { SV[rc] = cv; SE[rc] = (int)((127u - (kA & 127u)) * 128u + (127u - (kB & 127u))); }
                    LDS_WAIT();
                    const float top0 = SV[0], myv = SV[lane & 15]; const int mye = SE[lane & 15];
                    const float e = __expf(myv - top0);
                    float ssum = e; ssum += __shfl_xor(ssum, 1); ssum += __shfl_xor(ssum, 2); ssum += __shfl_xor(ssum, 4); ssum += __shfl_xor(ssum, 8);
                    if (lane < 16) { EXPW[tl * 128 + h * 16 + lane] = (unsigned short)mye; GACT[tl * 128 + h * 16 + lane] = e / ssum; }
                    LDS_WAIT();
                }
            }
            LAS float* ACC = (LAS float*)(lds + RING_OFF + 81920);
            for (int i = lane; i < 8 * 128; i += 64) ACC[wave * 1024 + i] = 0.f;
            LDS_WAIT();
            {
                v4u gn[16]; v4u hna, hnb;
#define P10_LOADU(idx) do { const int s_ = (idx) >> 3, j_ = (idx) & 7; const int tl_ = wave * 8 + j_; \
                    const unsigned char* tb_ = UB + (size_t)s_ * NEXP * 128 + 16 * c8; \
                    const v4u* hp_ = (const v4u*)(H + (size_t)(tok0 + tl_) * DM + 128 * s_ + 16 * c8); hna = hp_[0]; hnb = hp_[1]; \
                    _Pragma("unroll") for (int i = 0; i < 16; ++i) { const unsigned e_ = EXPW[tl_ * 128 + r8 + 8 * i]; gn[i] = *(const v4u*)(tb_ + (size_t)e_ * 128); } } while (0)
                P10_LOADU(0);
#pragma unroll 1
                for (int idx = 0; idx < 256; ++idx) {
                    v4u g[16]; const v4u ha = hna, hb = hnb;
#pragma unroll
                    for (int i = 0; i < 16; ++i) g[i] = gn[i];
                    if (idx + 1 < 256) P10_LOADU(idx + 1);
                    const int tl = wave * 8 + (idx & 7);
                    f32x2 hs[8];
                    hs[0] = (f32x2){bf_lo(ha.x), bf_hi(ha.x)}; hs[1] = (f32x2){bf_lo(ha.y), bf_hi(ha.y)}; hs[2] = (f32x2){bf_lo(ha.z), bf_hi(ha.z)}; hs[3] = (f32x2){bf_lo(ha.w), bf_hi(ha.w)};
                    hs[4] = (f32x2){bf_lo(hb.x), bf_hi(hb.x)}; hs[5] = (f32x2){bf_lo(hb.y), bf_hi(hb.y)}; hs[6] = (f32x2){bf_lo(hb.z), bf_hi(hb.z)}; hs[7] = (f32x2){bf_lo(hb.w), bf_hi(hb.w)};
                    float p[16];
#pragma unroll
                    for (int i = 0; i < 16; ++i) { f32x2 a2 = {0.f, 0.f};
#pragma unroll
                        for (int q = 0; q < 4; ++q) { a2 += __builtin_amdgcn_cvt_pk_f32_fp8((int)g[i][q], false) * hs[2 * q]; a2 += __builtin_amdgcn_cvt_pk_f32_fp8((int)g[i][q], true) * hs[2 * q + 1]; }
                        p[i] = a2.x + a2.y; }
                    float q8[8], q4[4], q2[2];
#pragma unroll
                    for (int m = 0; m < 8; ++m) { const float snd = (c8 & 4) ? p[m] : p[m + 8], kp = (c8 & 4) ? p[m + 8] : p[m]; q8[m] = kp + __shfl_xor(snd, 4); }
#pragma unroll
                    for (int m = 0; m < 4; ++m) { const float snd = (c8 & 2) ? q8[m] : q8[m + 4], kp = (c8 & 2) ? q8[m + 4] : q8[m]; q4[m] = kp + __shfl_xor(snd, 2); }
#pragma unroll
                    for (int m = 0; m < 2; ++m) { const float snd = (c8 & 1) ? q4[m] : q4[m + 2], kp = (c8 & 1) ? q4[m + 2] : q4[m]; q2[m] = kp + __shfl_xor(snd, 1); }
                    LAS float* ap = ACC + tl * 128 + r8 + 16 * c8;
                    ap[0] += q2[0]; ap[8] += q2[1];
                }
#undef P10_LOADU
            }
            LDS_WAIT();
            for (int i = lane; i < 8 * 128; i += 64) { const int o_ = wave * 1024 + i; const unsigned e = EXPW[o_];
                const float a = ACC[o_] * SCL[e]; GACT[o_] = gelu_tanh(a) * GACT[o_] * SCL[NEXP + e]; }
            LDS_WAIT();
            LAS float* SSQ = ACC;
            for (int j = 0; j < 8; ++j) SSQ[(wave * 8 + j) * 128 + lane] = 0.f;
            LDS_WAIT();
            const float* gtp = MODV + (size_t)(5 * 2 + b) * DM;
            {
                v4u gn[16]; float avn[16];
#define P10_LOADV(idx) do { const int s_ = (idx) >> 3, j_ = (idx) & 7; const int tl_ = wave * 8 + j_; \
                    const unsigned char* tb_ = VB + (size_t)s_ * NEXP * 128 + 16 * c8; \
                    _Pragma("unroll") for (int i = 0; i < 16; ++i) { const int k_ = tl_ * 128 + r8 + 8 * i; const unsigned e_ = EXPW[k_]; avn[i] = GACT[k_]; gn[i] = *(const v4u*)(tb_ + (size_t)e_ * 128); } } while (0)
                P10_LOADV(0);
#pragma unroll 1
                for (int idx = 0; idx < 256; ++idx) {
                    v4u g[16]; float av[16];
#pragma unroll
                    for (int i = 0; i < 16; ++i) { g[i] = gn[i]; av[i] = avn[i]; }
                    if (idx + 1 < 256) P10_LOADV(idx + 1);
                    const int s_c = idx >> 3; const int tl = wave * 8 + (idx & 7); const int t = tok0 + tl;
                    const int d = 128 * s_c + 16 * c8 + 2 * r8;
                    const unsigned xw = __builtin_nontemporal_load((const unsigned*)(X1B + (size_t)t * DM + d)); const f32x2 gv = *(const f32x2*)(gtp + d);
                    const float ssq_old = SSQ[tl * 128 + lane];
                    f32x2 o8[8];
#pragma unroll
                    for (int q = 0; q < 8; ++q) o8[q] = (f32x2){0.f, 0.f};
#pragma unroll
                    for (int i = 0; i < 16; ++i)
#pragma unroll
                        for (int q = 0; q < 4; ++q) { o8[2 * q] += __builtin_amdgcn_cvt_pk_f32_fp8((int)g[i][q], false) * av[i]; o8[2 * q + 1] += __builtin_amdgcn_cvt_pk_f32_fp8((int)g[i][q], true) * av[i]; }
                    float p[16], q8[8], q4[4], q2[2];
#pragma unroll
                    for (int q = 0; q < 8; ++q) { p[2 * q] = o8[q].x; p[2 * q + 1] = o8[q].y; }
#pragma unroll
                    for (int m = 0; m < 8; ++m) { const float snd = (r8 & 4) ? p[m] : p[m + 8], kp = (r8 & 4) ? p[m + 8] : p[m]; q8[m] = kp + __shfl_xor(snd, 32); }
#pragma unroll
                    for (int m = 0; m < 4; ++m) { const float snd = (r8 & 2) ? q8[m] : q8[m + 4], kp = (r8 & 2) ? q8[m + 4] : q8[m]; q4[m] = kp + __shfl_xor(snd, 16); }
#pragma unroll
                    for (int m = 0; m < 2; ++m) { const float snd = (r8 & 1) ? q4[m] : q4[m + 2], kp = (r8 & 1) ? q4[m + 2] : q4[m]; q2[m] = kp + __shfl_xor(snd, 8); }
                    f32x2 y; y.x = bf_lo(xw) + gv.x * q2[0]; y.y = bf_hi(xw) + gv.y * q2[1];
                    __builtin_nontemporal_store(cvt_pk_bf16(y.x, y.y), (unsigned*)(YB + (size_t)t * DM + d));
                    SSQ[tl * 128 + lane] = ssq_old + (y.x * y.x + y.y * y.y);
                }
#undef P10_LOADV
            }
            VM_WAIT(); LDS_WAIT();
            __builtin_amdgcn_fence(__ATOMIC_ACQUIRE, "agent");
            VM_WAIT();
            for (int j = 0; j < 8; ++j) {
                const int tl = wave * 8 + j; const int t = tok0 + tl;
                const float rstd = 1.0f / sqrtf(wave_sum(SSQ[tl * 128 + lane]) * (1.0f / DM) + RMS_EPS);
                f32x4* op = (f32x4*)(out + (size_t)t * DM) + lane; const f32x4* gp = (const f32x4*)g_final + lane; const v2u* yp = (const v2u*)(YB + (size_t)t * DM) + lane;
#pragma unroll 4
                for (int i = 0; i < 16; ++i) { const v2u yw = __builtin_nontemporal_load(yp + 64 * i); const f32x4 y = {bf_lo(yw.x), bf_hi(yw.x), bf_lo(yw.y), bf_hi(yw.y)}; __builtin_nontemporal_store(y * rstd * gp[64 * i], op + 64 * i); }
            }
            LDS_WAIT();
        }
    }
#undef IN
#undef BOTH
#undef GRID_BAR
}

extern "C" void kernel_launch(void* const* d_in, const int* in_sizes, int n_in, void* d_out, int out_size, void* d_ws, size_t ws_size, hipStream_t stream) {
    static int grid = 0;
    if (grid == 0) {
        if (n_in != 16 || in_sizes[0] != M * DM || out_size != M * DM || ws_size < WS_END) {
            fprintf(stderr, "kernel_launch: shape/workspace mismatch: n_in %d in0 %d out %d ws %zu (need %zu)\n", n_in, n_in > 0 ? in_sizes[0] : -1, out_size, ws_size, (size_t)WS_END); grid = -1; return; }
        int dev = 0, cus = 0, per_cu = 0;
        if (hipGetDevice(&dev) != hipSuccess || hipDeviceGetAttribute(&cus, hipDeviceAttributeMultiprocessorCount, dev) != hipSuccess) { grid = -1; return; }
        if (hipFuncSetAttribute((const void*)fwd_kernel, hipFuncAttributeMaxDynamicSharedMemorySize, LDS_BYTES) != hipSuccess) { fprintf(stderr, "kernel_launch: hipFuncSetAttribute failed\n"); grid = -1; return; }
        if (hipOccupancyMaxActiveBlocksPerMultiprocessor(&per_cu, (const void*)fwd_kernel, NWAVES * 64, LDS_BYTES) != hipSuccess || per_cu < 1)
            fprintf(stderr, "kernel_launch: note: occupancy query reports %d workgroups per CU\n", per_cu);
        (void)hipGetLastError();
        grid = cus;
    }
    if (grid < 0) return;
    if (hipMemsetAsync((char*)d_ws + WS_CTL, 0, CTL_ZERO_BYTES, stream) != hipSuccess) { fprintf(stderr, "kernel_launch: memset failed\n"); return; }
    Args a{};
    for (int i = 0; i < 16; ++i) a.in[i] = (const float*)d_in[i];
    a.out = (float*)d_out; a.ws = (unsigned char*)d_ws;
#ifdef PROBE_MASK
    {
#ifndef PROBE_PAD
#define PROBE_PAD 0
#endif
        a.mask = PROBE_MASK; a.pad = PROBE_PAD;
        hipLaunchKernelGGL(fwd_kernel, dim3(grid), dim3(NWAVES * 64), LDS_BYTES, stream, a);
        (void)hipMemsetAsync((char*)d_ws + WS_CTL, 0, CTL_ZERO_BYTES, stream);
    }
#endif
    for (int li = 0; li < MK_N_LAUNCHES; ++li) {
        a.mask = (MK_N_LAUNCHES == PER_PHASE) ? (1u << li) : ((1u << PER_PHASE) - 1u); a.pad = 0;
        hipLaunchKernelGGL(fwd_kernel, dim3(grid), dim3(NWAVES * 64), LDS_BYTES, stream, a);
        const hipError_t le = hipPeekAtLastError();
        if (le != hipSuccess) { fprintf(stderr, "kernel_launch: launch %d failed: %s\n", li, hipGetErrorName(le)); break; }
    }
}
```

```cpp
#include <hip/hip_runtime.h>
#include <cstdio>
#include <cstdint>

#ifndef MK_N_LAUNCHES
#define MK_N_LAUNCHES 1
#endif

#define GAS __attribute__((address_space(1)))
#define LAS __attribute__((address_space(3)))
typedef unsigned short bf16;
typedef unsigned v4u __attribute__((ext_vector_type(4)));
typedef unsigned v2u __attribute__((ext_vector_type(2)));
typedef float f32x4 __attribute__((ext_vector_type(4)));
typedef float f32x2 __attribute__((ext_vector_type(2)));
typedef float f32x16 __attribute__((ext_vector_type(16)));
typedef short bf16x8 __attribute__((ext_vector_type(8)));
typedef short s16x4 __attribute__((ext_vector_type(4)));
typedef __bf16 bf2_t __attribute__((ext_vector_type(2)));

constexpr int BATCH = 2, SEQ = 8192, DM = 4096, M = BATCH * SEQ;
constexpr int NH = 16, HD = 128, ATTW = 2048, POOLW = 2048, INW = 8192;
constexpr int NMOD = 6 * DM;
constexpr int PQ = 2048;
constexpr int NEXP = 16384;
constexpr float RMS_EPS = 1e-6f;
constexpr float LOG2E = 1.4426950408889634f;
constexpr float QSCALE = 0.08838834764831845f * LOG2E;
constexpr float H8SCALE = 16.f, W8SCALE = 64.f;
constexpr float A8SCALE = 64.f, P8SCALE = 16.f, WO8SCALE = 64.f;
constexpr int KS_ADA = 64;

constexpr size_t MiB = 1u << 20;
constexpr size_t WS_CTL = 0, CTL_ZERO_BYTES = 1 * MiB;
constexpr size_t WS_MODV = 1 * MiB;
constexpr size_t WS_SCL = 2 * MiB;
constexpr size_t WS_MODP = 4 * MiB;
constexpr size_t WS_SKT = 20 * MiB;
constexpr size_t WS_PWS = 22 * MiB;
constexpr size_t WS_WQST = 24 * MiB;
constexpr size_t WS_WOUT2 = 40 * MiB;
constexpr size_t WS_WINT = 72 * MiB;
constexpr size_t WS_WIN8 = 88 * MiB;
constexpr size_t WS_H8 = 1100 * MiB;
constexpr size_t WS_UB = 136 * MiB;
constexpr size_t WS_VB = 264 * MiB;
constexpr size_t WS_H = 392 * MiB;
constexpr size_t WS_PROJ = 520 * MiB;
constexpr size_t WS_QKVH = 1292 * MiB;
constexpr size_t WS_MIXIN = 776 * MiB;
constexpr size_t WS_WOPT = 904 * MiB;
constexpr size_t WS_WQB = 936 * MiB;
constexpr size_t WS_O0 = 968 * MiB, WS_O1 = 1032 * MiB;
constexpr size_t WS_LSE = 1096 * MiB;
constexpr size_t WS_SC = 1164 * MiB;
constexpr size_t WS_END = 1484 * MiB;

constexpr int RING_OFF = 0, RING_BYTES = 131072;
constexpr int ATT_WAVE_BYTES = 17408;
constexpr int SHARED_OFF = 139264;
constexpr int LDSCTL_OFF = 139264 + 4096, MISC_OFF = LDSCTL_OFF + 320;
constexpr int LDS_BYTES = 147456;
constexpr int NWAVES = 8;
constexpr int CW_BAR = 4096;

#define LDS_WAIT() asm volatile("s_waitcnt lgkmcnt(0)" ::: "memory")
#define VM_WAIT() asm volatile("s_waitcnt vmcnt(0)" ::: "memory")

__device__ __forceinline__ unsigned cvt_pk_bf16(float lo, float hi) { unsigned r; asm volatile("v_cvt_pk_bf16_f32 %0, %1, %2" : "=v"(r) : "v"(lo), "v"(hi)); return r; }
__device__ __forceinline__ float bf_lo(unsigned u) { return __uint_as_float(u << 16); }
__device__ __forceinline__ float bf_hi(unsigned u) { return __uint_as_float(u & 0xffff0000u); }
__device__ __forceinline__ float wave_sum(float v) {
#pragma unroll
    for (int o = 1; o < 64; o <<= 1) v += __shfl_xor(v, o);
    return v;
}

namespace pg8 {
typedef unsigned short bf16_t;
typedef int v4i_t __attribute__((ext_vector_type(4)));
typedef int v8i_t __attribute__((ext_vector_type(8)));
constexpr int BM = 256, BK = 64, HALF = 128, HTB = HALF * BK * 2, STAGE_BYTES = 8 * HTB, NXCD = 8, WGM = 8;

__host__ __device__ __forceinline__ int lds_byte(int r, int c) { const int st = (r >> 4) * 2 + (c >> 5), rr = r & 15, cc = c & 31, ob = rr * 64 + cc * 2; return st * 1024 + (ob ^ (((ob >> 9) & 1) << 5)); }
__host__ __device__ __forceinline__ void stage_rc(int b, int& R, int& C) { const int st = b / 1024, sb = b % 1024, swz = sb ^ (((sb >> 9) & 1) << 5); R = (st >> 1) * 16 + swz / 64; C = (st & 1) * 32 + (swz % 64) / 2; }
__host__ __device__ __forceinline__ int perm32(int rho) { const int n = rho >> 4, i = rho & 15; return 8 * (i >> 2) + 4 * n + (i & 3); }

template <int NF> __device__ __forceinline__ void pg8_ldfrag16(bf16x8 (&dst)[NF][2], const LAS unsigned char* base, int off) {
#pragma unroll
    for (int m = 0; m < NF; ++m)
#pragma unroll
        for (int k = 0; k < 2; ++k) dst[m][k] = *(const LAS bf16x8*)(base + off + m * 2048 + k * 1024);
}
template <int NF> __device__ __forceinline__ void pg8_ldfrag8(v8i_t (&dst)[NF], const LAS unsigned char* base, int off1, int off2) {
#pragma unroll
    for (int m = 0; m < NF; ++m) { const v4i_t lo = *(const LAS v4i_t*)(base + off1 + m * 2048), hi = *(const LAS v4i_t*)(base + off2 + m * 2048); dst[m] = __builtin_shufflevector(lo, hi, 0, 1, 2, 3, 4, 5, 6, 7); }
}
__device__ __forceinline__ void pg8_mma16(f32x4 (&acc)[4][2], const bf16x8 (&At)[4][2], const bf16x8 (&Bt)[2][2]) {
#pragma unroll
    for (int m = 0; m < 4; ++m)
#pragma unroll
        for (int n = 0; n < 2; ++n)
#pragma unroll
            for (int k = 0; k < 2; ++k) acc[m][n] = __builtin_amdgcn_mfma_f32_16x16x32_bf16(Bt[n][k], At[m][k], acc[m][n], 0, 0, 0);
}
__device__ __forceinline__ void pg8_mma8(f32x4 (&acc)[4][2], const v8i_t (&At)[4], const v8i_t (&Bt)[2]) {
    int sc = 0x7F7F7F7F;
#pragma unroll
    for (int m = 0; m < 4; ++m)
#pragma unroll
        for (int n = 0; n < 2; ++n) asm volatile("v_mfma_scale_f32_16x16x128_f8f6f4 %0, %1, %2, %0, %3, %3 op_sel_hi:[0,0,0]" : "+v"(acc[m][n]) : "v"(Bt[n]), "v"(At[m]), "v"(sc));
}
struct Unit { int pm, pn; };
struct Gemm { const bf16_t* A; const bf16_t* Bt; int M, N, K, lda, ldb, agrp_div, agrp_cols, bgrp_div, bgrp_cols; };

struct StaticOrder {
    int nM, nN, nwg, G, c;
    __host__ __device__ void init(int M_, int N_, int G_, int c_) { nM = M_ / BM; nN = N_ / BM; nwg = nM * nN; G = G_; c = c_; }
    __host__ __device__ bool next(int i, Unit& u) const {
        const long L = (long)i * G + c; if (L >= nwg) return false;
        int wgid = (int)L; { const int q = nwg / NXCD, r = nwg % NXCD, xcd = wgid % NXCD, off = wgid / NXCD; wgid = (xcd < r ? xcd * (q + 1) : r * (q + 1) + (xcd - r) * q) + off; }
        const int nig = WGM * nN, gid = wgid / nig, fm = gid * WGM, gsz = (nM - fm) < WGM ? (nM - fm) : WGM;
        u.pm = fm + ((wgid % nig) % gsz); u.pn = (wgid % nig) / gsz; return true;
    }
    __device__ __forceinline__ void a_ready(const Unit&) const {}
    __device__ __forceinline__ void done(const Unit&) const {}
};

struct EpiBf16 {
    static constexpr bool PERM = true, AFTER_DRAIN = false;
    bf16_t* O; int ldc; int scale_cols; float scale0; bf16_t* HM; int hm_cols; int hm_rows; float scale1 = 1.0f;
    __device__ __forceinline__ void operator()(const f32x4 (&acc)[2][2][4][2], const Unit& u, int wr, int wc, int fr, int fq) const {
        const int row0 = u.pm * BM + wr * 64 + fr; const int colt = u.pn * BM;
        const float sc = (colt < scale_cols) ? scale0 : scale1;
        const bool hm = colt < hm_cols;
        const int cw = wc * 32 + 8 * fq;
        bf16_t* base = hm ? HM + (size_t)(colt / HALF) * hm_rows * HALF + cw : O + (colt - hm_cols) + cw;
        const size_t rpitch = hm ? (size_t)HALF : (size_t)ldc, hstep = hm ? (size_t)hm_rows * HALF : (size_t)HALF;
#pragma unroll
        for (int ai = 0; ai < 2; ++ai)
#pragma unroll
            for (int m = 0; m < 4; ++m) { bf16_t* rowp = base + (size_t)(row0 + ai * HALF + m * 16) * rpitch;
#pragma unroll
                for (int bj = 0; bj < 2; ++bj) { f32x4 v0 = acc[ai][bj][m][0] * sc, v1 = acc[ai][bj][m][1] * sc;
                    v4u w; w.x = cvt_pk_bf16(v0[0], v0[1]); w.y = cvt_pk_bf16(v0[2], v0[3]); w.z = cvt_pk_bf16(v1[0], v1[1]); w.w = cvt_pk_bf16(v1[2], v1[3]);
                    *(v4u*)(rowp + bj * hstep) = w; } }
    }
};
struct EpiBf16ColScale {
    static constexpr bool PERM = true, AFTER_DRAIN = false;
    bf16_t* O; int ldc; int coff; const float* cs;
    __device__ __forceinline__ void operator()(const f32x4 (&acc)[2][2][4][2], const Unit& u, int wr, int wc, int fr, int fq) const {
        const int row0 = u.pm * BM + wr * 64 + fr; const int col0 = u.pn * BM + wc * 32 + 8 * fq;
        f32x4 sv[2][2];
#pragma unroll
        for (int bj = 0; bj < 2; ++bj)
#pragma unroll
            for (int n = 0; n < 2; ++n) sv[bj][n] = *(const f32x4*)(cs + col0 + bj * HALF + 4 * n);
#pragma unroll
        for (int ai = 0; ai < 2; ++ai)
#pragma unroll
            for (int m = 0; m < 4; ++m) { bf16_t* rowp = O + (size_t)(row0 + ai * HALF + m * 16) * ldc + coff + col0;
#pragma unroll
                for (int bj = 0; bj < 2; ++bj) { f32x4 v0 = acc[ai][bj][m][0] * sv[bj][0], v1 = acc[ai][bj][m][1] * sv[bj][1];
                    v4u w; w.x = cvt_pk_bf16(v0[0], v0[1]); w.y = cvt_pk_bf16(v0[2], v0[3]); w.z = cvt_pk_bf16(v1[0], v1[1]); w.w = cvt_pk_bf16(v1[2], v1[3]);
                    *(v4u*)(rowp + bj * HALF) = w; } }
    }
};
struct EpiFp8 {
    static constexpr bool PERM = true, AFTER_DRAIN = false;
    unsigned char* O; int ldc; int coff; float scale;
    __device__ __forceinline__ void operator()(const f32x4 (&acc)[2][2][4][2], const Unit& u, int wr, int wc, int fr, int fq) const {
        const int row0 = u.pm * BM + wr * 64 + fr; const int col0 = u.pn * BM + wc * 32 + 8 * fq;
#pragma unroll
        for (int ai = 0; ai < 2; ++ai)
#pragma unroll
            for (int m = 0; m < 4; ++m) { unsigned char* rowp = O + (size_t)(row0 + ai * HALF + m * 16) * ldc + coff + col0;
#pragma unroll
                for (int bj = 0; bj < 2; ++bj) { const f32x4 v0 = acc[ai][bj][m][0] * scale, v1 = acc[ai][bj][m][1] * scale; int lo = 0, hi = 0;
                    lo = __builtin_amdgcn_cvt_pk_fp8_f32(v0[0], v0[1], lo, false); lo = __builtin_amdgcn_cvt_pk_fp8_f32(v0[2], v0[3], lo, true);
                    hi = __builtin_amdgcn_cvt_pk_fp8_f32(v1[0], v1[1], hi, false); hi = __builtin_amdgcn_cvt_pk_fp8_f32(v1[2], v1[3], hi, true);
                    *(v2u*)(rowp + bj * HALF) = (v2u){(unsigned)lo, (unsigned)hi}; } }
    }
};
struct EpiResBf16 {
    static constexpr bool PERM = true, AFTER_DRAIN = false;
    const float* X; const float* gate; bf16_t* O; int ldc; float ascale;
    __device__ __forceinline__ void operator()(const f32x4 (&acc)[2][2][4][2], const Unit& u, int wr, int wc, int fr, int fq) const {
        const int row0 = u.pm * BM + wr * 64 + fr; const int col0 = u.pn * BM + wc * 32 + 8 * fq; const int b = (u.pm * BM) / SEQ;
        f32x4 gv[2][2];
#pragma unroll
        for (int bj = 0; bj < 2; ++bj)
#pragma unroll
            for (int n = 0; n < 2; ++n) gv[bj][n] = *(const f32x4*)(gate + (size_t)b * DM + col0 + bj * HALF + 4 * n) * ascale;
#pragma unroll
        for (int ai = 0; ai < 2; ++ai)
#pragma unroll
            for (int m = 0; m < 4; ++m) { const size_t off = (size_t)(row0 + ai * HALF + m * 16) * ldc + col0;
#pragma unroll
                for (int bj = 0; bj < 2; ++bj) { const f32x4 x0 = *(const f32x4*)(X + off + bj * HALF), x1 = *(const f32x4*)(X + off + bj * HALF + 4);
                    const f32x4 v0 = x0 + gv[bj][0] * acc[ai][bj][m][0], v1 = x1 + gv[bj][1] * acc[ai][bj][m][1];
                    v4u w; w.x = cvt_pk_bf16(v0[0], v0[1]); w.y = cvt_pk_bf16(v0[2], v0[3]); w.z = cvt_pk_bf16(v1[0], v1[1]); w.w = cvt_pk_bf16(v1[2], v1[3]);
                    *(v4u*)(O + off + bj * HALF) = w; } }
    }
};
struct EpiResF32 {
    static constexpr bool PERM = false, AFTER_DRAIN = false;
    const float* X; const float* gate; float* O; int ldc;
    __device__ __forceinline__ void operator()(const f32x4 (&acc)[2][2][4][2], const Unit& u, int wr, int wc, int fr, int fq) const {
        const int row0 = u.pm * BM + wr * 64 + fr; const int col0 = u.pn * BM + wc * 32 + 4 * fq; const int b = (u.pm * BM) / SEQ;
        f32x4 gv[2][2];
#pragma unroll
        for (int bj = 0; bj < 2; ++bj)
#pragma unroll
            for (int n = 0; n < 2; ++n) gv[bj][n] = *(const f32x4*)(gate + (size_t)b * DM + col0 + bj * HALF + n * 16);
#pragma unroll
        for (int ai = 0; ai < 2; ++ai)
#pragma unroll
            for (int m = 0; m < 4; ++m) { const size_t off = (size_t)(row0 + ai * HALF + m * 16) * ldc + col0;
#pragma unroll
                for (int bj = 0; bj < 2; ++bj)
#pragma unroll
                    for (int n = 0; n < 2; ++n) { const f32x4 xv = *(const f32x4*)(X + off + bj * HALF + n * 16);
                        *(f32x4*)(O + off + bj * HALF + n * 16) = xv + gv[bj][n] * acc[ai][bj][m][n]; } }
    }
};
struct EpiF32 {
    static constexpr bool PERM = false, AFTER_DRAIN = false;
    float* O; int ldc;
    __device__ __forceinline__ void operator()(const f32x4 (&acc)[2][2][4][2], const Unit& u, int wr, int wc, int fr, int fq) const {
        const int row0 = u.pm * BM + wr * 64 + fr; const int col0 = u.pn * BM + wc * 32 + 4 * fq;
#pragma unroll
        for (int ai = 0; ai < 2; ++ai)
#pragma unroll
            for (int m = 0; m < 4; ++m) { const size_t off = (size_t)(row0 + ai * HALF + m * 16) * ldc + col0;
#pragma unroll
                for (int bj = 0; bj < 2; ++bj)
#pragma unroll
                    for (int n = 0; n < 2; ++n) *(f32x4*)(O + off + bj * HALF + n * 16) = acc[ai][bj][m][n]; }
    }
};

template <class Epi, class Sched, bool ALIGN_EPI, bool FP8 = false>
__device__ __forceinline__ void gemm_phase(LAS unsigned char* lds, const Gemm g, const Sched& S, const Epi& E) {
    int tid_ = threadIdx.x; asm volatile("" : "+v"(tid_));
    const int tid = tid_, wid = __builtin_amdgcn_readfirstlane(tid >> 6), lane = tid & 63, wr = wid >> 2, wc = wid & 3, fr = lane & 15, fq = lane >> 4;
    const int K = g.K, nt = K / BK;
    unsigned voffA, voffB;
    { int R, C; stage_rc(tid * 16, R, C); const int Rb = Epi::PERM ? ((R & ~31) + perm32(R & 31)) : R;
      voffA = (unsigned)(R * g.lda + C) * 2u; voffB = (unsigned)(Rb * g.ldb + C) * 2u; }
    const size_t pstepA = (size_t)64 * g.lda * 2, pstepB = (size_t)64 * g.ldb * 2;
    const size_t kstep = (size_t)(BK * 2);
    const size_t hstepA = (size_t)HALF * g.lda * 2, hstepB = (size_t)HALF * g.ldb * 2;
    const size_t tstepA = 2 * hstepA, tstepB = 2 * hstepB;
    const unsigned ldsw = (unsigned)wid * 1024u;
    const int aoff = lds_byte(wr * 64 + fr, fq * 8), boff = lds_byte(wc * 32 + fr, fq * 8);
    const int h8 = (fq >> 1) & 1;
    const int aoff1 = lds_byte(wr * 64 + fr, fq * 16 + h8 * 8), aoff2 = lds_byte(wr * 64 + fr, fq * 16 + (1 - h8) * 8);
    const int boff1 = lds_byte(wc * 32 + fr, fq * 16 + h8 * 8), boff2 = lds_byte(wc * 32 + fr, fq * 16 + (1 - h8) * 8);
#define PG8_SA(b, h) (((b) * 2 + (h)) * HTB)
#define PG8_SB(b, h) ((4 + (b) * 2 + (h)) * HTB)
#define PG8_STAGE(bufoff, gbase, voff) do { _Pragma("unroll") for (int _i = 0; _i < 2; ++_i) \
        __builtin_amdgcn_global_load_lds((const unsigned*)((const char*)(gbase) + (size_t)_i * pstep_##voff + (voff)), (LAS unsigned*)(lds + (bufoff) + ldsw + _i * 8192), 16, 0, 0); } while (0)
#define pstep_voffA pstepA
#define pstep_voffB pstepB
#define PG8_LDA(dst, b, h) do { if constexpr (FP8) pg8_ldfrag8<4>(dst##8, lds + PG8_SA(b, h), aoff1, aoff2); else pg8_ldfrag16<4>(dst, lds + PG8_SA(b, h), aoff); } while (0)
#define PG8_LDB(dst, b, h) do { if constexpr (FP8) pg8_ldfrag8<2>(dst##8, lds + PG8_SB(b, h), boff1, boff2); else pg8_ldfrag16<2>(dst, lds + PG8_SB(b, h), boff); } while (0)
#define PG8_MMA(ai, bj, At, Bt) do { __builtin_amdgcn_s_setprio(1); if constexpr (FP8) pg8_mma8(acc[ai][bj], At##8, Bt##8); else pg8_mma16(acc[ai][bj], At, Bt); __builtin_amdgcn_s_setprio(0); } while (0)
#define PG8_WAIT_V(n) asm volatile("s_waitcnt vmcnt(" #n ")" ::: "memory")
#define PG8_WAIT_L(n) asm volatile("s_waitcnt lgkmcnt(" #n ")" ::: "memory")
#define PG8_BAR __builtin_amdgcn_s_barrier()
#define PG8_SCHED __builtin_amdgcn_sched_barrier(0)
#define PG8_ABASE(u) ((const char*)g.A + (size_t)(u).pm * tstepA + (size_t)((u).pn / g.agrp_div) * (size_t)g.agrp_cols * 2)
#define PG8_BBASE(u) ((const char*)g.Bt + (size_t)(u).pn * tstepB + (size_t)((u).pm / g.bgrp_div) * (size_t)g.bgrp_cols * 2)
    Unit cur, nxt; int ui = 0;
    if (!S.next(0, cur)) return;
    f32x4 acc[2][2][4][2];
#pragma unroll
    for (int a = 0; a < 2; ++a)
#pragma unroll
        for (int b = 0; b < 2; ++b)
#pragma unroll
            for (int m = 0; m < 4; ++m)
#pragma unroll
                for (int n = 0; n < 2; ++n) acc[a][b][m][n] = (f32x4){0.f, 0.f, 0.f, 0.f};
    bf16x8 At[4][2], B0[2][2], B1[2][2]; v8i_t At8[4], B08[2], B18[2];
    const char* cA = PG8_ABASE(cur); const char* cB = PG8_BBASE(cur);
    S.a_ready(cur);
    PG8_STAGE(PG8_SB(0, 0), cB, voffB); PG8_STAGE(PG8_SB(0, 1), cB + hstepB, voffB); PG8_STAGE(PG8_SA(0, 0), cA, voffA); PG8_STAGE(PG8_SA(0, 1), cA + hstepA, voffA);
    if (wr == 1) PG8_BAR;
    PG8_WAIT_V(2); PG8_BAR;
    PG8_STAGE(PG8_SB(1, 0), cB + kstep, voffB); PG8_STAGE(PG8_SA(1, 0), cA + kstep, voffA); PG8_STAGE(PG8_SB(1, 1), cB + hstepB + kstep, voffB);
    PG8_WAIT_V(6); PG8_BAR;
    for (;;) {
        const bool has_next = S.next(ui + 1, nxt);
        const char* nA = has_next ? PG8_ABASE(nxt) : cA; const char* nB = has_next ? PG8_BBASE(nxt) : cB;
        for (int t = 0; t < nt; t += 2) {
            const bool last = (t == nt - 2);
            const char* a1 = cA + (size_t)(t + 1) * kstep;
            const char* a2 = last ? nA : cA + (size_t)(t + 2) * kstep; const char* b2 = last ? nB : cB + (size_t)(t + 2) * kstep;
            const char* a3 = a2 + kstep; const char* b3 = b2 + kstep;
            if (last && has_next) S.a_ready(nxt);
            PG8_LDB(B0, 0, 0); PG8_LDB(B1, 0, 1); PG8_SCHED; PG8_LDA(At, 0, 0); PG8_STAGE(PG8_SA(1, 1), a1 + hstepA, voffA);
            PG8_WAIT_V(8); PG8_WAIT_L(0); PG8_BAR; PG8_MMA(0, 0, At, B0); PG8_MMA(0, 1, At, B1); PG8_BAR; PG8_SCHED;
            PG8_LDA(At, 0, 1); PG8_STAGE(PG8_SB(0, 0), b2, voffB); PG8_STAGE(PG8_SB(0, 1), b2 + hstepB, voffB); PG8_STAGE(PG8_SA(0, 0), a2, voffA);
            PG8_WAIT_V(8); PG8_WAIT_L(0); PG8_BAR; PG8_MMA(1, 0, At, B0); PG8_MMA(1, 1, At, B1); PG8_BAR; PG8_SCHED;
            PG8_LDB(B0, 1, 0); PG8_LDB(B1, 1, 1); PG8_SCHED; PG8_LDA(At, 1, 0); PG8_STAGE(PG8_SA(0, 1), a2 + hstepA, voffA);
            PG8_WAIT_V(8); PG8_WAIT_L(0); PG8_BAR; PG8_MMA(0, 0, At, B0); PG8_MMA(0, 1, At, B1); PG8_BAR; PG8_SCHED;
            PG8_LDA(At, 1, 1); PG8_STAGE(PG8_SB(1, 0), b3, voffB); PG8_STAGE(PG8_SB(1, 1), b3 + hstepB, voffB); PG8_STAGE(PG8_SA(1, 0), a3, voffA);
            PG8_WAIT_V(8); PG8_WAIT_L(0); PG8_BAR; PG8_MMA(1, 0, At, B0); PG8_MMA(1, 1, At, B1); PG8_BAR; PG8_SCHED;
        }
        if constexpr (ALIGN_EPI) { if (wr == 0) PG8_BAR; }
        if constexpr (FP8) asm volatile("s_nop 15\n\ts_nop 15" ::: "memory");
        if constexpr (FP8) { int ln_ = lane; asm volatile("" : "+v"(ln_));
          E(acc, cur, wr, wc, ln_ & 15, ln_ >> 4); } else E(acc, cur, wr, wc, fr, fq);
        S.done(cur);
        if (!has_next) break;
#pragma unroll
        for (int a = 0; a < 2; ++a)
#pragma unroll
            for (int b = 0; b < 2; ++b)
#pragma unroll
                for (int m = 0; m < 4; ++m)
#pragma unroll
                    for (int n = 0; n < 2; ++n) acc[a][b][m][n] = (f32x4){0.f, 0.f, 0.f, 0.f};
        cur = nxt; cA = nA; cB = nB; ++ui;
        if constexpr (ALIGN_EPI) { if (wr == 1) PG8_BAR; }
    }
    PG8_WAIT_V(0);
    if constexpr (!ALIGN_EPI) { if (wr == 0) PG8_BAR; }
    PG8_BAR;
#undef PG8_SA
#undef PG8_SB
#undef PG8_STAGE
#undef pstep_voffA
#undef pstep_voffB
#undef PG8_LDA
#undef PG8_LDB
#undef PG8_MMA
#undef PG8_WAIT_V
#undef PG8_WAIT_L
#undef PG8_BAR
#undef PG8_SCHED
#undef PG8_ABASE
#undef PG8_BBASE
}
}

#define XB_TMO      128
#define XB_XCNT(j)  (256  + 64 * (j))
#define XB_XSUB(j)  (1280 + 64 * (j))
#define XB_XGEN(j)  (2304 + 64 * (j))
#define XB_TOP      3328
#define XB_TOPGEN   3392
#define XCD_BAR_WORDS 3456
#define XB_SPIN_CAP (1u << 18)

__device__ __forceinline__ unsigned xb_ld(unsigned* p)              { return __hip_atomic_load(p, __ATOMIC_RELAXED, __HIP_MEMORY_SCOPE_AGENT); }
__device__ __forceinline__ unsigned xb_add(unsigned* p, unsigned v) { return __hip_atomic_fetch_add(p, v, __ATOMIC_RELAXED, __HIP_MEMORY_SCOPE_AGENT); }
__device__ __forceinline__ unsigned xb_xcc_id() { return (unsigned)__builtin_amdgcn_s_getreg((3 << 11) | 20) & 0xFu; }
#define XB_SPIN(cond, bar) do { unsigned _sp = 0; while (cond) { __builtin_amdgcn_s_sleep(1); \
    if ((++_sp & 255u) == 0u) { if (xb_ld(&(bar)[XB_TMO])) break; if (_sp > XB_SPIN_CAP) { atomicAdd(&(bar)[XB_TMO], 1u); break; } } } } while (0)

struct XcdBarrier { unsigned* bar; unsigned x; volatile LAS unsigned* st; };

__device__ __forceinline__ XcdBarrier xcd_barrier_post(unsigned* bar, volatile LAS unsigned* st) {
    XcdBarrier b; b.bar = bar; b.x = xb_xcc_id(); b.st = st;
    if (threadIdx.x == 0) (void)xb_add(&bar[XB_XCNT(b.x)], 1u);
    return b;
}
__device__ __forceinline__ void xcd_barrier_complete(unsigned* bar, unsigned x, unsigned& nloc, unsigned& nx) {
    const unsigned G = gridDim.x * gridDim.y * gridDim.z;
    unsigned sum, cnt, mine, sp = 0u;
    for (;;) {
        sum = 0u; cnt = 0u; mine = 0u;
#pragma unroll
        for (unsigned j = 0; j < 16; ++j) { const unsigned c = xb_ld(&bar[XB_XCNT(j)]); sum += c; cnt += (c > 0u) ? 1u : 0u; mine = (j == x) ? c : mine; }
        if (sum == G) break;
        __builtin_amdgcn_s_sleep(1);
        if ((++sp & 255u) == 0u) { if (xb_ld(&bar[XB_TMO])) break; if (sp > XB_SPIN_CAP) { atomicAdd(&bar[XB_TMO], 1u); break; } }
    }
    nloc = mine > 0u ? mine : 1u; nx = cnt > 0u ? cnt : 1u;
}
__device__ __forceinline__ void xcd_barrier(const XcdBarrier& b) {
    asm volatile("s_waitcnt vmcnt(0)" ::: "memory");
    __syncthreads();
    if (threadIdx.x == 0) {
        unsigned* bar = b.bar;
        __builtin_amdgcn_s_waitcnt(0);
        unsigned nloc = b.st[0], nx = b.st[1];
        if (nloc == 0u) { xcd_barrier_complete(bar, b.x, nloc, nx); b.st[0] = nloc; b.st[1] = nx; }
        const unsigned old = xb_add(&bar[XB_XSUB(b.x)], 1u);
        const unsigned gen = old / nloc;
        if (old + 1u == (gen + 1u) * nloc) {
            __builtin_amdgcn_fence(__ATOMIC_RELEASE, "agent");
            asm volatile("s_waitcnt vmcnt(0)" ::: "memory");
            const unsigned og = xb_add(&bar[XB_TOP], 1u);
            const unsigned tg = og / nx;
            if (og + 1u == (tg + 1u) * nx) xb_add(&bar[XB_TOPGEN], 1u);
            else XB_SPIN(xb_ld(&bar[XB_TOPGEN]) == tg, bar);
            __builtin_amdgcn_fence(__ATOMIC_ACQUIRE, "agent");
            xb_add(&bar[XB_XGEN(b.x)], 1u);
            asm volatile("s_waitcnt vmcnt(0)" ::: "memory");
        } else {
            XB_SPIN(xb_ld(&bar[XB_XGEN(b.x)]) == gen, bar);
            __builtin_amdgcn_fence(__ATOMIC_ACQUIRE, "agent");
            asm volatile("s_waitcnt vmcnt(0)" ::: "memory");
        }
    }
    __syncthreads();
}

template <bool F8>
__device__ __forceinline__ void p0_transpose_item(const float* W, int ldw, int N, void* WTv, int ldt, float scale, LAS float* scr, int item, int lane) {
    const int nblk = N / 32, kb = item / nblk, nb = item % nblk, k0 = 64 * kb, n0 = 32 * nb;
#pragma unroll 8
    for (int i = 0; i < 32; ++i) { const int kk = 2 * i + (lane >> 5); scr[kk * 33 + (lane & 31)] = W[(size_t)(k0 + kk) * ldw + n0 + (lane & 31)]; }
    LDS_WAIT(); asm volatile("" ::: "memory");
    const int c = lane & 7;
#pragma unroll
    for (int j = 0; j < 4; ++j) { const int n = (lane >> 3) + 8 * j; const LAS float* s = scr + (8 * c) * 33 + n;
        if constexpr (F8) { int lo = 0, hi = 0;
            lo = __builtin_amdgcn_cvt_pk_fp8_f32(s[0 * 33] * scale, s[1 * 33] * scale, lo, false); lo = __builtin_amdgcn_cvt_pk_fp8_f32(s[2 * 33] * scale, s[3 * 33] * scale, lo, true);
            hi = __builtin_amdgcn_cvt_pk_fp8_f32(s[4 * 33] * scale, s[5 * 33] * scale, hi, false); hi = __builtin_amdgcn_cvt_pk_fp8_f32(s[6 * 33] * scale, s[7 * 33] * scale, hi, true);
            *(GAS v2u*)((unsigned char*)WTv + (size_t)(n0 + n) * ldt + k0 + 8 * c) = (v2u){(unsigned)lo, (unsigned)hi};
        } else {
            v4u o; o.x = cvt_pk_bf16(s[0 * 33], s[1 * 33]); o.y = cvt_pk_bf16(s[2 * 33], s[3 * 33]); o.z = cvt_pk_bf16(s[4 * 33], s[5 * 33]); o.w = cvt_pk_bf16(s[6 * 33], s[7 * 33]);
            *(GAS v4u*)((bf16*)WTv + (size_t)(n0 + n) * ldt + k0 + 8 * c) = o; } }
    LDS_WAIT(); asm volatile("" ::: "memory");
}

__device__ __forceinline__ int t5_bucket(int rel) {
    int n = -rel; const int ret = n < 0 ? 16 : 0; n = n < 0 ? -n : n;
    if (n < 8) return ret + n;
    const float v = logf((float)n / 8.0f) / logf(128.0f) * 8.0f;
    int large = 8 + (int)v; large = large < 15 ? large : 15;
    return ret + large;
}
__device__ __forceinline__ float gelu_tanh(float x) {
    const float z = 0.7978845608028654f * (x + 0.044715f * x * x * x);
    const float e = __expf(2.0f * z);
    const float t = 1.0f - 2.0f / (e + 1.0f);
    return 0.5f * x * (1.0f + t);
}
__device__ __forceinline__ unsigned fkey(float v) { const unsigned u = __float_as_uint(v); return (u >> 31) ? ~u : (u | 0x80000000u); }
__device__ __forceinline__ float fdec(unsigned key) { const unsigned k2 = key & ~127u; const unsigned u = (k2 >> 31) ? (k2 & 0x7fffffffu) : (~k2 & ~127u); return __uint_as_float(u); }
template <int LJ> __device__ __forceinline__ unsigned xshfl(unsigned x, const int lane) {
    if constexpr (LJ == 1) return (unsigned)__builtin_amdgcn_update_dpp(0, (int)x, 0xB1, 0xF, 0xF, false);
    else if constexpr (LJ == 2) return (unsigned)__builtin_amdgcn_update_dpp(0, (int)x, 0x4E, 0xF, 0xF, false);
    else if constexpr (LJ == 4) { const int y = __builtin_amdgcn_update_dpp(0, (int)x, 0x141, 0xF, 0xF, false); return (unsigned)__builtin_amdgcn_update_dpp(0, y, 0x1B, 0xF, 0xF, false); }
    else if constexpr (LJ == 8) { const int y = __builtin_amdgcn_update_dpp(0, (int)x, 0x140, 0xF, 0xF, false); return (unsigned)__builtin_amdgcn_update_dpp(0, y, 0x141, 0xF, 0xF, false); }
    else if constexpr (LJ == 16) return (unsigned)__builtin_amdgcn_ds_swizzle((int)x, 0x401F);
    else { const auto rr = __builtin_amdgcn_permlane32_swap(x, x, false, false); return lane < 32 ? rr[1] : rr[0]; }
}
template <int K, int J> __device__ __forceinline__ void bitonic_step(unsigned& a0, unsigned& a1, unsigned& b0, unsigned& b1, const int lane) {
    const bool asc = (K == 128) ? true : ((lane & (K >> 1)) == 0);
    if constexpr (J == 1) {
        const unsigned la = a0 < a1 ? a0 : a1, ha = a0 < a1 ? a1 : a0, lb = b0 < b1 ? b0 : b1, hb = b0 < b1 ? b1 : b0;
        a0 = asc ? la : ha; a1 = asc ? ha : la; b0 = asc ? lb : hb; b1 = asc ? hb : lb;
    } else {
        constexpr int LJ = J >> 1; const bool tmin = (((lane & LJ) == 0) == asc);
        const unsigned pa0 = xshfl<LJ>(a0, lane), pa1 = xshfl<LJ>(a1, lane), pb0 = xshfl<LJ>(b0, lane), pb1 = xshfl<LJ>(b1, lane);
        a0 = tmin ? (a0 < pa0 ? a0 : pa0) : (a0 < pa0 ? pa0 : a0); a1 = tmin ? (a1 < pa1 ? a1 : pa1) : (a1 < pa1 ? pa1 : a1);
        b0 = tmin ? (b0 < pb0 ? b0 : pb0) : (b0 < pb0 ? pb0 : b0); b1 = tmin ? (b1 < pb1 ? b1 : pb1) : (b1 < pb1 ? pb1 : b1);
    }
    if constexpr (J > 1) bitonic_step<K, (J >> 1)>(a0, a1, b0, b1, lane);
}
template <int K> __device__ __forceinline__ void bitonic_stage(unsigned& a0, unsigned& a1, unsigned& b0, unsigned& b1, const int lane) {
    bitonic_step<K, (K >> 1)>(a0, a1, b0, b1, lane);
    if constexpr (K < 128) bitonic_stage<(K << 1)>(a0, a1, b0, b1, lane);
}
__device__ __forceinline__ void bitonic128x2(unsigned& a0, unsigned& a1, unsigned& b0, unsigned& b1, const int lane) { bitonic_stage<2>(a0, a1, b0, b1, lane); }
__device__ __forceinline__ unsigned q8x4(f32x4 v, float s) {
    const unsigned b0 = __float_as_uint(v[0] * s + 12582912.0f), b1 = __float_as_uint(v[1] * s + 12582912.0f), b2 = __float_as_uint(v[2] * s + 12582912.0f), b3 = __float_as_uint(v[3] * s + 12582912.0f);
    return (b0 & 0xffu) | ((b1 & 0xffu) << 8) | ((b2 & 0xffu) << 16) | (b3 << 24);
}
__device__ __forceinline__ float dot2bf(unsigned a, unsigned b, float c) { return __builtin_amdgcn_fdot2_f32_bf16(__builtin_bit_cast(bf2_t, a), __builtin_bit_cast(bf2_t, b), c, false); }

constexpr int ATT_SLOT = 8704;
__device__ __forceinline__ int crow(int r, int hi) { return (r & 3) + 8 * (r >> 2) + 4 * hi; }

__device__ __forceinline__ void attn_task(const int G, const bf16* QKVH, bf16* O0, bf16* O1, float* LSE0, float* LSE1, unsigned char* MIX8,
                                          const LAS float* btab, LAS unsigned char* wl, int b, int h, int mtile, int tk, int lane) {
    const int SH = 2 * G;
    const int L = SEQ >> SH, TPR = 32 >> SH;
    const int r32 = lane & 31, hi = lane >> 5;
    const int res = tk >> (5 - SH), l0 = ((mtile * 1024) >> SH) + 32 * (tk & (TPR - 1));
    const size_t rowbase = (size_t)b * SEQ;
    const int srow = lane >> 4, sch = lane & 15;
    const int rot = (tk & 1) ? 4 : 0;
#define ATT_JR(j) (((j) + rot) >= 5 ? ((j) + rot - 5) : ((j) + rot))
#define ATT_WAITV(n) asm volatile("s_waitcnt vmcnt(" #n ")" ::: "memory")
#define ATT_ISSUE(n) do { LAS unsigned char* sl_ = wl + ((n) & 1) * ATT_SLOT; const int jt_ = ATT_JR((n) < 5 ? (n) : (n) - 5); \
        _Pragma("unroll") for (int i_ = 0; i_ < 8; ++i_) { \
            const int key_ = (n) < 5 ? (4 * i_ + srow) : ((i_ & 3) + 4 * srow + 16 * (i_ >> 2)); \
            int lk_ = l0 - 64 + 32 * jt_ + key_; lk_ = lk_ < 0 ? 0 : (lk_ > L - 1 ? L - 1 : lk_); \
            const int ch_ = (n) < 5 ? (sch ^ (key_ & 7)) : sch; \
            const bf16* src_ = QKVH + ((size_t)(((n) < 5 ? NH : 2 * NH) + h) * M + rowbase + ((size_t)lk_ << SH) + res) * HD + ch_ * 8; \
            __builtin_amdgcn_global_load_lds((const unsigned*)src_, (LAS unsigned*)(sl_ + i_ * ((n) < 5 ? 1024 : 1088)), 16, 0, 0); } } while (0)
    const size_t qrow = rowbase + ((size_t)(l0 + r32) << SH) + res;
    bf16x8 qr[8];
    { const bf16* qp = QKVH + ((size_t)h * M + qrow) * HD + hi * 8;
#pragma unroll
      for (int d0 = 0; d0 < 8; ++d0) qr[d0] = *(const bf16x8*)(qp + d0 * 16); }
    ATT_ISSUE(0); ATT_ISSUE(1);
    f32x16 p[5];
#define ATT_KTILE(n) do { LAS unsigned char* sl_ = wl + ((n) & 1) * ATT_SLOT + r32 * 256; f32x16 s_ = {}; \
        _Pragma("unroll") for (int d0 = 0; d0 < 8; ++d0) { const bf16x8 a_ = *(const LAS bf16x8*)(sl_ + (((2 * d0 + hi) ^ (r32 & 7)) << 4)); s_ = __builtin_amdgcn_mfma_f32_32x32x16_bf16(a_, qr[d0], s_, 0, 0, 0); } \
        p[n] = s_; asm volatile("" ::: "memory"); } while (0)
    ATT_WAITV(8); ATT_KTILE(0); ATT_ISSUE(2);
    ATT_WAITV(8); ATT_KTILE(1); ATT_ISSUE(3);
    ATT_WAITV(8); ATT_KTILE(2); ATT_ISSUE(4);
    ATT_WAITV(8); ATT_KTILE(3); ATT_ISSUE(5);
    ATT_WAITV(8); ATT_KTILE(4); ATT_ISSUE(6);
    float mx = -1e30f;
    const bool edge = (l0 - 64 < 0) || (l0 + 96 > L);
    const LAS float* bt = btab + G * 256 + 32 + 4 * hi - r32;
#pragma unroll
    for (int j = 0; j < 5; ++j) {
        const int jr = ATT_JR(j); const LAS float* btj = bt + 32 * jr;
#pragma unroll
        for (int r = 0; r < 16; ++r) {
            const int kc = 32 * jr + (r & 3) + 8 * (r >> 2);
            float v = p[j][r] + btj[(r & 3) + 8 * (r >> 2)];
            if (edge) { const int lk = l0 - 64 + kc + 4 * hi; v = (lk >= 0 && lk < L) ? v : -1e30f; }
            p[j][r] = v; mx = fmaxf(mx, v);
        }
        asm volatile("" ::: "memory");
    }
    mx = fmaxf(mx, __shfl_xor(mx, 32));
    float ls = 0.f;
    bf16x8 pb[5][2];
#pragma unroll
    for (int j = 0; j < 5; ++j) {
        float e[16];
#pragma unroll
        for (int r = 0; r < 16; ++r) { e[r] = __builtin_amdgcn_exp2f(p[j][r] - mx); ls += e[r]; }
#pragma unroll
        for (int s = 0; s < 2; ++s) { v4u w; w.x = cvt_pk_bf16(e[8 * s + 0], e[8 * s + 1]); w.y = cvt_pk_bf16(e[8 * s + 2], e[8 * s + 3]);
            w.z = cvt_pk_bf16(e[8 * s + 4], e[8 * s + 5]); w.w = cvt_pk_bf16(e[8 * s + 6], e[8 * s + 7]); pb[j][s] = __builtin_bit_cast(bf16x8, w); }
    }
    ls += __shfl_xor(ls, 32);
    asm volatile("" ::: "memory");
    f32x16 o[4] = {};
    const int i16 = lane & 15, g16 = lane >> 4;
    const unsigned vbase = (unsigned)(uintptr_t)wl + (unsigned)((i16 >> 2) * 1088 + hi * 256 + (16 * (g16 & 1) + 4 * (i16 & 3)) * 2);
#define ATT_VTILE(n) do { const unsigned va_ = vbase + ((n) & 1) * ATT_SLOT; \
        _Pragma("unroll") for (int dt = 0; dt < 4; ++dt) { s16x4 lo0, hi0, lo1, hi1; \
            asm volatile("ds_read_b64_tr_b16 %0, %4 offset:%5\n\tds_read_b64_tr_b16 %1, %4 offset:%6\n\tds_read_b64_tr_b16 %2, %4 offset:%7\n\tds_read_b64_tr_b16 %3, %4 offset:%8\n\ts_waitcnt lgkmcnt(0)" \
                         : "=&v"(lo0), "=&v"(hi0), "=&v"(lo1), "=&v"(hi1) : "v"(va_), "i"(dt * 64), "i"(512 + dt * 64), "i"(4 * 1088 + dt * 64), "i"(4 * 1088 + 512 + dt * 64) : "memory"); \
            const bf16x8 af0 = (bf16x8){lo0[0], lo0[1], lo0[2], lo0[3], hi0[0], hi0[1], hi0[2], hi0[3]}; \
            const bf16x8 af1 = (bf16x8){lo1[0], lo1[1], lo1[2], lo1[3], hi1[0], hi1[1], hi1[2], hi1[3]}; \
            o[dt] = __builtin_amdgcn_mfma_f32_32x32x16_bf16(af0, pb[(n) - 5][0], o[dt], 0, 0, 0); \
            o[dt] = __builtin_amdgcn_mfma_f32_32x32x16_bf16(af1, pb[(n) - 5][1], o[dt], 0, 0, 0); } } while (0)
    ATT_WAITV(8); ATT_VTILE(5); ATT_ISSUE(7);
    ATT_WAITV(8); ATT_VTILE(6); ATT_ISSUE(8);
    ATT_WAITV(8); ATT_VTILE(7); ATT_ISSUE(9);
    ATT_WAITV(8); ATT_VTILE(8);
    ATT_WAITV(0); ATT_VTILE(9);
#undef ATT_WAITV
#undef ATT_ISSUE
#undef ATT_KTILE
#undef ATT_VTILE
#undef ATT_JR
    const float inv = 1.0f / ls;
    const float lse2 = mx + __builtin_amdgcn_logf(ls);
    const size_t orow = qrow;
    LAS unsigned char* T0 = wl;
    LAS unsigned char* T1 = T0 + ATT_SLOT;
    int ln_ = lane; asm volatile("" : "+v"(ln_));
    const int erow = ln_ >> 4, echk = ln_ & 15;
    const unsigned pofs = (unsigned)(r32 * 272 + 8 * hi);
    if (G < 2) {
#pragma unroll
        for (int dt = 0; dt < 4; ++dt)
#pragma unroll
            for (int rg = 0; rg < 4; ++rg) { v2u w; w.x = cvt_pk_bf16(o[dt][4 * rg] * inv, o[dt][4 * rg + 1] * inv); w.y = cvt_pk_bf16(o[dt][4 * rg + 2] * inv, o[dt][4 * rg + 3] * inv);
                *(LAS v2u*)(T0 + pofs + 64 * dt + 16 * rg) = w; }
        LDS_WAIT();
        bf16* ob = (G == 0 ? O0 : O1) + ((size_t)h * M + rowbase) * HD + echk * 8;
#pragma unroll
        for (int i = 0; i < 8; ++i) { const int qi = erow + 4 * i; const v4u w = *(const LAS v4u*)(T0 + qi * 272 + echk * 16);
            *(v4u*)(ob + (((size_t)(l0 + qi) << SH) + res) * HD) = w; }
        if (hi == 0) (G == 0 ? LSE0 : LSE1)[orow * NH + h] = lse2;
    } else {
        const float l0v = LSE0[orow * NH + h], l1v = LSE1[orow * NH + h];
        const bf16* ib0 = O0 + ((size_t)h * M + rowbase) * HD + echk * 8; const bf16* ib1 = O1 + ((size_t)h * M + rowbase) * HD + echk * 8;
#pragma unroll
        for (int hh = 0; hh < 2; ++hh) {
            v4u t0[4], t1[4];
#pragma unroll
            for (int i = 0; i < 4; ++i) { const size_t ro = (((size_t)(l0 + erow + 4 * (4 * hh + i)) << SH) + res) * HD; t0[i] = *(const v4u*)(ib0 + ro); t1[i] = *(const v4u*)(ib1 + ro); }
#pragma unroll
            for (int i = 0; i < 4; ++i) { const int qi = erow + 4 * (4 * hh + i); *(LAS v4u*)(T0 + qi * 272 + echk * 16) = t0[i]; *(LAS v4u*)(T1 + qi * 272 + echk * 16) = t1[i]; }
            asm volatile("" ::: "memory");
        }
        const float mm = fmaxf(fmaxf(l0v, l1v), lse2);
        const float w0 = __builtin_amdgcn_exp2f(l0v - mm), w1 = __builtin_amdgcn_exp2f(l1v - mm), w2 = __builtin_amdgcn_exp2f(lse2 - mm);
        const float wi = 1.0f / (w0 + w1 + w2);
        const float c0 = w0 * wi, c1 = w1 * wi, c2 = w2 * wi * inv;
        LDS_WAIT();
        unsigned y8[16];
#pragma unroll
        for (int dt = 0; dt < 4; ++dt)
#pragma unroll
            for (int rg = 0; rg < 4; ++rg) { const v2u a = *(const LAS v2u*)(T0 + pofs + 64 * dt + 16 * rg), c = *(const LAS v2u*)(T1 + pofs + 64 * dt + 16 * rg);
                const float y0 = c0 * bf_lo(a.x) + c1 * bf_lo(c.x) + c2 * o[dt][4 * rg], y1 = c0 * bf_hi(a.x) + c1 * bf_hi(c.x) + c2 * o[dt][4 * rg + 1];
                const float y2 = c0 * bf_lo(a.y) + c1 * bf_lo(c.y) + c2 * o[dt][4 * rg + 2], y3 = c0 * bf_hi(a.y) + c1 * bf_hi(c.y) + c2 * o[dt][4 * rg + 3];
                int w = 0; w = __builtin_amdgcn_cvt_pk_fp8_f32(y0 * A8SCALE, y1 * A8SCALE, w, false); w = __builtin_amdgcn_cvt_pk_fp8_f32(y2 * A8SCALE, y3 * A8SCALE, w, true); y8[4 * dt + rg] = (unsigned)w; }
        LDS_WAIT();
#pragma unroll
        for (int dt = 0; dt < 4; ++dt)
#pragma unroll
            for (int rg = 0; rg < 4; ++rg) *(LAS unsigned*)(T0 + r32 * 144 + 4 * hi + 32 * dt + 8 * rg) = y8[4 * dt + rg];
        LDS_WAIT();
        unsigned char* ob = MIX8 + rowbase * DM + h * HD + (ln_ & 7) * 16;
#pragma unroll
        for (int i = 0; i < 4; ++i) { const int qi = (ln_ >> 3) + 8 * i; const v4u w = *(const LAS v4u*)(T0 + qi * 144 + (ln_ & 7) * 16);
            *(v4u*)(ob + (((size_t)(l0 + qi) << SH) + res) * DM) = w; }
    }
    LDS_WAIT();
}

constexpr int PER_PHASE = 9;
struct Args { const float* in[16]; float* out; unsigned char* ws; unsigned mask; unsigned pad; };

__constant__ unsigned char CAND_I[64] = {0,0,0,0,0,0,0,0,0,0,0,0,0,0,0,0, 1,1,1,1,1,1,1,1, 2,2,2,2,2, 3,3,3,3, 4,4,4, 5,5, 6,6, 7,7, 8,9,10,11,12,13,14,15, 0,0,0,0,0,0,0,0,0,0,0,0,0,0};
__constant__ unsigned char CAND_J[64] = {0,1,2,3,4,5,6,7,8,9,10,11,12,13,14,15, 0,1,2,3,4,5,6,7, 0,1,2,3,4, 0,1,2,3, 0,1,2, 0,1, 0,1, 0,1, 0,0,0,0,0,0,0,0, 0,0,0,0,0,0,0,0,0,0,0,0,0,0};

__global__ void __launch_bounds__(NWAVES * 64, 2) fwd_kernel(Args args) {
    extern __shared__ __attribute__((aligned(16))) unsigned char lds_raw[];
    LAS unsigned char* lds = (LAS unsigned char*)lds_raw;
    volatile LAS unsigned* MISC = (volatile LAS unsigned*)(lds + MISC_OFF);
    const int tid0 = threadIdx.x, lane0 = tid0 & 63, wave = __builtin_amdgcn_readfirstlane(tid0 >> 6);
#define PHASE_LANES() int tid = tid0; asm volatile("" : "+v"(tid)); const int lane = tid & 63
    const int G = gridDim.x; const int bx = blockIdx.x;
    const int vcu = (G % 8 == 0) ? (bx % 8) * (G / 8) + bx / 8 : bx;
    const int gw = vcu * NWAVES + wave, NGW = G * NWAVES;
    unsigned char* ws = args.ws;
    unsigned* ctl = (unsigned*)(ws + WS_CTL);
    const float* x = args.in[0]; const float* cvec = args.in[1]; const float* w_ada = args.in[2]; const float* b_ada = args.in[3]; const float* g_mix = args.in[4];
    const float* w_in = args.in[5]; const float* rel_bias = args.in[6]; const float* pool_w = args.in[7]; const float* pool_scale = args.in[8]; const float* w_out = args.in[9];
    const float* g_ffn = args.in[10]; const float* peer_wq = args.in[11]; const float* peer_sk = args.in[12]; const float* peer_u = args.in[13]; const float* peer_v = args.in[14];
    const float* g_final = args.in[15];
    float* out = args.out;
    float* MODV = (float*)(ws + WS_MODV); float* MODP = (float*)(ws + WS_MODP);
    bf16* SKT = (bf16*)(ws + WS_SKT); bf16* PWS = (bf16*)(ws + WS_PWS); bf16* WQST = (bf16*)(ws + WS_WQST); unsigned char* WOUT8 = ws + WS_WOUT2;     bf16* WINT = (bf16*)(ws + WS_WINT); unsigned char* WIN8 = ws + WS_WIN8; unsigned char* H8 = ws + WS_H8;
    bf16* WOPT = (bf16*)(ws + WS_WOPT); bf16* WQB = (bf16*)(ws + WS_WQB);
    unsigned char* UB = ws + WS_UB; unsigned char* VB = ws + WS_VB; float* SCL = (float*)(ws + WS_SCL); float* TSC = SCL + 2 * NEXP;     bf16* H = (bf16*)(ws + WS_H); bf16* PIN = (bf16*)(ws + WS_PROJ); bf16* QKVH = (bf16*)(ws + WS_QKVH); unsigned char* MIX8 = ws + WS_MIXIN;
    bf16* O0 = (bf16*)(ws + WS_O0); bf16* O1 = (bf16*)(ws + WS_O1); float* LSE = (float*)(ws + WS_LSE);
    float* SC = (float*)(ws + WS_SC);
    bf16* X1B = (bf16*)(ws + WS_O0);
    bf16* YB = (bf16*)(ws + WS_PROJ + 64 * MiB);

    for (int u = tid0; u < (LDS_BYTES - LDSCTL_OFF) / 4; u += NWAVES * 64) ((LAS unsigned*)(lds + LDSCTL_OFF))[u] = 0u;
    __syncthreads();
    XcdBarrier bar; bar.bar = ctl + CW_BAR; bar.x = 0; bar.st = nullptr;
    if (MK_N_LAUNCHES != PER_PHASE) bar = xcd_barrier_post(ctl + CW_BAR, MISC + 8);
#define GRID_BAR() do { if (MK_N_LAUNCHES != PER_PHASE) xcd_barrier(bar); } while (0)
    const unsigned phmask = args.mask;
#ifndef PH_MASK
#define PH_MASK 0x1ff
#endif
#define IN(k) ((((PH_MASK) >> (k)) & 1) && ((phmask >> (k)) & 1u))
#define BOTH(k) (IN(k) && IN((k) + 1))

    if (IN(0)) {
        PHASE_LANES();
        LAS float* silu = (LAS float*)(lds + RING_OFF);
        for (int i = tid; i < BATCH * DM; i += NWAVES * 64) { const float v = cvec[i]; silu[i] = v / (1.0f + __expf(-v)); }
        __syncthreads();
        for (int task = gw; task < (NMOD / 256) * KS_ADA; task += NGW) {
            const int cg = task % (NMOD / 256), ks = task / (NMOD / 256); const int k0 = ks * (DM / KS_ADA), n0 = cg * 256 + 4 * lane;
            f32x4 a0 = {0.f, 0.f, 0.f, 0.f}, a1 = {0.f, 0.f, 0.f, 0.f};
            const float* wp = w_ada + (size_t)k0 * NMOD + n0;
#pragma unroll 8
            for (int kk = 0; kk < DM / KS_ADA; ++kk) { const f32x4 w4 = *(const f32x4*)(wp + (size_t)kk * NMOD); const float s0 = silu[k0 + kk], s1 = silu[DM + k0 + kk]; a0 += w4 * s0; a1 += w4 * s1; }
            *(f32x4*)(MODP + ((size_t)(ks * 2 + 0)) * NMOD + n0) = a0; *(f32x4*)(MODP + ((size_t)(ks * 2 + 1)) * NMOD + n0) = a1;
        }
        __syncthreads();
        {
            LAS float* scr = (LAS float*)(lds + RING_OFF + wave * 16384);
            constexpr int I_QKV = (DM / 64) * (3 * ATTW / 32), I_PIN = (DM / 64) * (POOLW / 32), I_OUTH = (ATTW / 64) * (DM / 32);
            constexpr int NITEMS = I_QKV + I_PIN + 2 * I_OUTH;
            for (int it = gw; it < NITEMS; it += NGW) {
                int r = it;
                if (r < I_QKV) { p0_transpose_item<true>(w_in, INW, 3 * ATTW, WIN8, DM, W8SCALE, scr, r, lane); continue; } r -= I_QKV;
                if (r < I_PIN) { p0_transpose_item<false>(w_in + 3 * ATTW, INW, POOLW, WINT, DM, 1.f, scr, r, lane); continue; } r -= I_PIN;
                if (r < I_OUTH) { p0_transpose_item<true>(w_out, DM, DM, WOUT8, DM, WO8SCALE, scr, r, lane); continue; } r -= I_OUTH;
                p0_transpose_item<false>(w_out + (size_t)ATTW * DM, DM, DM, WOPT, POOLW, 1.f, scr, r, lane);
            }
        }
        for (int i = gw * 64 + lane; i < (DM * PQ + 4 * 512 * 512) / 8; i += NGW * 64) {
            const bool isQ = i < DM * PQ / 8; const int j = isQ ? i : i - DM * PQ / 8;
            const float* src = (isQ ? peer_wq : pool_w) + (size_t)j * 8;
            f32x4 a = *(const f32x4*)src, c = *(const f32x4*)(src + 4);
            if (!isQ) { const int e0 = j * 8; const int gi = e0 >> 18, d0 = e0 & 511; const float* ps = pool_scale + gi * 512 + d0; a = a * *(const f32x4*)ps; c = c * *(const f32x4*)(ps + 4); }
            v4u w; w.x = cvt_pk_bf16(a[0], a[1]); w.y = cvt_pk_bf16(a[2], a[3]); w.z = cvt_pk_bf16(c[0], c[1]); w.w = cvt_pk_bf16(c[2], c[3]);
            *(v4u*)((isQ ? WQB : PWS) + (size_t)j * 8) = w;
        }
        for (int r = gw; r < 2 * NEXP; r += NGW) {
            const bool isU = r < NEXP; const int e = isU ? r : r - NEXP;
            const float* src = (isU ? peer_u : peer_v) + (size_t)e * DM + 16 * lane;
            f32x4 v[4][4]; float mx = 0.f;
#pragma unroll
            for (int i = 0; i < 4; ++i)
#pragma unroll
                for (int q = 0; q < 4; ++q) { v[i][q] = *(const f32x4*)(src + 1024 * i + 4 * q);
                    mx = fmaxf(mx, fmaxf(fmaxf(fabsf(v[i][q][0]), fabsf(v[i][q][1])), fmaxf(fabsf(v[i][q][2]), fabsf(v[i][q][3])))); }
#pragma unroll
            for (int o = 1; o < 64; o <<= 1) mx = fmaxf(mx, __shfl_xor(mx, o));
            const int ex = (int)((__float_as_uint(mx) >> 23) & 0xffu);
            float scale = 1.0f, inv = 1.0f;
            if (ex >= 32 && ex <= 230) { if (isU) { scale = 127.0f / mx; inv = mx * (1.0f / 127.0f); }
                else { scale = __uint_as_float((unsigned)(261 - ex) << 23); inv = __uint_as_float((unsigned)(ex - 7) << 23); } }
            unsigned char* dst = (isU ? UB : VB) + ((size_t)(lane >> 3) * NEXP + e) * 128 + 16 * (lane & 7);
#pragma unroll
            for (int i = 0; i < 4; ++i) { v4u w;
#pragma unroll
                for (int q = 0; q < 4; ++q) { if (isU) { w[q] = q8x4(v[i][q], scale); } else { int pk = 0; pk = __builtin_amdgcn_cvt_pk_fp8_f32(v[i][q][0] * scale, v[i][q][1] * scale, pk, false);
                    pk = __builtin_amdgcn_cvt_pk_fp8_f32(v[i][q][2] * scale, v[i][q][3] * scale, pk, true); w[q] = (unsigned)pk; } }
                *(v4u*)(dst + (size_t)(8 * i) * NEXP * 128) = w; }
            if (lane == 0) SCL[r] = inv;
        }
        for (int i = gw * 64 + lane; i < 2048 * 32; i += NGW * 64) {
            const int n = i >> 5, kc = (i & 31) * 8; const int p = (n >> 7) & 1, pp = kc >> 7;
            v4u w = {0u, 0u, 0u, 0u};
            if (p == pp) { const float* src = peer_sk + (size_t)n * 128 + (kc & 127); const f32x4 a = *(const f32x4*)src, c = *(const f32x4*)(src + 4);
                w.x = cvt_pk_bf16(a[0], a[1]); w.y = cvt_pk_bf16(a[2], a[3]); w.z = cvt_pk_bf16(c[0], c[1]); w.w = cvt_pk_bf16(c[2], c[3]); }
            *(v4u*)(SKT + (size_t)n * 256 + kc) = w;
        }
        if (BOTH(0)) GRID_BAR();
    }

    if (IN(1)) {
        PHASE_LANES();
        for (int i = bx * (NWAVES * 64) + tid; i < BATCH * NMOD; i += G * NWAVES * 64) {
            const int b = i / NMOD, n = i % NMOD; float s = b_ada[n];
#pragma unroll 8
            for (int ks = 0; ks < KS_ADA; ++ks) s += MODP[(size_t)(ks * 2 + b) * NMOD + n];
            const int j = n / DM, c = n % DM;
            MODV[(size_t)(j * 2 + b) * DM + c] = s;
        }
        if (bx < G / 2) {
            pg8::Gemm g{WOPT, PWS, DM, POOLW, 512, POOLW, 512, 2, 512, 1 << 30, 0}; pg8::StaticOrder S; S.init(DM, POOLW, G / 2, bx);
            pg8::EpiFp8 E{WOUT8, DM, ATTW, (A8SCALE * WO8SCALE) / P8SCALE};
            pg8::gemm_phase<pg8::EpiFp8, pg8::StaticOrder, true>(lds + RING_OFF, g, S, E);
        }
        else {
            pg8::Gemm g{SKT, WQB, PQ, DM, 256, 256, PQ, 1 << 30, 0, 1, 256}; pg8::StaticOrder S; S.init(PQ, DM, G - G / 2, bx - G / 2);
            pg8::EpiBf16 E{WQST, DM, 0, 1.0f, nullptr, 0, 0};
            pg8::gemm_phase<pg8::EpiBf16, pg8::StaticOrder, true>(lds + RING_OFF, g, S, E);
        }
        if (BOTH(1)) GRID_BAR();
    }

    if (IN(2)) {
        PHASE_LANES();
        for (int row = gw; row < M; row += NGW) {
            const int b = row / SEQ;
            const f32x4* xr = (const f32x4*)(x + (size_t)row * DM) + lane;
            f32x4 v[16]; float ss = 0.f;
#pragma unroll
            for (int j = 0; j < 16; ++j) { v[j] = xr[64 * j]; ss += (v[j][0] * v[j][0] + v[j][1] * v[j][1]) + (v[j][2] * v[j][2] + v[j][3] * v[j][3]); }
            const float rstd = 1.0f / sqrtf(wave_sum(ss) * (1.0f / DM) + RMS_EPS);
            const f32x4* gp = (const f32x4*)g_mix + lane; const f32x4* shp = (const f32x4*)(MODV + (size_t)(0 * 2 + b) * DM) + lane; const f32x4* scp = (const f32x4*)(MODV + (size_t)(1 * 2 + b) * DM) + lane;
            v2u* op = (v2u*)(H + (size_t)row * DM) + lane; unsigned* op8 = (unsigned*)(H8 + (size_t)row * DM) + lane;
#pragma unroll
            for (int j = 0; j < 16; ++j) { const f32x4 g4 = gp[64 * j], sh = shp[64 * j], sc = scp[64 * j];
                const f32x4 y = (v[j] * rstd) * g4 * (sc + 1.0f) + sh;
                v2u w; w.x = cvt_pk_bf16(y[0], y[1]); w.y = cvt_pk_bf16(y[2], y[3]); op[64 * j] = w;
                int p8 = 0; p8 = __builtin_amdgcn_cvt_pk_fp8_f32(y[0] * H8SCALE, y[1] * H8SCALE, p8, false); p8 = __builtin_amdgcn_cvt_pk_fp8_f32(y[2] * H8SCALE, y[3] * H8SCALE, p8, true); op8[64 * j] = (unsigned)p8; }
        }
        if (BOTH(2)) GRID_BAR();
    }

    if (IN(3)) {
        PHASE_LANES();
        {
            pg8::Gemm g{(const bf16*)H8, (const bf16*)WIN8, M, 3 * ATTW, DM / 2, DM / 2, DM / 2, 1 << 30, 0, 1 << 30, 0}; pg8::StaticOrder S; S.init(M, 3 * ATTW, G, bx);
            pg8::EpiBf16 E{PIN, POOLW, ATTW, QSCALE / (H8SCALE * W8SCALE), QKVH, 3 * ATTW, M, 1.0f / (H8SCALE * W8SCALE)};
            pg8::gemm_phase<pg8::EpiBf16, pg8::StaticOrder, true, true>(lds + RING_OFF, g, S, E);
        }
        {
            pg8::Gemm g{H, WINT, M, POOLW, DM, DM, DM, 1 << 30, 0, 1 << 30, 0}; pg8::StaticOrder S; S.init(M, POOLW, G, bx);
            pg8::EpiBf16 E{PIN, POOLW, 0, 1.0f, nullptr, 0, 0};
            pg8::gemm_phase<pg8::EpiBf16, pg8::StaticOrder, true>(lds + RING_OFF, g, S, E);
        }
        if (BOTH(3)) GRID_BAR();
    }

    if (IN(4)) {
        PHASE_LANES();
        LAS float* btab = (LAS float*)(lds + SHARED_OFF);
        LAS unsigned char* vt = lds + RING_OFF + wave * ATT_WAVE_BYTES;
        if (!(args.pad & 1u))
        for (int unit = bx; unit < BATCH * NH * (SEQ / 1024); unit += G) {
            const int b = unit >> 7, h = (unit >> 3) & 15, mt = unit & 7;
            __syncthreads();
            for (int i = tid; i < 3 * 256; i += NWAVES * 64) { const int gi = i >> 8, ri = (i & 255) - 32; const int dil = gi == 0 ? 1 : (gi == 1 ? 4 : 16);
                btab[i] = (ri >= 0 && ri <= 128) ? rel_bias[t5_bucket((ri - 64) * dil) * NH + h] * LOG2E : -1e30f; }
            __syncthreads();
            for (int g = 0; g < 3; ++g) {
                if (g == 2) { VM_WAIT(); __syncthreads(); }
                for (int tk = wave; tk < 32; tk += NWAVES) attn_task(g, QKVH, O0, O1, LSE, LSE + (size_t)M * NH, MIX8, btab, vt, b, h, mt, tk, lane);
            }
        }
        if (!(args.pad & 2u))
        for (int i = bx * (NWAVES * 64) + tid; i < BATCH * (SEQ / 8) * (POOLW / 8); i += G * NWAVES * 64) {
            const int cc = i & 255, run = (i >> 8) & (SEQ / 8 - 1), b = i >> 18; const int gi = __builtin_amdgcn_readfirstlane(cc >> 6);
            const int pos0 = run * 8;
            const bf16* base = PIN + (size_t)b * SEQ * POOLW + cc * 8;
            unsigned char* obase = MIX8 + ((size_t)b * SEQ + pos0) * DM + ATTW + cc * 8;
#define POOL_RUN(HW) do { constexpr int NR = 8 + 2 * (HW) - 1; v4u w_[NR]; \
                _Pragma("unroll") for (int q = 0; q < NR; ++q) { const int pp = pos0 - (HW) + q; const int pc = pp < 0 ? 0 : (pp > SEQ - 1 ? SEQ - 1 : pp); w_[q] = *(const v4u*)(base + (size_t)pc * POOLW); } \
                _Pragma("unroll") for (int q = 0; q < NR; ++q) { const int pp = pos0 - (HW) + q; if (pp < 0 || pp >= SEQ) w_[q] = (v4u){0u, 0u, 0u, 0u}; } \
                float s_[8] = {0.f, 0.f, 0.f, 0.f, 0.f, 0.f, 0.f, 0.f}; \
                _Pragma("unroll") for (int q = 0; q < 2 * (HW) - 1; ++q) { s_[0] += bf_lo(w_[q].x); s_[1] += bf_hi(w_[q].x); s_[2] += bf_lo(w_[q].y); s_[3] += bf_hi(w_[q].y); s_[4] += bf_lo(w_[q].z); s_[5] += bf_hi(w_[q].z); s_[6] += bf_lo(w_[q].w); s_[7] += bf_hi(w_[q].w); } \
                _Pragma("unroll") for (int k = 0; k < 8; ++k) { const v4u in_ = w_[k + 2 * (HW) - 1]; \
                    s_[0] += bf_lo(in_.x); s_[1] += bf_hi(in_.x); s_[2] += bf_lo(in_.y); s_[3] += bf_hi(in_.y); s_[4] += bf_lo(in_.z); s_[5] += bf_hi(in_.z); s_[6] += bf_lo(in_.w); s_[7] += bf_hi(in_.w); \
                    const int pos = pos0 + k; const int lo_ = pos - (HW) < 0 ? 0 : pos - (HW), hi_ = pos + (HW) > SEQ ? SEQ : pos + (HW); const float inv = 1.0f / (float)(hi_ - lo_); \
                    const v4u me = w_[k + (HW)]; int lo8_ = 0, hi8_ = 0; const float i8_ = inv * P8SCALE; \
                    lo8_ = __builtin_amdgcn_cvt_pk_fp8_f32(s_[0] * i8_ - bf_lo(me.x) * P8SCALE, s_[1] * i8_ - bf_hi(me.x) * P8SCALE, lo8_, false); lo8_ = __builtin_amdgcn_cvt_pk_fp8_f32(s_[2] * i8_ - bf_lo(me.y) * P8SCALE, s_[3] * i8_ - bf_hi(me.y) * P8SCALE, lo8_, true); \
                    hi8_ = __builtin_amdgcn_cvt_pk_fp8_f32(s_[4] * i8_ - bf_lo(me.z) * P8SCALE, s_[5] * i8_ - bf_hi(me.z) * P8SCALE, hi8_, false); hi8_ = __builtin_amdgcn_cvt_pk_fp8_f32(s_[6] * i8_ - bf_lo(me.w) * P8SCALE, s_[7] * i8_ - bf_hi(me.w) * P8SCALE, hi8_, true); \
                    *(v2u*)(obase + (size_t)k * DM) = (v2u){(unsigned)lo8_, (unsigned)hi8_}; \
                    const v4u out_ = w_[k]; \
                    s_[0] -= bf_lo(out_.x); s_[1] -= bf_hi(out_.x); s_[2] -= bf_lo(out_.y); s_[3] -= bf_hi(out_.y); s_[4] -= bf_lo(out_.z); s_[5] -= bf_hi(out_.z); s_[6] -= bf_lo(out_.w); s_[7] -= bf_hi(out_.w); } } while (0)
            if (gi == 0) POOL_RUN(1); else if (gi == 1) POOL_RUN(2); else if (gi == 2) POOL_RUN(4); else POOL_RUN(8);
#undef POOL_RUN
        }
        if (BOTH(4)) GRID_BAR();
    }

    if (IN(5)) {
        PHASE_LANES();
        pg8::Gemm g{(const bf16*)MIX8, (const bf16*)WOUT8, M, DM, DM / 2, DM / 2, DM / 2, 1 << 30, 0, 1 << 30, 0}; pg8::StaticOrder S; S.init(M, DM, G, bx);
        pg8::EpiResBf16 E{x, MODV + (size_t)(2 * 2) * DM, X1B, DM, 1.0f / (A8SCALE * WO8SCALE)};
        pg8::gemm_phase<pg8::EpiResBf16, pg8::StaticOrder, true, true>(lds + RING_OFF, g, S, E);
        if (BOTH(5)) GRID_BAR();
    }

    if (IN(6)) {
        PHASE_LANES();
        for (int row = gw; row < M; row += NGW) {
            const int b = row / SEQ;
            const v2u* xr = (const v2u*)(X1B + (size_t)row * DM) + lane;
            f32x4 v[16]; float ss = 0.f;
#pragma unroll
            for (int j = 0; j < 16; ++j) { const v2u xw = xr[64 * j]; v[j] = (f32x4){bf_lo(xw.x), bf_hi(xw.x), bf_lo(xw.y), bf_hi(xw.y)}; ss += (v[j][0] * v[j][0] + v[j][1] * v[j][1]) + (v[j][2] * v[j][2] + v[j][3] * v[j][3]); }
            const float rstd = 1.0f / sqrtf(wave_sum(ss) * (1.0f / DM) + RMS_EPS);
            const f32x4* gp = (const f32x4*)g_ffn + lane; const f32x4* shp = (const f32x4*)(MODV + (size_t)(3 * 2 + b) * DM) + lane; const f32x4* scp = (const f32x4*)(MODV + (size_t)(4 * 2 + b) * DM) + lane;
            v2u* op = (v2u*)(H + (size_t)row * DM) + lane; unsigned* op8 = (unsigned*)(H8 + (size_t)row * DM) + lane;
            float ymx = 0.f;
#pragma unroll
            for (int j = 0; j < 16; ++j) { const f32x4 g4 = gp[64 * j], sh = shp[64 * j], sc = scp[64 * j];
                const f32x4 y = (v[j] * rstd) * g4 * (sc + 1.0f) + sh; v[j] = y;
                ymx = fmaxf(ymx, fmaxf(fmaxf(fabsf(y[0]), fabsf(y[1])), fmaxf(fabsf(y[2]), fabsf(y[3]))));
                v2u w; w.x = cvt_pk_bf16(y[0], y[1]); w.y = cvt_pk_bf16(y[2], y[3]); op[64 * j] = w; }
#pragma unroll
            for (int o = 1; o < 64; o <<= 1) ymx = fmaxf(ymx, __shfl_xor(ymx, o));
            ymx = fmaxf(ymx, 1e-20f);
            const float qs = 127.0f / ymx;
#pragma unroll
            for (int j = 0; j < 16; ++j) op8[64 * j] = q8x4(v[j], qs);
            if (lane == 0) TSC[row] = ymx * (1.0f / 127.0f);
        }
        if (BOTH(6)) GRID_BAR();
    }

    if (IN(7)) {
        PHASE_LANES();
        pg8::Gemm g{H, WQST, M, PQ, DM, DM, DM, 1 << 30, 0, 1 << 30, 0}; pg8::StaticOrder S; S.init(M, PQ, G, bx);
        pg8::EpiF32 E{SC, PQ};
        pg8::gemm_phase<pg8::EpiF32, pg8::StaticOrder, true>(lds + RING_OFF, g, S, E);
        if (BOTH(7)) GRID_BAR();
    }

    if (IN(8)) {
        PHASE_LANES();
        LAS unsigned short* EXPW = (LAS unsigned short*)(lds + RING_OFF);
        LAS float* GACT = (LAS float*)(lds + RING_OFF + 16384);
        LAS unsigned* W = (LAS unsigned*)(lds + RING_OFF + 49152 + wave * 4096);
        LAS unsigned* K1 = W; LAS unsigned* K2 = W + 128;
        LAS float* TV1 = (LAS float*)(W + 256); LAS int* TI1 = (LAS int*)(W + 272); LAS float* TV2 = (LAS float*)(W + 288); LAS int* TI2 = (LAS int*)(W + 304);
        LAS unsigned* CK = W + 320; LAS float* SV = (LAS float*)(W + 384); LAS int* SE = (LAS int*)(W + 400);
        const int c8 = lane & 7, r8 = lane >> 3;
        for (int blk = vcu; blk < M / 64; blk += G) {
            const int tok0 = blk * 64; const int b = tok0 / SEQ;
            for (int j = 0; j < 8; ++j) {
                const int tl = wave * 8 + j; const int t = tok0 + tl;
#ifndef TOPK_REP
#define TOPK_REP 1
#endif
                for (int hh = 0; hh < 8 * TOPK_REP; ++hh) { const int h = hh & 7;
                    const float* sp = SC + (size_t)t * PQ + h * 256;
                    const float a0 = sp[lane], a1 = sp[64 + lane], b0 = sp[128 + lane], b1 = sp[192 + lane];
                    unsigned ka0 = (fkey(a0) & ~127u) | (unsigned)(127 - lane), ka1 = (fkey(a1) & ~127u) | (unsigned)(63 - lane);
                    unsigned kb0 = (fkey(b0) & ~127u) | (unsigned)(127 - lane), kb1 = (fkey(b1) & ~127u) | (unsigned)(63 - lane);
                    bitonic128x2(ka0, ka1, kb0, kb1, lane);
                    if (lane >= 56) { K1[127 - 2 * lane] = ka0; K1[126 - 2 * lane] = ka1; K2[127 - 2 * lane] = kb0; K2[126 - 2 * lane] = kb1; }
                    LDS_WAIT();
                    const int ci_i = CAND_I[lane], ci_j = CAND_J[lane];
                    const unsigned kA = K1[ci_i], kB = K2[ci_j];
                    const float cv = fdec(kA) + fdec(kB);
                    const unsigned ck = lane < 50 ? ((fkey(cv) & ~255u) | (unsigned)(255 - (ci_i * 16 + ci_j))) : 0u;
                    CK[lane] = ck;
                    LDS_WAIT();
                    int rc = 0;
#pragma unroll 8
                    for (int kk = 0; kk < 16; ++kk) { const v4u q = ((const LAS v4u*)CK)[kk]; rc += (q.x > ck) + (q.y > ck) + (q.z > ck) + (q.w > ck); }
                    if (lane < 50 && rc < 16) { SV[rc] = cv; SE[rc] = (int)((127u - (kA & 127u)) * 128u + (127u - (kB & 127u))); }
                    LDS_WAIT();
                    const float top0 = SV[0], myv = SV[lane & 15]; const int mye = SE[lane & 15];
                    const float e = __expf(myv - top0);
                    float ssum = e; ssum += __shfl_xor(ssum, 1); ssum += __shfl_xor(ssum, 2); ssum += __shfl_xor(ssum, 4); ssum += __shfl_xor(ssum, 8);
                    if (lane < 16) { EXPW[tl * 128 + h * 16 + lane] = (unsigned short)mye; GACT[tl * 128 + h * 16 + lane] = e / ssum; }
                    LDS_WAIT();
                }
            }
            LAS float* ACC = (LAS float*)(lds + RING_OFF + 81920);
            for (int i = lane; i < 8 * 128; i += 64) ACC[wave * 1024 + i] = 0.f;
            LDS_WAIT();
            {
                v4u gn[16]; v4u hna;
#define P10_LOADU(idx) do { const int s_ = (idx) >> 3, j_ = (idx) & 7; const int tl_ = wave * 8 + j_; \
                    const unsigned char* tb_ = UB + (size_t)s_ * NEXP * 128 + 16 * c8; \
                    hna = *(const v4u*)(H8 + (size_t)(tok0 + tl_) * DM + 128 * s_ + 16 * c8); \
                    _Pragma("unroll") for (int i = 0; i < 16; ++i) { const unsigned e_ = EXPW[tl_ * 128 + r8 + 8 * i]; gn[i] = *(const v4u*)(tb_ + (size_t)e_ * 128); } } while (0)
                P10_LOADU(0);
#pragma unroll 1
                for (int idx = 0; idx < 256; ++idx) {
                    v4u g[16]; const v4u ha = hna;
#pragma unroll
                    for (int i = 0; i < 16; ++i) g[i] = gn[i];
                    if (idx + 1 < 256) P10_LOADU(idx + 1);
                    const int tl = wave * 8 + (idx & 7);
                    float p[16];
#pragma unroll
                    for (int i = 0; i < 16; ++i) { int a_ = 0;
                        a_ = __builtin_amdgcn_sdot4((int)g[i].x, (int)ha.x, a_, false); a_ = __builtin_amdgcn_sdot4((int)g[i].y, (int)ha.y, a_, false);
                        a_ = __builtin_amdgcn_sdot4((int)g[i].z, (int)ha.z, a_, false); a_ = __builtin_amdgcn_sdot4((int)g[i].w, (int)ha.w, a_, false); p[i] = (float)a_; }
                    float q8[8], q4[4], q2[2];
#pragma unroll
                    for (int m = 0; m < 8; ++m) { const float snd = (c8 & 4) ? p[m] : p[m + 8], kp = (c8 & 4) ? p[m + 8] : p[m]; q8[m] = kp + __shfl_xor(snd, 4); }
#pragma unroll
                    for (int m = 0; m < 4; ++m) { const float snd = (c8 & 2) ? q8[m] : q8[m + 4], kp = (c8 & 2) ? q8[m + 4] : q8[m]; q4[m] = kp + __shfl_xor(snd, 2); }
#pragma unroll
                    for (int m = 0; m < 2; ++m) { const float snd = (c8 & 1) ? q4[m] : q4[m + 2], kp = (c8 & 1) ? q4[m + 2] : q4[m]; q2[m] = kp + __shfl_xor(snd, 1); }
                    LAS float* ap = ACC + tl * 128 + r8 + 16 * c8;
                    ap[0] += q2[0]; ap[8] += q2[1];
                }
#undef P10_LOADU
            }
            LDS_WAIT();
            for (int i = lane; i < 8 * 128; i += 64) { const int o_ = wave * 1024 + i; const unsigned e = EXPW[o_];
                const float a = ACC[o_] * SCL[e] * TSC[tok0 + (o_ >> 7)]; GACT[o_] = gelu_tanh(a) * GACT[o_] * SCL[NEXP + e]; }
            LDS_WAIT();
            LAS float* SSQ = ACC;
            for (int j = 0; j < 8; ++j) SSQ[(wave * 8 + j) * 128 + lane] = 0.f;
            LDS_WAIT();
            const float* gtp = MODV + (size_t)(5 * 2 + b) * DM;
            {
                v4u gn[16]; float avn[16];
#define P10_LOADV(idx) do { const int s_ = (idx) >> 3, j_ = (idx) & 7; const int tl_ = wave * 8 + j_; \
                    const unsigned char* tb_ = VB + (size_t)s_ * NEXP * 128 + 16 * c8; \
                    _Pragma("unroll") for (int i = 0; i < 16; ++i) { const int k_ = tl_ * 128 + r8 + 8 * i; const unsigned e_ = EXPW[k_]; avn[i] = GACT[k_]; gn[i] = *(const v4u*)(tb_ + (size_t)e_ * 128); } } while (0)
                P10_LOADV(0);
#pragma unroll 1
                for (int idx = 0; idx < 256; ++idx) {
                    v4u g[16]; float av[16];
#pragma unroll
                    for (int i = 0; i < 16; ++i) { g[i] = gn[i]; av[i] = avn[i]; }
                    if (idx + 1 < 256) P10_LOADV(idx + 1);
                    const int s_c = idx >> 3; const int tl = wave * 8 + (idx & 7); const int t = tok0 + tl;
                    const int d = 128 * s_c + 16 * c8 + 2 * r8;
                    const unsigned xw = __builtin_nontemporal_load((const unsigned*)(X1B + (size_t)t * DM + d)); const f32x2 gv = *(const f32x2*)(gtp + d);
                    const float ssq_old = SSQ[tl * 128 + lane];
                    f32x2 o8[8];
#pragma unroll
                    for (int q = 0; q < 8; ++q) o8[q] = (f32x2){0.f, 0.f};
#pragma unroll
                    for (int i = 0; i < 16; ++i)
#pragma unroll
                        for (int q = 0; q < 4; ++q) { o8[2 * q] += __builtin_amdgcn_cvt_pk_f32_fp8((int)g[i][q], false) * av[i]; o8[2 * q + 1] += __builtin_amdgcn_cvt_pk_f32_fp8((int)g[i][q], true) * av[i]; }
                    float p[16], q8[8], q4[4], q2[2];
#pragma unroll
                    for (int q = 0; q < 8; ++q) { p[2 * q] = o8[q].x; p[2 * q + 1] = o8[q].y; }
#pragma unroll
                    for (int m = 0; m < 8; ++m) { const float snd = (r8 & 4) ? p[m] : p[m + 8], kp = (r8 & 4) ? p[m + 8] : p[m]; q8[m] = kp + __shfl_xor(snd, 32); }
#pragma unroll
                    for (int m = 0; m < 4; ++m) { const float snd = (r8 & 2) ? q8[m] : q8[m + 4], kp = (r8 & 2) ? q8[m + 4] : q8[m]; q4[m] = kp + __shfl_xor(snd, 16); }
#pragma unroll
                    for (int m = 0; m < 2; ++m) { const float snd = (r8 & 1) ? q4[m] : q4[m + 2], kp = (r8 & 1) ? q4[m + 2] : q4[m]; q2[m] = kp + __shfl_xor(snd, 8); }
                    f32x2 y; y.x = bf_lo(xw) + gv.x * q2[0]; y.y = bf_hi(xw) + gv.y * q2[1];
                    __builtin_nontemporal_store(cvt_pk_bf16(y.x, y.y), (unsigned*)(YB + (size_t)t * DM + d));
                    SSQ[tl * 128 + lane] = ssq_old + (y.x * y.x + y.y * y.y);
                }
#undef P10_LOADV
            }
            VM_WAIT(); LDS_WAIT();
            __builtin_amdgcn_fence(__ATOMIC_ACQUIRE, "agent");
            VM_WAIT();
            for (int j = 0; j < 8; ++j) {
                const int tl = wave * 8 + j; const int t = tok0 + tl;
                const float rstd = 1.0f / sqrtf(wave_sum(SSQ[tl * 128 + lane]) * (1.0f / DM) + RMS_EPS);
                f32x4* op = (f32x4*)(out + (size_t)t * DM) + lane; const f32x4* gp = (const f32x4*)g_final + lane; const v2u* yp = (const v2u*)(YB + (size_t)t * DM) + lane;
#pragma unroll 4
                for (int i = 0; i < 16; ++i) { const v2u yw = __builtin_nontemporal_load(yp + 64 * i); const f32x4 y = {bf_lo(yw.x), bf_hi(yw.x), bf_lo(yw.y), bf_hi(yw.y)}; __builtin_nontemporal_store(y * rstd * gp[64 * i], op + 64 * i); }
            }
            LDS_WAIT();
        }
    }
#undef IN
#undef BOTH
#undef GRID_BAR
}

extern "C" void kernel_launch(void* const* d_in, const int* in_sizes, int n_in, void* d_out, int out_size, void* d_ws, size_t ws_size, hipStream_t stream) {
    static int grid = 0;
    if (grid == 0) {
        if (n_in != 16 || in_sizes[0] != M * DM || out_size != M * DM || ws_size < WS_END) {
            fprintf(stderr, "kernel_launch: shape/workspace mismatch: n_in %d in0 %d out %d ws %zu (need %zu)\n", n_in, n_in > 0 ? in_sizes[0] : -1, out_size, ws_size, (size_t)WS_END); grid = -1; return; }
        int dev = 0, cus = 0, per_cu = 0;
        if (hipGetDevice(&dev) != hipSuccess || hipDeviceGetAttribute(&cus, hipDeviceAttributeMultiprocessorCount, dev) != hipSuccess) { grid = -1; return; }
        if (hipFuncSetAttribute((const void*)fwd_kernel, hipFuncAttributeMaxDynamicSharedMemorySize, LDS_BYTES) != hipSuccess) { fprintf(stderr, "kernel_launch: hipFuncSetAttribute failed\n"); grid = -1; return; }
        if (hipOccupancyMaxActiveBlocksPerMultiprocessor(&per_cu, (const void*)fwd_kernel, NWAVES * 64, LDS_BYTES) != hipSuccess || per_cu < 1)
            fprintf(stderr, "kernel_launch: note: occupancy query reports %d workgroups per CU\n", per_cu);
        (void)hipGetLastError();
        grid = cus;
    }
    if (grid < 0) return;
    if (hipMemsetAsync((char*)d_ws + WS_CTL, 0, CTL_ZERO_BYTES, stream) != hipSuccess) { fprintf(stderr, "kernel_launch: memset failed\n"); return; }
    Args a{};
    for (int i = 0; i < 16; ++i) a.in[i] = (const float*)d_in[i];
    a.out = (float*)d_out; a.ws = (unsigned char*)d_ws;
#ifdef PROBE_MASK
    {
#ifndef PROBE_PAD
#define PROBE_PAD 0
#endif
        a.mask = PROBE_MASK; a.pad = PROBE_PAD;
        hipLaunchKernelGGL(fwd_kernel, dim3(grid), dim3(NWAVES * 64), LDS_BYTES, stream, a);
        (void)hipMemsetAsync((char*)d_ws + WS_CTL, 0, CTL_ZERO_BYTES, stream);
    }
#endif
    for (int li = 0; li < MK_N_LAUNCHES; ++li) {
        a.mask = (MK_N_LAUNCHES == PER_PHASE) ? (1u << li) : ((1u << PER_PHASE) - 1u); a.pad = 0;
        hipLaunchKernelGGL(fwd_kernel, dim3(grid), dim3(NWAVES * 64), LDS_BYTES, stream, a);
        const hipError_t le = hipPeekAtLastError();
        if (le != hipSuccess) { fprintf(stderr, "kernel_launch: launch %d failed: %s\n", li, hipGetErrorName(le)); break; }
    }
}
```

```cpp
#include <hip/hip_runtime.h>
#include <cstdio>
#include <cstdint>

#ifndef MK_N_LAUNCHES
#define MK_N_LAUNCHES 1
#endif

#define GAS __attribute__((address_space(1)))
#define LAS __attribute__((address_space(3)))
typedef unsigned short bf16;
typedef unsigned v4u __attribute__((ext_vector_type(4)));
typedef unsigned v2u __attribute__((ext_vector_type(2)));
typedef float f32x4 __attribute__((ext_vector_type(4)));
typedef float f32x2 __attribute__((ext_vector_type(2)));
typedef float f32x16 __attribute__((ext_vector_type(16)));
typedef short bf16x8 __attribute__((ext_vector_type(8)));
typedef short s16x4 __attribute__((ext_vector_type(4)));
typedef __bf16 bf2_t __attribute__((ext_vector_type(2)));

constexpr int BATCH = 2, SEQ = 8192, DM = 4096, M = BATCH * SEQ;
constexpr int NH = 16, HD = 128, ATTW = 2048, POOLW = 2048, INW = 8192;
constexpr int NMOD = 6 * DM;
constexpr int PQ = 2048;
constexpr int NEXP = 16384;
constexpr float RMS_EPS = 1e-6f;
constexpr float LOG2E = 1.4426950408889634f;
constexpr float QSCALE = 0.08838834764831845f * LOG2E;
constexpr float H8SCALE = 16.f, W8SCALE = 64.f;
constexpr float A8SCALE = 64.f, P8SCALE = 16.f, WO8SCALE = 64.f;
constexpr int KS_ADA = 64;

constexpr size_t MiB = 1u << 20;
constexpr size_t WS_CTL = 0, CTL_ZERO_BYTES = 1 * MiB;
constexpr size_t WS_MODV = 1 * MiB;
constexpr size_t WS_SCL = 2 * MiB;
constexpr size_t WS_MODP = 4 * MiB;
constexpr size_t WS_SKT = 20 * MiB;
constexpr size_t WS_PWS = 22 * MiB;
constexpr size_t WS_WQST = 24 * MiB;
constexpr size_t WS_WOUT2 = 40 * MiB;
constexpr size_t WS_WINT = 72 * MiB;
constexpr size_t WS_WIN8 = 88 * MiB;
constexpr size_t WS_H8 = 1100 * MiB;
constexpr size_t WS_UB = 136 * MiB;
constexpr size_t WS_VB = 264 * MiB;
constexpr size_t WS_H = 392 * MiB;
constexpr size_t WS_PROJ = 520 * MiB;
constexpr size_t WS_QKVH = 1292 * MiB;
constexpr size_t WS_MIXIN = 776 * MiB;
constexpr size_t WS_WOPT = 904 * MiB;
constexpr size_t WS_WQB = 936 * MiB;
constexpr size_t WS_O0 = 968 * MiB, WS_O1 = 1032 * MiB;
constexpr size_t WS_LSE = 1096 * MiB;
constexpr size_t WS_SC = 1164 * MiB;
constexpr size_t WS_END = 1484 * MiB;

constexpr int RING_OFF = 0, RING_BYTES = 131072;
constexpr int ATT_WAVE_BYTES = 17408;
constexpr int SHARED_OFF = 139264;
constexpr int LDSCTL_OFF = 139264 + 4096, MISC_OFF = LDSCTL_OFF + 320;
constexpr int LDS_BYTES = 147456;
constexpr int NWAVES = 8;
constexpr int CW_BAR = 4096;

#define LDS_WAIT() asm volatile("s_waitcnt lgkmcnt(0)" ::: "memory")
#define VM_WAIT() asm volatile("s_waitcnt vmcnt(0)" ::: "memory")

__device__ __forceinline__ unsigned cvt_pk_bf16(float lo, float hi) { unsigned r; asm volatile("v_cvt_pk_bf16_f32 %0, %1, %2" : "=v"(r) : "v"(lo), "v"(hi)); return r; }
__device__ __forceinline__ float bf_lo(unsigned u) { return __uint_as_float(u << 16); }
__device__ __forceinline__ float bf_hi(unsigned u) { return __uint_as_float(u & 0xffff0000u); }
__device__ __forceinline__ float wave_sum(float v) {
#pragma unroll
    for (int o = 1; o < 64; o <<= 1) v += __shfl_xor(v, o);
    return v;
}

namespace pg8 {
typedef unsigned short bf16_t;
typedef int v4i_t __attribute__((ext_vector_type(4)));
typedef int v8i_t __attribute__((ext_vector_type(8)));
constexpr int BM = 256, BK = 64, HALF = 128, HTB = HALF * BK * 2, STAGE_BYTES = 8 * HTB, NXCD = 8, WGM = 8;

__host__ __device__ __forceinline__ int lds_byte(int r, int c) { const int st = (r >> 4) * 2 + (c >> 5), rr = r & 15, cc = c & 31, ob = rr * 64 + cc * 2; return st * 1024 + (ob ^ (((ob >> 9) & 1) << 5)); }
__host__ __device__ __forceinline__ void stage_rc(int b, int& R, int& C) { const int st = b / 1024, sb = b % 1024, swz = sb ^ (((sb >> 9) & 1) << 5); R = (st >> 1) * 16 + swz / 64; C = (st & 1) * 32 + (swz % 64) / 2; }
__host__ __device__ __forceinline__ int perm32(int rho) { const int n = rho >> 4, i = rho & 15; return 8 * (i >> 2) + 4 * n + (i & 3); }

template <int NF> __device__ __forceinline__ void pg8_ldfrag16(bf16x8 (&dst)[NF][2], const LAS unsigned char* base, int off) {
#pragma unroll
    for (int m = 0; m < NF; ++m)
#pragma unroll
        for (int k = 0; k < 2; ++k) dst[m][k] = *(const LAS bf16x8*)(base + off + m * 2048 + k * 1024);
}
template <int NF> __device__ __forceinline__ void pg8_ldfrag8(v8i_t (&dst)[NF], const LAS unsigned char* base, int off1, int off2) {
#pragma unroll
    for (int m = 0; m < NF; ++m) { const v4i_t lo = *(const LAS v4i_t*)(base + off1 + m * 2048), hi = *(const LAS v4i_t*)(base + off2 + m * 2048); dst[m] = __builtin_shufflevector(lo, hi, 0, 1, 2, 3, 4, 5, 6, 7); }
}
__device__ __forceinline__ void pg8_mma16(f32x4 (&acc)[4][2], const bf16x8 (&At)[4][2], const bf16x8 (&Bt)[2][2]) {
#pragma unroll
    for (int m = 0; m < 4; ++m)
#pragma unroll
        for (int n = 0; n < 2; ++n)
#pragma unroll
            for (int k = 0; k < 2; ++k) acc[m][n] = __builtin_amdgcn_mfma_f32_16x16x32_bf16(Bt[n][k], At[m][k], acc[m][n], 0, 0, 0);
}
__device__ __forceinline__ void pg8_mma8(f32x4 (&acc)[4][2], const v8i_t (&At)[4], const v8i_t (&Bt)[2]) {
    int sc = 0x7F7F7F7F;
#pragma unroll
    for (int m = 0; m < 4; ++m)
#pragma unroll
        for (int n = 0; n < 2; ++n) asm volatile("v_mfma_scale_f32_16x16x128_f8f6f4 %0, %1, %2, %0, %3, %3 op_sel_hi:[0,0,0]" : "+v"(acc[m][n]) : "v"(Bt[n]), "v"(At[m]), "v"(sc));
}
struct Unit { int pm, pn; };
struct Gemm { const bf16_t* A; const bf16_t* Bt; int M, N, K, lda, ldb, agrp_div, agrp_cols, bgrp_div, bgrp_cols; };

struct StaticOrder {
    int nM, nN, nwg, G, c;
    __host__ __device__ void init(int M_, int N_, int G_, int c_) { nM = M_ / BM; nN = N_ / BM; nwg = nM * nN; G = G_; c = c_; }
    __host__ __device__ bool next(int i, Unit& u) const {
        const long L = (long)i * G + c; if (L >= nwg) return false;
        int wgid = (int)L; { const int q = nwg / NXCD, r = nwg % NXCD, xcd = wgid % NXCD, off = wgid / NXCD; wgid = (xcd < r ? xcd * (q + 1) : r * (q + 1) + (xcd - r) * q) + off; }
        const int nig = WGM * nN, gid = wgid / nig, fm = gid * WGM, gsz = (nM - fm) < WGM ? (nM - fm) : WGM;
        u.pm = fm + ((wgid % nig) % gsz); u.pn = (wgid % nig) / gsz; return true;
    }
    __device__ __forceinline__ void a_ready(const Unit&) const {}
    __device__ __forceinline__ void done(const Unit&) const {}
};

struct EpiBf16 {
    static constexpr bool PERM = true, AFTER_DRAIN = false;
    bf16_t* O; int ldc; int scale_cols; float scale0; bf16_t* HM; int hm_cols; int hm_rows; float scale1 = 1.0f;
    __device__ __forceinline__ void operator()(const f32x4 (&acc)[2][2][4][2], const Unit& u, int wr, int wc, int fr, int fq) const {
        const int row0 = u.pm * BM + wr * 64 + fr; const int colt = u.pn * BM;
        const float sc = (colt < scale_cols) ? scale0 : scale1;
        const bool hm = colt < hm_cols;
        const int cw = wc * 32 + 8 * fq;
        bf16_t* base = hm ? HM + (size_t)(colt / HALF) * hm_rows * HALF + cw : O + (colt - hm_cols) + cw;
        const size_t rpitch = hm ? (size_t)HALF : (size_t)ldc, hstep = hm ? (size_t)hm_rows * HALF : (size_t)HALF;
#pragma unroll
        for (int ai = 0; ai < 2; ++ai)
#pragma unroll
            for (int m = 0; m < 4; ++m) { bf16_t* rowp = base + (size_t)(row0 + ai * HALF + m * 16) * rpitch;
#pragma unroll
                for (int bj = 0; bj < 2; ++bj) { f32x4 v0 = acc[ai][bj][m][0] * sc, v1 = acc[ai][bj][m][1] * sc;
                    v4u w; w.x = cvt_pk_bf16(v0[0], v0[1]); w.y = cvt_pk_bf16(v0[2], v0[3]); w.z = cvt_pk_bf16(v1[0], v1[1]); w.w = cvt_pk_bf16(v1[2], v1[3]);
                    *(v4u*)(rowp + bj * hstep) = w; } }
    }
};
struct EpiBf16ColScale {
    static constexpr bool PERM = true, AFTER_DRAIN = false;
    bf16_t* O; int ldc; int coff; const float* cs;
    __device__ __forceinline__ void operator()(const f32x4 (&acc)[2][2][4][2], const Unit& u, int wr, int wc, int fr, int fq) const {
        const int row0 = u.pm * BM + wr * 64 + fr; const int col0 = u.pn * BM + wc * 32 + 8 * fq;
        f32x4 sv[2][2];
#pragma unroll
        for (int bj = 0; bj < 2; ++bj)
#pragma unroll
            for (int n = 0; n < 2; ++n) sv[bj][n] = *(const f32x4*)(cs + col0 + bj * HALF + 4 * n);
#pragma unroll
        for (int ai = 0; ai < 2; ++ai)
#pragma unroll
            for (int m = 0; m < 4; ++m) { bf16_t* rowp = O + (size_t)(row0 + ai * HALF + m * 16) * ldc + coff + col0;
#pragma unroll
                for (int bj = 0; bj < 2; ++bj) { f32x4 v0 = acc[ai][bj][m][0] * sv[bj][0], v1 = acc[ai][bj][m][1] * sv[bj][1];
                    v4u w; w.x = cvt_pk_bf16(v0[0], v0[1]); w.y = cvt_pk_bf16(v0[2], v0[3]); w.z = cvt_pk_bf16(v1[0], v1[1]); w.w = cvt_pk_bf16(v1[2], v1[3]);
                    *(v4u*)(rowp + bj * HALF) = w; } }
    }
};
struct EpiFp8 {
    static constexpr bool PERM = true, AFTER_DRAIN = false;
    unsigned char* O; int ldc; int coff; float scale;
    __device__ __forceinline__ void operator()(const f32x4 (&acc)[2][2][4][2], const Unit& u, int wr, int wc, int fr, int fq) const {
        const int row0 = u.pm * BM + wr * 64 + fr; const int col0 = u.pn * BM + wc * 32 + 8 * fq;
#pragma unroll
        for (int ai = 0; ai < 2; ++ai)
#pragma unroll
            for (int m = 0; m < 4; ++m) { unsigned char* rowp = O + (size_t)(row0 + ai * HALF + m * 16) * ldc + coff + col0;
#pragma unroll
                for (int bj = 0; bj < 2; ++bj) { const f32x4 v0 = acc[ai][bj][m][0] * scale, v1 = acc[ai][bj][m][1] * scale; int lo = 0, hi = 0;
                    lo = __builtin_amdgcn_cvt_pk_fp8_f32(v0[0], v0[1], lo, false); lo = __builtin_amdgcn_cvt_pk_fp8_f32(v0[2], v0[3], lo, true);
                    hi = __builtin_amdgcn_cvt_pk_fp8_f32(v1[0], v1[1], hi, false); hi = __builtin_amdgcn_cvt_pk_fp8_f32(v1[2], v1[3], hi, true);
                    *(v2u*)(rowp + bj * HALF) = (v2u){(unsigned)lo, (unsigned)hi}; } }
    }
};
struct EpiResBf16 {
    static constexpr bool PERM = true, AFTER_DRAIN = false;
    const float* X; const float* gate; bf16_t* O; int ldc; float ascale;
    __device__ __forceinline__ void operator()(const f32x4 (&acc)[2][2][4][2], const Unit& u, int wr, int wc, int fr, int fq) const {
        const int row0 = u.pm * BM + wr * 64 + fr; const int col0 = u.pn * BM + wc * 32 + 8 * fq; const int b = (u.pm * BM) / SEQ;
        f32x4 gv[2][2];
#pragma unroll
        for (int bj = 0; bj < 2; ++bj)
#pragma unroll
            for (int n = 0; n < 2; ++n) gv[bj][n] = *(const f32x4*)(gate + (size_t)b * DM + col0 + bj * HALF + 4 * n) * ascale;
#pragma unroll
        for (int ai = 0; ai < 2; ++ai)
#pragma unroll
            for (int m = 0; m < 4; ++m) { const size_t off = (size_t)(row0 + ai * HALF + m * 16) * ldc + col0;
#pragma unroll
                for (int bj = 0; bj < 2; ++bj) { const f32x4 x0 = *(const f32x4*)(X + off + bj * HALF), x1 = *(const f32x4*)(X + off + bj * HALF + 4);
                    const f32x4 v0 = x0 + gv[bj][0] * acc[ai][bj][m][0], v1 = x1 + gv[bj][1] * acc[ai][bj][m][1];
                    v4u w; w.x = cvt_pk_bf16(v0[0], v0[1]); w.y = cvt_pk_bf16(v0[2], v0[3]); w.z = cvt_pk_bf16(v1[0], v1[1]); w.w = cvt_pk_bf16(v1[2], v1[3]);
                    *(v4u*)(O + off + bj * HALF) = w; } }
    }
};
struct EpiResF32 {
    static constexpr bool PERM = false, AFTER_DRAIN = false;
    const float* X; const float* gate; float* O; int ldc;
    __device__ __forceinline__ void operator()(const f32x4 (&acc)[2][2][4][2], const Unit& u, int wr, int wc, int fr, int fq) const {
        const int row0 = u.pm * BM + wr * 64 + fr; const int col0 = u.pn * BM + wc * 32 + 4 * fq; const int b = (u.pm * BM) / SEQ;
        f32x4 gv[2][2];
#pragma unroll
        for (int bj = 0; bj < 2; ++bj)
#pragma unroll
            for (int n = 0; n < 2; ++n) gv[bj][n] = *(const f32x4*)(gate + (size_t)b * DM + col0 + bj * HALF + n * 16);
#pragma unroll
        for (int ai = 0; ai < 2; ++ai)
#pragma unroll
            for (int m = 0; m < 4; ++m) { const size_t off = (size_t)(row0 + ai * HALF + m * 16) * ldc + col0;
#pragma unroll
                for (int bj = 0; bj < 2; ++bj)
#pragma unroll
                    for (int n = 0; n < 2; ++n) { const f32x4 xv = *(const f32x4*)(X + off + bj * HALF + n * 16);
                        *(f32x4*)(O + off + bj * HALF + n * 16) = xv + gv[bj][n] * acc[ai][bj][m][n]; } }
    }
};
struct EpiF32 {
    static constexpr bool PERM = false, AFTER_DRAIN = false;
    float* O; int ldc;
    __device__ __forceinline__ void operator()(const f32x4 (&acc)[2][2][4][2], const Unit& u, int wr, int wc, int fr, int fq) const {
        const int row0 = u.pm * BM + wr * 64 + fr; const int col0 = u.pn * BM + wc * 32 + 4 * fq;
#pragma unroll
        for (int ai = 0; ai < 2; ++ai)
#pragma unroll
            for (int m = 0; m < 4; ++m) { const size_t off = (size_t)(row0 + ai * HALF + m * 16) * ldc + col0;
#pragma unroll
                for (int bj = 0; bj < 2; ++bj)
#pragma unroll
                    for (int n = 0; n < 2; ++n) *(f32x4*)(O + off + bj * HALF + n * 16) = acc[ai][bj][m][n]; }
    }
};

template <class Epi, class Sched, bool ALIGN_EPI, bool FP8 = false>
__device__ __forceinline__ void gemm_phase(LAS unsigned char* lds, const Gemm g, const Sched& S, const Epi& E) {
    int tid_ = threadIdx.x; asm volatile("" : "+v"(tid_));
    const int tid = tid_, wid = __builtin_amdgcn_readfirstlane(tid >> 6), lane = tid & 63, wr = wid >> 2, wc = wid & 3, fr = lane & 15, fq = lane >> 4;
    const int K = g.K, nt = K / BK;
    unsigned voffA, voffB;
    { int R, C; stage_rc(tid * 16, R, C); const int Rb = Epi::PERM ? ((R & ~31) + perm32(R & 31)) : R;
      voffA = (unsigned)(R * g.lda + C) * 2u; voffB = (unsigned)(Rb * g.ldb + C) * 2u; }
    const size_t pstepA = (size_t)64 * g.lda * 2, pstepB = (size_t)64 * g.ldb * 2;
    const size_t kstep = (size_t)(BK * 2);
    const size_t hstepA = (size_t)HALF * g.lda * 2, hstepB = (size_t)HALF * g.ldb * 2;
    const size_t tstepA = 2 * hstepA, tstepB = 2 * hstepB;
    const unsigned ldsw = (unsigned)wid * 1024u;
    const int aoff = lds_byte(wr * 64 + fr, fq * 8), boff = lds_byte(wc * 32 + fr, fq * 8);
    const int h8 = (fq >> 1) & 1;
    const int aoff1 = lds_byte(wr * 64 + fr, fq * 16 + h8 * 8), aoff2 = lds_byte(wr * 64 + fr, fq * 16 + (1 - h8) * 8);
    const int boff1 = lds_byte(wc * 32 + fr, fq * 16 + h8 * 8), boff2 = lds_byte(wc * 32 + fr, fq * 16 + (1 - h8) * 8);
#define PG8_SA(b, h) (((b) * 2 + (h)) * HTB)
#define PG8_SB(b, h) ((4 + (b) * 2 + (h)) * HTB)
#define PG8_STAGE(bufoff, gbase, voff) do { _Pragma("unroll") for (int _i = 0; _i < 2; ++_i) \
        __builtin_amdgcn_global_load_lds((const unsigned*)((const char*)(gbase) + (size_t)_i * pstep_##voff + (voff)), (LAS unsigned*)(lds + (bufoff) + ldsw + _i * 8192), 16, 0, 0); } while (0)
#define pstep_voffA pstepA
#define pstep_voffB pstepB
#define PG8_LDA(dst, b, h) do { if constexpr (FP8) pg8_ldfrag8<4>(dst##8, lds + PG8_SA(b, h), aoff1, aoff2); else pg8_ldfrag16<4>(dst, lds + PG8_SA(b, h), aoff); } while (0)
#define PG8_LDB(dst, b, h) do { if constexpr (FP8) pg8_ldfrag8<2>(dst##8, lds + PG8_SB(b, h), boff1, boff2); else pg8_ldfrag16<2>(dst, lds + PG8_SB(b, h), boff); } while (0)
#define PG8_MMA(ai, bj, At, Bt) do { __builtin_amdgcn_s_setprio(1); if constexpr (FP8) pg8_mma8(acc[ai][bj], At##8, Bt##8); else pg8_mma16(acc[ai][bj], At, Bt); __builtin_amdgcn_s_setprio(0); } while (0)
#define PG8_WAIT_V(n) asm volatile("s_waitcnt vmcnt(" #n ")" ::: "memory")
#define PG8_WAIT_L(n) asm volatile("s_waitcnt lgkmcnt(" #n ")" ::: "memory")
#define PG8_BAR __builtin_amdgcn_s_barrier()
#define PG8_SCHED __builtin_amdgcn_sched_barrier(0)
#define PG8_ABASE(u) ((const char*)g.A + (size_t)(u).pm * tstepA + (size_t)((u).pn / g.agrp_div) * (size_t)g.agrp_cols * 2)
#define PG8_BBASE(u) ((const char*)g.Bt + (size_t)(u).pn * tstepB + (size_t)((u).pm / g.bgrp_div) * (size_t)g.bgrp_cols * 2)
    Unit cur, nxt; int ui = 0;
    if (!S.next(0, cur)) return;
    f32x4 acc[2][2][4][2];
#pragma unroll
    for (int a = 0; a < 2; ++a)
#pragma unroll
        for (int b = 0; b < 2; ++b)
#pragma unroll
            for (int m = 0; m < 4; ++m)
#pragma unroll
                for (int n = 0; n < 2; ++n) acc[a][b][m][n] = (f32x4){0.f, 0.f, 0.f, 0.f};
    bf16x8 At[4][2], B0[2][2], B1[2][2]; v8i_t At8[4], B08[2], B18[2];
    const char* cA = PG8_ABASE(cur); const char* cB = PG8_BBASE(cur);
    S.a_ready(cur);
    PG8_STAGE(PG8_SB(0, 0), cB, voffB); PG8_STAGE(PG8_SB(0, 1), cB + hstepB, voffB); PG8_STAGE(PG8_SA(0, 0), cA, voffA); PG8_STAGE(PG8_SA(0, 1), cA + hstepA, voffA);
    if (wr == 1) PG8_BAR;
    PG8_WAIT_V(2); PG8_BAR;
    PG8_STAGE(PG8_SB(1, 0), cB + kstep, voffB); PG8_STAGE(PG8_SA(1, 0), cA + kstep, voffA); PG8_STAGE(PG8_SB(1, 1), cB + hstepB + kstep, voffB);
    PG8_WAIT_V(6); PG8_BAR;
    for (;;) {
        const bool has_next = S.next(ui + 1, nxt);
        const char* nA = has_next ? PG8_ABASE(nxt) : cA; const char* nB = has_next ? PG8_BBASE(nxt) : cB;
        for (int t = 0; t < nt; t += 2) {
            const bool last = (t == nt - 2);
            const char* a1 = cA + (size_t)(t + 1) * kstep;
            const char* a2 = last ? nA : cA + (size_t)(t + 2) * kstep; const char* b2 = last ? nB : cB + (size_t)(t + 2) * kstep;
            const char* a3 = a2 + kstep; const char* b3 = b2 + kstep;
            if (last && has_next) S.a_ready(nxt);
            PG8_LDB(B0, 0, 0); PG8_LDB(B1, 0, 1); PG8_SCHED; PG8_LDA(At, 0, 0); PG8_STAGE(PG8_SA(1, 1), a1 + hstepA, voffA);
            PG8_WAIT_V(8); PG8_WAIT_L(0); PG8_BAR; PG8_MMA(0, 0, At, B0); PG8_MMA(0, 1, At, B1); PG8_BAR; PG8_SCHED;
            PG8_LDA(At, 0, 1); PG8_STAGE(PG8_SB(0, 0), b2, voffB); PG8_STAGE(PG8_SB(0, 1), b2 + hstepB, voffB); PG8_STAGE(PG8_SA(0, 0), a2, voffA);
            PG8_WAIT_V(8); PG8_WAIT_L(0); PG8_BAR; PG8_MMA(1, 0, At, B0); PG8_MMA(1, 1, At, B1); PG8_BAR; PG8_SCHED;
            PG8_LDB(B0, 1, 0); PG8_LDB(B1, 1, 1); PG8_SCHED; PG8_LDA(At, 1, 0); PG8_STAGE(PG8_SA(0, 1), a2 + hstepA, voffA);
            PG8_WAIT_V(8); PG8_WAIT_L(0); PG8_BAR; PG8_MMA(0, 0, At, B0); PG8_MMA(0, 1, At, B1); PG8_BAR; PG8_SCHED;
            PG8_LDA(At, 1, 1); PG8_STAGE(PG8_SB(1, 0), b3, voffB); PG8_STAGE(PG8_SB(1, 1), b3 + hstepB, voffB); PG8_STAGE(PG8_SA(1, 0), a3, voffA);
            PG8_WAIT_V(8); PG8_WAIT_L(0); PG8_BAR; PG8_MMA(1, 0, At, B0); PG8_MMA(1, 1, At, B1); PG8_BAR; PG8_SCHED;
        }
        if constexpr (ALIGN_EPI) { if (wr == 0) PG8_BAR; }
        if constexpr (FP8) asm volatile("s_nop 15\n\ts_nop 15" ::: "memory");
        if constexpr (FP8) { int ln_ = lane; asm volatile("" : "+v"(ln_));
          E(acc, cur, wr, wc, ln_ & 15, ln_ >> 4); } else E(acc, cur, wr, wc, fr, fq);
        S.done(cur);
        if (!has_next) break;
#pragma unroll
        for (int a = 0; a < 2; ++a)
#pragma unroll
            for (int b = 0; b < 2; ++b)
#pragma unroll
                for (int m = 0; m < 4; ++m)
#pragma unroll
                    for (int n = 0; n < 2; ++n) acc[a][b][m][n] = (f32x4){0.f, 0.f, 0.f, 0.f};
        cur = nxt; cA = nA; cB = nB; ++ui;
        if constexpr (ALIGN_EPI) { if (wr == 1) PG8_BAR; }
    }
    PG8_WAIT_V(0);
    if constexpr (!ALIGN_EPI) { if (wr == 0) PG8_BAR; }
    PG8_BAR;
#undef PG8_SA
#undef PG8_SB
#undef PG8_STAGE
#undef pstep_voffA
#undef pstep_voffB
#undef PG8_LDA
#undef PG8_LDB
#undef PG8_MMA
#undef PG8_WAIT_V
#undef PG8_WAIT_L
#undef PG8_BAR
#undef PG8_SCHED
#undef PG8_ABASE
#undef PG8_BBASE
}
}

#define XB_TMO      128
#define XB_XCNT(j)  (256  + 64 * (j))
#define XB_XSUB(j)  (1280 + 64 * (j))
#define XB_XGEN(j)  (2304 + 64 * (j))
#define XB_TOP      3328
#define XB_TOPGEN   3392
#define XCD_BAR_WORDS 3456
#define XB_SPIN_CAP (1u << 18)

__device__ __forceinline__ unsigned xb_ld(unsigned* p)              { return __hip_atomic_load(p, __ATOMIC_RELAXED, __HIP_MEMORY_SCOPE_AGENT); }
__device__ __forceinline__ unsigned xb_add(unsigned* p, unsigned v) { return __hip_atomic_fetch_add(p, v, __ATOMIC_RELAXED, __HIP_MEMORY_SCOPE_AGENT); }
__device__ __forceinline__ unsigned xb_xcc_id() { return (unsigned)__builtin_amdgcn_s_getreg((3 << 11) | 20) & 0xFu; }
#define XB_SPIN(cond, bar) do { unsigned _sp = 0; while (cond) { __builtin_amdgcn_s_sleep(1); \
    if ((++_sp & 255u) == 0u) { if (xb_ld(&(bar)[XB_TMO])) break; if (_sp > XB_SPIN_CAP) { atomicAdd(&(bar)[XB_TMO], 1u); break; } } } } while (0)

struct XcdBarrier { unsigned* bar; unsigned x; volatile LAS unsigned* st; };

__device__ __forceinline__ XcdBarrier xcd_barrier_post(unsigned* bar, volatile LAS unsigned* st) {
    XcdBarrier b; b.bar = bar; b.x = xb_xcc_id(); b.st = st;
    if (threadIdx.x == 0) (void)xb_add(&bar[XB_XCNT(b.x)], 1u);
    return b;
}
__device__ __forceinline__ void xcd_barrier_complete(unsigned* bar, unsigned x, unsigned& nloc, unsigned& nx) {
    const unsigned G = gridDim.x * gridDim.y * gridDim.z;
    unsigned sum, cnt, mine, sp = 0u;
    for (;;) {
        sum = 0u; cnt = 0u; mine = 0u;
#pragma unroll
        for (unsigned j = 0; j < 16; ++j) { const unsigned c = xb_ld(&bar[XB_XCNT(j)]); sum += c; cnt += (c > 0u) ? 1u : 0u; mine = (j == x) ? c : mine; }
        if (sum == G) break;
        __builtin_amdgcn_s_sleep(1);
        if ((++sp & 255u) == 0u) { if (xb_ld(&bar[XB_TMO])) break; if (sp > XB_SPIN_CAP) { atomicAdd(&bar[XB_TMO], 1u); break; } }
    }
    nloc = mine > 0u ? mine : 1u; nx = cnt > 0u ? cnt : 1u;
}
__device__ __forceinline__ void xcd_barrier(const XcdBarrier& b) {
    asm volatile("s_waitcnt vmcnt(0)" ::: "memory");
    __syncthreads();
    if (threadIdx.x == 0) {
        unsigned* bar = b.bar;
        __builtin_amdgcn_s_waitcnt(0);
        unsigned nloc = b.st[0], nx = b.st[1];
        if (nloc == 0u) { xcd_barrier_complete(bar, b.x, nloc, nx); b.st[0] = nloc; b.st[1] = nx; }
        const unsigned old = xb_add(&bar[XB_XSUB(b.x)], 1u);
        const unsigned gen = old / nloc;
        if (old + 1u == (gen + 1u) * nloc) {
            __builtin_amdgcn_fence(__ATOMIC_RELEASE, "agent");
            asm volatile("s_waitcnt vmcnt(0)" ::: "memory");
            const unsigned og = xb_add(&bar[XB_TOP], 1u);
            const unsigned tg = og / nx;
            if (og + 1u == (tg + 1u) * nx) xb_add(&bar[XB_TOPGEN], 1u);
            else XB_SPIN(xb_ld(&bar[XB_TOPGEN]) == tg, bar);
            __builtin_amdgcn_fence(__ATOMIC_ACQUIRE, "agent");
            xb_add(&bar[XB_XGEN(b.x)], 1u);
            asm volatile("s_waitcnt vmcnt(0)" ::: "memory");
        } else {
            XB_SPIN(xb_ld(&bar[XB_XGEN(b.x)]) == gen, bar);
            __builtin_amdgcn_fence(__ATOMIC_ACQUIRE, "agent");
            asm volatile("s_waitcnt vmcnt(0)" ::: "memory");
        }
    }
    __syncthreads();
}

template <bool F8>
__device__ __forceinline__ void p0_transpose_item(const float* W, int ldw, int N, void* WTv, int ldt, float scale, LAS float* scr, int item, int lane) {
    const int nblk = N / 32, kb = item / nblk, nb = item % nblk, k0 = 64 * kb, n0 = 32 * nb;
#pragma unroll 8
    for (int i = 0; i < 32; ++i) { const int kk = 2 * i + (lane >> 5); scr[kk * 33 + (lane & 31)] = W[(size_t)(k0 + kk) * ldw + n0 + (lane & 31)]; }
    LDS_WAIT(); asm volatile("" ::: "memory");
    const int c = lane & 7;
#pragma unroll
    for (int j = 0; j < 4; ++j) { const int n = (lane >> 3) + 8 * j; const LAS float* s = scr + (8 * c) * 33 + n;
        if constexpr (F8) { int lo = 0, hi = 0;
            lo = __builtin_amdgcn_cvt_pk_fp8_f32(s[0 * 33] * scale, s[1 * 33] * scale, lo, false); lo = __builtin_amdgcn_cvt_pk_fp8_f32(s[2 * 33] * scale, s[3 * 33] * scale, lo, true);
            hi = __builtin_amdgcn_cvt_pk_fp8_f32(s[4 * 33] * scale, s[5 * 33] * scale, hi, false); hi = __builtin_amdgcn_cvt_pk_fp8_f32(s[6 * 33] * scale, s[7 * 33] * scale, hi, true);
            *(GAS v2u*)((unsigned char*)WTv + (size_t)(n0 + n) * ldt + k0 + 8 * c) = (v2u){(unsigned)lo, (unsigned)hi};
        } else {
            v4u o; o.x = cvt_pk_bf16(s[0 * 33], s[1 * 33]); o.y = cvt_pk_bf16(s[2 * 33], s[3 * 33]); o.z = cvt_pk_bf16(s[4 * 33], s[5 * 33]); o.w = cvt_pk_bf16(s[6 * 33], s[7 * 33]);
            *(GAS v4u*)((bf16*)WTv + (size_t)(n0 + n) * ldt + k0 + 8 * c) = o; } }
    LDS_WAIT(); asm volatile("" ::: "memory");
}

__device__ __forceinline__ int t5_bucket(int rel) {
    int n = -rel; const int ret = n < 0 ? 16 : 0; n = n < 0 ? -n : n;
    if (n < 8) return ret + n;
    const float v = logf((float)n / 8.0f) / logf(128.0f) * 8.0f;
    int large = 8 + (int)v; large = large < 15 ? large : 15;
    return ret + large;
}
__device__ __forceinline__ float gelu_tanh(float x) {
    const float z = 0.7978845608028654f * (x + 0.044715f * x * x * x);
    const float e = __expf(2.0f * z);
    const float t = 1.0f - 2.0f / (e + 1.0f);
    return 0.5f * x * (1.0f + t);
}
__device__ __forceinline__ unsigned fkey(float v) { const unsigned u = __float_as_uint(v); return (u >> 31) ? ~u : (u | 0x80000000u); }
__device__ __forceinline__ float fdec(unsigned key) { const unsigned k2 = key & ~127u; const unsigned u = (k2 >> 31) ? (k2 & 0x7fffffffu) : (~k2 & ~127u); return __uint_as_float(u); }
template <int LJ> __device__ __forceinline__ unsigned xshfl(unsigned x, const int lane) {
    if constexpr (LJ == 1) return (unsigned)__builtin_amdgcn_update_dpp(0, (int)x, 0xB1, 0xF, 0xF, false);
    else if constexpr (LJ == 2) return (unsigned)__builtin_amdgcn_update_dpp(0, (int)x, 0x4E, 0xF, 0xF, false);
    else if constexpr (LJ == 4) { const int y = __builtin_amdgcn_update_dpp(0, (int)x, 0x141, 0xF, 0xF, false); return (unsigned)__builtin_amdgcn_update_dpp(0, y, 0x1B, 0xF, 0xF, false); }
    else if constexpr (LJ == 8) { const int y = __builtin_amdgcn_update_dpp(0, (int)x, 0x140, 0xF, 0xF, false); return (unsigned)__builtin_amdgcn_update_dpp(0, y, 0x141, 0xF, 0xF, false); }
    else if constexpr (LJ == 16) return (unsigned)__builtin_amdgcn_ds_swizzle((int)x, 0x401F);
    else { const auto rr = __builtin_amdgcn_permlane32_swap(x, x, false, false); return lane < 32 ? rr[1] : rr[0]; }
}
template <int K, int J> __device__ __forceinline__ void bitonic_step(unsigned& a0, unsigned& a1, unsigned& b0, unsigned& b1, const int lane) {
    const bool asc = (K == 128) ? true : ((lane & (K >> 1)) == 0);
    if constexpr (J == 1) {
        const unsigned la = a0 < a1 ? a0 : a1, ha = a0 < a1 ? a1 : a0, lb = b0 < b1 ? b0 : b1, hb = b0 < b1 ? b1 : b0;
        a0 = asc ? la : ha; a1 = asc ? ha : la; b0 = asc ? lb : hb; b1 = asc ? hb : lb;
    } else {
        constexpr int LJ = J >> 1; const bool tmin = (((lane & LJ) == 0) == asc);
        const unsigned pa0 = xshfl<LJ>(a0, lane), pa1 = xshfl<LJ>(a1, lane), pb0 = xshfl<LJ>(b0, lane), pb1 = xshfl<LJ>(b1, lane);
        a0 = tmin ? (a0 < pa0 ? a0 : pa0) : (a0 < pa0 ? pa0 : a0); a1 = tmin ? (a1 < pa1 ? a1 : pa1) : (a1 < pa1 ? pa1 : a1);
        b0 = tmin ? (b0 < pb0 ? b0 : pb0) : (b0 < pb0 ? pb0 : b0); b1 = tmin ? (b1 < pb1 ? b1 : pb1) : (b1 < pb1 ? pb1 : b1);
    }
    if constexpr (J > 1) bitonic_step<K, (J >> 1)>(a0, a1, b0, b1, lane);
}
template <int K> __device__ __forceinline__ void bitonic_stage(unsigned& a0, unsigned& a1, unsigned& b0, unsigned& b1, const int lane) {
    bitonic_step<K, (K >> 1)>(a0, a1, b0, b1, lane);
    if constexpr (K < 128) bitonic_stage<(K << 1)>(a0, a1, b0, b1, lane);
}
__device__ __forceinline__ void bitonic128x2(unsigned& a0, unsigned& a1, unsigned& b0, unsigned& b1, const int lane) { bitonic_stage<2>(a0, a1, b0, b1, lane); }
__device__ __forceinline__ unsigned q8x4(f32x4 v, float s) {
    const unsigned b0 = __float_as_uint(v[0] * s + 12582912.0f), b1 = __float_as_uint(v[1] * s + 12582912.0f), b2 = __float_as_uint(v[2] * s + 12582912.0f), b3 = __float_as_uint(v[3] * s + 12582912.0f);
    return (b0 & 0xffu) | ((b1 & 0xffu) << 8) | ((b2 & 0xffu) << 16) | (b3 << 24);
}
__device__ __forceinline__ float dot2bf(unsigned a, unsigned b, float c) { return __builtin_amdgcn_fdot2_f32_bf16(__builtin_bit_cast(bf2_t, a), __builtin_bit_cast(bf2_t, b), c, false); }

constexpr int ATT_SLOT = 8704;
__device__ __forceinline__ int crow(int r, int hi) { return (r & 3) + 8 * (r >> 2) + 4 * hi; }

__device__ __forceinline__ void attn_task(const int G, const bf16* QKVH, bf16* O0, bf16* O1, float* LSE0, float* LSE1, unsigned char* MIX8,
                                          const LAS float* btab, LAS unsigned char* wl, int b, int h, int mtile, int tk, int lane) {
    const int SH = 2 * G;
    const int L = SEQ >> SH, TPR = 32 >> SH;
    const int r32 = lane & 31, hi = lane >> 5;
    const int res = tk >> (5 - SH), l0 = ((mtile * 1024) >> SH) + 32 * (tk & (TPR - 1));
    const size_t rowbase = (size_t)b * SEQ;
    const int srow = lane >> 4, sch = lane & 15;
    const int rot = (tk & 1) ? 4 : 0;
#define ATT_JR(j) (((j) + rot) >= 5 ? ((j) + rot - 5) : ((j) + rot))
#define ATT_WAITV(n) asm volatile("s_waitcnt vmcnt(" #n ")" ::: "memory")
#define ATT_ISSUE(n) do { LAS unsigned char* sl_ = wl + ((n) & 1) * ATT_SLOT; const int jt_ = ATT_JR((n) < 5 ? (n) : (n) - 5); \
        _Pragma("unroll") for (int i_ = 0; i_ < 8; ++i_) { \
            const int key_ = (n) < 5 ? (4 * i_ + srow) : ((i_ & 3) + 4 * srow + 16 * (i_ >> 2)); \
            int lk_ = l0 - 64 + 32 * jt_ + key_; lk_ = lk_ < 0 ? 0 : (lk_ > L - 1 ? L - 1 : lk_); \
            const int ch_ = (n) < 5 ? (sch ^ (key_ & 7)) : sch; \
            const bf16* src_ = QKVH + ((size_t)(((n) < 5 ? NH : 2 * NH) + h) * M + rowbase + ((size_t)lk_ << SH) + res) * HD + ch_ * 8; \
            __builtin_amdgcn_global_load_lds((const unsigned*)src_, (LAS unsigned*)(sl_ + i_ * ((n) < 5 ? 1024 : 1088)), 16, 0, 0); } } while (0)
    const size_t qrow = rowbase + ((size_t)(l0 + r32) << SH) + res;
    bf16x8 qr[8];
    { const bf16* qp = QKVH + ((size_t)h * M + qrow) * HD + hi * 8;
#pragma unroll
      for (int d0 = 0; d0 < 8; ++d0) qr[d0] = *(const bf16x8*)(qp + d0 * 16); }
    ATT_ISSUE(0); ATT_ISSUE(1);
    f32x16 p[5];
#define ATT_KTILE(n) do { LAS unsigned char* sl_ = wl + ((n) & 1) * ATT_SLOT + r32 * 256; f32x16 s_ = {}; \
        _Pragma("unroll") for (int d0 = 0; d0 < 8; ++d0) { const bf16x8 a_ = *(const LAS bf16x8*)(sl_ + (((2 * d0 + hi) ^ (r32 & 7)) << 4)); s_ = __builtin_amdgcn_mfma_f32_32x32x16_bf16(a_, qr[d0], s_, 0, 0, 0); } \
        p[n] = s_; asm volatile("" ::: "memory"); } while (0)
    ATT_WAITV(8); ATT_KTILE(0); ATT_ISSUE(2);
    ATT_WAITV(8); ATT_KTILE(1); ATT_ISSUE(3);
    ATT_WAITV(8); ATT_KTILE(2); ATT_ISSUE(4);
    ATT_WAITV(8); ATT_KTILE(3); ATT_ISSUE(5);
    ATT_WAITV(8); ATT_KTILE(4); ATT_ISSUE(6);
    float mx = -1e30f;
    const bool edge = (l0 - 64 < 0) || (l0 + 96 > L);
    const LAS float* bt = btab + G * 256 + 32 + 4 * hi - r32;
#pragma unroll
    for (int j = 0; j < 5; ++j) {
        const int jr = ATT_JR(j); const LAS float* btj = bt + 32 * jr;
#pragma unroll
        for (int r = 0; r < 16; ++r) {
            const int kc = 32 * jr + (r & 3) + 8 * (r >> 2);
            float v = p[j][r] + btj[(r & 3) + 8 * (r >> 2)];
            if (edge) { const int lk = l0 - 64 + kc + 4 * hi; v = (lk >= 0 && lk < L) ? v : -1e30f; }
            p[j][r] = v; mx = fmaxf(mx, v);
        }
        asm volatile("" ::: "memory");
    }
    mx = fmaxf(mx, __shfl_xor(mx, 32));
    float ls = 0.f;
    bf16x8 pb[5][2];
#pragma unroll
    for (int j = 0; j < 5; ++j) {
        float e[16];
#pragma unroll
        for (int r = 0; r < 16; ++r) { e[r] = __builtin_amdgcn_exp2f(p[j][r] - mx); ls += e[r]; }
#pragma unroll
        for (int s = 0; s < 2; ++s) { v4u w; w.x = cvt_pk_bf16(e[8 * s + 0], e[8 * s + 1]); w.y = cvt_pk_bf16(e[8 * s + 2], e[8 * s + 3]);
            w.z = cvt_pk_bf16(e[8 * s + 4], e[8 * s + 5]); w.w = cvt_pk_bf16(e[8 * s + 6], e[8 * s + 7]); pb[j][s] = __builtin_bit_cast(bf16x8, w); }
    }
    ls += __shfl_xor(ls, 32);
    asm volatile("" ::: "memory");
    f32x16 o[4] = {};
    const int i16 = lane & 15, g16 = lane >> 4;
    const unsigned vbase = (unsigned)(uintptr_t)wl + (unsigned)((i16 >> 2) * 1088 + hi * 256 + (16 * (g16 & 1) + 4 * (i16 & 3)) * 2);
#define ATT_VTILE(n) do { const unsigned va_ = vbase + ((n) & 1) * ATT_SLOT; \
        _Pragma("unroll") for (int dt = 0; dt < 4; ++dt) { s16x4 lo0, hi0, lo1, hi1; \
            asm volatile("ds_read_b64_tr_b16 %0, %4 offset:%5\n\tds_read_b64_tr_b16 %1, %4 offset:%6\n\tds_read_b64_tr_b16 %2, %4 offset:%7\n\tds_read_b64_tr_b16 %3, %4 offset:%8\n\ts_waitcnt lgkmcnt(0)" \
                         : "=&v"(lo0), "=&v"(hi0), "=&v"(lo1), "=&v"(hi1) : "v"(va_), "i"(dt * 64), "i"(512 + dt * 64), "i"(4 * 1088 + dt * 64), "i"(4 * 1088 + 512 + dt * 64) : "memory"); \
            const bf16x8 af0 = (bf16x8){lo0[0], lo0[1], lo0[2], lo0[3], hi0[0], hi0[1], hi0[2], hi0[3]}; \
            const bf16x8 af1 = (bf16x8){lo1[0], lo1[1], lo1[2], lo1[3], hi1[0], hi1[1], hi1[2], hi1[3]}; \
            o[dt] = __builtin_amdgcn_mfma_f32_32x32x16_bf16(af0, pb[(n) - 5][0], o[dt], 0, 0, 0); \
            o[dt] = __builtin_amdgcn_mfma_f32_32x32x16_bf16(af1, pb[(n) - 5][1], o[dt], 0, 0, 0); } } while (0)
    ATT_WAITV(8); ATT_VTILE(5); ATT_ISSUE(7);
    ATT_WAITV(8); ATT_VTILE(6); ATT_ISSUE(8);
    ATT_WAITV(8); ATT_VTILE(7); ATT_ISSUE(9);
    ATT_WAITV(8); ATT_VTILE(8);
    ATT_WAITV(0); ATT_VTILE(9);
#undef ATT_WAITV
#undef ATT_ISSUE
#undef ATT_KTILE
#undef ATT_VTILE
#undef ATT_JR
    const float inv = 1.0f / ls;
    const float lse2 = mx + __builtin_amdgcn_logf(ls);
    const size_t orow = qrow;
    LAS unsigned char* T0 = wl;
    LAS unsigned char* T1 = T0 + ATT_SLOT;
    int ln_ = lane; asm volatile("" : "+v"(ln_));
    const int erow = ln_ >> 4, echk = ln_ & 15;
    const unsigned pofs = (unsigned)(r32 * 272 + 8 * hi);
    if (G < 2) {
#pragma unroll
        for (int dt = 0; dt < 4; ++dt)
#pragma unroll
            for (int rg = 0; rg < 4; ++rg) { v2u w; w.x = cvt_pk_bf16(o[dt][4 * rg] * inv, o[dt][4 * rg + 1] * inv); w.y = cvt_pk_bf16(o[dt][4 * rg + 2] * inv, o[dt][4 * rg + 3] * inv);
                *(LAS v2u*)(T0 + pofs + 64 * dt + 16 * rg) = w; }
        LDS_WAIT();
        bf16* ob = (G == 0 ? O0 : O1) + ((size_t)h * M + rowbase) * HD + echk * 8;
#pragma unroll
        for (int i = 0; i < 8; ++i) { const int qi = erow + 4 * i; const v4u w = *(const LAS v4u*)(T0 + qi * 272 + echk * 16);
            *(v4u*)(ob + (((size_t)(l0 + qi) << SH) + res) * HD) = w; }
        if (hi == 0) (G == 0 ? LSE0 : LSE1)[orow * NH + h] = lse2;
    } else {
        const float l0v = LSE0[orow * NH + h], l1v = LSE1[orow * NH + h];
        const bf16* ib0 = O0 + ((size_t)h * M + rowbase) * HD + echk * 8; const bf16* ib1 = O1 + ((size_t)h * M + rowbase) * HD + echk * 8;
#pragma unroll
        for (int hh = 0; hh < 2; ++hh) {
            v4u t0[4], t1[4];
#pragma unroll
            for (int i = 0; i < 4; ++i) { const size_t ro = (((size_t)(l0 + erow + 4 * (4 * hh + i)) << SH) + res) * HD; t0[i] = *(const v4u*)(ib0 + ro); t1[i] = *(const v4u*)(ib1 + ro); }
#pragma unroll
            for (int i = 0; i < 4; ++i) { const int qi = erow + 4 * (4 * hh + i); *(LAS v4u*)(T0 + qi * 272 + echk * 16) = t0[i]; *(LAS v4u*)(T1 + qi * 272 + echk * 16) = t1[i]; }
            asm volatile("" ::: "memory");
        }
        const float mm = fmaxf(fmaxf(l0v, l1v), lse2);
        const float w0 = __builtin_amdgcn_exp2f(l0v - mm), w1 = __builtin_amdgcn_exp2f(l1v - mm), w2 = __builtin_amdgcn_exp2f(lse2 - mm);
        const float wi = 1.0f / (w0 + w1 + w2);
        const float c0 = w0 * wi, c1 = w1 * wi, c2 = w2 * wi * inv;
        LDS_WAIT();
        unsigned y8[16];
#pragma unroll
        for (int dt = 0; dt < 4; ++dt)
#pragma unroll
            for (int rg = 0; rg < 4; ++rg) { const v2u a = *(const LAS v2u*)(T0 + pofs + 64 * dt + 16 * rg), c = *(const LAS v2u*)(T1 + pofs + 64 * dt + 16 * rg);
                const float y0 = c0 * bf_lo(a.x) + c1 * bf_lo(c.x) + c2 * o[dt][4 * rg], y1 = c0 * bf_hi(a.x) + c1 * bf_hi(c.x) + c2 * o[dt][4 * rg + 1];
                const float y2 = c0 * bf_lo(a.y) + c1 * bf_lo(c.y) + c2 * o[dt][4 * rg + 2], y3 = c0 * bf_hi(a.y) + c1 * bf_hi(c.y) + c2 * o[dt][4 * rg + 3];
                int w = 0; w = __builtin_amdgcn_cvt_pk_fp8_f32(y0 * A8SCALE, y1 * A8SCALE, w, false); w = __builtin_amdgcn_cvt_pk_fp8_f32(y2 * A8SCALE, y3 * A8SCALE, w, true); y8[4 * dt + rg] = (unsigned)w; }
        LDS_WAIT();
#pragma unroll
        for (int dt = 0; dt < 4; ++dt)
#pragma unroll
            for (int rg = 0; rg < 4; ++rg) *(LAS unsigned*)(T0 + r32 * 144 + 4 * hi + 32 * dt + 8 * rg) = y8[4 * dt + rg];
        LDS_WAIT();
        unsigned char* ob = MIX8 + rowbase * DM + h * HD + (ln_ & 7) * 16;
#pragma unroll
        for (int i = 0; i < 4; ++i) { const int qi = (ln_ >> 3) + 8 * i; const v4u w = *(const LAS v4u*)(T0 + qi * 144 + (ln_ & 7) * 16);
            *(v4u*)(ob + (((size_t)(l0 + qi) << SH) + res) * DM) = w; }
    }
    LDS_WAIT();
}

constexpr int PER_PHASE = 9;
struct Args { const float* in[16]; float* out; unsigned char* ws; unsigned mask; unsigned pad; };

__constant__ unsigned char CAND_I[64] = {0,0,0,0,0,0,0,0,0,0,0,0,0,0,0,0, 1,1,1,1,1,1,1,1, 2,2,2,2,2, 3,3,3,3, 4,4,4, 5,5, 6,6, 7,7, 8,9,10,11,12,13,14,15, 0,0,0,0,0,0,0,0,0,0,0,0,0,0};
__constant__ unsigned char CAND_J[64] = {0,1,2,3,4,5,6,7,8,9,10,11,12,13,14,15, 0,1,2,3,4,5,6,7, 0,1,2,3,4, 0,1,2,3, 0,1,2, 0,1, 0,1, 0,1, 0,0,0,0,0,0,0,0, 0,0,0,0,0,0,0,0,0,0,0,0,0,0};

__global__ void __launch_bounds__(NWAVES * 64, 2) fwd_kernel(Args args) {
    extern __shared__ __attribute__((aligned(16))) unsigned char lds_raw[];
    LAS unsigned char* lds = (LAS unsigned char*)lds_raw;
    volatile LAS unsigned* MISC = (volatile LAS unsigned*)(lds + MISC_OFF);
    const int tid0 = threadIdx.x, lane0 = tid0 & 63, wave = __builtin_amdgcn_readfirstlane(tid0 >> 6);
#define PHASE_LANES() int tid = tid0; asm volatile("" : "+v"(tid)); const int lane = tid & 63
    const int G = gridDim.x; const int bx = blockIdx.x;
    const int vcu = (G % 8 == 0) ? (bx % 8) * (G / 8) + bx / 8 : bx;
    const int gw = vcu * NWAVES + wave, NGW = G * NWAVES;
    unsigned char* ws = args.ws;
    unsigned* ctl = (unsigned*)(ws + WS_CTL);
    const float* x = args.in[0]; const float* cvec = args.in[1]; const float* w_ada = args.in[2]; const float* b_ada = args.in[3]; const float* g_mix = args.in[4];
    const float* w_in = args.in[5]; const float* rel_bias = args.in[6]; const float* pool_w = args.in[7]; const float* pool_scale = args.in[8]; const float* w_out = args.in[9];
    const float* g_ffn = args.in[10]; const float* peer_wq = args.in[11]; const float* peer_sk = args.in[12]; const float* peer_u = args.in[13]; const float* peer_v = args.in[14];
    const float* g_final = args.in[15];
    float* out = args.out;
    float* MODV = (float*)(ws + WS_MODV); float* MODP = (float*)(ws + WS_MODP);
    bf16* SKT = (bf16*)(ws + WS_SKT); bf16* PWS = (bf16*)(ws + WS_PWS); bf16* WQST = (bf16*)(ws + WS_WQST); unsigned char* WOUT8 = ws + WS_WOUT2;     bf16* WINT = (bf16*)(ws + WS_WINT); unsigned char* WIN8 = ws + WS_WIN8; unsigned char* H8 = ws + WS_H8;
    bf16* WOPT = (bf16*)(ws + WS_WOPT); bf16* WQB = (bf16*)(ws + WS_WQB);
    unsigned char* UB = ws + WS_UB; unsigned char* VB = ws + WS_VB; float* SCL = (float*)(ws + WS_SCL); float* TSC = SCL + 2 * NEXP;     bf16* H = (bf16*)(ws + WS_H); bf16* PIN = (bf16*)(ws + WS_PROJ); bf16* QKVH = (bf16*)(ws + WS_QKVH); unsigned char* MIX8 = ws + WS_MIXIN;
    bf16* O0 = (bf16*)(ws + WS_O0); bf16* O1 = (bf16*)(ws + WS_O1); float* LSE = (float*)(ws + WS_LSE);
    float* SC = (float*)(ws + WS_SC);
    bf16* X1B = (bf16*)(ws + WS_O0);
    bf16* YB = (bf16*)(ws + WS_PROJ + 64 * MiB);

    for (int u = tid0; u < (LDS_BYTES - LDSCTL_OFF) / 4; u += NWAVES * 64) ((LAS unsigned*)(lds + LDSCTL_OFF))[u] = 0u;
    __syncthreads();
    XcdBarrier bar; bar.bar = ctl + CW_BAR; bar.x = 0; bar.st = nullptr;
    if (MK_N_LAUNCHES != PER_PHASE) bar = xcd_barrier_post(ctl + CW_BAR, MISC + 8);
#define GRID_BAR() do { if (MK_N_LAUNCHES != PER_PHASE) xcd_barrier(bar); } while (0)
    const unsigned phmask = args.mask;
#ifndef PH_MASK
#define PH_MASK 0x1ff
#endif
#define IN(k) ((((PH_MASK) >> (k)) & 1) && ((phmask >> (k)) & 1u))
#define BOTH(k) (IN(k) && IN((k) + 1))

    if (IN(0)) {
        PHASE_LANES();
        LAS float* silu = (LAS float*)(lds + RING_OFF);
        for (int i = tid; i < BATCH * DM; i += NWAVES * 64) { const float v = cvec[i]; silu[i] = v / (1.0f + __expf(-v)); }
        __syncthreads();
        for (int task = gw; task < (NMOD / 256) * KS_ADA; task += NGW) {
            const int cg = task % (NMOD / 256), ks = task / (NMOD / 256); const int k0 = ks * (DM / KS_ADA), n0 = cg * 256 + 4 * lane;
            f32x4 a0 = {0.f, 0.f, 0.f, 0.f}, a1 = {0.f, 0.f, 0.f, 0.f};
            const float* wp = w_ada + (size_t)k0 * NMOD + n0;
            static_assert(DM / KS_ADA == 64, "four 16-row batches");
            f32x4 wA[16], wB[16];
#define ADA_LD(W_, b_) _Pragma("unroll") for (int q_ = 0; q_ < 16; ++q_) W_[q_] = *(const f32x4*)(wp + (size_t)(16 * (b_) + q_) * NMOD)
#define ADA_FMA(W_, b_) _Pragma("unroll") for (int q_ = 0; q_ < 16; ++q_) { const float s0 = silu[k0 + 16 * (b_) + q_], s1 = silu[DM + k0 + 16 * (b_) + q_]; a0 += W_[q_] * s0; a1 += W_[q_] * s1; }
            ADA_LD(wA, 0); ADA_LD(wB, 1); ADA_FMA(wA, 0); ADA_LD(wA, 2); ADA_FMA(wB, 1); ADA_LD(wB, 3); ADA_FMA(wA, 2); ADA_FMA(wB, 3);
#undef ADA_LD
#undef ADA_FMA
            *(f32x4*)(MODP + ((size_t)(ks * 2 + 0)) * NMOD + n0) = a0; *(f32x4*)(MODP + ((size_t)(ks * 2 + 1)) * NMOD + n0) = a1;
        }
        __syncthreads();
        {
            LAS float* scr = (LAS float*)(lds + RING_OFF + wave * 16384);
            constexpr int I_QKV = (DM / 64) * (3 * ATTW / 32), I_PIN = (DM / 64) * (POOLW / 32), I_OUTH = (ATTW / 64) * (DM / 32);
            constexpr int NITEMS = I_QKV + I_PIN + 2 * I_OUTH;
            for (int it = gw; it < NITEMS; it += NGW) {
                int r = it;
                if (r < I_QKV) { p0_transpose_item<true>(w_in, INW, 3 * ATTW, WIN8, DM, W8SCALE, scr, r, lane); continue; } r -= I_QKV;
                if (r < I_PIN) { p0_transpose_item<false>(w_in + 3 * ATTW, INW, POOLW, WINT, DM, 1.f, scr, r, lane); continue; } r -= I_PIN;
                if (r < I_OUTH) { p0_transpose_item<true>(w_out, DM, DM, WOUT8, DM, WO8SCALE, scr, r, lane); continue; } r -= I_OUTH;
                p0_transpose_item<false>(w_out + (size_t)ATTW * DM, DM, DM, WOPT, POOLW, 1.f, scr, r, lane);
            }
        }
        for (int i = gw * 64 + lane; i < (DM * PQ + 4 * 512 * 512) / 8; i += NGW * 64) {
            const bool isQ = i < DM * PQ / 8; const int j = isQ ? i : i - DM * PQ / 8;
            const float* src = (isQ ? peer_wq : pool_w) + (size_t)j * 8;
            f32x4 a = *(const f32x4*)src, c = *(const f32x4*)(src + 4);
            if (!isQ) { const int e0 = j * 8; const int gi = e0 >> 18, d0 = e0 & 511; const float* ps = pool_scale + gi * 512 + d0; a = a * *(const f32x4*)ps; c = c * *(const f32x4*)(ps + 4); }
            v4u w; w.x = cvt_pk_bf16(a[0], a[1]); w.y = cvt_pk_bf16(a[2], a[3]); w.z = cvt_pk_bf16(c[0], c[1]); w.w = cvt_pk_bf16(c[2], c[3]);
            *(v4u*)((isQ ? WQB : PWS) + (size_t)j * 8) = w;
        }
        f32x4 vnx[4][4];
#define PEER_LD(r_) do { const float* s_ = ((r_) < NEXP ? peer_u + (size_t)(r_) * DM : peer_v + (size_t)((r_) - NEXP) * DM) + 16 * lane; \
            _Pragma("unroll") for (int i = 0; i < 4; ++i) _Pragma("unroll") for (int q = 0; q < 4; ++q) vnx[i][q] = *(const f32x4*)(s_ + 1024 * i + 4 * q); } while (0)
        if (gw < 2 * NEXP) PEER_LD(gw);
        for (int r = gw; r < 2 * NEXP; r += NGW) {
            const bool isU = r < NEXP; const int e = isU ? r : r - NEXP;
            f32x4 v[4][4]; float mx = 0.f;
#pragma unroll
            for (int i = 0; i < 4; ++i)
#pragma unroll
                for (int q = 0; q < 4; ++q) { v[i][q] = vnx[i][q];
                    mx = fmaxf(mx, fmaxf(fmaxf(fabsf(v[i][q][0]), fabsf(v[i][q][1])), fmaxf(fabsf(v[i][q][2]), fabsf(v[i][q][3])))); }
            if (r + NGW < 2 * NEXP) PEER_LD(r + NGW);
#pragma unroll
            for (int o = 1; o < 64; o <<= 1) mx = fmaxf(mx, __shfl_xor(mx, o));
            const int ex = (int)((__float_as_uint(mx) >> 23) & 0xffu);
            float scale = 1.0f, inv = 1.0f;
            if (ex >= 32 && ex <= 230) { if (isU) { scale = 127.0f / mx; inv = mx * (1.0f / 127.0f); }
                else { scale = __uint_as_float((unsigned)(261 - ex) << 23); inv = __uint_as_float((unsigned)(ex - 7) << 23); } }
            unsigned char* dst = (isU ? UB : VB) + ((size_t)(lane >> 3) * NEXP + e) * 128 + 16 * (lane & 7);
#pragma unroll
            for (int i = 0; i < 4; ++i) { v4u w;
#pragma unroll
                for (int q = 0; q < 4; ++q) { if (isU) { w[q] = q8x4(v[i][q], scale); } else { int pk = 0; pk = __builtin_amdgcn_cvt_pk_fp8_f32(v[i][q][0] * scale, v[i][q][1] * scale, pk, false);
                    pk = __builtin_amdgcn_cvt_pk_fp8_f32(v[i][q][2] * scale, v[i][q][3] * scale, pk, true); w[q] = (unsigned)pk; } }
                *(v4u*)(dst + (size_t)(8 * i) * NEXP * 128) = w; }
            if (lane == 0) SCL[r] = inv;
        }
#undef PEER_LD
        for (int i = gw * 64 + lane; i < 2048 * 32; i += NGW * 64) {
            const int n = i >> 5, kc = (i & 31) * 8; const int p = (n >> 7) & 1, pp = kc >> 7;
            v4u w = {0u, 0u, 0u, 0u};
            if (p == pp) { const float* src = peer_sk + (size_t)n * 128 + (kc & 127); const f32x4 a = *(const f32x4*)src, c = *(const f32x4*)(src + 4);
                w.x = cvt_pk_bf16(a[0], a[1]); w.y = cvt_pk_bf16(a[2], a[3]); w.z = cvt_pk_bf16(c[0], c[1]); w.w = cvt_pk_bf16(c[2], c[3]); }
            *(v4u*)(SKT + (size_t)n * 256 + kc) = w;
        }
        if (BOTH(0)) GRID_BAR();
    }

    if (IN(1)) {
        PHASE_LANES();
        for (int i = bx * (NWAVES * 64) + tid; i < BATCH * NMOD; i += G * NWAVES * 64) {
            const int b = i / NMOD, n = i % NMOD; float s = b_ada[n];
#pragma unroll 8
            for (int ks = 0; ks < KS_ADA; ++ks) s += MODP[(size_t)(ks * 2 + b) * NMOD + n];
            const int j = n / DM, c = n % DM;
            MODV[(size_t)(j * 2 + b) * DM + c] = s;
        }
        if (bx < G / 2) {
            pg8::Gemm g{WOPT, PWS, DM, POOLW, 512, POOLW, 512, 2, 512, 1 << 30, 0}; pg8::StaticOrder S; S.init(DM, POOLW, G / 2, bx);
            pg8::EpiFp8 E{WOUT8, DM, ATTW, (A8SCALE * WO8SCALE) / P8SCALE};
            pg8::gemm_phase<pg8::EpiFp8, pg8::StaticOrder, true>(lds + RING_OFF, g, S, E);
        }
        else {
            pg8::Gemm g{SKT, WQB, PQ, DM, 256, 256, PQ, 1 << 30, 0, 1, 256}; pg8::StaticOrder S; S.init(PQ, DM, G - G / 2, bx - G / 2);
            pg8::EpiBf16 E{WQST, DM, 0, 1.0f, nullptr, 0, 0};
            pg8::gemm_phase<pg8::EpiBf16, pg8::StaticOrder, true>(lds + RING_OFF, g, S, E);
        }
        if (BOTH(1)) GRID_BAR();
    }

    if (IN(2)) {
        PHASE_LANES();
        for (int row = gw; row < M; row += NGW) {
            const int b = row / SEQ;
            const f32x4* xr = (const f32x4*)(x + (size_t)row * DM) + lane;
            f32x4 v[16]; float ss = 0.f;
#pragma unroll
            for (int j = 0; j < 16; ++j) { v[j] = xr[64 * j]; ss += (v[j][0] * v[j][0] + v[j][1] * v[j][1]) + (v[j][2] * v[j][2] + v[j][3] * v[j][3]); }
            const float rstd = 1.0f / sqrtf(wave_sum(ss) * (1.0f / DM) + RMS_EPS);
            const f32x4* gp = (const f32x4*)g_mix + lane; const f32x4* shp = (const f32x4*)(MODV + (size_t)(0 * 2 + b) * DM) + lane; const f32x4* scp = (const f32x4*)(MODV + (size_t)(1 * 2 + b) * DM) + lane;
            v2u* op = (v2u*)(H + (size_t)row * DM) + lane; unsigned* op8 = (unsigned*)(H8 + (size_t)row * DM) + lane;
#pragma unroll
            for (int j = 0; j < 16; ++j) { const f32x4 g4 = gp[64 * j], sh = shp[64 * j], sc = scp[64 * j];
                const f32x4 y = (v[j] * rstd) * g4 * (sc + 1.0f) + sh;
                v2u w; w.x = cvt_pk_bf16(y[0], y[1]); w.y = cvt_pk_bf16(y[2], y[3]); op[64 * j] = w;
                int p8 = 0; p8 = __builtin_amdgcn_cvt_pk_fp8_f32(y[0] * H8SCALE, y[1] * H8SCALE, p8, false); p8 = __builtin_amdgcn_cvt_pk_fp8_f32(y[2] * H8SCALE, y[3] * H8SCALE, p8, true); op8[64 * j] = (unsigned)p8; }
        }
        if (BOTH(2)) GRID_BAR();
    }

    if (IN(3)) {
        PHASE_LANES();
        {
            pg8::Gemm g{(const bf16*)H8, (const bf16*)WIN8, M, 3 * ATTW, DM / 2, DM / 2, DM / 2, 1 << 30, 0, 1 << 30, 0}; pg8::StaticOrder S; S.init(M, 3 * ATTW, G, bx);
            pg8::EpiBf16 E{PIN, POOLW, ATTW, QSCALE / (H8SCALE * W8SCALE), QKVH, 3 * ATTW, M, 1.0f / (H8SCALE * W8SCALE)};
            pg8::gemm_phase<pg8::EpiBf16, pg8::StaticOrder, true, true>(lds + RING_OFF, g, S, E);
        }
        {
            pg8::Gemm g{H, WINT, M, POOLW, DM, DM, DM, 1 << 30, 0, 1 << 30, 0}; pg8::StaticOrder S; S.init(M, POOLW, G, bx);
            pg8::EpiBf16 E{PIN, POOLW, 0, 1.0f, nullptr, 0, 0};
            pg8::gemm_phase<pg8::EpiBf16, pg8::StaticOrder, true>(lds + RING_OFF, g, S, E);
        }
        if (BOTH(3)) GRID_BAR();
    }

    if (IN(4)) {
        PHASE_LANES();
        LAS float* btab = (LAS float*)(lds + SHARED_OFF);
        LAS unsigned char* vt = lds + RING_OFF + wave * ATT_WAVE_BYTES;
        if (!(args.pad & 1u))
        for (int unit = bx; unit < BATCH * NH * (SEQ / 1024); unit += G) {
            const int b = unit >> 7, h = (unit >> 3) & 15, mt = unit & 7;
            __syncthreads();
            for (int i = tid; i < 3 * 256; i += NWAVES * 64) { const int gi = i >> 8, ri = (i & 255) - 32; const int dil = gi == 0 ? 1 : (gi == 1 ? 4 : 16);
                btab[i] = (ri >= 0 && ri <= 128) ? rel_bias[t5_bucket((ri - 64) * dil) * NH + h] * LOG2E : -1e30f; }
            __syncthreads();
            for (int g = 0; g < 3; ++g) {
                if (g == 2) { VM_WAIT(); __syncthreads(); }
                for (int tk = wave; tk < 32; tk += NWAVES) attn_task(g, QKVH, O0, O1, LSE, LSE + (size_t)M * NH, MIX8, btab, vt, b, h, mt, tk, lane);
            }
        }
        if (!(args.pad & 2u))
        for (int i = bx * (NWAVES * 64) + tid; i < BATCH * (SEQ / 8) * (POOLW / 8); i += G * NWAVES * 64) {
            const int cc = i & 255, run = (i >> 8) & (SEQ / 8 - 1), b = i >> 18; const int gi = __builtin_amdgcn_readfirstlane(cc >> 6);
            const int pos0 = run * 8;
            const bf16* base = PIN + (size_t)b * SEQ * POOLW + cc * 8;
            unsigned char* obase = MIX8 + ((size_t)b * SEQ + pos0) * DM + ATTW + cc * 8;
#define POOL_RUN(HW) do { constexpr int NR = 8 + 2 * (HW) - 1; v4u w_[NR]; \
                _Pragma("unroll") for (int q = 0; q < NR; ++q) { const int pp = pos0 - (HW) + q; const int pc = pp < 0 ? 0 : (pp > SEQ - 1 ? SEQ - 1 : pp); w_[q] = *(const v4u*)(base + (size_t)pc * POOLW); } \
                _Pragma("unroll") for (int q = 0; q < NR; ++q) { const int pp = pos0 - (HW) + q; if (pp < 0 || pp >= SEQ) w_[q] = (v4u){0u, 0u, 0u, 0u}; } \
                float s_[8] = {0.f, 0.f, 0.f, 0.f, 0.f, 0.f, 0.f, 0.f}; \
                _Pragma("unroll") for (int q = 0; q < 2 * (HW) - 1; ++q) { s_[0] += bf_lo(w_[q].x); s_[1] += bf_hi(w_[q].x); s_[2] += bf_lo(w_[q].y); s_[3] += bf_hi(w_[q].y); s_[4] += bf_lo(w_[q].z); s_[5] += bf_hi(w_[q].z); s_[6] += bf_lo(w_[q].w); s_[7] += bf_hi(w_[q].w); } \
                _Pragma("unroll") for (int k = 0; k < 8; ++k) { const v4u in_ = w_[k + 2 * (HW) - 1]; \
                    s_[0] += bf_lo(in_.x); s_[1] += bf_hi(in_.x); s_[2] += bf_lo(in_.y); s_[3] += bf_hi(in_.y); s_[4] += bf_lo(in_.z); s_[5] += bf_hi(in_.z); s_[6] += bf_lo(in_.w); s_[7] += bf_hi(in_.w); \
                    const int pos = pos0 + k; const int lo_ = pos - (HW) < 0 ? 0 : pos - (HW), hi_ = pos + (HW) > SEQ ? SEQ : pos + (HW); const float inv = 1.0f / (float)(hi_ - lo_); \
                    const v4u me = w_[k + (HW)]; int lo8_ = 0, hi8_ = 0; const float i8_ = inv * P8SCALE; \
                    lo8_ = __builtin_amdgcn_cvt_pk_fp8_f32(s_[0] * i8_ - bf_lo(me.x) * P8SCALE, s_[1] * i8_ - bf_hi(me.x) * P8SCALE, lo8_, false); lo8_ = __builtin_amdgcn_cvt_pk_fp8_f32(s_[2] * i8_ - bf_lo(me.y) * P8SCALE, s_[3] * i8_ - bf_hi(me.y) * P8SCALE, lo8_, true); \
                    hi8_ = __builtin_amdgcn_cvt_pk_fp8_f32(s_[4] * i8_ - bf_lo(me.z) * P8SCALE, s_[5] * i8_ - bf_hi(me.z) * P8SCALE, hi8_, false); hi8_ = __builtin_amdgcn_cvt_pk_fp8_f32(s_[6] * i8_ - bf_lo(me.w) * P8SCALE, s_[7] * i8_ - bf_hi(me.w) * P8SCALE, hi8_, true); \
                    *(v2u*)(obase + (size_t)k * DM) = (v2u){(unsigned)lo8_, (unsigned)hi8_}; \
                    const v4u out_ = w_[k]; \
                    s_[0] -= bf_lo(out_.x); s_[1] -= bf_hi(out_.x); s_[2] -= bf_lo(out_.y); s_[3] -= bf_hi(out_.y); s_[4] -= bf_lo(out_.z); s_[5] -= bf_hi(out_.z); s_[6] -= bf_lo(out_.w); s_[7] -= bf_hi(out_.w); } } while (0)
            if (gi == 0) POOL_RUN(1); else if (gi == 1) POOL_RUN(2); else if (gi == 2) POOL_RUN(4); else POOL_RUN(8);
#undef POOL_RUN
        }
        if (BOTH(4)) GRID_BAR();
    }

    if (IN(5)) {
        PHASE_LANES();
        pg8::Gemm g{(const bf16*)MIX8, (const bf16*)WOUT8, M, DM, DM / 2, DM / 2, DM / 2, 1 << 30, 0, 1 << 30, 0}; pg8::StaticOrder S; S.init(M, DM, G, bx);
        pg8::EpiResBf16 E{x, MODV + (size_t)(2 * 2) * DM, X1B, DM, 1.0f / (A8SCALE * WO8SCALE)};
        pg8::gemm_phase<pg8::EpiResBf16, pg8::StaticOrder, true, true>(lds + RING_OFF, g, S, E);
        if (BOTH(5)) GRID_BAR();
    }

    if (IN(6)) {
        PHASE_LANES();
        for (int row = gw; row < M; row += NGW) {
            const int b = row / SEQ;
            const v2u* xr = (const v2u*)(X1B + (size_t)row * DM) + lane;
            f32x4 v[16]; float ss = 0.f;
#pragma unroll
            for (int j = 0; j < 16; ++j) { const v2u xw = xr[64 * j]; v[j] = (f32x4){bf_lo(xw.x), bf_hi(xw.x), bf_lo(xw.y), bf_hi(xw.y)}; ss += (v[j][0] * v[j][0] + v[j][1] * v[j][1]) + (v[j][2] * v[j][2] + v[j][3] * v[j][3]); }
            const float rstd = 1.0f / sqrtf(wave_sum(ss) * (1.0f / DM) + RMS_EPS);
            const f32x4* gp = (const f32x4*)g_ffn + lane; const f32x4* shp = (const f32x4*)(MODV + (size_t)(3 * 2 + b) * DM) + lane; const f32x4* scp = (const f32x4*)(MODV + (size_t)(4 * 2 + b) * DM) + lane;
            v2u* op = (v2u*)(H + (size_t)row * DM) + lane; unsigned* op8 = (unsigned*)(H8 + (size_t)row * DM) + lane;
            float ymx = 0.f;
#pragma unroll
            for (int j = 0; j < 16; ++j) { const f32x4 g4 = gp[64 * j], sh = shp[64 * j], sc = scp[64 * j];
                const f32x4 y = (v[j] * rstd) * g4 * (sc + 1.0f) + sh; v[j] = y;
                ymx = fmaxf(ymx, fmaxf(fmaxf(fabsf(y[0]), fabsf(y[1])), fmaxf(fabsf(y[2]), fabsf(y[3]))));
                v2u w; w.x = cvt_pk_bf16(y[0], y[1]); w.y = cvt_pk_bf16(y[2], y[3]); op[64 * j] = w; }
#pragma unroll
            for (int o = 1; o < 64; o <<= 1) ymx = fmaxf(ymx, __shfl_xor(ymx, o));
            ymx = fmaxf(ymx, 1e-20f);
            const float qs = 127.0f / ymx;
#pragma unroll
            for (int j = 0; j < 16; ++j) op8[64 * j] = q8x4(v[j], qs);
            if (lane == 0) TSC[row] = ymx * (1.0f / 127.0f);
        }
        if (BOTH(6)) GRID_BAR();
    }

    if (IN(7)) {
        PHASE_LANES();
        pg8::Gemm g{H, WQST, M, PQ, DM, DM, DM, 1 << 30, 0, 1 << 30, 0}; pg8::StaticOrder S; S.init(M, PQ, G, bx);
        pg8::EpiF32 E{SC, PQ};
        pg8::gemm_phase<pg8::EpiF32, pg8::StaticOrder, true>(lds + RING_OFF, g, S, E);
        if (BOTH(7)) GRID_BAR();
    }

    if (IN(8)) {
        PHASE_LANES();
        LAS unsigned short* EXPW = (LAS unsigned short*)(lds + RING_OFF);
        LAS float* GACT = (LAS float*)(lds + RING_OFF + 16384);
        LAS unsigned* W = (LAS unsigned*)(lds + RING_OFF + 49152 + wave * 4096);
        LAS unsigned* K1 = W; LAS unsigned* K2 = W + 128;
        LAS float* TV1 = (LAS float*)(W + 256); LAS int* TI1 = (LAS int*)(W + 272); LAS float* TV2 = (LAS float*)(W + 288); LAS int* TI2 = (LAS int*)(W + 304);
        LAS unsigned* CK = W + 320; LAS float* SV = (LAS float*)(W + 384); LAS int* SE = (LAS int*)(W + 400);
        const int c8 = lane & 7, r8 = lane >> 3;
        for (int blk = vcu; blk < M / 64; blk += G) {
            const int tok0 = blk * 64; const int b = tok0 / SEQ;
            const float* sp0 = SC + (size_t)(tok0 + wave * 8) * PQ + lane;
            float na0 = sp0[0], na1 = sp0[64], nb0 = sp0[128], nb1 = sp0[192];
            for (int j = 0; j < 8; ++j) {
                const int tl = wave * 8 + j;
                for (int h = 0; h < 8; ++h) {
                    const float a0 = na0, a1 = na1, b0 = nb0, b1 = nb1;
                    { const int nx = (j * 8 + h + 1) & 63; const float* sp = sp0 + (size_t)nx * 256; na0 = sp[0]; na1 = sp[64]; nb0 = sp[128]; nb1 = sp[192]; }
                    unsigned ka0 = (fkey(a0) & ~127u) | (unsigned)(127 - lane), ka1 = (fkey(a1) & ~127u) | (unsigned)(63 - lane);
                    unsigned kb0 = (fkey(b0) & ~127u) | (unsigned)(127 - lane), kb1 = (fkey(b1) & ~127u) | (unsigned)(63 - lane);
                    bitonic128x2(ka0, ka1, kb0, kb1, lane);
                    if (lane >= 56) { K1[127 - 2 * lane] = ka0; K1[126 - 2 * lane] = ka1; K2[127 - 2 * lane] = kb0; K2[126 - 2 * lane] = kb1; }
                    LDS_WAIT();
                    const int ci_i = CAND_I[lane], ci_j = CAND_J[lane];
                    const unsigned kA = K1[ci_i], kB = K2[ci_j];
                    const float cv = fdec(kA) + fdec(kB);
                    const unsigned ck = lane < 50 ? ((fkey(cv) & ~255u) | (unsigned)(255 - (ci_i * 16 + ci_j))) : 0u;
                    CK[lane] = ck;
                    LDS_WAIT();
                    int rc = 0;
#pragma unroll 8
                    for (int kk = 0; kk < 16; ++kk) { const v4u q = ((const LAS v4u*)CK)[kk]; rc += (q.x > ck) + (q.y > ck) + (q.z > ck) + (q.w > ck); }
                    if (lane < 50 && rc < 16) { SV[rc] = cv; SE[rc] = (int)((127u - (kA & 127u)) * 128u + (127u - (kB & 127u))); }
                    LDS_WAIT();
                    const float top0 = SV[0], myv = SV[lane & 15]; const int mye = SE[lane & 15];
                    const float e = __expf(myv - top0);
                    float ssum = e; ssum += __shfl_xor(ssum, 1); ssum += __shfl_xor(ssum, 2); ssum += __shfl_xor(ssum, 4); ssum += __shfl_xor(ssum, 8);
                    if (lane < 16) { EXPW[tl * 128 + h * 16 + lane] = (unsigned short)mye; GACT[tl * 128 + h * 16 + lane] = e / ssum; }
                    LDS_WAIT();
                }
            }
            LAS float* ACC = (LAS float*)(lds + RING_OFF + 81920);
            for (int i = lane; i < 8 * 128; i += 64) ACC[wave * 1024 + i] = 0.f;
            LDS_WAIT();
            {
                v4u gA[16], gB[16]; v4u hA, hB;
#define P10_LOADU(idx, G_, H_) do { const int s_ = (idx) >> 3, j_ = (idx) & 7; const int tl_ = wave * 8 + j_; \
                    const unsigned char* tb_ = UB + (size_t)s_ * NEXP * 128 + 16 * c8; \
                    H_ = *(const v4u*)(H8 + (size_t)(tok0 + tl_) * DM + 128 * s_ + 16 * c8); \
                    _Pragma("unroll") for (int i = 0; i < 16; ++i) { const unsigned e_ = EXPW[tl_ * 128 + r8 + 8 * i]; G_[i] = *(const v4u*)(tb_ + (size_t)e_ * 128); } } while (0)
#define P10_COMPU(idx, G_, H_) do { const int tl = wave * 8 + ((idx) & 7); int p[16]; \
                    _Pragma("unroll") for (int i = 0; i < 16; ++i) { int a_ = 0; \
                        a_ = __builtin_amdgcn_sdot4((int)G_[i].x, (int)H_.x, a_, false); a_ = __builtin_amdgcn_sdot4((int)G_[i].y, (int)H_.y, a_, false); \
                        a_ = __builtin_amdgcn_sdot4((int)G_[i].z, (int)H_.z, a_, false); a_ = __builtin_amdgcn_sdot4((int)G_[i].w, (int)H_.w, a_, false); p[i] = a_; } \
                    int q8[8], q4[4], q2[2]; \
                    _Pragma("unroll") for (int m = 0; m < 8; ++m) { const int snd = (c8 & 4) ? p[m] : p[m + 8], kp = (c8 & 4) ? p[m + 8] : p[m]; q8[m] = kp + __shfl_xor(snd, 4); } \
                    _Pragma("unroll") for (int m = 0; m < 4; ++m) { const int snd = (c8 & 2) ? q8[m] : q8[m + 4], kp = (c8 & 2) ? q8[m + 4] : q8[m]; q4[m] = kp + __shfl_xor(snd, 2); } \
                    _Pragma("unroll") for (int m = 0; m < 2; ++m) { const int snd = (c8 & 1) ? q4[m] : q4[m + 2], kp = (c8 & 1) ? q4[m + 2] : q4[m]; q2[m] = kp + __shfl_xor(snd, 1); } \
                    LAS float* ap = ACC + tl * 128 + r8 + 16 * c8;         \
                    ap[0] += (float)q2[0]; ap[8] += (float)q2[1]; } while (0)
                P10_LOADU(0, gA, hA);
#pragma unroll 1
                for (int idx = 0; idx < 256; idx += 2) {
                    P10_LOADU(idx + 1, gB, hB);
                    P10_COMPU(idx, gA, hA);
                    if (idx + 2 < 256) P10_LOADU(idx + 2, gA, hA);
                    P10_COMPU(idx + 1, gB, hB);
                }
#undef P10_LOADU
#undef P10_COMPU
            }
            LDS_WAIT();
            for (int i = lane; i < 8 * 128; i += 64) { const int o_ = wave * 1024 + i; const unsigned e = EXPW[o_];
                const float a = ACC[o_] * SCL[e] * TSC[tok0 + (o_ >> 7)]; GACT[o_] = gelu_tanh(a) * GACT[o_] * SCL[NEXP + e]; }
            LDS_WAIT();
            LAS float* SSQ = ACC;
            for (int j = 0; j < 8; ++j) SSQ[(wave * 8 + j) * 128 + lane] = 0.f;
            LDS_WAIT();
            const float* gtp = MODV + (size_t)(5 * 2 + b) * DM;
            {
                v4u gA[16], gB[16]; float aA[16], aB[16];
#define P10_LOADV(idx, G_, A_) do { const int s_ = (idx) >> 3, j_ = (idx) & 7; const int tl_ = wave * 8 + j_; \
                    const unsigned char* tb_ = VB + (size_t)s_ * NEXP * 128 + 16 * c8; \
                    _Pragma("unroll") for (int i = 0; i < 16; ++i) { const int k_ = tl_ * 128 + r8 + 8 * i; const unsigned e_ = EXPW[k_]; A_[i] = GACT[k_]; G_[i] = *(const v4u*)(tb_ + (size_t)e_ * 128); } } while (0)
#define P10_COMPV(idx, G_, A_) do { const int s_c = (idx) >> 3; const int tl = wave * 8 + ((idx) & 7); const int t = tok0 + tl; \
                    const int d = 128 * s_c + 16 * c8 + 2 * r8; \
                    const unsigned xw = __builtin_nontemporal_load((const unsigned*)(X1B + (size_t)t * DM + d)); const f32x2 gv = *(const f32x2*)(gtp + d);     \
                    const float ssq_old = SSQ[tl * 128 + lane]; \
                    f32x2 o8[8]; \
                    _Pragma("unroll") for (int q = 0; q < 8; ++q) o8[q] = (f32x2){0.f, 0.f}; \
                    _Pragma("unroll") for (int i = 0; i < 16; ++i) \
                        _Pragma("unroll") for (int q = 0; q < 4; ++q) { o8[2 * q] += __builtin_amdgcn_cvt_pk_f32_fp8((int)G_[i][q], false) * A_[i]; o8[2 * q + 1] += __builtin_amdgcn_cvt_pk_f32_fp8((int)G_[i][q], true) * A_[i]; } \
                    float p[16], q8[8], q4[4], q2[2]; \
                    _Pragma("unroll") for (int q = 0; q < 8; ++q) { p[2 * q] = o8[q].x; p[2 * q + 1] = o8[q].y; } \
                    _Pragma("unroll") for (int m = 0; m < 8; ++m) { const float snd = (r8 & 4) ? p[m] : p[m + 8], kp = (r8 & 4) ? p[m + 8] : p[m]; q8[m] = kp + __shfl_xor(snd, 32); } \
                    _Pragma("unroll") for (int m = 0; m < 4; ++m) { const float snd = (r8 & 2) ? q8[m] : q8[m + 4], kp = (r8 & 2) ? q8[m + 4] : q8[m]; q4[m] = kp + __shfl_xor(snd, 16); } \
                    _Pragma("unroll") for (int m = 0; m < 2; ++m) { const float snd = (r8 & 1) ? q4[m] : q4[m + 2], kp = (r8 & 1) ? q4[m + 2] : q4[m]; q2[m] = kp + __shfl_xor(snd, 8); } \
                    f32x2 y; y.x = bf_lo(xw) + gv.x * q2[0]; y.y = bf_hi(xw) + gv.y * q2[1]; \
                    __builtin_nontemporal_store(cvt_pk_bf16(y.x, y.y), (unsigned*)(YB + (size_t)t * DM + d)); \
                    SSQ[tl * 128 + lane] = ssq_old + (y.x * y.x + y.y * y.y); } while (0)
                P10_LOADV(0, gA, aA);
#pragma unroll 1
                for (int idx = 0; idx < 256; idx += 2) {
                    P10_LOADV(idx + 1, gB, aB);
                    P10_COMPV(idx, gA, aA);
                    if (idx + 2 < 256) P10_LOADV(idx + 2, gA, aA);
                    P10_COMPV(idx + 1, gB, aB);
                }
#undef P10_LOADV
#undef P10_COMPV
            }
            VM_WAIT(); LDS_WAIT();
            __builtin_amdgcn_fence(__ATOMIC_ACQUIRE, "agent");
            VM_WAIT();
            for (int j = 0; j < 8; ++j) {
                const int tl = wave * 8 + j; const int t = tok0 + tl;
                const float rstd = 1.0f / sqrtf(wave_sum(SSQ[tl * 128 + lane]) * (1.0f / DM) + RMS_EPS);
                f32x4* op = (f32x4*)(out + (size_t)t * DM) + lane; const f32x4* gp = (const f32x4*)g_final + lane; const v2u* yp = (const v2u*)(YB + (size_t)t * DM) + lane;
#pragma unroll 4
                for (int i = 0; i < 16; ++i) { const v2u yw = __builtin_nontemporal_load(yp + 64 * i); const f32x4 y = {bf_lo(yw.x), bf_hi(yw.x), bf_lo(yw.y), bf_hi(yw.y)}; __builtin_nontemporal_store(y * rstd * gp[64 * i], op + 64 * i); }
            }
            LDS_WAIT();
        }
    }
#undef IN
#undef BOTH
#undef GRID_BAR
}

extern "C" void kernel_launch(void* const* d_in, const int* in_sizes, int n_in, void* d_out, int out_size, void* d_ws, size_t ws_size, hipStream_t stream) {
    static int grid = 0;
    if (grid == 0) {
        if (n_in != 16 || in_sizes[0] != M * DM || out_size != M * DM || ws_size < WS_END) {
            fprintf(stderr, "kernel_launch: shape/workspace mismatch: n_in %d in0 %d out %d ws %zu (need %zu)\n", n_in, n_in > 0 ? in_sizes[0] : -1, out_size, ws_size, (size_t)WS_END); grid = -1; return; }
        int dev = 0, cus = 0, per_cu = 0;
        if (hipGetDevice(&dev) != hipSuccess || hipDeviceGetAttribute(&cus, hipDeviceAttributeMultiprocessorCount, dev) != hipSuccess) { grid = -1; return; }
        if (hipFuncSetAttribute((const void*)fwd_kernel, hipFuncAttributeMaxDynamicSharedMemorySize, LDS_BYTES) != hipSuccess) { fprintf(stderr, "kernel_launch: hipFuncSetAttribute failed\n"); grid = -1; return; }
        if (hipOccupancyMaxActiveBlocksPerMultiprocessor(&per_cu, (const void*)fwd_kernel, NWAVES * 64, LDS_BYTES) != hipSuccess || per_cu < 1)
            fprintf(stderr, "kernel_launch: note: occupancy query reports %d workgroups per CU\n", per_cu);
        (void)hipGetLastError();
        grid = cus;
    }
    if (grid < 0) return;
    if (hipMemsetAsync((char*)d_ws + WS_CTL, 0, CTL_ZERO_BYTES, stream) != hipSuccess) { fprintf(stderr, "kernel_launch: memset failed\n"); return; }
    Args a{};
    for (int i = 0; i < 16; ++i) a.in[i] = (const float*)d_in[i];
    a.out = (float*)d_out; a.ws = (unsigned char*)d_ws;
#ifdef PROBE_MASK
    {
#ifndef PROBE_PAD
#define PROBE_PAD 0
#endif
        a.mask = PROBE_MASK; a.pad = PROBE_PAD;
        hipLaunchKernelGGL(fwd_kernel, dim3(grid), dim3(NWAVES * 64), LDS_BYTES, stream, a);
        (void)hipMemsetAsync((char*)d_ws + WS_CTL, 0, CTL_ZERO_BYTES, stream);
    }
#endif
    for (int li = 0; li < MK_N_LAUNCHES; ++li) {
        a.mask = (MK_N_LAUNCHES == PER_PHASE) ? (1u << li) : ((1u << PER_PHASE) - 1u); a.pad = 0;
        hipLaunchKernelGGL(fwd_kernel, dim3(grid), dim3(NWAVES * 64), LDS_BYTES, stream, a);
        const hipError_t le = hipPeekAtLastError();
        if (le != hipSuccess) { fprintf(stderr, "kernel_launch: launch %d failed: %s\n", li, hipGetErrorName(le)); break; }
    }
}
```

```cpp
#include <hip/hip_runtime.h>
#include <cstdio>
#include <cstdint>

#ifndef MK_N_LAUNCHES
#define MK_N_LAUNCHES 1
#endif

#define GAS __attribute__((address_space(1)))
#define LAS __attribute__((address_space(3)))
typedef unsigned short bf16;
typedef unsigned v4u __attribute__((ext_vector_type(4)));
typedef unsigned v2u __attribute__((ext_vector_type(2)));
typedef float f32x4 __attribute__((ext_vector_type(4)));
typedef float f32x2 __attribute__((ext_vector_type(2)));
typedef float f32x16 __attribute__((ext_vector_type(16)));
typedef short bf16x8 __attribute__((ext_vector_type(8)));
typedef short s16x4 __attribute__((ext_vector_type(4)));
typedef __bf16 bf2_t __attribute__((ext_vector_type(2)));

constexpr int BATCH = 2, SEQ = 8192, DM = 4096, M = BATCH * SEQ;
constexpr int NH = 16, HD = 128, ATTW = 2048, POOLW = 2048, INW = 8192;
constexpr int NMOD = 6 * DM;
constexpr int PQ = 2048;
constexpr int NEXP = 16384;
constexpr float RMS_EPS = 1e-6f;
constexpr float LOG2E = 1.4426950408889634f;
constexpr float QSCALE = 0.08838834764831845f * LOG2E;
constexpr float H8SCALE = 16.f, W8SCALE = 64.f;
constexpr float A8SCALE = 64.f, P8SCALE = 16.f, WO8SCALE = 64.f;
constexpr int KS_ADA = 64;

constexpr size_t MiB = 1u << 20;
constexpr size_t WS_CTL = 0, CTL_ZERO_BYTES = 1 * MiB;
constexpr size_t WS_MODV = 1 * MiB;
constexpr size_t WS_SCL = 2 * MiB;
constexpr size_t WS_MODP = 4 * MiB;
constexpr size_t WS_SKT = 20 * MiB;
constexpr size_t WS_PWS = 22 * MiB;
constexpr size_t WS_WQST = 24 * MiB;
constexpr size_t WS_WOUT2 = 40 * MiB;
constexpr size_t WS_WINT = 72 * MiB;
constexpr size_t WS_WIN8 = 88 * MiB;
constexpr size_t WS_H8 = 1100 * MiB;
constexpr size_t WS_UB = 136 * MiB;
constexpr size_t WS_VB = 264 * MiB;
constexpr size_t WS_H = 392 * MiB;
constexpr size_t WS_PROJ = 520 * MiB;
constexpr size_t WS_QKVH = 1292 * MiB;
constexpr size_t WS_MIXIN = 776 * MiB;
constexpr size_t WS_WOPT = 904 * MiB;
constexpr size_t WS_WQB = 936 * MiB;
constexpr size_t WS_O0 = 968 * MiB, WS_O1 = 1032 * MiB;
constexpr size_t WS_LSE = 1096 * MiB;
constexpr size_t WS_SC = 1164 * MiB;
constexpr size_t WS_END = 1484 * MiB;

constexpr int RING_OFF = 0, RING_BYTES = 131072;
constexpr int ATT_WAVE_BYTES = 17408;
constexpr int SHARED_OFF = 139264;
constexpr int LDSCTL_OFF = 139264 + 4096, MISC_OFF = LDSCTL_OFF + 320;
constexpr int LDS_BYTES = 147456;
constexpr int NWAVES = 8;
constexpr int CW_BAR = 4096;

#define LDS_WAIT() asm volatile("s_waitcnt lgkmcnt(0)" ::: "memory")
#define VM_WAIT() asm volatile("s_waitcnt vmcnt(0)" ::: "memory")

__device__ __forceinline__ unsigned cvt_pk_bf16(float lo, float hi) { unsigned r; asm volatile("v_cvt_pk_bf16_f32 %0, %1, %2" : "=v"(r) : "v"(lo), "v"(hi)); return r; }
__device__ __forceinline__ float bf_lo(unsigned u) { return __uint_as_float(u << 16); }
__device__ __forceinline__ float bf_hi(unsigned u) { return __uint_as_float(u & 0xffff0000u); }
__device__ __forceinline__ float wave_sum(float v) {
#pragma unroll
    for (int o = 1; o < 64; o <<= 1) v += __shfl_xor(v, o);
    return v;
}

namespace pg8 {
typedef unsigned short bf16_t;
typedef int v4i_t __attribute__((ext_vector_type(4)));
typedef int v8i_t __attribute__((ext_vector_type(8)));
constexpr int BM = 256, BK = 64, HALF = 128, HTB = HALF * BK * 2, STAGE_BYTES = 8 * HTB, NXCD = 8, WGM = 8;

__host__ __device__ __forceinline__ int lds_byte(int r, int c) { const int st = (r >> 4) * 2 + (c >> 5), rr = r & 15, cc = c & 31, ob = rr * 64 + cc * 2; return st * 1024 + (ob ^ (((ob >> 9) & 1) << 5)); }
__host__ __device__ __forceinline__ void stage_rc(int b, int& R, int& C) { const int st = b / 1024, sb = b % 1024, swz = sb ^ (((sb >> 9) & 1) << 5); R = (st >> 1) * 16 + swz / 64; C = (st & 1) * 32 + (swz % 64) / 2; }
__host__ __device__ __forceinline__ int perm32(int rho) { const int n = rho >> 4, i = rho & 15; return 8 * (i >> 2) + 4 * n + (i & 3); }

template <int NF> __device__ __forceinline__ void pg8_ldfrag16(bf16x8 (&dst)[NF][2], const LAS unsigned char* base, int off) {
#pragma unroll
    for (int m = 0; m < NF; ++m)
#pragma unroll
        for (int k = 0; k < 2; ++k) dst[m][k] = *(const LAS bf16x8*)(base + off + m * 2048 + k * 1024);
}
template <int NF> __device__ __forceinline__ void pg8_ldfrag8(v8i_t (&dst)[NF], const LAS unsigned char* base, int off1, int off2) {
#pragma unroll
    for (int m = 0; m < NF; ++m) { const v4i_t lo = *(const LAS v4i_t*)(base + off1 + m * 2048), hi = *(const LAS v4i_t*)(base + off2 + m * 2048); dst[m] = __builtin_shufflevector(lo, hi, 0, 1, 2, 3, 4, 5, 6, 7); }
}
__device__ __forceinline__ void pg8_mma16(f32x4 (&acc)[4][2], const bf16x8 (&At)[4][2], const bf16x8 (&Bt)[2][2]) {
#pragma unroll
    for (int m = 0; m < 4; ++m)
#pragma unroll
        for (int n = 0; n < 2; ++n)
#pragma unroll
            for (int k = 0; k < 2; ++k) acc[m][n] = __builtin_amdgcn_mfma_f32_16x16x32_bf16(Bt[n][k], At[m][k], acc[m][n], 0, 0, 0);
}
__device__ __forceinline__ void pg8_mma8(f32x4 (&acc)[4][2], const v8i_t (&At)[4], const v8i_t (&Bt)[2]) {
    int sc = 0x7F7F7F7F;
#pragma unroll
    for (int m = 0; m < 4; ++m)
#pragma unroll
        for (int n = 0; n < 2; ++n) asm volatile("v_mfma_scale_f32_16x16x128_f8f6f4 %0, %1, %2, %0, %3, %3 op_sel_hi:[0,0,0]" : "+v"(acc[m][n]) : "v"(Bt[n]), "v"(At[m]), "v"(sc));
}
struct Unit { int pm, pn; };
struct Gemm { const bf16_t* A; const bf16_t* Bt; int M, N, K, lda, ldb, agrp_div, agrp_cols, bgrp_div, bgrp_cols; };

struct StaticOrder {
    int nM, nN, nwg, G, c;
    __host__ __device__ void init(int M_, int N_, int G_, int c_) { nM = M_ / BM; nN = N_ / BM; nwg = nM * nN; G = G_; c = c_; }
    __host__ __device__ bool next(int i, Unit& u) const {
        const long L = (long)i * G + c; if (L >= nwg) return false;
        int wgid = (int)L; { const int q = nwg / NXCD, r = nwg % NXCD, xcd = wgid % NXCD, off = wgid / NXCD; wgid = (xcd < r ? xcd * (q + 1) : r * (q + 1) + (xcd - r) * q) + off; }
        const int nig = WGM * nN, gid = wgid / nig, fm = gid * WGM, gsz = (nM - fm) < WGM ? (nM - fm) : WGM;
        u.pm = fm + ((wgid % nig) % gsz); u.pn = (wgid % nig) / gsz; return true;
    }
    __device__ __forceinline__ void a_ready(const Unit&) const {}
    __device__ __forceinline__ void done(const Unit&) const {}
};

struct EpiBf16 {
    static constexpr bool PERM = true, AFTER_DRAIN = false;
    bf16_t* O; int ldc; int scale_cols; float scale0; bf16_t* HM; int hm_cols; int hm_rows; float scale1 = 1.0f;
    __device__ __forceinline__ void operator()(const f32x4 (&acc)[2][2][4][2], const Unit& u, int wr, int wc, int fr, int fq) const {
        const int row0 = u.pm * BM + wr * 64 + fr; const int colt = u.pn * BM;
        const float sc = (colt < scale_cols) ? scale0 : scale1;
        const bool hm = colt < hm_cols;
        const int cw = wc * 32 + 8 * fq;
        bf16_t* base = hm ? HM + (size_t)(colt / HALF) * hm_rows * HALF + cw : O + (colt - hm_cols) + cw;
        const size_t rpitch = hm ? (size_t)HALF : (size_t)ldc, hstep = hm ? (size_t)hm_rows * HALF : (size_t)HALF;
#pragma unroll
        for (int ai = 0; ai < 2; ++ai)
#pragma unroll
            for (int m = 0; m < 4; ++m) { bf16_t* rowp = base + (size_t)(row0 + ai * HALF + m * 16) * rpitch;
#pragma unroll
                for (int bj = 0; bj < 2; ++bj) { f32x4 v0 = acc[ai][bj][m][0] * sc, v1 = acc[ai][bj][m][1] * sc;
                    v4u w; w.x = cvt_pk_bf16(v0[0], v0[1]); w.y = cvt_pk_bf16(v0[2], v0[3]); w.z = cvt_pk_bf16(v1[0], v1[1]); w.w = cvt_pk_bf16(v1[2], v1[3]);
                    *(v4u*)(rowp + bj * hstep) = w; } }
    }
};
struct EpiBf16ColScale {
    static constexpr bool PERM = true, AFTER_DRAIN = false;
    bf16_t* O; int ldc; int coff; const float* cs;
    __device__ __forceinline__ void operator()(const f32x4 (&acc)[2][2][4][2], const Unit& u, int wr, int wc, int fr, int fq) const {
        const int row0 = u.pm * BM + wr * 64 + fr; const int col0 = u.pn * BM + wc * 32 + 8 * fq;
        f32x4 sv[2][2];
#pragma unroll
        for (int bj = 0; bj < 2; ++bj)
#pragma unroll
            for (int n = 0; n < 2; ++n) sv[bj][n] = *(const f32x4*)(cs + col0 + bj * HALF + 4 * n);
#pragma unroll
        for (int ai = 0; ai < 2; ++ai)
#pragma unroll
            for (int m = 0; m < 4; ++m) { bf16_t* rowp = O + (size_t)(row0 + ai * HALF + m * 16) * ldc + coff + col0;
#pragma unroll
                for (int bj = 0; bj < 2; ++bj) { f32x4 v0 = acc[ai][bj][m][0] * sv[bj][0], v1 = acc[ai][bj][m][1] * sv[bj][1];
                    v4u w; w.x = cvt_pk_bf16(v0[0], v0[1]); w.y = cvt_pk_bf16(v0[2], v0[3]); w.z = cvt_pk_bf16(v1[0], v1[1]); w.w = cvt_pk_bf16(v1[2], v1[3]);
                    *(v4u*)(rowp + bj * HALF) = w; } }
    }
};
struct EpiFp8 {
    static constexpr bool PERM = true, AFTER_DRAIN = false;
    unsigned char* O; int ldc; int coff; float scale;
    __device__ __forceinline__ void operator()(const f32x4 (&acc)[2][2][4][2], const Unit& u, int wr, int wc, int fr, int fq) const {
        const int row0 = u.pm * BM + wr * 64 + fr; const int col0 = u.pn * BM + wc * 32 + 8 * fq;
#pragma unroll
        for (int ai = 0; ai < 2; ++ai)
#pragma unroll
            for (int m = 0; m < 4; ++m) { unsigned char* rowp = O + (size_t)(row0 + ai * HALF + m * 16) * ldc + coff + col0;
#pragma unroll
                for (int bj = 0; bj < 2; ++bj) { const f32x4 v0 = acc[ai][bj][m][0] * scale, v1 = acc[ai][bj][m][1] * scale; int lo = 0, hi = 0;
                    lo = __builtin_amdgcn_cvt_pk_fp8_f32(v0[0], v0[1], lo, false); lo = __builtin_amdgcn_cvt_pk_fp8_f32(v0[2], v0[3], lo, true);
                    hi = __builtin_amdgcn_cvt_pk_fp8_f32(v1[0], v1[1], hi, false); hi = __builtin_amdgcn_cvt_pk_fp8_f32(v1[2], v1[3], hi, true);
                    *(v2u*)(rowp + bj * HALF) = (v2u){(unsigned)lo, (unsigned)hi}; } }
    }
};
struct EpiResBf16 {
    static constexpr bool PERM = true, AFTER_DRAIN = false;
    const float* X; const float* gate; bf16_t* O; int ldc; float ascale;
    __device__ __forceinline__ void operator()(const f32x4 (&acc)[2][2][4][2], const Unit& u, int wr, int wc, int fr, int fq) const {
        const int row0 = u.pm * BM + wr * 64 + fr; const int col0 = u.pn * BM + wc * 32 + 8 * fq; const int b = (u.pm * BM) / SEQ;
        f32x4 gv[2][2];
#pragma unroll
        for (int bj = 0; bj < 2; ++bj)
#pragma unroll
            for (int n = 0; n < 2; ++n) gv[bj][n] = *(const f32x4*)(gate + (size_t)b * DM + col0 + bj * HALF + 4 * n) * ascale;
#pragma unroll
        for (int ai = 0; ai < 2; ++ai)
#pragma unroll
            for (int m = 0; m < 4; ++m) { const size_t off = (size_t)(row0 + ai * HALF + m * 16) * ldc + col0;
#pragma unroll
                for (int bj = 0; bj < 2; ++bj) { const f32x4 x0 = *(const f32x4*)(X + off + bj * HALF), x1 = *(const f32x4*)(X + off + bj * HALF + 4);
                    const f32x4 v0 = x0 + gv[bj][0] * acc[ai][bj][m][0], v1 = x1 + gv[bj][1] * acc[ai][bj][m][1];
                    v4u w; w.x = cvt_pk_bf16(v0[0], v0[1]); w.y = cvt_pk_bf16(v0[2], v0[3]); w.z = cvt_pk_bf16(v1[0], v1[1]); w.w = cvt_pk_bf16(v1[2], v1[3]);
                    *(v4u*)(O + off + bj * HALF) = w; } }
    }
};
struct EpiResF32 {
    static constexpr bool PERM = false, AFTER_DRAIN = false;
    const float* X; const float* gate; float* O; int ldc;
    __device__ __forceinline__ void operator()(const f32x4 (&acc)[2][2][4][2], const Unit& u, int wr, int wc, int fr, int fq) const {
        const int row0 = u.pm * BM + wr * 64 + fr; const int col0 = u.pn * BM + wc * 32 + 4 * fq; const int b = (u.pm * BM) / SEQ;
        f32x4 gv[2][2];
#pragma unroll
        for (int bj = 0; bj < 2; ++bj)
#pragma unroll
            for (int n = 0; n < 2; ++n) gv[bj][n] = *(const f32x4*)(gate + (size_t)b * DM + col0 + bj * HALF + n * 16);
#pragma unroll
        for (int ai = 0; ai < 2; ++ai)
#pragma unroll
            for (int m = 0; m < 4; ++m) { const size_t off = (size_t)(row0 + ai * HALF + m * 16) * ldc + col0;
#pragma unroll
                for (int bj = 0; bj < 2; ++bj)
#pragma unroll
                    for (int n = 0; n < 2; ++n) { const f32x4 xv = *(const f32x4*)(X + off + bj * HALF + n * 16);
                        *(f32x4*)(O + off + bj * HALF + n * 16) = xv + gv[bj][n] * acc[ai][bj][m][n]; } }
    }
};
struct EpiF32 {
    static constexpr bool PERM = false, AFTER_DRAIN = false;
    float* O; int ldc;
    __device__ __forceinline__ void operator()(const f32x4 (&acc)[2][2][4][2], const Unit& u, int wr, int wc, int fr, int fq) const {
        const int row0 = u.pm * BM + wr * 64 + fr; const int col0 = u.pn * BM + wc * 32 + 4 * fq;
#pragma unroll
        for (int ai = 0; ai < 2; ++ai)
#pragma unroll
            for (int m = 0; m < 4; ++m) { const size_t off = (size_t)(row0 + ai * HALF + m * 16) * ldc + col0;
#pragma unroll
                for (int bj = 0; bj < 2; ++bj)
#pragma unroll
                    for (int n = 0; n < 2; ++n) *(f32x4*)(O + off + bj * HALF + n * 16) = acc[ai][bj][m][n]; }
    }
};

template <class Epi, class Sched, bool ALIGN_EPI, bool FP8 = false>
__device__ __forceinline__ void gemm_phase(LAS unsigned char* lds, const Gemm g, const Sched& S, const Epi& E) {
    int tid_ = threadIdx.x; asm volatile("" : "+v"(tid_));
    const int tid = tid_, wid = __builtin_amdgcn_readfirstlane(tid >> 6), lane = tid & 63, wr = wid >> 2, wc = wid & 3, fr = lane & 15, fq = lane >> 4;
    const int K = g.K, nt = K / BK;
    unsigned voffA, voffB;
    { int R, C; stage_rc(tid * 16, R, C); const int Rb = Epi::PERM ? ((R & ~31) + perm32(R & 31)) : R;
      voffA = (unsigned)(R * g.lda + C) * 2u; voffB = (unsigned)(Rb * g.ldb + C) * 2u; }
    const size_t pstepA = (size_t)64 * g.lda * 2, pstepB = (size_t)64 * g.ldb * 2;
    const size_t kstep = (size_t)(BK * 2);
    const size_t hstepA = (size_t)HALF * g.lda * 2, hstepB = (size_t)HALF * g.ldb * 2;
    const size_t tstepA = 2 * hstepA, tstepB = 2 * hstepB;
    const unsigned ldsw = (unsigned)wid * 1024u;
    const int aoff = lds_byte(wr * 64 + fr, fq * 8), boff = lds_byte(wc * 32 + fr, fq * 8);
    const int h8 = (fq >> 1) & 1;
    const int aoff1 = lds_byte(wr * 64 + fr, fq * 16 + h8 * 8), aoff2 = lds_byte(wr * 64 + fr, fq * 16 + (1 - h8) * 8);
    const int boff1 = lds_byte(wc * 32 + fr, fq * 16 + h8 * 8), boff2 = lds_byte(wc * 32 + fr, fq * 16 + (1 - h8) * 8);
#define PG8_SA(b, h) (((b) * 2 + (h)) * HTB)
#define PG8_SB(b, h) ((4 + (b) * 2 + (h)) * HTB)
#define PG8_STAGE(bufoff, gbase, voff) do { _Pragma("unroll") for (int _i = 0; _i < 2; ++_i) \
        __builtin_amdgcn_global_load_lds((const unsigned*)((const char*)(gbase) + (size_t)_i * pstep_##voff + (voff)), (LAS unsigned*)(lds + (bufoff) + ldsw + _i * 8192), 16, 0, 0); } while (0)
#define pstep_voffA pstepA
#define pstep_voffB pstepB
#define PG8_LDA(dst, b, h) do { if constexpr (FP8) pg8_ldfrag8<4>(dst##8, lds + PG8_SA(b, h), aoff1, aoff2); else pg8_ldfrag16<4>(dst, lds + PG8_SA(b, h), aoff); } while (0)
#define PG8_LDB(dst, b, h) do { if constexpr (FP8) pg8_ldfrag8<2>(dst##8, lds + PG8_SB(b, h), boff1, boff2); else pg8_ldfrag16<2>(dst, lds + PG8_SB(b, h), boff); } while (0)
#define PG8_MMA(ai, bj, At, Bt) do { __builtin_amdgcn_s_setprio(1); if constexpr (FP8) pg8_mma8(acc[ai][bj], At##8, Bt##8); else pg8_mma16(acc[ai][bj], At, Bt); __builtin_amdgcn_s_setprio(0); } while (0)
#define PG8_WAIT_V(n) asm volatile("s_waitcnt vmcnt(" #n ")" ::: "memory")
#define PG8_WAIT_L(n) asm volatile("s_waitcnt lgkmcnt(" #n ")" ::: "memory")
#define PG8_BAR __builtin_amdgcn_s_barrier()
#define PG8_SCHED __builtin_amdgcn_sched_barrier(0)
#define PG8_ABASE(u) ((const char*)g.A + (size_t)(u).pm * tstepA + (size_t)((u).pn / g.agrp_div) * (size_t)g.agrp_cols * 2)
#define PG8_BBASE(u) ((const char*)g.Bt + (size_t)(u).pn * tstepB + (size_t)((u).pm / g.bgrp_div) * (size_t)g.bgrp_cols * 2)
    Unit cur, nxt; int ui = 0;
    if (!S.next(0, cur)) return;
    f32x4 acc[2][2][4][2];
#pragma unroll
    for (int a = 0; a < 2; ++a)
#pragma unroll
        for (int b = 0; b < 2; ++b)
#pragma unroll
            for (int m = 0; m < 4; ++m)
#pragma unroll
                for (int n = 0; n < 2; ++n) acc[a][b][m][n] = (f32x4){0.f, 0.f, 0.f, 0.f};
    bf16x8 At[4][2], B0[2][2], B1[2][2]; v8i_t At8[4], B08[2], B18[2];
    const char* cA = PG8_ABASE(cur); const char* cB = PG8_BBASE(cur);
    S.a_ready(cur);
    PG8_STAGE(PG8_SB(0, 0), cB, voffB); PG8_STAGE(PG8_SB(0, 1), cB + hstepB, voffB); PG8_STAGE(PG8_SA(0, 0), cA, voffA); PG8_STAGE(PG8_SA(0, 1), cA + hstepA, voffA);
    if (wr == 1) PG8_BAR;
    PG8_WAIT_V(2); PG8_BAR;
    PG8_STAGE(PG8_SB(1, 0), cB + kstep, voffB); PG8_STAGE(PG8_SA(1, 0), cA + kstep, voffA); PG8_STAGE(PG8_SB(1, 1), cB + hstepB + kstep, voffB);
    PG8_WAIT_V(6); PG8_BAR;
    for (;;) {
        const bool has_next = S.next(ui + 1, nxt);
        const char* nA = has_next ? PG8_ABASE(nxt) : cA; const char* nB = has_next ? PG8_BBASE(nxt) : cB;
        for (int t = 0; t < nt; t += 2) {
            const bool last = (t == nt - 2);
            const char* a1 = cA + (size_t)(t + 1) * kstep;
            const char* a2 = last ? nA : cA + (size_t)(t + 2) * kstep; const char* b2 = last ? nB : cB + (size_t)(t + 2) * kstep;
            const char* a3 = a2 + kstep; const char* b3 = b2 + kstep;
            if (last && has_next) S.a_ready(nxt);
            PG8_LDB(B0, 0, 0); PG8_LDB(B1, 0, 1); PG8_SCHED; PG8_LDA(At, 0, 0); PG8_STAGE(PG8_SA(1, 1), a1 + hstepA, voffA);
            PG8_WAIT_V(8); PG8_WAIT_L(0); PG8_BAR; PG8_MMA(0, 0, At, B0); PG8_MMA(0, 1, At, B1); PG8_BAR; PG8_SCHED;
            PG8_LDA(At, 0, 1); PG8_STAGE(PG8_SB(0, 0), b2, voffB); PG8_STAGE(PG8_SB(0, 1), b2 + hstepB, voffB); PG8_STAGE(PG8_SA(0, 0), a2, voffA);
            PG8_WAIT_V(8); PG8_WAIT_L(0); PG8_BAR; PG8_MMA(1, 0, At, B0); PG8_MMA(1, 1, At, B1); PG8_BAR; PG8_SCHED;
            PG8_LDB(B0, 1, 0); PG8_LDB(B1, 1, 1); PG8_SCHED; PG8_LDA(At, 1, 0); PG8_STAGE(PG8_SA(0, 1), a2 + hstepA, voffA);
            PG8_WAIT_V(8); PG8_WAIT_L(0); PG8_BAR; PG8_MMA(0, 0, At, B0); PG8_MMA(0, 1, At, B1); PG8_BAR; PG8_SCHED;
            PG8_LDA(At, 1, 1); PG8_STAGE(PG8_SB(1, 0), b3, voffB); PG8_STAGE(PG8_SB(1, 1), b3 + hstepB, voffB); PG8_STAGE(PG8_SA(1, 0), a3, voffA);
            PG8_WAIT_V(8); PG8_WAIT_L(0); PG8_BAR; PG8_MMA(1, 0, At, B0); PG8_MMA(1, 1, At, B1); PG8_BAR; PG8_SCHED;
        }
        if constexpr (ALIGN_EPI) { if (wr == 0) PG8_BAR; }
        if constexpr (FP8) asm volatile("s_nop 15\n\ts_nop 15" ::: "memory");
        if constexpr (FP8) { int ln_ = lane; asm volatile("" : "+v"(ln_));
          E(acc, cur, wr, wc, ln_ & 15, ln_ >> 4); } else E(acc, cur, wr, wc, fr, fq);
        S.done(cur);
        if (!has_next) break;
#pragma unroll
        for (int a = 0; a < 2; ++a)
#pragma unroll
            for (int b = 0; b < 2; ++b)
#pragma unroll
                for (int m = 0; m < 4; ++m)
#pragma unroll
                    for (int n = 0; n < 2; ++n) acc[a][b][m][n] = (f32x4){0.f, 0.f, 0.f, 0.f};
        cur = nxt; cA = nA; cB = nB; ++ui;
        if constexpr (ALIGN_EPI) { if (wr == 1) PG8_BAR; }
    }
    PG8_WAIT_V(0);
    if constexpr (!ALIGN_EPI) { if (wr == 0) PG8_BAR; }
    PG8_BAR;
#undef PG8_SA
#undef PG8_SB
#undef PG8_STAGE
#undef pstep_voffA
#undef pstep_voffB
#undef PG8_LDA
#undef PG8_LDB
#undef PG8_MMA
#undef PG8_WAIT_V
#undef PG8_WAIT_L
#undef PG8_BAR
#undef PG8_SCHED
#undef PG8_ABASE
#undef PG8_BBASE
}
}

#define XB_TMO      128
#define XB_XCNT(j)  (256  + 64 * (j))
#define XB_XSUB(j)  (1280 + 64 * (j))
#define XB_XGEN(j)  (2304 + 64 * (j))
#define XB_TOP      3328
#define XB_TOPGEN   3392
#define XCD_BAR_WORDS 3456
#define XB_SPIN_CAP (1u << 18)

__device__ __forceinline__ unsigned xb_ld(unsigned* p)              { return __hip_atomic_load(p, __ATOMIC_RELAXED, __HIP_MEMORY_SCOPE_AGENT); }
__device__ __forceinline__ unsigned xb_add(unsigned* p, unsigned v) { return __hip_atomic_fetch_add(p, v, __ATOMIC_RELAXED, __HIP_MEMORY_SCOPE_AGENT); }
__device__ __forceinline__ unsigned xb_xcc_id() { return (unsigned)__builtin_amdgcn_s_getreg((3 << 11) | 20) & 0xFu; }
#define XB_SPIN(cond, bar) do { unsigned _sp = 0; while (cond) { __builtin_amdgcn_s_sleep(1); \
    if ((++_sp & 255u) == 0u) { if (xb_ld(&(bar)[XB_TMO])) break; if (_sp > XB_SPIN_CAP) { atomicAdd(&(bar)[XB_TMO], 1u); break; } } } } while (0)

struct XcdBarrier { unsigned* bar; unsigned x; volatile LAS unsigned* st; };

__device__ __forceinline__ XcdBarrier xcd_barrier_post(unsigned* bar, volatile LAS unsigned* st) {
    XcdBarrier b; b.bar = bar; b.x = xb_xcc_id(); b.st = st;
    if (threadIdx.x == 0) (void)xb_add(&bar[XB_XCNT(b.x)], 1u);
    return b;
}
__device__ __forceinline__ void xcd_barrier_complete(unsigned* bar, unsigned x, unsigned& nloc, unsigned& nx) {
    const unsigned G = gridDim.x * gridDim.y * gridDim.z;
    unsigned sum, cnt, mine, sp = 0u;
    for (;;) {
        sum = 0u; cnt = 0u; mine = 0u;
#pragma unroll
        for (unsigned j = 0; j < 16; ++j) { const unsigned c = xb_ld(&bar[XB_XCNT(j)]); sum += c; cnt += (c > 0u) ? 1u : 0u; mine = (j == x) ? c : mine; }
        if (sum == G) break;
        __builtin_amdgcn_s_sleep(1);
        if ((++sp & 255u) == 0u) { if (xb_ld(&bar[XB_TMO])) break; if (sp > XB_SPIN_CAP) { atomicAdd(&bar[XB_TMO], 1u); break; } }
    }
    nloc = mine > 0u ? mine : 1u; nx = cnt > 0u ? cnt : 1u;
}
__device__ __forceinline__ void xcd_barrier(const XcdBarrier& b) {
    asm volatile("s_waitcnt vmcnt(0)" ::: "memory");
    __syncthreads();
    if (threadIdx.x == 0) {
        unsigned* bar = b.bar;
        __builtin_amdgcn_s_waitcnt(0);
        unsigned nloc = b.st[0], nx = b.st[1];
        if (nloc == 0u) { xcd_barrier_complete(bar, b.x, nloc, nx); b.st[0] = nloc; b.st[1] = nx; }
        const unsigned old = xb_add(&bar[XB_XSUB(b.x)], 1u);
        const unsigned gen = old / nloc;
        if (old + 1u == (gen + 1u) * nloc) {
            __builtin_amdgcn_fence(__ATOMIC_RELEASE, "agent");
            asm volatile("s_waitcnt vmcnt(0)" ::: "memory");
            const unsigned og = xb_add(&bar[XB_TOP], 1u);
            const unsigned tg = og / nx;
            if (og + 1u == (tg + 1u) * nx) xb_add(&bar[XB_TOPGEN], 1u);
            else XB_SPIN(xb_ld(&bar[XB_TOPGEN]) == tg, bar);
            __builtin_amdgcn_fence(__ATOMIC_ACQUIRE, "agent");
            xb_add(&bar[XB_XGEN(b.x)], 1u);
            asm volatile("s_waitcnt vmcnt(0)" ::: "memory");
        } else {
            XB_SPIN(xb_ld(&bar[XB_XGEN(b.x)]) == gen, bar);
            __builtin_amdgcn_fence(__ATOMIC_ACQUIRE, "agent");
            asm volatile("s_waitcnt vmcnt(0)" ::: "memory");
        }
    }
    __syncthreads();
}

template <bool F8>
__device__ __forceinline__ void p0_transpose_item(const float* W, int ldw, int N, void* WTv, int ldt, float scale, LAS float* scr, int item, int lane) {
    const int nblk = N / 32, kb = item / nblk, nb = item % nblk, k0 = 64 * kb, n0 = 32 * nb;
#pragma unroll 8
    for (int i = 0; i < 32; ++i) { const int kk = 2 * i + (lane >> 5); scr[kk * 33 + (lane & 31)] = W[(size_t)(k0 + kk) * ldw + n0 + (lane & 31)]; }
    LDS_WAIT(); asm volatile("" ::: "memory");
    const int c = lane & 7;
#pragma unroll
    for (int j = 0; j < 4; ++j) { const int n = (lane >> 3) + 8 * j; const LAS float* s = scr + (8 * c) * 33 + n;
        if constexpr (F8) { int lo = 0, hi = 0;
            lo = __builtin_amdgcn_cvt_pk_fp8_f32(s[0 * 33] * scale, s[1 * 33] * scale, lo, false); lo = __builtin_amdgcn_cvt_pk_fp8_f32(s[2 * 33] * scale, s[3 * 33] * scale, lo, true);
            hi = __builtin_amdgcn_cvt_pk_fp8_f32(s[4 * 33] * scale, s[5 * 33] * scale, hi, false); hi = __builtin_amdgcn_cvt_pk_fp8_f32(s[6 * 33] * scale, s[7 * 33] * scale, hi, true);
            *(GAS v2u*)((unsigned char*)WTv + (size_t)(n0 + n) * ldt + k0 + 8 * c) = (v2u){(unsigned)lo, (unsigned)hi};
        } else {
            v4u o; o.x = cvt_pk_bf16(s[0 * 33], s[1 * 33]); o.y = cvt_pk_bf16(s[2 * 33], s[3 * 33]); o.z = cvt_pk_bf16(s[4 * 33], s[5 * 33]); o.w = cvt_pk_bf16(s[6 * 33], s[7 * 33]);
            *(GAS v4u*)((bf16*)WTv + (size_t)(n0 + n) * ldt + k0 + 8 * c) = o; } }
    LDS_WAIT(); asm volatile("" ::: "memory");
}

__device__ __forceinline__ int t5_bucket(int rel) {
    int n = -rel; const int ret = n < 0 ? 16 : 0; n = n < 0 ? -n : n;
    if (n < 8) return ret + n;
    const float v = logf((float)n / 8.0f) / logf(128.0f) * 8.0f;
    int large = 8 + (int)v; large = large < 15 ? large : 15;
    return ret + large;
}
__device__ __forceinline__ float gelu_tanh(float x) {
    const float z = 0.7978845608028654f * (x + 0.044715f * x * x * x);
    const float e = __expf(2.0f * z);
    const float t = 1.0f - 2.0f / (e + 1.0f);
    return 0.5f * x * (1.0f + t);
}
__device__ __forceinline__ unsigned fkey(float v) { const unsigned u = __float_as_uint(v); return (u >> 31) ? ~u : (u | 0x80000000u); }
__device__ __forceinline__ float fdec(unsigned key) { const unsigned k2 = key & ~127u; const unsigned u = (k2 >> 31) ? (k2 & 0x7fffffffu) : (~k2 & ~127u); return __uint_as_float(u); }
template <int LJ> __device__ __forceinline__ unsigned xshfl(unsigned x, const int lane) {
    if constexpr (LJ == 1) return (unsigned)__builtin_amdgcn_update_dpp(0, (int)x, 0xB1, 0xF, 0xF, false);
    else if constexpr (LJ == 2) return (unsigned)__builtin_amdgcn_update_dpp(0, (int)x, 0x4E, 0xF, 0xF, false);
    else if constexpr (LJ == 4) { const int y = __builtin_amdgcn_update_dpp(0, (int)x, 0x141, 0xF, 0xF, false); return (unsigned)__builtin_amdgcn_update_dpp(0, y, 0x1B, 0xF, 0xF, false); }
    else if constexpr (LJ == 8) { const int y = __builtin_amdgcn_update_dpp(0, (int)x, 0x140, 0xF, 0xF, false); return (unsigned)__builtin_amdgcn_update_dpp(0, y, 0x141, 0xF, 0xF, false); }
    else if constexpr (LJ == 16) return (unsigned)__builtin_amdgcn_ds_swizzle((int)x, 0x401F);
    else { const auto rr = __builtin_amdgcn_permlane32_swap(x, x, false, false); return lane < 32 ? rr[1] : rr[0]; }
}
template <int K, int J> __device__ __forceinline__ void bitonic_step(unsigned& a0, unsigned& a1, unsigned& b0, unsigned& b1, const int lane) {
    const bool asc = (K == 128) ? true : ((lane & (K >> 1)) == 0);
    if constexpr (J == 1) {
        const unsigned la = a0 < a1 ? a0 : a1, ha = a0 < a1 ? a1 : a0, lb = b0 < b1 ? b0 : b1, hb = b0 < b1 ? b1 : b0;
        a0 = asc ? la : ha; a1 = asc ? ha : la; b0 = asc ? lb : hb; b1 = asc ? hb : lb;
    } else {
        constexpr int LJ = J >> 1; const bool tmin = (((lane & LJ) == 0) == asc);
        const unsigned pa0 = xshfl<LJ>(a0, lane), pa1 = xshfl<LJ>(a1, lane), pb0 = xshfl<LJ>(b0, lane), pb1 = xshfl<LJ>(b1, lane);
        a0 = tmin ? (a0 < pa0 ? a0 : pa0) : (a0 < pa0 ? pa0 : a0); a1 = tmin ? (a1 < pa1 ? a1 : pa1) : (a1 < pa1 ? pa1 : a1);
        b0 = tmin ? (b0 < pb0 ? b0 : pb0) : (b0 < pb0 ? pb0 : b0); b1 = tmin ? (b1 < pb1 ? b1 : pb1) : (b1 < pb1 ? pb1 : b1);
    }
    if constexpr (J > 1) bitonic_step<K, (J >> 1)>(a0, a1, b0, b1, lane);
}
template <int K> __device__ __forceinline__ void bitonic_stage(unsigned& a0, unsigned& a1, unsigned& b0, unsigned& b1, const int lane) {
    bitonic_step<K, (K >> 1)>(a0, a1, b0, b1, lane);
    if constexpr (K < 128) bitonic_stage<(K << 1)>(a0, a1, b0, b1, lane);
}
__device__ __forceinline__ void bitonic128x2(unsigned& a0, unsigned& a1, unsigned& b0, unsigned& b1, const int lane) { bitonic_stage<2>(a0, a1, b0, b1, lane); }
__device__ __forceinline__ unsigned q8x4(f32x4 v, float s) {
    const unsigned b0 = __float_as_uint(v[0] * s + 12582912.0f), b1 = __float_as_uint(v[1] * s + 12582912.0f), b2 = __float_as_uint(v[2] * s + 12582912.0f), b3 = __float_as_uint(v[3] * s + 12582912.0f);
    return (b0 & 0xffu) | ((b1 & 0xffu) << 8) | ((b2 & 0xffu) << 16) | (b3 << 24);
}
__device__ __forceinline__ float dot2bf(unsigned a, unsigned b, float c) { return __builtin_amdgcn_fdot2_f32_bf16(__builtin_bit_cast(bf2_t, a), __builtin_bit_cast(bf2_t, b), c, false); }

constexpr int ATT_SLOT = 8704;
__device__ __forceinline__ int crow(int r, int hi) { return (r & 3) + 8 * (r >> 2) + 4 * hi; }

__device__ __forceinline__ void attn_task(const int G, const bf16* QKVH, bf16* O0, bf16* O1, float* LSE0, float* LSE1, unsigned char* MIX8,
                                          const LAS float* btab, LAS unsigned char* wl, int b, int h, int mtile, int tk, int lane) {
    const int SH = 2 * G;
    const int L = SEQ >> SH, TPR = 32 >> SH;
    const int r32 = lane & 31, hi = lane >> 5;
    const int res = tk >> (5 - SH), l0 = ((mtile * 1024) >> SH) + 32 * (tk & (TPR - 1));
    const size_t rowbase = (size_t)b * SEQ;
    const int srow = lane >> 4, sch = lane & 15;
    const int rot = (tk & 1) ? 4 : 0;
#define ATT_JR(j) (((j) + rot) >= 5 ? ((j) + rot - 5) : ((j) + rot))
#define ATT_WAITV(n) asm volatile("s_waitcnt vmcnt(" #n ")" ::: "memory")
#define ATT_ISSUE(n) do { LAS unsigned char* sl_ = wl + ((n) & 1) * ATT_SLOT; const int jt_ = ATT_JR((n) < 5 ? (n) : (n) - 5); \
        _Pragma("unroll") for (int i_ = 0; i_ < 8; ++i_) { \
            const int key_ = (n) < 5 ? (4 * i_ + srow) : ((i_ & 3) + 4 * srow + 16 * (i_ >> 2)); \
            int lk_ = l0 - 64 + 32 * jt_ + key_; lk_ = lk_ < 0 ? 0 : (lk_ > L - 1 ? L - 1 : lk_); \
            const int ch_ = (n) < 5 ? (sch ^ (key_ & 7)) : sch; \
            const bf16* src_ = QKVH + ((size_t)(((n) < 5 ? NH : 2 * NH) + h) * M + rowbase + ((size_t)lk_ << SH) + res) * HD + ch_ * 8; \
            __builtin_amdgcn_global_load_lds((const unsigned*)src_, (LAS unsigned*)(sl_ + i_ * ((n) < 5 ? 1024 : 1088)), 16, 0, 0); } } while (0)
    const size_t qrow = rowbase + ((size_t)(l0 + r32) << SH) + res;
    bf16x8 qr[8];
    { const bf16* qp = QKVH + ((size_t)h * M + qrow) * HD + hi * 8;
#pragma unroll
      for (int d0 = 0; d0 < 8; ++d0) qr[d0] = *(const bf16x8*)(qp + d0 * 16); }
    ATT_ISSUE(0); ATT_ISSUE(1);
    f32x16 p[5];
#define ATT_KTILE(n) do { LAS unsigned char* sl_ = wl + ((n) & 1) * ATT_SLOT + r32 * 256; f32x16 s_ = {}; \
        _Pragma("unroll") for (int d0 = 0; d0 < 8; ++d0) { const bf16x8 a_ = *(const LAS bf16x8*)(sl_ + (((2 * d0 + hi) ^ (r32 & 7)) << 4)); s_ = __builtin_amdgcn_mfma_f32_32x32x16_bf16(a_, qr[d0], s_, 0, 0, 0); } \
        p[n] = s_; asm volatile("" ::: "memory"); } while (0)
    ATT_WAITV(8); ATT_KTILE(0); ATT_ISSUE(2);
    ATT_WAITV(8); ATT_KTILE(1); ATT_ISSUE(3);
    ATT_WAITV(8); ATT_KTILE(2); ATT_ISSUE(4);
    ATT_WAITV(8); ATT_KTILE(3); ATT_ISSUE(5);
    ATT_WAITV(8); ATT_KTILE(4); ATT_ISSUE(6);
    float mx = -1e30f;
    const bool edge = (l0 - 64 < 0) || (l0 + 96 > L);
    const LAS float* bt = btab + G * 256 + 32 + 4 * hi - r32;
#pragma unroll
    for (int j = 0; j < 5; ++j) {
        const int jr = ATT_JR(j); const LAS float* btj = bt + 32 * jr;
#pragma unroll
        for (int r = 0; r < 16; ++r) {
            const int kc = 32 * jr + (r & 3) + 8 * (r >> 2);
            float v = p[j][r] + btj[(r & 3) + 8 * (r >> 2)];
            if (edge) { const int lk = l0 - 64 + kc + 4 * hi; v = (lk >= 0 && lk < L) ? v : -1e30f; }
            p[j][r] = v; mx = fmaxf(mx, v);
        }
        asm volatile("" ::: "memory");
    }
    mx = fmaxf(mx, __shfl_xor(mx, 32));
    float ls = 0.f;
    bf16x8 pb[5][2];
#pragma unroll
    for (int j = 0; j < 5; ++j) {
        float e[16];
#pragma unroll
        for (int r = 0; r < 16; ++r) { e[r] = __builtin_amdgcn_exp2f(p[j][r] - mx); ls += e[r]; }
#pragma unroll
        for (int s = 0; s < 2; ++s) { v4u w; w.x = cvt_pk_bf16(e[8 * s + 0], e[8 * s + 1]); w.y = cvt_pk_bf16(e[8 * s + 2], e[8 * s + 3]);
            w.z = cvt_pk_bf16(e[8 * s + 4], e[8 * s + 5]); w.w = cvt_pk_bf16(e[8 * s + 6], e[8 * s + 7]); pb[j][s] = __builtin_bit_cast(bf16x8, w); }
    }
    ls += __shfl_xor(ls, 32);
    asm volatile("" ::: "memory");
    f32x16 o[4] = {};
    const int i16 = lane & 15, g16 = lane >> 4;
    const unsigned vbase = (unsigned)(uintptr_t)wl + (unsigned)((i16 >> 2) * 1088 + hi * 256 + (16 * (g16 & 1) + 4 * (i16 & 3)) * 2);
#define ATT_VTILE(n) do { const unsigned va_ = vbase + ((n) & 1) * ATT_SLOT; \
        _Pragma("unroll") for (int dt = 0; dt < 4; ++dt) { s16x4 lo0, hi0, lo1, hi1; \
            asm volatile("ds_read_b64_tr_b16 %0, %4 offset:%5\n\tds_read_b64_tr_b16 %1, %4 offset:%6\n\tds_read_b64_tr_b16 %2, %4 offset:%7\n\tds_read_b64_tr_b16 %3, %4 offset:%8\n\ts_waitcnt lgkmcnt(0)" \
                         : "=&v"(lo0), "=&v"(hi0), "=&v"(lo1), "=&v"(hi1) : "v"(va_), "i"(dt * 64), "i"(512 + dt * 64), "i"(4 * 1088 + dt * 64), "i"(4 * 1088 + 512 + dt * 64) : "memory"); \
            const bf16x8 af0 = (bf16x8){lo0[0], lo0[1], lo0[2], lo0[3], hi0[0], hi0[1], hi0[2], hi0[3]}; \
            const bf16x8 af1 = (bf16x8){lo1[0], lo1[1], lo1[2], lo1[3], hi1[0], hi1[1], hi1[2], hi1[3]}; \
            o[dt] = __builtin_amdgcn_mfma_f32_32x32x16_bf16(af0, pb[(n) - 5][0], o[dt], 0, 0, 0); \
            o[dt] = __builtin_amdgcn_mfma_f32_32x32x16_bf16(af1, pb[(n) - 5][1], o[dt], 0, 0, 0); } } while (0)
    ATT_WAITV(8); ATT_VTILE(5); ATT_ISSUE(7);
    ATT_WAITV(8); ATT_VTILE(6); ATT_ISSUE(8);
    ATT_WAITV(8); ATT_VTILE(7); ATT_ISSUE(9);
    ATT_WAITV(8); ATT_VTILE(8);
    ATT_WAITV(0); ATT_VTILE(9);
#undef ATT_WAITV
#undef ATT_ISSUE
#undef ATT_KTILE
#undef ATT_VTILE
#undef ATT_JR
    const float inv = 1.0f / ls;
    const float lse2 = mx + __builtin_amdgcn_logf(ls);
    const size_t orow = qrow;
    LAS unsigned char* T0 = wl;
    LAS unsigned char* T1 = T0 + ATT_SLOT;
    int ln_ = lane; asm volatile("" : "+v"(ln_));
    const int erow = ln_ >> 4, echk = ln_ & 15;
    const unsigned pofs = (unsigned)(r32 * 272 + 8 * hi);
    if (G < 2) {
#pragma unroll
        for (int dt = 0; dt < 4; ++dt)
#pragma unroll
            for (int rg = 0; rg < 4; ++rg) { v2u w; w.x = cvt_pk_bf16(o[dt][4 * rg] * inv, o[dt][4 * rg + 1] * inv); w.y = cvt_pk_bf16(o[dt][4 * rg + 2] * inv, o[dt][4 * rg + 3] * inv);
                *(LAS v2u*)(T0 + pofs + 64 * dt + 16 * rg) = w; }
        LDS_WAIT();
        bf16* ob = (G == 0 ? O0 : O1) + ((size_t)h * M + rowbase) * HD + echk * 8;
#pragma unroll
        for (int i = 0; i < 8; ++i) { const int qi = erow + 4 * i; const v4u w = *(const LAS v4u*)(T0 + qi * 272 + echk * 16);
            *(v4u*)(ob + (((size_t)(l0 + qi) << SH) + res) * HD) = w; }
        if (hi == 0) (G == 0 ? LSE0 : LSE1)[orow * NH + h] = lse2;
    } else {
        const float l0v = LSE0[orow * NH + h], l1v = LSE1[orow * NH + h];
        const bf16* ib0 = O0 + ((size_t)h * M + rowbase) * HD + echk * 8; const bf16* ib1 = O1 + ((size_t)h * M + rowbase) * HD + echk * 8;
#pragma unroll
        for (int hh = 0; hh < 2; ++hh) {
            v4u t0[4], t1[4];
#pragma unroll
            for (int i = 0; i < 4; ++i) { const size_t ro = (((size_t)(l0 + erow + 4 * (4 * hh + i)) << SH) + res) * HD; t0[i] = *(const v4u*)(ib0 + ro); t1[i] = *(const v4u*)(ib1 + ro); }
#pragma unroll
            for (int i = 0; i < 4; ++i) { const int qi = erow + 4 * (4 * hh + i); *(LAS v4u*)(T0 + qi * 272 + echk * 16) = t0[i]; *(LAS v4u*)(T1 + qi * 272 + echk * 16) = t1[i]; }
            asm volatile("" ::: "memory");
        }
        const float mm = fmaxf(fmaxf(l0v, l1v), lse2);
        const float w0 = __builtin_amdgcn_exp2f(l0v - mm), w1 = __builtin_amdgcn_exp2f(l1v - mm), w2 = __builtin_amdgcn_exp2f(lse2 - mm);
        const float wi = 1.0f / (w0 + w1 + w2);
        const float c0 = w0 * wi, c1 = w1 * wi, c2 = w2 * wi * inv;
        LDS_WAIT();
        unsigned y8[16];
#pragma unroll
        for (int dt = 0; dt < 4; ++dt)
#pragma unroll
            for (int rg = 0; rg < 4; ++rg) { const v2u a = *(const LAS v2u*)(T0 + pofs + 64 * dt + 16 * rg), c = *(const LAS v2u*)(T1 + pofs + 64 * dt + 16 * rg);
                const float y0 = c0 * bf_lo(a.x) + c1 * bf_lo(c.x) + c2 * o[dt][4 * rg], y1 = c0 * bf_hi(a.x) + c1 * bf_hi(c.x) + c2 * o[dt][4 * rg + 1];
                const float y2 = c0 * bf_lo(a.y) + c1 * bf_lo(c.y) + c2 * o[dt][4 * rg + 2], y3 = c0 * bf_hi(a.y) + c1 * bf_hi(c.y) + c2 * o[dt][4 * rg + 3];
                int w = 0; w = __builtin_amdgcn_cvt_pk_fp8_f32(y0 * A8SCALE, y1 * A8SCALE, w, false); w = __builtin_amdgcn_cvt_pk_fp8_f32(y2 * A8SCALE, y3 * A8SCALE, w, true); y8[4 * dt + rg] = (unsigned)w; }
        LDS_WAIT();
#pragma unroll
        for (int dt = 0; dt < 4; ++dt)
#pragma unroll
            for (int rg = 0; rg < 4; ++rg) *(LAS unsigned*)(T0 + r32 * 144 + 4 * hi + 32 * dt + 8 * rg) = y8[4 * dt + rg];
        LDS_WAIT();
        unsigned char* ob = MIX8 + rowbase * DM + h * HD + (ln_ & 7) * 16;
#pragma unroll
        for (int i = 0; i < 4; ++i) { const int qi = (ln_ >> 3) + 8 * i; const v4u w = *(const LAS v4u*)(T0 + qi * 144 + (ln_ & 7) * 16);
            *(v4u*)(ob + (((size_t)(l0 + qi) << SH) + res) * DM) = w; }
    }
    LDS_WAIT();
}

constexpr int PER_PHASE = 9;
struct Args { const float* in[16]; float* out; unsigned char* ws; unsigned mask; unsigned pad; };

__constant__ unsigned char CAND_I[64] = {0,0,0,0,0,0,0,0,0,0,0,0,0,0,0,0, 1,1,1,1,1,1,1,1, 2,2,2,2,2, 3,3,3,3, 4,4,4, 5,5, 6,6, 7,7, 8,9,10,11,12,13,14,15, 0,0,0,0,0,0,0,0,0,0,0,0,0,0};
__constant__ unsigned char CAND_J[64] = {0,1,2,3,4,5,6,7,8,9,10,11,12,13,14,15, 0,1,2,3,4,5,6,7, 0,1,2,3,4, 0,1,2,3, 0,1,2, 0,1, 0,1, 0,1, 0,0,0,0,0,0,0,0, 0,0,0,0,0,0,0,0,0,0,0,0,0,0};

__global__ void __launch_bounds__(NWAVES * 64, 2) fwd_kernel(Args args) {
    extern __shared__ __attribute__((aligned(16))) unsigned char lds_raw[];
    LAS unsigned char* lds = (LAS unsigned char*)lds_raw;
    volatile LAS unsigned* MISC = (volatile LAS unsigned*)(lds + MISC_OFF);
    const int tid0 = threadIdx.x, lane0 = tid0 & 63, wave = __builtin_amdgcn_readfirstlane(tid0 >> 6);
#define PHASE_LANES() int tid = tid0; asm volatile("" : "+v"(tid)); const int lane = tid & 63
    const int G = gridDim.x; const int bx = blockIdx.x;
    const int vcu = (G % 8 == 0) ? (bx % 8) * (G / 8) + bx / 8 : bx;
    const int gw = vcu * NWAVES + wave, NGW = G * NWAVES;
    unsigned char* ws = args.ws;
    unsigned* ctl = (unsigned*)(ws + WS_CTL);
    const float* x = args.in[0]; const float* cvec = args.in[1]; const float* w_ada = args.in[2]; const float* b_ada = args.in[3]; const float* g_mix = args.in[4];
    const float* w_in = args.in[5]; const float* rel_bias = args.in[6]; const float* pool_w = args.in[7]; const float* pool_scale = args.in[8]; const float* w_out = args.in[9];
    const float* g_ffn = args.in[10]; const float* peer_wq = args.in[11]; const float* peer_sk = args.in[12]; const float* peer_u = args.in[13]; const float* peer_v = args.in[14];
    const float* g_final = args.in[15];
    float* out = args.out;
    float* MODV = (float*)(ws + WS_MODV); float* MODP = (float*)(ws + WS_MODP);
    bf16* SKT = (bf16*)(ws + WS_SKT); bf16* PWS = (bf16*)(ws + WS_PWS); bf16* WQST = (bf16*)(ws + WS_WQST); unsigned char* WOUT8 = ws + WS_WOUT2;     bf16* WINT = (bf16*)(ws + WS_WINT); unsigned char* WIN8 = ws + WS_WIN8; unsigned char* H8 = ws + WS_H8;
    bf16* WOPT = (bf16*)(ws + WS_WOPT); bf16* WQB = (bf16*)(ws + WS_WQB);
    unsigned char* UB = ws + WS_UB; unsigned char* VB = ws + WS_VB; float* SCL = (float*)(ws + WS_SCL); float* TSC = SCL + 2 * NEXP;     bf16* H = (bf16*)(ws + WS_H); bf16* PIN = (bf16*)(ws + WS_PROJ); bf16* QKVH = (bf16*)(ws + WS_QKVH); unsigned char* MIX8 = ws + WS_MIXIN;
    bf16* O0 = (bf16*)(ws + WS_O0); bf16* O1 = (bf16*)(ws + WS_O1); float* LSE = (float*)(ws + WS_LSE);
    float* SC = (float*)(ws + WS_SC);
    bf16* X1B = (bf16*)(ws + WS_O0);
    bf16* YB = (bf16*)(ws + WS_PROJ + 64 * MiB);

    for (int u = tid0; u < (LDS_BYTES - LDSCTL_OFF) / 4; u += NWAVES * 64) ((LAS unsigned*)(lds + LDSCTL_OFF))[u] = 0u;
    __syncthreads();
    XcdBarrier bar; bar.bar = ctl + CW_BAR; bar.x = 0; bar.st = nullptr;
    if (MK_N_LAUNCHES != PER_PHASE) bar = xcd_barrier_post(ctl + CW_BAR, MISC + 8);
#define GRID_BAR() do { if (MK_N_LAUNCHES != PER_PHASE) xcd_barrier(bar); } while (0)
    const unsigned phmask = args.mask;
#ifndef PH_MASK
#define PH_MASK 0x1ff
#endif
#define IN(k) ((((PH_MASK) >> (k)) & 1) && ((phmask >> (k)) & 1u))
#define BOTH(k) (IN(k) && IN((k) + 1))

    if (IN(0)) {
        PHASE_LANES();
        LAS float* silu = (LAS float*)(lds + RING_OFF);
        for (int i = tid; i < BATCH * DM; i += NWAVES * 64) { const float v = cvec[i]; silu[i] = v / (1.0f + __expf(-v)); }
        __syncthreads();
        for (int task = gw; task < (NMOD / 256) * KS_ADA; task += NGW) {
            const int cg = task % (NMOD / 256), ks = task / (NMOD / 256); const int k0 = ks * (DM / KS_ADA), n0 = cg * 256 + 4 * lane;
            f32x4 a0 = {0.f, 0.f, 0.f, 0.f}, a1 = {0.f, 0.f, 0.f, 0.f};
            const float* wp = w_ada + (size_t)k0 * NMOD + n0;
            static_assert(DM / KS_ADA == 64, "four 16-row batches");
            f32x4 wA[16], wB[16];
#define ADA_LD(W_, b_) _Pragma("unroll") for (int q_ = 0; q_ < 16; ++q_) W_[q_] = *(const f32x4*)(wp + (size_t)(16 * (b_) + q_) * NMOD)
#define ADA_FMA(W_, b_) _Pragma("unroll") for (int q_ = 0; q_ < 16; ++q_) { const float s0 = silu[k0 + 16 * (b_) + q_], s1 = silu[DM + k0 + 16 * (b_) + q_]; a0 += W_[q_] * s0; a1 += W_[q_] * s1; }
            ADA_LD(wA, 0); ADA_LD(wB, 1); ADA_FMA(wA, 0); ADA_LD(wA, 2); ADA_FMA(wB, 1); ADA_LD(wB, 3); ADA_FMA(wA, 2); ADA_FMA(wB, 3);
#undef ADA_LD
#undef ADA_FMA
            *(f32x4*)(MODP + ((size_t)(ks * 2 + 0)) * NMOD + n0) = a0; *(f32x4*)(MODP + ((size_t)(ks * 2 + 1)) * NMOD + n0) = a1;
        }
        __syncthreads();
        {
            LAS float* scr = (LAS float*)(lds + RING_OFF + wave * 16384);
            constexpr int I_QKV = (DM / 64) * (3 * ATTW / 32), I_PIN = (DM / 64) * (POOLW / 32), I_OUTH = (ATTW / 64) * (DM / 32);
            constexpr int NITEMS = I_QKV + I_PIN + 2 * I_OUTH;
            for (int it = gw; it < NITEMS; it += NGW) {
                int r = it;
                if (r < I_QKV) { p0_transpose_item<true>(w_in, INW, 3 * ATTW, WIN8, DM, W8SCALE, scr, r, lane); continue; } r -= I_QKV;
                if (r < I_PIN) { p0_transpose_item<false>(w_in + 3 * ATTW, INW, POOLW, WINT, DM, 1.f, scr, r, lane); continue; } r -= I_PIN;
                if (r < I_OUTH) { p0_transpose_item<true>(w_out, DM, DM, WOUT8, DM, WO8SCALE, scr, r, lane); continue; } r -= I_OUTH;
                p0_transpose_item<false>(w_out + (size_t)ATTW * DM, DM, DM, WOPT, POOLW, 1.f, scr, r, lane);
            }
        }
        for (int i = gw * 64 + lane; i < (DM * PQ + 4 * 512 * 512) / 8; i += NGW * 64) {
            const bool isQ = i < DM * PQ / 8; const int j = isQ ? i : i - DM * PQ / 8;
            const float* src = (isQ ? peer_wq : pool_w) + (size_t)j * 8;
            f32x4 a = *(const f32x4*)src, c = *(const f32x4*)(src + 4);
            if (!isQ) { const int e0 = j * 8; const int gi = e0 >> 18, d0 = e0 & 511; const float* ps = pool_scale + gi * 512 + d0; a = a * *(const f32x4*)ps; c = c * *(const f32x4*)(ps + 4); }
            v4u w; w.x = cvt_pk_bf16(a[0], a[1]); w.y = cvt_pk_bf16(a[2], a[3]); w.z = cvt_pk_bf16(c[0], c[1]); w.w = cvt_pk_bf16(c[2], c[3]);
            *(v4u*)((isQ ? WQB : PWS) + (size_t)j * 8) = w;
        }
        f32x4 vnx[4][4];
#define PEER_LD(r_) do { const float* s_ = ((r_) < NEXP ? peer_u + (size_t)(r_) * DM : peer_v + (size_t)((r_) - NEXP) * DM) + 16 * lane; \
            _Pragma("unroll") for (int i = 0; i < 4; ++i) _Pragma("unroll") for (int q = 0; q < 4; ++q) vnx[i][q] = *(const f32x4*)(s_ + 1024 * i + 4 * q); } while (0)
        if (gw < 2 * NEXP) PEER_LD(gw);
        for (int r = gw; r < 2 * NEXP; r += NGW) {
            const bool isU = r < NEXP; const int e = isU ? r : r - NEXP;
            f32x4 v[4][4]; float mx = 0.f;
#pragma unroll
            for (int i = 0; i < 4; ++i)
#pragma unroll
                for (int q = 0; q < 4; ++q) { v[i][q] = vnx[i][q];
                    mx = fmaxf(mx, fmaxf(fmaxf(fabsf(v[i][q][0]), fabsf(v[i][q][1])), fmaxf(fabsf(v[i][q][2]), fabsf(v[i][q][3])))); }
            if (r + NGW < 2 * NEXP) PEER_LD(r + NGW);
#pragma unroll
            for (int o = 1; o < 64; o <<= 1) mx = fmaxf(mx, __shfl_xor(mx, o));
            const int ex = (int)((__float_as_uint(mx) >> 23) & 0xffu);
            float scale = 1.0f, inv = 1.0f;
            if (ex >= 32 && ex <= 230) { if (isU) { scale = 127.0f / mx; inv = mx * (1.0f / 127.0f); }
                else { scale = __uint_as_float((unsigned)(261 - ex) << 23); inv = __uint_as_float((unsigned)(ex - 7) << 23); } }
            unsigned char* dst = (isU ? UB : VB) + ((size_t)(lane >> 3) * NEXP + e) * 128 + 16 * (lane & 7);
#pragma unroll
            for (int i = 0; i < 4; ++i) { v4u w;
#pragma unroll
                for (int q = 0; q < 4; ++q) { if (isU) { w[q] = q8x4(v[i][q], scale); } else { int pk = 0; pk = __builtin_amdgcn_cvt_pk_fp8_f32(v[i][q][0] * scale, v[i][q][1] * scale, pk, false);
                    pk = __builtin_amdgcn_cvt_pk_fp8_f32(v[i][q][2] * scale, v[i][q][3] * scale, pk, true); w[q] = (unsigned)pk; } }
                *(v4u*)(dst + (size_t)(8 * i) * NEXP * 128) = w; }
            if (lane == 0) SCL[r] = inv;
        }
#undef PEER_LD
        for (int i = gw * 64 + lane; i < 2048 * 32; i += NGW * 64) {
            const int n = i >> 5, kc = (i & 31) * 8; const int p = (n >> 7) & 1, pp = kc >> 7;
            v4u w = {0u, 0u, 0u, 0u};
            if (p == pp) { const float* src = peer_sk + (size_t)n * 128 + (kc & 127); const f32x4 a = *(const f32x4*)src, c = *(const f32x4*)(src + 4);
                w.x = cvt_pk_bf16(a[0], a[1]); w.y = cvt_pk_bf16(a[2], a[3]); w.z = cvt_pk_bf16(c[0], c[1]); w.w = cvt_pk_bf16(c[2], c[3]); }
            *(v4u*)(SKT + (size_t)n * 256 + kc) = w;
        }
        if (BOTH(0)) GRID_BAR();
    }

    if (IN(1)) {
        PHASE_LANES();
        for (int i = bx * (NWAVES * 64) + tid; i < BATCH * NMOD; i += G * NWAVES * 64) {
            const int b = i / NMOD, n = i % NMOD; float s = b_ada[n];
#pragma unroll 8
            for (int ks = 0; ks < KS_ADA; ++ks) s += MODP[(size_t)(ks * 2 + b) * NMOD + n];
            const int j = n / DM, c = n % DM;
            MODV[(size_t)(j * 2 + b) * DM + c] = s;
        }
        if (bx < G / 2) {
            pg8::Gemm g{WOPT, PWS, DM, POOLW, 512, POOLW, 512, 2, 512, 1 << 30, 0}; pg8::StaticOrder S; S.init(DM, POOLW, G / 2, bx);
            pg8::EpiFp8 E{WOUT8, DM, ATTW, (A8SCALE * WO8SCALE) / P8SCALE};
            pg8::gemm_phase<pg8::EpiFp8, pg8::StaticOrder, true>(lds + RING_OFF, g, S, E);
        }
        else {
            pg8::Gemm g{SKT, WQB, PQ, DM, 256, 256, PQ, 1 << 30, 0, 1, 256}; pg8::StaticOrder S; S.init(PQ, DM, G - G / 2, bx - G / 2);
            pg8::EpiBf16 E{WQST, DM, 0, 1.0f, nullptr, 0, 0};
            pg8::gemm_phase<pg8::EpiBf16, pg8::StaticOrder, true>(lds + RING_OFF, g, S, E);
        }
        if (BOTH(1)) GRID_BAR();
    }

    if (IN(2)) {
        PHASE_LANES();
        f32x4 xnx[16];
#define P2_LD(r_) do { const f32x4* xr_ = (const f32x4*)(x + (size_t)(r_) * DM) + lane; _Pragma("unroll") for (int j = 0; j < 16; ++j) xnx[j] = xr_[64 * j]; } while (0)
        if (gw < M) P2_LD(gw);
        for (int row = gw; row < M; row += NGW) {
            const int b = row / SEQ;
            f32x4 v[16]; float ss = 0.f;
#pragma unroll
            for (int j = 0; j < 16; ++j) { v[j] = xnx[j]; ss += (v[j][0] * v[j][0] + v[j][1] * v[j][1]) + (v[j][2] * v[j][2] + v[j][3] * v[j][3]); }
            if (row + NGW < M) P2_LD(row + NGW);
            const float rstd = 1.0f / sqrtf(wave_sum(ss) * (1.0f / DM) + RMS_EPS);
            const f32x4* gp = (const f32x4*)g_mix + lane; const f32x4* shp = (const f32x4*)(MODV + (size_t)(0 * 2 + b) * DM) + lane; const f32x4* scp = (const f32x4*)(MODV + (size_t)(1 * 2 + b) * DM) + lane;
            v2u* op = (v2u*)(H + (size_t)row * DM) + lane; unsigned* op8 = (unsigned*)(H8 + (size_t)row * DM) + lane;
#pragma unroll
            for (int j = 0; j < 16; ++j) { const f32x4 g4 = gp[64 * j], sh = shp[64 * j], sc = scp[64 * j];
                const f32x4 y = (v[j] * rstd) * g4 * (sc + 1.0f) + sh;
                v2u w; w.x = cvt_pk_bf16(y[0], y[1]); w.y = cvt_pk_bf16(y[2], y[3]); op[64 * j] = w;
                int p8 = 0; p8 = __builtin_amdgcn_cvt_pk_fp8_f32(y[0] * H8SCALE, y[1] * H8SCALE, p8, false); p8 = __builtin_amdgcn_cvt_pk_fp8_f32(y[2] * H8SCALE, y[3] * H8SCALE, p8, true); op8[64 * j] = (unsigned)p8; }
        }
        if (BOTH(2)) GRID_BAR();
    }

    if (IN(3)) {
        PHASE_LANES();
        {
            pg8::Gemm g{(const bf16*)H8, (const bf16*)WIN8, M, 3 * ATTW, DM / 2, DM / 2, DM / 2, 1 << 30, 0, 1 << 30, 0}; pg8::StaticOrder S; S.init(M, 3 * ATTW, G, bx);
            pg8::EpiBf16 E{PIN, POOLW, ATTW, QSCALE / (H8SCALE * W8SCALE), QKVH, 3 * ATTW, M, 1.0f / (H8SCALE * W8SCALE)};
            pg8::gemm_phase<pg8::EpiBf16, pg8::StaticOrder, true, true>(lds + RING_OFF, g, S, E);
        }
        {
            pg8::Gemm g{H, WINT, M, POOLW, DM, DM, DM, 1 << 30, 0, 1 << 30, 0}; pg8::StaticOrder S; S.init(M, POOLW, G, bx);
            pg8::EpiBf16 E{PIN, POOLW, 0, 1.0f, nullptr, 0, 0};
            pg8::gemm_phase<pg8::EpiBf16, pg8::StaticOrder, true>(lds + RING_OFF, g, S, E);
        }
        if (BOTH(3)) GRID_BAR();
    }

    if (IN(4)) {
        PHASE_LANES();
        LAS float* btab = (LAS float*)(lds + SHARED_OFF);
        LAS unsigned char* vt = lds + RING_OFF + wave * ATT_WAVE_BYTES;
        if (!(args.pad & 1u))
        for (int unit = bx; unit < BATCH * NH * (SEQ / 1024); unit += G) {
            const int b = unit >> 7, h = (unit >> 3) & 15, mt = unit & 7;
            __syncthreads();
            for (int i = tid; i < 3 * 256; i += NWAVES * 64) { const int gi = i >> 8, ri = (i & 255) - 32; const int dil = gi == 0 ? 1 : (gi == 1 ? 4 : 16);
                btab[i] = (ri >= 0 && ri <= 128) ? rel_bias[t5_bucket((ri - 64) * dil) * NH + h] * LOG2E : -1e30f; }
            __syncthreads();
            for (int g = 0; g < 3; ++g) {
                if (g == 2) { VM_WAIT(); __syncthreads(); }
                for (int tk = wave; tk < 32; tk += NWAVES) attn_task(g, QKVH, O0, O1, LSE, LSE + (size_t)M * NH, MIX8, btab, vt, b, h, mt, tk, lane);
            }
        }
        if (!(args.pad & 2u))
        for (int i = bx * (NWAVES * 64) + tid; i < BATCH * (SEQ / 8) * (POOLW / 8); i += G * NWAVES * 64) {
            const int cc = i & 255, run = (i >> 8) & (SEQ / 8 - 1), b = i >> 18; const int gi = __builtin_amdgcn_readfirstlane(cc >> 6);
            const int pos0 = run * 8;
            const bf16* base = PIN + (size_t)b * SEQ * POOLW + cc * 8;
            unsigned char* obase = MIX8 + ((size_t)b * SEQ + pos0) * DM + ATTW + cc * 8;
#define POOL_RUN(HW) do { constexpr int NR = 8 + 2 * (HW) - 1; v4u w_[NR]; \
                _Pragma("unroll") for (int q = 0; q < NR; ++q) { const int pp = pos0 - (HW) + q; const int pc = pp < 0 ? 0 : (pp > SEQ - 1 ? SEQ - 1 : pp); w_[q] = *(const v4u*)(base + (size_t)pc * POOLW); } \
                _Pragma("unroll") for (int q = 0; q < NR; ++q) { const int pp = pos0 - (HW) + q; if (pp < 0 || pp >= SEQ) w_[q] = (v4u){0u, 0u, 0u, 0u}; } \
                float s_[8] = {0.f, 0.f, 0.f, 0.f, 0.f, 0.f, 0.f, 0.f}; \
                _Pragma("unroll") for (int q = 0; q < 2 * (HW) - 1; ++q) { s_[0] += bf_lo(w_[q].x); s_[1] += bf_hi(w_[q].x); s_[2] += bf_lo(w_[q].y); s_[3] += bf_hi(w_[q].y); s_[4] += bf_lo(w_[q].z); s_[5] += bf_hi(w_[q].z); s_[6] += bf_lo(w_[q].w); s_[7] += bf_hi(w_[q].w); } \
                _Pragma("unroll") for (int k = 0; k < 8; ++k) { const v4u in_ = w_[k + 2 * (HW) - 1]; \
                    s_[0] += bf_lo(in_.x); s_[1] += bf_hi(in_.x); s_[2] += bf_lo(in_.y); s_[3] += bf_hi(in_.y); s_[4] += bf_lo(in_.z); s_[5] += bf_hi(in_.z); s_[6] += bf_lo(in_.w); s_[7] += bf_hi(in_.w); \
                    const int pos = pos0 + k; const int lo_ = pos - (HW) < 0 ? 0 : pos - (HW), hi_ = pos + (HW) > SEQ ? SEQ : pos + (HW); const float inv = 1.0f / (float)(hi_ - lo_); \
                    const v4u me = w_[k + (HW)]; int lo8_ = 0, hi8_ = 0; const float i8_ = inv * P8SCALE; \
                    lo8_ = __builtin_amdgcn_cvt_pk_fp8_f32(s_[0] * i8_ - bf_lo(me.x) * P8SCALE, s_[1] * i8_ - bf_hi(me.x) * P8SCALE, lo8_, false); lo8_ = __builtin_amdgcn_cvt_pk_fp8_f32(s_[2] * i8_ - bf_lo(me.y) * P8SCALE, s_[3] * i8_ - bf_hi(me.y) * P8SCALE, lo8_, true); \
                    hi8_ = __builtin_amdgcn_cvt_pk_fp8_f32(s_[4] * i8_ - bf_lo(me.z) * P8SCALE, s_[5] * i8_ - bf_hi(me.z) * P8SCALE, hi8_, false); hi8_ = __builtin_amdgcn_cvt_pk_fp8_f32(s_[6] * i8_ - bf_lo(me.w) * P8SCALE, s_[7] * i8_ - bf_hi(me.w) * P8SCALE, hi8_, true); \
                    *(v2u*)(obase + (size_t)k * DM) = (v2u){(unsigned)lo8_, (unsigned)hi8_}; \
                    const v4u out_ = w_[k]; \
                    s_[0] -= bf_lo(out_.x); s_[1] -= bf_hi(out_.x); s_[2] -= bf_lo(out_.y); s_[3] -= bf_hi(out_.y); s_[4] -= bf_lo(out_.z); s_[5] -= bf_hi(out_.z); s_[6] -= bf_lo(out_.w); s_[7] -= bf_hi(out_.w); } } while (0)
            if (gi == 0) POOL_RUN(1); else if (gi == 1) POOL_RUN(2); else if (gi == 2) POOL_RUN(4); else POOL_RUN(8);
#undef POOL_RUN
        }
        if (BOTH(4)) GRID_BAR();
    }

    if (IN(5)) {
        PHASE_LANES();
        pg8::Gemm g{(const bf16*)MIX8, (const bf16*)WOUT8, M, DM, DM / 2, DM / 2, DM / 2, 1 << 30, 0, 1 << 30, 0}; pg8::StaticOrder S; S.init(M, DM, G, bx);
        pg8::EpiResBf16 E{x, MODV + (size_t)(2 * 2) * DM, X1B, DM, 1.0f / (A8SCALE * WO8SCALE)};
        pg8::gemm_phase<pg8::EpiResBf16, pg8::StaticOrder, true, true>(lds + RING_OFF, g, S, E);
        if (BOTH(5)) GRID_BAR();
    }

    if (IN(6)) {
        PHASE_LANES();
        v2u xnx[16];
#define P6_LD(r_) do { const v2u* xr_ = (const v2u*)(X1B + (size_t)(r_) * DM) + lane; _Pragma("unroll") for (int j = 0; j < 16; ++j) xnx[j] = xr_[64 * j]; } while (0)
        if (gw < M) P6_LD(gw);
        for (int row = gw; row < M; row += NGW) {
            const int b = row / SEQ;
            f32x4 v[16]; float ss = 0.f;
#pragma unroll
            for (int j = 0; j < 16; ++j) { const v2u xw = xnx[j]; v[j] = (f32x4){bf_lo(xw.x), bf_hi(xw.x), bf_lo(xw.y), bf_hi(xw.y)}; ss += (v[j][0] * v[j][0] + v[j][1] * v[j][1]) + (v[j][2] * v[j][2] + v[j][3] * v[j][3]); }
            if (row + NGW < M) P6_LD(row + NGW);
            const float rstd = 1.0f / sqrtf(wave_sum(ss) * (1.0f / DM) + RMS_EPS);
            const f32x4* gp = (const f32x4*)g_ffn + lane; const f32x4* shp = (const f32x4*)(MODV + (size_t)(3 * 2 + b) * DM) + lane; const f32x4* scp = (const f32x4*)(MODV + (size_t)(4 * 2 + b) * DM) + lane;
            v2u* op = (v2u*)(H + (size_t)row * DM) + lane; unsigned* op8 = (unsigned*)(H8 + (size_t)row * DM) + lane;
            float ymx = 0.f;
#pragma unroll
            for (int j = 0; j < 16; ++j) { const f32x4 g4 = gp[64 * j], sh = shp[64 * j], sc = scp[64 * j];
                const f32x4 y = (v[j] * rstd) * g4 * (sc + 1.0f) + sh; v[j] = y;
                ymx = fmaxf(ymx, fmaxf(fmaxf(fabsf(y[0]), fabsf(y[1])), fmaxf(fabsf(y[2]), fabsf(y[3]))));
                v2u w; w.x = cvt_pk_bf16(y[0], y[1]); w.y = cvt_pk_bf16(y[2], y[3]); op[64 * j] = w; }
#pragma unroll
            for (int o = 1; o < 64; o <<= 1) ymx = fmaxf(ymx, __shfl_xor(ymx, o));
            ymx = fmaxf(ymx, 1e-20f);
            const float qs = 127.0f / ymx;
#pragma unroll
            for (int j = 0; j < 16; ++j) op8[64 * j] = q8x4(v[j], qs);
            if (lane == 0) TSC[row] = ymx * (1.0f / 127.0f);
        }
        if (BOTH(6)) GRID_BAR();
    }

    if (IN(7)) {
        PHASE_LANES();
        pg8::Gemm g{H, WQST, M, PQ, DM, DM, DM, 1 << 30, 0, 1 << 30, 0}; pg8::StaticOrder S; S.init(M, PQ, G, bx);
        pg8::EpiF32 E{SC, PQ};
        pg8::gemm_phase<pg8::EpiF32, pg8::StaticOrder, true>(lds + RING_OFF, g, S, E);
        if (BOTH(7)) GRID_BAR();
    }

    if (IN(8)) {
        PHASE_LANES();
        LAS unsigned short* EXPW = (LAS unsigned short*)(lds + RING_OFF);
        LAS float* GACT = (LAS float*)(lds + RING_OFF + 16384);
        LAS unsigned* W = (LAS unsigned*)(lds + RING_OFF + 49152 + wave * 4096);
        LAS unsigned* K1 = W; LAS unsigned* K2 = W + 128;
        LAS float* TV1 = (LAS float*)(W + 256); LAS int* TI1 = (LAS int*)(W + 272); LAS float* TV2 = (LAS float*)(W + 288); LAS int* TI2 = (LAS int*)(W + 304);
        LAS unsigned* CK = W + 320; LAS float* SV = (LAS float*)(W + 384); LAS int* SE = (LAS int*)(W + 400);
        const int c8 = lane & 7, r8 = lane >> 3;
        for (int blk = vcu; blk < M / 64; blk += G) {
            const int tok0 = blk * 64; const int b = tok0 / SEQ;
            const float* sp0 = SC + (size_t)(tok0 + wave * 8) * PQ + lane;
            float na0 = sp0[0], na1 = sp0[64], nb0 = sp0[128], nb1 = sp0[192];
            for (int j = 0; j < 8; ++j) {
                const int tl = wave * 8 + j;
                for (int h = 0; h < 8; ++h) {
                    const float a0 = na0, a1 = na1, b0 = nb0, b1 = nb1;
                    { const int nx = (j * 8 + h + 1) & 63; const float* sp = sp0 + (size_t)nx * 256; na0 = sp[0]; na1 = sp[64]; nb0 = sp[128]; nb1 = sp[192]; }
                    unsigned ka0 = (fkey(a0) & ~127u) | (unsigned)(127 - lane), ka1 = (fkey(a1) & ~127u) | (unsigned)(63 - lane);
                    unsigned kb0 = (fkey(b0) & ~127u) | (unsigned)(127 - lane), kb1 = (fkey(b1) & ~127u) | (unsigned)(63 - lane);
                    bitonic128x2(ka0, ka1, kb0, kb1, lane);
                    if (lane >= 56) { K1[127 - 2 * lane] = ka0; K1[126 - 2 * lane] = ka1; K2[127 - 2 * lane] = kb0; K2[126 - 2 * lane] = kb1; }
                    LDS_WAIT();
                    const int ci_i = CAND_I[lane], ci_j = CAND_J[lane];
                    const unsigned kA = K1[ci_i], kB = K2[ci_j];
                    const float cv = fdec(kA) + fdec(kB);
                    const unsigned ck = lane < 50 ? ((fkey(cv) & ~255u) | (unsigned)(255 - (ci_i * 16 + ci_j))) : 0u;
                    CK[lane] = ck;
                    LDS_WAIT();
                    int rc = 0;
#pragma unroll 8
                    for (int kk = 0; kk < 16; ++kk) { const v4u q = ((const LAS v4u*)CK)[kk]; rc += (q.x > ck) + (q.y > ck) + (q.z > ck) + (q.w > ck); }
                    if (lane < 50 && rc < 16) { SV[rc] = cv; SE[rc] = (int)((127u - (kA & 127u)) * 128u + (127u - (kB & 127u))); }
                    LDS_WAIT();
                    const float top0 = SV[0], myv = SV[lane & 15]; const int mye = SE[lane & 15];
                    const float e = __expf(myv - top0);
                    float ssum = e; ssum += __shfl_xor(ssum, 1); ssum += __shfl_xor(ssum, 2); ssum += __shfl_xor(ssum, 4); ssum += __shfl_xor(ssum, 8);
                    if (lane < 16) { EXPW[tl * 128 + h * 16 + lane] = (unsigned short)mye; GACT[tl * 128 + h * 16 + lane] = e / ssum; }
                    LDS_WAIT();
                }
            }
            LAS float* ACC = (LAS float*)(lds + RING_OFF + 81920);
            for (int i = lane; i < 8 * 128; i += 64) ACC[wave * 1024 + i] = 0.f;
            LDS_WAIT();
            {
                v4u gA[16], gB[16]; v4u hA, hB;
#define P10_LOADU(idx, G_, H_) do { const int s_ = (idx) >> 3, j_ = (idx) & 7; const int tl_ = wave * 8 + j_; \
                    const unsigned char* tb_ = UB + (size_t)s_ * NEXP * 128 + 16 * c8; \
                    H_ = *(const v4u*)(H8 + (size_t)(tok0 + tl_) * DM + 128 * s_ + 16 * c8); \
                    _Pragma("unroll") for (int i = 0; i < 16; ++i) { const unsigned e_ = EXPW[tl_ * 128 + r8 + 8 * i]; G_[i] = *(const v4u*)(tb_ + (size_t)e_ * 128); } } while (0)
#define P10_COMPU(idx, G_, H_) do { const int tl = wave * 8 + ((idx) & 7); int p[16]; \
                    _Pragma("unroll") for (int i = 0; i < 16; ++i) { int a_ = 0; \
                        a_ = __builtin_amdgcn_sdot4((int)G_[i].x, (int)H_.x, a_, false); a_ = __builtin_amdgcn_sdot4((int)G_[i].y, (int)H_.y, a_, false); \
                        a_ = __builtin_amdgcn_sdot4((int)G_[i].z, (int)H_.z, a_, false); a_ = __builtin_amdgcn_sdot4((int)G_[i].w, (int)H_.w, a_, false); p[i] = a_; } \
                    int q8[8], q4[4], q2[2]; \
                    _Pragma("unroll") for (int m = 0; m < 8; ++m) { const int snd = (c8 & 4) ? p[m] : p[m + 8], kp = (c8 & 4) ? p[m + 8] : p[m]; q8[m] = kp + __shfl_xor(snd, 4); } \
                    _Pragma("unroll") for (int m = 0; m < 4; ++m) { const int snd = (c8 & 2) ? q8[m] : q8[m + 4], kp = (c8 & 2) ? q8[m + 4] : q8[m]; q4[m] = kp + __shfl_xor(snd, 2); } \
                    _Pragma("unroll") for (int m = 0; m < 2; ++m) { const int snd = (c8 & 1) ? q4[m] : q4[m + 2], kp = (c8 & 1) ? q4[m + 2] : q4[m]; q2[m] = kp + __shfl_xor(snd, 1); } \
                    LAS float* ap = ACC + tl * 128 + r8 + 16 * c8;         \
                    ap[0] += (float)q2[0]; ap[8] += (float)q2[1]; } while (0)
                P10_LOADU(0, gA, hA);
#pragma unroll 1
                for (int idx = 0; idx < 256; idx += 2) {
                    P10_LOADU(idx + 1, gB, hB);
                    P10_COMPU(idx, gA, hA);
                    if (idx + 2 < 256) P10_LOADU(idx + 2, gA, hA);
                    P10_COMPU(idx + 1, gB, hB);
                }
#undef P10_LOADU
#undef P10_COMPU
            }
            LDS_WAIT();
            for (int i = lane; i < 8 * 128; i += 64) { const int o_ = wave * 1024 + i; const unsigned e = EXPW[o_];
                const float a = ACC[o_] * SCL[e] * TSC[tok0 + (o_ >> 7)]; GACT[o_] = gelu_tanh(a) * GACT[o_] * SCL[NEXP + e]; }
            LDS_WAIT();
            LAS float* SSQ = ACC;
            for (int j = 0; j < 8; ++j) SSQ[(wave * 8 + j) * 128 + lane] = 0.f;
            LDS_WAIT();
            const float* gtp = MODV + (size_t)(5 * 2 + b) * DM;
            {
                v4u gA[16], gB[16]; float aA[16], aB[16];
#define P10_LOADV(idx, G_, A_) do { const int s_ = (idx) >> 3, j_ = (idx) & 7; const int tl_ = wave * 8 + j_; \
                    const unsigned char* tb_ = VB + (size_t)s_ * NEXP * 128 + 16 * c8; \
                    _Pragma("unroll") for (int i = 0; i < 16; ++i) { const int k_ = tl_ * 128 + r8 + 8 * i; const unsigned e_ = EXPW[k_]; A_[i] = GACT[k_]; G_[i] = *(const v4u*)(tb_ + (size_t)e_ * 128); } } while (0)
#define P10_COMPV(idx, G_, A_) do { const int s_c = (idx) >> 3; const int tl = wave * 8 + ((idx) & 7); const int t = tok0 + tl; \
                    const int d = 128 * s_c + 16 * c8 + 2 * r8; \
                    const unsigned xw = __builtin_nontemporal_load((const unsigned*)(X1B + (size_t)t * DM + d)); const f32x2 gv = *(const f32x2*)(gtp + d);     \
                    const float ssq_old = SSQ[tl * 128 + lane]; \
                    f32x2 o8[8]; \
                    _Pragma("unroll") for (int q = 0; q < 8; ++q) o8[q] = (f32x2){0.f, 0.f}; \
                    _Pragma("unroll") for (int i = 0; i < 16; ++i) \
                        _Pragma("unroll") for (int q = 0; q < 4; ++q) { o8[2 * q] += __builtin_amdgcn_cvt_pk_f32_fp8((int)G_[i][q], false) * A_[i]; o8[2 * q + 1] += __builtin_amdgcn_cvt_pk_f32_fp8((int)G_[i][q], true) * A_[i]; } \
                    float p[16], q8[8], q4[4], q2[2]; \
                    _Pragma("unroll") for (int q = 0; q < 8; ++q) { p[2 * q] = o8[q].x; p[2 * q + 1] = o8[q].y; } \
                    _Pragma("unroll") for (int m = 0; m < 8; ++m) { const float snd = (r8 & 4) ? p[m] : p[m + 8], kp = (r8 & 4) ? p[m + 8] : p[m]; q8[m] = kp + __shfl_xor(snd, 32); } \
                    _Pragma("unroll") for (int m = 0; m < 4; ++m) { const float snd = (r8 & 2) ? q8[m] : q8[m + 4], kp = (r8 & 2) ? q8[m + 4] : q8[m]; q4[m] = kp + __shfl_xor(snd, 16); } \
                    _Pragma("unroll") for (int m = 0; m < 2; ++m) { const float snd = (r8 & 1) ? q4[m] : q4[m + 2], kp = (r8 & 1) ? q4[m + 2] : q4[m]; q2[m] = kp + __shfl_xor(snd, 8); } \
                    f32x2 y; y.x = bf_lo(xw) + gv.x * q2[0]; y.y = bf_hi(xw) + gv.y * q2[1]; \
                    __builtin_nontemporal_store(cvt_pk_bf16(y.x, y.y), (unsigned*)(YB + (size_t)t * DM + d)); \
                    SSQ[tl * 128 + lane] = ssq_old + (y.x * y.x + y.y * y.y); } while (0)
                P10_LOADV(0, gA, aA);
#pragma unroll 1
                for (int idx = 0; idx < 256; idx += 2) {
                    P10_LOADV(idx + 1, gB, aB);
                    P10_COMPV(idx, gA, aA);
                    if (idx + 2 < 256) P10_LOADV(idx + 2, gA, aA);
                    P10_COMPV(idx + 1, gB, aB);
                }
#undef P10_LOADV
#undef P10_COMPV
            }
            VM_WAIT(); LDS_WAIT();
            __builtin_amdgcn_fence(__ATOMIC_ACQUIRE, "agent");
            VM_WAIT();
            for (int j = 0; j < 8; ++j) {
                const int tl = wave * 8 + j; const int t = tok0 + tl;
                const float rstd = 1.0f / sqrtf(wave_sum(SSQ[tl * 128 + lane]) * (1.0f / DM) + RMS_EPS);
                f32x4* op = (f32x4*)(out + (size_t)t * DM) + lane; const f32x4* gp = (const f32x4*)g_final + lane; const v2u* yp = (const v2u*)(YB + (size_t)t * DM) + lane;
#pragma unroll 4
                for (int i = 0; i < 16; ++i) { const v2u yw = __builtin_nontemporal_load(yp + 64 * i); const f32x4 y = {bf_lo(yw.x), bf_hi(yw.x), bf_lo(yw.y), bf_hi(yw.y)}; __builtin_nontemporal_store(y * rstd * gp[64 * i], op + 64 * i); }
            }
            LDS_WAIT();
        }
    }
#undef IN
#undef BOTH
#undef GRID_BAR
}

extern "C" void kernel_launch(void* const* d_in, const int* in_sizes, int n_in, void* d_out, int out_size, void* d_ws, size_t ws_size, hipStream_t stream) {
    static int grid = 0;
    if (grid == 0) {
        if (n_in != 16 || in_sizes[0] != M * DM || out_size != M * DM || ws_size < WS_END) {
            fprintf(stderr, "kernel_launch: shape/workspace mismatch: n_in %d in0 %d out %d ws %zu (need %zu)\n", n_in, n_in > 0 ? in_sizes[0] : -1, out_size, ws_size, (size_t)WS_END); grid = -1; return; }
        int dev = 0, cus = 0, per_cu = 0;
        if (hipGetDevice(&dev) != hipSuccess || hipDeviceGetAttribute(&cus, hipDeviceAttributeMultiprocessorCount, dev) != hipSuccess) { grid = -1; return; }
        if (hipFuncSetAttribute((const void*)fwd_kernel, hipFuncAttributeMaxDynamicSharedMemorySize, LDS_BYTES) != hipSuccess) { fprintf(stderr, "kernel_launch: hipFuncSetAttribute failed\n"); grid = -1; return; }
        if (hipOccupancyMaxActiveBlocksPerMultiprocessor(&per_cu, (const void*)fwd_kernel, NWAVES * 64, LDS_BYTES) != hipSuccess || per_cu < 1)
            fprintf(stderr, "kernel_launch: note: occupancy query reports %d workgroups per CU\n", per_cu);
        (void)hipGetLastError();
        grid = cus;
    }
    if (grid < 0) return;
    if (hipMemsetAsync((char*)d_ws + WS_CTL, 0, CTL_ZERO_BYTES, stream) != hipSuccess) { fprintf(stderr, "kernel_launch: memset failed\n"); return; }
    Args a{};
    for (int i = 0; i < 16; ++i) a.in[i] = (const float*)d_in[i];
    a.out = (float*)d_out; a.ws = (unsigned char*)d_ws;
#ifdef PROBE_MASK
    {
#ifndef PROBE_PAD
#define PROBE_PAD 0
#endif
        a.mask = PROBE_MASK; a.pad = PROBE_PAD;
        hipLaunchKernelGGL(fwd_kernel, dim3(grid), dim3(NWAVES * 64), LDS_BYTES, stream, a);
        (void)hipMemsetAsync((char*)d_ws + WS_CTL, 0, CTL_ZERO_BYTES, stream);
    }
#endif
    for (int li = 0; li < MK_N_LAUNCHES; ++li) {
        a.mask = (MK_N_LAUNCHES == PER_PHASE) ? (1u << li) : ((1u << PER_PHASE) - 1u); a.pad = 0;
        hipLaunchKernelGGL(fwd_kernel, dim3(grid), dim3(NWAVES * 64), LDS_BYTES, stream, a);
        const hipError_t le = hipPeekAtLastError();
        if (le != hipSuccess) { fprintf(stderr, "kernel_launch: launch %d failed: %s\n", li, hipGetErrorName(le)); break; }
    }
}
```

```cpp
#include <hip/hip_runtime.h>
#include <cstdio>
#include <cstdint>

#ifndef MK_N_LAUNCHES
#define MK_N_LAUNCHES 1
#endif

#define GAS __attribute__((address_space(1)))
#define LAS __attribute__((address_space(3)))
typedef unsigned short bf16;
typedef unsigned v4u __attribute__((ext_vector_type(4)));
typedef unsigned v2u __attribute__((ext_vector_type(2)));
typedef float f32x4 __attribute__((ext_vector_type(4)));
typedef float f32x2 __attribute__((ext_vector_type(2)));
typedef float f32x16 __attribute__((ext_vector_type(16)));
typedef short bf16x8 __attribute__((ext_vector_type(8)));
typedef short s16x4 __attribute__((ext_vector_type(4)));
typedef __bf16 bf2_t __attribute__((ext_vector_type(2)));

constexpr int BATCH = 2, SEQ = 8192, DM = 4096, M = BATCH * SEQ;
constexpr int NH = 16, HD = 128, ATTW = 2048, POOLW = 2048, INW = 8192;
constexpr int NMOD = 6 * DM;
constexpr int PQ = 2048;
constexpr int NEXP = 16384;
constexpr float RMS_EPS = 1e-6f;
constexpr float LOG2E = 1.4426950408889634f;
constexpr float QSCALE = 0.08838834764831845f * LOG2E;
constexpr float H8SCALE = 16.f, W8SCALE = 2048.f;
constexpr float A8SCALE = 128.f, P8SCALE = 24.f, WOA8SCALE = 256.f, WOP8SCALE = (A8SCALE * WOA8SCALE) / P8SCALE;
constexpr float WQ8SCALE = 1024.f;
constexpr int KS_ADA = 64;

constexpr size_t MiB = 1u << 20;
constexpr size_t WS_CTL = 0, CTL_ZERO_BYTES = 1 * MiB;
constexpr size_t WS_MODV = 1 * MiB;
constexpr size_t WS_SCL = 2 * MiB;
constexpr size_t WS_MODP = 4 * MiB;
constexpr size_t WS_SKT = 20 * MiB;
constexpr size_t WS_PWS = 22 * MiB;
constexpr size_t WS_WQST = 24 * MiB;
constexpr size_t WS_WOUT2 = 40 * MiB;
constexpr size_t WS_WIN8 = 72 * MiB;
constexpr size_t WS_H8 = 1100 * MiB;
constexpr size_t WS_UB = 136 * MiB;
constexpr size_t WS_VB = 264 * MiB;
constexpr size_t WS_H = 392 * MiB;
constexpr size_t WS_PROJ = 520 * MiB;
constexpr size_t WS_QKVH = 1292 * MiB;
constexpr size_t WS_MIXIN = 776 * MiB;
constexpr size_t WS_WOPT = 904 * MiB;
constexpr size_t WS_WQB = 936 * MiB;
constexpr size_t WS_O0 = 968 * MiB, WS_O1 = 1032 * MiB;
constexpr size_t WS_LSE = 1096 * MiB;
constexpr size_t WS_SC = 1164 * MiB;
constexpr size_t WS_END = 1484 * MiB;

constexpr int RING_OFF = 0, RING_BYTES = 131072;
constexpr int ATT_WAVE_BYTES = 17408;
constexpr int SHARED_OFF = 139264;
constexpr int LDSCTL_OFF = 139264 + 4096, MISC_OFF = LDSCTL_OFF + 320;
constexpr int LDS_BYTES = 147456;
constexpr int NWAVES = 8;
constexpr int CW_BAR = 4096;

#define LDS_WAIT() asm volatile("s_waitcnt lgkmcnt(0)" ::: "memory")
#define VM_WAIT() asm volatile("s_waitcnt vmcnt(0)" ::: "memory")

__device__ __forceinline__ unsigned cvt_pk_bf16(float lo, float hi) { unsigned r; asm volatile("v_cvt_pk_bf16_f32 %0, %1, %2" : "=v"(r) : "v"(lo), "v"(hi)); return r; }
__device__ __forceinline__ float bf_lo(unsigned u) { return __uint_as_float(u << 16); }
__device__ __forceinline__ float bf_hi(unsigned u) { return __uint_as_float(u & 0xffff0000u); }
__device__ __forceinline__ float wave_sum(float v) {
#pragma unroll
    for (int o = 1; o < 64; o <<= 1) v += __shfl_xor(v, o);
    return v;
}

__device__ __forceinline__ unsigned q8x4c(f32x4 v, float s) {
    const unsigned b0 = __float_as_uint(__builtin_amdgcn_fmed3f(v[0] * s, -127.f, 127.f) + 12582912.0f), b1 = __float_as_uint(__builtin_amdgcn_fmed3f(v[1] * s, -127.f, 127.f) + 12582912.0f);
    const unsigned b2 = __float_as_uint(__builtin_amdgcn_fmed3f(v[2] * s, -127.f, 127.f) + 12582912.0f), b3 = __float_as_uint(__builtin_amdgcn_fmed3f(v[3] * s, -127.f, 127.f) + 12582912.0f);
    return (b0 & 0xffu) | ((b1 & 0xffu) << 8) | ((b2 & 0xffu) << 16) | (b3 << 24);
}
__device__ __forceinline__ unsigned q8x4(f32x4 v, float s) {
    const unsigned b0 = __float_as_uint(v[0] * s + 12582912.0f), b1 = __float_as_uint(v[1] * s + 12582912.0f), b2 = __float_as_uint(v[2] * s + 12582912.0f), b3 = __float_as_uint(v[3] * s + 12582912.0f);
    return (b0 & 0xffu) | ((b1 & 0xffu) << 8) | ((b2 & 0xffu) << 16) | (b3 << 24);
}
namespace pg8 {
typedef unsigned short bf16_t;
typedef int v4i_t __attribute__((ext_vector_type(4)));
typedef int v8i_t __attribute__((ext_vector_type(8)));
constexpr int BM = 256, BK = 64, HALF = 128, HTB = HALF * BK * 2, STAGE_BYTES = 8 * HTB, NXCD = 8, WGM = 8;

__host__ __device__ __forceinline__ int lds_byte(int r, int c) { const int st = (r >> 4) * 2 + (c >> 5), rr = r & 15, cc = c & 31, ob = rr * 64 + cc * 2; return st * 1024 + (ob ^ (((ob >> 9) & 1) << 5)); }
__host__ __device__ __forceinline__ void stage_rc(int b, int& R, int& C) { const int st = b / 1024, sb = b % 1024, swz = sb ^ (((sb >> 9) & 1) << 5); R = (st >> 1) * 16 + swz / 64; C = (st & 1) * 32 + (swz % 64) / 2; }
__host__ __device__ __forceinline__ int perm32(int rho) { const int n = rho >> 4, i = rho & 15; return 8 * (i >> 2) + 4 * n + (i & 3); }

template <int NF> __device__ __forceinline__ void pg8_ldfrag16(bf16x8 (&dst)[NF][2], const LAS unsigned char* base, int off) {
#pragma unroll
    for (int m = 0; m < NF; ++m)
#pragma unroll
        for (int k = 0; k < 2; ++k) dst[m][k] = *(const LAS bf16x8*)(base + off + m * 2048 + k * 1024);
}
__device__ __forceinline__ void pg8_mma16(f32x4 (&acc)[4][2], const bf16x8 (&At)[4][2], const bf16x8 (&Bt)[2][2]) {
#pragma unroll
    for (int m = 0; m < 4; ++m)
#pragma unroll
        for (int n = 0; n < 2; ++n)
#pragma unroll
            for (int k = 0; k < 2; ++k) acc[m][n] = __builtin_amdgcn_mfma_f32_16x16x32_bf16(Bt[n][k], At[m][k], acc[m][n], 0, 0, 0);
}
__device__ __forceinline__ void pg8_mma8(v4i_t (&acc)[4][2], const bf16x8 (&At)[4][2], const bf16x8 (&Bt)[2][2]) {
#pragma unroll
    for (int m = 0; m < 4; ++m)
#pragma unroll
        for (int n = 0; n < 2; ++n)
#pragma unroll
            for (int k = 0; k < 2; ++k) acc[m][n] = __builtin_amdgcn_mfma_i32_16x16x64_i8(__builtin_bit_cast(v4i_t, Bt[n][k]), __builtin_bit_cast(v4i_t, At[m][k]), acc[m][n], 0, 0, 0);
}
struct Unit { int pm, pn; };
struct Gemm { const bf16_t* A; const bf16_t* Bt; int M, N, K, lda, ldb, agrp_div, agrp_cols, bgrp_div, bgrp_cols; };

struct StaticOrder {
    int nM, nN, nwg, G, c;
    __host__ __device__ void init(int M_, int N_, int G_, int c_) { nM = M_ / BM; nN = N_ / BM; nwg = nM * nN; G = G_; c = c_; }
    __host__ __device__ bool next(int i, Unit& u) const {
        const long L = (long)i * G + c; if (L >= nwg) return false;
        int wgid = (int)L; { const int q = nwg / NXCD, r = nwg % NXCD, xcd = wgid % NXCD, off = wgid / NXCD; wgid = (xcd < r ? xcd * (q + 1) : r * (q + 1) + (xcd - r) * q) + off; }
        const int nig = WGM * nN, gid = wgid / nig, fm = gid * WGM, gsz = (nM - fm) < WGM ? (nM - fm) : WGM;
        u.pm = fm + ((wgid % nig) % gsz); u.pn = (wgid % nig) / gsz; return true;
    }
    __device__ __forceinline__ void a_ready(const Unit&) const {}
    __device__ __forceinline__ void done(const Unit&) const {}
};

struct EpiBf16 {
    static constexpr bool PERM = true, AFTER_DRAIN = false;
    bf16_t* O; int ldc; int scale_cols; float scale0; bf16_t* HM; int hm_cols; int hm_rows; float scale1 = 1.0f;
    __device__ __forceinline__ void operator()(const f32x4 (&acc)[2][2][4][2], const Unit& u, int wr, int wc, int fr, int fq) const {
        const int row0 = u.pm * BM + wr * 64 + fr; const int colt = u.pn * BM;
        const float sc = (colt < scale_cols) ? scale0 : scale1;
        const bool hm = colt < hm_cols;
        const int cw = wc * 32 + 8 * fq;
        bf16_t* base = hm ? HM + (size_t)(colt / HALF) * hm_rows * HALF + cw : O + (colt - hm_cols) + cw;
        const size_t rpitch = hm ? (size_t)HALF : (size_t)ldc, hstep = hm ? (size_t)hm_rows * HALF : (size_t)HALF;
#pragma unroll
        for (int ai = 0; ai < 2; ++ai)
#pragma unroll
            for (int m = 0; m < 4; ++m) { bf16_t* rowp = base + (size_t)(row0 + ai * HALF + m * 16) * rpitch;
#pragma unroll
                for (int bj = 0; bj < 2; ++bj) { f32x4 v0 = acc[ai][bj][m][0] * sc, v1 = acc[ai][bj][m][1] * sc;
                    v4u w; w.x = cvt_pk_bf16(v0[0], v0[1]); w.y = cvt_pk_bf16(v0[2], v0[3]); w.z = cvt_pk_bf16(v1[0], v1[1]); w.w = cvt_pk_bf16(v1[2], v1[3]);
                    *(v4u*)(rowp + bj * hstep) = w; } }
    }
};
struct EpiBf16ColScale {
    static constexpr bool PERM = true, AFTER_DRAIN = false;
    bf16_t* O; int ldc; int coff; const float* cs;
    __device__ __forceinline__ void operator()(const f32x4 (&acc)[2][2][4][2], const Unit& u, int wr, int wc, int fr, int fq) const {
        const int row0 = u.pm * BM + wr * 64 + fr; const int col0 = u.pn * BM + wc * 32 + 8 * fq;
        f32x4 sv[2][2];
#pragma unroll
        for (int bj = 0; bj < 2; ++bj)
#pragma unroll
            for (int n = 0; n < 2; ++n) sv[bj][n] = *(const f32x4*)(cs + col0 + bj * HALF + 4 * n);
#pragma unroll
        for (int ai = 0; ai < 2; ++ai)
#pragma unroll
            for (int m = 0; m < 4; ++m) { bf16_t* rowp = O + (size_t)(row0 + ai * HALF + m * 16) * ldc + coff + col0;
#pragma unroll
                for (int bj = 0; bj < 2; ++bj) { f32x4 v0 = acc[ai][bj][m][0] * sv[bj][0], v1 = acc[ai][bj][m][1] * sv[bj][1];
                    v4u w; w.x = cvt_pk_bf16(v0[0], v0[1]); w.y = cvt_pk_bf16(v0[2], v0[3]); w.z = cvt_pk_bf16(v1[0], v1[1]); w.w = cvt_pk_bf16(v1[2], v1[3]);
                    *(v4u*)(rowp + bj * HALF) = w; } }
    }
};
struct EpiI8 {
    static constexpr bool PERM = true, AFTER_DRAIN = false;
    unsigned char* O; int ldc; int coff; float scale;
    __device__ __forceinline__ void operator()(const f32x4 (&acc)[2][2][4][2], const Unit& u, int wr, int wc, int fr, int fq) const {
        const int row0 = u.pm * BM + wr * 64 + fr; const int col0 = u.pn * BM + wc * 32 + 8 * fq;
#pragma unroll
        for (int ai = 0; ai < 2; ++ai)
#pragma unroll
            for (int m = 0; m < 4; ++m) { unsigned char* rowp = O + (size_t)(row0 + ai * HALF + m * 16) * ldc + coff + col0;
#pragma unroll
                for (int bj = 0; bj < 2; ++bj) *(v2u*)(rowp + bj * HALF) = (v2u){q8x4c(acc[ai][bj][m][0], scale), q8x4c(acc[ai][bj][m][1], scale)}; }
    }
};
struct EpiF32RowScale {
    static constexpr bool PERM = false, AFTER_DRAIN = false;
    float* O; int ldc; const float* rs; const float* cs;
    __device__ __forceinline__ void operator()(const f32x4 (&acc)[2][2][4][2], const Unit& u, int wr, int wc, int fr, int fq) const {
        const int row0 = u.pm * BM + wr * 64 + fr; const int col0 = u.pn * BM + wc * 32 + 4 * fq;
        f32x4 cv[2][2];
#pragma unroll
        for (int bj = 0; bj < 2; ++bj)
#pragma unroll
            for (int n = 0; n < 2; ++n) cv[bj][n] = *(const f32x4*)(cs + col0 + bj * HALF + n * 16);
#pragma unroll
        for (int ai = 0; ai < 2; ++ai)
#pragma unroll
            for (int m = 0; m < 4; ++m) { const int row = row0 + ai * HALF + m * 16; const float r = rs[row]; const size_t off = (size_t)row * ldc + col0;
#pragma unroll
                for (int bj = 0; bj < 2; ++bj)
#pragma unroll
                    for (int n = 0; n < 2; ++n) *(f32x4*)(O + off + bj * HALF + n * 16) = acc[ai][bj][m][n] * cv[bj][n] * r; }
    }
};
struct EpiResBf16 {
    static constexpr bool PERM = true, AFTER_DRAIN = false;
    const float* X; const float* gate; bf16_t* O; int ldc; float ascale;
    __device__ __forceinline__ void operator()(const f32x4 (&acc)[2][2][4][2], const Unit& u, int wr, int wc, int fr, int fq) const {
        const int row0 = u.pm * BM + wr * 64 + fr; const int col0 = u.pn * BM + wc * 32 + 8 * fq; const int b = (u.pm * BM) / SEQ;
        f32x4 gv[2][2];
#pragma unroll
        for (int bj = 0; bj < 2; ++bj)
#pragma unroll
            for (int n = 0; n < 2; ++n) gv[bj][n] = *(const f32x4*)(gate + (size_t)b * DM + col0 + bj * HALF + 4 * n) * ascale;
#pragma unroll
        for (int ai = 0; ai < 2; ++ai)
#pragma unroll
            for (int m = 0; m < 4; ++m) { const size_t off = (size_t)(row0 + ai * HALF + m * 16) * ldc + col0;
#pragma unroll
                for (int bj = 0; bj < 2; ++bj) { const f32x4 x0 = *(const f32x4*)(X + off + bj * HALF), x1 = *(const f32x4*)(X + off + bj * HALF + 4);
                    const f32x4 v0 = x0 + gv[bj][0] * acc[ai][bj][m][0], v1 = x1 + gv[bj][1] * acc[ai][bj][m][1];
                    v4u w; w.x = cvt_pk_bf16(v0[0], v0[1]); w.y = cvt_pk_bf16(v0[2], v0[3]); w.z = cvt_pk_bf16(v1[0], v1[1]); w.w = cvt_pk_bf16(v1[2], v1[3]);
                    *(v4u*)(O + off + bj * HALF) = w; } }
    }
};
struct EpiResF32 {
    static constexpr bool PERM = false, AFTER_DRAIN = false;
    const float* X; const float* gate; float* O; int ldc;
    __device__ __forceinline__ void operator()(const f32x4 (&acc)[2][2][4][2], const Unit& u, int wr, int wc, int fr, int fq) const {
        const int row0 = u.pm * BM + wr * 64 + fr; const int col0 = u.pn * BM + wc * 32 + 4 * fq; const int b = (u.pm * BM) / SEQ;
        f32x4 gv[2][2];
#pragma unroll
        for (int bj = 0; bj < 2; ++bj)
#pragma unroll
            for (int n = 0; n < 2; ++n) gv[bj][n] = *(const f32x4*)(gate + (size_t)b * DM + col0 + bj * HALF + n * 16);
#pragma unroll
        for (int ai = 0; ai < 2; ++ai)
#pragma unroll
            for (int m = 0; m < 4; ++m) { const size_t off = (size_t)(row0 + ai * HALF + m * 16) * ldc + col0;
#pragma unroll
                for (int bj = 0; bj < 2; ++bj)
#pragma unroll
                    for (int n = 0; n < 2; ++n) { const f32x4 xv = *(const f32x4*)(X + off + bj * HALF + n * 16);
                        *(f32x4*)(O + off + bj * HALF + n * 16) = xv + gv[bj][n] * acc[ai][bj][m][n]; } }
    }
};
struct EpiF32 {
    static constexpr bool PERM = false, AFTER_DRAIN = false;
    float* O; int ldc;
    __device__ __forceinline__ void operator()(const f32x4 (&acc)[2][2][4][2], const Unit& u, int wr, int wc, int fr, int fq) const {
        const int row0 = u.pm * BM + wr * 64 + fr; const int col0 = u.pn * BM + wc * 32 + 4 * fq;
#pragma unroll
        for (int ai = 0; ai < 2; ++ai)
#pragma unroll
            for (int m = 0; m < 4; ++m) { const size_t off = (size_t)(row0 + ai * HALF + m * 16) * ldc + col0;
#pragma unroll
                for (int bj = 0; bj < 2; ++bj)
#pragma unroll
                    for (int n = 0; n < 2; ++n) *(f32x4*)(O + off + bj * HALF + n * 16) = acc[ai][bj][m][n]; }
    }
};

template <class Epi, class Sched, bool ALIGN_EPI, bool I8 = false>
__device__ __forceinline__ void gemm_phase(LAS unsigned char* lds, const Gemm g, const Sched& S, const Epi& E) {
    int tid_ = threadIdx.x; asm volatile("" : "+v"(tid_));
    const int tid = tid_, wid = __builtin_amdgcn_readfirstlane(tid >> 6), lane = tid & 63, wr = wid >> 2, wc = wid & 3, fr = lane & 15, fq = lane >> 4;
    const int K = g.K, nt = K / BK;
    unsigned voffA, voffB;
    { int R, C; stage_rc(tid * 16, R, C); const int Rb = Epi::PERM ? ((R & ~31) + perm32(R & 31)) : R;
      voffA = (unsigned)(R * g.lda + C) * 2u; voffB = (unsigned)(Rb * g.ldb + C) * 2u; }
    const size_t pstepA = (size_t)64 * g.lda * 2, pstepB = (size_t)64 * g.ldb * 2;
    const size_t kstep = (size_t)(BK * 2);
    const size_t hstepA = (size_t)HALF * g.lda * 2, hstepB = (size_t)HALF * g.ldb * 2;
    const size_t tstepA = 2 * hstepA, tstepB = 2 * hstepB;
    const unsigned ldsw = (unsigned)wid * 1024u;
    const int aoff = lds_byte(wr * 64 + fr, fq * 8), boff = lds_byte(wc * 32 + fr, fq * 8);
#define PG8_SA(b, h) (((b) * 2 + (h)) * HTB)
#define PG8_SB(b, h) ((4 + (b) * 2 + (h)) * HTB)
#define PG8_STAGE(bufoff, gbase, voff) do { _Pragma("unroll") for (int _i = 0; _i < 2; ++_i) \
        __builtin_amdgcn_global_load_lds((const unsigned*)((const char*)(gbase) + (size_t)_i * pstep_##voff + (voff)), (LAS unsigned*)(lds + (bufoff) + ldsw + _i * 8192), 16, 0, 0); } while (0)
#define pstep_voffA pstepA
#define pstep_voffB pstepB
#define PG8_LDA(dst, b, h) pg8_ldfrag16<4>(dst, lds + PG8_SA(b, h), aoff)
#define PG8_LDB(dst, b, h) pg8_ldfrag16<2>(dst, lds + PG8_SB(b, h), boff)
#define PG8_MMA(ai, bj, At, Bt) do { __builtin_amdgcn_s_setprio(1); if constexpr (I8) pg8_mma8(acci[ai][bj], At, Bt); else pg8_mma16(acc[ai][bj], At, Bt); __builtin_amdgcn_s_setprio(0); } while (0)
#define PG8_WAIT_V(n) asm volatile("s_waitcnt vmcnt(" #n ")" ::: "memory")
#define PG8_WAIT_L(n) asm volatile("s_waitcnt lgkmcnt(" #n ")" ::: "memory")
#define PG8_BAR __builtin_amdgcn_s_barrier()
#define PG8_SCHED __builtin_amdgcn_sched_barrier(0)
#define PG8_ABASE(u) ((const char*)g.A + (size_t)(u).pm * tstepA + (size_t)((u).pn / g.agrp_div) * (size_t)g.agrp_cols * 2)
#define PG8_BBASE(u) ((const char*)g.Bt + (size_t)(u).pn * tstepB + (size_t)((u).pm / g.bgrp_div) * (size_t)g.bgrp_cols * 2)
    Unit cur, nxt; int ui = 0;
    if (!S.next(0, cur)) return;
    f32x4 acc[2][2][4][2]; v4i_t acci[2][2][4][2];
#pragma unroll
    for (int a = 0; a < 2; ++a)
#pragma unroll
        for (int b = 0; b < 2; ++b)
#pragma unroll
            for (int m = 0; m < 4; ++m)
#pragma unroll
                for (int n = 0; n < 2; ++n) { acc[a][b][m][n] = (f32x4){0.f, 0.f, 0.f, 0.f}; acci[a][b][m][n] = (v4i_t){0, 0, 0, 0}; }
    bf16x8 At[4][2], B0[2][2], B1[2][2];
    const char* cA = PG8_ABASE(cur); const char* cB = PG8_BBASE(cur);
    S.a_ready(cur);
    PG8_STAGE(PG8_SB(0, 0), cB, voffB); PG8_STAGE(PG8_SB(0, 1), cB + hstepB, voffB); PG8_STAGE(PG8_SA(0, 0), cA, voffA); PG8_STAGE(PG8_SA(0, 1), cA + hstepA, voffA);
    if (wr == 1) PG8_BAR;
    PG8_WAIT_V(2); PG8_BAR;
    PG8_STAGE(PG8_SB(1, 0), cB + kstep, voffB); PG8_STAGE(PG8_SA(1, 0), cA + kstep, voffA); PG8_STAGE(PG8_SB(1, 1), cB + hstepB + kstep, voffB);
    PG8_WAIT_V(6); PG8_BAR;
    for (;;) {
        const bool has_next = S.next(ui + 1, nxt);
        const char* nA = has_next ? PG8_ABASE(nxt) : cA; const char* nB = has_next ? PG8_BBASE(nxt) : cB;
        for (int t = 0; t < nt; t += 2) {
            const bool last = (t == nt - 2);
            const char* a1 = cA + (size_t)(t + 1) * kstep;
            const char* a2 = last ? nA : cA + (size_t)(t + 2) * kstep; const char* b2 = last ? nB : cB + (size_t)(t + 2) * kstep;
            const char* a3 = a2 + kstep; const char* b3 = b2 + kstep;
            if (last && has_next) S.a_ready(nxt);
            PG8_LDB(B0, 0, 0); PG8_LDB(B1, 0, 1); PG8_SCHED; PG8_LDA(At, 0, 0); PG8_STAGE(PG8_SA(1, 1), a1 + hstepA, voffA);
            PG8_WAIT_V(8); PG8_WAIT_L(0); PG8_BAR; PG8_MMA(0, 0, At, B0); PG8_MMA(0, 1, At, B1); PG8_BAR; PG8_SCHED;
            PG8_LDA(At, 0, 1); PG8_STAGE(PG8_SB(0, 0), b2, voffB); PG8_STAGE(PG8_SB(0, 1), b2 + hstepB, voffB); PG8_STAGE(PG8_SA(0, 0), a2, voffA);
            PG8_WAIT_V(8); PG8_WAIT_L(0); PG8_BAR; PG8_MMA(1, 0, At, B0); PG8_MMA(1, 1, At, B1); PG8_BAR; PG8_SCHED;
            PG8_LDB(B0, 1, 0); PG8_LDB(B1, 1, 1); PG8_SCHED; PG8_LDA(At, 1, 0); PG8_STAGE(PG8_SA(0, 1), a2 + hstepA, voffA);
            PG8_WAIT_V(8); PG8_WAIT_L(0); PG8_BAR; PG8_MMA(0, 0, At, B0); PG8_MMA(0, 1, At, B1); PG8_BAR; PG8_SCHED;
            PG8_LDA(At, 1, 1); PG8_STAGE(PG8_SB(1, 0), b3, voffB); PG8_STAGE(PG8_SB(1, 1), b3 + hstepB, voffB); PG8_STAGE(PG8_SA(1, 0), a3, voffA);
            PG8_WAIT_V(8); PG8_WAIT_L(0); PG8_BAR; PG8_MMA(1, 0, At, B0); PG8_MMA(1, 1, At, B1); PG8_BAR; PG8_SCHED;
        }
        if constexpr (ALIGN_EPI) { if (wr == 0) PG8_BAR; }
        if constexpr (I8) {
#pragma unroll
            for (int a = 0; a < 2; ++a)
#pragma unroll
                for (int b = 0; b < 2; ++b)
#pragma unroll
                    for (int m = 0; m < 4; ++m)
#pragma unroll
                        for (int n = 0; n < 2; ++n) acc[a][b][m][n] = __builtin_convertvector(acci[a][b][m][n], f32x4);
        }
        E(acc, cur, wr, wc, fr, fq);
        S.done(cur);
        if (!has_next) break;
#pragma unroll
        for (int a = 0; a < 2; ++a)
#pragma unroll
            for (int b = 0; b < 2; ++b)
#pragma unroll
                for (int m = 0; m < 4; ++m)
#pragma unroll
                    for (int n = 0; n < 2; ++n) { acc[a][b][m][n] = (f32x4){0.f, 0.f, 0.f, 0.f}; acci[a][b][m][n] = (v4i_t){0, 0, 0, 0}; }
        cur = nxt; cA = nA; cB = nB; ++ui;
        if constexpr (ALIGN_EPI) { if (wr == 1) PG8_BAR; }
    }
    PG8_WAIT_V(0);
    if constexpr (!ALIGN_EPI) { if (wr == 0) PG8_BAR; }
    PG8_BAR;
#undef PG8_SA
#undef PG8_SB
#undef PG8_STAGE
#undef pstep_voffA
#undef pstep_voffB
#undef PG8_LDA
#undef PG8_LDB
#undef PG8_MMA
#undef PG8_WAIT_V
#undef PG8_WAIT_L
#undef PG8_BAR
#undef PG8_SCHED
#undef PG8_ABASE
#undef PG8_BBASE
}
}

#define XB_TMO      128
#define XB_XCNT(j)  (256  + 64 * (j))
#define XB_XSUB(j)  (1280 + 64 * (j))
#define XB_XGEN(j)  (2304 + 64 * (j))
#define XB_TOP      3328
#define XB_TOPGEN   3392
#define XCD_BAR_WORDS 3456
#define XB_SPIN_CAP (1u << 18)

__device__ __forceinline__ unsigned xb_ld(unsigned* p)              { return __hip_atomic_load(p, __ATOMIC_RELAXED, __HIP_MEMORY_SCOPE_AGENT); }
__device__ __forceinline__ unsigned xb_add(unsigned* p, unsigned v) { return __hip_atomic_fetch_add(p, v, __ATOMIC_RELAXED, __HIP_MEMORY_SCOPE_AGENT); }
__device__ __forceinline__ unsigned xb_xcc_id() { return (unsigned)__builtin_amdgcn_s_getreg((3 << 11) | 20) & 0xFu; }
#define XB_SPIN(cond, bar) do { unsigned _sp = 0; while (cond) { __builtin_amdgcn_s_sleep(1); \
    if ((++_sp & 255u) == 0u) { if (xb_ld(&(bar)[XB_TMO])) break; if (_sp > XB_SPIN_CAP) { atomicAdd(&(bar)[XB_TMO], 1u); break; } } } } while (0)

struct XcdBarrier { unsigned* bar; unsigned x; volatile LAS unsigned* st; };

__device__ __forceinline__ XcdBarrier xcd_barrier_post(unsigned* bar, volatile LAS unsigned* st) {
    XcdBarrier b; b.bar = bar; b.x = xb_xcc_id(); b.st = st;
    if (threadIdx.x == 0) (void)xb_add(&bar[XB_XCNT(b.x)], 1u);
    return b;
}
__device__ __forceinline__ void xcd_barrier_complete(unsigned* bar, unsigned x, unsigned& nloc, unsigned& nx) {
    const unsigned G = gridDim.x * gridDim.y * gridDim.z;
    unsigned sum, cnt, mine, sp = 0u;
    for (;;) {
        sum = 0u; cnt = 0u; mine = 0u;
#pragma unroll
        for (unsigned j = 0; j < 16; ++j) { const unsigned c = xb_ld(&bar[XB_XCNT(j)]); sum += c; cnt += (c > 0u) ? 1u : 0u; mine = (j == x) ? c : mine; }
        if (sum == G) break;
        __builtin_amdgcn_s_sleep(1);
        if ((++sp & 255u) == 0u) { if (xb_ld(&bar[XB_TMO])) break; if (sp > XB_SPIN_CAP) { atomicAdd(&bar[XB_TMO], 1u); break; } }
    }
    nloc = mine > 0u ? mine : 1u; nx = cnt > 0u ? cnt : 1u;
}
__device__ __forceinline__ void xcd_barrier(const XcdBarrier& b) {
    asm volatile("s_waitcnt vmcnt(0)" ::: "memory");
    __syncthreads();
    if (threadIdx.x == 0) {
        unsigned* bar = b.bar;
        __builtin_amdgcn_s_waitcnt(0);
        unsigned nloc = b.st[0], nx = b.st[1];
        if (nloc == 0u) { xcd_barrier_complete(bar, b.x, nloc, nx); b.st[0] = nloc; b.st[1] = nx; }
        const unsigned old = xb_add(&bar[XB_XSUB(b.x)], 1u);
        const unsigned gen = old / nloc;
        if (old + 1u == (gen + 1u) * nloc) {
            __builtin_amdgcn_fence(__ATOMIC_RELEASE, "agent");
            asm volatile("s_waitcnt vmcnt(0)" ::: "memory");
            const unsigned og = xb_add(&bar[XB_TOP], 1u);
            const unsigned tg = og / nx;
            if (og + 1u == (tg + 1u) * nx) xb_add(&bar[XB_TOPGEN], 1u);
            else XB_SPIN(xb_ld(&bar[XB_TOPGEN]) == tg, bar);
            __builtin_amdgcn_fence(__ATOMIC_ACQUIRE, "agent");
            xb_add(&bar[XB_XGEN(b.x)], 1u);
            asm volatile("s_waitcnt vmcnt(0)" ::: "memory");
        } else {
            XB_SPIN(xb_ld(&bar[XB_XGEN(b.x)]) == gen, bar);
            __builtin_amdgcn_fence(__ATOMIC_ACQUIRE, "agent");
            asm volatile("s_waitcnt vmcnt(0)" ::: "memory");
        }
    }
    __syncthreads();
}

template <bool F8>
__device__ __forceinline__ void p0_transpose_item(const float* W, int ldw, int N, void* WTv, int ldt, float scale, LAS float* scr, int item, int lane) {
    const int nblk = N / 32, kb = item / nblk, nb = item % nblk, k0 = 64 * kb, n0 = 32 * nb;
#pragma unroll 8
    for (int i = 0; i < 32; ++i) { const int kk = 2 * i + (lane >> 5); scr[kk * 33 + (lane & 31)] = W[(size_t)(k0 + kk) * ldw + n0 + (lane & 31)]; }
    LDS_WAIT(); asm volatile("" ::: "memory");
    const int c = lane & 7;
#pragma unroll
    for (int j = 0; j < 4; ++j) { const int n = (lane >> 3) + 8 * j; const LAS float* s = scr + (8 * c) * 33 + n;
        if constexpr (F8) {
            const f32x4 lo4 = {s[0 * 33], s[1 * 33], s[2 * 33], s[3 * 33]}, hi4 = {s[4 * 33], s[5 * 33], s[6 * 33], s[7 * 33]};
            *(GAS v2u*)((unsigned char*)WTv + (size_t)(n0 + n) * ldt + k0 + 8 * c) = (v2u){q8x4c(lo4, scale), q8x4c(hi4, scale)};
        } else {
            v4u o; o.x = cvt_pk_bf16(s[0 * 33], s[1 * 33]); o.y = cvt_pk_bf16(s[2 * 33], s[3 * 33]); o.z = cvt_pk_bf16(s[4 * 33], s[5 * 33]); o.w = cvt_pk_bf16(s[6 * 33], s[7 * 33]);
            *(GAS v4u*)((bf16*)WTv + (size_t)(n0 + n) * ldt + k0 + 8 * c) = o; } }
    LDS_WAIT(); asm volatile("" ::: "memory");
}

__device__ __forceinline__ int t5_bucket(int rel) {
    int n = -rel; const int ret = n < 0 ? 16 : 0; n = n < 0 ? -n : n;
    if (n < 8) return ret + n;
    const float v = logf((float)n / 8.0f) / logf(128.0f) * 8.0f;
    int large = 8 + (int)v; large = large < 15 ? large : 15;
    return ret + large;
}
__device__ __forceinline__ float gelu_tanh(float x) {
    const float z = 0.7978845608028654f * (x + 0.044715f * x * x * x);
    const float e = __expf(2.0f * z);
    const float t = 1.0f - 2.0f / (e + 1.0f);
    return 0.5f * x * (1.0f + t);
}
__device__ __forceinline__ unsigned fkey(float v) { const unsigned u = __float_as_uint(v); return (u >> 31) ? ~u : (u | 0x80000000u); }
__device__ __forceinline__ float fdec(unsigned key) { const unsigned k2 = key & ~127u; const unsigned u = (k2 >> 31) ? (k2 & 0x7fffffffu) : (~k2 & ~127u); return __uint_as_float(u); }
template <int LJ> __device__ __forceinline__ unsigned xshfl(unsigned x, const int lane) {
    if constexpr (LJ == 1) return (unsigned)__builtin_amdgcn_update_dpp(0, (int)x, 0xB1, 0xF, 0xF, false);
    else if constexpr (LJ == 2) return (unsigned)__builtin_amdgcn_update_dpp(0, (int)x, 0x4E, 0xF, 0xF, false);
    else if constexpr (LJ == 4) { const int y = __builtin_amdgcn_update_dpp(0, (int)x, 0x141, 0xF, 0xF, false); return (unsigned)__builtin_amdgcn_update_dpp(0, y, 0x1B, 0xF, 0xF, false); }
    else if constexpr (LJ == 8) { const int y = __builtin_amdgcn_update_dpp(0, (int)x, 0x140, 0xF, 0xF, false); return (unsigned)__builtin_amdgcn_update_dpp(0, y, 0x141, 0xF, 0xF, false); }
    else if constexpr (LJ == 16) return (unsigned)__builtin_amdgcn_ds_swizzle((int)x, 0x401F);
    else { const auto rr = __builtin_amdgcn_permlane32_swap(x, x, false, false); return lane < 32 ? rr[1] : rr[0]; }
}
template <int K, int J> __device__ __forceinline__ void bitonic_step(unsigned& a0, unsigned& a1, unsigned& b0, unsigned& b1, const int lane) {
    const bool asc = (K == 128) ? true : ((lane & (K >> 1)) == 0);
    if constexpr (J == 1) {
        const unsigned la = a0 < a1 ? a0 : a1, ha = a0 < a1 ? a1 : a0, lb = b0 < b1 ? b0 : b1, hb = b0 < b1 ? b1 : b0;
        a0 = asc ? la : ha; a1 = asc ? ha : la; b0 = asc ? lb : hb; b1 = asc ? hb : lb;
    } else {
        constexpr int LJ = J >> 1; const bool tmin = (((lane & LJ) == 0) == asc);
        const unsigned pa0 = xshfl<LJ>(a0, lane), pa1 = xshfl<LJ>(a1, lane), pb0 = xshfl<LJ>(b0, lane), pb1 = xshfl<LJ>(b1, lane);
        a0 = tmin ? (a0 < pa0 ? a0 : pa0) : (a0 < pa0 ? pa0 : a0); a1 = tmin ? (a1 < pa1 ? a1 : pa1) : (a1 < pa1 ? pa1 : a1);
        b0 = tmin ? (b0 < pb0 ? b0 : pb0) : (b0 < pb0 ? pb0 : b0); b1 = tmin ? (b1 < pb1 ? b1 : pb1) : (b1 < pb1 ? pb1 : b1);
    }
    if constexpr (J > 1) bitonic_step<K, (J >> 1)>(a0, a1, b0, b1, lane);
}
template <int K> __device__ __forceinline__ void bitonic_stage(unsigned& a0, unsigned& a1, unsigned& b0, unsigned& b1, const int lane) {
    bitonic_step<K, (K >> 1)>(a0, a1, b0, b1, lane);
    if constexpr (K < 128) bitonic_stage<(K << 1)>(a0, a1, b0, b1, lane);
}
__device__ __forceinline__ void bitonic128x2(unsigned& a0, unsigned& a1, unsigned& b0, unsigned& b1, const int lane) { bitonic_stage<2>(a0, a1, b0, b1, lane); }
__device__ __forceinline__ float dot2bf(unsigned a, unsigned b, float c) { return __builtin_amdgcn_fdot2_f32_bf16(__builtin_bit_cast(bf2_t, a), __builtin_bit_cast(bf2_t, b), c, false); }

constexpr int ATT_SLOT = 8704;
__device__ __forceinline__ int crow(int r, int hi) { return (r & 3) + 8 * (r >> 2) + 4 * hi; }

__device__ __forceinline__ void attn_task(const int G, const bf16* QKVH, bf16* O0, bf16* O1, float* LSE0, float* LSE1, unsigned char* MIX8,
                                          const LAS float* btab, LAS unsigned char* wl, int b, int h, int mtile, int tk, int lane) {
    const int SH = 2 * G;
    const int L = SEQ >> SH, TPR = 32 >> SH;
    const int r32 = lane & 31, hi = lane >> 5;
    const int res = tk >> (5 - SH), l0 = ((mtile * 1024) >> SH) + 32 * (tk & (TPR - 1));
    const size_t rowbase = (size_t)b * SEQ;
    const int srow = lane >> 4, sch = lane & 15;
    const int rot = (tk & 1) ? 4 : 0;
#define ATT_JR(j) (((j) + rot) >= 5 ? ((j) + rot - 5) : ((j) + rot))
#define ATT_WAITV(n) asm volatile("s_waitcnt vmcnt(" #n ")" ::: "memory")
#define ATT_ISSUE(n) do { LAS unsigned char* sl_ = wl + ((n) & 1) * ATT_SLOT; const int jt_ = ATT_JR((n) < 5 ? (n) : (n) - 5); \
        _Pragma("unroll") for (int i_ = 0; i_ < 8; ++i_) { \
            const int key_ = (n) < 5 ? (4 * i_ + srow) : ((i_ & 3) + 4 * srow + 16 * (i_ >> 2)); \
            int lk_ = l0 - 64 + 32 * jt_ + key_; lk_ = lk_ < 0 ? 0 : (lk_ > L - 1 ? L - 1 : lk_); \
            const int ch_ = (n) < 5 ? (sch ^ (key_ & 7)) : sch; \
            const bf16* src_ = QKVH + ((size_t)(((n) < 5 ? NH : 2 * NH) + h) * M + rowbase + ((size_t)lk_ << SH) + res) * HD + ch_ * 8; \
            __builtin_amdgcn_global_load_lds((const unsigned*)src_, (LAS unsigned*)(sl_ + i_ * ((n) < 5 ? 1024 : 1088)), 16, 0, 0); } } while (0)
    const size_t qrow = rowbase + ((size_t)(l0 + r32) << SH) + res;
    bf16x8 qr[8];
    { const bf16* qp = QKVH + ((size_t)h * M + qrow) * HD + hi * 8;
#pragma unroll
      for (int d0 = 0; d0 < 8; ++d0) qr[d0] = *(const bf16x8*)(qp + d0 * 16); }
    ATT_ISSUE(0); ATT_ISSUE(1);
    f32x16 p[5];
#define ATT_KTILE(n) do { LAS unsigned char* sl_ = wl + ((n) & 1) * ATT_SLOT + r32 * 256; f32x16 s_ = {}; \
        _Pragma("unroll") for (int d0 = 0; d0 < 8; ++d0) { const bf16x8 a_ = *(const LAS bf16x8*)(sl_ + (((2 * d0 + hi) ^ (r32 & 7)) << 4)); s_ = __builtin_amdgcn_mfma_f32_32x32x16_bf16(a_, qr[d0], s_, 0, 0, 0); } \
        p[n] = s_; asm volatile("" ::: "memory"); } while (0)
    ATT_WAITV(8); ATT_KTILE(0); ATT_ISSUE(2);
    ATT_WAITV(8); ATT_KTILE(1); ATT_ISSUE(3);
    ATT_WAITV(8); ATT_KTILE(2); ATT_ISSUE(4);
    ATT_WAITV(8); ATT_KTILE(3); ATT_ISSUE(5);
    ATT_WAITV(8); ATT_KTILE(4); ATT_ISSUE(6);
    float mx = -1e30f;
    const bool edge = (l0 - 64 < 0) || (l0 + 96 > L);
    const LAS float* bt = btab + G * 256 + 32 + 4 * hi - r32;
#pragma unroll
    for (int j = 0; j < 5; ++j) {
        const int jr = ATT_JR(j); const LAS float* btj = bt + 32 * jr;
#pragma unroll
        for (int r = 0; r < 16; ++r) {
            const int kc = 32 * jr + (r & 3) + 8 * (r >> 2);
            float v = p[j][r] + btj[(r & 3) + 8 * (r >> 2)];
            if (edge) { const int lk = l0 - 64 + kc + 4 * hi; v = (lk >= 0 && lk < L) ? v : -1e30f; }
            p[j][r] = v; mx = fmaxf(mx, v);
        }
        asm volatile("" ::: "memory");
    }
    mx = fmaxf(mx, __shfl_xor(mx, 32));
    float ls = 0.f;
    bf16x8 pb[5][2];
#pragma unroll
    for (int j = 0; j < 5; ++j) {
        float e[16];
#pragma unroll
        for (int r = 0; r < 16; ++r) { e[r] = __builtin_amdgcn_exp2f(p[j][r] - mx); ls += e[r]; }
#pragma unroll
        for (int s = 0; s < 2; ++s) { v4u w; w.x = cvt_pk_bf16(e[8 * s + 0], e[8 * s + 1]); w.y = cvt_pk_bf16(e[8 * s + 2], e[8 * s + 3]);
            w.z = cvt_pk_bf16(e[8 * s + 4], e[8 * s + 5]); w.w = cvt_pk_bf16(e[8 * s + 6], e[8 * s + 7]); pb[j][s] = __builtin_bit_cast(bf16x8, w); }
    }
    ls += __shfl_xor(ls, 32);
    asm volatile("" ::: "memory");
    f32x16 o[4] = {};
    const int i16 = lane & 15, g16 = lane >> 4;
    const unsigned vbase = (unsigned)(uintptr_t)wl + (unsigned)((i16 >> 2) * 1088 + hi * 256 + (16 * (g16 & 1) + 4 * (i16 & 3)) * 2);
#define ATT_VTILE(n) do { const unsigned va_ = vbase + ((n) & 1) * ATT_SLOT; \
        _Pragma("unroll") for (int dt = 0; dt < 4; ++dt) { s16x4 lo0, hi0, lo1, hi1; \
            asm volatile("ds_read_b64_tr_b16 %0, %4 offset:%5\n\tds_read_b64_tr_b16 %1, %4 offset:%6\n\tds_read_b64_tr_b16 %2, %4 offset:%7\n\tds_read_b64_tr_b16 %3, %4 offset:%8\n\ts_waitcnt lgkmcnt(0)" \
                         : "=&v"(lo0), "=&v"(hi0), "=&v"(lo1), "=&v"(hi1) : "v"(va_), "i"(dt * 64), "i"(512 + dt * 64), "i"(4 * 1088 + dt * 64), "i"(4 * 1088 + 512 + dt * 64) : "memory"); \
            const bf16x8 af0 = (bf16x8){lo0[0], lo0[1], lo0[2], lo0[3], hi0[0], hi0[1], hi0[2], hi0[3]}; \
            const bf16x8 af1 = (bf16x8){lo1[0], lo1[1], lo1[2], lo1[3], hi1[0], hi1[1], hi1[2], hi1[3]}; \
            o[dt] = __builtin_amdgcn_mfma_f32_32x32x16_bf16(af0, pb[(n) - 5][0], o[dt], 0, 0, 0); \
            o[dt] = __builtin_amdgcn_mfma_f32_32x32x16_bf16(af1, pb[(n) - 5][1], o[dt], 0, 0, 0); } } while (0)
    ATT_WAITV(8); ATT_VTILE(5); ATT_ISSUE(7);
    ATT_WAITV(8); ATT_VTILE(6); ATT_ISSUE(8);
    ATT_WAITV(8); ATT_VTILE(7); ATT_ISSUE(9);
    ATT_WAITV(8); ATT_VTILE(8);
    ATT_WAITV(0); ATT_VTILE(9);
#undef ATT_WAITV
#undef ATT_ISSUE
#undef ATT_KTILE
#undef ATT_VTILE
#undef ATT_JR
    const float inv = 1.0f / ls;
    const float lse2 = mx + __builtin_amdgcn_logf(ls);
    const size_t orow = qrow;
    LAS unsigned char* T0 = wl;
    LAS unsigned char* T1 = T0 + ATT_SLOT;
    int ln_ = lane; asm volatile("" : "+v"(ln_));
    const int erow = ln_ >> 4, echk = ln_ & 15;
    const unsigned pofs = (unsigned)(r32 * 272 + 8 * hi);
    if (G < 2) {
#pragma unroll
        for (int dt = 0; dt < 4; ++dt)
#pragma unroll
            for (int rg = 0; rg < 4; ++rg) { v2u w; w.x = cvt_pk_bf16(o[dt][4 * rg] * inv, o[dt][4 * rg + 1] * inv); w.y = cvt_pk_bf16(o[dt][4 * rg + 2] * inv, o[dt][4 * rg + 3] * inv);
                *(LAS v2u*)(T0 + pofs + 64 * dt + 16 * rg) = w; }
        LDS_WAIT();
        bf16* ob = (G == 0 ? O0 : O1) + ((size_t)h * M + rowbase) * HD + echk * 8;
#pragma unroll
        for (int i = 0; i < 8; ++i) { const int qi = erow + 4 * i; const v4u w = *(const LAS v4u*)(T0 + qi * 272 + echk * 16);
            *(v4u*)(ob + (((size_t)(l0 + qi) << SH) + res) * HD) = w; }
        if (hi == 0) (G == 0 ? LSE0 : LSE1)[orow * NH + h] = lse2;
    } else {
        const float l0v = LSE0[orow * NH + h], l1v = LSE1[orow * NH + h];
        const bf16* ib0 = O0 + ((size_t)h * M + rowbase) * HD + echk * 8; const bf16* ib1 = O1 + ((size_t)h * M + rowbase) * HD + echk * 8;
#pragma unroll
        for (int hh = 0; hh < 2; ++hh) {
            v4u t0[4], t1[4];
#pragma unroll
            for (int i = 0; i < 4; ++i) { const size_t ro = (((size_t)(l0 + erow + 4 * (4 * hh + i)) << SH) + res) * HD; t0[i] = *(const v4u*)(ib0 + ro); t1[i] = *(const v4u*)(ib1 + ro); }
#pragma unroll
            for (int i = 0; i < 4; ++i) { const int qi = erow + 4 * (4 * hh + i); *(LAS v4u*)(T0 + qi * 272 + echk * 16) = t0[i]; *(LAS v4u*)(T1 + qi * 272 + echk * 16) = t1[i]; }
            asm volatile("" ::: "memory");
        }
        const float mm = fmaxf(fmaxf(l0v, l1v), lse2);
        const float w0 = __builtin_amdgcn_exp2f(l0v - mm), w1 = __builtin_amdgcn_exp2f(l1v - mm), w2 = __builtin_amdgcn_exp2f(lse2 - mm);
        const float wi = 1.0f / (w0 + w1 + w2);
        const float c0 = w0 * wi, c1 = w1 * wi, c2 = w2 * wi * inv;
        LDS_WAIT();
        unsigned y8[16];
#pragma unroll
        for (int dt = 0; dt < 4; ++dt)
#pragma unroll
            for (int rg = 0; rg < 4; ++rg) { const v2u a = *(const LAS v2u*)(T0 + pofs + 64 * dt + 16 * rg), c = *(const LAS v2u*)(T1 + pofs + 64 * dt + 16 * rg);
                const float y0 = c0 * bf_lo(a.x) + c1 * bf_lo(c.x) + c2 * o[dt][4 * rg], y1 = c0 * bf_hi(a.x) + c1 * bf_hi(c.x) + c2 * o[dt][4 * rg + 1];
                const float y2 = c0 * bf_lo(a.y) + c1 * bf_lo(c.y) + c2 * o[dt][4 * rg + 2], y3 = c0 * bf_hi(a.y) + c1 * bf_hi(c.y) + c2 * o[dt][4 * rg + 3];
                y8[4 * dt + rg] = q8x4c((f32x4){y0, y1, y2, y3}, A8SCALE); }
        LDS_WAIT();
#pragma unroll
        for (int dt = 0; dt < 4; ++dt)
#pragma unroll
            for (int rg = 0; rg < 4; ++rg) *(LAS unsigned*)(T0 + r32 * 144 + 4 * hi + 32 * dt + 8 * rg) = y8[4 * dt + rg];
        LDS_WAIT();
        unsigned char* ob = MIX8 + rowbase * DM + h * HD + (ln_ & 7) * 16;
#pragma unroll
        for (int i = 0; i < 4; ++i) { const int qi = (ln_ >> 3) + 8 * i; const v4u w = *(const LAS v4u*)(T0 + qi * 144 + (ln_ & 7) * 16);
            *(v4u*)(ob + (((size_t)(l0 + qi) << SH) + res) * DM) = w; }
    }
    LDS_WAIT();
}

constexpr int PER_PHASE = 9;
struct Args { const float* in[16]; float* out; unsigned char* ws; unsigned mask; unsigned pad; };

__constant__ unsigned char CAND_I[64] = {0,0,0,0,0,0,0,0,0,0,0,0,0,0,0,0, 1,1,1,1,1,1,1,1, 2,2,2,2,2, 3,3,3,3, 4,4,4, 5,5, 6,6, 7,7, 8,9,10,11,12,13,14,15, 0,0,0,0,0,0,0,0,0,0,0,0,0,0};
__constant__ unsigned char CAND_J[64] = {0,1,2,3,4,5,6,7,8,9,10,11,12,13,14,15, 0,1,2,3,4,5,6,7, 0,1,2,3,4, 0,1,2,3, 0,1,2, 0,1, 0,1, 0,1, 0,0,0,0,0,0,0,0, 0,0,0,0,0,0,0,0,0,0,0,0,0,0};

__global__ void __launch_bounds__(NWAVES * 64, 2) fwd_kernel(Args args) {
    extern __shared__ __attribute__((aligned(16))) unsigned char lds_raw[];
    LAS unsigned char* lds = (LAS unsigned char*)lds_raw;
    volatile LAS unsigned* MISC = (volatile LAS unsigned*)(lds + MISC_OFF);
    const int tid0 = threadIdx.x, lane0 = tid0 & 63, wave = __builtin_amdgcn_readfirstlane(tid0 >> 6);
#define PHASE_LANES() int tid = tid0; asm volatile("" : "+v"(tid)); const int lane = tid & 63
    const int G = gridDim.x; const int bx = blockIdx.x;
    const int vcu = (G % 8 == 0) ? (bx % 8) * (G / 8) + bx / 8 : bx;
    const int gw = vcu * NWAVES + wave, NGW = G * NWAVES;
    unsigned char* ws = args.ws;
    unsigned* ctl = (unsigned*)(ws + WS_CTL);
    const float* x = args.in[0]; const float* cvec = args.in[1]; const float* w_ada = args.in[2]; const float* b_ada = args.in[3]; const float* g_mix = args.in[4];
    const float* w_in = args.in[5]; const float* rel_bias = args.in[6]; const float* pool_w = args.in[7]; const float* pool_scale = args.in[8]; const float* w_out = args.in[9];
    const float* g_ffn = args.in[10]; const float* peer_wq = args.in[11]; const float* peer_sk = args.in[12]; const float* peer_u = args.in[13]; const float* peer_v = args.in[14];
    const float* g_final = args.in[15];
    float* out = args.out;
    float* MODV = (float*)(ws + WS_MODV); float* MODP = (float*)(ws + WS_MODP);
    bf16* SKT = (bf16*)(ws + WS_SKT); bf16* PWS = (bf16*)(ws + WS_PWS); bf16* WQSTB = (bf16*)(ws + WS_WQST);     unsigned char* WQST8 = ws + 104 * MiB;     unsigned char* WOUT8 = ws + WS_WOUT2;     unsigned char* WIN8 = ws + WS_WIN8; unsigned char* H8 = ws + WS_H8;
    bf16* WOPT = (bf16*)(ws + WS_WOPT); bf16* WQB = (bf16*)(ws + WS_WQB);
    unsigned char* UB = ws + WS_UB; unsigned char* VB = ws + WS_VB; float* SCL = (float*)(ws + WS_SCL); float* TSC = SCL + 2 * NEXP; float* WQS = TSC + M;         bf16* H = (bf16*)(ws + WS_H); bf16* PIN = (bf16*)(ws + WS_PROJ); bf16* QKVH = (bf16*)(ws + WS_QKVH); unsigned char* MIX8 = ws + WS_MIXIN;
    bf16* O0 = (bf16*)(ws + WS_O0); bf16* O1 = (bf16*)(ws + WS_O1); float* LSE = (float*)(ws + WS_LSE);
    float* SC = (float*)(ws + WS_SC);
    bf16* X1B = (bf16*)(ws + WS_O0);
    bf16* YB = (bf16*)(ws + WS_PROJ + 64 * MiB);

    for (int u = tid0; u < (LDS_BYTES - LDSCTL_OFF) / 4; u += NWAVES * 64) ((LAS unsigned*)(lds + LDSCTL_OFF))[u] = 0u;
    __syncthreads();
    XcdBarrier bar; bar.bar = ctl + CW_BAR; bar.x = 0; bar.st = nullptr;
    if (MK_N_LAUNCHES != PER_PHASE) bar = xcd_barrier_post(ctl + CW_BAR, MISC + 8);
#define GRID_BAR() do { if (MK_N_LAUNCHES != PER_PHASE) xcd_barrier(bar); } while (0)
    const unsigned phmask = args.mask;
#ifndef PH_MASK
#define PH_MASK 0x1ff
#endif
#define IN(k) ((((PH_MASK) >> (k)) & 1) && ((phmask >> (k)) & 1u))
#define BOTH(k) (IN(k) && IN((k) + 1))

    if (IN(0)) {
        PHASE_LANES();
        LAS float* silu = (LAS float*)(lds + RING_OFF);
        for (int i = tid; i < BATCH * DM; i += NWAVES * 64) { const float v = cvec[i]; silu[i] = v / (1.0f + __expf(-v)); }
        __syncthreads();
        for (int task = gw; task < (NMOD / 256) * KS_ADA; task += NGW) {
            const int cg = task % (NMOD / 256), ks = task / (NMOD / 256); const int k0 = ks * (DM / KS_ADA), n0 = cg * 256 + 4 * lane;
            f32x4 a0 = {0.f, 0.f, 0.f, 0.f}, a1 = {0.f, 0.f, 0.f, 0.f};
            const float* wp = w_ada + (size_t)k0 * NMOD + n0;
            static_assert(DM / KS_ADA == 64, "four 16-row batches");
            f32x4 wA[16], wB[16];
#define ADA_LD(W_, b_) _Pragma("unroll") for (int q_ = 0; q_ < 16; ++q_) W_[q_] = *(const f32x4*)(wp + (size_t)(16 * (b_) + q_) * NMOD)
#define ADA_FMA(W_, b_) _Pragma("unroll") for (int q_ = 0; q_ < 16; ++q_) { const float s0 = silu[k0 + 16 * (b_) + q_], s1 = silu[DM + k0 + 16 * (b_) + q_]; a0 += W_[q_] * s0; a1 += W_[q_] * s1; }
            ADA_LD(wA, 0); ADA_LD(wB, 1); ADA_FMA(wA, 0); ADA_LD(wA, 2); ADA_FMA(wB, 1); ADA_LD(wB, 3); ADA_FMA(wA, 2); ADA_FMA(wB, 3);
#undef ADA_LD
#undef ADA_FMA
            *(f32x4*)(MODP + ((size_t)(ks * 2 + 0)) * NMOD + n0) = a0; *(f32x4*)(MODP + ((size_t)(ks * 2 + 1)) * NMOD + n0) = a1;
        }
        __syncthreads();
        {
            LAS float* scr = (LAS float*)(lds + RING_OFF + wave * 16384);
            constexpr int I_QKV = (DM / 64) * (3 * ATTW / 32), I_PIN = (DM / 64) * (POOLW / 32), I_OUTH = (ATTW / 64) * (DM / 32);
            constexpr int NITEMS = I_QKV + I_PIN + 2 * I_OUTH;
            for (int it = gw; it < NITEMS; it += NGW) {
                int r = it;
                if (r < I_QKV + I_PIN) { p0_transpose_item<true>(w_in, INW, INW, WIN8, DM, W8SCALE, scr, r, lane); continue; } r -= I_QKV + I_PIN;
                if (r < I_OUTH) { p0_transpose_item<true>(w_out, DM, DM, WOUT8, DM, WOA8SCALE, scr, r, lane); continue; } r -= I_OUTH;
                p0_transpose_item<false>(w_out + (size_t)ATTW * DM, DM, DM, WOPT, POOLW, 1.f, scr, r, lane);
            }
        }
        for (int i = gw * 64 + lane; i < (DM * PQ + 4 * 512 * 512) / 8; i += NGW * 64) {
            const bool isQ = i < DM * PQ / 8; const int j = isQ ? i : i - DM * PQ / 8;
            const float* src = (isQ ? peer_wq : pool_w) + (size_t)j * 8;
            f32x4 a = *(const f32x4*)src, c = *(const f32x4*)(src + 4);
            if (!isQ) { const int e0 = j * 8; const int gi = e0 >> 18, d0 = e0 & 511; const float* ps = pool_scale + gi * 512 + d0; a = a * *(const f32x4*)ps; c = c * *(const f32x4*)(ps + 4); }
            v4u w; w.x = cvt_pk_bf16(a[0], a[1]); w.y = cvt_pk_bf16(a[2], a[3]); w.z = cvt_pk_bf16(c[0], c[1]); w.w = cvt_pk_bf16(c[2], c[3]);
            *(v4u*)((isQ ? WQB : PWS) + (size_t)j * 8) = w;
        }
        f32x4 vnx[4][4];
#define PEER_LD(r_) do { const float* s_ = ((r_) < NEXP ? peer_u + (size_t)(r_) * DM : peer_v + (size_t)((r_) - NEXP) * DM) + 16 * lane; \
            _Pragma("unroll") for (int i = 0; i < 4; ++i) _Pragma("unroll") for (int q = 0; q < 4; ++q) vnx[i][q] = *(const f32x4*)(s_ + 1024 * i + 4 * q); } while (0)
        if (gw < 2 * NEXP) PEER_LD(gw);
        for (int r = gw; r < 2 * NEXP; r += NGW) {
            const bool isU = r < NEXP; const int e = isU ? r : r - NEXP;
            f32x4 v[4][4]; float mx = 0.f;
#pragma unroll
            for (int i = 0; i < 4; ++i)
#pragma unroll
                for (int q = 0; q < 4; ++q) { v[i][q] = vnx[i][q];
                    mx = fmaxf(mx, fmaxf(fmaxf(fabsf(v[i][q][0]), fabsf(v[i][q][1])), fmaxf(fabsf(v[i][q][2]), fabsf(v[i][q][3])))); }
            if (r + NGW < 2 * NEXP) PEER_LD(r + NGW);
#pragma unroll
            for (int o = 1; o < 64; o <<= 1) mx = fmaxf(mx, __shfl_xor(mx, o));
            const int ex = (int)((__float_as_uint(mx) >> 23) & 0xffu);
            float scale = 1.0f, inv = 1.0f;
            if (ex >= 32 && ex <= 230) { if (isU) { scale = 127.0f / mx; inv = mx * (1.0f / 127.0f); }
                else { scale = __uint_as_float((unsigned)(261 - ex) << 23); inv = __uint_as_float((unsigned)(ex - 7) << 23); } }
            unsigned char* dst = (isU ? UB : VB) + ((size_t)(lane >> 3) * NEXP + e) * 128 + 16 * (lane & 7);
#pragma unroll
            for (int i = 0; i < 4; ++i) { v4u w;
#pragma unroll
                for (int q = 0; q < 4; ++q) { if (isU) { w[q] = q8x4(v[i][q], scale); } else { int pk = 0; pk = __builtin_amdgcn_cvt_pk_fp8_f32(v[i][q][0] * scale, v[i][q][1] * scale, pk, false);
                    pk = __builtin_amdgcn_cvt_pk_fp8_f32(v[i][q][2] * scale, v[i][q][3] * scale, pk, true); w[q] = (unsigned)pk; } }
                *(v4u*)(dst + (size_t)(8 * i) * NEXP * 128) = w; }
            if (lane == 0) SCL[r] = inv;
        }
#undef PEER_LD
        for (int i = gw * 64 + lane; i < 2048 * 32; i += NGW * 64) {
            const int n = i >> 5, kc = (i & 31) * 8; const int p = (n >> 7) & 1, pp = kc >> 7;
            v4u w = {0u, 0u, 0u, 0u};
            if (p == pp) { const float* src = peer_sk + (size_t)n * 128 + (kc & 127); const f32x4 a = *(const f32x4*)src, c = *(const f32x4*)(src + 4);
                w.x = cvt_pk_bf16(a[0], a[1]); w.y = cvt_pk_bf16(a[2], a[3]); w.z = cvt_pk_bf16(c[0], c[1]); w.w = cvt_pk_bf16(c[2], c[3]); }
            *(v4u*)(SKT + (size_t)n * 256 + kc) = w;
        }
        if (BOTH(0)) GRID_BAR();
    }

    if (IN(1)) {
        PHASE_LANES();
        for (int i = bx * (NWAVES * 64) + tid; i < BATCH * NMOD; i += G * NWAVES * 64) {
            const int b = i / NMOD, n = i % NMOD; float s = b_ada[n];
#pragma unroll 8
            for (int ks = 0; ks < KS_ADA; ++ks) s += MODP[(size_t)(ks * 2 + b) * NMOD + n];
            const int j = n / DM, c = n % DM;
            MODV[(size_t)(j * 2 + b) * DM + c] = s;
        }
        if (bx < G / 2) {
            pg8::Gemm g{WOPT, PWS, DM, POOLW, 512, POOLW, 512, 2, 512, 1 << 30, 0}; pg8::StaticOrder S; S.init(DM, POOLW, G / 2, bx);
            pg8::EpiI8 E{WOUT8, DM, ATTW, WOP8SCALE};
            pg8::gemm_phase<pg8::EpiI8, pg8::StaticOrder, true>(lds + RING_OFF, g, S, E);
        }
        else {
            pg8::Gemm g{SKT, WQB, PQ, DM, 256, 256, PQ, 1 << 30, 0, 1, 256}; pg8::StaticOrder S; S.init(PQ, DM, G - G / 2, bx - G / 2);
            pg8::EpiBf16 E{WQSTB, DM, 0, 1.0f, nullptr, 0, 0};
            pg8::gemm_phase<pg8::EpiBf16, pg8::StaticOrder, true>(lds + RING_OFF, g, S, E);
        }
        if (BOTH(1)) GRID_BAR();
    }

    if (IN(2)) {
        PHASE_LANES();
        for (int row = gw; row < M; row += NGW) {
            const int b = row / SEQ;
            const f32x4* xr = (const f32x4*)(x + (size_t)row * DM) + lane;
            f32x4 v[16]; float ss = 0.f;
#pragma unroll
            for (int j = 0; j < 16; ++j) { v[j] = xr[64 * j]; ss += (v[j][0] * v[j][0] + v[j][1] * v[j][1]) + (v[j][2] * v[j][2] + v[j][3] * v[j][3]); }
            const float rstd = 1.0f / sqrtf(wave_sum(ss) * (1.0f / DM) + RMS_EPS);
            const f32x4* gp = (const f32x4*)g_mix + lane; const f32x4* shp = (const f32x4*)(MODV + (size_t)(0 * 2 + b) * DM) + lane; const f32x4* scp = (const f32x4*)(MODV + (size_t)(1 * 2 + b) * DM) + lane;
            unsigned* op8 = (unsigned*)(H8 + (size_t)row * DM) + lane;
#pragma unroll
            for (int j = 0; j < 16; ++j) { const f32x4 g4 = gp[64 * j], sh = shp[64 * j], sc = scp[64 * j];
                const f32x4 y = (v[j] * rstd) * g4 * (sc + 1.0f) + sh;
                op8[64 * j] = q8x4c(y, H8SCALE); }
        }
        for (int n = gw; n < PQ; n += NGW) {
            const v2u* wr_ = (const v2u*)(WQSTB + (size_t)n * DM) + lane;
            f32x4 v[16]; float mx = 0.f;
#pragma unroll
            for (int j = 0; j < 16; ++j) { const v2u xw = wr_[64 * j]; v[j] = (f32x4){bf_lo(xw.x), bf_hi(xw.x), bf_lo(xw.y), bf_hi(xw.y)};
                mx = fmaxf(mx, fmaxf(fmaxf(fabsf(v[j][0]), fabsf(v[j][1])), fmaxf(fabsf(v[j][2]), fabsf(v[j][3])))); }
#pragma unroll
            for (int o = 1; o < 64; o <<= 1) mx = fmaxf(mx, __shfl_xor(mx, o));
            mx = fmaxf(mx, 1e-20f);
            const float qs = 127.0f / mx; unsigned* op8 = (unsigned*)(WQST8 + (size_t)n * DM) + lane;
#pragma unroll
            for (int j = 0; j < 16; ++j) op8[64 * j] = q8x4(v[j], qs);
            if (lane == 0) WQS[n] = mx * (1.0f / 127.0f);
        }
        if (BOTH(2)) GRID_BAR();
    }

    if (IN(3)) {
        PHASE_LANES();
        {
            pg8::Gemm g{(const bf16*)H8, (const bf16*)WIN8, M, INW, DM / 2, DM / 2, DM / 2, 1 << 30, 0, 1 << 30, 0}; pg8::StaticOrder S; S.init(M, INW, G, bx);
            pg8::EpiBf16 E{PIN, POOLW, ATTW, QSCALE / (H8SCALE * W8SCALE), QKVH, 3 * ATTW, M, 1.0f / (H8SCALE * W8SCALE)};
            pg8::gemm_phase<pg8::EpiBf16, pg8::StaticOrder, true, true>(lds + RING_OFF, g, S, E);
        }
        if (BOTH(3)) GRID_BAR();
    }

    if (IN(4)) {
        PHASE_LANES();
        LAS float* btab = (LAS float*)(lds + SHARED_OFF);
        LAS unsigned char* vt = lds + RING_OFF + wave * ATT_WAVE_BYTES;
        if (!(args.pad & 1u))
        for (int unit = bx; unit < BATCH * NH * (SEQ / 1024); unit += G) {
            const int b = unit >> 7, h = (unit >> 3) & 15, mt = unit & 7;
            __syncthreads();
            for (int i = tid; i < 3 * 256; i += NWAVES * 64) { const int gi = i >> 8, ri = (i & 255) - 32; const int dil = gi == 0 ? 1 : (gi == 1 ? 4 : 16);
                btab[i] = (ri >= 0 && ri <= 128) ? rel_bias[t5_bucket((ri - 64) * dil) * NH + h] * LOG2E : -1e30f; }
            __syncthreads();
            for (int g = 0; g < 3; ++g) {
                if (g == 2) { VM_WAIT(); __syncthreads(); }
                for (int tk = wave; tk < 32; tk += NWAVES) attn_task(g, QKVH, O0, O1, LSE, LSE + (size_t)M * NH, MIX8, btab, vt, b, h, mt, tk, lane);
            }
        }
        if (!(args.pad & 2u))
        for (int i = bx * (NWAVES * 64) + tid; i < BATCH * (SEQ / 8) * (POOLW / 8); i += G * NWAVES * 64) {
            const int cc = i & 255, run = (i >> 8) & (SEQ / 8 - 1), b = i >> 18; const int gi = __builtin_amdgcn_readfirstlane(cc >> 6);
            const int pos0 = run * 8;
            const bf16* base = PIN + (size_t)b * SEQ * POOLW + cc * 8;
            unsigned char* obase = MIX8 + ((size_t)b * SEQ + pos0) * DM + ATTW + cc * 8;
#define POOL_RUN(HW) do { constexpr int NR = 8 + 2 * (HW) - 1; v4u w_[NR]; \
                _Pragma("unroll") for (int q = 0; q < NR; ++q) { const int pp = pos0 - (HW) + q; const int pc = pp < 0 ? 0 : (pp > SEQ - 1 ? SEQ - 1 : pp); w_[q] = *(const v4u*)(base + (size_t)pc * POOLW); } \
                _Pragma("unroll") for (int q = 0; q < NR; ++q) { const int pp = pos0 - (HW) + q; if (pp < 0 || pp >= SEQ) w_[q] = (v4u){0u, 0u, 0u, 0u}; } \
                float s_[8] = {0.f, 0.f, 0.f, 0.f, 0.f, 0.f, 0.f, 0.f}; \
                _Pragma("unroll") for (int q = 0; q < 2 * (HW) - 1; ++q) { s_[0] += bf_lo(w_[q].x); s_[1] += bf_hi(w_[q].x); s_[2] += bf_lo(w_[q].y); s_[3] += bf_hi(w_[q].y); s_[4] += bf_lo(w_[q].z); s_[5] += bf_hi(w_[q].z); s_[6] += bf_lo(w_[q].w); s_[7] += bf_hi(w_[q].w); } \
                _Pragma("unroll") for (int k = 0; k < 8; ++k) { const v4u in_ = w_[k + 2 * (HW) - 1]; \
                    s_[0] += bf_lo(in_.x); s_[1] += bf_hi(in_.x); s_[2] += bf_lo(in_.y); s_[3] += bf_hi(in_.y); s_[4] += bf_lo(in_.z); s_[5] += bf_hi(in_.z); s_[6] += bf_lo(in_.w); s_[7] += bf_hi(in_.w); \
                    const int pos = pos0 + k; const int lo_ = pos - (HW) < 0 ? 0 : pos - (HW), hi_ = pos + (HW) > SEQ ? SEQ : pos + (HW); const float inv = 1.0f / (float)(hi_ - lo_); \
                    const v4u me = w_[k + (HW)]; \
                    const f32x4 lo4_ = {s_[0] * inv - bf_lo(me.x), s_[1] * inv - bf_hi(me.x), s_[2] * inv - bf_lo(me.y), s_[3] * inv - bf_hi(me.y)}, hi4_ = {s_[4] * inv - bf_lo(me.z), s_[5] * inv - bf_hi(me.z), s_[6] * inv - bf_lo(me.w), s_[7] * inv - bf_hi(me.w)}; \
                    const unsigned lo8_ = q8x4c(lo4_, P8SCALE), hi8_ = q8x4c(hi4_, P8SCALE); \
                    *(v2u*)(obase + (size_t)k * DM) = (v2u){lo8_, hi8_}; \
                    const v4u out_ = w_[k]; \
                    s_[0] -= bf_lo(out_.x); s_[1] -= bf_hi(out_.x); s_[2] -= bf_lo(out_.y); s_[3] -= bf_hi(out_.y); s_[4] -= bf_lo(out_.z); s_[5] -= bf_hi(out_.z); s_[6] -= bf_lo(out_.w); s_[7] -= bf_hi(out_.w); } } while (0)
            if (gi == 0) POOL_RUN(1); else if (gi == 1) POOL_RUN(2); else if (gi == 2) POOL_RUN(4); else POOL_RUN(8);
#undef POOL_RUN
        }
        if (BOTH(4)) GRID_BAR();
    }

    if (IN(5)) {
        PHASE_LANES();
        pg8::Gemm g{(const bf16*)MIX8, (const bf16*)WOUT8, M, DM, DM / 2, DM / 2, DM / 2, 1 << 30, 0, 1 << 30, 0}; pg8::StaticOrder S; S.init(M, DM, G, bx);
        pg8::EpiResBf16 E{x, MODV + (size_t)(2 * 2) * DM, X1B, DM, 1.0f / (A8SCALE * WOA8SCALE)};
        pg8::gemm_phase<pg8::EpiResBf16, pg8::StaticOrder, true, true>(lds + RING_OFF, g, S, E);
        if (BOTH(5)) GRID_BAR();
    }

    if (IN(6)) {
        PHASE_LANES();
        for (int row = gw; row < M; row += NGW) {
            const int b = row / SEQ;
            const v2u* xr = (const v2u*)(X1B + (size_t)row * DM) + lane;
            f32x4 v[16]; float ss = 0.f;
#pragma unroll
            for (int j = 0; j < 16; ++j) { const v2u xw = xr[64 * j]; v[j] = (f32x4){bf_lo(xw.x), bf_hi(xw.x), bf_lo(xw.y), bf_hi(xw.y)}; ss += (v[j][0] * v[j][0] + v[j][1] * v[j][1]) + (v[j][2] * v[j][2] + v[j][3] * v[j][3]); }
            const float rstd = 1.0f / sqrtf(wave_sum(ss) * (1.0f / DM) + RMS_EPS);
            const f32x4* gp = (const f32x4*)g_ffn + lane; const f32x4* shp = (const f32x4*)(MODV + (size_t)(3 * 2 + b) * DM) + lane; const f32x4* scp = (const f32x4*)(MODV + (size_t)(4 * 2 + b) * DM) + lane;
            unsigned* op8 = (unsigned*)(H8 + (size_t)row * DM) + lane;
            float ymx = 0.f;
#pragma unroll
            for (int j = 0; j < 16; ++j) { const f32x4 g4 = gp[64 * j], sh = shp[64 * j], sc = scp[64 * j];
                const f32x4 y = (v[j] * rstd) * g4 * (sc + 1.0f) + sh; v[j] = y;
                ymx = fmaxf(ymx, fmaxf(fmaxf(fabsf(y[0]), fabsf(y[1])), fmaxf(fabsf(y[2]), fabsf(y[3])))); }
#pragma unroll
            for (int o = 1; o < 64; o <<= 1) ymx = fmaxf(ymx, __shfl_xor(ymx, o));
            ymx = fmaxf(ymx, 1e-20f);
            const float qs = 127.0f / ymx;
#pragma unroll
            for (int j = 0; j < 16; ++j) op8[64 * j] = q8x4(v[j], qs);
            if (lane == 0) TSC[row] = ymx * (1.0f / 127.0f);
        }
        if (BOTH(6)) GRID_BAR();
    }

    if (IN(7)) {
        PHASE_LANES();
        pg8::Gemm g{(const bf16*)H8, (const bf16*)WQST8, M, PQ, DM / 2, DM / 2, DM / 2, 1 << 30, 0, 1 << 30, 0}; pg8::StaticOrder S; S.init(M, PQ, G, bx);
        pg8::EpiF32RowScale E{SC, PQ, TSC, WQS};
        pg8::gemm_phase<pg8::EpiF32RowScale, pg8::StaticOrder, true, true>(lds + RING_OFF, g, S, E);
        if (BOTH(7)) GRID_BAR();
    }

    if (IN(8)) {
        PHASE_LANES();
        LAS unsigned short* EXPW = (LAS unsigned short*)(lds + RING_OFF);
        LAS float* GACT = (LAS float*)(lds + RING_OFF + 16384);
        LAS unsigned* W = (LAS unsigned*)(lds + RING_OFF + 49152 + wave * 4096);
        LAS unsigned* K1 = W; LAS unsigned* K2 = W + 128;
        LAS float* TV1 = (LAS float*)(W + 256); LAS int* TI1 = (LAS int*)(W + 272); LAS float* TV2 = (LAS float*)(W + 288); LAS int* TI2 = (LAS int*)(W + 304);
        LAS unsigned* CK = W + 320; LAS float* SV = (LAS float*)(W + 384); LAS int* SE = (LAS int*)(W + 400);
        const int c8 = lane & 7, r8 = lane >> 3;
        for (int blk = vcu; blk < M / 64; blk += G) {
            const int tok0 = blk * 64; const int b = tok0 / SEQ;
            const float* sp0 = SC + (size_t)(tok0 + wave * 8) * PQ + lane;
            float na0 = sp0[0], na1 = sp0[64], nb0 = sp0[128], nb1 = sp0[192];
            for (int j = 0; j < 8; ++j) {
                const int tl = wave * 8 + j;
                for (int h = 0; h < 8; ++h) {
                    const float a0 = na0, a1 = na1, b0 = nb0, b1 = nb1;
                    { const int nx = (j * 8 + h + 1) & 63; const float* sp = sp0 + (size_t)nx * 256; na0 = sp[0]; na1 = sp[64]; nb0 = sp[128]; nb1 = sp[192]; }
                    unsigned ka0 = (fkey(a0) & ~127u) | (unsigned)(127 - lane), ka1 = (fkey(a1) & ~127u) | (unsigned)(63 - lane);
                    unsigned kb0 = (fkey(b0) & ~127u) | (unsigned)(127 - lane), kb1 = (fkey(b1) & ~127u) | (unsigned)(63 - lane);
                    bitonic128x2(ka0, ka1, kb0, kb1, lane);
                    if (lane >= 56) { K1[127 - 2 * lane] = ka0; K1[126 - 2 * lane] = ka1; K2[127 - 2 * lane] = kb0; K2[126 - 2 * lane] = kb1; }
                    LDS_WAIT();
                    const int ci_i = CAND_I[lane], ci_j = CAND_J[lane];
                    const unsigned kA = K1[ci_i], kB = K2[ci_j];
                    const float cv = fdec(kA) + fdec(kB);
                    const unsigned ck = lane < 50 ? ((fkey(cv) & ~255u) | (unsigned)(255 - (ci_i * 16 + ci_j))) : 0u;
                    CK[lane] = ck;
                    LDS_WAIT();
                    int rc = 0;
#pragma unroll 8
                    for (int kk = 0; kk < 16; ++kk) { const v4u q = ((const LAS v4u*)CK)[kk]; rc += (q.x > ck) + (q.y > ck) + (q.z > ck) + (q.w > ck); }
                    if (lane < 50 && rc < 16) { SV[rc] = cv; SE[rc] = (int)((127u - (kA & 127u)) * 128u + (127u - (kB & 127u))); }
                    LDS_WAIT();
                    const float top0 = SV[0], myv = SV[lane & 15]; const int mye = SE[lane & 15];
                    const float e = __expf(myv - top0);
                    float ssum = e; ssum += __shfl_xor(ssum, 1); ssum += __shfl_xor(ssum, 2); ssum += __shfl_xor(ssum, 4); ssum += __shfl_xor(ssum, 8);
                    if (lane < 16) { EXPW[tl * 128 + h * 16 + lane] = (unsigned short)mye; GACT[tl * 128 + h * 16 + lane] = e / ssum; }
                    LDS_WAIT();
                }
            }
            LAS float* ACC = (LAS float*)(lds + RING_OFF + 81920);
            for (int i = lane; i < 8 * 128; i += 64) ACC[wave * 1024 + i] = 0.f;
            LDS_WAIT();
            {
                v4u gA[16], gB[16]; v4u hA, hB;
#define P10_LOADU(idx, G_, H_) do { const int s_ = (idx) >> 3, j_ = (idx) & 7; const int tl_ = wave * 8 + j_; \
                    const unsigned char* tb_ = UB + (size_t)s_ * NEXP * 128 + 16 * c8; \
                    H_ = *(const v4u*)(H8 + (size_t)(tok0 + tl_) * DM + 128 * s_ + 16 * c8); \
                    _Pragma("unroll") for (int i = 0; i < 16; ++i) { const unsigned e_ = EXPW[tl_ * 128 + r8 + 8 * i]; G_[i] = *(const v4u*)(tb_ + (size_t)e_ * 128); } } while (0)
#define P10_COMPU(idx, G_, H_) do { const int tl = wave * 8 + ((idx) & 7); int p[16]; \
                    _Pragma("unroll") for (int i = 0; i < 16; ++i) { int a_ = 0; \
                        a_ = __builtin_amdgcn_sdot4((int)G_[i].x, (int)H_.x, a_, false); a_ = __builtin_amdgcn_sdot4((int)G_[i].y, (int)H_.y, a_, false); \
                        a_ = __builtin_amdgcn_sdot4((int)G_[i].z, (int)H_.z, a_, false); a_ = __builtin_amdgcn_sdot4((int)G_[i].w, (int)H_.w, a_, false); p[i] = a_; } \
                    int q8[8], q4[4], q2[2]; \
                    _Pragma("unroll") for (int m = 0; m < 8; ++m) { const int snd = (c8 & 4) ? p[m] : p[m + 8], kp = (c8 & 4) ? p[m + 8] : p[m]; q8[m] = kp + __shfl_xor(snd, 4); } \
                    _Pragma("unroll") for (int m = 0; m < 4; ++m) { const int snd = (c8 & 2) ? q8[m] : q8[m + 4], kp = (c8 & 2) ? q8[m + 4] : q8[m]; q4[m] = kp + __shfl_xor(snd, 2); } \
                    _Pragma("unroll") for (int m = 0; m < 2; ++m) { const int snd = (c8 & 1) ? q4[m] : q4[m + 2], kp = (c8 & 1) ? q4[m + 2] : q4[m]; q2[m] = kp + __shfl_xor(snd, 1); } \
                    LAS float* ap = ACC + tl * 128 + r8 + 16 * c8;         \
                    ap[0] += (float)q2[0]; ap[8] += (float)q2[1]; } while (0)
                P10_LOADU(0, gA, hA);
#pragma unroll 1
                for (int idx = 0; idx < 256; idx += 2) {
                    P10_LOADU(idx + 1, gB, hB);
                    P10_COMPU(idx, gA, hA);
                    if (idx + 2 < 256) P10_LOADU(idx + 2, gA, hA);
                    P10_COMPU(idx + 1, gB, hB);
                }
#undef P10_LOADU
#undef P10_COMPU
            }
            LDS_WAIT();
            for (int i = lane; i < 8 * 128; i += 64) { const int o_ = wave * 1024 + i; const unsigned e = EXPW[o_];
                const float a = ACC[o_] * SCL[e] * TSC[tok0 + (o_ >> 7)]; GACT[o_] = gelu_tanh(a) * GACT[o_] * SCL[NEXP + e]; }
            LDS_WAIT();
            LAS float* SSQ = ACC;
            for (int j = 0; j < 8; ++j) SSQ[(wave * 8 + j) * 128 + lane] = 0.f;
            LDS_WAIT();
            const float* gtp = MODV + (size_t)(5 * 2 + b) * DM;
            {
                v4u gA[16], gB[16]; float aA[16], aB[16];
#define P10_LOADV(idx, G_, A_) do { const int s_ = (idx) >> 3, j_ = (idx) & 7; const int tl_ = wave * 8 + j_; \
                    const unsigned char* tb_ = VB + (size_t)s_ * NEXP * 128 + 16 * c8; \
                    _Pragma("unroll") for (int i = 0; i < 16; ++i) { const int k_ = tl_ * 128 + r8 + 8 * i; const unsigned e_ = EXPW[k_]; A_[i] = GACT[k_]; G_[i] = *(const v4u*)(tb_ + (size_t)e_ * 128); } } while (0)
#define P10_COMPV(idx, G_, A_) do { const int s_c = (idx) >> 3; const int tl = wave * 8 + ((idx) & 7); const int t = tok0 + tl; \
                    const int d = 128 * s_c + 16 * c8 + 2 * r8; \
                    const unsigned xw = __builtin_nontemporal_load((const unsigned*)(X1B + (size_t)t * DM + d)); const f32x2 gv = *(const f32x2*)(gtp + d);     \
                    const float ssq_old = SSQ[tl * 128 + lane]; \
                    f32x2 o8[8]; \
                    _Pragma("unroll") for (int q = 0; q < 8; ++q) o8[q] = (f32x2){0.f, 0.f}; \
                    _Pragma("unroll") for (int i = 0; i < 16; ++i) \
                        _Pragma("unroll") for (int q = 0; q < 4; ++q) { o8[2 * q] += __builtin_amdgcn_cvt_pk_f32_fp8((int)G_[i][q], false) * A_[i]; o8[2 * q + 1] += __builtin_amdgcn_cvt_pk_f32_fp8((int)G_[i][q], true) * A_[i]; } \
                    float p[16], q8[8], q4[4], q2[2]; \
                    _Pragma("unroll") for (int q = 0; q < 8; ++q) { p[2 * q] = o8[q].x; p[2 * q + 1] = o8[q].y; } \
                    _Pragma("unroll") for (int m = 0; m < 8; ++m) { const float snd = (r8 & 4) ? p[m] : p[m + 8], kp = (r8 & 4) ? p[m + 8] : p[m]; q8[m] = kp + __shfl_xor(snd, 32); } \
                    _Pragma("unroll") for (int m = 0; m < 4; ++m) { const float snd = (r8 & 2) ? q8[m] : q8[m + 4], kp = (r8 & 2) ? q8[m + 4] : q8[m]; q4[m] = kp + __shfl_xor(snd, 16); } \
                    _Pragma("unroll") for (int m = 0; m < 2; ++m) { const float snd = (r8 & 1) ? q4[m] : q4[m + 2], kp = (r8 & 1) ? q4[m + 2] : q4[m]; q2[m] = kp + __shfl_xor(snd, 8); } \
                    f32x2 y; y.x = bf_lo(xw) + gv.x * q2[0]; y.y = bf_hi(xw) + gv.y * q2[1]; \
                    __builtin_nontemporal_store(cvt_pk_bf16(y.x, y.y), (unsigned*)(YB + (size_t)t * DM + d)); \
                    SSQ[tl * 128 + lane] = ssq_old + (y.x * y.x + y.y * y.y); } while (0)
                P10_LOADV(0, gA, aA);
#pragma unroll 1
                for (int idx = 0; idx < 256; idx += 2) {
                    P10_LOADV(idx + 1, gB, aB);
                    P10_COMPV(idx, gA, aA);
                    if (idx + 2 < 256) P10_LOADV(idx + 2, gA, aA);
                    P10_COMPV(idx + 1, gB, aB);
                }
#undef P10_LOADV
#undef P10_COMPV
            }
            VM_WAIT(); LDS_WAIT();
            __builtin_amdgcn_fence(__ATOMIC_ACQUIRE, "agent");
            VM_WAIT();
            for (int j = 0; j < 8; ++j) {
                const int tl = wave * 8 + j; const int t = tok0 + tl;
                const float rstd = 1.0f / sqrtf(wave_sum(SSQ[tl * 128 + lane]) * (1.0f / DM) + RMS_EPS);
                f32x4* op = (f32x4*)(out + (size_t)t * DM) + lane; const f32x4* gp = (const f32x4*)g_final + lane; const v2u* yp = (const v2u*)(YB + (size_t)t * DM) + lane;
#pragma unroll 4
                for (int i = 0; i < 16; ++i) { const v2u yw = __builtin_nontemporal_load(yp + 64 * i); const f32x4 y = {bf_lo(yw.x), bf_hi(yw.x), bf_lo(yw.y), bf_hi(yw.y)}; __builtin_nontemporal_store(y * rstd * gp[64 * i], op + 64 * i); }
            }
            LDS_WAIT();
        }
    }
#undef IN
#undef BOTH
#undef GRID_BAR
}

extern "C" void kernel_launch(void* const* d_in, const int* in_sizes, int n_in, void* d_out, int out_size, void* d_ws, size_t ws_size, hipStream_t stream) {
    static int grid = 0;
    if (grid == 0) {
        if (n_in != 16 || in_sizes[0] != M * DM || out_size != M * DM || ws_size < WS_END) {
            fprintf(stderr, "kernel_launch: shape/workspace mismatch: n_in %d in0 %d out %d ws %zu (need %zu)\n", n_in, n_in > 0 ? in_sizes[0] : -1, out_size, ws_size, (size_t)WS_END); grid = -1; return; }
        int dev = 0, cus = 0, per_cu = 0;
        if (hipGetDevice(&dev) != hipSuccess || hipDeviceGetAttribute(&cus, hipDeviceAttributeMultiprocessorCount, dev) != hipSuccess) { grid = -1; return; }
        if (hipFuncSetAttribute((const void*)fwd_kernel, hipFuncAttributeMaxDynamicSharedMemorySize, LDS_BYTES) != hipSuccess) { fprintf(stderr, "kernel_launch: hipFuncSetAttribute failed\n"); grid = -1; return; }
        if (hipOccupancyMaxActiveBlocksPerMultiprocessor(&per_cu, (const void*)fwd_kernel, NWAVES * 64, LDS_BYTES) != hipSuccess || per_cu < 1)
            fprintf(stderr, "kernel_launch: note: occupancy query reports %d workgroups per CU\n", per_cu);
        (void)hipGetLastError();
        grid = cus;
    }
    if (grid < 0) return;
    if (hipMemsetAsync((char*)d_ws + WS_CTL, 0, CTL_ZERO_BYTES, stream) != hipSuccess) { fprintf(stderr, "kernel_launch: memset failed\n"); return; }
    Args a{};
    for (int i = 0; i < 16; ++i) a.in[i] = (const float*)d_in[i];
    a.out = (float*)d_out; a.ws = (unsigned char*)d_ws;
#ifdef PROBE_MASK
    {
#ifndef PROBE_PAD
#define PROBE_PAD 0
#endif
        a.mask = PROBE_MASK; a.pad = PROBE_PAD;
        hipLaunchKernelGGL(fwd_kernel, dim3(grid), dim3(NWAVES * 64), LDS_BYTES, stream, a);
        (void)hipMemsetAsync((char*)d_ws + WS_CTL, 0, CTL_ZERO_BYTES, stream);
    }
#endif
    for (int li = 0; li < MK_N_LAUNCHES; ++li) {
        a.mask = (MK_N_LAUNCHES == PER_PHASE) ? (1u << li) : ((1u << PER_PHASE) - 1u); a.pad = 0;
        hipLaunchKernelGGL(fwd_kernel, dim3(grid), dim3(NWAVES * 64), LDS_BYTES, stream, a);
        const hipError_t le = hipPeekAtLastError();
        if (le != hipSuccess) { fprintf(stderr, "kernel_launch: launch %d failed: %s\n", li, hipGetErrorName(le)); break; }
    }
}
```

```cpp
#include <hip/hip_runtime.h>
#include <cstdio>
#include <cstdint>

#ifndef MK_N_LAUNCHES
#define MK_N_LAUNCHES 1
#endif

#define GAS __attribute__((address_space(1)))
#define LAS __attribute__((address_space(3)))
typedef unsigned short bf16;
typedef unsigned v4u __attribute__((ext_vector_type(4)));
typedef unsigned v2u __attribute__((ext_vector_type(2)));
typedef float f32x4 __attribute__((ext_vector_type(4)));
typedef float f32x2 __attribute__((ext_vector_type(2)));
typedef float f32x16 __attribute__((ext_vector_type(16)));
typedef short bf16x8 __attribute__((ext_vector_type(8)));
typedef short s16x4 __attribute__((ext_vector_type(4)));
typedef __bf16 bf2_t __attribute__((ext_vector_type(2)));

constexpr int BATCH = 2, SEQ = 8192, DM = 4096, M = BATCH * SEQ;
constexpr int NH = 16, HD = 128, ATTW = 2048, POOLW = 2048, INW = 8192;
constexpr int NMOD = 6 * DM;
constexpr int PQ = 2048;
constexpr int NEXP = 16384;
constexpr float RMS_EPS = 1e-6f;
constexpr float LOG2E = 1.4426950408889634f;
constexpr float QSCALE = 0.08838834764831845f * LOG2E;
constexpr float H8SCALE = 16.f, W8SCALE = 2048.f;
constexpr float A8SCALE = 128.f, P8SCALE = 24.f, WOA8SCALE = 256.f, WOP8SCALE = (A8SCALE * WOA8SCALE) / P8SCALE;
constexpr float WQ8SCALE = 1024.f;
constexpr int KS_ADA = 64;

constexpr size_t MiB = 1u << 20;
constexpr float V8MUL = 4.0f, P8MUL = 256.0f;
constexpr float Q8MUL = 16.0f, K8MUL = 2.0f;
constexpr size_t WS_CTL = 0, CTL_ZERO_BYTES = 1 * MiB;
constexpr size_t WS_MODV = 1 * MiB;
constexpr size_t WS_SCL = 2 * MiB;
constexpr size_t WS_MODP = 4 * MiB;
constexpr size_t WS_SKT = 20 * MiB;
constexpr size_t WS_PWS = 22 * MiB;
constexpr size_t WS_WQST = 24 * MiB;
constexpr size_t WS_WOUT2 = 40 * MiB;
constexpr size_t WS_WIN8 = 72 * MiB;
constexpr size_t WS_H8 = 1100 * MiB;
constexpr size_t WS_UB = 136 * MiB;
constexpr size_t WS_VB = 264 * MiB;
constexpr size_t WS_H = 392 * MiB;
constexpr size_t WS_PROJ = 520 * MiB;
constexpr size_t WS_QKVH = 1292 * MiB;
constexpr size_t WS_MIXIN = 776 * MiB;
constexpr size_t WS_WOPT = 904 * MiB;
constexpr size_t WS_WQB = 936 * MiB;
constexpr size_t WS_O0 = 968 * MiB, WS_O1 = 1032 * MiB;
constexpr size_t WS_LSE = 1096 * MiB;
constexpr size_t WS_SC = 1164 * MiB;
constexpr size_t WS_END = 1484 * MiB;

constexpr int RING_OFF = 0, RING_BYTES = 131072;
constexpr int ATT_WAVE_BYTES = 17408;
constexpr int SHARED_OFF = 139264;
constexpr int LDSCTL_OFF = 139264 + 4096, MISC_OFF = LDSCTL_OFF + 320;
constexpr int LDS_BYTES = 147456;
constexpr int NWAVES = 8;
constexpr int CW_BAR = 4096;

#define LDS_WAIT() asm volatile("s_waitcnt lgkmcnt(0)" ::: "memory")
#define VM_WAIT() asm volatile("s_waitcnt vmcnt(0)" ::: "memory")

__device__ __forceinline__ unsigned cvt_pk_bf16(float lo, float hi) { unsigned r; asm volatile("v_cvt_pk_bf16_f32 %0, %1, %2" : "=v"(r) : "v"(lo), "v"(hi)); return r; }
__device__ __forceinline__ float bf_lo(unsigned u) { return __uint_as_float(u << 16); }
__device__ __forceinline__ float bf_hi(unsigned u) { return __uint_as_float(u & 0xffff0000u); }
__device__ __forceinline__ float wave_sum(float v) {
#pragma unroll
    for (int o = 1; o < 64; o <<= 1) v += __shfl_xor(v, o);
    return v;
}

__device__ __forceinline__ unsigned q8x4c(f32x4 v, float s) {
    const unsigned b0 = __float_as_uint(__builtin_amdgcn_fmed3f(v[0] * s, -127.f, 127.f) + 12582912.0f), b1 = __float_as_uint(__builtin_amdgcn_fmed3f(v[1] * s, -127.f, 127.f) + 12582912.0f);
    const unsigned b2 = __float_as_uint(__builtin_amdgcn_fmed3f(v[2] * s, -127.f, 127.f) + 12582912.0f), b3 = __float_as_uint(__builtin_amdgcn_fmed3f(v[3] * s, -127.f, 127.f) + 12582912.0f);
    return (b0 & 0xffu) | ((b1 & 0xffu) << 8) | ((b2 & 0xffu) << 16) | (b3 << 24);
}
__device__ __forceinline__ unsigned q8x4(f32x4 v, float s) {
    const unsigned b0 = __float_as_uint(v[0] * s + 12582912.0f), b1 = __float_as_uint(v[1] * s + 12582912.0f), b2 = __float_as_uint(v[2] * s + 12582912.0f), b3 = __float_as_uint(v[3] * s + 12582912.0f);
    return (b0 & 0xffu) | ((b1 & 0xffu) << 8) | ((b2 & 0xffu) << 16) | (b3 << 24);
}
__device__ __forceinline__ int hw_lane() { int l; asm volatile("v_mbcnt_lo_u32_b32 %0, -1, 0\n\tv_mbcnt_hi_u32_b32 %0, -1, %0" : "=v"(l)); return l; }
__device__ __forceinline__ unsigned q4x4(f32x4 v, float s) {
    const unsigned b0 = __float_as_uint(__builtin_amdgcn_fmed3f(v[0] * s, -8.f, 7.f) + 12582912.0f), b1 = __float_as_uint(__builtin_amdgcn_fmed3f(v[1] * s, -8.f, 7.f) + 12582912.0f);
    const unsigned b2 = __float_as_uint(__builtin_amdgcn_fmed3f(v[2] * s, -8.f, 7.f) + 12582912.0f), b3 = __float_as_uint(__builtin_amdgcn_fmed3f(v[3] * s, -8.f, 7.f) + 12582912.0f);
    return (b0 & 15u) | ((b1 & 15u) << 4) | ((b2 & 15u) << 8) | ((b3 & 15u) << 12);
}
__device__ __forceinline__ unsigned nibs16(unsigned x) { x = (x | (x >> 4)) & 0x00ff00ffu; return (x | (x >> 8)) & 0xffffu; }
namespace pg8 {
typedef unsigned short bf16_t;
typedef int v4i_t __attribute__((ext_vector_type(4)));
typedef int v8i_t __attribute__((ext_vector_type(8)));
constexpr int BM = 256, BK = 64, HALF = 128, HTB = HALF * BK * 2, STAGE_BYTES = 8 * HTB, NXCD = 8, WGM = 8;

__host__ __device__ __forceinline__ int lds_byte(int r, int c) { const int st = (r >> 4) * 2 + (c >> 5), rr = r & 15, cc = c & 31, ob = rr * 64 + cc * 2; return st * 1024 + (ob ^ (((ob >> 9) & 1) << 5)); }
__host__ __device__ __forceinline__ void stage_rc(int b, int& R, int& C) { const int st = b / 1024, sb = b % 1024, swz = sb ^ (((sb >> 9) & 1) << 5); R = (st >> 1) * 16 + swz / 64; C = (st & 1) * 32 + (swz % 64) / 2; }
__host__ __device__ __forceinline__ int perm32(int rho) { const int n = rho >> 4, i = rho & 15; return 8 * (i >> 2) + 4 * n + (i & 3); }

template <int NF> __device__ __forceinline__ void pg8_ldfrag16(bf16x8 (&dst)[NF][2], const LAS unsigned char* base, int off) {
#pragma unroll
    for (int m = 0; m < NF; ++m)
#pragma unroll
        for (int k = 0; k < 2; ++k) dst[m][k] = *(const LAS bf16x8*)(base + off + m * 2048 + k * 1024);
}
__device__ __forceinline__ void pg8_mma16(f32x4 (&acc)[4][2], const bf16x8 (&At)[4][2], const bf16x8 (&Bt)[2][2]) {
#pragma unroll
    for (int m = 0; m < 4; ++m)
#pragma unroll
        for (int n = 0; n < 2; ++n)
#pragma unroll
            for (int k = 0; k < 2; ++k) acc[m][n] = __builtin_amdgcn_mfma_f32_16x16x32_bf16(Bt[n][k], At[m][k], acc[m][n], 0, 0, 0);
}
__device__ __forceinline__ void pg8_mma8(v4i_t (&acc)[4][2], const bf16x8 (&At)[4][2], const bf16x8 (&Bt)[2][2]) {
#pragma unroll
    for (int m = 0; m < 4; ++m)
#pragma unroll
        for (int n = 0; n < 2; ++n)
#pragma unroll
            for (int k = 0; k < 2; ++k) acc[m][n] = __builtin_amdgcn_mfma_i32_16x16x64_i8(__builtin_bit_cast(v4i_t, Bt[n][k]), __builtin_bit_cast(v4i_t, At[m][k]), acc[m][n], 0, 0, 0);
}
struct Unit { int pm, pn; };
struct Gemm { const bf16_t* A; const bf16_t* Bt; int M, N, K, lda, ldb, agrp_div, agrp_cols, bgrp_div, bgrp_cols; };

struct StaticOrder {
    int nM, nN, nwg, G, c;
    __host__ __device__ void init(int M_, int N_, int G_, int c_) { nM = M_ / BM; nN = N_ / BM; nwg = nM * nN; G = G_; c = c_; }
    __host__ __device__ bool next(int i, Unit& u) const {
        const long L = (long)i * G + c; if (L >= nwg) return false;
        int wgid = (int)L; { const int q = nwg / NXCD, r = nwg % NXCD, xcd = wgid % NXCD, off = wgid / NXCD; wgid = (xcd < r ? xcd * (q + 1) : r * (q + 1) + (xcd - r) * q) + off; }
        const int nig = WGM * nN, gid = wgid / nig, fm = gid * WGM, gsz = (nM - fm) < WGM ? (nM - fm) : WGM;
        u.pm = fm + ((wgid % nig) % gsz); u.pn = (wgid % nig) / gsz; return true;
    }
    __device__ __forceinline__ void a_ready(const Unit&) const {}
    __device__ __forceinline__ void done(const Unit&) const {}
};

struct EpiBf16 {
    static constexpr bool PERM = true, AFTER_DRAIN = false;
    bf16_t* O; int ldc; int scale_cols; float scale0; bf16_t* HM; int hm_cols; int hm_rows; float scale1 = 1.0f;
    int f8_cols = 0;
    __device__ __forceinline__ void operator()(const f32x4 (&acc)[2][2][4][2], const Unit& u, int wr, int wc, int fr, int fq) const {
        const int row0 = u.pm * BM + wr * 64 + fr; const int colt = u.pn * BM;
        const float sc = (colt < scale_cols) ? scale0 : scale1;
        const bool hm = colt < hm_cols;
        const int cw = wc * 32 + 8 * fq;
        bf16_t* base = hm ? HM + (size_t)(colt / HALF) * hm_rows * HALF + cw : O + (colt - hm_cols) + cw;
        const size_t rpitch = hm ? (size_t)HALF : (size_t)ldc, hstep = hm ? (size_t)hm_rows * HALF : (size_t)HALF;
        if (colt < f8_cols) {
            const float s8 = sc * ((colt < scale_cols) ? Q8MUL : (colt < 2 * scale_cols ? K8MUL : V8MUL));
            unsigned char* b8 = (unsigned char*)HM + (size_t)(colt / HALF) * hm_rows * HALF + cw;
#pragma unroll
            for (int ai = 0; ai < 2; ++ai)
#pragma unroll
                for (int m = 0; m < 4; ++m) { unsigned char* rowp = b8 + (size_t)(row0 + ai * HALF + m * 16) * HALF;
#pragma unroll
                    for (int bj = 0; bj < 2; ++bj) { const f32x4 v0 = acc[ai][bj][m][0] * s8, v1 = acc[ai][bj][m][1] * s8;
                        int lo = 0, hi = 0;
                        lo = __builtin_amdgcn_cvt_pk_fp8_f32(v0[0], v0[1], lo, false); lo = __builtin_amdgcn_cvt_pk_fp8_f32(v0[2], v0[3], lo, true);
                        hi = __builtin_amdgcn_cvt_pk_fp8_f32(v1[0], v1[1], hi, false); hi = __builtin_amdgcn_cvt_pk_fp8_f32(v1[2], v1[3], hi, true);
                        *(v2u*)(rowp + (size_t)bj * hm_rows * HALF) = (v2u){(unsigned)lo, (unsigned)hi}; } }
            return;
        }
#pragma unroll
        for (int ai = 0; ai < 2; ++ai)
#pragma unroll
            for (int m = 0; m < 4; ++m) { bf16_t* rowp = base + (size_t)(row0 + ai * HALF + m * 16) * rpitch;
#pragma unroll
                for (int bj = 0; bj < 2; ++bj) { f32x4 v0 = acc[ai][bj][m][0] * sc, v1 = acc[ai][bj][m][1] * sc;
                    v4u w; w.x = cvt_pk_bf16(v0[0], v0[1]); w.y = cvt_pk_bf16(v0[2], v0[3]); w.z = cvt_pk_bf16(v1[0], v1[1]); w.w = cvt_pk_bf16(v1[2], v1[3]);
                    *(v4u*)(rowp + bj * hstep) = w; } }
    }
};
struct EpiBf16ColScale {
    static constexpr bool PERM = true, AFTER_DRAIN = false;
    bf16_t* O; int ldc; int coff; const float* cs;
    __device__ __forceinline__ void operator()(const f32x4 (&acc)[2][2][4][2], const Unit& u, int wr, int wc, int fr, int fq) const {
        const int row0 = u.pm * BM + wr * 64 + fr; const int col0 = u.pn * BM + wc * 32 + 8 * fq;
        f32x4 sv[2][2];
#pragma unroll
        for (int bj = 0; bj < 2; ++bj)
#pragma unroll
            for (int n = 0; n < 2; ++n) sv[bj][n] = *(const f32x4*)(cs + col0 + bj * HALF + 4 * n);
#pragma unroll
        for (int ai = 0; ai < 2; ++ai)
#pragma unroll
            for (int m = 0; m < 4; ++m) { bf16_t* rowp = O + (size_t)(row0 + ai * HALF + m * 16) * ldc + coff + col0;
#pragma unroll
                for (int bj = 0; bj < 2; ++bj) { f32x4 v0 = acc[ai][bj][m][0] * sv[bj][0], v1 = acc[ai][bj][m][1] * sv[bj][1];
                    v4u w; w.x = cvt_pk_bf16(v0[0], v0[1]); w.y = cvt_pk_bf16(v0[2], v0[3]); w.z = cvt_pk_bf16(v1[0], v1[1]); w.w = cvt_pk_bf16(v1[2], v1[3]);
                    *(v4u*)(rowp + bj * HALF) = w; } }
    }
};
struct EpiI8 {
    static constexpr bool PERM = true, AFTER_DRAIN = false;
    unsigned char* O; int ldc; int coff; float scale;
    __device__ __forceinline__ void operator()(const f32x4 (&acc)[2][2][4][2], const Unit& u, int wr, int wc, int fr, int fq) const {
        const int row0 = u.pm * BM + wr * 64 + fr; const int col0 = u.pn * BM + wc * 32 + 8 * fq;
#pragma unroll
        for (int ai = 0; ai < 2; ++ai)
#pragma unroll
            for (int m = 0; m < 4; ++m) { unsigned char* rowp = O + (size_t)(row0 + ai * HALF + m * 16) * ldc + coff + col0;
#pragma unroll
                for (int bj = 0; bj < 2; ++bj) *(v2u*)(rowp + bj * HALF) = (v2u){q8x4c(acc[ai][bj][m][0], scale), q8x4c(acc[ai][bj][m][1], scale)}; }
    }
};
struct EpiF32RowScale {
    static constexpr bool PERM = false, AFTER_DRAIN = false;
    float* O; int ldc; const float* rs; const float* cs;
    __device__ __forceinline__ void operator()(const f32x4 (&acc)[2][2][4][2], const Unit& u, int wr, int wc, int fr, int fq) const {
        const int row0 = u.pm * BM + wr * 64 + fr; const int col0 = u.pn * BM + wc * 32 + 4 * fq;
        f32x4 cv[2][2];
#pragma unroll
        for (int bj = 0; bj < 2; ++bj)
#pragma unroll
            for (int n = 0; n < 2; ++n) cv[bj][n] = *(const f32x4*)(cs + col0 + bj * HALF + n * 16);
#pragma unroll
        for (int ai = 0; ai < 2; ++ai)
#pragma unroll
            for (int m = 0; m < 4; ++m) { const int row = row0 + ai * HALF + m * 16; const float r = rs[row]; const size_t off = (size_t)row * ldc + col0;
#pragma unroll
                for (int bj = 0; bj < 2; ++bj)
#pragma unroll
                    for (int n = 0; n < 2; ++n) *(f32x4*)(O + off + bj * HALF + n * 16) = acc[ai][bj][m][n] * cv[bj][n] * r; }
    }
};
struct EpiResBf16 {
    static constexpr bool PERM = true, AFTER_DRAIN = false;
    const float* X; const float* gate; bf16_t* O; int ldc; float ascale;
    __device__ __forceinline__ void operator()(const f32x4 (&acc)[2][2][4][2], const Unit& u, int wr, int wc, int fr, int fq) const {
        const int row0 = u.pm * BM + wr * 64 + fr; const int col0 = u.pn * BM + wc * 32 + 8 * fq; const int b = (u.pm * BM) / SEQ;
        f32x4 gv[2][2];
#pragma unroll
        for (int bj = 0; bj < 2; ++bj)
#pragma unroll
            for (int n = 0; n < 2; ++n) gv[bj][n] = *(const f32x4*)(gate + (size_t)b * DM + col0 + bj * HALF + 4 * n) * ascale;
#pragma unroll
        for (int ai = 0; ai < 2; ++ai)
#pragma unroll
            for (int m = 0; m < 4; ++m) { const size_t off = (size_t)(row0 + ai * HALF + m * 16) * ldc + col0;
#pragma unroll
                for (int bj = 0; bj < 2; ++bj) { const f32x4 x0 = *(const f32x4*)(X + off + bj * HALF), x1 = *(const f32x4*)(X + off + bj * HALF + 4);
                    const f32x4 v0 = x0 + gv[bj][0] * acc[ai][bj][m][0], v1 = x1 + gv[bj][1] * acc[ai][bj][m][1];
                    v4u w; w.x = cvt_pk_bf16(v0[0], v0[1]); w.y = cvt_pk_bf16(v0[2], v0[3]); w.z = cvt_pk_bf16(v1[0], v1[1]); w.w = cvt_pk_bf16(v1[2], v1[3]);
                    *(v4u*)(O + off + bj * HALF) = w; } }
    }
};
struct EpiResF32 {
    static constexpr bool PERM = false, AFTER_DRAIN = false;
    const float* X; const float* gate; float* O; int ldc;
    __device__ __forceinline__ void operator()(const f32x4 (&acc)[2][2][4][2], const Unit& u, int wr, int wc, int fr, int fq) const {
        const int row0 = u.pm * BM + wr * 64 + fr; const int col0 = u.pn * BM + wc * 32 + 4 * fq; const int b = (u.pm * BM) / SEQ;
        f32x4 gv[2][2];
#pragma unroll
        for (int bj = 0; bj < 2; ++bj)
#pragma unroll
            for (int n = 0; n < 2; ++n) gv[bj][n] = *(const f32x4*)(gate + (size_t)b * DM + col0 + bj * HALF + n * 16);
#pragma unroll
        for (int ai = 0; ai < 2; ++ai)
#pragma unroll
            for (int m = 0; m < 4; ++m) { const size_t off = (size_t)(row0 + ai * HALF + m * 16) * ldc + col0;
#pragma unroll
                for (int bj = 0; bj < 2; ++bj)
#pragma unroll
                    for (int n = 0; n < 2; ++n) { const f32x4 xv = *(const f32x4*)(X + off + bj * HALF + n * 16);
                        *(f32x4*)(O + off + bj * HALF + n * 16) = xv + gv[bj][n] * acc[ai][bj][m][n]; } }
    }
};
struct EpiF32 {
    static constexpr bool PERM = false, AFTER_DRAIN = false;
    float* O; int ldc;
    __device__ __forceinline__ void operator()(const f32x4 (&acc)[2][2][4][2], const Unit& u, int wr, int wc, int fr, int fq) const {
        const int row0 = u.pm * BM + wr * 64 + fr; const int col0 = u.pn * BM + wc * 32 + 4 * fq;
#pragma unroll
        for (int ai = 0; ai < 2; ++ai)
#pragma unroll
            for (int m = 0; m < 4; ++m) { const size_t off = (size_t)(row0 + ai * HALF + m * 16) * ldc + col0;
#pragma unroll
                for (int bj = 0; bj < 2; ++bj)
#pragma unroll
                    for (int n = 0; n < 2; ++n) *(f32x4*)(O + off + bj * HALF + n * 16) = acc[ai][bj][m][n]; }
    }
};

template <class Epi, class Sched, bool ALIGN_EPI, bool I8 = false>
__device__ __forceinline__ void gemm_phase(LAS unsigned char* lds, const Gemm g, const Sched& S, const Epi& E, const int wave_id) {
    const int wid = wave_id, lane = hw_lane(), tid = wid * 64 + lane,
              wr = wid >> 2, wc = wid & 3, fr = lane & 15, fq = lane >> 4;
    const int K = g.K, nt = K / BK;
    unsigned voffA, voffB;
    { int R, C; stage_rc(tid * 16, R, C); const int Rb = Epi::PERM ? ((R & ~31) + perm32(R & 31)) : R;
      voffA = (unsigned)(R * g.lda + C) * 2u; voffB = (unsigned)(Rb * g.ldb + C) * 2u; }
    const size_t pstepA = (size_t)64 * g.lda * 2, pstepB = (size_t)64 * g.ldb * 2;
    const size_t kstep = (size_t)(BK * 2);
    const size_t hstepA = (size_t)HALF * g.lda * 2, hstepB = (size_t)HALF * g.ldb * 2;
    const size_t tstepA = 2 * hstepA, tstepB = 2 * hstepB;
    const unsigned ldsw = (unsigned)wid * 1024u;
    const int aoff = lds_byte(wr * 64 + fr, fq * 8), boff = lds_byte(wc * 32 + fr, fq * 8);
#define PG8_SA(b, h) (((b) * 2 + (h)) * HTB)
#define PG8_SB(b, h) ((4 + (b) * 2 + (h)) * HTB)
#define PG8_STAGE(bufoff, gbase, voff) do { _Pragma("unroll") for (int _i = 0; _i < 2; ++_i) \
        __builtin_amdgcn_global_load_lds((const unsigned*)((const char*)(gbase) + (size_t)_i * pstep_##voff + (voff)), (LAS unsigned*)(lds + (bufoff) + ldsw + _i * 8192), 16, 0, 0); } while (0)
#define pstep_voffA pstepA
#define pstep_voffB pstepB
#define PG8_LDA(dst, b, h) pg8_ldfrag16<4>(dst, lds + PG8_SA(b, h), aoff)
#define PG8_LDB(dst, b, h) pg8_ldfrag16<2>(dst, lds + PG8_SB(b, h), boff)
#define PG8_MMA(ai, bj, At, Bt) do { __builtin_amdgcn_s_setprio(1); if constexpr (I8) pg8_mma8(acci[ai][bj], At, Bt); else pg8_mma16(acc[ai][bj], At, Bt); __builtin_amdgcn_s_setprio(0); } while (0)
#define PG8_WAIT_V(n) asm volatile("s_waitcnt vmcnt(" #n ")" ::: "memory")
#define PG8_WAIT_L(n) asm volatile("s_waitcnt lgkmcnt(" #n ")" ::: "memory")
#define PG8_BAR __builtin_amdgcn_s_barrier()
#define PG8_SCHED __builtin_amdgcn_sched_barrier(0)
#define PG8_ABASE(u) ((const char*)g.A + (size_t)(u).pm * tstepA + (size_t)((u).pn / g.agrp_div) * (size_t)g.agrp_cols * 2)
#define PG8_BBASE(u) ((const char*)g.Bt + (size_t)(u).pn * tstepB + (size_t)((u).pm / g.bgrp_div) * (size_t)g.bgrp_cols * 2)
    Unit cur, nxt; int ui = 0;
    if (!S.next(0, cur)) return;
    f32x4 acc[2][2][4][2]; v4i_t acci[2][2][4][2];
#pragma unroll
    for (int a = 0; a < 2; ++a)
#pragma unroll
        for (int b = 0; b < 2; ++b)
#pragma unroll
            for (int m = 0; m < 4; ++m)
#pragma unroll
                for (int n = 0; n < 2; ++n) { acc[a][b][m][n] = (f32x4){0.f, 0.f, 0.f, 0.f}; acci[a][b][m][n] = (v4i_t){0, 0, 0, 0}; }
    bf16x8 At[4][2], B0[2][2], B1[2][2];
    const char* cA = PG8_ABASE(cur); const char* cB = PG8_BBASE(cur);
    S.a_ready(cur);
    PG8_STAGE(PG8_SB(0, 0), cB, voffB); PG8_STAGE(PG8_SB(0, 1), cB + hstepB, voffB); PG8_STAGE(PG8_SA(0, 0), cA, voffA); PG8_STAGE(PG8_SA(0, 1), cA + hstepA, voffA);
    if (wr == 1) PG8_BAR;
    PG8_WAIT_V(2); PG8_BAR;
    PG8_STAGE(PG8_SB(1, 0), cB + kstep, voffB); PG8_STAGE(PG8_SA(1, 0), cA + kstep, voffA); PG8_STAGE(PG8_SB(1, 1), cB + hstepB + kstep, voffB);
    PG8_WAIT_V(6); PG8_BAR;
    for (;;) {
        const bool has_next = S.next(ui + 1, nxt);
        const char* nA = has_next ? PG8_ABASE(nxt) : cA; const char* nB = has_next ? PG8_BBASE(nxt) : cB;
        for (int t = 0; t < nt; t += 2) {
            const bool last = (t == nt - 2);
            const char* a1 = cA + (size_t)(t + 1) * kstep;
            const char* a2 = last ? nA : cA + (size_t)(t + 2) * kstep; const char* b2 = last ? nB : cB + (size_t)(t + 2) * kstep;
            const char* a3 = a2 + kstep; const char* b3 = b2 + kstep;
            if (last && has_next) S.a_ready(nxt);
            PG8_LDB(B0, 0, 0); PG8_LDB(B1, 0, 1); PG8_SCHED; PG8_LDA(At, 0, 0); PG8_STAGE(PG8_SA(1, 1), a1 + hstepA, voffA);
            PG8_WAIT_V(8); PG8_WAIT_L(0); PG8_BAR; PG8_MMA(0, 0, At, B0); PG8_MMA(0, 1, At, B1); PG8_BAR; PG8_SCHED;
            PG8_LDA(At, 0, 1); PG8_STAGE(PG8_SB(0, 0), b2, voffB); PG8_STAGE(PG8_SB(0, 1), b2 + hstepB, voffB); PG8_STAGE(PG8_SA(0, 0), a2, voffA);
            PG8_WAIT_V(8); PG8_WAIT_L(0); PG8_BAR; PG8_MMA(1, 0, At, B0); PG8_MMA(1, 1, At, B1); PG8_BAR; PG8_SCHED;
            PG8_LDB(B0, 1, 0); PG8_LDB(B1, 1, 1); PG8_SCHED; PG8_LDA(At, 1, 0); PG8_STAGE(PG8_SA(0, 1), a2 + hstepA, voffA);
            PG8_WAIT_V(8); PG8_WAIT_L(0); PG8_BAR; PG8_MMA(0, 0, At, B0); PG8_MMA(0, 1, At, B1); PG8_BAR; PG8_SCHED;
            PG8_LDA(At, 1, 1); PG8_STAGE(PG8_SB(1, 0), b3, voffB); PG8_STAGE(PG8_SB(1, 1), b3 + hstepB, voffB); PG8_STAGE(PG8_SA(1, 0), a3, voffA);
            PG8_WAIT_V(8); PG8_WAIT_L(0); PG8_BAR; PG8_MMA(1, 0, At, B0); PG8_MMA(1, 1, At, B1); PG8_BAR; PG8_SCHED;
        }
        if constexpr (ALIGN_EPI) { if (wr == 0) PG8_BAR; }
        if constexpr (I8) {
#pragma unroll
            for (int a = 0; a < 2; ++a)
#pragma unroll
                for (int b = 0; b < 2; ++b)
#pragma unroll
                    for (int m = 0; m < 4; ++m)
#pragma unroll
                        for (int n = 0; n < 2; ++n) acc[a][b][m][n] = __builtin_convertvector(acci[a][b][m][n], f32x4);
        }
        E(acc, cur, wr, wc, fr, fq);
        S.done(cur);
        if (!has_next) break;
#pragma unroll
        for (int a = 0; a < 2; ++a)
#pragma unroll
            for (int b = 0; b < 2; ++b)
#pragma unroll
                for (int m = 0; m < 4; ++m)
#pragma unroll
                    for (int n = 0; n < 2; ++n) { acc[a][b][m][n] = (f32x4){0.f, 0.f, 0.f, 0.f}; acci[a][b][m][n] = (v4i_t){0, 0, 0, 0}; }
        cur = nxt; cA = nA; cB = nB; ++ui;
        if constexpr (ALIGN_EPI) { if (wr == 1) PG8_BAR; }
    }
    PG8_WAIT_V(0);
    if constexpr (!ALIGN_EPI) { if (wr == 0) PG8_BAR; }
    PG8_BAR;
#undef PG8_SA
#undef PG8_SB
#undef PG8_STAGE
#undef pstep_voffA
#undef pstep_voffB
#undef PG8_LDA
#undef PG8_LDB
#undef PG8_MMA
#undef PG8_WAIT_V
#undef PG8_WAIT_L
#undef PG8_BAR
#undef PG8_SCHED
#undef PG8_ABASE
#undef PG8_BBASE
}
}

#define XB_TMO      128
#define XB_XCNT(j)  (256  + 64 * (j))
#define XB_XSUB(j)  (1280 + 64 * (j))
#define XB_XGEN(j)  (2304 + 64 * (j))
#define XB_TOP      3328
#define XB_TOPGEN   3392
#define XCD_BAR_WORDS 3456
#define XB_SPIN_CAP (1u << 18)

__device__ __forceinline__ unsigned xb_ld(unsigned* p)              { return __hip_atomic_load(p, __ATOMIC_RELAXED, __HIP_MEMORY_SCOPE_AGENT); }
__device__ __forceinline__ unsigned xb_add(unsigned* p, unsigned v) { return __hip_atomic_fetch_add(p, v, __ATOMIC_RELAXED, __HIP_MEMORY_SCOPE_AGENT); }
__device__ __forceinline__ unsigned xb_xcc_id() { return (unsigned)__builtin_amdgcn_s_getreg((3 << 11) | 20) & 0xFu; }
#define XB_SPIN(cond, bar) do { unsigned _sp = 0; while (cond) { __builtin_amdgcn_s_sleep(1); \
    if ((++_sp & 255u) == 0u) { if (xb_ld(&(bar)[XB_TMO])) break; if (_sp > XB_SPIN_CAP) { atomicAdd(&(bar)[XB_TMO], 1u); break; } } } } while (0)

struct XcdBarrier { unsigned* bar; unsigned x; volatile LAS unsigned* st; };

__device__ __forceinline__ XcdBarrier xcd_barrier_post(unsigned* bar, volatile LAS unsigned* st, const int wave_id) {
    XcdBarrier b; b.bar = bar; b.x = xb_xcc_id(); b.st = st;
    if (wave_id == 0 && hw_lane() == 0) (void)xb_add(&bar[XB_XCNT(b.x)], 1u);
    return b;
}
__device__ __forceinline__ void xcd_barrier_complete(unsigned* bar, unsigned x, unsigned& nloc, unsigned& nx) {
    const unsigned G = gridDim.x * gridDim.y * gridDim.z;
    unsigned sum, cnt, mine, sp = 0u;
    for (;;) {
        sum = 0u; cnt = 0u; mine = 0u;
#pragma unroll
        for (unsigned j = 0; j < 16; ++j) { const unsigned c = xb_ld(&bar[XB_XCNT(j)]); sum += c; cnt += (c > 0u) ? 1u : 0u; mine = (j == x) ? c : mine; }
        if (sum == G) break;
        __builtin_amdgcn_s_sleep(1);
        if ((++sp & 255u) == 0u) { if (xb_ld(&bar[XB_TMO])) break; if (sp > XB_SPIN_CAP) { atomicAdd(&bar[XB_TMO], 1u); break; } }
    }
    nloc = mine > 0u ? mine : 1u; nx = cnt > 0u ? cnt : 1u;
}
__device__ __forceinline__ void xcd_barrier(const XcdBarrier& b, const int wave_id) {
    asm volatile("s_waitcnt vmcnt(0)" ::: "memory");
    __syncthreads();
    if (wave_id == 0 && hw_lane() == 0) {
        unsigned* bar = b.bar;
        __builtin_amdgcn_s_waitcnt(0);
        unsigned nloc = b.st[0], nx = b.st[1];
        if (nloc == 0u) { xcd_barrier_complete(bar, b.x, nloc, nx); b.st[0] = nloc; b.st[1] = nx; }
        const unsigned old = xb_add(&bar[XB_XSUB(b.x)], 1u);
        const unsigned gen = old / nloc;
        if (old + 1u == (gen + 1u) * nloc) {
            __builtin_amdgcn_fence(__ATOMIC_RELEASE, "agent");
            asm volatile("s_waitcnt vmcnt(0)" ::: "memory");
            const unsigned og = xb_add(&bar[XB_TOP], 1u);
            const unsigned tg = og / nx;
            if (og + 1u == (tg + 1u) * nx) xb_add(&bar[XB_TOPGEN], 1u);
            else XB_SPIN(xb_ld(&bar[XB_TOPGEN]) == tg, bar);
            __builtin_amdgcn_fence(__ATOMIC_ACQUIRE, "agent");
            xb_add(&bar[XB_XGEN(b.x)], 1u);
            asm volatile("s_waitcnt vmcnt(0)" ::: "memory");
        } else {
            XB_SPIN(xb_ld(&bar[XB_XGEN(b.x)]) == gen, bar);
            __builtin_amdgcn_fence(__ATOMIC_ACQUIRE, "agent");
            asm volatile("s_waitcnt vmcnt(0)" ::: "memory");
        }
    }
    __syncthreads();
}

template <bool F8>
__device__ __forceinline__ void p0_transpose_item(const float* W, int ldw, int N, void* WTv, int ldt, float scale, LAS float* scr, int item, int lane) {
    const int nblk = N / 32, kb = item / nblk, nb = item % nblk, k0 = 64 * kb, n0 = 32 * nb;
#pragma unroll 8
    for (int i = 0; i < 32; ++i) { const int kk = 2 * i + (lane >> 5); scr[kk * 33 + (lane & 31)] = W[(size_t)(k0 + kk) * ldw + n0 + (lane & 31)]; }
    LDS_WAIT(); asm volatile("" ::: "memory");
    const int c = lane & 7;
#pragma unroll
    for (int j = 0; j < 4; ++j) { const int n = (lane >> 3) + 8 * j; const LAS float* s = scr + (8 * c) * 33 + n;
        if constexpr (F8) {
            const f32x4 lo4 = {s[0 * 33], s[1 * 33], s[2 * 33], s[3 * 33]}, hi4 = {s[4 * 33], s[5 * 33], s[6 * 33], s[7 * 33]};
            *(GAS v2u*)((unsigned char*)WTv + (size_t)(n0 + n) * ldt + k0 + 8 * c) = (v2u){q8x4c(lo4, scale), q8x4c(hi4, scale)};
        } else {
            v4u o; o.x = cvt_pk_bf16(s[0 * 33], s[1 * 33]); o.y = cvt_pk_bf16(s[2 * 33], s[3 * 33]); o.z = cvt_pk_bf16(s[4 * 33], s[5 * 33]); o.w = cvt_pk_bf16(s[6 * 33], s[7 * 33]);
            *(GAS v4u*)((bf16*)WTv + (size_t)(n0 + n) * ldt + k0 + 8 * c) = o; } }
    LDS_WAIT(); asm volatile("" ::: "memory");
}

__device__ __forceinline__ int t5_bucket(int rel) {
    int n = -rel; const int ret = n < 0 ? 16 : 0; n = n < 0 ? -n : n;
    if (n < 8) return ret + n;
    const float v = logf((float)n / 8.0f) / logf(128.0f) * 8.0f;
    int large = 8 + (int)v; large = large < 15 ? large : 15;
    return ret + large;
}
__device__ __forceinline__ float gelu_tanh(float x) {
    const float z = 0.7978845608028654f * (x + 0.044715f * x * x * x);
    const float e = __expf(2.0f * z);
    const float t = 1.0f - 2.0f / (e + 1.0f);
    return 0.5f * x * (1.0f + t);
}
__device__ __forceinline__ unsigned fkey(float v) { const unsigned u = __float_as_uint(v); return (u >> 31) ? ~u : (u | 0x80000000u); }
__device__ __forceinline__ float fdec(unsigned key) { const unsigned k2 = key & ~127u; const unsigned u = (k2 >> 31) ? (k2 & 0x7fffffffu) : (~k2 & ~127u); return __uint_as_float(u); }
template <int LJ> __device__ __forceinline__ unsigned xshfl(unsigned x, const int lane) {
    if constexpr (LJ == 1) return (unsigned)__builtin_amdgcn_update_dpp(0, (int)x, 0xB1, 0xF, 0xF, false);
    else if constexpr (LJ == 2) return (unsigned)__builtin_amdgcn_update_dpp(0, (int)x, 0x4E, 0xF, 0xF, false);
    else if constexpr (LJ == 4) { const int y = __builtin_amdgcn_update_dpp(0, (int)x, 0x141, 0xF, 0xF, false); return (unsigned)__builtin_amdgcn_update_dpp(0, y, 0x1B, 0xF, 0xF, false); }
    else if constexpr (LJ == 8) { const int y = __builtin_amdgcn_update_dpp(0, (int)x, 0x140, 0xF, 0xF, false); return (unsigned)__builtin_amdgcn_update_dpp(0, y, 0x141, 0xF, 0xF, false); }
    else if constexpr (LJ == 16) return (unsigned)__builtin_amdgcn_ds_swizzle((int)x, 0x401F);
    else { const auto rr = __builtin_amdgcn_permlane32_swap(x, x, false, false); return lane < 32 ? rr[1] : rr[0]; }
}
template <int K, int J> __device__ __forceinline__ void bitonic_step(unsigned& a0, unsigned& a1, unsigned& b0, unsigned& b1, const int lane) {
    const bool asc = (K == 128) ? true : ((lane & (K >> 1)) == 0);
    if constexpr (J == 1) {
        const unsigned la = a0 < a1 ? a0 : a1, ha = a0 < a1 ? a1 : a0, lb = b0 < b1 ? b0 : b1, hb = b0 < b1 ? b1 : b0;
        a0 = asc ? la : ha; a1 = asc ? ha : la; b0 = asc ? lb : hb; b1 = asc ? hb : lb;
    } else {
        constexpr int LJ = J >> 1; const bool tmin = (((lane & LJ) == 0) == asc);
        const unsigned pa0 = xshfl<LJ>(a0, lane), pa1 = xshfl<LJ>(a1, lane), pb0 = xshfl<LJ>(b0, lane), pb1 = xshfl<LJ>(b1, lane);
        a0 = tmin ? (a0 < pa0 ? a0 : pa0) : (a0 < pa0 ? pa0 : a0); a1 = tmin ? (a1 < pa1 ? a1 : pa1) : (a1 < pa1 ? pa1 : a1);
        b0 = tmin ? (b0 < pb0 ? b0 : pb0) : (b0 < pb0 ? pb0 : b0); b1 = tmin ? (b1 < pb1 ? b1 : pb1) : (b1 < pb1 ? pb1 : b1);
    }
    if constexpr (J > 1) bitonic_step<K, (J >> 1)>(a0, a1, b0, b1, lane);
}
template <int K> __device__ __forceinline__ void bitonic_stage(unsigned& a0, unsigned& a1, unsigned& b0, unsigned& b1, const int lane) {
    bitonic_step<K, (K >> 1)>(a0, a1, b0, b1, lane);
    if constexpr (K < 128) bitonic_stage<(K << 1)>(a0, a1, b0, b1, lane);
}
__device__ __forceinline__ void bitonic128x2(unsigned& a0, unsigned& a1, unsigned& b0, unsigned& b1, const int lane) { bitonic_stage<2>(a0, a1, b0, b1, lane); }
__device__ __forceinline__ float dot2bf(unsigned a, unsigned b, float c) { return __builtin_amdgcn_fdot2_f32_bf16(__builtin_bit_cast(bf2_t, a), __builtin_bit_cast(bf2_t, b), c, false); }

constexpr int ATT_SLOT4 = 4352;
constexpr int ATT_SLOT = 8704;
__device__ __forceinline__ int crow(int r, int hi) { return (r & 3) + 8 * (r >> 2) + 4 * hi; }

__device__ __forceinline__ void attn_task(const int G, const bf16* QKVH, bf16* O0, bf16* O1, float* LSE0, float* LSE1, unsigned char* MIX8,
                                          const LAS float* btab, LAS unsigned char* wl, int b, int h, int mtile, int tk, int lane) {
    const int SH = 2 * G;
    const int L = SEQ >> SH, TPR = 32 >> SH;
    const int r32 = lane & 31, hi = lane >> 5;
    const int res = tk >> (5 - SH), l0 = ((mtile * 1024) >> SH) + 32 * (tk & (TPR - 1));
    const size_t rowbase = (size_t)b * SEQ;
    const int srow = lane >> 4, sch = lane & 15;
    const int rot = (tk & 1) ? 4 : 0;
#define ATT_JR(j) (((j) + rot) >= 5 ? ((j) + rot - 5) : ((j) + rot))
#define ATT_WAITV(n) asm volatile("s_waitcnt vmcnt(" #n ")" ::: "memory")
      \
#define ATT_ISSUE(n) do { LAS unsigned char* sl_ = wl + ((n) & 3) * ATT_SLOT4; const int jt_ = ATT_JR((n) - 5); \
        _Pragma("unroll") for (int i_ = 0; i_ < 4; ++i_) { \
            const int key_ = i_ + 4 * ((krow8 >> 1) & 1) + 8 * (krow8 & 1) + 16 * (krow8 >> 2); \
            int lk_ = l0 - 64 + 32 * jt_ + key_; lk_ = lk_ < 0 ? 0 : (lk_ > L - 1 ? L - 1 : lk_); \
            const unsigned char* src_ = QK8 + ((size_t)(2 * NH + h) * M + rowbase + ((size_t)lk_ << SH) + res) * HD + kch8 * 16; \
            __builtin_amdgcn_global_load_lds((const unsigned*)src_, (LAS unsigned*)(sl_ + i_ * 1056), 16, 0, 0); } } while (0)
    const int krow8 = lane >> 3, kch8 = lane & 7;
#define ATT_ISSUEK(n) do { LAS unsigned char* sl_ = wl + ((n) & 3) * ATT_SLOT4; const int jt_ = ATT_JR(n); \
        _Pragma("unroll") for (int i_ = 0; i_ < 4; ++i_) { \
            const int key_ = 8 * i_ + krow8; \
            int lk_ = l0 - 64 + 32 * jt_ + key_; lk_ = lk_ < 0 ? 0 : (lk_ > L - 1 ? L - 1 : lk_); \
            const int ch_ = kch8 ^ ((key_ ^ (key_ >> 3)) & 7); \
            const unsigned char* src_ = QK8 + ((size_t)(NH + h) * M + rowbase + ((size_t)lk_ << SH) + res) * HD + ch_ * 16; \
            __builtin_amdgcn_global_load_lds((const unsigned*)src_, (LAS unsigned*)(sl_ + i_ * 1024), 16, 0, 0); } } while (0)
    const size_t qrow = rowbase + ((size_t)(l0 + r32) << SH) + res;
    const unsigned char* QK8 = (const unsigned char*)QKVH;
    long qr[8];
    { const unsigned char* qp = QK8 + ((size_t)h * M + qrow) * HD + hi * 8;
#pragma unroll
      for (int d0 = 0; d0 < 8; ++d0) qr[d0] = *(const long*)(qp + d0 * 16); }
    ATT_ISSUEK(0); ATT_ISSUEK(1); ATT_ISSUEK(2); ATT_ISSUEK(3);
    f32x16 p[5];
    const int ksw = (r32 ^ (r32 >> 3)) & 7;
#define ATT_KTILE(n) do { LAS unsigned char* sl_ = wl + ((n) & 3) * ATT_SLOT4 + r32 * 128 + 8 * hi; f32x16 s_ = {}; \
        _Pragma("unroll") for (int d0 = 0; d0 < 8; ++d0) { const long a_ = *(const LAS long*)(sl_ + ((d0 ^ ksw) << 4)); s_ = __builtin_amdgcn_mfma_f32_32x32x16_fp8_fp8(a_, qr[d0], s_, 0, 0, 0); } \
        p[n] = s_; asm volatile("" ::: "memory"); } while (0)
    ATT_WAITV(12); ATT_KTILE(0); ATT_ISSUEK(4);
    ATT_WAITV(12); ATT_KTILE(1); ATT_ISSUE(5);
    ATT_WAITV(12); ATT_KTILE(2); ATT_ISSUE(6);
    ATT_WAITV(12); ATT_KTILE(3); ATT_ISSUE(7);
    ATT_WAITV(12); ATT_KTILE(4); ATT_ISSUE(8);
    float mx = -1e30f;
    const bool edge = (l0 - 64 < 0) || (l0 + 96 > L);
    const LAS float* bt = btab + G * 256 + 32 + 4 * hi - r32;
#pragma unroll
    for (int j = 0; j < 5; ++j) {
        const int jr = ATT_JR(j); const LAS float* btj = bt + 32 * jr;
#pragma unroll
        for (int r = 0; r < 16; ++r) {
            const int kc = 32 * jr + (r & 3) + 8 * (r >> 2);
            float v = p[j][r] * (1.0f / (Q8MUL * K8MUL)) + btj[(r & 3) + 8 * (r >> 2)];
            if (edge) { const int lk = l0 - 64 + kc + 4 * hi; v = (lk >= 0 && lk < L) ? v : -1e30f; }
            p[j][r] = v; mx = fmaxf(mx, v);
        }
        asm volatile("" ::: "memory");
    }
    mx = fmaxf(mx, __shfl_xor(mx, 32));
    float ls = 0.f;
    long pb[5][2];
#pragma unroll
    for (int j = 0; j < 5; ++j) {
        float e[16];
#pragma unroll
        for (int r = 0; r < 16; ++r) { e[r] = __builtin_amdgcn_exp2f(p[j][r] - mx); ls += e[r]; }
#pragma unroll
        for (int s = 0; s < 2; ++s) { int lo_ = 0, hi_ = 0;
            lo_ = __builtin_amdgcn_cvt_pk_fp8_f32(e[8 * s + 0] * P8MUL, e[8 * s + 1] * P8MUL, lo_, false); lo_ = __builtin_amdgcn_cvt_pk_fp8_f32(e[8 * s + 2] * P8MUL, e[8 * s + 3] * P8MUL, lo_, true);
            hi_ = __builtin_amdgcn_cvt_pk_fp8_f32(e[8 * s + 4] * P8MUL, e[8 * s + 5] * P8MUL, hi_, false); hi_ = __builtin_amdgcn_cvt_pk_fp8_f32(e[8 * s + 6] * P8MUL, e[8 * s + 7] * P8MUL, hi_, true);
            pb[j][s] = (long)(((unsigned long)(unsigned)hi_ << 32) | (unsigned long)(unsigned)lo_); }
    }
    ls += __shfl_xor(ls, 32);
    asm volatile("" ::: "memory");
    f32x16 o[4] = {};
    const int i16 = lane & 15, g16 = lane >> 4;
    const int tr_ = i16 >> 1;
    const unsigned vbase = (unsigned)(uintptr_t)wl + (unsigned)((tr_ & 3) * 1056 + (2 * hi + (tr_ >> 2)) * 128 + 16 * (g16 & 1) + 8 * (i16 & 1));
#define ATT_VTILE(n) do { const unsigned va_ = vbase + ((n) & 3) * ATT_SLOT4; \
        _Pragma("unroll") for (int dt = 0; dt < 4; ++dt) { long af0, af1; \
            asm volatile("ds_read_b64_tr_b8 %0, %2 offset:%3\n\tds_read_b64_tr_b8 %1, %2 offset:%4\n\ts_waitcnt lgkmcnt(0)" \
                         : "=&v"(af0), "=&v"(af1) : "v"(va_), "i"(dt * 32), "i"(512 + dt * 32) : "memory"); \
            o[dt] = __builtin_amdgcn_mfma_f32_32x32x16_fp8_fp8(af0, pb[(n) - 5][0], o[dt], 0, 0, 0); \
            o[dt] = __builtin_amdgcn_mfma_f32_32x32x16_fp8_fp8(af1, pb[(n) - 5][1], o[dt], 0, 0, 0); } } while (0)
    ATT_WAITV(12); ATT_VTILE(5); ATT_ISSUE(9);
    ATT_WAITV(12); ATT_VTILE(6);
    ATT_WAITV(8);  ATT_VTILE(7);
    ATT_WAITV(4);  ATT_VTILE(8);
    ATT_WAITV(0);  ATT_VTILE(9);
#undef ATT_WAITV
#undef ATT_ISSUE
#undef ATT_ISSUEK
#undef ATT_KTILE
#undef ATT_VTILE
#undef ATT_JR
    const float inv = 1.0f / (ls * (P8MUL * V8MUL));
    const float lse2 = mx + __builtin_amdgcn_logf(ls);
    const size_t orow = qrow;
    LAS unsigned char* T0 = wl;
    LAS unsigned char* T1 = T0 + ATT_SLOT;
    int ln_ = lane; asm volatile("" : "+v"(ln_));
    const int erow = ln_ >> 4, echk = ln_ & 15;
    const unsigned pofs = (unsigned)(r32 * 272 + 8 * hi);
    if (G < 2) {
#pragma unroll
        for (int dt = 0; dt < 4; ++dt)
#pragma unroll
            for (int rg = 0; rg < 4; ++rg) { v2u w; w.x = cvt_pk_bf16(o[dt][4 * rg] * inv, o[dt][4 * rg + 1] * inv); w.y = cvt_pk_bf16(o[dt][4 * rg + 2] * inv, o[dt][4 * rg + 3] * inv);
                *(LAS v2u*)(T0 + pofs + 64 * dt + 16 * rg) = w; }
        LDS_WAIT();
        bf16* ob = (G == 0 ? O0 : O1) + ((size_t)h * M + rowbase) * HD + echk * 8;
#pragma unroll
        for (int i = 0; i < 8; ++i) { const int qi = erow + 4 * i; const v4u w = *(const LAS v4u*)(T0 + qi * 272 + echk * 16);
            *(v4u*)(ob + (((size_t)(l0 + qi) << SH) + res) * HD) = w; }
        if (hi == 0) (G == 0 ? LSE0 : LSE1)[orow * NH + h] = lse2;
    } else {
        const float l0v = LSE0[orow * NH + h], l1v = LSE1[orow * NH + h];
        const bf16* ib0 = O0 + ((size_t)h * M + rowbase) * HD + echk * 8; const bf16* ib1 = O1 + ((size_t)h * M + rowbase) * HD + echk * 8;
#pragma unroll
        for (int hh = 0; hh < 2; ++hh) {
            v4u t0[4], t1[4];
#pragma unroll
            for (int i = 0; i < 4; ++i) { const size_t ro = (((size_t)(l0 + erow + 4 * (4 * hh + i)) << SH) + res) * HD; t0[i] = *(const v4u*)(ib0 + ro); t1[i] = *(const v4u*)(ib1 + ro); }
#pragma unroll
            for (int i = 0; i < 4; ++i) { const int qi = erow + 4 * (4 * hh + i); *(LAS v4u*)(T0 + qi * 272 + echk * 16) = t0[i]; *(LAS v4u*)(T1 + qi * 272 + echk * 16) = t1[i]; }
            asm volatile("" ::: "memory");
        }
        const float mm = fmaxf(fmaxf(l0v, l1v), lse2);
        const float w0 = __builtin_amdgcn_exp2f(l0v - mm), w1 = __builtin_amdgcn_exp2f(l1v - mm), w2 = __builtin_amdgcn_exp2f(lse2 - mm);
        const float wi = 1.0f / (w0 + w1 + w2);
        const float c0 = w0 * wi, c1 = w1 * wi, c2 = w2 * wi * inv;
        LDS_WAIT();
        unsigned y8[16];
#pragma unroll
        for (int dt = 0; dt < 4; ++dt)
#pragma unroll
            for (int rg = 0; rg < 4; ++rg) { const v2u a = *(const LAS v2u*)(T0 + pofs + 64 * dt + 16 * rg), c = *(const LAS v2u*)(T1 + pofs + 64 * dt + 16 * rg);
                const float y0 = c0 * bf_lo(a.x) + c1 * bf_lo(c.x) + c2 * o[dt][4 * rg], y1 = c0 * bf_hi(a.x) + c1 * bf_hi(c.x) + c2 * o[dt][4 * rg + 1];
                const float y2 = c0 * bf_lo(a.y) + c1 * bf_lo(c.y) + c2 * o[dt][4 * rg + 2], y3 = c0 * bf_hi(a.y) + c1 * bf_hi(c.y) + c2 * o[dt][4 * rg + 3];
                y8[4 * dt + rg] = q8x4c((f32x4){y0, y1, y2, y3}, A8SCALE); }
        LDS_WAIT();
#pragma unroll
        for (int dt = 0; dt < 4; ++dt)
#pragma unroll
            for (int rg = 0; rg < 4; ++rg) *(LAS unsigned*)(T0 + r32 * 144 + 4 * hi + 32 * dt + 8 * rg) = y8[4 * dt + rg];
        LDS_WAIT();
        unsigned char* ob = MIX8 + rowbase * DM + h * HD + (ln_ & 7) * 16;
#pragma unroll
        for (int i = 0; i < 4; ++i) { const int qi = (ln_ >> 3) + 8 * i; const v4u w = *(const LAS v4u*)(T0 + qi * 144 + (ln_ & 7) * 16);
            *(v4u*)(ob + (((size_t)(l0 + qi) << SH) + res) * DM) = w; }
    }
    LDS_WAIT();
}

constexpr int PER_PHASE = 9;
struct Args { const float* in[16]; float* out; unsigned char* ws; unsigned mask; unsigned pad; };

__constant__ unsigned char CAND_I[64] = {0,0,0,0,0,0,0,0,0,0,0,0,0,0,0,0, 1,1,1,1,1,1,1,1, 2,2,2,2,2, 3,3,3,3, 4,4,4, 5,5, 6,6, 7,7, 8,9,10,11,12,13,14,15, 0,0,0,0,0,0,0,0,0,0,0,0,0,0};
__constant__ unsigned char CAND_J[64] = {0,1,2,3,4,5,6,7,8,9,10,11,12,13,14,15, 0,1,2,3,4,5,6,7, 0,1,2,3,4, 0,1,2,3, 0,1,2, 0,1, 0,1, 0,1, 0,0,0,0,0,0,0,0, 0,0,0,0,0,0,0,0,0,0,0,0,0,0};

__global__ void __launch_bounds__(NWAVES * 64, 2) fwd_kernel(Args args) {
    extern __shared__ __attribute__((aligned(16))) unsigned char lds_raw[];
    LAS unsigned char* lds = (LAS unsigned char*)lds_raw;
    volatile LAS unsigned* MISC = (volatile LAS unsigned*)(lds + MISC_OFF);
    const int tid0 = threadIdx.x, lane0 = tid0 & 63, wave = __builtin_amdgcn_readfirstlane(tid0 >> 6);
#define PHASE_LANES() int lane; asm volatile("v_mbcnt_lo_u32_b32 %0, -1, 0\n\tv_mbcnt_hi_u32_b32 %0, -1, %0" : "=v"(lane)); const int tid = wave * 64 + lane
    const int G = gridDim.x; const int bx = blockIdx.x;
    const int vcu = (G % 8 == 0) ? (bx % 8) * (G / 8) + bx / 8 : bx;
    const int gw = vcu * NWAVES + wave, NGW = G * NWAVES;
    unsigned char* ws = args.ws;
    unsigned* ctl = (unsigned*)(ws + WS_CTL);
    const float* x = args.in[0]; const float* cvec = args.in[1]; const float* w_ada = args.in[2]; const float* b_ada = args.in[3]; const float* g_mix = args.in[4];
    const float* w_in = args.in[5]; const float* rel_bias = args.in[6]; const float* pool_w = args.in[7]; const float* pool_scale = args.in[8]; const float* w_out = args.in[9];
    const float* g_ffn = args.in[10]; const float* peer_wq = args.in[11]; const float* peer_sk = args.in[12]; const float* peer_u = args.in[13]; const float* peer_v = args.in[14];
    const float* g_final = args.in[15];
    float* out = args.out;
    float* MODV = (float*)(ws + WS_MODV); float* MODP = (float*)(ws + WS_MODP);
    bf16* SKT = (bf16*)(ws + WS_SKT); bf16* PWS = (bf16*)(ws + WS_PWS); bf16* WQSTB = (bf16*)(ws + WS_WQST);     unsigned char* WQST8 = ws + 104 * MiB;     unsigned char* WOUT8 = ws + WS_WOUT2;     unsigned char* WIN8 = ws + WS_WIN8; unsigned char* H8 = ws + WS_H8;
    bf16* WOPT = (bf16*)(ws + WS_WOPT); bf16* WQB = (bf16*)(ws + WS_WQB);
    unsigned char* UB = ws + WS_UB; unsigned char* VB = ws + WS_VB; float* SCL = (float*)(ws + WS_SCL); float* TSC = SCL + 2 * NEXP; float* WQS = TSC + M;         unsigned char* HHI = ws + WS_H; unsigned char* HLO = ws + WS_H + 32 * MiB;     bf16* PIN = (bf16*)(ws + WS_PROJ); bf16* QKVH = (bf16*)(ws + WS_QKVH); unsigned char* MIX8 = ws + WS_MIXIN;
    bf16* O0 = (bf16*)(ws + WS_O0); bf16* O1 = (bf16*)(ws + WS_O1); float* LSE = (float*)(ws + WS_LSE);
    float* SC = (float*)(ws + WS_SC);
    bf16* X1B = (bf16*)(ws + WS_O0);
    bf16* YB = (bf16*)(ws + WS_PROJ + 64 * MiB);

    for (int u = tid0; u < (LDS_BYTES - LDSCTL_OFF) / 4; u += NWAVES * 64) ((LAS unsigned*)(lds + LDSCTL_OFF))[u] = 0u;
    __syncthreads();
    XcdBarrier bar; bar.bar = ctl + CW_BAR; bar.x = 0; bar.st = nullptr;
    if (MK_N_LAUNCHES != PER_PHASE) bar = xcd_barrier_post(ctl + CW_BAR, MISC + 8, wave);
#define GRID_BAR() do { if (MK_N_LAUNCHES != PER_PHASE) xcd_barrier(bar, wave); } while (0)
    const unsigned phmask = args.mask;
#ifndef PH_MASK
#define PH_MASK 0x1ff
#endif
#define IN(k) ((((PH_MASK) >> (k)) & 1) && ((phmask >> (k)) & 1u))
#define BOTH(k) (IN(k) && IN((k) + 1))

    if (IN(0)) {
        PHASE_LANES();
        LAS float* silu = (LAS float*)(lds + RING_OFF);
        for (int i = tid; i < BATCH * DM; i += NWAVES * 64) { const float v = cvec[i]; silu[i] = v / (1.0f + __expf(-v)); }
        __syncthreads();
        for (int task = gw; task < (NMOD / 256) * KS_ADA; task += NGW) {
            const int cg = task % (NMOD / 256), ks = task / (NMOD / 256); const int k0 = ks * (DM / KS_ADA), n0 = cg * 256 + 4 * lane;
            f32x4 a0 = {0.f, 0.f, 0.f, 0.f}, a1 = {0.f, 0.f, 0.f, 0.f};
            const float* wp = w_ada + (size_t)k0 * NMOD + n0;
            static_assert(DM / KS_ADA == 64, "four 16-row batches");
            f32x4 wA[16], wB[16];
#define ADA_LD(W_, b_) _Pragma("unroll") for (int q_ = 0; q_ < 16; ++q_) W_[q_] = *(const f32x4*)(wp + (size_t)(16 * (b_) + q_) * NMOD)
#define ADA_FMA(W_, b_) _Pragma("unroll") for (int q_ = 0; q_ < 16; ++q_) { const float s0 = silu[k0 + 16 * (b_) + q_], s1 = silu[DM + k0 + 16 * (b_) + q_]; a0 += W_[q_] * s0; a1 += W_[q_] * s1; }
            ADA_LD(wA, 0); ADA_LD(wB, 1); ADA_FMA(wA, 0); ADA_LD(wA, 2); ADA_FMA(wB, 1); ADA_LD(wB, 3); ADA_FMA(wA, 2); ADA_FMA(wB, 3);
#undef ADA_LD
#undef ADA_FMA
            *(f32x4*)(MODP + ((size_t)(ks * 2 + 0)) * NMOD + n0) = a0; *(f32x4*)(MODP + ((size_t)(ks * 2 + 1)) * NMOD + n0) = a1;
        }
        __syncthreads();
        {
            LAS float* scr = (LAS float*)(lds + RING_OFF + wave * 16384);
            constexpr int I_QKV = (DM / 64) * (3 * ATTW / 32), I_PIN = (DM / 64) * (POOLW / 32), I_OUTH = (ATTW / 64) * (DM / 32);
            constexpr int NITEMS = I_QKV + I_PIN + 2 * I_OUTH;
            for (int it = gw; it < NITEMS; it += NGW) {
                int r = it;
                if (r < I_QKV + I_PIN) { p0_transpose_item<true>(w_in, INW, INW, WIN8, DM, W8SCALE, scr, r, lane); continue; } r -= I_QKV + I_PIN;
                if (r < I_OUTH) { p0_transpose_item<true>(w_out, DM, DM, WOUT8, DM, WOA8SCALE, scr, r, lane); continue; } r -= I_OUTH;
                p0_transpose_item<false>(w_out + (size_t)ATTW * DM, DM, DM, WOPT, POOLW, 1.f, scr, r, lane);
            }
        }
        for (int i = gw * 64 + lane; i < (DM * PQ + 4 * 512 * 512) / 8; i += NGW * 64) {
            const bool isQ = i < DM * PQ / 8; const int j = isQ ? i : i - DM * PQ / 8;
            const float* src = (isQ ? peer_wq : pool_w) + (size_t)j * 8;
            f32x4 a = *(const f32x4*)src, c = *(const f32x4*)(src + 4);
            if (!isQ) { const int e0 = j * 8; const int gi = e0 >> 18, d0 = e0 & 511; const float* ps = pool_scale + gi * 512 + d0; a = a * *(const f32x4*)ps; c = c * *(const f32x4*)(ps + 4); }
            v4u w; w.x = cvt_pk_bf16(a[0], a[1]); w.y = cvt_pk_bf16(a[2], a[3]); w.z = cvt_pk_bf16(c[0], c[1]); w.w = cvt_pk_bf16(c[2], c[3]);
            *(v4u*)((isQ ? WQB : PWS) + (size_t)j * 8) = w;
        }
        f32x4 vnx[4][4];
#define PEER_LD(r_) do { const float* s_ = ((r_) < NEXP ? peer_u + (size_t)(r_) * DM : peer_v + (size_t)((r_) - NEXP) * DM) + 16 * lane; \
            _Pragma("unroll") for (int i = 0; i < 4; ++i) _Pragma("unroll") for (int q = 0; q < 4; ++q) vnx[i][q] = *(const f32x4*)(s_ + 1024 * i + 4 * q); } while (0)
        if (gw < 2 * NEXP) PEER_LD(gw);
        for (int r = gw; r < 2 * NEXP; r += NGW) {
            const bool isU = r < NEXP; const int e = isU ? r : r - NEXP;
            f32x4 v[4][4]; float mx = 0.f, ss = 0.f;
#pragma unroll
            for (int i = 0; i < 4; ++i)
#pragma unroll
                for (int q = 0; q < 4; ++q) { v[i][q] = vnx[i][q];
                    mx = fmaxf(mx, fmaxf(fmaxf(fabsf(v[i][q][0]), fabsf(v[i][q][1])), fmaxf(fabsf(v[i][q][2]), fabsf(v[i][q][3]))));
                    ss += (v[i][q][0] * v[i][q][0] + v[i][q][1] * v[i][q][1]) + (v[i][q][2] * v[i][q][2] + v[i][q][3] * v[i][q][3]); }
            if (r + NGW < 2 * NEXP) PEER_LD(r + NGW);
#pragma unroll
            for (int o = 1; o < 64; o <<= 1) mx = fmaxf(mx, __shfl_xor(mx, o));
            const int ex = (int)((__float_as_uint(mx) >> 23) & 0xffu);
            float scale = 1.0f, inv = 1.0f;
            if (ex >= 32 && ex <= 230) { const float rms = sqrtf(wave_sum(ss) * (1.0f / DM));
                if (isU) { inv = 0.3352f * rms; scale = 1.0f / inv; }
                else { inv = 0.5f * rms; scale = 1.0f / inv; } }
            if (isU) {
                unsigned char* dst = UB + ((size_t)(lane >> 4) * NEXP + e) * 128 + 8 * (lane & 15);
#pragma unroll
                for (int i = 0; i < 4; ++i) { const unsigned lo = q4x4(v[i][0], scale) | (q4x4(v[i][1], scale) << 16), hi = q4x4(v[i][2], scale) | (q4x4(v[i][3], scale) << 16);
                    *(v2u*)(dst + (size_t)(4 * i) * NEXP * 128) = (v2u){lo, hi}; }
            } else {
                unsigned char* dst = VB + ((size_t)(lane >> 4) * NEXP + e) * 128 + 8 * (lane & 15);
#pragma unroll
                for (int i = 0; i < 4; ++i) { unsigned lo = 0u, hi = 0u;
                    lo = __builtin_amdgcn_cvt_scalef32_pk_fp4_f32(lo, v[i][0][0] * scale, v[i][0][1] * scale, 1.0f, 0); lo = __builtin_amdgcn_cvt_scalef32_pk_fp4_f32(lo, v[i][0][2] * scale, v[i][0][3] * scale, 1.0f, 1);
                    lo = __builtin_amdgcn_cvt_scalef32_pk_fp4_f32(lo, v[i][1][0] * scale, v[i][1][1] * scale, 1.0f, 2); lo = __builtin_amdgcn_cvt_scalef32_pk_fp4_f32(lo, v[i][1][2] * scale, v[i][1][3] * scale, 1.0f, 3);
                    hi = __builtin_amdgcn_cvt_scalef32_pk_fp4_f32(hi, v[i][2][0] * scale, v[i][2][1] * scale, 1.0f, 0); hi = __builtin_amdgcn_cvt_scalef32_pk_fp4_f32(hi, v[i][2][2] * scale, v[i][2][3] * scale, 1.0f, 1);
                    hi = __builtin_amdgcn_cvt_scalef32_pk_fp4_f32(hi, v[i][3][0] * scale, v[i][3][1] * scale, 1.0f, 2); hi = __builtin_amdgcn_cvt_scalef32_pk_fp4_f32(hi, v[i][3][2] * scale, v[i][3][3] * scale, 1.0f, 3);
                    *(v2u*)(dst + (size_t)(4 * i) * NEXP * 128) = (v2u){lo, hi}; }
            }
            if (lane == 0) SCL[r] = inv;
        }
#undef PEER_LD
        for (int i = gw * 64 + lane; i < 2048 * 32; i += NGW * 64) {
            const int n = i >> 5, kc = (i & 31) * 8; const int p = (n >> 7) & 1, pp = kc >> 7;
            v4u w = {0u, 0u, 0u, 0u};
            if (p == pp) { const float* src = peer_sk + (size_t)n * 128 + (kc & 127); const f32x4 a = *(const f32x4*)src, c = *(const f32x4*)(src + 4);
                w.x = cvt_pk_bf16(a[0], a[1]); w.y = cvt_pk_bf16(a[2], a[3]); w.z = cvt_pk_bf16(c[0], c[1]); w.w = cvt_pk_bf16(c[2], c[3]); }
            *(v4u*)(SKT + (size_t)n * 256 + kc) = w;
        }
        if (BOTH(0)) GRID_BAR();
    }

    if (IN(1)) {
        PHASE_LANES();
        for (int i = bx * (NWAVES * 64) + tid; i < BATCH * NMOD; i += G * NWAVES * 64) {
            const int b = i / NMOD, n = i % NMOD; float s = b_ada[n];
#pragma unroll 8
            for (int ks = 0; ks < KS_ADA; ++ks) s += MODP[(size_t)(ks * 2 + b) * NMOD + n];
            const int j = n / DM, c = n % DM;
            MODV[(size_t)(j * 2 + b) * DM + c] = s;
        }
        if (bx < G / 2) {
            pg8::Gemm g{WOPT, PWS, DM, POOLW, 512, POOLW, 512, 2, 512, 1 << 30, 0}; pg8::StaticOrder S; S.init(DM, POOLW, G / 2, bx);
            pg8::EpiI8 E{WOUT8, DM, ATTW, WOP8SCALE};
            pg8::gemm_phase<pg8::EpiI8, pg8::StaticOrder, true>(lds + RING_OFF, g, S, E, wave);
        }
        else {
            pg8::Gemm g{SKT, WQB, PQ, DM, 256, 256, PQ, 1 << 30, 0, 1, 256}; pg8::StaticOrder S; S.init(PQ, DM, G - G / 2, bx - G / 2);
            pg8::EpiBf16 E{WQSTB, DM, 0, 1.0f, nullptr, 0, 0};
            pg8::gemm_phase<pg8::EpiBf16, pg8::StaticOrder, true>(lds + RING_OFF, g, S, E, wave);
        }
        if (BOTH(1)) GRID_BAR();
    }

    if (IN(2)) {
        PHASE_LANES();
        for (int row = gw; row < M; row += NGW) {
            const int b = row / SEQ;
            const f32x4* xr = (const f32x4*)(x + (size_t)row * DM) + lane;
            f32x4 v[16]; float ss = 0.f;
#pragma unroll
            for (int j = 0; j < 16; ++j) { v[j] = xr[64 * j]; ss += (v[j][0] * v[j][0] + v[j][1] * v[j][1]) + (v[j][2] * v[j][2] + v[j][3] * v[j][3]); }
            const float rstd = 1.0f / sqrtf(wave_sum(ss) * (1.0f / DM) + RMS_EPS);
            const f32x4* gp = (const f32x4*)g_mix + lane; const f32x4* shp = (const f32x4*)(MODV + (size_t)(0 * 2 + b) * DM) + lane; const f32x4* scp = (const f32x4*)(MODV + (size_t)(1 * 2 + b) * DM) + lane;
            unsigned* op8 = (unsigned*)(H8 + (size_t)row * DM) + lane;
#pragma unroll
            for (int j = 0; j < 16; ++j) { const f32x4 g4 = gp[64 * j], sh = shp[64 * j], sc = scp[64 * j];
                const f32x4 y = (v[j] * rstd) * g4 * (sc + 1.0f) + sh;
                op8[64 * j] = q8x4c(y, H8SCALE); }
        }
        for (int n = gw; n < PQ; n += NGW) {
            const v2u* wr_ = (const v2u*)(WQSTB + (size_t)n * DM) + lane;
            f32x4 v[16]; float mx = 0.f;
#pragma unroll
            for (int j = 0; j < 16; ++j) { const v2u xw = wr_[64 * j]; v[j] = (f32x4){bf_lo(xw.x), bf_hi(xw.x), bf_lo(xw.y), bf_hi(xw.y)};
                mx = fmaxf(mx, fmaxf(fmaxf(fabsf(v[j][0]), fabsf(v[j][1])), fmaxf(fabsf(v[j][2]), fabsf(v[j][3])))); }
#pragma unroll
            for (int o = 1; o < 64; o <<= 1) mx = fmaxf(mx, __shfl_xor(mx, o));
            mx = fmaxf(mx, 1e-20f);
            const float qs = 127.0f / mx; unsigned* op8 = (unsigned*)(WQST8 + (size_t)n * DM) + lane;
#pragma unroll
            for (int j = 0; j < 16; ++j) op8[64 * j] = q8x4(v[j], qs);
            if (lane == 0) WQS[n] = mx * (1.0f / 127.0f);
        }
        if (BOTH(2)) GRID_BAR();
    }

    if (IN(3)) {
        PHASE_LANES();
        {
            pg8::Gemm g{(const bf16*)H8, (const bf16*)WIN8, M, INW, DM / 2, DM / 2, DM / 2, 1 << 30, 0, 1 << 30, 0}; pg8::StaticOrder S; S.init(M, INW, G, bx);
            pg8::EpiBf16 E{PIN, POOLW, ATTW, QSCALE / (H8SCALE * W8SCALE), QKVH, 3 * ATTW, M, 1.0f / (H8SCALE * W8SCALE), 3 * ATTW};
            pg8::gemm_phase<pg8::EpiBf16, pg8::StaticOrder, true, true>(lds + RING_OFF, g, S, E, wave);
        }
        if (BOTH(3)) GRID_BAR();
    }

    if (IN(4)) {
        PHASE_LANES();
        LAS float* btab = (LAS float*)(lds + SHARED_OFF);
        LAS unsigned char* vt = lds + RING_OFF + wave * ATT_WAVE_BYTES;
        if (!(args.pad & 1u))
        for (int unit = bx; unit < BATCH * NH * (SEQ / 1024); unit += G) {
            const int b = unit >> 7, h = (unit >> 3) & 15, mt = unit & 7;
            __syncthreads();
            for (int i = tid; i < 3 * 256; i += NWAVES * 64) { const int gi = i >> 8, ri = (i & 255) - 32; const int dil = gi == 0 ? 1 : (gi == 1 ? 4 : 16);
                btab[i] = (ri >= 0 && ri <= 128) ? rel_bias[t5_bucket((ri - 64) * dil) * NH + h] * LOG2E : -1e30f; }
            __syncthreads();
            for (int g = 0; g < 3; ++g) {
                if (g == 2) { VM_WAIT(); __syncthreads(); }
                for (int tk = wave; tk < 32; tk += NWAVES) attn_task(g, QKVH, O0, O1, LSE, LSE + (size_t)M * NH, MIX8, btab, vt, b, h, mt, tk, lane);
            }
        }
        if (!(args.pad & 2u))
        for (int i = bx * (NWAVES * 64) + tid; i < BATCH * (SEQ / 8) * (POOLW / 8); i += G * NWAVES * 64) {
            const int cc = i & 255, run = (i >> 8) & (SEQ / 8 - 1), b = i >> 18; const int gi = __builtin_amdgcn_readfirstlane(cc >> 6);
            const int pos0 = run * 8;
            const bf16* base = PIN + (size_t)b * SEQ * POOLW + cc * 8;
            unsigned char* obase = MIX8 + ((size_t)b * SEQ + pos0) * DM + ATTW + cc * 8;
#define POOL_RUN(HW) do { constexpr int NR = 8 + 2 * (HW) - 1; v4u w_[NR]; \
                _Pragma("unroll") for (int q = 0; q < NR; ++q) { const int pp = pos0 - (HW) + q; const int pc = pp < 0 ? 0 : (pp > SEQ - 1 ? SEQ - 1 : pp); w_[q] = *(const v4u*)(base + (size_t)pc * POOLW); } \
                _Pragma("unroll") for (int q = 0; q < NR; ++q) { const int pp = pos0 - (HW) + q; if (pp < 0 || pp >= SEQ) w_[q] = (v4u){0u, 0u, 0u, 0u}; } \
                float s_[8] = {0.f, 0.f, 0.f, 0.f, 0.f, 0.f, 0.f, 0.f}; \
                _Pragma("unroll") for (int q = 0; q < 2 * (HW) - 1; ++q) { s_[0] += bf_lo(w_[q].x); s_[1] += bf_hi(w_[q].x); s_[2] += bf_lo(w_[q].y); s_[3] += bf_hi(w_[q].y); s_[4] += bf_lo(w_[q].z); s_[5] += bf_hi(w_[q].z); s_[6] += bf_lo(w_[q].w); s_[7] += bf_hi(w_[q].w); } \
                _Pragma("unroll") for (int k = 0; k < 8; ++k) { const v4u in_ = w_[k + 2 * (HW) - 1]; \
                    s_[0] += bf_lo(in_.x); s_[1] += bf_hi(in_.x); s_[2] += bf_lo(in_.y); s_[3] += bf_hi(in_.y); s_[4] += bf_lo(in_.z); s_[5] += bf_hi(in_.z); s_[6] += bf_lo(in_.w); s_[7] += bf_hi(in_.w); \
                    const int pos = pos0 + k; const int lo_ = pos - (HW) < 0 ? 0 : pos - (HW), hi_ = pos + (HW) > SEQ ? SEQ : pos + (HW); const float inv = 1.0f / (float)(hi_ - lo_); \
                    const v4u me = w_[k + (HW)]; \
                    const f32x4 lo4_ = {s_[0] * inv - bf_lo(me.x), s_[1] * inv - bf_hi(me.x), s_[2] * inv - bf_lo(me.y), s_[3] * inv - bf_hi(me.y)}, hi4_ = {s_[4] * inv - bf_lo(me.z), s_[5] * inv - bf_hi(me.z), s_[6] * inv - bf_lo(me.w), s_[7] * inv - bf_hi(me.w)}; \
                    const unsigned lo8_ = q8x4c(lo4_, P8SCALE), hi8_ = q8x4c(hi4_, P8SCALE); \
                    *(v2u*)(obase + (size_t)k * DM) = (v2u){lo8_, hi8_}; \
                    const v4u out_ = w_[k]; \
                    s_[0] -= bf_lo(out_.x); s_[1] -= bf_hi(out_.x); s_[2] -= bf_lo(out_.y); s_[3] -= bf_hi(out_.y); s_[4] -= bf_lo(out_.z); s_[5] -= bf_hi(out_.z); s_[6] -= bf_lo(out_.w); s_[7] -= bf_hi(out_.w); } } while (0)
            if (gi == 0) POOL_RUN(1); else if (gi == 1) POOL_RUN(2); else if (gi == 2) POOL_RUN(4); else POOL_RUN(8);
#undef POOL_RUN
        }
        if (BOTH(4)) GRID_BAR();
    }

    if (IN(5)) {
        PHASE_LANES();
        pg8::Gemm g{(const bf16*)MIX8, (const bf16*)WOUT8, M, DM, DM / 2, DM / 2, DM / 2, 1 << 30, 0, 1 << 30, 0}; pg8::StaticOrder S; S.init(M, DM, G, bx);
        pg8::EpiResBf16 E{x, MODV + (size_t)(2 * 2) * DM, X1B, DM, 1.0f / (A8SCALE * WOA8SCALE)};
        pg8::gemm_phase<pg8::EpiResBf16, pg8::StaticOrder, true, true>(lds + RING_OFF, g, S, E, wave);
        if (BOTH(5)) GRID_BAR();
    }

    if (IN(6)) {
        PHASE_LANES();
        for (int row = gw; row < M; row += NGW) {
            const int b = row / SEQ;
            const v4u* xr = (const v4u*)(X1B + (size_t)row * DM) + lane;
            f32x4 v[16]; float ss = 0.f;
#pragma unroll
            for (int j = 0; j < 8; ++j) { const v4u xw = xr[64 * j]; v[2 * j] = (f32x4){bf_lo(xw.x), bf_hi(xw.x), bf_lo(xw.y), bf_hi(xw.y)}; v[2 * j + 1] = (f32x4){bf_lo(xw.z), bf_hi(xw.z), bf_lo(xw.w), bf_hi(xw.w)};
                ss += (v[2 * j][0] * v[2 * j][0] + v[2 * j][1] * v[2 * j][1]) + (v[2 * j][2] * v[2 * j][2] + v[2 * j][3] * v[2 * j][3]);
                ss += (v[2 * j + 1][0] * v[2 * j + 1][0] + v[2 * j + 1][1] * v[2 * j + 1][1]) + (v[2 * j + 1][2] * v[2 * j + 1][2] + v[2 * j + 1][3] * v[2 * j + 1][3]); }
            const float rstd = 1.0f / sqrtf(wave_sum(ss) * (1.0f / DM) + RMS_EPS);
            const f32x4* gp = (const f32x4*)g_ffn + 2 * lane; const f32x4* shp = (const f32x4*)(MODV + (size_t)(3 * 2 + b) * DM) + 2 * lane; const f32x4* scp = (const f32x4*)(MODV + (size_t)(4 * 2 + b) * DM) + 2 * lane;
            v2u* op8 = (v2u*)(H8 + (size_t)row * DM) + lane;
            unsigned* hip = (unsigned*)(HHI + (size_t)row * (DM / 2)) + lane; unsigned* lop = (unsigned*)(HLO + (size_t)row * (DM / 2)) + lane;
            float ymx = 0.f;
#pragma unroll
            for (int j = 0; j < 16; ++j) { const int o_ = 128 * (j >> 1) + (j & 1); const f32x4 g4 = gp[o_], sh = shp[o_], sc = scp[o_];
                const f32x4 y = (v[j] * rstd) * g4 * (sc + 1.0f) + sh; v[j] = y;
                ymx = fmaxf(ymx, fmaxf(fmaxf(fabsf(y[0]), fabsf(y[1])), fmaxf(fabsf(y[2]), fabsf(y[3])))); }
#pragma unroll
            for (int o = 1; o < 64; o <<= 1) ymx = fmaxf(ymx, __shfl_xor(ymx, o));
            ymx = fmaxf(ymx, 1e-20f);
            const float qs = 119.0f / ymx;
#pragma unroll
            for (int j = 0; j < 8; ++j) { const unsigned w0 = q8x4(v[2 * j], qs), w1 = q8x4(v[2 * j + 1], qs);
                op8[64 * j] = (v2u){w0, w1};
                const unsigned t0 = (w0 ^ 0x80808080u) + 0x08080808u, t1 = (w1 ^ 0x80808080u) + 0x08080808u;
                hip[64 * j] = nibs16(((t0 >> 4) & 0x0f0f0f0fu) ^ 0x08080808u) | (nibs16(((t1 >> 4) & 0x0f0f0f0fu) ^ 0x08080808u) << 16);
                lop[64 * j] = nibs16(w0 & 0x0f0f0f0fu) | (nibs16(w1 & 0x0f0f0f0fu) << 16); }
            if (lane == 0) TSC[row] = ymx * (1.0f / 119.0f);
        }
        if (BOTH(6)) GRID_BAR();
    }

    if (IN(7)) {
        PHASE_LANES();
        pg8::Gemm g{(const bf16*)H8, (const bf16*)WQST8, M, PQ, DM / 2, DM / 2, DM / 2, 1 << 30, 0, 1 << 30, 0}; pg8::StaticOrder S; S.init(M, PQ, G, bx);
        pg8::EpiF32RowScale E{SC, PQ, TSC, WQS};
        pg8::gemm_phase<pg8::EpiF32RowScale, pg8::StaticOrder, true, true>(lds + RING_OFF, g, S, E, wave);
        if (BOTH(7)) GRID_BAR();
    }

    if (IN(8)) {
        PHASE_LANES();
        LAS unsigned short* EXPW = (LAS unsigned short*)(lds + RING_OFF);
        LAS float* GACT = (LAS float*)(lds + RING_OFF + 16384);
        LAS unsigned* W = (LAS unsigned*)(lds + RING_OFF + 49152 + wave * 4096);
        LAS unsigned* K1 = W; LAS unsigned* K2 = W + 128;
        LAS float* TV1 = (LAS float*)(W + 256); LAS int* TI1 = (LAS int*)(W + 272); LAS float* TV2 = (LAS float*)(W + 288); LAS int* TI2 = (LAS int*)(W + 304);
        LAS unsigned* CK = W + 320; LAS float* SV = (LAS float*)(W + 384); LAS int* SE = (LAS int*)(W + 400);
        const int c8 = lane & 7, r8 = lane >> 3;
        for (int blk = vcu; blk < M / 64; blk += G) {
            const int tok0 = blk * 64; const int b = tok0 / SEQ;
            const int ph = ((wave >> 2) ^ wave) & 1;
            for (int pass = 0; pass < 2 + ph; ++pass) {
            const int lt = ph ? (pass == 1 ? 2 : 1) : 2;
            const int jb = ph ? (pass == 0 ? 0 : (pass == 1 ? 2 : 6)) : 4 * pass;
            const int nt = 1 << lt;
            const float* sp0 = SC + (size_t)(tok0 + wave * 8 + jb) * PQ + lane;
            float na0 = sp0[0], na1 = sp0[64], nb0 = sp0[128], nb1 = sp0[192];
#pragma unroll 1
            for (int rec = 0; rec < 8 * nt; ++rec) {
                const int tl = wave * 8 + jb + (rec >> 3);
                { const int h = rec & 7;
                    const float a0 = na0, a1 = na1, b0 = nb0, b1 = nb1;
                    { const int nx = rec + 1 < 8 * nt ? rec + 1 : 0; const float* sp = sp0 + (size_t)nx * 256; na0 = sp[0]; na1 = sp[64]; nb0 = sp[128]; nb1 = sp[192]; }
                    unsigned ka0 = (fkey(a0) & ~127u) | (unsigned)(127 - lane), ka1 = (fkey(a1) & ~127u) | (unsigned)(63 - lane);
                    unsigned kb0 = (fkey(b0) & ~127u) | (unsigned)(127 - lane), kb1 = (fkey(b1) & ~127u) | (unsigned)(63 - lane);
                    bitonic128x2(ka0, ka1, kb0, kb1, lane);
                    if (lane >= 56) { K1[127 - 2 * lane] = ka0; K1[126 - 2 * lane] = ka1; K2[127 - 2 * lane] = kb0; K2[126 - 2 * lane] = kb1; }
                    LDS_WAIT();
                    const int ci_i = CAND_I[lane], ci_j = CAND_J[lane];
                    const unsigned kA = K1[ci_i], kB = K2[ci_j];
                    const float cv = fdec(kA) + fdec(kB);
                    const unsigned ck = lane < 50 ? ((fkey(cv) & ~255u) | (unsigned)(255 - (ci_i * 16 + ci_j))) : 0u;
                    CK[lane] = ck;
                    LDS_WAIT();
                    int rc = 0;
#pragma unroll 8
                    for (int kk = 0; kk < 16; ++kk) { const v4u q = ((const LAS v4u*)CK)[kk]; rc += (q.x > ck) + (q.y > ck) + (q.z > ck) + (q.w > ck); }
                    if (lane < 50 && rc < 16) { SV[rc] = cv; SE[rc] = (int)((127u - (kA & 127u)) * 128u + (127u - (kB & 127u))); }
                    LDS_WAIT();
                    const float top0 = SV[0], myv = SV[lane & 15]; const int mye = SE[lane & 15];
                    const float e = __expf(myv - top0);
                    float ssum = e; ssum += __shfl_xor(ssum, 1); ssum += __shfl_xor(ssum, 2); ssum += __shfl_xor(ssum, 4); ssum += __shfl_xor(ssum, 8);
                    if (lane < 16) { EXPW[tl * 128 + h * 16 + lane] = (unsigned short)mye; GACT[tl * 128 + h * 16 + lane] = e / ssum; }
                    LDS_WAIT();
                }
            }
            LAS float* ACC = (LAS float*)(lds + RING_OFF + 81920);
            for (int i = lane; i < nt * 128; i += 64) ACC[(wave * 8 + jb) * 128 + i] = 0.f;
            LDS_WAIT();
            if (!(args.pad & 8u)) {
                v4u gA[16], gB[16]; v4u hA, hB, lA, lB;
#define P10_LOADU(idx, G_, H_, L_) do { const int s_ = (idx) >> lt, j_ = jb + ((idx) & (nt - 1)); const int tl_ = wave * 8 + j_; \
                    const unsigned char* tb_ = UB + (size_t)s_ * NEXP * 128 + 16 * c8; \
                    H_ = *(const v4u*)(HHI + (size_t)(tok0 + tl_) * (DM / 2) + 128 * s_ + 16 * c8); L_ = *(const v4u*)(HLO + (size_t)(tok0 + tl_) * (DM / 2) + 128 * s_ + 16 * c8); \
                    _Pragma("unroll") for (int i = 0; i < 16; ++i) { const unsigned e_ = EXPW[tl_ * 128 + r8 + 8 * i]; G_[i] = *(const v4u*)(tb_ + (size_t)e_ * 128); } } while (0)
#define P10_COMPU(idx, G_, H_, L_) do { const int tl = wave * 8 + jb + ((idx) & (nt - 1)); int p[16]; \
                    _Pragma("unroll") for (int i = 0; i < 16; ++i) { int a_ = 0, b_ = 0; \
                        a_ = __builtin_amdgcn_sdot8((int)G_[i].x, (int)H_.x, a_, false); a_ = __builtin_amdgcn_sdot8((int)G_[i].y, (int)H_.y, a_, false); \
                        a_ = __builtin_amdgcn_sdot8((int)G_[i].z, (int)H_.z, a_, false); a_ = __builtin_amdgcn_sdot8((int)G_[i].w, (int)H_.w, a_, false); \
                        b_ = __builtin_amdgcn_sdot8((int)G_[i].x, (int)L_.x, b_, false); b_ = __builtin_amdgcn_sdot8((int)G_[i].y, (int)L_.y, b_, false); \
                        b_ = __builtin_amdgcn_sdot8((int)G_[i].z, (int)L_.z, b_, false); b_ = __builtin_amdgcn_sdot8((int)G_[i].w, (int)L_.w, b_, false); p[i] = a_ * 16 + b_; } \
                    int q8[8], q4[4], q2[2]; \
                      \
                    _Pragma("unroll") for (int m = 0; m < 8; ++m) { const int kp = (c8 & 4) ? p[m + 8] : p[m]; \
                        unsigned rv_ = __builtin_amdgcn_update_dpp(0u, (unsigned)p[m], 0x104, 0xf, 0x5, false); rv_ = __builtin_amdgcn_update_dpp(rv_, (unsigned)p[m + 8], 0x114, 0xf, 0xa, false); q8[m] = kp + (int)rv_; } \
                    _Pragma("unroll") for (int m = 0; m < 4; ++m) { const int snd = (c8 & 2) ? q8[m] : q8[m + 4], kp = (c8 & 2) ? q8[m + 4] : q8[m]; q4[m] = kp + (int)__builtin_amdgcn_update_dpp(0u, (unsigned)snd, 0x4e, 0xf, 0xf, false); } \
                    _Pragma("unroll") for (int m = 0; m < 2; ++m) { const int snd = (c8 & 1) ? q4[m] : q4[m + 2], kp = (c8 & 1) ? q4[m + 2] : q4[m]; q2[m] = kp + (int)__builtin_amdgcn_update_dpp(0u, (unsigned)snd, 0xb1, 0xf, 0xf, false); } \
                    LAS float* ap = ACC + tl * 128 + r8 + 16 * c8;         \
                    ap[0] += (float)q2[0]; ap[8] += (float)q2[1]; } while (0)
                P10_LOADU(0, gA, hA, lA);
#pragma unroll 1
                for (int idx = 0; idx < 16 * nt; idx += 2) {
                    P10_LOADU(idx + 1, gB, hB, lB);
                    P10_COMPU(idx, gA, hA, lA);
                    if (idx + 2 < 16 * nt) P10_LOADU(idx + 2, gA, hA, lA);
                    P10_COMPU(idx + 1, gB, hB, lB);
                }
#undef P10_LOADU
#undef P10_COMPU
            }
            LDS_WAIT();
            for (int i = lane; i < nt * 128; i += 64) { const int o_ = (wave * 8 + jb) * 128 + i; const unsigned e = EXPW[o_];
                const float a = ACC[o_] * SCL[e] * TSC[tok0 + (o_ >> 7)]; GACT[o_] = gelu_tanh(a) * GACT[o_] * SCL[NEXP + e]; }
            LDS_WAIT();
            LAS float* SSQ = ACC;
            for (int j = 0; j < nt; ++j) SSQ[(wave * 8 + jb + j) * 128 + lane] = 0.f;
            LDS_WAIT();
            const float* gtp = MODV + (size_t)(5 * 2 + b) * DM;
            if (!(args.pad & 16u)) {
                v4u gA[16], gB[16]; float aA[16], aB[16];
#define P10_LOADV(idx, G_, A_) do { const int s_ = (idx) >> lt, j_ = jb + ((idx) & (nt - 1)); const int tl_ = wave * 8 + j_; \
                    const unsigned char* tb_ = VB + (size_t)s_ * NEXP * 128 + 16 * c8; \
                    _Pragma("unroll") for (int i = 0; i < 16; ++i) { const int k_ = tl_ * 128 + r8 + 8 * i; const unsigned e_ = EXPW[k_]; A_[i] = GACT[k_]; G_[i] = *(const v4u*)(tb_ + (size_t)e_ * 128); } } while (0)
#define P10_COMPV(idx, G_, A_) do { const int s_c = (idx) >> lt; const int tl = wave * 8 + jb + ((idx) & (nt - 1)); const int t = tok0 + tl; \
                    const int d = 256 * s_c + 32 * c8 + 2 * r8; \
                    const unsigned xw0 = __builtin_nontemporal_load((const unsigned*)(X1B + (size_t)t * DM + d)), xw1 = __builtin_nontemporal_load((const unsigned*)(X1B + (size_t)t * DM + d + 16)); \
                    const f32x2 gv0 = *(const f32x2*)(gtp + d), gv1 = *(const f32x2*)(gtp + d + 16);     \
                    float ssq = SSQ[tl * 128 + lane]; \
                    _Pragma("unroll") for (int hf = 0; hf < 2; ++hf) {     \
                        f32x2 o8[8]; \
                        _Pragma("unroll") for (int q = 0; q < 8; ++q) o8[q] = (f32x2){0.f, 0.f}; \
                        _Pragma("unroll") for (int i = 0; i < 16; ++i) \
                            _Pragma("unroll") for (int q = 0; q < 2; ++q) { const unsigned w_ = G_[i][2 * hf + q]; \
                                o8[4 * q] += __builtin_amdgcn_cvt_scalef32_pk_f32_fp4(w_, 1.0f, 0) * A_[i]; o8[4 * q + 1] += __builtin_amdgcn_cvt_scalef32_pk_f32_fp4(w_, 1.0f, 1) * A_[i]; \
                                o8[4 * q + 2] += __builtin_amdgcn_cvt_scalef32_pk_f32_fp4(w_, 1.0f, 2) * A_[i]; o8[4 * q + 3] += __builtin_amdgcn_cvt_scalef32_pk_f32_fp4(w_, 1.0f, 3) * A_[i]; } \
                        float p[16], q8[8], q4[4], q2[2]; \
                        _Pragma("unroll") for (int q = 0; q < 8; ++q) { p[2 * q] = o8[q].x; p[2 * q + 1] = o8[q].y; } \
                          \
                        _Pragma("unroll") for (int m = 0; m < 8; ++m) { const auto r_ = __builtin_amdgcn_permlane32_swap(__float_as_uint(p[m]), __float_as_uint(p[m + 8]), false, false); q8[m] = __uint_as_float(r_[0]) + __uint_as_float(r_[1]); } \
                        _Pragma("unroll") for (int m = 0; m < 4; ++m) { const auto r_ = __builtin_amdgcn_permlane16_swap(__float_as_uint(q8[m]), __float_as_uint(q8[m + 4]), false, false); q4[m] = __uint_as_float(r_[0]) + __uint_as_float(r_[1]); } \
                        _Pragma("unroll") for (int m = 0; m < 2; ++m) { const float snd = (r8 & 1) ? q4[m] : q4[m + 2], kp = (r8 & 1) ? q4[m + 2] : q4[m]; q2[m] = kp + __uint_as_float(__builtin_amdgcn_update_dpp(0u, __float_as_uint(snd), 0x128, 0xf, 0xf, false)); } \
                        const unsigned xw = hf ? xw1 : xw0; const f32x2 gv = hf ? gv1 : gv0; \
                        f32x2 y; y.x = bf_lo(xw) + gv.x * q2[0]; y.y = bf_hi(xw) + gv.y * q2[1]; \
                        __builtin_nontemporal_store(cvt_pk_bf16(y.x, y.y), (unsigned*)(YB + (size_t)t * DM + d + 16 * hf)); \
                        ssq += (y.x * y.x + y.y * y.y); } \
                    SSQ[tl * 128 + lane] = ssq; } while (0)
                P10_LOADV(0, gA, aA);
#pragma unroll 1
                for (int idx = 0; idx < 16 * nt; idx += 2) {
                    P10_LOADV(idx + 1, gB, aB);
                    P10_COMPV(idx, gA, aA);
                    if (idx + 2 < 16 * nt) P10_LOADV(idx + 2, gA, aA);
                    P10_COMPV(idx + 1, gB, aB);
                }
#undef P10_LOADV
#undef P10_COMPV
            }
            VM_WAIT(); LDS_WAIT();
            __builtin_amdgcn_fence(__ATOMIC_ACQUIRE, "agent");
            VM_WAIT();
            for (int j = 0; j < nt; ++j) {
                const int tl = wave * 8 + jb + j; const int t = tok0 + tl;
                const float rstd = 1.0f / sqrtf(wave_sum(SSQ[tl * 128 + lane]) * (1.0f / DM) + RMS_EPS);
                f32x4* op = (f32x4*)(out + (size_t)t * DM) + lane; const f32x4* gp = (const f32x4*)g_final + lane; const v2u* yp = (const v2u*)(YB + (size_t)t * DM) + lane;
#pragma unroll 4
                for (int i = 0; i < 16; ++i) { const v2u yw = __builtin_nontemporal_load(yp + 64 * i); const f32x4 y = {bf_lo(yw.x), bf_hi(yw.x), bf_lo(yw.y), bf_hi(yw.y)}; __builtin_nontemporal_store(y * rstd * gp[64 * i], op + 64 * i); }
            }
            LDS_WAIT();
            }
        }
    }
#undef IN
#undef BOTH
#undef GRID_BAR
}

extern "C" void kernel_launch(void* const* d_in, const int* in_sizes, int n_in, void* d_out, int out_size, void* d_ws, size_t ws_size, hipStream_t stream) {
    static int grid = 0;
    if (grid == 0) {
        if (n_in != 16 || in_sizes[0] != M * DM || out_size != M * DM || ws_size < WS_END) {
            fprintf(stderr, "kernel_launch: shape/workspace mismatch: n_in %d in0 %d out %d ws %zu (need %zu)\n", n_in, n_in > 0 ? in_sizes[0] : -1, out_size, ws_size, (size_t)WS_END); grid = -1; return; }
        int dev = 0, cus = 0, per_cu = 0;
        if (hipGetDevice(&dev) != hipSuccess || hipDeviceGetAttribute(&cus, hipDeviceAttributeMultiprocessorCount, dev) != hipSuccess) { grid = -1; return; }
        if (hipFuncSetAttribute((const void*)fwd_kernel, hipFuncAttributeMaxDynamicSharedMemorySize, LDS_BYTES) != hipSuccess) { fprintf(stderr, "kernel_launch: hipFuncSetAttribute failed\n"); grid = -1; return; }
        if (hipOccupancyMaxActiveBlocksPerMultiprocessor(&per_cu, (const void*)fwd_kernel, NWAVES * 64, LDS_BYTES) != hipSuccess || per_cu < 1)
            fprintf(stderr, "kernel_launch: note: occupancy query reports %d workgroups per CU\n", per_cu);
        (void)hipGetLastError();
        grid = cus;
    }
    if (grid < 0) return;
    if (hipMemsetAsync((char*)d_ws + WS_CTL, 0, CTL_ZERO_BYTES, stream) != hipSuccess) { fprintf(stderr, "kernel_launch: memset failed\n"); return; }
    Args a{};
    for (int i = 0; i < 16; ++i) a.in[i] = (const float*)d_in[i];
    a.out = (float*)d_out; a.ws = (unsigned char*)d_ws;
#ifdef PROBE_MASK
    {
#ifndef PROBE_PAD
#define PROBE_PAD 0
#endif
        a.mask = PROBE_MASK; a.pad = PROBE_PAD;
        hipLaunchKernelGGL(fwd_kernel, dim3(grid), dim3(NWAVES * 64), LDS_BYTES, stream, a);
        (void)hipMemsetAsync((char*)d_ws + WS_CTL, 0, CTL_ZERO_BYTES, stream);
    }
#endif
    for (int li = 0; li < MK_N_LAUNCHES; ++li) {
        a.mask = (MK_N_LAUNCHES == PER_PHASE) ? (1u << li) : ((1u << PER_PHASE) - 1u); a.pad = 0;
        hipLaunchKernelGGL(fwd_kernel, dim3(grid), dim3(NWAVES * 64), LDS_BYTES, stream, a);
        const hipError_t le = hipPeekAtLastError();
        if (le != hipSuccess) { fprintf(stderr, "kernel_launch: launch %d failed: %s\n", li, hipGetErrorName(le)); break; }
    }
}
```

```cpp
#include <hip/hip_runtime.h>
#include <cstdio>
#include <cstdint>

#ifndef MK_N_LAUNCHES
#define MK_N_LAUNCHES 1
#endif

#define GAS __attribute__((address_space(1)))
#define LAS __attribute__((address_space(3)))
typedef unsigned short bf16;
typedef unsigned v4u __attribute__((ext_vector_type(4)));
typedef unsigned v2u __attribute__((ext_vector_type(2)));
typedef float f32x4 __attribute__((ext_vector_type(4)));
typedef float f32x2 __attribute__((ext_vector_type(2)));
typedef float f32x16 __attribute__((ext_vector_type(16)));
typedef short bf16x8 __attribute__((ext_vector_type(8)));
typedef short s16x4 __attribute__((ext_vector_type(4)));
typedef __bf16 bf2_t __attribute__((ext_vector_type(2)));

constexpr int BATCH = 2, SEQ = 8192, DM = 4096, M = BATCH * SEQ;
constexpr int NH = 16, HD = 128, ATTW = 2048, POOLW = 2048, INW = 8192;
constexpr int NMOD = 6 * DM;
constexpr int PQ = 2048;
constexpr int NEXP = 16384;
constexpr float RMS_EPS = 1e-6f;
constexpr float LOG2E = 1.4426950408889634f;
constexpr float QSCALE = 0.08838834764831845f * LOG2E;
constexpr float H8SCALE = 16.f, W8SCALE = 2048.f;
constexpr float A8SCALE = 128.f, P8SCALE = 24.f, WOA8SCALE = 256.f, WOP8SCALE = (A8SCALE * WOA8SCALE) / P8SCALE;
constexpr float WQ8SCALE = 1024.f;
constexpr int KS_ADA = 64;

constexpr size_t MiB = 1u << 20;
constexpr float V8MUL = 4.0f, P8MUL = 256.0f;
constexpr float Q8MUL = 16.0f, K8MUL = 2.0f;
constexpr size_t WS_CTL = 0, CTL_ZERO_BYTES = 1 * MiB;
constexpr size_t WS_MODV = 1 * MiB;
constexpr size_t WS_SCL = 2 * MiB;
constexpr size_t WS_MODP = 4 * MiB;
constexpr size_t WS_SKT = 20 * MiB;
constexpr size_t WS_PWS = 22 * MiB;
constexpr size_t WS_WQST = 24 * MiB;
constexpr size_t WS_WOUT2 = 40 * MiB;
constexpr size_t WS_WIN8 = 72 * MiB;
constexpr size_t WS_H8 = 1100 * MiB;
constexpr size_t WS_UB = 136 * MiB;
constexpr size_t WS_VB = 264 * MiB;
constexpr size_t WS_H = 392 * MiB;
constexpr size_t WS_PROJ = 520 * MiB;
constexpr size_t WS_QKVH = 1292 * MiB;
constexpr size_t WS_MIXIN = 776 * MiB;
constexpr size_t WS_WOPT = 904 * MiB;
constexpr size_t WS_WQB = 936 * MiB;
constexpr size_t WS_O0 = 968 * MiB, WS_O1 = 1032 * MiB;
constexpr size_t WS_LSE = 1096 * MiB;
constexpr size_t WS_SC = 1164 * MiB;
constexpr size_t WS_END = 1484 * MiB;

constexpr int RING_OFF = 0, RING_BYTES = 131072;
constexpr int ATT_WAVE_BYTES = 17408;
constexpr int SHARED_OFF = 139264;
constexpr int LDSCTL_OFF = 139264 + 4096, MISC_OFF = LDSCTL_OFF + 320;
constexpr int LDS_BYTES = 147456;
constexpr int NWAVES = 8;
constexpr int CW_BAR = 4096;

#define LDS_WAIT() asm volatile("s_waitcnt lgkmcnt(0)" ::: "memory")
#define VM_WAIT() asm volatile("s_waitcnt vmcnt(0)" ::: "memory")

__device__ __forceinline__ unsigned cvt_pk_bf16(float lo, float hi) { unsigned r; asm volatile("v_cvt_pk_bf16_f32 %0, %1, %2" : "=v"(r) : "v"(lo), "v"(hi)); return r; }
__device__ __forceinline__ float bf_lo(unsigned u) { return __uint_as_float(u << 16); }
__device__ __forceinline__ float bf_hi(unsigned u) { return __uint_as_float(u & 0xffff0000u); }
__device__ __forceinline__ float wave_sum(float v) {
#pragma unroll
    for (int o = 1; o < 64; o <<= 1) v += __shfl_xor(v, o);
    return v;
}

__device__ __forceinline__ unsigned q8x4c(f32x4 v, float s) {
    const unsigned b0 = __float_as_uint(__builtin_amdgcn_fmed3f(v[0] * s, -127.f, 127.f) + 12582912.0f), b1 = __float_as_uint(__builtin_amdgcn_fmed3f(v[1] * s, -127.f, 127.f) + 12582912.0f);
    const unsigned b2 = __float_as_uint(__builtin_amdgcn_fmed3f(v[2] * s, -127.f, 127.f) + 12582912.0f), b3 = __float_as_uint(__builtin_amdgcn_fmed3f(v[3] * s, -127.f, 127.f) + 12582912.0f);
    return (b0 & 0xffu) | ((b1 & 0xffu) << 8) | ((b2 & 0xffu) << 16) | (b3 << 24);
}
__device__ __forceinline__ unsigned q8x4(f32x4 v, float s) {
    const unsigned b0 = __float_as_uint(v[0] * s + 12582912.0f), b1 = __float_as_uint(v[1] * s + 12582912.0f), b2 = __float_as_uint(v[2] * s + 12582912.0f), b3 = __float_as_uint(v[3] * s + 12582912.0f);
    return (b0 & 0xffu) | ((b1 & 0xffu) << 8) | ((b2 & 0xffu) << 16) | (b3 << 24);
}
__device__ __forceinline__ int hw_lane() { int l; asm volatile("v_mbcnt_lo_u32_b32 %0, -1, 0\n\tv_mbcnt_hi_u32_b32 %0, -1, %0" : "=v"(l)); return l; }
__device__ __forceinline__ unsigned q4x4(f32x4 v, float s) {
    const unsigned b0 = __float_as_uint(__builtin_amdgcn_fmed3f(v[0] * s, -8.f, 7.f) + 12582912.0f), b1 = __float_as_uint(__builtin_amdgcn_fmed3f(v[1] * s, -8.f, 7.f) + 12582912.0f);
    const unsigned b2 = __float_as_uint(__builtin_amdgcn_fmed3f(v[2] * s, -8.f, 7.f) + 12582912.0f), b3 = __float_as_uint(__builtin_amdgcn_fmed3f(v[3] * s, -8.f, 7.f) + 12582912.0f);
    return (b0 & 15u) | ((b1 & 15u) << 4) | ((b2 & 15u) << 8) | ((b3 & 15u) << 12);
}
__device__ __forceinline__ unsigned nibs16(unsigned x) { x = (x | (x >> 4)) & 0x00ff00ffu; return (x | (x >> 8)) & 0xffffu; }
namespace pg8 {
typedef unsigned short bf16_t;
typedef int v4i_t __attribute__((ext_vector_type(4)));
typedef int v8i_t __attribute__((ext_vector_type(8)));
constexpr int BM = 256, BK = 64, HALF = 128, HTB = HALF * BK * 2, STAGE_BYTES = 8 * HTB, NXCD = 8, WGM = 8;

__host__ __device__ __forceinline__ int lds_byte(int r, int c) { const int st = (r >> 4) * 2 + (c >> 5), rr = r & 15, cc = c & 31, ob = rr * 64 + cc * 2; return st * 1024 + (ob ^ (((ob >> 9) & 1) << 5)); }
__host__ __device__ __forceinline__ void stage_rc(int b, int& R, int& C) { const int st = b / 1024, sb = b % 1024, swz = sb ^ (((sb >> 9) & 1) << 5); R = (st >> 1) * 16 + swz / 64; C = (st & 1) * 32 + (swz % 64) / 2; }
__host__ __device__ __forceinline__ int perm32(int rho) { const int n = rho >> 4, i = rho & 15; return 8 * (i >> 2) + 4 * n + (i & 3); }

template <int NF> __device__ __forceinline__ void pg8_ldfrag16(bf16x8 (&dst)[NF][2], const LAS unsigned char* base, int off) {
#pragma unroll
    for (int m = 0; m < NF; ++m)
#pragma unroll
        for (int k = 0; k < 2; ++k) dst[m][k] = *(const LAS bf16x8*)(base + off + m * 2048 + k * 1024);
}
__device__ __forceinline__ void pg8_mma16(f32x4 (&acc)[4][2], const bf16x8 (&At)[4][2], const bf16x8 (&Bt)[2][2]) {
#pragma unroll
    for (int m = 0; m < 4; ++m)
#pragma unroll
        for (int n = 0; n < 2; ++n)
#pragma unroll
            for (int k = 0; k < 2; ++k) acc[m][n] = __builtin_amdgcn_mfma_f32_16x16x32_bf16(Bt[n][k], At[m][k], acc[m][n], 0, 0, 0);
}
__device__ __forceinline__ void pg8_mma8(v4i_t (&acc)[4][2], const bf16x8 (&At)[4][2], const bf16x8 (&Bt)[2][2]) {
#pragma unroll
    for (int m = 0; m < 4; ++m)
#pragma unroll
        for (int n = 0; n < 2; ++n)
#pragma unroll
            for (int k = 0; k < 2; ++k) acc[m][n] = __builtin_amdgcn_mfma_i32_16x16x64_i8(__builtin_bit_cast(v4i_t, Bt[n][k]), __builtin_bit_cast(v4i_t, At[m][k]), acc[m][n], 0, 0, 0);
}
struct Unit { int pm, pn; };
struct Gemm { const bf16_t* A; const bf16_t* Bt; int M, N, K, lda, ldb, agrp_div, agrp_cols, bgrp_div, bgrp_cols; };

struct StaticOrder {
    int nM, nN, nwg, G, c;
    __host__ __device__ void init(int M_, int N_, int G_, int c_) { nM = M_ / BM; nN = N_ / BM; nwg = nM * nN; G = G_; c = c_; }
    __host__ __device__ bool next(int i, Unit& u) const {
        const long L = (long)i * G + c; if (L >= nwg) return false;
        int wgid = (int)L; { const int q = nwg / NXCD, r = nwg % NXCD, xcd = wgid % NXCD, off = wgid / NXCD; wgid = (xcd < r ? xcd * (q + 1) : r * (q + 1) + (xcd - r) * q) + off; }
        const int nig = WGM * nN, gid = wgid / nig, fm = gid * WGM, gsz = (nM - fm) < WGM ? (nM - fm) : WGM;
        u.pm = fm + ((wgid % nig) % gsz); u.pn = (wgid % nig) / gsz; return true;
    }
    __device__ __forceinline__ void a_ready(const Unit&) const {}
    __device__ __forceinline__ void done(const Unit&) const {}
};

struct EpiBf16 {
    static constexpr bool PERM = true, AFTER_DRAIN = false;
    bf16_t* O; int ldc; int scale_cols; float scale0; bf16_t* HM; int hm_cols; int hm_rows; float scale1 = 1.0f;
    int f8_cols = 0;
    __device__ __forceinline__ void operator()(const f32x4 (&acc)[2][2][4][2], const Unit& u, int wr, int wc, int fr, int fq) const {
        const int row0 = u.pm * BM + wr * 64 + fr; const int colt = u.pn * BM;
        const float sc = (colt < scale_cols) ? scale0 : scale1;
        const bool hm = colt < hm_cols;
        const int cw = wc * 32 + 8 * fq;
        bf16_t* base = hm ? HM + (size_t)(colt / HALF) * hm_rows * HALF + cw : O + (colt - hm_cols) + cw;
        const size_t rpitch = hm ? (size_t)HALF : (size_t)ldc, hstep = hm ? (size_t)hm_rows * HALF : (size_t)HALF;
        if (colt < f8_cols) {
            const float s8 = sc * ((colt < scale_cols) ? Q8MUL : (colt < 2 * scale_cols ? K8MUL : V8MUL));
            unsigned char* b8 = (unsigned char*)HM + (size_t)(colt / HALF) * hm_rows * HALF + cw;
#pragma unroll
            for (int ai = 0; ai < 2; ++ai)
#pragma unroll
                for (int m = 0; m < 4; ++m) { unsigned char* rowp = b8 + (size_t)(row0 + ai * HALF + m * 16) * HALF;
#pragma unroll
                    for (int bj = 0; bj < 2; ++bj) { const f32x4 v0 = acc[ai][bj][m][0] * s8, v1 = acc[ai][bj][m][1] * s8;
                        int lo = 0, hi = 0;
                        lo = __builtin_amdgcn_cvt_pk_fp8_f32(v0[0], v0[1], lo, false); lo = __builtin_amdgcn_cvt_pk_fp8_f32(v0[2], v0[3], lo, true);
                        hi = __builtin_amdgcn_cvt_pk_fp8_f32(v1[0], v1[1], hi, false); hi = __builtin_amdgcn_cvt_pk_fp8_f32(v1[2], v1[3], hi, true);
                        *(v2u*)(rowp + (size_t)bj * hm_rows * HALF) = (v2u){(unsigned)lo, (unsigned)hi}; } }
            return;
        }
#pragma unroll
        for (int ai = 0; ai < 2; ++ai)
#pragma unroll
            for (int m = 0; m < 4; ++m) { bf16_t* rowp = base + (size_t)(row0 + ai * HALF + m * 16) * rpitch;
#pragma unroll
                for (int bj = 0; bj < 2; ++bj) { f32x4 v0 = acc[ai][bj][m][0] * sc, v1 = acc[ai][bj][m][1] * sc;
                    v4u w; w.x = cvt_pk_bf16(v0[0], v0[1]); w.y = cvt_pk_bf16(v0[2], v0[3]); w.z = cvt_pk_bf16(v1[0], v1[1]); w.w = cvt_pk_bf16(v1[2], v1[3]);
                    *(v4u*)(rowp + bj * hstep) = w; } }
    }
};
struct EpiBf16ColScale {
    static constexpr bool PERM = true, AFTER_DRAIN = false;
    bf16_t* O; int ldc; int coff; const float* cs;
    __device__ __forceinline__ void operator()(const f32x4 (&acc)[2][2][4][2], const Unit& u, int wr, int wc, int fr, int fq) const {
        const int row0 = u.pm * BM + wr * 64 + fr; const int col0 = u.pn * BM + wc * 32 + 8 * fq;
        f32x4 sv[2][2];
#pragma unroll
        for (int bj = 0; bj < 2; ++bj)
#pragma unroll
            for (int n = 0; n < 2; ++n) sv[bj][n] = *(const f32x4*)(cs + col0 + bj * HALF + 4 * n);
#pragma unroll
        for (int ai = 0; ai < 2; ++ai)
#pragma unroll
            for (int m = 0; m < 4; ++m) { bf16_t* rowp = O + (size_t)(row0 + ai * HALF + m * 16) * ldc + coff + col0;
#pragma unroll
                for (int bj = 0; bj < 2; ++bj) { f32x4 v0 = acc[ai][bj][m][0] * sv[bj][0], v1 = acc[ai][bj][m][1] * sv[bj][1];
                    v4u w; w.x = cvt_pk_bf16(v0[0], v0[1]); w.y = cvt_pk_bf16(v0[2], v0[3]); w.z = cvt_pk_bf16(v1[0], v1[1]); w.w = cvt_pk_bf16(v1[2], v1[3]);
                    *(v4u*)(rowp + bj * HALF) = w; } }
    }
};
struct EpiI8 {
    static constexpr bool PERM = true, AFTER_DRAIN = false;
    unsigned char* O; int ldc; int coff; float scale;
    __device__ __forceinline__ void operator()(const f32x4 (&acc)[2][2][4][2], const Unit& u, int wr, int wc, int fr, int fq) const {
        const int row0 = u.pm * BM + wr * 64 + fr; const int col0 = u.pn * BM + wc * 32 + 8 * fq;
#pragma unroll
        for (int ai = 0; ai < 2; ++ai)
#pragma unroll
            for (int m = 0; m < 4; ++m) { unsigned char* rowp = O + (size_t)(row0 + ai * HALF + m * 16) * ldc + coff + col0;
#pragma unroll
                for (int bj = 0; bj < 2; ++bj) *(v2u*)(rowp + bj * HALF) = (v2u){q8x4c(acc[ai][bj][m][0], scale), q8x4c(acc[ai][bj][m][1], scale)}; }
    }
};
struct EpiF32RowScale {
    static constexpr bool PERM = false, AFTER_DRAIN = false;
    float* O; int ldc; const float* rs; const float* cs;
    __device__ __forceinline__ void operator()(const f32x4 (&acc)[2][2][4][2], const Unit& u, int wr, int wc, int fr, int fq) const {
        const int row0 = u.pm * BM + wr * 64 + fr; const int col0 = u.pn * BM + wc * 32 + 4 * fq;
        f32x4 cv[2][2];
#pragma unroll
        for (int bj = 0; bj < 2; ++bj)
#pragma unroll
            for (int n = 0; n < 2; ++n) cv[bj][n] = *(const f32x4*)(cs + col0 + bj * HALF + n * 16);
#pragma unroll
        for (int ai = 0; ai < 2; ++ai)
#pragma unroll
            for (int m = 0; m < 4; ++m) { const int row = row0 + ai * HALF + m * 16; const float r = rs[row]; const size_t off = (size_t)row * ldc + col0;
#pragma unroll
                for (int bj = 0; bj < 2; ++bj)
#pragma unroll
                    for (int n = 0; n < 2; ++n) *(f32x4*)(O + off + bj * HALF + n * 16) = acc[ai][bj][m][n] * cv[bj][n] * r; }
    }
};
struct EpiResBf16 {
    static constexpr bool PERM = true, AFTER_DRAIN = false;
    const float* X; const float* gate; bf16_t* O; int ldc; float ascale;
    __device__ __forceinline__ void operator()(const f32x4 (&acc)[2][2][4][2], const Unit& u, int wr, int wc, int fr, int fq) const {
        const int row0 = u.pm * BM + wr * 64 + fr; const int col0 = u.pn * BM + wc * 32 + 8 * fq; const int b = (u.pm * BM) / SEQ;
        f32x4 gv[2][2];
#pragma unroll
        for (int bj = 0; bj < 2; ++bj)
#pragma unroll
            for (int n = 0; n < 2; ++n) gv[bj][n] = *(const f32x4*)(gate + (size_t)b * DM + col0 + bj * HALF + 4 * n) * ascale;
#pragma unroll
        for (int ai = 0; ai < 2; ++ai)
#pragma unroll
            for (int m = 0; m < 4; ++m) { const size_t off = (size_t)(row0 + ai * HALF + m * 16) * ldc + col0;
#pragma unroll
                for (int bj = 0; bj < 2; ++bj) { const f32x4 x0 = *(const f32x4*)(X + off + bj * HALF), x1 = *(const f32x4*)(X + off + bj * HALF + 4);
                    const f32x4 v0 = x0 + gv[bj][0] * acc[ai][bj][m][0], v1 = x1 + gv[bj][1] * acc[ai][bj][m][1];
                    v4u w; w.x = cvt_pk_bf16(v0[0], v0[1]); w.y = cvt_pk_bf16(v0[2], v0[3]); w.z = cvt_pk_bf16(v1[0], v1[1]); w.w = cvt_pk_bf16(v1[2], v1[3]);
                    *(v4u*)(O + off + bj * HALF) = w; } }
    }
};
struct EpiResF32 {
    static constexpr bool PERM = false, AFTER_DRAIN = false;
    const float* X; const float* gate; float* O; int ldc;
    __device__ __forceinline__ void operator()(const f32x4 (&acc)[2][2][4][2], const Unit& u, int wr, int wc, int fr, int fq) const {
        const int row0 = u.pm * BM + wr * 64 + fr; const int col0 = u.pn * BM + wc * 32 + 4 * fq; const int b = (u.pm * BM) / SEQ;
        f32x4 gv[2][2];
#pragma unroll
        for (int bj = 0; bj < 2; ++bj)
#pragma unroll
            for (int n = 0; n < 2; ++n) gv[bj][n] = *(const f32x4*)(gate + (size_t)b * DM + col0 + bj * HALF + n * 16);
#pragma unroll
        for (int ai = 0; ai < 2; ++ai)
#pragma unroll
            for (int m = 0; m < 4; ++m) { const size_t off = (size_t)(row0 + ai * HALF + m * 16) * ldc + col0;
#pragma unroll
                for (int bj = 0; bj < 2; ++bj)
#pragma unroll
                    for (int n = 0; n < 2; ++n) { const f32x4 xv = *(const f32x4*)(X + off + bj * HALF + n * 16);
                        *(f32x4*)(O + off + bj * HALF + n * 16) = xv + gv[bj][n] * acc[ai][bj][m][n]; } }
    }
};
struct EpiF32 {
    static constexpr bool PERM = false, AFTER_DRAIN = false;
    float* O; int ldc;
    __device__ __forceinline__ void operator()(const f32x4 (&acc)[2][2][4][2], const Unit& u, int wr, int wc, int fr, int fq) const {
        const int row0 = u.pm * BM + wr * 64 + fr; const int col0 = u.pn * BM + wc * 32 + 4 * fq;
#pragma unroll
        for (int ai = 0; ai < 2; ++ai)
#pragma unroll
            for (int m = 0; m < 4; ++m) { const size_t off = (size_t)(row0 + ai * HALF + m * 16) * ldc + col0;
#pragma unroll
                for (int bj = 0; bj < 2; ++bj)
#pragma unroll
                    for (int n = 0; n < 2; ++n) *(f32x4*)(O + off + bj * HALF + n * 16) = acc[ai][bj][m][n]; }
    }
};

template <class Epi, class Sched, bool ALIGN_EPI, bool I8 = false>
__device__ __forceinline__ void gemm_phase(LAS unsigned char* lds, const Gemm g, const Sched& S, const Epi& E, const int wave_id) {
    const int wid = wave_id, lane = hw_lane(), tid = wid * 64 + lane,
              wr = wid >> 2, wc = wid & 3, fr = lane & 15, fq = lane >> 4;
    const int K = g.K, nt = K / BK;
    unsigned voffA, voffB;
    { int R, C; stage_rc(tid * 16, R, C); const int Rb = Epi::PERM ? ((R & ~31) + perm32(R & 31)) : R;
      voffA = (unsigned)(R * g.lda + C) * 2u; voffB = (unsigned)(Rb * g.ldb + C) * 2u; }
    const size_t pstepA = (size_t)64 * g.lda * 2, pstepB = (size_t)64 * g.ldb * 2;
    const size_t kstep = (size_t)(BK * 2);
    const size_t hstepA = (size_t)HALF * g.lda * 2, hstepB = (size_t)HALF * g.ldb * 2;
    const size_t tstepA = 2 * hstepA, tstepB = 2 * hstepB;
    const unsigned ldsw = (unsigned)wid * 1024u;
    const int aoff = lds_byte(wr * 64 + fr, fq * 8), boff = lds_byte(wc * 32 + fr, fq * 8);
#define PG8_SA(b, h) (((b) * 2 + (h)) * HTB)
#define PG8_SB(b, h) ((4 + (b) * 2 + (h)) * HTB)
#define PG8_STAGE(bufoff, gbase, voff) do { _Pragma("unroll") for (int _i = 0; _i < 2; ++_i) \
        __builtin_amdgcn_global_load_lds((const unsigned*)((const char*)(gbase) + (size_t)_i * pstep_##voff + (voff)), (LAS unsigned*)(lds + (bufoff) + ldsw + _i * 8192), 16, 0, 0); } while (0)
#define pstep_voffA pstepA
#define pstep_voffB pstepB
#define PG8_LDA(dst, b, h) pg8_ldfrag16<4>(dst, lds + PG8_SA(b, h), aoff)
#define PG8_LDB(dst, b, h) pg8_ldfrag16<2>(dst, lds + PG8_SB(b, h), boff)
#define PG8_MMA(ai, bj, At, Bt) do { __builtin_amdgcn_s_setprio(1); if constexpr (I8) pg8_mma8(acci[ai][bj], At, Bt); else pg8_mma16(acc[ai][bj], At, Bt); __builtin_amdgcn_s_setprio(0); } while (0)
#define PG8_WAIT_V(n) asm volatile("s_waitcnt vmcnt(" #n ")" ::: "memory")
#define PG8_WAIT_L(n) asm volatile("s_waitcnt lgkmcnt(" #n ")" ::: "memory")
#define PG8_BAR __builtin_amdgcn_s_barrier()
#define PG8_SCHED __builtin_amdgcn_sched_barrier(0)
#define PG8_ABASE(u) ((const char*)g.A + (size_t)(u).pm * tstepA + (size_t)((u).pn / g.agrp_div) * (size_t)g.agrp_cols * 2)
#define PG8_BBASE(u) ((const char*)g.Bt + (size_t)(u).pn * tstepB + (size_t)((u).pm / g.bgrp_div) * (size_t)g.bgrp_cols * 2)
    Unit cur, nxt; int ui = 0;
    if (!S.next(0, cur)) return;
    f32x4 acc[2][2][4][2]; v4i_t acci[2][2][4][2];
#pragma unroll
    for (int a = 0; a < 2; ++a)
#pragma unroll
        for (int b = 0; b < 2; ++b)
#pragma unroll
            for (int m = 0; m < 4; ++m)
#pragma unroll
                for (int n = 0; n < 2; ++n) { acc[a][b][m][n] = (f32x4){0.f, 0.f, 0.f, 0.f}; acci[a][b][m][n] = (v4i_t){0, 0, 0, 0}; }
    bf16x8 At[4][2], B0[2][2], B1[2][2];
    const char* cA = PG8_ABASE(cur); const char* cB = PG8_BBASE(cur);
    S.a_ready(cur);
    PG8_STAGE(PG8_SB(0, 0), cB, voffB); PG8_STAGE(PG8_SB(0, 1), cB + hstepB, voffB); PG8_STAGE(PG8_SA(0, 0), cA, voffA); PG8_STAGE(PG8_SA(0, 1), cA + hstepA, voffA);
    if (wr == 1) PG8_BAR;
    PG8_WAIT_V(2); PG8_BAR;
    PG8_STAGE(PG8_SB(1, 0), cB + kstep, voffB); PG8_STAGE(PG8_SA(1, 0), cA + kstep, voffA); PG8_STAGE(PG8_SB(1, 1), cB + hstepB + kstep, voffB);
    PG8_WAIT_V(6); PG8_BAR;
    for (;;) {
        const bool has_next = S.next(ui + 1, nxt);
        const char* nA = has_next ? PG8_ABASE(nxt) : cA; const char* nB = has_next ? PG8_BBASE(nxt) : cB;
        for (int t = 0; t < nt; t += 2) {
            const bool last = (t == nt - 2);
            const char* a1 = cA + (size_t)(t + 1) * kstep;
            const char* a2 = last ? nA : cA + (size_t)(t + 2) * kstep; const char* b2 = last ? nB : cB + (size_t)(t + 2) * kstep;
            const char* a3 = a2 + kstep; const char* b3 = b2 + kstep;
            if (last && has_next) S.a_ready(nxt);
            PG8_LDB(B0, 0, 0); PG8_LDB(B1, 0, 1); PG8_SCHED; PG8_LDA(At, 0, 0); PG8_STAGE(PG8_SA(1, 1), a1 + hstepA, voffA);
            PG8_WAIT_V(8); PG8_WAIT_L(0); PG8_BAR; PG8_MMA(0, 0, At, B0); PG8_MMA(0, 1, At, B1); PG8_BAR; PG8_SCHED;
            PG8_LDA(At, 0, 1); PG8_STAGE(PG8_SB(0, 0), b2, voffB); PG8_STAGE(PG8_SB(0, 1), b2 + hstepB, voffB); PG8_STAGE(PG8_SA(0, 0), a2, voffA);
            PG8_WAIT_V(8); PG8_WAIT_L(0); PG8_BAR; PG8_MMA(1, 0, At, B0); PG8_MMA(1, 1, At, B1); PG8_BAR; PG8_SCHED;
            PG8_LDB(B0, 1, 0); PG8_LDB(B1, 1, 1); PG8_SCHED; PG8_LDA(At, 1, 0); PG8_STAGE(PG8_SA(0, 1), a2 + hstepA, voffA);
            PG8_WAIT_V(8); PG8_WAIT_L(0); PG8_BAR; PG8_MMA(0, 0, At, B0); PG8_MMA(0, 1, At, B1); PG8_BAR; PG8_SCHED;
            PG8_LDA(At, 1, 1); PG8_STAGE(PG8_SB(1, 0), b3, voffB); PG8_STAGE(PG8_SB(1, 1), b3 + hstepB, voffB); PG8_STAGE(PG8_SA(1, 0), a3, voffA);
            PG8_WAIT_V(8); PG8_WAIT_L(0); PG8_BAR; PG8_MMA(1, 0, At, B0); PG8_MMA(1, 1, At, B1); PG8_BAR; PG8_SCHED;
        }
        if constexpr (ALIGN_EPI) { if (wr == 0) PG8_BAR; }
        if constexpr (I8) {
#pragma unroll
            for (int a = 0; a < 2; ++a)
#pragma unroll
                for (int b = 0; b < 2; ++b)
#pragma unroll
                    for (int m = 0; m < 4; ++m)
#pragma unroll
                        for (int n = 0; n < 2; ++n) acc[a][b][m][n] = __builtin_convertvector(acci[a][b][m][n], f32x4);
        }
        E(acc, cur, wr, wc, fr, fq);
        S.done(cur);
        if (!has_next) break;
#pragma unroll
        for (int a = 0; a < 2; ++a)
#pragma unroll
            for (int b = 0; b < 2; ++b)
#pragma unroll
                for (int m = 0; m < 4; ++m)
#pragma unroll
                    for (int n = 0; n < 2; ++n) { acc[a][b][m][n] = (f32x4){0.f, 0.f, 0.f, 0.f}; acci[a][b][m][n] = (v4i_t){0, 0, 0, 0}; }
        cur = nxt; cA = nA; cB = nB; ++ui;
        if constexpr (ALIGN_EPI) { if (wr == 1) PG8_BAR; }
    }
    PG8_WAIT_V(0);
    if constexpr (!ALIGN_EPI) { if (wr == 0) PG8_BAR; }
    PG8_BAR;
#undef PG8_SA
#undef PG8_SB
#undef PG8_STAGE
#undef pstep_voffA
#undef pstep_voffB
#undef PG8_LDA
#undef PG8_LDB
#undef PG8_MMA
#undef PG8_WAIT_V
#undef PG8_WAIT_L
#undef PG8_BAR
#undef PG8_SCHED
#undef PG8_ABASE
#undef PG8_BBASE
}
}

#define XB_TMO      128
#define XB_XCNT(j)  (256  + 64 * (j))
#define XB_XSUB(j)  (1280 + 64 * (j))
#define XB_XGEN(j)  (2304 + 64 * (j))
#define XB_TOP      3328
#define XB_TOPGEN   3392
#define XCD_BAR_WORDS 3456
#define XB_SPIN_CAP (1u << 18)

__device__ __forceinline__ unsigned xb_ld(unsigned* p)              { return __hip_atomic_load(p, __ATOMIC_RELAXED, __HIP_MEMORY_SCOPE_AGENT); }
__device__ __forceinline__ unsigned xb_add(unsigned* p, unsigned v) { return __hip_atomic_fetch_add(p, v, __ATOMIC_RELAXED, __HIP_MEMORY_SCOPE_AGENT); }
__device__ __forceinline__ unsigned xb_xcc_id() { return (unsigned)__builtin_amdgcn_s_getreg((3 << 11) | 20) & 0xFu; }
#define XB_SPIN(cond, bar) do { unsigned _sp = 0; while (cond) { __builtin_amdgcn_s_sleep(1); \
    if ((++_sp & 255u) == 0u) { if (xb_ld(&(bar)[XB_TMO])) break; if (_sp > XB_SPIN_CAP) { atomicAdd(&(bar)[XB_TMO], 1u); break; } } } } while (0)

struct XcdBarrier { unsigned* bar; unsigned x; volatile LAS unsigned* st; };

__device__ __forceinline__ XcdBarrier xcd_barrier_post(unsigned* bar, volatile LAS unsigned* st, const int wave_id) {
    XcdBarrier b; b.bar = bar; b.x = xb_xcc_id(); b.st = st;
    if (wave_id == 0 && hw_lane() == 0) (void)xb_add(&bar[XB_XCNT(b.x)], 1u);
    return b;
}
__device__ __forceinline__ void xcd_barrier_complete(unsigned* bar, unsigned x, unsigned& nloc, unsigned& nx) {
    const unsigned G = gridDim.x * gridDim.y * gridDim.z;
    unsigned sum, cnt, mine, sp = 0u;
    for (;;) {
        sum = 0u; cnt = 0u; mine = 0u;
#pragma unroll
        for (unsigned j = 0; j < 16; ++j) { const unsigned c = xb_ld(&bar[XB_XCNT(j)]); sum += c; cnt += (c > 0u) ? 1u : 0u; mine = (j == x) ? c : mine; }
        if (sum == G) break;
        __builtin_amdgcn_s_sleep(1);
        if ((++sp & 255u) == 0u) { if (xb_ld(&bar[XB_TMO])) break; if (sp > XB_SPIN_CAP) { atomicAdd(&bar[XB_TMO], 1u); break; } }
    }
    nloc = mine > 0u ? mine : 1u; nx = cnt > 0u ? cnt : 1u;
}
__device__ __forceinline__ void xcd_barrier(const XcdBarrier& b, const int wave_id) {
    asm volatile("s_waitcnt vmcnt(0)" ::: "memory");
    __syncthreads();
    if (wave_id == 0 && hw_lane() == 0) {
        unsigned* bar = b.bar;
        __builtin_amdgcn_s_waitcnt(0);
        unsigned nloc = b.st[0], nx = b.st[1];
        if (nloc == 0u) { xcd_barrier_complete(bar, b.x, nloc, nx); b.st[0] = nloc; b.st[1] = nx; }
        const unsigned old = xb_add(&bar[XB_XSUB(b.x)], 1u);
        const unsigned gen = old / nloc;
        if (old + 1u == (gen + 1u) * nloc) {
            __builtin_amdgcn_fence(__ATOMIC_RELEASE, "agent");
            asm volatile("s_waitcnt vmcnt(0)" ::: "memory");
            const unsigned og = xb_add(&bar[XB_TOP], 1u);
            const unsigned tg = og / nx;
            if (og + 1u == (tg + 1u) * nx) xb_add(&bar[XB_TOPGEN], 1u);
            else XB_SPIN(xb_ld(&bar[XB_TOPGEN]) == tg, bar);
            __builtin_amdgcn_fence(__ATOMIC_ACQUIRE, "agent");
            xb_add(&bar[XB_XGEN(b.x)], 1u);
            asm volatile("s_waitcnt vmcnt(0)" ::: "memory");
        } else {
            XB_SPIN(xb_ld(&bar[XB_XGEN(b.x)]) == gen, bar);
            __builtin_amdgcn_fence(__ATOMIC_ACQUIRE, "agent");
            asm volatile("s_waitcnt vmcnt(0)" ::: "memory");
        }
    }
    __syncthreads();
}

template <bool F8>
__device__ __forceinline__ void p0_transpose_item(const float* W, int ldw, int N, void* WTv, int ldt, float scale, LAS float* scr, int item, int lane) {
    const int nblk = N / 32, kb = item / nblk, nb = item % nblk, k0 = 64 * kb, n0 = 32 * nb;
#pragma unroll 8
    for (int i = 0; i < 32; ++i) { const int kk = 2 * i + (lane >> 5); scr[kk * 33 + (lane & 31)] = W[(size_t)(k0 + kk) * ldw + n0 + (lane & 31)]; }
    LDS_WAIT(); asm volatile("" ::: "memory");
    const int c = lane & 7;
#pragma unroll
    for (int j = 0; j < 4; ++j) { const int n = (lane >> 3) + 8 * j; const LAS float* s = scr + (8 * c) * 33 + n;
        if constexpr (F8) {
            const f32x4 lo4 = {s[0 * 33], s[1 * 33], s[2 * 33], s[3 * 33]}, hi4 = {s[4 * 33], s[5 * 33], s[6 * 33], s[7 * 33]};
            *(GAS v2u*)((unsigned char*)WTv + (size_t)(n0 + n) * ldt + k0 + 8 * c) = (v2u){q8x4c(lo4, scale), q8x4c(hi4, scale)};
        } else {
            v4u o; o.x = cvt_pk_bf16(s[0 * 33], s[1 * 33]); o.y = cvt_pk_bf16(s[2 * 33], s[3 * 33]); o.z = cvt_pk_bf16(s[4 * 33], s[5 * 33]); o.w = cvt_pk_bf16(s[6 * 33], s[7 * 33]);
            *(GAS v4u*)((bf16*)WTv + (size_t)(n0 + n) * ldt + k0 + 8 * c) = o; } }
    LDS_WAIT(); asm volatile("" ::: "memory");
}

__device__ __forceinline__ int t5_bucket(int rel) {
    int n = -rel; const int ret = n < 0 ? 16 : 0; n = n < 0 ? -n : n;
    if (n < 8) return ret + n;
    const float v = logf((float)n / 8.0f) / logf(128.0f) * 8.0f;
    int large = 8 + (int)v; large = large < 15 ? large : 15;
    return ret + large;
}
__device__ __forceinline__ float gelu_tanh(float x) {
    const float z = 0.7978845608028654f * (x + 0.044715f * x * x * x);
    const float e = __expf(2.0f * z);
    const float t = 1.0f - 2.0f / (e + 1.0f);
    return 0.5f * x * (1.0f + t);
}
__device__ __forceinline__ unsigned fkey(float v) { const unsigned u = __float_as_uint(v); return (u >> 31) ? ~u : (u | 0x80000000u); }
__device__ __forceinline__ float fdec(unsigned key) { const unsigned k2 = key & ~127u; const unsigned u = (k2 >> 31) ? (k2 & 0x7fffffffu) : (~k2 & ~127u); return __uint_as_float(u); }
template <int LJ> __device__ __forceinline__ unsigned xshfl(unsigned x, const int lane) {
    if constexpr (LJ == 1) return (unsigned)__builtin_amdgcn_update_dpp(0, (int)x, 0xB1, 0xF, 0xF, false);
    else if constexpr (LJ == 2) return (unsigned)__builtin_amdgcn_update_dpp(0, (int)x, 0x4E, 0xF, 0xF, false);
    else if constexpr (LJ == 4) { const int y = __builtin_amdgcn_update_dpp(0, (int)x, 0x141, 0xF, 0xF, false); return (unsigned)__builtin_amdgcn_update_dpp(0, y, 0x1B, 0xF, 0xF, false); }
    else if constexpr (LJ == 8) { const int y = __builtin_amdgcn_update_dpp(0, (int)x, 0x140, 0xF, 0xF, false); return (unsigned)__builtin_amdgcn_update_dpp(0, y, 0x141, 0xF, 0xF, false); }
    else if constexpr (LJ == 16) return (unsigned)__builtin_amdgcn_ds_swizzle((int)x, 0x401F);
    else { const auto rr = __builtin_amdgcn_permlane32_swap(x, x, false, false); return lane < 32 ? rr[1] : rr[0]; }
}
template <int K, int J> __device__ __forceinline__ void bitonic_step(unsigned& a0, unsigned& a1, unsigned& b0, unsigned& b1, const int lane) {
    const bool asc = (K == 128) ? true : ((lane & (K >> 1)) == 0);
    if constexpr (J == 1) {
        const unsigned la = a0 < a1 ? a0 : a1, ha = a0 < a1 ? a1 : a0, lb = b0 < b1 ? b0 : b1, hb = b0 < b1 ? b1 : b0;
        a0 = asc ? la : ha; a1 = asc ? ha : la; b0 = asc ? lb : hb; b1 = asc ? hb : lb;
    } else {
        constexpr int LJ = J >> 1; const bool tmin = (((lane & LJ) == 0) == asc);
        const unsigned pa0 = xshfl<LJ>(a0, lane), pa1 = xshfl<LJ>(a1, lane), pb0 = xshfl<LJ>(b0, lane), pb1 = xshfl<LJ>(b1, lane);
        a0 = tmin ? (a0 < pa0 ? a0 : pa0) : (a0 < pa0 ? pa0 : a0); a1 = tmin ? (a1 < pa1 ? a1 : pa1) : (a1 < pa1 ? pa1 : a1);
        b0 = tmin ? (b0 < pb0 ? b0 : pb0) : (b0 < pb0 ? pb0 : b0); b1 = tmin ? (b1 < pb1 ? b1 : pb1) : (b1 < pb1 ? pb1 : b1);
    }
    if constexpr (J > 1) bitonic_step<K, (J >> 1)>(a0, a1, b0, b1, lane);
}
template <int K> __device__ __forceinline__ void bitonic_stage(unsigned& a0, unsigned& a1, unsigned& b0, unsigned& b1, const int lane) {
    bitonic_step<K, (K >> 1)>(a0, a1, b0, b1, lane);
    if constexpr (K < 128) bitonic_stage<(K << 1)>(a0, a1, b0, b1, lane);
}
__device__ __forceinline__ void bitonic128x2(unsigned& a0, unsigned& a1, unsigned& b0, unsigned& b1, const int lane) { bitonic_stage<2>(a0, a1, b0, b1, lane); }
__device__ __forceinline__ float dot2bf(unsigned a, unsigned b, float c) { return __builtin_amdgcn_fdot2_f32_bf16(__builtin_bit_cast(bf2_t, a), __builtin_bit_cast(bf2_t, b), c, false); }

constexpr int ATT_SLOT4 = 4352;
constexpr int ATT_SLOT = 8704;
__device__ __forceinline__ int crow(int r, int hi) { return (r & 3) + 8 * (r >> 2) + 4 * hi; }

__device__ __forceinline__ void attn_task(const int G, const bf16* QKVH, bf16* O0, bf16* O1, float* LSE0, float* LSE1, unsigned char* MIX8,
                                          const LAS float* btab, LAS unsigned char* wl, int b, int h, int mtile, int tk, int lane) {
    const int SH = 2 * G;
    const int L = SEQ >> SH, TPR = 32 >> SH;
    const int r32 = lane & 31, hi = lane >> 5;
    const int res = tk >> (5 - SH), l0 = ((mtile * 1024) >> SH) + 32 * (tk & (TPR - 1));
    const size_t rowbase = (size_t)b * SEQ;
    const int srow = lane >> 4, sch = lane & 15;
    const int rot = (tk & 1) ? 4 : 0;
#define ATT_JR(j) (((j) + rot) >= 5 ? ((j) + rot - 5) : ((j) + rot))
#define ATT_WAITV(n) asm volatile("s_waitcnt vmcnt(" #n ")" ::: "memory")
      \
#define ATT_ISSUE(n) do { LAS unsigned char* sl_ = wl + ((n) & 3) * ATT_SLOT4; const int jt_ = ATT_JR((n) - 5); \
        _Pragma("unroll") for (int i_ = 0; i_ < 4; ++i_) { \
            const int key_ = i_ + 4 * ((krow8 >> 1) & 1) + 8 * (krow8 & 1) + 16 * (krow8 >> 2); \
            int lk_ = l0 - 64 + 32 * jt_ + key_; lk_ = lk_ < 0 ? 0 : (lk_ > L - 1 ? L - 1 : lk_); \
            const unsigned char* src_ = QK8 + ((size_t)(2 * NH + h) * M + rowbase + ((size_t)lk_ << SH) + res) * HD + kch8 * 16; \
            __builtin_amdgcn_global_load_lds((const unsigned*)src_, (LAS unsigned*)(sl_ + i_ * 1056), 16, 0, 0); } } while (0)
    const int krow8 = lane >> 3, kch8 = lane & 7;
#define ATT_ISSUEK(n) do { LAS unsigned char* sl_ = wl + ((n) & 3) * ATT_SLOT4; const int jt_ = ATT_JR(n); \
        _Pragma("unroll") for (int i_ = 0; i_ < 4; ++i_) { \
            const int key_ = 8 * i_ + krow8; \
            int lk_ = l0 - 64 + 32 * jt_ + key_; lk_ = lk_ < 0 ? 0 : (lk_ > L - 1 ? L - 1 : lk_); \
            const int ch_ = kch8 ^ ((key_ ^ (key_ >> 3)) & 7); \
            const unsigned char* src_ = QK8 + ((size_t)(NH + h) * M + rowbase + ((size_t)lk_ << SH) + res) * HD + ch_ * 16; \
            __builtin_amdgcn_global_load_lds((const unsigned*)src_, (LAS unsigned*)(sl_ + i_ * 1024), 16, 0, 0); } } while (0)
    const size_t qrow = rowbase + ((size_t)(l0 + r32) << SH) + res;
    const unsigned char* QK8 = (const unsigned char*)QKVH;
    long qr[8];
    { const unsigned char* qp = QK8 + ((size_t)h * M + qrow) * HD + hi * 8;
#pragma unroll
      for (int d0 = 0; d0 < 8; ++d0) qr[d0] = *(const long*)(qp + d0 * 16); }
    ATT_ISSUEK(0); ATT_ISSUEK(1); ATT_ISSUEK(2); ATT_ISSUEK(3);
    f32x16 p[5];
    const int ksw = (r32 ^ (r32 >> 3)) & 7;
#define ATT_KTILE(n) do { LAS unsigned char* sl_ = wl + ((n) & 3) * ATT_SLOT4 + r32 * 128 + 8 * hi; f32x16 s_ = {}; \
        _Pragma("unroll") for (int d0 = 0; d0 < 8; ++d0) { const long a_ = *(const LAS long*)(sl_ + ((d0 ^ ksw) << 4)); s_ = __builtin_amdgcn_mfma_f32_32x32x16_fp8_fp8(a_, qr[d0], s_, 0, 0, 0); } \
        p[n] = s_; asm volatile("" ::: "memory"); } while (0)
    ATT_WAITV(12); ATT_KTILE(0); ATT_ISSUEK(4);
    ATT_WAITV(12); ATT_KTILE(1); ATT_ISSUE(5);
    ATT_WAITV(12); ATT_KTILE(2); ATT_ISSUE(6);
    ATT_WAITV(12); ATT_KTILE(3); ATT_ISSUE(7);
    ATT_WAITV(12); ATT_KTILE(4); ATT_ISSUE(8);
    float mx = -1e30f;
    const bool edge = (l0 - 64 < 0) || (l0 + 96 > L);
    const LAS float* bt = btab + G * 256 + 32 + 4 * hi - r32;
#pragma unroll
    for (int j = 0; j < 5; ++j) {
        const int jr = ATT_JR(j); const LAS float* btj = bt + 32 * jr;
#pragma unroll
        for (int r = 0; r < 16; ++r) {
            const int kc = 32 * jr + (r & 3) + 8 * (r >> 2);
            float v = p[j][r] * (1.0f / (Q8MUL * K8MUL)) + btj[(r & 3) + 8 * (r >> 2)];
            if (edge) { const int lk = l0 - 64 + kc + 4 * hi; v = (lk >= 0 && lk < L) ? v : -1e30f; }
            p[j][r] = v; mx = fmaxf(mx, v);
        }
        asm volatile("" ::: "memory");
    }
    mx = fmaxf(mx, __shfl_xor(mx, 32));
    float ls = 0.f;
    long pb[5][2];
#pragma unroll
    for (int j = 0; j < 5; ++j) {
        float e[16];
#pragma unroll
        for (int r = 0; r < 16; ++r) { e[r] = __builtin_amdgcn_exp2f(p[j][r] - mx); ls += e[r]; }
#pragma unroll
        for (int s = 0; s < 2; ++s) { int lo_ = 0, hi_ = 0;
            lo_ = __builtin_amdgcn_cvt_pk_fp8_f32(e[8 * s + 0] * P8MUL, e[8 * s + 1] * P8MUL, lo_, false); lo_ = __builtin_amdgcn_cvt_pk_fp8_f32(e[8 * s + 2] * P8MUL, e[8 * s + 3] * P8MUL, lo_, true);
            hi_ = __builtin_amdgcn_cvt_pk_fp8_f32(e[8 * s + 4] * P8MUL, e[8 * s + 5] * P8MUL, hi_, false); hi_ = __builtin_amdgcn_cvt_pk_fp8_f32(e[8 * s + 6] * P8MUL, e[8 * s + 7] * P8MUL, hi_, true);
            pb[j][s] = (long)(((unsigned long)(unsigned)hi_ << 32) | (unsigned long)(unsigned)lo_); }
    }
    ls += __shfl_xor(ls, 32);
    asm volatile("" ::: "memory");
    f32x16 o[4] = {};
    const int i16 = lane & 15, g16 = lane >> 4;
    const int tr_ = i16 >> 1;
    const unsigned vbase = (unsigned)(uintptr_t)wl + (unsigned)((tr_ & 3) * 1056 + (2 * hi + (tr_ >> 2)) * 128 + 16 * (g16 & 1) + 8 * (i16 & 1));
#define ATT_VTILE(n) do { const unsigned va_ = vbase + ((n) & 3) * ATT_SLOT4; \
        _Pragma("unroll") for (int dt = 0; dt < 4; ++dt) { long af0, af1; \
            asm volatile("ds_read_b64_tr_b8 %0, %2 offset:%3\n\tds_read_b64_tr_b8 %1, %2 offset:%4\n\ts_waitcnt lgkmcnt(0)" \
                         : "=&v"(af0), "=&v"(af1) : "v"(va_), "i"(dt * 32), "i"(512 + dt * 32) : "memory"); \
            o[dt] = __builtin_amdgcn_mfma_f32_32x32x16_fp8_fp8(af0, pb[(n) - 5][0], o[dt], 0, 0, 0); \
            o[dt] = __builtin_amdgcn_mfma_f32_32x32x16_fp8_fp8(af1, pb[(n) - 5][1], o[dt], 0, 0, 0); } } while (0)
    ATT_WAITV(12); ATT_VTILE(5); ATT_ISSUE(9);
    ATT_WAITV(12); ATT_VTILE(6);
    ATT_WAITV(8);  ATT_VTILE(7);
    ATT_WAITV(4);  ATT_VTILE(8);
    ATT_WAITV(0);  ATT_VTILE(9);
#undef ATT_WAITV
#undef ATT_ISSUE
#undef ATT_ISSUEK
#undef ATT_KTILE
#undef ATT_VTILE
#undef ATT_JR
    const float inv = 1.0f / (ls * (P8MUL * V8MUL));
    const float lse2 = mx + __builtin_amdgcn_logf(ls);
    const size_t orow = qrow;
    LAS unsigned char* T0 = wl;
    LAS unsigned char* T1 = T0 + ATT_SLOT;
    int ln_ = lane; asm volatile("" : "+v"(ln_));
    const int erow = ln_ >> 4, echk = ln_ & 15;
    const unsigned pofs = (unsigned)(r32 * 272 + 8 * hi);
    if (G < 2) {
#pragma unroll
        for (int dt = 0; dt < 4; ++dt)
#pragma unroll
            for (int rg = 0; rg < 4; ++rg) { v2u w; w.x = cvt_pk_bf16(o[dt][4 * rg] * inv, o[dt][4 * rg + 1] * inv); w.y = cvt_pk_bf16(o[dt][4 * rg + 2] * inv, o[dt][4 * rg + 3] * inv);
                *(LAS v2u*)(T0 + pofs + 64 * dt + 16 * rg) = w; }
        LDS_WAIT();
        bf16* ob = (G == 0 ? O0 : O1) + ((size_t)h * M + rowbase) * HD + echk * 8;
#pragma unroll
        for (int i = 0; i < 8; ++i) { const int qi = erow + 4 * i; const v4u w = *(const LAS v4u*)(T0 + qi * 272 + echk * 16);
            *(v4u*)(ob + (((size_t)(l0 + qi) << SH) + res) * HD) = w; }
        if (hi == 0) (G == 0 ? LSE0 : LSE1)[orow * NH + h] = lse2;
    } else {
        const float l0v = LSE0[orow * NH + h], l1v = LSE1[orow * NH + h];
        const bf16* ib0 = O0 + ((size_t)h * M + rowbase) * HD + echk * 8; const bf16* ib1 = O1 + ((size_t)h * M + rowbase) * HD + echk * 8;
#pragma unroll
        for (int hh = 0; hh < 2; ++hh) {
            v4u t0[4], t1[4];
#pragma unroll
            for (int i = 0; i < 4; ++i) { const size_t ro = (((size_t)(l0 + erow + 4 * (4 * hh + i)) << SH) + res) * HD; t0[i] = *(const v4u*)(ib0 + ro); t1[i] = *(const v4u*)(ib1 + ro); }
#pragma unroll
            for (int i = 0; i < 4; ++i) { const int qi = erow + 4 * (4 * hh + i); *(LAS v4u*)(T0 + qi * 272 + echk * 16) = t0[i]; *(LAS v4u*)(T1 + qi * 272 + echk * 16) = t1[i]; }
            asm volatile("" ::: "memory");
        }
        const float mm = fmaxf(fmaxf(l0v, l1v), lse2);
        const float w0 = __builtin_amdgcn_exp2f(l0v - mm), w1 = __builtin_amdgcn_exp2f(l1v - mm), w2 = __builtin_amdgcn_exp2f(lse2 - mm);
        const float wi = 1.0f / (w0 + w1 + w2);
        const float c0 = w0 * wi, c1 = w1 * wi, c2 = w2 * wi * inv;
        LDS_WAIT();
        unsigned y8[16];
#pragma unroll
        for (int dt = 0; dt < 4; ++dt)
#pragma unroll
            for (int rg = 0; rg < 4; ++rg) { const v2u a = *(const LAS v2u*)(T0 + pofs + 64 * dt + 16 * rg), c = *(const LAS v2u*)(T1 + pofs + 64 * dt + 16 * rg);
                const float y0 = c0 * bf_lo(a.x) + c1 * bf_lo(c.x) + c2 * o[dt][4 * rg], y1 = c0 * bf_hi(a.x) + c1 * bf_hi(c.x) + c2 * o[dt][4 * rg + 1];
                const float y2 = c0 * bf_lo(a.y) + c1 * bf_lo(c.y) + c2 * o[dt][4 * rg + 2], y3 = c0 * bf_hi(a.y) + c1 * bf_hi(c.y) + c2 * o[dt][4 * rg + 3];
                y8[4 * dt + rg] = q8x4c((f32x4){y0, y1, y2, y3}, A8SCALE); }
        LDS_WAIT();
#pragma unroll
        for (int dt = 0; dt < 4; ++dt)
#pragma unroll
            for (int rg = 0; rg < 4; ++rg) *(LAS unsigned*)(T0 + r32 * 144 + 4 * hi + 32 * dt + 8 * rg) = y8[4 * dt + rg];
        LDS_WAIT();
        unsigned char* ob = MIX8 + rowbase * DM + h * HD + (ln_ & 7) * 16;
#pragma unroll
        for (int i = 0; i < 4; ++i) { const int qi = (ln_ >> 3) + 8 * i; const v4u w = *(const LAS v4u*)(T0 + qi * 144 + (ln_ & 7) * 16);
            *(v4u*)(ob + (((size_t)(l0 + qi) << SH) + res) * DM) = w; }
    }
    LDS_WAIT();
}

constexpr int PER_PHASE = 9;
struct Args { const float* in[16]; float* out; unsigned char* ws; unsigned mask; unsigned pad; };

__constant__ unsigned char CAND_I[64] = {0,0,0,0,0,0,0,0,0,0,0,0,0,0,0,0, 1,1,1,1,1,1,1,1, 2,2,2,2,2, 3,3,3,3, 4,4,4, 5,5, 6,6, 7,7, 8,9,10,11,12,13,14,15, 0,0,0,0,0,0,0,0,0,0,0,0,0,0};
__constant__ unsigned char CAND_J[64] = {0,1,2,3,4,5,6,7,8,9,10,11,12,13,14,15, 0,1,2,3,4,5,6,7, 0,1,2,3,4, 0,1,2,3, 0,1,2, 0,1, 0,1, 0,1, 0,0,0,0,0,0,0,0, 0,0,0,0,0,0,0,0,0,0,0,0,0,0};

__global__ void __launch_bounds__(NWAVES * 64, 2) fwd_kernel(Args args) {
    extern __shared__ __attribute__((aligned(16))) unsigned char lds_raw[];
    LAS unsigned char* lds = (LAS unsigned char*)lds_raw;
    volatile LAS unsigned* MISC = (volatile LAS unsigned*)(lds + MISC_OFF);
    const int tid0 = threadIdx.x, lane0 = tid0 & 63, wave = __builtin_amdgcn_readfirstlane(tid0 >> 6);
#define PHASE_LANES() int lane; asm volatile("v_mbcnt_lo_u32_b32 %0, -1, 0\n\tv_mbcnt_hi_u32_b32 %0, -1, %0" : "=v"(lane)); const int tid = wave * 64 + lane
    const int G = gridDim.x; const int bx = blockIdx.x;
    const int vcu = (G % 8 == 0) ? (bx % 8) * (G / 8) + bx / 8 : bx;
    const int gw = vcu * NWAVES + wave, NGW = G * NWAVES;
    unsigned char* ws = args.ws;
    unsigned* ctl = (unsigned*)(ws + WS_CTL);
    const float* x = args.in[0]; const float* cvec = args.in[1]; const float* w_ada = args.in[2]; const float* b_ada = args.in[3]; const float* g_mix = args.in[4];
    const float* w_in = args.in[5]; const float* rel_bias = args.in[6]; const float* pool_w = args.in[7]; const float* pool_scale = args.in[8]; const float* w_out = args.in[9];
    const float* g_ffn = args.in[10]; const float* peer_wq = args.in[11]; const float* peer_sk = args.in[12]; const float* peer_u = args.in[13]; const float* peer_v = args.in[14];
    const float* g_final = args.in[15];
    float* out = args.out;
    float* MODV = (float*)(ws + WS_MODV); float* MODP = (float*)(ws + WS_MODP);
    bf16* SKT = (bf16*)(ws + WS_SKT); bf16* PWS = (bf16*)(ws + WS_PWS); bf16* WQSTB = (bf16*)(ws + WS_WQST);     unsigned char* WQST8 = ws + 104 * MiB;     unsigned char* WOUT8 = ws + WS_WOUT2;     unsigned char* WIN8 = ws + WS_WIN8; unsigned char* H8 = ws + WS_H8;
    bf16* WOPT = (bf16*)(ws + WS_WOPT); bf16* WQB = (bf16*)(ws + WS_WQB);
    unsigned char* UB = ws + WS_UB; unsigned char* VB = ws + WS_VB; float* SCL = (float*)(ws + WS_SCL); float* TSC = SCL + 2 * NEXP; float* WQS = TSC + M;         unsigned char* HHI = ws + WS_H; unsigned char* HLO = ws + WS_H + 32 * MiB;     bf16* PIN = (bf16*)(ws + WS_PROJ); bf16* QKVH = (bf16*)(ws + WS_QKVH); unsigned char* MIX8 = ws + WS_MIXIN;
    bf16* O0 = (bf16*)(ws + WS_O0); bf16* O1 = (bf16*)(ws + WS_O1); float* LSE = (float*)(ws + WS_LSE);
    float* SC = (float*)(ws + WS_SC);
    bf16* X1B = (bf16*)(ws + WS_O0);
    bf16* YB = (bf16*)(ws + WS_PROJ + 64 * MiB);

    for (int u = tid0; u < (LDS_BYTES - LDSCTL_OFF) / 4; u += NWAVES * 64) ((LAS unsigned*)(lds + LDSCTL_OFF))[u] = 0u;
    __syncthreads();
    XcdBarrier bar; bar.bar = ctl + CW_BAR; bar.x = 0; bar.st = nullptr;
    if (MK_N_LAUNCHES != PER_PHASE) bar = xcd_barrier_post(ctl + CW_BAR, MISC + 8, wave);
#define GRID_BAR() do { if (MK_N_LAUNCHES != PER_PHASE) xcd_barrier(bar, wave); } while (0)
    const unsigned phmask = args.mask;
#ifndef PH_MASK
#define PH_MASK 0x1ff
#endif
#define IN(k) ((((PH_MASK) >> (k)) & 1) && ((phmask >> (k)) & 1u))
#define BOTH(k) (IN(k) && IN((k) + 1))

    if (IN(0)) {
        PHASE_LANES();
        LAS float* silu = (LAS float*)(lds + RING_OFF);
        for (int i = tid; i < BATCH * DM; i += NWAVES * 64) { const float v = cvec[i]; silu[i] = v / (1.0f + __expf(-v)); }
        __syncthreads();
        for (int task = gw; task < (NMOD / 256) * KS_ADA; task += NGW) {
            const int cg = task % (NMOD / 256), ks = task / (NMOD / 256); const int k0 = ks * (DM / KS_ADA), n0 = cg * 256 + 4 * lane;
            f32x4 a0 = {0.f, 0.f, 0.f, 0.f}, a1 = {0.f, 0.f, 0.f, 0.f};
            const float* wp = w_ada + (size_t)k0 * NMOD + n0;
            static_assert(DM / KS_ADA == 64, "four 16-row batches");
            f32x4 wA[16], wB[16];
#define ADA_LD(W_, b_) _Pragma("unroll") for (int q_ = 0; q_ < 16; ++q_) W_[q_] = *(const f32x4*)(wp + (size_t)(16 * (b_) + q_) * NMOD)
#define ADA_FMA(W_, b_) _Pragma("unroll") for (int q_ = 0; q_ < 16; ++q_) { const float s0 = silu[k0 + 16 * (b_) + q_], s1 = silu[DM + k0 + 16 * (b_) + q_]; a0 += W_[q_] * s0; a1 += W_[q_] * s1; }
            ADA_LD(wA, 0); ADA_LD(wB, 1); ADA_FMA(wA, 0); ADA_LD(wA, 2); ADA_FMA(wB, 1); ADA_LD(wB, 3); ADA_FMA(wA, 2); ADA_FMA(wB, 3);
#undef ADA_LD
#undef ADA_FMA
            *(f32x4*)(MODP + ((size_t)(ks * 2 + 0)) * NMOD + n0) = a0; *(f32x4*)(MODP + ((size_t)(ks * 2 + 1)) * NMOD + n0) = a1;
        }
        __syncthreads();
        {
            LAS float* scr = (LAS float*)(lds + RING_OFF + wave * 16384);
            constexpr int I_QKV = (DM / 64) * (3 * ATTW / 32), I_PIN = (DM / 64) * (POOLW / 32), I_OUTH = (ATTW / 64) * (DM / 32);
            constexpr int NITEMS = I_QKV + I_PIN + 2 * I_OUTH;
            for (int it = gw; it < NITEMS; it += NGW) {
                int r = it;
                if (r < I_QKV + I_PIN) { p0_transpose_item<true>(w_in, INW, INW, WIN8, DM, W8SCALE, scr, r, lane); continue; } r -= I_QKV + I_PIN;
                if (r < I_OUTH) { p0_transpose_item<true>(w_out, DM, DM, WOUT8, DM, WOA8SCALE, scr, r, lane); continue; } r -= I_OUTH;
                p0_transpose_item<false>(w_out + (size_t)ATTW * DM, DM, DM, WOPT, POOLW, 1.f, scr, r, lane);
            }
        }
        for (int i = gw * 64 + lane; i < (DM * PQ + 4 * 512 * 512) / 8; i += NGW * 64) {
            const bool isQ = i < DM * PQ / 8; const int j = isQ ? i : i - DM * PQ / 8;
            const float* src = (isQ ? peer_wq : pool_w) + (size_t)j * 8;
            f32x4 a = *(const f32x4*)src, c = *(const f32x4*)(src + 4);
            if (!isQ) { const int e0 = j * 8; const int gi = e0 >> 18, d0 = e0 & 511; const float* ps = pool_scale + gi * 512 + d0; a = a * *(const f32x4*)ps; c = c * *(const f32x4*)(ps + 4); }
            v4u w; w.x = cvt_pk_bf16(a[0], a[1]); w.y = cvt_pk_bf16(a[2], a[3]); w.z = cvt_pk_bf16(c[0], c[1]); w.w = cvt_pk_bf16(c[2], c[3]);
            *(v4u*)((isQ ? WQB : PWS) + (size_t)j * 8) = w;
        }
        f32x4 vnx[4][4];
#define PEER_LD(r_) do { const float* s_ = ((r_) < NEXP ? peer_u + (size_t)(r_) * DM : peer_v + (size_t)((r_) - NEXP) * DM) + 16 * lane; \
            _Pragma("unroll") for (int i = 0; i < 4; ++i) _Pragma("unroll") for (int q = 0; q < 4; ++q) vnx[i][q] = *(const f32x4*)(s_ + 1024 * i + 4 * q); } while (0)
        if (gw < 2 * NEXP) PEER_LD(gw);
        for (int r = gw; r < 2 * NEXP; r += NGW) {
            const bool isU = r < NEXP; const int e = isU ? r : r - NEXP;
            f32x4 v[4][4]; float mx = 0.f, ss = 0.f;
#pragma unroll
            for (int i = 0; i < 4; ++i)
#pragma unroll
                for (int q = 0; q < 4; ++q) { v[i][q] = vnx[i][q];
                    mx = fmaxf(mx, fmaxf(fmaxf(fabsf(v[i][q][0]), fabsf(v[i][q][1])), fmaxf(fabsf(v[i][q][2]), fabsf(v[i][q][3]))));
                    ss += (v[i][q][0] * v[i][q][0] + v[i][q][1] * v[i][q][1]) + (v[i][q][2] * v[i][q][2] + v[i][q][3] * v[i][q][3]); }
            if (r + NGW < 2 * NEXP) PEER_LD(r + NGW);
#pragma unroll
            for (int o = 1; o < 64; o <<= 1) mx = fmaxf(mx, __shfl_xor(mx, o));
            const int ex = (int)((__float_as_uint(mx) >> 23) & 0xffu);
            float scale = 1.0f, inv = 1.0f;
            if (ex >= 32 && ex <= 230) { const float rms = sqrtf(wave_sum(ss) * (1.0f / DM));
                if (isU) { inv = 0.3352f * rms; scale = 1.0f / inv; }
                else { inv = 0.5f * rms; scale = 1.0f / inv; } }
            if (isU) {
                unsigned char* dst = UB + ((size_t)(lane >> 4) * NEXP + e) * 128 + 8 * (lane & 15);
#pragma unroll
                for (int i = 0; i < 4; ++i) { const unsigned lo = q4x4(v[i][0], scale) | (q4x4(v[i][1], scale) << 16), hi = q4x4(v[i][2], scale) | (q4x4(v[i][3], scale) << 16);
                    *(v2u*)(dst + (size_t)(4 * i) * NEXP * 128) = (v2u){lo, hi}; }
            } else {
                unsigned char* dst = VB + ((size_t)(lane >> 4) * NEXP + e) * 128 + 8 * (lane & 15);
#pragma unroll
                for (int i = 0; i < 4; ++i) { unsigned lo = 0u, hi = 0u;
                    lo = __builtin_amdgcn_cvt_scalef32_pk_fp4_f32(lo, v[i][0][0] * scale, v[i][0][1] * scale, 1.0f, 0); lo = __builtin_amdgcn_cvt_scalef32_pk_fp4_f32(lo, v[i][0][2] * scale, v[i][0][3] * scale, 1.0f, 1);
                    lo = __builtin_amdgcn_cvt_scalef32_pk_fp4_f32(lo, v[i][1][0] * scale, v[i][1][1] * scale, 1.0f, 2); lo = __builtin_amdgcn_cvt_scalef32_pk_fp4_f32(lo, v[i][1][2] * scale, v[i][1][3] * scale, 1.0f, 3);
                    hi = __builtin_amdgcn_cvt_scalef32_pk_fp4_f32(hi, v[i][2][0] * scale, v[i][2][1] * scale, 1.0f, 0); hi = __builtin_amdgcn_cvt_scalef32_pk_fp4_f32(hi, v[i][2][2] * scale, v[i][2][3] * scale, 1.0f, 1);
                    hi = __builtin_amdgcn_cvt_scalef32_pk_fp4_f32(hi, v[i][3][0] * scale, v[i][3][1] * scale, 1.0f, 2); hi = __builtin_amdgcn_cvt_scalef32_pk_fp4_f32(hi, v[i][3][2] * scale, v[i][3][3] * scale, 1.0f, 3);
                    *(v2u*)(dst + (size_t)(4 * i) * NEXP * 128) = (v2u){lo, hi}; }
            }
            if (lane == 0) SCL[r] = inv;
        }
#undef PEER_LD
        for (int i = gw * 64 + lane; i < 2048 * 32; i += NGW * 64) {
            const int n = i >> 5, kc = (i & 31) * 8; const int p = (n >> 7) & 1, pp = kc >> 7;
            v4u w = {0u, 0u, 0u, 0u};
            if (p == pp) { const float* src = peer_sk + (size_t)n * 128 + (kc & 127); const f32x4 a = *(const f32x4*)src, c = *(const f32x4*)(src + 4);
                w.x = cvt_pk_bf16(a[0], a[1]); w.y = cvt_pk_bf16(a[2], a[3]); w.z = cvt_pk_bf16(c[0], c[1]); w.w = cvt_pk_bf16(c[2], c[3]); }
            *(v4u*)(SKT + (size_t)n * 256 + kc) = w;
        }
        if (BOTH(0)) GRID_BAR();
    }

    if (IN(1)) {
        PHASE_LANES();
        for (int i = bx * (NWAVES * 64) + tid; i < BATCH * NMOD; i += G * NWAVES * 64) {
            const int b = i / NMOD, n = i % NMOD; float s = b_ada[n];
#pragma unroll 8
            for (int ks = 0; ks < KS_ADA; ++ks) s += MODP[(size_t)(ks * 2 + b) * NMOD + n];
            const int j = n / DM, c = n % DM;
            MODV[(size_t)(j * 2 + b) * DM + c] = s;
        }
        if (bx < G / 2) {
            pg8::Gemm g{WOPT, PWS, DM, POOLW, 512, POOLW, 512, 2, 512, 1 << 30, 0}; pg8::StaticOrder S; S.init(DM, POOLW, G / 2, bx);
            pg8::EpiI8 E{WOUT8, DM, ATTW, WOP8SCALE};
            pg8::gemm_phase<pg8::EpiI8, pg8::StaticOrder, true>(lds + RING_OFF, g, S, E, wave);
        }
        else {
            pg8::Gemm g{SKT, WQB, PQ, DM, 256, 256, PQ, 1 << 30, 0, 1, 256}; pg8::StaticOrder S; S.init(PQ, DM, G - G / 2, bx - G / 2);
            pg8::EpiBf16 E{WQSTB, DM, 0, 1.0f, nullptr, 0, 0};
            pg8::gemm_phase<pg8::EpiBf16, pg8::StaticOrder, true>(lds + RING_OFF, g, S, E, wave);
        }
        if (BOTH(1)) GRID_BAR();
    }

    if (IN(2)) {
        PHASE_LANES();
        for (int row = gw; row < M; row += NGW) {
            const int b = row / SEQ;
            const f32x4* xr = (const f32x4*)(x + (size_t)row * DM) + lane;
            f32x4 v[16]; float ss = 0.f;
#pragma unroll
            for (int j = 0; j < 16; ++j) { v[j] = xr[64 * j]; ss += (v[j][0] * v[j][0] + v[j][1] * v[j][1]) + (v[j][2] * v[j][2] + v[j][3] * v[j][3]); }
            const float rstd = 1.0f / sqrtf(wave_sum(ss) * (1.0f / DM) + RMS_EPS);
            const f32x4* gp = (const f32x4*)g_mix + lane; const f32x4* shp = (const f32x4*)(MODV + (size_t)(0 * 2 + b) * DM) + lane; const f32x4* scp = (const f32x4*)(MODV + (size_t)(1 * 2 + b) * DM) + lane;
            unsigned* op8 = (unsigned*)(H8 + (size_t)row * DM) + lane;
#pragma unroll
            for (int j = 0; j < 16; ++j) { const f32x4 g4 = gp[64 * j], sh = shp[64 * j], sc = scp[64 * j];
                const f32x4 y = (v[j] * rstd) * g4 * (sc + 1.0f) + sh;
                op8[64 * j] = q8x4c(y, H8SCALE); }
        }
        for (int n = gw; n < PQ; n += NGW) {
            const v2u* wr_ = (const v2u*)(WQSTB + (size_t)n * DM) + lane;
            f32x4 v[16]; float mx = 0.f;
#pragma unroll
            for (int j = 0; j < 16; ++j) { const v2u xw = wr_[64 * j]; v[j] = (f32x4){bf_lo(xw.x), bf_hi(xw.x), bf_lo(xw.y), bf_hi(xw.y)};
                mx = fmaxf(mx, fmaxf(fmaxf(fabsf(v[j][0]), fabsf(v[j][1])), fmaxf(fabsf(v[j][2]), fabsf(v[j][3])))); }
#pragma unroll
            for (int o = 1; o < 64; o <<= 1) mx = fmaxf(mx, __shfl_xor(mx, o));
            mx = fmaxf(mx, 1e-20f);
            const float qs = 127.0f / mx; unsigned* op8 = (unsigned*)(WQST8 + (size_t)n * DM) + lane;
#pragma unroll
            for (int j = 0; j < 16; ++j) op8[64 * j] = q8x4(v[j], qs);
            if (lane == 0) WQS[n] = mx * (1.0f / 127.0f);
        }
        if (BOTH(2)) GRID_BAR();
    }

    if (IN(3)) {
        PHASE_LANES();
        {
            pg8::Gemm g{(const bf16*)H8, (const bf16*)WIN8, M, INW, DM / 2, DM / 2, DM / 2, 1 << 30, 0, 1 << 30, 0}; pg8::StaticOrder S; S.init(M, INW, G, bx);
            pg8::EpiBf16 E{PIN, POOLW, ATTW, QSCALE / (H8SCALE * W8SCALE), QKVH, 3 * ATTW, M, 1.0f / (H8SCALE * W8SCALE), 3 * ATTW};
            pg8::gemm_phase<pg8::EpiBf16, pg8::StaticOrder, true, true>(lds + RING_OFF, g, S, E, wave);
        }
        if (BOTH(3)) GRID_BAR();
    }

    if (IN(4)) {
        PHASE_LANES();
        LAS float* btab = (LAS float*)(lds + SHARED_OFF);
        LAS unsigned char* vt = lds + RING_OFF + wave * ATT_WAVE_BYTES;
        if (!(args.pad & 1u))
        for (int unit = bx; unit < BATCH * NH * (SEQ / 1024); unit += G) {
            const int b = unit >> 7, h = (unit >> 3) & 15, mt = unit & 7;
            __syncthreads();
            for (int i = tid; i < 3 * 256; i += NWAVES * 64) { const int gi = i >> 8, ri = (i & 255) - 32; const int dil = gi == 0 ? 1 : (gi == 1 ? 4 : 16);
                btab[i] = (ri >= 0 && ri <= 128) ? rel_bias[t5_bucket((ri - 64) * dil) * NH + h] * LOG2E : -1e30f; }
            __syncthreads();
            for (int g = 0; g < 3; ++g) {
                if (g == 2) { VM_WAIT(); __syncthreads(); }
                for (int tk = wave; tk < 32; tk += NWAVES) attn_task(g, QKVH, O0, O1, LSE, LSE + (size_t)M * NH, MIX8, btab, vt, b, h, mt, tk, lane);
            }
        }
        if (!(args.pad & 2u))
        for (int i = bx * (NWAVES * 64) + tid; i < BATCH * (SEQ / 8) * (POOLW / 8); i += G * NWAVES * 64) {
            const int cc = i & 255, run = (i >> 8) & (SEQ / 8 - 1), b = i >> 18; const int gi = __builtin_amdgcn_readfirstlane(cc >> 6);
            const int pos0 = run * 8;
            const bf16* base = PIN + (size_t)b * SEQ * POOLW + cc * 8;
            unsigned char* obase = MIX8 + ((size_t)b * SEQ + pos0) * DM + ATTW + cc * 8;
#define POOL_RUN(HW) do { constexpr int NR = 8 + 2 * (HW) - 1; v4u w_[NR]; \
                _Pragma("unroll") for (int q = 0; q < NR; ++q) { const int pp = pos0 - (HW) + q; const int pc = pp < 0 ? 0 : (pp > SEQ - 1 ? SEQ - 1 : pp); w_[q] = *(const v4u*)(base + (size_t)pc * POOLW); } \
                _Pragma("unroll") for (int q = 0; q < NR; ++q) { const int pp = pos0 - (HW) + q; if (pp < 0 || pp >= SEQ) w_[q] = (v4u){0u, 0u, 0u, 0u}; } \
                float s_[8] = {0.f, 0.f, 0.f, 0.f, 0.f, 0.f, 0.f, 0.f}; \
                _Pragma("unroll") for (int q = 0; q < 2 * (HW) - 1; ++q) { s_[0] += bf_lo(w_[q].x); s_[1] += bf_hi(w_[q].x); s_[2] += bf_lo(w_[q].y); s_[3] += bf_hi(w_[q].y); s_[4] += bf_lo(w_[q].z); s_[5] += bf_hi(w_[q].z); s_[6] += bf_lo(w_[q].w); s_[7] += bf_hi(w_[q].w); } \
                _Pragma("unroll") for (int k = 0; k < 8; ++k) { const v4u in_ = w_[k + 2 * (HW) - 1]; \
                    s_[0] += bf_lo(in_.x); s_[1] += bf_hi(in_.x); s_[2] += bf_lo(in_.y); s_[3] += bf_hi(in_.y); s_[4] += bf_lo(in_.z); s_[5] += bf_hi(in_.z); s_[6] += bf_lo(in_.w); s_[7] += bf_hi(in_.w); \
                    const int pos = pos0 + k; const int lo_ = pos - (HW) < 0 ? 0 : pos - (HW), hi_ = pos + (HW) > SEQ ? SEQ : pos + (HW); const float inv = 1.0f / (float)(hi_ - lo_); \
                    const v4u me = w_[k + (HW)]; \
                    const f32x4 lo4_ = {s_[0] * inv - bf_lo(me.x), s_[1] * inv - bf_hi(me.x), s_[2] * inv - bf_lo(me.y), s_[3] * inv - bf_hi(me.y)}, hi4_ = {s_[4] * inv - bf_lo(me.z), s_[5] * inv - bf_hi(me.z), s_[6] * inv - bf_lo(me.w), s_[7] * inv - bf_hi(me.w)}; \
                    const unsigned lo8_ = q8x4c(lo4_, P8SCALE), hi8_ = q8x4c(hi4_, P8SCALE); \
                    *(v2u*)(obase + (size_t)k * DM) = (v2u){lo8_, hi8_}; \
                    const v4u out_ = w_[k]; \
                    s_[0] -= bf_lo(out_.x); s_[1] -= bf_hi(out_.x); s_[2] -= bf_lo(out_.y); s_[3] -= bf_hi(out_.y); s_[4] -= bf_lo(out_.z); s_[5] -= bf_hi(out_.z); s_[6] -= bf_lo(out_.w); s_[7] -= bf_hi(out_.w); } } while (0)
            if (gi == 0) POOL_RUN(1); else if (gi == 1) POOL_RUN(2); else if (gi == 2) POOL_RUN(4); else POOL_RUN(8);
#undef POOL_RUN
        }
        if (BOTH(4)) GRID_BAR();
    }

    if (IN(5)) {
        PHASE_LANES();
        pg8::Gemm g{(const bf16*)MIX8, (const bf16*)WOUT8, M, DM, DM / 2, DM / 2, DM / 2, 1 << 30, 0, 1 << 30, 0}; pg8::StaticOrder S; S.init(M, DM, G, bx);
        pg8::EpiResBf16 E{x, MODV + (size_t)(2 * 2) * DM, X1B, DM, 1.0f / (A8SCALE * WOA8SCALE)};
        pg8::gemm_phase<pg8::EpiResBf16, pg8::StaticOrder, true, true>(lds + RING_OFF, g, S, E, wave);
        if (BOTH(5)) GRID_BAR();
    }

    if (IN(6)) {
        PHASE_LANES();
        for (int row = gw; row < M; row += NGW) {
            const int b = row / SEQ;
            const v4u* xr = (const v4u*)(X1B + (size_t)row * DM) + lane;
            f32x4 v[16]; float ss = 0.f;
#pragma unroll
            for (int j = 0; j < 8; ++j) { const v4u xw = xr[64 * j]; v[2 * j] = (f32x4){bf_lo(xw.x), bf_hi(xw.x), bf_lo(xw.y), bf_hi(xw.y)}; v[2 * j + 1] = (f32x4){bf_lo(xw.z), bf_hi(xw.z), bf_lo(xw.w), bf_hi(xw.w)};
                ss += (v[2 * j][0] * v[2 * j][0] + v[2 * j][1] * v[2 * j][1]) + (v[2 * j][2] * v[2 * j][2] + v[2 * j][3] * v[2 * j][3]);
                ss += (v[2 * j + 1][0] * v[2 * j + 1][0] + v[2 * j + 1][1] * v[2 * j + 1][1]) + (v[2 * j + 1][2] * v[2 * j + 1][2] + v[2 * j + 1][3] * v[2 * j + 1][3]); }
            const float rstd = 1.0f / sqrtf(wave_sum(ss) * (1.0f / DM) + RMS_EPS);
            const f32x4* gp = (const f32x4*)g_ffn + 2 * lane; const f32x4* shp = (const f32x4*)(MODV + (size_t)(3 * 2 + b) * DM) + 2 * lane; const f32x4* scp = (const f32x4*)(MODV + (size_t)(4 * 2 + b) * DM) + 2 * lane;
            v2u* op8 = (v2u*)(H8 + (size_t)row * DM) + lane;
            unsigned* hip = (unsigned*)(HHI + (size_t)row * (DM / 2)) + lane; unsigned* lop = (unsigned*)(HLO + (size_t)row * (DM / 2)) + lane;
            float ymx = 0.f;
#pragma unroll
            for (int j = 0; j < 16; ++j) { const int o_ = 128 * (j >> 1) + (j & 1); const f32x4 g4 = gp[o_], sh = shp[o_], sc = scp[o_];
                const f32x4 y = (v[j] * rstd) * g4 * (sc + 1.0f) + sh; v[j] = y;
                ymx = fmaxf(ymx, fmaxf(fmaxf(fabsf(y[0]), fabsf(y[1])), fmaxf(fabsf(y[2]), fabsf(y[3])))); }
#pragma unroll
            for (int o = 1; o < 64; o <<= 1) ymx = fmaxf(ymx, __shfl_xor(ymx, o));
            ymx = fmaxf(ymx, 1e-20f);
            const float qs = 119.0f / ymx;
#pragma unroll
            for (int j = 0; j < 8; ++j) { const unsigned w0 = q8x4(v[2 * j], qs), w1 = q8x4(v[2 * j + 1], qs);
                op8[64 * j] = (v2u){w0, w1};
                const unsigned t0 = (w0 ^ 0x80808080u) + 0x08080808u, t1 = (w1 ^ 0x80808080u) + 0x08080808u;
                hip[64 * j] = nibs16(((t0 >> 4) & 0x0f0f0f0fu) ^ 0x08080808u) | (nibs16(((t1 >> 4) & 0x0f0f0f0fu) ^ 0x08080808u) << 16);
                lop[64 * j] = nibs16(w0 & 0x0f0f0f0fu) | (nibs16(w1 & 0x0f0f0f0fu) << 16); }
            if (lane == 0) TSC[row] = ymx * (1.0f / 119.0f);
        }
        if (BOTH(6)) GRID_BAR();
    }

    if (IN(7)) {
        PHASE_LANES();
        pg8::Gemm g{(const bf16*)H8, (const bf16*)WQST8, M, PQ, DM / 2, DM / 2, DM / 2, 1 << 30, 0, 1 << 30, 0}; pg8::StaticOrder S; S.init(M, PQ, G, bx);
        pg8::EpiF32RowScale E{SC, PQ, TSC, WQS};
        pg8::gemm_phase<pg8::EpiF32RowScale, pg8::StaticOrder, true, true>(lds + RING_OFF, g, S, E, wave);
        if (BOTH(7)) GRID_BAR();
    }

    if (IN(8)) {
        PHASE_LANES();
        LAS unsigned short* EXPW = (LAS unsigned short*)(lds + RING_OFF);
        LAS float* GACT = (LAS float*)(lds + RING_OFF + 16384);
        LAS unsigned* W = (LAS unsigned*)(lds + RING_OFF + 49152 + wave * 4096);
        LAS unsigned* K1 = W; LAS unsigned* K2 = W + 128;
        LAS float* TV1 = (LAS float*)(W + 256); LAS int* TI1 = (LAS int*)(W + 272); LAS float* TV2 = (LAS float*)(W + 288); LAS int* TI2 = (LAS int*)(W + 304);
        LAS unsigned* CK = W + 320; LAS float* SV = (LAS float*)(W + 384); LAS int* SE = (LAS int*)(W + 400);
        const int c8 = lane & 7, r8 = lane >> 3;
        for (int blk = vcu; blk < M / 64; blk += G) {
            const int tok0 = blk * 64; const int b = tok0 / SEQ;
            const int ph = ((wave >> 2) ^ wave) & 1;
            for (int pass = 0; pass < 1 + ph; ++pass) {
            const int lt = ph ? 2 : 3;
            const int jb = 4 * pass;
            const int nt = 1 << lt;
            const float* sp0 = SC + (size_t)(tok0 + wave * 8 + jb) * PQ + lane;
            float na0 = sp0[0], na1 = sp0[64], nb0 = sp0[128], nb1 = sp0[192];
#pragma unroll 1
            for (int rec = 0; rec < 8 * nt; ++rec) {
                const int tl = wave * 8 + jb + (rec >> 3);
                { const int h = rec & 7;
                    const float a0 = na0, a1 = na1, b0 = nb0, b1 = nb1;
                    { const int nx = rec + 1 < 8 * nt ? rec + 1 : 0; const float* sp = sp0 + (size_t)nx * 256; na0 = sp[0]; na1 = sp[64]; nb0 = sp[128]; nb1 = sp[192]; }
                    unsigned ka0 = (fkey(a0) & ~127u) | (unsigned)(127 - lane), ka1 = (fkey(a1) & ~127u) | (unsigned)(63 - lane);
                    unsigned kb0 = (fkey(b0) & ~127u) | (unsigned)(127 - lane), kb1 = (fkey(b1) & ~127u) | (unsigned)(63 - lane);
                    bitonic128x2(ka0, ka1, kb0, kb1, lane);
                    if (lane >= 56) { K1[127 - 2 * lane] = ka0; K1[126 - 2 * lane] = ka1; K2[127 - 2 * lane] = kb0; K2[126 - 2 * lane] = kb1; }
                    LDS_WAIT();
                    const int ci_i = CAND_I[lane], ci_j = CAND_J[lane];
                    const unsigned kA = K1[ci_i], kB = K2[ci_j];
                    const float cv = fdec(kA) + fdec(kB);
                    const unsigned ck = lane < 50 ? ((fkey(cv) & ~255u) | (unsigned)(255 - (ci_i * 16 + ci_j))) : 0u;
                    CK[lane] = ck;
                    LDS_WAIT();
                    int rc = 0;
#pragma unroll 8
                    for (int kk = 0; kk < 16; ++kk) { const v4u q = ((const LAS v4u*)CK)[kk]; rc += (q.x > ck) + (q.y > ck) + (q.z > ck) + (q.w > ck); }
                    if (lane < 50 && rc < 16) { SV[rc] = cv; SE[rc] = (int)((127u - (kA & 127u)) * 128u + (127u - (kB & 127u))); }
                    LDS_WAIT();
                    const float top0 = SV[0], myv = SV[lane & 15]; const int mye = SE[lane & 15];
                    const float e = __expf(myv - top0);
                    float ssum = e; ssum += __shfl_xor(ssum, 1); ssum += __shfl_xor(ssum, 2); ssum += __shfl_xor(ssum, 4); ssum += __shfl_xor(ssum, 8);
                    if (lane < 16) { EXPW[tl * 128 + h * 16 + lane] = (unsigned short)mye; GACT[tl * 128 + h * 16 + lane] = e / ssum; }
                    LDS_WAIT();
                }
            }
            LAS float* ACC = (LAS float*)(lds + RING_OFF + 81920);
            for (int i = lane; i < nt * 128; i += 64) ACC[(wave * 8 + jb) * 128 + i] = 0.f;
            LDS_WAIT();
            if (!(args.pad & 8u)) {
                v4u gA[16], gB[16]; v4u hA, hB, lA, lB;
#define P10_LOADU(idx, G_, H_, L_) do { const int s_ = (idx) >> lt, j_ = jb + ((idx) & (nt - 1)); const int tl_ = wave * 8 + j_; \
                    const unsigned char* tb_ = UB + (size_t)s_ * NEXP * 128 + 16 * c8; \
                    H_ = *(const v4u*)(HHI + (size_t)(tok0 + tl_) * (DM / 2) + 128 * s_ + 16 * c8); L_ = *(const v4u*)(HLO + (size_t)(tok0 + tl_) * (DM / 2) + 128 * s_ + 16 * c8); \
                    _Pragma("unroll") for (int i = 0; i < 16; ++i) { const unsigned e_ = EXPW[tl_ * 128 + r8 + 8 * i]; G_[i] = *(const v4u*)(tb_ + (size_t)e_ * 128); } } while (0)
#define P10_COMPU(idx, G_, H_, L_) do { const int tl = wave * 8 + jb + ((idx) & (nt - 1)); int p[16]; \
                    _Pragma("unroll") for (int i = 0; i < 16; ++i) { int a_ = 0, b_ = 0; \
                        a_ = __builtin_amdgcn_sdot8((int)G_[i].x, (int)H_.x, a_, false); a_ = __builtin_amdgcn_sdot8((int)G_[i].y, (int)H_.y, a_, false); \
                        a_ = __builtin_amdgcn_sdot8((int)G_[i].z, (int)H_.z, a_, false); a_ = __builtin_amdgcn_sdot8((int)G_[i].w, (int)H_.w, a_, false); \
                        b_ = __builtin_amdgcn_sdot8((int)G_[i].x, (int)L_.x, b_, false); b_ = __builtin_amdgcn_sdot8((int)G_[i].y, (int)L_.y, b_, false); \
                        b_ = __builtin_amdgcn_sdot8((int)G_[i].z, (int)L_.z, b_, false); b_ = __builtin_amdgcn_sdot8((int)G_[i].w, (int)L_.w, b_, false); p[i] = a_ * 16 + b_; } \
                    int q8[8], q4[4], q2[2]; \
                      \
                    _Pragma("unroll") for (int m = 0; m < 8; ++m) { const int kp = (c8 & 4) ? p[m + 8] : p[m]; \
                        unsigned rv_ = __builtin_amdgcn_update_dpp(0u, (unsigned)p[m], 0x104, 0xf, 0x5, false); rv_ = __builtin_amdgcn_update_dpp(rv_, (unsigned)p[m + 8], 0x114, 0xf, 0xa, false); q8[m] = kp + (int)rv_; } \
                    _Pragma("unroll") for (int m = 0; m < 4; ++m) { const int snd = (c8 & 2) ? q8[m] : q8[m + 4], kp = (c8 & 2) ? q8[m + 4] : q8[m]; q4[m] = kp + (int)__builtin_amdgcn_update_dpp(0u, (unsigned)snd, 0x4e, 0xf, 0xf, false); } \
                    _Pragma("unroll") for (int m = 0; m < 2; ++m) { const int snd = (c8 & 1) ? q4[m] : q4[m + 2], kp = (c8 & 1) ? q4[m + 2] : q4[m]; q2[m] = kp + (int)__builtin_amdgcn_update_dpp(0u, (unsigned)snd, 0xb1, 0xf, 0xf, false); } \
                    LAS float* ap = ACC + tl * 128 + r8 + 16 * c8;         \
                    ap[0] += (float)q2[0]; ap[8] += (float)q2[1]; } while (0)
                P10_LOADU(0, gA, hA, lA);
#pragma unroll 1
                for (int idx = 0; idx < 16 * nt; idx += 2) {
                    P10_LOADU(idx + 1, gB, hB, lB);
                    P10_COMPU(idx, gA, hA, lA);
                    if (idx + 2 < 16 * nt) P10_LOADU(idx + 2, gA, hA, lA);
                    P10_COMPU(idx + 1, gB, hB, lB);
                }
#undef P10_LOADU
#undef P10_COMPU
            }
            LDS_WAIT();
            for (int i = lane; i < nt * 128; i += 64) { const int o_ = (wave * 8 + jb) * 128 + i; const unsigned e = EXPW[o_];
                const float a = ACC[o_] * SCL[e] * TSC[tok0 + (o_ >> 7)]; GACT[o_] = gelu_tanh(a) * GACT[o_] * SCL[NEXP + e]; }
            LDS_WAIT();
            LAS float* SSQ = ACC;
            for (int j = 0; j < nt; ++j) SSQ[(wave * 8 + jb + j) * 128 + lane] = 0.f;
            LDS_WAIT();
            const float* gtp = MODV + (size_t)(5 * 2 + b) * DM;
            if (!(args.pad & 16u)) {
                v4u gA[16], gB[16]; float aA[16], aB[16];
#define P10_LOADV(idx, G_, A_) do { const int s_ = (idx) >> lt, j_ = jb + ((idx) & (nt - 1)); const int tl_ = wave * 8 + j_; \
                    const unsigned char* tb_ = VB + (size_t)s_ * NEXP * 128 + 16 * c8; \
                    _Pragma("unroll") for (int i = 0; i < 16; ++i) { const int k_ = tl_ * 128 + r8 + 8 * i; const unsigned e_ = EXPW[k_]; A_[i] = GACT[k_]; G_[i] = *(const v4u*)(tb_ + (size_t)e_ * 128); } } while (0)
#define P10_COMPV(idx, G_, A_) do { const int s_c = (idx) >> lt; const int tl = wave * 8 + jb + ((idx) & (nt - 1)); const int t = tok0 + tl; \
                    const int d = 256 * s_c + 32 * c8 + 2 * r8; \
                    const unsigned xw0 = __builtin_nontemporal_load((const unsigned*)(X1B + (size_t)t * DM + d)), xw1 = __builtin_nontemporal_load((const unsigned*)(X1B + (size_t)t * DM + d + 16)); \
                    const f32x2 gv0 = *(const f32x2*)(gtp + d), gv1 = *(const f32x2*)(gtp + d + 16);     \
                    float ssq = SSQ[tl * 128 + lane]; \
                    _Pragma("unroll") for (int hf = 0; hf < 2; ++hf) {     \
                        f32x2 o8[8]; \
                        _Pragma("unroll") for (int q = 0; q < 8; ++q) o8[q] = (f32x2){0.f, 0.f}; \
                        _Pragma("unroll") for (int i = 0; i < 16; ++i) \
                            _Pragma("unroll") for (int q = 0; q < 2; ++q) { const unsigned w_ = G_[i][2 * hf + q]; \
                                o8[4 * q] += __builtin_amdgcn_cvt_scalef32_pk_f32_fp4(w_, 1.0f, 0) * A_[i]; o8[4 * q + 1] += __builtin_amdgcn_cvt_scalef32_pk_f32_fp4(w_, 1.0f, 1) * A_[i]; \
                                o8[4 * q + 2] += __builtin_amdgcn_cvt_scalef32_pk_f32_fp4(w_, 1.0f, 2) * A_[i]; o8[4 * q + 3] += __builtin_amdgcn_cvt_scalef32_pk_f32_fp4(w_, 1.0f, 3) * A_[i]; } \
                        float p[16], q8[8], q4[4], q2[2]; \
                        _Pragma("unroll") for (int q = 0; q < 8; ++q) { p[2 * q] = o8[q].x; p[2 * q + 1] = o8[q].y; } \
                          \
                        _Pragma("unroll") for (int m = 0; m < 8; ++m) { const auto r_ = __builtin_amdgcn_permlane32_swap(__float_as_uint(p[m]), __float_as_uint(p[m + 8]), false, false); q8[m] = __uint_as_float(r_[0]) + __uint_as_float(r_[1]); } \
                        _Pragma("unroll") for (int m = 0; m < 4; ++m) { const auto r_ = __builtin_amdgcn_permlane16_swap(__float_as_uint(q8[m]), __float_as_uint(q8[m + 4]), false, false); q4[m] = __uint_as_float(r_[0]) + __uint_as_float(r_[1]); } \
                        _Pragma("unroll") for (int m = 0; m < 2; ++m) { const float snd = (r8 & 1) ? q4[m] : q4[m + 2], kp = (r8 & 1) ? q4[m + 2] : q4[m]; q2[m] = kp + __uint_as_float(__builtin_amdgcn_update_dpp(0u, __float_as_uint(snd), 0x128, 0xf, 0xf, false)); } \
                        const unsigned xw = hf ? xw1 : xw0; const f32x2 gv = hf ? gv1 : gv0; \
                        f32x2 y; y.x = bf_lo(xw) + gv.x * q2[0]; y.y = bf_hi(xw) + gv.y * q2[1]; \
                        __builtin_nontemporal_store(cvt_pk_bf16(y.x, y.y), (unsigned*)(YB + (size_t)t * DM + d + 16 * hf)); \
                        ssq += (y.x * y.x + y.y * y.y); } \
                    SSQ[tl * 128 + lane] = ssq; } while (0)
                P10_LOADV(0, gA, aA);
#pragma unroll 1
                for (int idx = 0; idx < 16 * nt; idx += 2) {
                    P10_LOADV(idx + 1, gB, aB);
                    P10_COMPV(idx, gA, aA);
                    if (idx + 2 < 16 * nt) P10_LOADV(idx + 2, gA, aA);
                    P10_COMPV(idx + 1, gB, aB);
                }
#undef P10_LOADV
#undef P10_COMPV
            }
            VM_WAIT(); LDS_WAIT();
            __builtin_amdgcn_fence(__ATOMIC_ACQUIRE, "agent");
            VM_WAIT();
            for (int j = 0; j < nt; ++j) {
                const int tl = wave * 8 + jb + j; const int t = tok0 + tl;
                const float rstd = 1.0f / sqrtf(wave_sum(SSQ[tl * 128 + lane]) * (1.0f / DM) + RMS_EPS);
                f32x4* op = (f32x4*)(out + (size_t)t * DM) + lane; const f32x4* gp = (const f32x4*)g_final + lane; const v2u* yp = (const v2u*)(YB + (size_t)t * DM) + lane;
#pragma unroll 4
                for (int i = 0; i < 16; ++i) { const v2u yw = __builtin_nontemporal_load(yp + 64 * i); const f32x4 y = {bf_lo(yw.x), bf_hi(yw.x), bf_lo(yw.y), bf_hi(yw.y)}; __builtin_nontemporal_store(y * rstd * gp[64 * i], op + 64 * i); }
            }
            LDS_WAIT();
            }
        }
    }
#undef IN
#undef BOTH
#undef GRID_BAR
}

extern "C" void kernel_launch(void* const* d_in, const int* in_sizes, int n_in, void* d_out, int out_size, void* d_ws, size_t ws_size, hipStream_t stream) {
    static int grid = 0;
    if (grid == 0) {
        if (n_in != 16 || in_sizes[0] != M * DM || out_size != M * DM || ws_size < WS_END) {
            fprintf(stderr, "kernel_launch: shape/workspace mismatch: n_in %d in0 %d out %d ws %zu (need %zu)\n", n_in, n_in > 0 ? in_sizes[0] : -1, out_size, ws_size, (size_t)WS_END); grid = -1; return; }
        int dev = 0, cus = 0, per_cu = 0;
        if (hipGetDevice(&dev) != hipSuccess || hipDeviceGetAttribute(&cus, hipDeviceAttributeMultiprocessorCount, dev) != hipSuccess) { grid = -1; return; }
        if (hipFuncSetAttribute((const void*)fwd_kernel, hipFuncAttributeMaxDynamicSharedMemorySize, LDS_BYTES) != hipSuccess) { fprintf(stderr, "kernel_launch: hipFuncSetAttribute failed\n"); grid = -1; return; }
        if (hipOccupancyMaxActiveBlocksPerMultiprocessor(&per_cu, (const void*)fwd_kernel, NWAVES * 64, LDS_BYTES) != hipSuccess || per_cu < 1)
            fprintf(stderr, "kernel_launch: note: occupancy query reports %d workgroups per CU\n", per_cu);
        (void)hipGetLastError();
        grid = cus;
    }
    if (grid < 0) return;
    if (hipMemsetAsync((char*)d_ws + WS_CTL, 0, CTL_ZERO_BYTES, stream) != hipSuccess) { fprintf(stderr, "kernel_launch: memset failed\n"); return; }
    Args a{};
    for (int i = 0; i < 16; ++i) a.in[i] = (const float*)d_in[i];
    a.out = (float*)d_out; a.ws = (unsigned char*)d_ws;
#ifdef PROBE_MASK
    {
#ifndef PROBE_PAD
#define PROBE_PAD 0
#endif
        a.mask = PROBE_MASK; a.pad = PROBE_PAD;
        hipLaunchKernelGGL(fwd_kernel, dim3(grid), dim3(NWAVES * 64), LDS_BYTES, stream, a);
        (void)hipMemsetAsync((char*)d_ws + WS_CTL, 0, CTL_ZERO_BYTES, stream);
    }
#endif
    for (int li = 0; li < MK_N_LAUNCHES; ++li) {
        a.mask = (MK_N_LAUNCHES == PER_PHASE) ? (1u << li) : ((1u << PER_PHASE) - 1u); a.pad = 0;
        hipLaunchKernelGGL(fwd_kernel, dim3(grid), dim3(NWAVES * 64), LDS_BYTES, stream, a);
        const hipError_t le = hipPeekAtLastError();
        if (le != hipSuccess) { fprintf(stderr, "kernel_launch: launch %d failed: %s\n", li, hipGetErrorName(le)); break; }
    }
}
```

```cpp
#include <hip/hip_runtime.h>
#include <cstdio>
#include <cstdint>

#ifndef MK_N_LAUNCHES
#define MK_N_LAUNCHES 1
#endif

#define GAS __attribute__((address_space(1)))
#define LAS __attribute__((address_space(3)))
typedef unsigned short bf16;
typedef unsigned v4u __attribute__((ext_vector_type(4)));
typedef unsigned v2u __attribute__((ext_vector_type(2)));
typedef float f32x4 __attribute__((ext_vector_type(4)));
typedef float f32x2 __attribute__((ext_vector_type(2)));
typedef float f32x16 __attribute__((ext_vector_type(16)));
typedef short bf16x8 __attribute__((ext_vector_type(8)));
typedef short s16x4 __attribute__((ext_vector_type(4)));
typedef __bf16 bf2_t __attribute__((ext_vector_type(2)));

constexpr int BATCH = 2, SEQ = 8192, DM = 4096, M = BATCH * SEQ;
constexpr int NH = 16, HD = 128, ATTW = 2048, POOLW = 2048, INW = 8192;
constexpr int NMOD = 6 * DM;
constexpr int PQ = 2048;
constexpr int NEXP = 16384;
constexpr float RMS_EPS = 1e-6f;
constexpr float LOG2E = 1.4426950408889634f;
constexpr float QSCALE = 0.08838834764831845f * LOG2E;
constexpr float H8SCALE = 16.f, W8SCALE = 2048.f;
constexpr float A8SCALE = 128.f, P8SCALE = 24.f, WOA8SCALE = 256.f, WOP8SCALE = (A8SCALE * WOA8SCALE) / P8SCALE;
constexpr float WQ8SCALE = 1024.f;
constexpr int KS_ADA = 64;

constexpr size_t MiB = 1u << 20;
constexpr float O8MUL = 16.0f;
constexpr float V8MUL = 4.0f, P8MUL = 256.0f;
constexpr float Q8MUL = 16.0f, K8MUL = 2.0f;
constexpr size_t WS_CTL = 0, CTL_ZERO_BYTES = 1 * MiB;
constexpr size_t WS_MODV = 1 * MiB;
constexpr size_t WS_SCL = 2 * MiB;
constexpr size_t WS_MODP = 4 * MiB;
constexpr size_t WS_SKT = 20 * MiB;
constexpr size_t WS_PWS = 22 * MiB;
constexpr size_t WS_WQST = 24 * MiB;
constexpr size_t WS_WOUT2 = 40 * MiB;
constexpr size_t WS_WIN8 = 72 * MiB;
constexpr size_t WS_H8 = 1100 * MiB;
constexpr size_t WS_UB = 136 * MiB;
constexpr size_t WS_VB = 264 * MiB;
constexpr size_t WS_H = 392 * MiB;
constexpr size_t WS_PROJ = 520 * MiB;
constexpr size_t WS_QKVH = 1292 * MiB;
constexpr size_t WS_MIXIN = 776 * MiB;
constexpr size_t WS_WOPT = 904 * MiB;
constexpr size_t WS_WQB = 936 * MiB;
constexpr size_t WS_O0 = 968 * MiB, WS_O1 = 1032 * MiB;
constexpr size_t WS_LSE = 1096 * MiB;
constexpr size_t WS_SC = 1164 * MiB;
constexpr size_t WS_END = 1484 * MiB;

constexpr int RING_OFF = 0, RING_BYTES = 131072;
constexpr int ATT_WAVE_BYTES = 17408;
constexpr int SHARED_OFF = 139264;
constexpr int LDSCTL_OFF = 139264 + 4096, MISC_OFF = LDSCTL_OFF + 320;
constexpr int LDS_BYTES = 147456;
constexpr int NWAVES = 8;
constexpr int CW_BAR = 4096;

#define LDS_WAIT() asm volatile("s_waitcnt lgkmcnt(0)" ::: "memory")
#define VM_WAIT() asm volatile("s_waitcnt vmcnt(0)" ::: "memory")

__device__ __forceinline__ unsigned cvt_pk_bf16(float lo, float hi) { unsigned r; asm volatile("v_cvt_pk_bf16_f32 %0, %1, %2" : "=v"(r) : "v"(lo), "v"(hi)); return r; }
__device__ __forceinline__ float bf_lo(unsigned u) { return __uint_as_float(u << 16); }
__device__ __forceinline__ float bf_hi(unsigned u) { return __uint_as_float(u & 0xffff0000u); }
__device__ __forceinline__ float wave_sum(float v) {
#pragma unroll
    for (int o = 1; o < 64; o <<= 1) v += __shfl_xor(v, o);
    return v;
}

__device__ __forceinline__ unsigned q8x4c(f32x4 v, float s) {
    const unsigned b0 = __float_as_uint(__builtin_amdgcn_fmed3f(v[0] * s, -127.f, 127.f) + 12582912.0f), b1 = __float_as_uint(__builtin_amdgcn_fmed3f(v[1] * s, -127.f, 127.f) + 12582912.0f);
    const unsigned b2 = __float_as_uint(__builtin_amdgcn_fmed3f(v[2] * s, -127.f, 127.f) + 12582912.0f), b3 = __float_as_uint(__builtin_amdgcn_fmed3f(v[3] * s, -127.f, 127.f) + 12582912.0f);
    return (b0 & 0xffu) | ((b1 & 0xffu) << 8) | ((b2 & 0xffu) << 16) | (b3 << 24);
}
__device__ __forceinline__ unsigned q8x4(f32x4 v, float s) {
    const unsigned b0 = __float_as_uint(v[0] * s + 12582912.0f), b1 = __float_as_uint(v[1] * s + 12582912.0f), b2 = __float_as_uint(v[2] * s + 12582912.0f), b3 = __float_as_uint(v[3] * s + 12582912.0f);
    return (b0 & 0xffu) | ((b1 & 0xffu) << 8) | ((b2 & 0xffu) << 16) | (b3 << 24);
}
__device__ __forceinline__ int hw_lane() { int l; asm volatile("v_mbcnt_lo_u32_b32 %0, -1, 0\n\tv_mbcnt_hi_u32_b32 %0, -1, %0" : "=v"(l)); return l; }
__device__ __forceinline__ unsigned q4x4(f32x4 v, float s) {
    const unsigned b0 = __float_as_uint(__builtin_amdgcn_fmed3f(v[0] * s, -8.f, 7.f) + 12582912.0f), b1 = __float_as_uint(__builtin_amdgcn_fmed3f(v[1] * s, -8.f, 7.f) + 12582912.0f);
    const unsigned b2 = __float_as_uint(__builtin_amdgcn_fmed3f(v[2] * s, -8.f, 7.f) + 12582912.0f), b3 = __float_as_uint(__builtin_amdgcn_fmed3f(v[3] * s, -8.f, 7.f) + 12582912.0f);
    return (b0 & 15u) | ((b1 & 15u) << 4) | ((b2 & 15u) << 8) | ((b3 & 15u) << 12);
}
__device__ __forceinline__ unsigned nibs16(unsigned x) { x = (x | (x >> 4)) & 0x00ff00ffu; return (x | (x >> 8)) & 0xffffu; }
namespace pg8 {
typedef unsigned short bf16_t;
typedef int v4i_t __attribute__((ext_vector_type(4)));
typedef int v8i_t __attribute__((ext_vector_type(8)));
constexpr int BM = 256, BK = 64, HALF = 128, HTB = HALF * BK * 2, STAGE_BYTES = 8 * HTB, NXCD = 8, WGM = 8;

__host__ __device__ __forceinline__ int lds_byte(int r, int c) { const int st = (r >> 4) * 2 + (c >> 5), rr = r & 15, cc = c & 31, ob = rr * 64 + cc * 2; return st * 1024 + (ob ^ (((ob >> 9) & 1) << 5)); }
__host__ __device__ __forceinline__ void stage_rc(int b, int& R, int& C) { const int st = b / 1024, sb = b % 1024, swz = sb ^ (((sb >> 9) & 1) << 5); R = (st >> 1) * 16 + swz / 64; C = (st & 1) * 32 + (swz % 64) / 2; }
__host__ __device__ __forceinline__ int perm32(int rho) { const int n = rho >> 4, i = rho & 15; return 8 * (i >> 2) + 4 * n + (i & 3); }

template <int NF> __device__ __forceinline__ void pg8_ldfrag16(bf16x8 (&dst)[NF][2], const LAS unsigned char* base, int off) {
#pragma unroll
    for (int m = 0; m < NF; ++m)
#pragma unroll
        for (int k = 0; k < 2; ++k) dst[m][k] = *(const LAS bf16x8*)(base + off + m * 2048 + k * 1024);
}
__device__ __forceinline__ void pg8_mma16(f32x4 (&acc)[4][2], const bf16x8 (&At)[4][2], const bf16x8 (&Bt)[2][2]) {
#pragma unroll
    for (int m = 0; m < 4; ++m)
#pragma unroll
        for (int n = 0; n < 2; ++n)
#pragma unroll
            for (int k = 0; k < 2; ++k) acc[m][n] = __builtin_amdgcn_mfma_f32_16x16x32_bf16(Bt[n][k], At[m][k], acc[m][n], 0, 0, 0);
}
__device__ __forceinline__ void pg8_mma8(v4i_t (&acc)[4][2], const bf16x8 (&At)[4][2], const bf16x8 (&Bt)[2][2]) {
#pragma unroll
    for (int m = 0; m < 4; ++m)
#pragma unroll
        for (int n = 0; n < 2; ++n)
#pragma unroll
            for (int k = 0; k < 2; ++k) acc[m][n] = __builtin_amdgcn_mfma_i32_16x16x64_i8(__builtin_bit_cast(v4i_t, Bt[n][k]), __builtin_bit_cast(v4i_t, At[m][k]), acc[m][n], 0, 0, 0);
}
struct Unit { int pm, pn; };
struct Gemm { const bf16_t* A; const bf16_t* Bt; int M, N, K, lda, ldb, agrp_div, agrp_cols, bgrp_div, bgrp_cols; };

struct StaticOrder {
    int nM, nN, nwg, G, c;
    __host__ __device__ void init(int M_, int N_, int G_, int c_) { nM = M_ / BM; nN = N_ / BM; nwg = nM * nN; G = G_; c = c_; }
    __host__ __device__ bool next(int i, Unit& u) const {
        const long L = (long)i * G + c; if (L >= nwg) return false;
        int wgid = (int)L; { const int q = nwg / NXCD, r = nwg % NXCD, xcd = wgid % NXCD, off = wgid / NXCD; wgid = (xcd < r ? xcd * (q + 1) : r * (q + 1) + (xcd - r) * q) + off; }
        const int nig = WGM * nN, gid = wgid / nig, fm = gid * WGM, gsz = (nM - fm) < WGM ? (nM - fm) : WGM;
        u.pm = fm + ((wgid % nig) % gsz); u.pn = (wgid % nig) / gsz; return true;
    }
    __device__ __forceinline__ void a_ready(const Unit&) const {}
    __device__ __forceinline__ void done(const Unit&) const {}
};

struct EpiBf16 {
    static constexpr bool PERM = true, AFTER_DRAIN = false;
    bf16_t* O; int ldc; int scale_cols; float scale0; bf16_t* HM; int hm_cols; int hm_rows; float scale1 = 1.0f;
    int f8_cols = 0;
    __device__ __forceinline__ void operator()(const f32x4 (&acc)[2][2][4][2], const Unit& u, int wr, int wc, int fr, int fq) const {
        const int row0 = u.pm * BM + wr * 64 + fr; const int colt = u.pn * BM;
        const float sc = (colt < scale_cols) ? scale0 : scale1;
        const bool hm = colt < hm_cols;
        const int cw = wc * 32 + 8 * fq;
        bf16_t* base = hm ? HM + (size_t)(colt / HALF) * hm_rows * HALF + cw : O + (colt - hm_cols) + cw;
        const size_t rpitch = hm ? (size_t)HALF : (size_t)ldc, hstep = hm ? (size_t)hm_rows * HALF : (size_t)HALF;
        if (colt < f8_cols) {
            const float s8 = sc * ((colt < scale_cols) ? Q8MUL : (colt < 2 * scale_cols ? K8MUL : V8MUL));
            unsigned char* b8 = (unsigned char*)HM + (size_t)(colt / HALF) * hm_rows * HALF + cw;
#pragma unroll
            for (int ai = 0; ai < 2; ++ai)
#pragma unroll
                for (int m = 0; m < 4; ++m) { unsigned char* rowp = b8 + (size_t)(row0 + ai * HALF + m * 16) * HALF;
#pragma unroll
                    for (int bj = 0; bj < 2; ++bj) { const f32x4 v0 = acc[ai][bj][m][0] * s8, v1 = acc[ai][bj][m][1] * s8;
                        int lo = 0, hi = 0;
                        lo = __builtin_amdgcn_cvt_pk_fp8_f32(v0[0], v0[1], lo, false); lo = __builtin_amdgcn_cvt_pk_fp8_f32(v0[2], v0[3], lo, true);
                        hi = __builtin_amdgcn_cvt_pk_fp8_f32(v1[0], v1[1], hi, false); hi = __builtin_amdgcn_cvt_pk_fp8_f32(v1[2], v1[3], hi, true);
                        *(v2u*)(rowp + (size_t)bj * hm_rows * HALF) = (v2u){(unsigned)lo, (unsigned)hi}; } }
            return;
        }
#pragma unroll
        for (int ai = 0; ai < 2; ++ai)
#pragma unroll
            for (int m = 0; m < 4; ++m) { bf16_t* rowp = base + (size_t)(row0 + ai * HALF + m * 16) * rpitch;
#pragma unroll
                for (int bj = 0; bj < 2; ++bj) { f32x4 v0 = acc[ai][bj][m][0] * sc, v1 = acc[ai][bj][m][1] * sc;
                    v4u w; w.x = cvt_pk_bf16(v0[0], v0[1]); w.y = cvt_pk_bf16(v0[2], v0[3]); w.z = cvt_pk_bf16(v1[0], v1[1]); w.w = cvt_pk_bf16(v1[2], v1[3]);
                    *(v4u*)(rowp + bj * hstep) = w; } }
    }
};
struct EpiBf16ColScale {
    static constexpr bool PERM = true, AFTER_DRAIN = false;
    bf16_t* O; int ldc; int coff; const float* cs;
    __device__ __forceinline__ void operator()(const f32x4 (&acc)[2][2][4][2], const Unit& u, int wr, int wc, int fr, int fq) const {
        const int row0 = u.pm * BM + wr * 64 + fr; const int col0 = u.pn * BM + wc * 32 + 8 * fq;
        f32x4 sv[2][2];
#pragma unroll
        for (int bj = 0; bj < 2; ++bj)
#pragma unroll
            for (int n = 0; n < 2; ++n) sv[bj][n] = *(const f32x4*)(cs + col0 + bj * HALF + 4 * n);
#pragma unroll
        for (int ai = 0; ai < 2; ++ai)
#pragma unroll
            for (int m = 0; m < 4; ++m) { bf16_t* rowp = O + (size_t)(row0 + ai * HALF + m * 16) * ldc + coff + col0;
#pragma unroll
                for (int bj = 0; bj < 2; ++bj) { f32x4 v0 = acc[ai][bj][m][0] * sv[bj][0], v1 = acc[ai][bj][m][1] * sv[bj][1];
                    v4u w; w.x = cvt_pk_bf16(v0[0], v0[1]); w.y = cvt_pk_bf16(v0[2], v0[3]); w.z = cvt_pk_bf16(v1[0], v1[1]); w.w = cvt_pk_bf16(v1[2], v1[3]);
                    *(v4u*)(rowp + bj * HALF) = w; } }
    }
};
struct EpiI8 {
    static constexpr bool PERM = true, AFTER_DRAIN = false;
    unsigned char* O; int ldc; int coff; float scale;
    __device__ __forceinline__ void operator()(const f32x4 (&acc)[2][2][4][2], const Unit& u, int wr, int wc, int fr, int fq) const {
        const int row0 = u.pm * BM + wr * 64 + fr; const int col0 = u.pn * BM + wc * 32 + 8 * fq;
#pragma unroll
        for (int ai = 0; ai < 2; ++ai)
#pragma unroll
            for (int m = 0; m < 4; ++m) { unsigned char* rowp = O + (size_t)(row0 + ai * HALF + m * 16) * ldc + coff + col0;
#pragma unroll
                for (int bj = 0; bj < 2; ++bj) *(v2u*)(rowp + bj * HALF) = (v2u){q8x4c(acc[ai][bj][m][0], scale), q8x4c(acc[ai][bj][m][1], scale)}; }
    }
};
struct EpiF32RowScale {
    static constexpr bool PERM = false, AFTER_DRAIN = false;
    float* O; int ldc; const float* rs; const float* cs;
    __device__ __forceinline__ void operator()(const f32x4 (&acc)[2][2][4][2], const Unit& u, int wr, int wc, int fr, int fq) const {
        const int row0 = u.pm * BM + wr * 64 + fr; const int col0 = u.pn * BM + wc * 32 + 4 * fq;
        f32x4 cv[2][2];
#pragma unroll
        for (int bj = 0; bj < 2; ++bj)
#pragma unroll
            for (int n = 0; n < 2; ++n) cv[bj][n] = *(const f32x4*)(cs + col0 + bj * HALF + n * 16);
#pragma unroll
        for (int ai = 0; ai < 2; ++ai)
#pragma unroll
            for (int m = 0; m < 4; ++m) { const int row = row0 + ai * HALF + m * 16; const float r = rs[row]; const size_t off = (size_t)row * ldc + col0;
#pragma unroll
                for (int bj = 0; bj < 2; ++bj)
#pragma unroll
                    for (int n = 0; n < 2; ++n) *(f32x4*)(O + off + bj * HALF + n * 16) = acc[ai][bj][m][n] * cv[bj][n] * r; }
    }
};
struct EpiResBf16 {
    static constexpr bool PERM = true, AFTER_DRAIN = false;
    const float* X; const float* gate; bf16_t* O; int ldc; float ascale;
    __device__ __forceinline__ void operator()(const f32x4 (&acc)[2][2][4][2], const Unit& u, int wr, int wc, int fr, int fq) const {
        const int row0 = u.pm * BM + wr * 64 + fr; const int col0 = u.pn * BM + wc * 32 + 8 * fq; const int b = (u.pm * BM) / SEQ;
        f32x4 gv[2][2];
#pragma unroll
        for (int bj = 0; bj < 2; ++bj)
#pragma unroll
            for (int n = 0; n < 2; ++n) gv[bj][n] = *(const f32x4*)(gate + (size_t)b * DM + col0 + bj * HALF + 4 * n) * ascale;
#pragma unroll
        for (int ai = 0; ai < 2; ++ai)
#pragma unroll
            for (int m = 0; m < 4; ++m) { const size_t off = (size_t)(row0 + ai * HALF + m * 16) * ldc + col0;
#pragma unroll
                for (int bj = 0; bj < 2; ++bj) { const f32x4 x0 = *(const f32x4*)(X + off + bj * HALF), x1 = *(const f32x4*)(X + off + bj * HALF + 4);
                    const f32x4 v0 = x0 + gv[bj][0] * acc[ai][bj][m][0], v1 = x1 + gv[bj][1] * acc[ai][bj][m][1];
                    v4u w; w.x = cvt_pk_bf16(v0[0], v0[1]); w.y = cvt_pk_bf16(v0[2], v0[3]); w.z = cvt_pk_bf16(v1[0], v1[1]); w.w = cvt_pk_bf16(v1[2], v1[3]);
                    *(v4u*)(O + off + bj * HALF) = w; } }
    }
};
struct EpiResF32 {
    static constexpr bool PERM = false, AFTER_DRAIN = false;
    const float* X; const float* gate; float* O; int ldc;
    __device__ __forceinline__ void operator()(const f32x4 (&acc)[2][2][4][2], const Unit& u, int wr, int wc, int fr, int fq) const {
        const int row0 = u.pm * BM + wr * 64 + fr; const int col0 = u.pn * BM + wc * 32 + 4 * fq; const int b = (u.pm * BM) / SEQ;
        f32x4 gv[2][2];
#pragma unroll
        for (int bj = 0; bj < 2; ++bj)
#pragma unroll
            for (int n = 0; n < 2; ++n) gv[bj][n] = *(const f32x4*)(gate + (size_t)b * DM + col0 + bj * HALF + n * 16);
#pragma unroll
        for (int ai = 0; ai < 2; ++ai)
#pragma unroll
            for (int m = 0; m < 4; ++m) { const size_t off = (size_t)(row0 + ai * HALF + m * 16) * ldc + col0;
#pragma unroll
                for (int bj = 0; bj < 2; ++bj)
#pragma unroll
                    for (int n = 0; n < 2; ++n) { const f32x4 xv = *(const f32x4*)(X + off + bj * HALF + n * 16);
                        *(f32x4*)(O + off + bj * HALF + n * 16) = xv + gv[bj][n] * acc[ai][bj][m][n]; } }
    }
};
struct EpiF32 {
    static constexpr bool PERM = false, AFTER_DRAIN = false;
    float* O; int ldc;
    __device__ __forceinline__ void operator()(const f32x4 (&acc)[2][2][4][2], const Unit& u, int wr, int wc, int fr, int fq) const {
        const int row0 = u.pm * BM + wr * 64 + fr; const int col0 = u.pn * BM + wc * 32 + 4 * fq;
#pragma unroll
        for (int ai = 0; ai < 2; ++ai)
#pragma unroll
            for (int m = 0; m < 4; ++m) { const size_t off = (size_t)(row0 + ai * HALF + m * 16) * ldc + col0;
#pragma unroll
                for (int bj = 0; bj < 2; ++bj)
#pragma unroll
                    for (int n = 0; n < 2; ++n) *(f32x4*)(O + off + bj * HALF + n * 16) = acc[ai][bj][m][n]; }
    }
};

template <class Epi, class Sched, bool ALIGN_EPI, bool I8 = false>
__device__ __forceinline__ void gemm_phase(LAS unsigned char* lds, const Gemm g, const Sched& S, const Epi& E, const int wave_id) {
    const int wid = wave_id, lane = hw_lane(), tid = wid * 64 + lane,
              wr = wid >> 2, wc = wid & 3, fr = lane & 15, fq = lane >> 4;
    const int K = g.K, nt = K / BK;
    unsigned voffA, voffB;
    { int R, C; stage_rc(tid * 16, R, C); const int Rb = Epi::PERM ? ((R & ~31) + perm32(R & 31)) : R;
      voffA = (unsigned)(R * g.lda + C) * 2u; voffB = (unsigned)(Rb * g.ldb + C) * 2u; }
    const size_t pstepA = (size_t)64 * g.lda * 2, pstepB = (size_t)64 * g.ldb * 2;
    const size_t kstep = (size_t)(BK * 2);
    const size_t hstepA = (size_t)HALF * g.lda * 2, hstepB = (size_t)HALF * g.ldb * 2;
    const size_t tstepA = 2 * hstepA, tstepB = 2 * hstepB;
    const unsigned ldsw = (unsigned)wid * 1024u;
    const int aoff = lds_byte(wr * 64 + fr, fq * 8), boff = lds_byte(wc * 32 + fr, fq * 8);
#define PG8_SA(b, h) (((b) * 2 + (h)) * HTB)
#define PG8_SB(b, h) ((4 + (b) * 2 + (h)) * HTB)
#define PG8_STAGE(bufoff, gbase, voff) do { _Pragma("unroll") for (int _i = 0; _i < 2; ++_i) \
        __builtin_amdgcn_global_load_lds((const unsigned*)((const char*)(gbase) + (size_t)_i * pstep_##voff + (voff)), (LAS unsigned*)(lds + (bufoff) + ldsw + _i * 8192), 16, 0, 0); } while (0)
#define pstep_voffA pstepA
#define pstep_voffB pstepB
#define PG8_LDA(dst, b, h) pg8_ldfrag16<4>(dst, lds + PG8_SA(b, h), aoff)
#define PG8_LDB(dst, b, h) pg8_ldfrag16<2>(dst, lds + PG8_SB(b, h), boff)
#define PG8_MMA(ai, bj, At, Bt) do { __builtin_amdgcn_s_setprio(1); if constexpr (I8) pg8_mma8(acci[ai][bj], At, Bt); else pg8_mma16(acc[ai][bj], At, Bt); __builtin_amdgcn_s_setprio(0); } while (0)
#define PG8_WAIT_V(n) asm volatile("s_waitcnt vmcnt(" #n ")" ::: "memory")
#define PG8_WAIT_L(n) asm volatile("s_waitcnt lgkmcnt(" #n ")" ::: "memory")
#define PG8_BAR __builtin_amdgcn_s_barrier()
#define PG8_SCHED __builtin_amdgcn_sched_barrier(0)
#define PG8_ABASE(u) ((const char*)g.A + (size_t)(u).pm * tstepA + (size_t)((u).pn / g.agrp_div) * (size_t)g.agrp_cols * 2)
#define PG8_BBASE(u) ((const char*)g.Bt + (size_t)(u).pn * tstepB + (size_t)((u).pm / g.bgrp_div) * (size_t)g.bgrp_cols * 2)
    Unit cur, nxt; int ui = 0;
    if (!S.next(0, cur)) return;
    f32x4 acc[2][2][4][2]; v4i_t acci[2][2][4][2];
#pragma unroll
    for (int a = 0; a < 2; ++a)
#pragma unroll
        for (int b = 0; b < 2; ++b)
#pragma unroll
            for (int m = 0; m < 4; ++m)
#pragma unroll
                for (int n = 0; n < 2; ++n) { acc[a][b][m][n] = (f32x4){0.f, 0.f, 0.f, 0.f}; acci[a][b][m][n] = (v4i_t){0, 0, 0, 0}; }
    bf16x8 At[4][2], B0[2][2], B1[2][2];
    const char* cA = PG8_ABASE(cur); const char* cB = PG8_BBASE(cur);
    S.a_ready(cur);
    PG8_STAGE(PG8_SB(0, 0), cB, voffB); PG8_STAGE(PG8_SB(0, 1), cB + hstepB, voffB); PG8_STAGE(PG8_SA(0, 0), cA, voffA); PG8_STAGE(PG8_SA(0, 1), cA + hstepA, voffA);
    if (wr == 1) PG8_BAR;
    PG8_WAIT_V(2); PG8_BAR;
    PG8_STAGE(PG8_SB(1, 0), cB + kstep, voffB); PG8_STAGE(PG8_SA(1, 0), cA + kstep, voffA); PG8_STAGE(PG8_SB(1, 1), cB + hstepB + kstep, voffB);
    PG8_WAIT_V(6); PG8_BAR;
    for (;;) {
        const bool has_next = S.next(ui + 1, nxt);
        const char* nA = has_next ? PG8_ABASE(nxt) : cA; const char* nB = has_next ? PG8_BBASE(nxt) : cB;
        for (int t = 0; t < nt; t += 2) {
            const bool last = (t == nt - 2);
            const char* a1 = cA + (size_t)(t + 1) * kstep;
            const char* a2 = last ? nA : cA + (size_t)(t + 2) * kstep; const char* b2 = last ? nB : cB + (size_t)(t + 2) * kstep;
            const char* a3 = a2 + kstep; const char* b3 = b2 + kstep;
            if (last && has_next) S.a_ready(nxt);
            PG8_LDB(B0, 0, 0); PG8_LDB(B1, 0, 1); PG8_SCHED; PG8_LDA(At, 0, 0); PG8_STAGE(PG8_SA(1, 1), a1 + hstepA, voffA);
            PG8_WAIT_V(8); PG8_WAIT_L(0); PG8_BAR; PG8_MMA(0, 0, At, B0); PG8_MMA(0, 1, At, B1); PG8_BAR; PG8_SCHED;
            PG8_LDA(At, 0, 1); PG8_STAGE(PG8_SB(0, 0), b2, voffB); PG8_STAGE(PG8_SB(0, 1), b2 + hstepB, voffB); PG8_STAGE(PG8_SA(0, 0), a2, voffA);
            PG8_WAIT_V(8); PG8_WAIT_L(0); PG8_BAR; PG8_MMA(1, 0, At, B0); PG8_MMA(1, 1, At, B1); PG8_BAR; PG8_SCHED;
            PG8_LDB(B0, 1, 0); PG8_LDB(B1, 1, 1); PG8_SCHED; PG8_LDA(At, 1, 0); PG8_STAGE(PG8_SA(0, 1), a2 + hstepA, voffA);
            PG8_WAIT_V(8); PG8_WAIT_L(0); PG8_BAR; PG8_MMA(0, 0, At, B0); PG8_MMA(0, 1, At, B1); PG8_BAR; PG8_SCHED;
            PG8_LDA(At, 1, 1); PG8_STAGE(PG8_SB(1, 0), b3, voffB); PG8_STAGE(PG8_SB(1, 1), b3 + hstepB, voffB); PG8_STAGE(PG8_SA(1, 0), a3, voffA);
            PG8_WAIT_V(8); PG8_WAIT_L(0); PG8_BAR; PG8_MMA(1, 0, At, B0); PG8_MMA(1, 1, At, B1); PG8_BAR; PG8_SCHED;
        }
        if constexpr (ALIGN_EPI) { if (wr == 0) PG8_BAR; }
        if constexpr (I8) {
#pragma unroll
            for (int a = 0; a < 2; ++a)
#pragma unroll
                for (int b = 0; b < 2; ++b)
#pragma unroll
                    for (int m = 0; m < 4; ++m)
#pragma unroll
                        for (int n = 0; n < 2; ++n) acc[a][b][m][n] = __builtin_convertvector(acci[a][b][m][n], f32x4);
        }
        E(acc, cur, wr, wc, fr, fq);
        S.done(cur);
        if (!has_next) break;
#pragma unroll
        for (int a = 0; a < 2; ++a)
#pragma unroll
            for (int b = 0; b < 2; ++b)
#pragma unroll
                for (int m = 0; m < 4; ++m)
#pragma unroll
                    for (int n = 0; n < 2; ++n) { acc[a][b][m][n] = (f32x4){0.f, 0.f, 0.f, 0.f}; acci[a][b][m][n] = (v4i_t){0, 0, 0, 0}; }
        cur = nxt; cA = nA; cB = nB; ++ui;
        if constexpr (ALIGN_EPI) { if (wr == 1) PG8_BAR; }
    }
    PG8_WAIT_V(0);
    if constexpr (!ALIGN_EPI) { if (wr == 0) PG8_BAR; }
    PG8_BAR;
#undef PG8_SA
#undef PG8_SB
#undef PG8_STAGE
#undef pstep_voffA
#undef pstep_voffB
#undef PG8_LDA
#undef PG8_LDB
#undef PG8_MMA
#undef PG8_WAIT_V
#undef PG8_WAIT_L
#undef PG8_BAR
#undef PG8_SCHED
#undef PG8_ABASE
#undef PG8_BBASE
}
}

#define XB_TMO      128
#define XB_XCNT(j)  (256  + 64 * (j))
#define XB_XSUB(j)  (1280 + 64 * (j))
#define XB_XGEN(j)  (2304 + 64 * (j))
#define XB_TOP      3328
#define XB_TOPGEN   3392
#define XCD_BAR_WORDS 3456
#define XB_SPIN_CAP (1u << 18)

__device__ __forceinline__ unsigned xb_ld(unsigned* p)              { return __hip_atomic_load(p, __ATOMIC_RELAXED, __HIP_MEMORY_SCOPE_AGENT); }
__device__ __forceinline__ unsigned xb_add(unsigned* p, unsigned v) { return __hip_atomic_fetch_add(p, v, __ATOMIC_RELAXED, __HIP_MEMORY_SCOPE_AGENT); }
__device__ __forceinline__ unsigned xb_xcc_id() { return (unsigned)__builtin_amdgcn_s_getreg((3 << 11) | 20) & 0xFu; }
#define XB_SPIN(cond, bar) do { unsigned _sp = 0; while (cond) { __builtin_amdgcn_s_sleep(1); \
    if ((++_sp & 255u) == 0u) { if (xb_ld(&(bar)[XB_TMO])) break; if (_sp > XB_SPIN_CAP) { atomicAdd(&(bar)[XB_TMO], 1u); break; } } } } while (0)

struct XcdBarrier { unsigned* bar; unsigned x; volatile LAS unsigned* st; };

__device__ __forceinline__ XcdBarrier xcd_barrier_post(unsigned* bar, volatile LAS unsigned* st, const int wave_id) {
    XcdBarrier b; b.bar = bar; b.x = xb_xcc_id(); b.st = st;
    if (wave_id == 0 && hw_lane() == 0) (void)xb_add(&bar[XB_XCNT(b.x)], 1u);
    return b;
}
__device__ __forceinline__ void xcd_barrier_complete(unsigned* bar, unsigned x, unsigned& nloc, unsigned& nx) {
    const unsigned G = gridDim.x * gridDim.y * gridDim.z;
    unsigned sum, cnt, mine, sp = 0u;
    for (;;) {
        sum = 0u; cnt = 0u; mine = 0u;
#pragma unroll
        for (unsigned j = 0; j < 16; ++j) { const unsigned c = xb_ld(&bar[XB_XCNT(j)]); sum += c; cnt += (c > 0u) ? 1u : 0u; mine = (j == x) ? c : mine; }
        if (sum == G) break;
        __builtin_amdgcn_s_sleep(1);
        if ((++sp & 255u) == 0u) { if (xb_ld(&bar[XB_TMO])) break; if (sp > XB_SPIN_CAP) { atomicAdd(&bar[XB_TMO], 1u); break; } }
    }
    nloc = mine > 0u ? mine : 1u; nx = cnt > 0u ? cnt : 1u;
}
__device__ __forceinline__ void xcd_barrier(const XcdBarrier& b, const int wave_id) {
    asm volatile("s_waitcnt vmcnt(0)" ::: "memory");
    __syncthreads();
    if (wave_id == 0 && hw_lane() == 0) {
        unsigned* bar = b.bar;
        __builtin_amdgcn_s_waitcnt(0);
        unsigned nloc = b.st[0], nx = b.st[1];
        if (nloc == 0u) { xcd_barrier_complete(bar, b.x, nloc, nx); b.st[0] = nloc; b.st[1] = nx; }
        const unsigned old = xb_add(&bar[XB_XSUB(b.x)], 1u);
        const unsigned gen = old / nloc;
        if (old + 1u == (gen + 1u) * nloc) {
            __builtin_amdgcn_fence(__ATOMIC_RELEASE, "agent");
            asm volatile("s_waitcnt vmcnt(0)" ::: "memory");
            const unsigned og = xb_add(&bar[XB_TOP], 1u);
            const unsigned tg = og / nx;
            if (og + 1u == (tg + 1u) * nx) xb_add(&bar[XB_TOPGEN], 1u);
            else XB_SPIN(xb_ld(&bar[XB_TOPGEN]) == tg, bar);
            __builtin_amdgcn_fence(__ATOMIC_ACQUIRE, "agent");
            xb_add(&bar[XB_XGEN(b.x)], 1u);
            asm volatile("s_waitcnt vmcnt(0)" ::: "memory");
        } else {
            XB_SPIN(xb_ld(&bar[XB_XGEN(b.x)]) == gen, bar);
            __builtin_amdgcn_fence(__ATOMIC_ACQUIRE, "agent");
            asm volatile("s_waitcnt vmcnt(0)" ::: "memory");
        }
    }
    __syncthreads();
}

template <bool F8>
__device__ __forceinline__ void p0_transpose_item(const float* W, int ldw, int N, void* WTv, int ldt, float scale, LAS float* scr, int item, int lane) {
    const int nblk = N / 32, kb = item / nblk, nb = item % nblk, k0 = 64 * kb, n0 = 32 * nb;
#pragma unroll 8
    for (int i = 0; i < 32; ++i) { const int kk = 2 * i + (lane >> 5); scr[kk * 33 + (lane & 31)] = W[(size_t)(k0 + kk) * ldw + n0 + (lane & 31)]; }
    LDS_WAIT(); asm volatile("" ::: "memory");
    const int c = lane & 7;
#pragma unroll
    for (int j = 0; j < 4; ++j) { const int n = (lane >> 3) + 8 * j; const LAS float* s = scr + (8 * c) * 33 + n;
        if constexpr (F8) {
            const f32x4 lo4 = {s[0 * 33], s[1 * 33], s[2 * 33], s[3 * 33]}, hi4 = {s[4 * 33], s[5 * 33], s[6 * 33], s[7 * 33]};
            *(GAS v2u*)((unsigned char*)WTv + (size_t)(n0 + n) * ldt + k0 + 8 * c) = (v2u){q8x4c(lo4, scale), q8x4c(hi4, scale)};
        } else {
            v4u o; o.x = cvt_pk_bf16(s[0 * 33], s[1 * 33]); o.y = cvt_pk_bf16(s[2 * 33], s[3 * 33]); o.z = cvt_pk_bf16(s[4 * 33], s[5 * 33]); o.w = cvt_pk_bf16(s[6 * 33], s[7 * 33]);
            *(GAS v4u*)((bf16*)WTv + (size_t)(n0 + n) * ldt + k0 + 8 * c) = o; } }
    LDS_WAIT(); asm volatile("" ::: "memory");
}

__device__ __forceinline__ int t5_bucket(int rel) {
    int n = -rel; const int ret = n < 0 ? 16 : 0; n = n < 0 ? -n : n;
    if (n < 8) return ret + n;
    const float v = logf((float)n / 8.0f) / logf(128.0f) * 8.0f;
    int large = 8 + (int)v; large = large < 15 ? large : 15;
    return ret + large;
}
__device__ __forceinline__ float gelu_tanh(float x) {
    const float z = 0.7978845608028654f * (x + 0.044715f * x * x * x);
    const float e = __expf(2.0f * z);
    const float t = 1.0f - 2.0f / (e + 1.0f);
    return 0.5f * x * (1.0f + t);
}
__device__ __forceinline__ unsigned fkey(float v) { const unsigned u = __float_as_uint(v); return (u >> 31) ? ~u : (u | 0x80000000u); }
__device__ __forceinline__ float fdec(unsigned key) { const unsigned k2 = key & ~127u; const unsigned u = (k2 >> 31) ? (k2 & 0x7fffffffu) : (~k2 & ~127u); return __uint_as_float(u); }
template <int LJ> __device__ __forceinline__ unsigned xshfl(unsigned x, const int lane) {
    if constexpr (LJ == 1) return (unsigned)__builtin_amdgcn_update_dpp(0, (int)x, 0xB1, 0xF, 0xF, false);
    else if constexpr (LJ == 2) return (unsigned)__builtin_amdgcn_update_dpp(0, (int)x, 0x4E, 0xF, 0xF, false);
    else if constexpr (LJ == 4) { const int y = __builtin_amdgcn_update_dpp(0, (int)x, 0x141, 0xF, 0xF, false); return (unsigned)__builtin_amdgcn_update_dpp(0, y, 0x1B, 0xF, 0xF, false); }
    else if constexpr (LJ == 8) { const int y = __builtin_amdgcn_update_dpp(0, (int)x, 0x140, 0xF, 0xF, false); return (unsigned)__builtin_amdgcn_update_dpp(0, y, 0x141, 0xF, 0xF, false); }
    else if constexpr (LJ == 16) return (unsigned)__builtin_amdgcn_ds_swizzle((int)x, 0x401F);
    else { const auto rr = __builtin_amdgcn_permlane32_swap(x, x, false, false); return lane < 32 ? rr[1] : rr[0]; }
}
template <int K, int J> __device__ __forceinline__ void bitonic_step(unsigned& a0, unsigned& a1, unsigned& b0, unsigned& b1, const int lane) {
    const bool asc = (K == 128) ? true : ((lane & (K >> 1)) == 0);
    if constexpr (J == 1) {
        const unsigned la = a0 < a1 ? a0 : a1, ha = a0 < a1 ? a1 : a0, lb = b0 < b1 ? b0 : b1, hb = b0 < b1 ? b1 : b0;
        a0 = asc ? la : ha; a1 = asc ? ha : la; b0 = asc ? lb : hb; b1 = asc ? hb : lb;
    } else {
        constexpr int LJ = J >> 1; const bool tmin = (((lane & LJ) == 0) == asc);
        const unsigned pa0 = xshfl<LJ>(a0, lane), pa1 = xshfl<LJ>(a1, lane), pb0 = xshfl<LJ>(b0, lane), pb1 = xshfl<LJ>(b1, lane);
        a0 = tmin ? (a0 < pa0 ? a0 : pa0) : (a0 < pa0 ? pa0 : a0); a1 = tmin ? (a1 < pa1 ? a1 : pa1) : (a1 < pa1 ? pa1 : a1);
        b0 = tmin ? (b0 < pb0 ? b0 : pb0) : (b0 < pb0 ? pb0 : b0); b1 = tmin ? (b1 < pb1 ? b1 : pb1) : (b1 < pb1 ? pb1 : b1);
    }
    if constexpr (J > 1) bitonic_step<K, (J >> 1)>(a0, a1, b0, b1, lane);
}
template <int K> __device__ __forceinline__ void bitonic_stage(unsigned& a0, unsigned& a1, unsigned& b0, unsigned& b1, const int lane) {
    bitonic_step<K, (K >> 1)>(a0, a1, b0, b1, lane);
    if constexpr (K < 128) bitonic_stage<(K << 1)>(a0, a1, b0, b1, lane);
}
__device__ __forceinline__ void bitonic128x2(unsigned& a0, unsigned& a1, unsigned& b0, unsigned& b1, const int lane) { bitonic_stage<2>(a0, a1, b0, b1, lane); }
__device__ __forceinline__ float dot2bf(unsigned a, unsigned b, float c) { return __builtin_amdgcn_fdot2_f32_bf16(__builtin_bit_cast(bf2_t, a), __builtin_bit_cast(bf2_t, b), c, false); }

constexpr int ATT_SLOT4 = 4352;
constexpr int ATT_SLOT = 8704;
__device__ __forceinline__ int crow(int r, int hi) { return (r & 3) + 8 * (r >> 2) + 4 * hi; }

__device__ __forceinline__ void attn_task(const int G, const bf16* QKVH, bf16* O0, bf16* O1, float* LSE0, float* LSE1, unsigned char* MIX8,
                                          const LAS float* btab, LAS unsigned char* wl, int b, int h, int mtile, int tk, int lane) {
    const int SH = 2 * G;
    const int L = SEQ >> SH, TPR = 32 >> SH;
    const int r32 = lane & 31, hi = lane >> 5;
    const int res = tk >> (5 - SH), l0 = ((mtile * 1024) >> SH) + 32 * (tk & (TPR - 1));
    const size_t rowbase = (size_t)b * SEQ;
    const int srow = lane >> 4, sch = lane & 15;
    const int rot = (tk & 1) ? 4 : 0;
#define ATT_JR(j) (((j) + rot) >= 5 ? ((j) + rot - 5) : ((j) + rot))
#define ATT_WAITV(n) asm volatile("s_waitcnt vmcnt(" #n ")" ::: "memory")
      \
#define ATT_ISSUE(n) do { LAS unsigned char* sl_ = wl + ((n) & 3) * ATT_SLOT4; const int jt_ = ATT_JR((n) - 5); \
        _Pragma("unroll") for (int i_ = 0; i_ < 4; ++i_) { \
            const int key_ = i_ + 4 * ((krow8 >> 1) & 1) + 8 * (krow8 & 1) + 16 * (krow8 >> 2); \
            int lk_ = l0 - 64 + 32 * jt_ + key_; lk_ = lk_ < 0 ? 0 : (lk_ > L - 1 ? L - 1 : lk_); \
            const unsigned char* src_ = QK8 + ((size_t)(2 * NH + h) * M + rowbase + ((size_t)lk_ << SH) + res) * HD + kch8 * 16; \
            __builtin_amdgcn_global_load_lds((const unsigned*)src_, (LAS unsigned*)(sl_ + i_ * 1056), 16, 0, 0); } } while (0)
    const int krow8 = lane >> 3, kch8 = lane & 7;
#define ATT_ISSUEK(n) do { LAS unsigned char* sl_ = wl + ((n) & 3) * ATT_SLOT4; const int jt_ = ATT_JR(n); \
        _Pragma("unroll") for (int i_ = 0; i_ < 4; ++i_) { \
            const int key_ = 8 * i_ + krow8; \
            int lk_ = l0 - 64 + 32 * jt_ + key_; lk_ = lk_ < 0 ? 0 : (lk_ > L - 1 ? L - 1 : lk_); \
            const int ch_ = kch8 ^ ((key_ ^ (key_ >> 3)) & 7); \
            const unsigned char* src_ = QK8 + ((size_t)(NH + h) * M + rowbase + ((size_t)lk_ << SH) + res) * HD + ch_ * 16; \
            __builtin_amdgcn_global_load_lds((const unsigned*)src_, (LAS unsigned*)(sl_ + i_ * 1024), 16, 0, 0); } } while (0)
    const size_t qrow = rowbase + ((size_t)(l0 + r32) << SH) + res;
    const unsigned char* QK8 = (const unsigned char*)QKVH;
    long qr[8];
    { const unsigned char* qp = QK8 + ((size_t)h * M + qrow) * HD + hi * 8;
#pragma unroll
      for (int d0 = 0; d0 < 8; ++d0) qr[d0] = *(const long*)(qp + d0 * 16); }
    ATT_ISSUEK(0); ATT_ISSUEK(1); ATT_ISSUEK(2); ATT_ISSUEK(3);
    f32x16 p[5];
    const int ksw = (r32 ^ (r32 >> 3)) & 7;
#define ATT_KTILE(n) do { LAS unsigned char* sl_ = wl + ((n) & 3) * ATT_SLOT4 + r32 * 128 + 8 * hi; f32x16 s_ = {}; \
        _Pragma("unroll") for (int d0 = 0; d0 < 8; ++d0) { const long a_ = *(const LAS long*)(sl_ + ((d0 ^ ksw) << 4)); s_ = __builtin_amdgcn_mfma_f32_32x32x16_fp8_fp8(a_, qr[d0], s_, 0, 0, 0); } \
        p[n] = s_; asm volatile("" ::: "memory"); } while (0)
    ATT_WAITV(12); ATT_KTILE(0); ATT_ISSUEK(4);
    ATT_WAITV(12); ATT_KTILE(1); ATT_ISSUE(5);
    ATT_WAITV(12); ATT_KTILE(2); ATT_ISSUE(6);
    ATT_WAITV(12); ATT_KTILE(3); ATT_ISSUE(7);
    ATT_WAITV(12); ATT_KTILE(4); ATT_ISSUE(8);
    float mx = -1e30f;
    const bool edge = (l0 - 64 < 0) || (l0 + 96 > L);
    const LAS float* bt = btab + G * 256 + 32 + 4 * hi - r32;
#pragma unroll
    for (int j = 0; j < 5; ++j) {
        const int jr = ATT_JR(j); const LAS float* btj = bt + 32 * jr;
#pragma unroll
        for (int r = 0; r < 16; ++r) {
            const int kc = 32 * jr + (r & 3) + 8 * (r >> 2);
            float v = p[j][r] * (1.0f / (Q8MUL * K8MUL)) + btj[(r & 3) + 8 * (r >> 2)];
            if (edge) { const int lk = l0 - 64 + kc + 4 * hi; v = (lk >= 0 && lk < L) ? v : -1e30f; }
            p[j][r] = v; mx = fmaxf(mx, v);
        }
        asm volatile("" ::: "memory");
    }
    mx = fmaxf(mx, __shfl_xor(mx, 32));
    float ls = 0.f;
    long pb[5][2];
#pragma unroll
    for (int j = 0; j < 5; ++j) {
        float e[16];
#pragma unroll
        for (int r = 0; r < 16; ++r) { e[r] = __builtin_amdgcn_exp2f(p[j][r] - mx); ls += e[r]; }
#pragma unroll
        for (int s = 0; s < 2; ++s) { int lo_ = 0, hi_ = 0;
            lo_ = __builtin_amdgcn_cvt_pk_fp8_f32(e[8 * s + 0] * P8MUL, e[8 * s + 1] * P8MUL, lo_, false); lo_ = __builtin_amdgcn_cvt_pk_fp8_f32(e[8 * s + 2] * P8MUL, e[8 * s + 3] * P8MUL, lo_, true);
            hi_ = __builtin_amdgcn_cvt_pk_fp8_f32(e[8 * s + 4] * P8MUL, e[8 * s + 5] * P8MUL, hi_, false); hi_ = __builtin_amdgcn_cvt_pk_fp8_f32(e[8 * s + 6] * P8MUL, e[8 * s + 7] * P8MUL, hi_, true);
            pb[j][s] = (long)(((unsigned long)(unsigned)hi_ << 32) | (unsigned long)(unsigned)lo_); }
    }
    ls += __shfl_xor(ls, 32);
    asm volatile("" ::: "memory");
    f32x16 o[4] = {};
    const int i16 = lane & 15, g16 = lane >> 4;
    const int tr_ = i16 >> 1;
    const unsigned vbase = (unsigned)(uintptr_t)wl + (unsigned)((tr_ & 3) * 1056 + (2 * hi + (tr_ >> 2)) * 128 + 16 * (g16 & 1) + 8 * (i16 & 1));
#define ATT_VTILE(n) do { const unsigned va_ = vbase + ((n) & 3) * ATT_SLOT4; \
        _Pragma("unroll") for (int dt = 0; dt < 4; ++dt) { long af0, af1; \
            asm volatile("ds_read_b64_tr_b8 %0, %2 offset:%3\n\tds_read_b64_tr_b8 %1, %2 offset:%4\n\ts_waitcnt lgkmcnt(0)" \
                         : "=&v"(af0), "=&v"(af1) : "v"(va_), "i"(dt * 32), "i"(512 + dt * 32) : "memory"); \
            o[dt] = __builtin_amdgcn_mfma_f32_32x32x16_fp8_fp8(af0, pb[(n) - 5][0], o[dt], 0, 0, 0); \
            o[dt] = __builtin_amdgcn_mfma_f32_32x32x16_fp8_fp8(af1, pb[(n) - 5][1], o[dt], 0, 0, 0); } } while (0)
    ATT_WAITV(12); ATT_VTILE(5); ATT_ISSUE(9);
    ATT_WAITV(12); ATT_VTILE(6);
    ATT_WAITV(8);  ATT_VTILE(7);
    ATT_WAITV(4);  ATT_VTILE(8);
    ATT_WAITV(0);  ATT_VTILE(9);
#undef ATT_WAITV
#undef ATT_ISSUE
#undef ATT_ISSUEK
#undef ATT_KTILE
#undef ATT_VTILE
#undef ATT_JR
    const float inv = 1.0f / (ls * (P8MUL * V8MUL));
    const float lse2 = mx + __builtin_amdgcn_logf(ls);
    const size_t orow = qrow;
    LAS unsigned char* T0 = wl;
    LAS unsigned char* T1 = T0 + ATT_SLOT;
    int ln_ = lane; asm volatile("" : "+v"(ln_));
    const int erow = ln_ >> 4, echk = ln_ & 15;
    const unsigned pofs = (unsigned)(r32 * 272 + 8 * hi);
    if (G < 2) {
        const float inv8 = inv * O8MUL;
#pragma unroll
        for (int dt = 0; dt < 4; ++dt)
#pragma unroll
            for (int rg = 0; rg < 4; ++rg) { int pk = 0; pk = __builtin_amdgcn_cvt_pk_fp8_f32(o[dt][4 * rg] * inv8, o[dt][4 * rg + 1] * inv8, pk, false); pk = __builtin_amdgcn_cvt_pk_fp8_f32(o[dt][4 * rg + 2] * inv8, o[dt][4 * rg + 3] * inv8, pk, true);
                *(LAS unsigned*)(T0 + r32 * 144 + 4 * hi + 32 * dt + 8 * rg) = (unsigned)pk; }
        LDS_WAIT();
        unsigned char* ob = (unsigned char*)(G == 0 ? O0 : O1) + ((size_t)h * M + rowbase) * HD + (ln_ & 7) * 16;
#pragma unroll
        for (int i = 0; i < 4; ++i) { const int qi = (ln_ >> 3) + 8 * i; const v4u w = *(const LAS v4u*)(T0 + qi * 144 + (ln_ & 7) * 16);
            *(v4u*)(ob + (((size_t)(l0 + qi) << SH) + res) * HD) = w; }
        if (hi == 0) (G == 0 ? LSE0 : LSE1)[orow * NH + h] = lse2;
    } else {
        const float l0v = LSE0[orow * NH + h], l1v = LSE1[orow * NH + h];
        const unsigned char* ib0 = (const unsigned char*)O0 + ((size_t)h * M + rowbase) * HD + (ln_ & 7) * 16; const unsigned char* ib1 = (const unsigned char*)O1 + ((size_t)h * M + rowbase) * HD + (ln_ & 7) * 16;
        {
            v4u t0[4], t1[4];
#pragma unroll
            for (int i = 0; i < 4; ++i) { const size_t ro = (((size_t)(l0 + (ln_ >> 3) + 8 * i) << SH) + res) * HD; t0[i] = *(const v4u*)(ib0 + ro); t1[i] = *(const v4u*)(ib1 + ro); }
#pragma unroll
            for (int i = 0; i < 4; ++i) { const int qi = (ln_ >> 3) + 8 * i; *(LAS v4u*)(T0 + qi * 144 + (ln_ & 7) * 16) = t0[i]; *(LAS v4u*)(T1 + qi * 144 + (ln_ & 7) * 16) = t1[i]; }
            asm volatile("" ::: "memory");
        }
        const float mm = fmaxf(fmaxf(l0v, l1v), lse2);
        const float w0 = __builtin_amdgcn_exp2f(l0v - mm), w1 = __builtin_amdgcn_exp2f(l1v - mm), w2 = __builtin_amdgcn_exp2f(lse2 - mm);
        const float wi = 1.0f / (w0 + w1 + w2);
        const float c0 = w0 * wi * (1.0f / O8MUL), c1 = w1 * wi * (1.0f / O8MUL), c2 = w2 * wi * inv;
        LDS_WAIT();
        unsigned y8[16];
#pragma unroll
        for (int dt = 0; dt < 4; ++dt)
#pragma unroll
            for (int rg = 0; rg < 4; ++rg) { const int a = (int)*(const LAS unsigned*)(T0 + r32 * 144 + 4 * hi + 32 * dt + 8 * rg), c = (int)*(const LAS unsigned*)(T1 + r32 * 144 + 4 * hi + 32 * dt + 8 * rg);
                const f32x2 a01 = __builtin_amdgcn_cvt_pk_f32_fp8(a, false), a23 = __builtin_amdgcn_cvt_pk_f32_fp8(a, true), c01 = __builtin_amdgcn_cvt_pk_f32_fp8(c, false), c23 = __builtin_amdgcn_cvt_pk_f32_fp8(c, true);
                const float y0 = c0 * a01.x + c1 * c01.x + c2 * o[dt][4 * rg], y1 = c0 * a01.y + c1 * c01.y + c2 * o[dt][4 * rg + 1];
                const float y2 = c0 * a23.x + c1 * c23.x + c2 * o[dt][4 * rg + 2], y3 = c0 * a23.y + c1 * c23.y + c2 * o[dt][4 * rg + 3];
                y8[4 * dt + rg] = q8x4c((f32x4){y0, y1, y2, y3}, A8SCALE); }
        LDS_WAIT();
#pragma unroll
        for (int dt = 0; dt < 4; ++dt)
#pragma unroll
            for (int rg = 0; rg < 4; ++rg) *(LAS unsigned*)(T0 + r32 * 144 + 4 * hi + 32 * dt + 8 * rg) = y8[4 * dt + rg];
        LDS_WAIT();
        unsigned char* ob = MIX8 + rowbase * DM + h * HD + (ln_ & 7) * 16;
#pragma unroll
        for (int i = 0; i < 4; ++i) { const int qi = (ln_ >> 3) + 8 * i; const v4u w = *(const LAS v4u*)(T0 + qi * 144 + (ln_ & 7) * 16);
            *(v4u*)(ob + (((size_t)(l0 + qi) << SH) + res) * DM) = w; }
    }
    LDS_WAIT();
}

constexpr int PER_PHASE = 9;
struct Args { const float* in[16]; float* out; unsigned char* ws; unsigned mask; unsigned pad; };

__constant__ unsigned char CAND_I[64] = {0,0,0,0,0,0,0,0,0,0,0,0,0,0,0,0, 1,1,1,1,1,1,1,1, 2,2,2,2,2, 3,3,3,3, 4,4,4, 5,5, 6,6, 7,7, 8,9,10,11,12,13,14,15, 0,0,0,0,0,0,0,0,0,0,0,0,0,0};
__constant__ unsigned char CAND_J[64] = {0,1,2,3,4,5,6,7,8,9,10,11,12,13,14,15, 0,1,2,3,4,5,6,7, 0,1,2,3,4, 0,1,2,3, 0,1,2, 0,1, 0,1, 0,1, 0,0,0,0,0,0,0,0, 0,0,0,0,0,0,0,0,0,0,0,0,0,0};

__global__ void __launch_bounds__(NWAVES * 64, 2) fwd_kernel(Args args) {
    extern __shared__ __attribute__((aligned(16))) unsigned char lds_raw[];
    LAS unsigned char* lds = (LAS unsigned char*)lds_raw;
    volatile LAS unsigned* MISC = (volatile LAS unsigned*)(lds + MISC_OFF);
    const int tid0 = threadIdx.x, lane0 = tid0 & 63, wave = __builtin_amdgcn_readfirstlane(tid0 >> 6);
#define PHASE_LANES() int lane; asm volatile("v_mbcnt_lo_u32_b32 %0, -1, 0\n\tv_mbcnt_hi_u32_b32 %0, -1, %0" : "=v"(lane)); const int tid = wave * 64 + lane
    const int G = gridDim.x; const int bx = blockIdx.x;
    const int vcu = (G % 8 == 0) ? (bx % 8) * (G / 8) + bx / 8 : bx;
    const int gw = vcu * NWAVES + wave, NGW = G * NWAVES;
    unsigned char* ws = args.ws;
    unsigned* ctl = (unsigned*)(ws + WS_CTL);
    const float* x = args.in[0]; const float* cvec = args.in[1]; const float* w_ada = args.in[2]; const float* b_ada = args.in[3]; const float* g_mix = args.in[4];
    const float* w_in = args.in[5]; const float* rel_bias = args.in[6]; const float* pool_w = args.in[7]; const float* pool_scale = args.in[8]; const float* w_out = args.in[9];
    const float* g_ffn = args.in[10]; const float* peer_wq = args.in[11]; const float* peer_sk = args.in[12]; const float* peer_u = args.in[13]; const float* peer_v = args.in[14];
    const float* g_final = args.in[15];
    float* out = args.out;
    float* MODV = (float*)(ws + WS_MODV); float* MODP = (float*)(ws + WS_MODP);
    bf16* SKT = (bf16*)(ws + WS_SKT); bf16* PWS = (bf16*)(ws + WS_PWS); bf16* WQSTB = (bf16*)(ws + WS_WQST);     unsigned char* WQST8 = ws + 104 * MiB;     unsigned char* WOUT8 = ws + WS_WOUT2;     unsigned char* WIN8 = ws + WS_WIN8; unsigned char* H8 = ws + WS_H8;
    bf16* WOPT = (bf16*)(ws + WS_WOPT); bf16* WQB = (bf16*)(ws + WS_WQB);
    unsigned char* UB = ws + WS_UB; unsigned char* VB = ws + WS_VB; float* SCL = (float*)(ws + WS_SCL); float* TSC = SCL + 2 * NEXP; float* WQS = TSC + M;         unsigned char* HHI = ws + WS_H; unsigned char* HLO = ws + WS_H + 32 * MiB;     bf16* PIN = (bf16*)(ws + WS_PROJ); bf16* QKVH = (bf16*)(ws + WS_QKVH); unsigned char* MIX8 = ws + WS_MIXIN;
    bf16* O0 = (bf16*)(ws + WS_O0); bf16* O1 = (bf16*)(ws + WS_O1); float* LSE = (float*)(ws + WS_LSE);
    float* SC = (float*)(ws + WS_SC);
    bf16* X1B = (bf16*)(ws + WS_O0);
    bf16* YB = (bf16*)(ws + WS_PROJ + 64 * MiB);

    for (int u = tid0; u < (LDS_BYTES - LDSCTL_OFF) / 4; u += NWAVES * 64) ((LAS unsigned*)(lds + LDSCTL_OFF))[u] = 0u;
    __syncthreads();
    XcdBarrier bar; bar.bar = ctl + CW_BAR; bar.x = 0; bar.st = nullptr;
    if (MK_N_LAUNCHES != PER_PHASE) bar = xcd_barrier_post(ctl + CW_BAR, MISC + 8, wave);
#define GRID_BAR() do { if (MK_N_LAUNCHES != PER_PHASE) xcd_barrier(bar, wave); } while (0)
    const unsigned phmask = args.mask;
#ifndef PH_MASK
#define PH_MASK 0x1ff
#endif
#define IN(k) ((((PH_MASK) >> (k)) & 1) && ((phmask >> (k)) & 1u))
#define BOTH(k) (IN(k) && IN((k) + 1))

    if (IN(0)) {
        PHASE_LANES();
        LAS float* silu = (LAS float*)(lds + RING_OFF);
        for (int i = tid; i < BATCH * DM; i += NWAVES * 64) { const float v = cvec[i]; silu[i] = v / (1.0f + __expf(-v)); }
        __syncthreads();
        for (int task = gw; task < (NMOD / 256) * KS_ADA; task += NGW) {
            const int cg = task % (NMOD / 256), ks = task / (NMOD / 256); const int k0 = ks * (DM / KS_ADA), n0 = cg * 256 + 4 * lane;
            f32x4 a0 = {0.f, 0.f, 0.f, 0.f}, a1 = {0.f, 0.f, 0.f, 0.f};
            const float* wp = w_ada + (size_t)k0 * NMOD + n0;
            static_assert(DM / KS_ADA == 64, "four 16-row batches");
            f32x4 wA[16], wB[16];
#define ADA_LD(W_, b_) _Pragma("unroll") for (int q_ = 0; q_ < 16; ++q_) W_[q_] = *(const f32x4*)(wp + (size_t)(16 * (b_) + q_) * NMOD)
#define ADA_FMA(W_, b_) _Pragma("unroll") for (int q_ = 0; q_ < 16; ++q_) { const float s0 = silu[k0 + 16 * (b_) + q_], s1 = silu[DM + k0 + 16 * (b_) + q_]; a0 += W_[q_] * s0; a1 += W_[q_] * s1; }
            ADA_LD(wA, 0); ADA_LD(wB, 1); ADA_FMA(wA, 0); ADA_LD(wA, 2); ADA_FMA(wB, 1); ADA_LD(wB, 3); ADA_FMA(wA, 2); ADA_FMA(wB, 3);
#undef ADA_LD
#undef ADA_FMA
            *(f32x4*)(MODP + ((size_t)(ks * 2 + 0)) * NMOD + n0) = a0; *(f32x4*)(MODP + ((size_t)(ks * 2 + 1)) * NMOD + n0) = a1;
        }
        __syncthreads();
        {
            LAS float* scr = (LAS float*)(lds + RING_OFF + wave * 16384);
            constexpr int I_QKV = (DM / 64) * (3 * ATTW / 32), I_PIN = (DM / 64) * (POOLW / 32), I_OUTH = (ATTW / 64) * (DM / 32);
            constexpr int NITEMS = I_QKV + I_PIN + 2 * I_OUTH;
            for (int it = gw; it < NITEMS; it += NGW) {
                int r = it;
                if (r < I_QKV + I_PIN) { p0_transpose_item<true>(w_in, INW, INW, WIN8, DM, W8SCALE, scr, r, lane); continue; } r -= I_QKV + I_PIN;
                if (r < I_OUTH) { p0_transpose_item<true>(w_out, DM, DM, WOUT8, DM, WOA8SCALE, scr, r, lane); continue; } r -= I_OUTH;
                p0_transpose_item<false>(w_out + (size_t)ATTW * DM, DM, DM, WOPT, POOLW, 1.f, scr, r, lane);
            }
        }
        for (int i = gw * 64 + lane; i < (DM * PQ + 4 * 512 * 512) / 8; i += NGW * 64) {
            const bool isQ = i < DM * PQ / 8; const int j = isQ ? i : i - DM * PQ / 8;
            const float* src = (isQ ? peer_wq : pool_w) + (size_t)j * 8;
            f32x4 a = *(const f32x4*)src, c = *(const f32x4*)(src + 4);
            if (!isQ) { const int e0 = j * 8; const int gi = e0 >> 18, d0 = e0 & 511; const float* ps = pool_scale + gi * 512 + d0; a = a * *(const f32x4*)ps; c = c * *(const f32x4*)(ps + 4); }
            v4u w; w.x = cvt_pk_bf16(a[0], a[1]); w.y = cvt_pk_bf16(a[2], a[3]); w.z = cvt_pk_bf16(c[0], c[1]); w.w = cvt_pk_bf16(c[2], c[3]);
            *(v4u*)((isQ ? WQB : PWS) + (size_t)j * 8) = w;
        }
        f32x4 vnx[4][4];
#define PEER_LD(r_) do { const float* s_ = ((r_) < NEXP ? peer_u + (size_t)(r_) * DM : peer_v + (size_t)((r_) - NEXP) * DM) + 16 * lane; \
            _Pragma("unroll") for (int i = 0; i < 4; ++i) _Pragma("unroll") for (int q = 0; q < 4; ++q) vnx[i][q] = *(const f32x4*)(s_ + 1024 * i + 4 * q); } while (0)
        if (gw < 2 * NEXP) PEER_LD(gw);
        for (int r = gw; r < 2 * NEXP; r += NGW) {
            const bool isU = r < NEXP; const int e = isU ? r : r - NEXP;
            f32x4 v[4][4]; float mx = 0.f, ss = 0.f;
#pragma unroll
            for (int i = 0; i < 4; ++i)
#pragma unroll
                for (int q = 0; q < 4; ++q) { v[i][q] = vnx[i][q];
                    mx = fmaxf(mx, fmaxf(fmaxf(fabsf(v[i][q][0]), fabsf(v[i][q][1])), fmaxf(fabsf(v[i][q][2]), fabsf(v[i][q][3]))));
                    ss += (v[i][q][0] * v[i][q][0] + v[i][q][1] * v[i][q][1]) + (v[i][q][2] * v[i][q][2] + v[i][q][3] * v[i][q][3]); }
            if (r + NGW < 2 * NEXP) PEER_LD(r + NGW);
#pragma unroll
            for (int o = 1; o < 64; o <<= 1) mx = fmaxf(mx, __shfl_xor(mx, o));
            const int ex = (int)((__float_as_uint(mx) >> 23) & 0xffu);
            float scale = 1.0f, inv = 1.0f;
            if (ex >= 32 && ex <= 230) { const float rms = sqrtf(wave_sum(ss) * (1.0f / DM));
                if (isU) { inv = 0.3352f * rms; scale = 1.0f / inv; }
                else { inv = 0.5f * rms; scale = 1.0f / inv; } }
            if (isU) {
                unsigned char* dst = UB + ((size_t)(lane >> 4) * NEXP + e) * 128 + 8 * (lane & 15);
#pragma unroll
                for (int i = 0; i < 4; ++i) { const unsigned lo = q4x4(v[i][0], scale) | (q4x4(v[i][1], scale) << 16), hi = q4x4(v[i][2], scale) | (q4x4(v[i][3], scale) << 16);
                    *(v2u*)(dst + (size_t)(4 * i) * NEXP * 128) = (v2u){lo, hi}; }
            } else {
                unsigned char* dst = VB + ((size_t)(lane >> 4) * NEXP + e) * 128 + 8 * (lane & 15);
#pragma unroll
                for (int i = 0; i < 4; ++i) { unsigned lo = 0u, hi = 0u;
                    lo = __builtin_amdgcn_cvt_scalef32_pk_fp4_f32(lo, v[i][0][0] * scale, v[i][0][1] * scale, 1.0f, 0); lo = __builtin_amdgcn_cvt_scalef32_pk_fp4_f32(lo, v[i][0][2] * scale, v[i][0][3] * scale, 1.0f, 1);
                    lo = __builtin_amdgcn_cvt_scalef32_pk_fp4_f32(lo, v[i][1][0] * scale, v[i][1][1] * scale, 1.0f, 2); lo = __builtin_amdgcn_cvt_scalef32_pk_fp4_f32(lo, v[i][1][2] * scale, v[i][1][3] * scale, 1.0f, 3);
                    hi = __builtin_amdgcn_cvt_scalef32_pk_fp4_f32(hi, v[i][2][0] * scale, v[i][2][1] * scale, 1.0f, 0); hi = __builtin_amdgcn_cvt_scalef32_pk_fp4_f32(hi, v[i][2][2] * scale, v[i][2][3] * scale, 1.0f, 1);
                    hi = __builtin_amdgcn_cvt_scalef32_pk_fp4_f32(hi, v[i][3][0] * scale, v[i][3][1] * scale, 1.0f, 2); hi = __builtin_amdgcn_cvt_scalef32_pk_fp4_f32(hi, v[i][3][2] * scale, v[i][3][3] * scale, 1.0f, 3);
                    *(v2u*)(dst + (size_t)(4 * i) * NEXP * 128) = (v2u){lo, hi}; }
            }
            if (lane == 0) SCL[r] = inv;
        }
#undef PEER_LD
        for (int i = gw * 64 + lane; i < 2048 * 32; i += NGW * 64) {
            const int n = i >> 5, kc = (i & 31) * 8; const int p = (n >> 7) & 1, pp = kc >> 7;
            v4u w = {0u, 0u, 0u, 0u};
            if (p == pp) { const float* src = peer_sk + (size_t)n * 128 + (kc & 127); const f32x4 a = *(const f32x4*)src, c = *(const f32x4*)(src + 4);
                w.x = cvt_pk_bf16(a[0], a[1]); w.y = cvt_pk_bf16(a[2], a[3]); w.z = cvt_pk_bf16(c[0], c[1]); w.w = cvt_pk_bf16(c[2], c[3]); }
            *(v4u*)(SKT + (size_t)n * 256 + kc) = w;
        }
        if (BOTH(0)) GRID_BAR();
    }

    if (IN(1)) {
        PHASE_LANES();
        for (int i = bx * (NWAVES * 64) + tid; i < BATCH * NMOD; i += G * NWAVES * 64) {
            const int b = i / NMOD, n = i % NMOD; float s = b_ada[n];
#pragma unroll 8
            for (int ks = 0; ks < KS_ADA; ++ks) s += MODP[(size_t)(ks * 2 + b) * NMOD + n];
            const int j = n / DM, c = n % DM;
            MODV[(size_t)(j * 2 + b) * DM + c] = s;
        }
        if (bx < G / 2) {
            pg8::Gemm g{WOPT, PWS, DM, POOLW, 512, POOLW, 512, 2, 512, 1 << 30, 0}; pg8::StaticOrder S; S.init(DM, POOLW, G / 2, bx);
            pg8::EpiI8 E{WOUT8, DM, ATTW, WOP8SCALE};
            pg8::gemm_phase<pg8::EpiI8, pg8::StaticOrder, true>(lds + RING_OFF, g, S, E, wave);
        }
        else {
            pg8::Gemm g{SKT, WQB, PQ, DM, 256, 256, PQ, 1 << 30, 0, 1, 256}; pg8::StaticOrder S; S.init(PQ, DM, G - G / 2, bx - G / 2);
            pg8::EpiBf16 E{WQSTB, DM, 0, 1.0f, nullptr, 0, 0};
            pg8::gemm_phase<pg8::EpiBf16, pg8::StaticOrder, true>(lds + RING_OFF, g, S, E, wave);
        }
        if (BOTH(1)) GRID_BAR();
    }

    if (IN(2)) {
        PHASE_LANES();
        for (int row = gw; row < M; row += NGW) {
            const int b = row / SEQ;
            const f32x4* xr = (const f32x4*)(x + (size_t)row * DM) + lane;
            f32x4 v[16]; float ss = 0.f;
#pragma unroll
            for (int j = 0; j < 16; ++j) { v[j] = xr[64 * j]; ss += (v[j][0] * v[j][0] + v[j][1] * v[j][1]) + (v[j][2] * v[j][2] + v[j][3] * v[j][3]); }
            const float rstd = 1.0f / sqrtf(wave_sum(ss) * (1.0f / DM) + RMS_EPS);
            const f32x4* gp = (const f32x4*)g_mix + lane; const f32x4* shp = (const f32x4*)(MODV + (size_t)(0 * 2 + b) * DM) + lane; const f32x4* scp = (const f32x4*)(MODV + (size_t)(1 * 2 + b) * DM) + lane;
            unsigned* op8 = (unsigned*)(H8 + (size_t)row * DM) + lane;
#pragma unroll
            for (int j = 0; j < 16; ++j) { const f32x4 g4 = gp[64 * j], sh = shp[64 * j], sc = scp[64 * j];
                const f32x4 y = (v[j] * rstd) * g4 * (sc + 1.0f) + sh;
                op8[64 * j] = q8x4c(y, H8SCALE); }
        }
        for (int n = gw; n < PQ; n += NGW) {
            const v2u* wr_ = (const v2u*)(WQSTB + (size_t)n * DM) + lane;
            f32x4 v[16]; float mx = 0.f;
#pragma unroll
            for (int j = 0; j < 16; ++j) { const v2u xw = wr_[64 * j]; v[j] = (f32x4){bf_lo(xw.x), bf_hi(xw.x), bf_lo(xw.y), bf_hi(xw.y)};
                mx = fmaxf(mx, fmaxf(fmaxf(fabsf(v[j][0]), fabsf(v[j][1])), fmaxf(fabsf(v[j][2]), fabsf(v[j][3])))); }
#pragma unroll
            for (int o = 1; o < 64; o <<= 1) mx = fmaxf(mx, __shfl_xor(mx, o));
            mx = fmaxf(mx, 1e-20f);
            const float qs = 127.0f / mx; unsigned* op8 = (unsigned*)(WQST8 + (size_t)n * DM) + lane;
#pragma unroll
            for (int j = 0; j < 16; ++j) op8[64 * j] = q8x4(v[j], qs);
            if (lane == 0) WQS[n] = mx * (1.0f / 127.0f);
        }
        if (BOTH(2)) GRID_BAR();
    }

    if (IN(3)) {
        PHASE_LANES();
        {
            pg8::Gemm g{(const bf16*)H8, (const bf16*)WIN8, M, INW, DM / 2, DM / 2, DM / 2, 1 << 30, 0, 1 << 30, 0}; pg8::StaticOrder S; S.init(M, INW, G, bx);
            pg8::EpiBf16 E{PIN, POOLW, ATTW, QSCALE / (H8SCALE * W8SCALE), QKVH, 3 * ATTW, M, 1.0f / (H8SCALE * W8SCALE), 3 * ATTW};
            pg8::gemm_phase<pg8::EpiBf16, pg8::StaticOrder, true, true>(lds + RING_OFF, g, S, E, wave);
        }
        if (BOTH(3)) GRID_BAR();
    }

    if (IN(4)) {
        PHASE_LANES();
        LAS float* btab = (LAS float*)(lds + SHARED_OFF);
        LAS unsigned char* vt = lds + RING_OFF + wave * ATT_WAVE_BYTES;
        if (!(args.pad & 1u))
        for (int unit = bx; unit < BATCH * NH * (SEQ / 1024); unit += G) {
            const int b = unit >> 7, h = (unit >> 3) & 15, mt = unit & 7;
            __syncthreads();
            for (int i = tid; i < 3 * 256; i += NWAVES * 64) { const int gi = i >> 8, ri = (i & 255) - 32; const int dil = gi == 0 ? 1 : (gi == 1 ? 4 : 16);
                btab[i] = (ri >= 0 && ri <= 128) ? rel_bias[t5_bucket((ri - 64) * dil) * NH + h] * LOG2E : -1e30f; }
            __syncthreads();
            for (int g = 0; g < 3; ++g) {
                if (g == 2) { VM_WAIT(); __syncthreads(); }
                for (int tk = wave; tk < 32; tk += NWAVES) attn_task(g, QKVH, O0, O1, LSE, LSE + (size_t)M * NH, MIX8, btab, vt, b, h, mt, tk, lane);
            }
        }
        if (!(args.pad & 2u))
        for (int i = bx * (NWAVES * 64) + tid; i < BATCH * (SEQ / 8) * (POOLW / 8); i += G * NWAVES * 64) {
            const int cc = i & 255, run = (i >> 8) & (SEQ / 8 - 1), b = i >> 18; const int gi = __builtin_amdgcn_readfirstlane(cc >> 6);
            const int pos0 = run * 8;
            const bf16* base = PIN + (size_t)b * SEQ * POOLW + cc * 8;
            unsigned char* obase = MIX8 + ((size_t)b * SEQ + pos0) * DM + ATTW + cc * 8;
#define POOL_RUN(HW) do { constexpr int NR = 8 + 2 * (HW) - 1; v4u w_[NR]; \
                _Pragma("unroll") for (int q = 0; q < NR; ++q) { const int pp = pos0 - (HW) + q; const int pc = pp < 0 ? 0 : (pp > SEQ - 1 ? SEQ - 1 : pp); w_[q] = *(const v4u*)(base + (size_t)pc * POOLW); } \
                _Pragma("unroll") for (int q = 0; q < NR; ++q) { const int pp = pos0 - (HW) + q; if (pp < 0 || pp >= SEQ) w_[q] = (v4u){0u, 0u, 0u, 0u}; } \
                float s_[8] = {0.f, 0.f, 0.f, 0.f, 0.f, 0.f, 0.f, 0.f}; \
                _Pragma("unroll") for (int q = 0; q < 2 * (HW) - 1; ++q) { s_[0] += bf_lo(w_[q].x); s_[1] += bf_hi(w_[q].x); s_[2] += bf_lo(w_[q].y); s_[3] += bf_hi(w_[q].y); s_[4] += bf_lo(w_[q].z); s_[5] += bf_hi(w_[q].z); s_[6] += bf_lo(w_[q].w); s_[7] += bf_hi(w_[q].w); } \
                _Pragma("unroll") for (int k = 0; k < 8; ++k) { const v4u in_ = w_[k + 2 * (HW) - 1]; \
                    s_[0] += bf_lo(in_.x); s_[1] += bf_hi(in_.x); s_[2] += bf_lo(in_.y); s_[3] += bf_hi(in_.y); s_[4] += bf_lo(in_.z); s_[5] += bf_hi(in_.z); s_[6] += bf_lo(in_.w); s_[7] += bf_hi(in_.w); \
                    const int pos = pos0 + k; const int lo_ = pos - (HW) < 0 ? 0 : pos - (HW), hi_ = pos + (HW) > SEQ ? SEQ : pos + (HW); const float inv = 1.0f / (float)(hi_ - lo_); \
                    const v4u me = w_[k + (HW)]; \
                    const f32x4 lo4_ = {s_[0] * inv - bf_lo(me.x), s_[1] * inv - bf_hi(me.x), s_[2] * inv - bf_lo(me.y), s_[3] * inv - bf_hi(me.y)}, hi4_ = {s_[4] * inv - bf_lo(me.z), s_[5] * inv - bf_hi(me.z), s_[6] * inv - bf_lo(me.w), s_[7] * inv - bf_hi(me.w)}; \
                    const unsigned lo8_ = q8x4c(lo4_, P8SCALE), hi8_ = q8x4c(hi4_, P8SCALE); \
                    *(v2u*)(obase + (size_t)k * DM) = (v2u){lo8_, hi8_}; \
                    const v4u out_ = w_[k]; \
                    s_[0] -= bf_lo(out_.x); s_[1] -= bf_hi(out_.x); s_[2] -= bf_lo(out_.y); s_[3] -= bf_hi(out_.y); s_[4] -= bf_lo(out_.z); s_[5] -= bf_hi(out_.z); s_[6] -= bf_lo(out_.w); s_[7] -= bf_hi(out_.w); } } while (0)
            if (gi == 0) POOL_RUN(1); else if (gi == 1) POOL_RUN(2); else if (gi == 2) POOL_RUN(4); else POOL_RUN(8);
#undef POOL_RUN
        }
        if (BOTH(4)) GRID_BAR();
    }

    if (IN(5)) {
        PHASE_LANES();
        pg8::Gemm g{(const bf16*)MIX8, (const bf16*)WOUT8, M, DM, DM / 2, DM / 2, DM / 2, 1 << 30, 0, 1 << 30, 0}; pg8::StaticOrder S; S.init(M, DM, G, bx);
        pg8::EpiResBf16 E{x, MODV + (size_t)(2 * 2) * DM, X1B, DM, 1.0f / (A8SCALE * WOA8SCALE)};
        pg8::gemm_phase<pg8::EpiResBf16, pg8::StaticOrder, true, true>(lds + RING_OFF, g, S, E, wave);
        if (BOTH(5)) GRID_BAR();
    }

    if (IN(6)) {
        PHASE_LANES();
        for (int row = gw; row < M; row += NGW) {
            const int b = row / SEQ;
            const v4u* xr = (const v4u*)(X1B + (size_t)row * DM) + lane;
            f32x4 v[16]; float ss = 0.f;
#pragma unroll
            for (int j = 0; j < 8; ++j) { const v4u xw = xr[64 * j]; v[2 * j] = (f32x4){bf_lo(xw.x), bf_hi(xw.x), bf_lo(xw.y), bf_hi(xw.y)}; v[2 * j + 1] = (f32x4){bf_lo(xw.z), bf_hi(xw.z), bf_lo(xw.w), bf_hi(xw.w)};
                ss += (v[2 * j][0] * v[2 * j][0] + v[2 * j][1] * v[2 * j][1]) + (v[2 * j][2] * v[2 * j][2] + v[2 * j][3] * v[2 * j][3]);
                ss += (v[2 * j + 1][0] * v[2 * j + 1][0] + v[2 * j + 1][1] * v[2 * j + 1][1]) + (v[2 * j + 1][2] * v[2 * j + 1][2] + v[2 * j + 1][3] * v[2 * j + 1][3]); }
            const float rstd = 1.0f / sqrtf(wave_sum(ss) * (1.0f / DM) + RMS_EPS);
            const f32x4* gp = (const f32x4*)g_ffn + 2 * lane; const f32x4* shp = (const f32x4*)(MODV + (size_t)(3 * 2 + b) * DM) + 2 * lane; const f32x4* scp = (const f32x4*)(MODV + (size_t)(4 * 2 + b) * DM) + 2 * lane;
            v2u* op8 = (v2u*)(H8 + (size_t)row * DM) + lane;
            unsigned* hip = (unsigned*)(HHI + (size_t)row * (DM / 2)) + lane; unsigned* lop = (unsigned*)(HLO + (size_t)row * (DM / 2)) + lane;
            float ymx = 0.f;
#pragma unroll
            for (int j = 0; j < 16; ++j) { const int o_ = 128 * (j >> 1) + (j & 1); const f32x4 g4 = gp[o_], sh = shp[o_], sc = scp[o_];
                const f32x4 y = (v[j] * rstd) * g4 * (sc + 1.0f) + sh; v[j] = y;
                ymx = fmaxf(ymx, fmaxf(fmaxf(fabsf(y[0]), fabsf(y[1])), fmaxf(fabsf(y[2]), fabsf(y[3])))); }
#pragma unroll
            for (int o = 1; o < 64; o <<= 1) ymx = fmaxf(ymx, __shfl_xor(ymx, o));
            ymx = fmaxf(ymx, 1e-20f);
            const float qs = 119.0f / ymx;
#pragma unroll
            for (int j = 0; j < 8; ++j) { const unsigned w0 = q8x4(v[2 * j], qs), w1 = q8x4(v[2 * j + 1], qs);
                op8[64 * j] = (v2u){w0, w1};
                const unsigned t0 = (w0 ^ 0x80808080u) + 0x08080808u, t1 = (w1 ^ 0x80808080u) + 0x08080808u;
                hip[64 * j] = nibs16(((t0 >> 4) & 0x0f0f0f0fu) ^ 0x08080808u) | (nibs16(((t1 >> 4) & 0x0f0f0f0fu) ^ 0x08080808u) << 16);
                lop[64 * j] = nibs16(w0 & 0x0f0f0f0fu) | (nibs16(w1 & 0x0f0f0f0fu) << 16); }
            if (lane == 0) TSC[row] = ymx * (1.0f / 119.0f);
        }
        if (BOTH(6)) GRID_BAR();
    }

    if (IN(7)) {
        PHASE_LANES();
        pg8::Gemm g{(const bf16*)H8, (const bf16*)WQST8, M, PQ, DM / 2, DM / 2, DM / 2, 1 << 30, 0, 1 << 30, 0}; pg8::StaticOrder S; S.init(M, PQ, G, bx);
        pg8::EpiF32RowScale E{SC, PQ, TSC, WQS};
        pg8::gemm_phase<pg8::EpiF32RowScale, pg8::StaticOrder, true, true>(lds + RING_OFF, g, S, E, wave);
        if (BOTH(7)) GRID_BAR();
    }

    if (IN(8)) {
        PHASE_LANES();
        LAS unsigned short* EXPW = (LAS unsigned short*)(lds + RING_OFF);
        LAS float* GACT = (LAS float*)(lds + RING_OFF + 16384);
        LAS unsigned* W = (LAS unsigned*)(lds + RING_OFF + 49152 + wave * 4096);
        LAS unsigned* K1 = W; LAS unsigned* K2 = W + 128;
        LAS float* TV1 = (LAS float*)(W + 256); LAS int* TI1 = (LAS int*)(W + 272); LAS float* TV2 = (LAS float*)(W + 288); LAS int* TI2 = (LAS int*)(W + 304);
        LAS unsigned* CK = W + 320; LAS float* SV = (LAS float*)(W + 384); LAS int* SE = (LAS int*)(W + 400);
        const int c8 = lane & 7, r8 = lane >> 3;
        for (int blk = vcu; blk < M / 64; blk += G) {
            const int tok0 = blk * 64; const int b = tok0 / SEQ;
            const int ph = ((wave >> 2) ^ wave) & 1;
            for (int pass = 0; pass < 1 + ph; ++pass) {
            const int lt = ph ? 2 : 3;
            const int jb = 4 * pass;
            const int nt = 1 << lt;
            const float* sp0 = SC + (size_t)(tok0 + wave * 8 + jb) * PQ + lane;
            float na0 = sp0[0], na1 = sp0[64], nb0 = sp0[128], nb1 = sp0[192];
#pragma unroll 1
            for (int rec = 0; rec < 8 * nt; ++rec) {
                const int tl = wave * 8 + jb + (rec >> 3);
                { const int h = rec & 7;
                    const float a0 = na0, a1 = na1, b0 = nb0, b1 = nb1;
                    { const int nx = rec + 1 < 8 * nt ? rec + 1 : 0; const float* sp = sp0 + (size_t)nx * 256; na0 = sp[0]; na1 = sp[64]; nb0 = sp[128]; nb1 = sp[192]; }
                    unsigned ka0 = (fkey(a0) & ~127u) | (unsigned)(127 - lane), ka1 = (fkey(a1) & ~127u) | (unsigned)(63 - lane);
                    unsigned kb0 = (fkey(b0) & ~127u) | (unsigned)(127 - lane), kb1 = (fkey(b1) & ~127u) | (unsigned)(63 - lane);
                    bitonic128x2(ka0, ka1, kb0, kb1, lane);
                    if (lane >= 56) { K1[127 - 2 * lane] = ka0; K1[126 - 2 * lane] = ka1; K2[127 - 2 * lane] = kb0; K2[126 - 2 * lane] = kb1; }
                    LDS_WAIT();
                    const int ci_i = CAND_I[lane], ci_j = CAND_J[lane];
                    const unsigned kA = K1[ci_i], kB = K2[ci_j];
                    const float cv = fdec(kA) + fdec(kB);
                    const unsigned ck = lane < 50 ? ((fkey(cv) & ~255u) | (unsigned)(255 - (ci_i * 16 + ci_j))) : 0u;
                    CK[lane] = ck;
                    LDS_WAIT();
                    int rc = 0;
#pragma unroll 8
                    for (int kk = 0; kk < 16; ++kk) { const v4u q = ((const LAS v4u*)CK)[kk]; rc += (q.x > ck) + (q.y > ck) + (q.z > ck) + (q.w > ck); }
                    if (lane < 50 && rc < 16) { SV[rc] = cv; SE[rc] = (int)((127u - (kA & 127u)) * 128u + (127u - (kB & 127u))); }
                    LDS_WAIT();
                    const float top0 = SV[0], myv = SV[lane & 15]; const int mye = SE[lane & 15];
                    const float e = __expf(myv - top0);
                    float ssum = e; ssum += __shfl_xor(ssum, 1); ssum += __shfl_xor(ssum, 2); ssum += __shfl_xor(ssum, 4); ssum += __shfl_xor(ssum, 8);
                    if (lane < 16) { EXPW[tl * 128 + h * 16 + lane] = (unsigned short)mye; GACT[tl * 128 + h * 16 + lane] = e / ssum; }
                    LDS_WAIT();
                }
            }
            LAS float* ACC = (LAS float*)(lds + RING_OFF + 81920);
            for (int i = lane; i < nt * 128; i += 64) ACC[(wave * 8 + jb) * 128 + i] = 0.f;
            LDS_WAIT();
            if (!(args.pad & 8u)) {
                v4u gA[16], gB[16]; v4u hA, hB, lA, lB;
#define P10_LOADU(idx, G_, H_, L_) do { const int s_ = (idx) >> lt, j_ = jb + ((idx) & (nt - 1)); const int tl_ = wave * 8 + j_; \
                    const unsigned char* tb_ = UB + (size_t)s_ * NEXP * 128 + 16 * c8; \
                    H_ = *(const v4u*)(HHI + (size_t)(tok0 + tl_) * (DM / 2) + 128 * s_ + 16 * c8); L_ = *(const v4u*)(HLO + (size_t)(tok0 + tl_) * (DM / 2) + 128 * s_ + 16 * c8); \
                    _Pragma("unroll") for (int i = 0; i < 16; ++i) { const unsigned e_ = EXPW[tl_ * 128 + r8 + 8 * i]; G_[i] = *(const v4u*)(tb_ + (size_t)e_ * 128); } } while (0)
#define P10_COMPU(idx, G_, H_, L_) do { const int tl = wave * 8 + jb + ((idx) & (nt - 1)); int p[16]; \
                    _Pragma("unroll") for (int i = 0; i < 16; ++i) { int a_ = 0, b_ = 0; \
                        a_ = __builtin_amdgcn_sdot8((int)G_[i].x, (int)H_.x, a_, false); a_ = __builtin_amdgcn_sdot8((int)G_[i].y, (int)H_.y, a_, false); \
                        a_ = __builtin_amdgcn_sdot8((int)G_[i].z, (int)H_.z, a_, false); a_ = __builtin_amdgcn_sdot8((int)G_[i].w, (int)H_.w, a_, false); \
                        b_ = __builtin_amdgcn_sdot8((int)G_[i].x, (int)L_.x, b_, false); b_ = __builtin_amdgcn_sdot8((int)G_[i].y, (int)L_.y, b_, false); \
                        b_ = __builtin_amdgcn_sdot8((int)G_[i].z, (int)L_.z, b_, false); b_ = __builtin_amdgcn_sdot8((int)G_[i].w, (int)L_.w, b_, false); p[i] = a_ * 16 + b_; } \
                    int q8[8], q4[4], q2[2]; \
                      \
                    _Pragma("unroll") for (int m = 0; m < 8; ++m) { const int kp = (c8 & 4) ? p[m + 8] : p[m]; \
                        unsigned rv_ = __builtin_amdgcn_update_dpp(0u, (unsigned)p[m], 0x104, 0xf, 0x5, false); rv_ = __builtin_amdgcn_update_dpp(rv_, (unsigned)p[m + 8], 0x114, 0xf, 0xa, false); q8[m] = kp + (int)rv_; } \
                    _Pragma("unroll") for (int m = 0; m < 4; ++m) { const int snd = (c8 & 2) ? q8[m] : q8[m + 4], kp = (c8 & 2) ? q8[m + 4] : q8[m]; q4[m] = kp + (int)__builtin_amdgcn_update_dpp(0u, (unsigned)snd, 0x4e, 0xf, 0xf, false); } \
                    _Pragma("unroll") for (int m = 0; m < 2; ++m) { const int snd = (c8 & 1) ? q4[m] : q4[m + 2], kp = (c8 & 1) ? q4[m + 2] : q4[m]; q2[m] = kp + (int)__builtin_amdgcn_update_dpp(0u, (unsigned)snd, 0xb1, 0xf, 0xf, false); } \
                    LAS float* ap = ACC + tl * 128 + r8 + 16 * c8;         \
                    ap[0] += (float)q2[0]; ap[8] += (float)q2[1]; } while (0)
                P10_LOADU(0, gA, hA, lA);
#pragma unroll 1
                for (int idx = 0; idx < 16 * nt; idx += 2) {
                    P10_LOADU(idx + 1, gB, hB, lB);
                    P10_COMPU(idx, gA, hA, lA);
                    if (idx + 2 < 16 * nt) P10_LOADU(idx + 2, gA, hA, lA);
                    P10_COMPU(idx + 1, gB, hB, lB);
                }
#undef P10_LOADU
#undef P10_COMPU
            }
            LDS_WAIT();
            for (int i = lane; i < nt * 128; i += 64) { const int o_ = (wave * 8 + jb) * 128 + i; const unsigned e = EXPW[o_];
                const float a = ACC[o_] * SCL[e] * TSC[tok0 + (o_ >> 7)]; GACT[o_] = gelu_tanh(a) * GACT[o_] * SCL[NEXP + e]; }
            LDS_WAIT();
            LAS float* SSQ = ACC;
            for (int j = 0; j < nt; ++j) SSQ[(wave * 8 + jb + j) * 128 + lane] = 0.f;
            LDS_WAIT();
            const float* gtp = MODV + (size_t)(5 * 2 + b) * DM;
            if (!(args.pad & 16u)) {
                v4u gA[16], gB[16]; float aA[16], aB[16];
#define P10_LOADV(idx, G_, A_) do { const int s_ = (idx) >> lt, j_ = jb + ((idx) & (nt - 1)); const int tl_ = wave * 8 + j_; \
                    const unsigned char* tb_ = VB + (size_t)s_ * NEXP * 128 + 16 * c8; \
                    _Pragma("unroll") for (int i = 0; i < 16; ++i) { const int k_ = tl_ * 128 + r8 + 8 * i; const unsigned e_ = EXPW[k_]; A_[i] = GACT[k_]; G_[i] = *(const v4u*)(tb_ + (size_t)e_ * 128); } } while (0)
#define P10_COMPV(idx, G_, A_) do { const int s_c = (idx) >> lt; const int tl = wave * 8 + jb + ((idx) & (nt - 1)); const int t = tok0 + tl; \
                    const int d = 256 * s_c + 32 * c8 + 2 * r8; \
                    const unsigned xw0 = __builtin_nontemporal_load((const unsigned*)(X1B + (size_t)t * DM + d)), xw1 = __builtin_nontemporal_load((const unsigned*)(X1B + (size_t)t * DM + d + 16)); \
                    const f32x2 gv0 = *(const f32x2*)(gtp + d), gv1 = *(const f32x2*)(gtp + d + 16);     \
                    float ssq = SSQ[tl * 128 + lane]; \
                    _Pragma("unroll") for (int hf = 0; hf < 2; ++hf) {     \
                        f32x2 o8[8]; \
                        _Pragma("unroll") for (int q = 0; q < 8; ++q) o8[q] = (f32x2){0.f, 0.f}; \
                        _Pragma("unroll") for (int i = 0; i < 16; ++i) \
                            _Pragma("unroll") for (int q = 0; q < 2; ++q) { const unsigned w_ = G_[i][2 * hf + q]; \
                                o8[4 * q] += __builtin_amdgcn_cvt_scalef32_pk_f32_fp4(w_, 1.0f, 0) * A_[i]; o8[4 * q + 1] += __builtin_amdgcn_cvt_scalef32_pk_f32_fp4(w_, 1.0f, 1) * A_[i]; \
                                o8[4 * q + 2] += __builtin_amdgcn_cvt_scalef32_pk_f32_fp4(w_, 1.0f, 2) * A_[i]; o8[4 * q + 3] += __builtin_amdgcn_cvt_scalef32_pk_f32_fp4(w_, 1.0f, 3) * A_[i]; } \
                        float p[16], q8[8], q4[4], q2[2]; \
                        _Pragma("unroll") for (int q = 0; q < 8; ++q) { p[2 * q] = o8[q].x; p[2 * q + 1] = o8[q].y; } \
                          \
                        _Pragma("unroll") for (int m = 0; m < 8; ++m) { const auto r_ = __builtin_amdgcn_permlane32_swap(__float_as_uint(p[m]), __float_as_uint(p[m + 8]), false, false); q8[m] = __uint_as_float(r_[0]) + __uint_as_float(r_[1]); } \
                        _Pragma("unroll") for (int m = 0; m < 4; ++m) { const auto r_ = __builtin_amdgcn_permlane16_swap(__float_as_uint(q8[m]), __float_as_uint(q8[m + 4]), false, false); q4[m] = __uint_as_float(r_[0]) + __uint_as_float(r_[1]); } \
                        _Pragma("unroll") for (int m = 0; m < 2; ++m) { const float snd = (r8 & 1) ? q4[m] : q4[m + 2], kp = (r8 & 1) ? q4[m + 2] : q4[m]; q2[m] = kp + __uint_as_float(__builtin_amdgcn_update_dpp(0u, __float_as_uint(snd), 0x128, 0xf, 0xf, false)); } \
                        const unsigned xw = hf ? xw1 : xw0; const f32x2 gv = hf ? gv1 : gv0; \
                        f32x2 y; y.x = bf_lo(xw) + gv.x * q2[0]; y.y = bf_hi(xw) + gv.y * q2[1]; \
                        __builtin_nontemporal_store(cvt_pk_bf16(y.x, y.y), (unsigned*)(YB + (size_t)t * DM + d + 16 * hf)); \
                        ssq += (y.x * y.x + y.y * y.y); } \
                    SSQ[tl * 128 + lane] = ssq; } while (0)
                P10_LOADV(0, gA, aA);
#pragma unroll 1
                for (int idx = 0; idx < 16 * nt; idx += 2) {
                    P10_LOADV(idx + 1, gB, aB);
                    P10_COMPV(idx, gA, aA);
                    if (idx + 2 < 16 * nt) P10_LOADV(idx + 2, gA, aA);
                    P10_COMPV(idx + 1, gB, aB);
                }
#undef P10_LOADV
#undef P10_COMPV
            }
            VM_WAIT(); LDS_WAIT();
            __builtin_amdgcn_fence(__ATOMIC_ACQUIRE, "agent");
            VM_WAIT();
            for (int j = 0; j < nt; ++j) {
                const int tl = wave * 8 + jb + j; const int t = tok0 + tl;
                const float rstd = 1.0f / sqrtf(wave_sum(SSQ[tl * 128 + lane]) * (1.0f / DM) + RMS_EPS);
                f32x4* op = (f32x4*)(out + (size_t)t * DM) + lane; const f32x4* gp = (const f32x4*)g_final + lane; const v2u* yp = (const v2u*)(YB + (size_t)t * DM) + lane;
#pragma unroll 4
                for (int i = 0; i < 16; ++i) { const v2u yw = __builtin_nontemporal_load(yp + 64 * i); const f32x4 y = {bf_lo(yw.x), bf_hi(yw.x), bf_lo(yw.y), bf_hi(yw.y)}; __builtin_nontemporal_store(y * rstd * gp[64 * i], op + 64 * i); }
            }
            LDS_WAIT();
            }
        }
    }
#undef IN
#undef BOTH
#undef GRID_BAR
}

extern "C" void kernel_launch(void* const* d_in, const int* in_sizes, int n_in, void* d_out, int out_size, void* d_ws, size_t ws_size, hipStream_t stream) {
    static int grid = 0;
    if (grid == 0) {
        if (n_in != 16 || in_sizes[0] != M * DM || out_size != M * DM || ws_size < WS_END) {
            fprintf(stderr, "kernel_launch: shape/workspace mismatch: n_in %d in0 %d out %d ws %zu (need %zu)\n", n_in, n_in > 0 ? in_sizes[0] : -1, out_size, ws_size, (size_t)WS_END); grid = -1; return; }
        int dev = 0, cus = 0, per_cu = 0;
        if (hipGetDevice(&dev) != hipSuccess || hipDeviceGetAttribute(&cus, hipDeviceAttributeMultiprocessorCount, dev) != hipSuccess) { grid = -1; return; }
        if (hipFuncSetAttribute((const void*)fwd_kernel, hipFuncAttributeMaxDynamicSharedMemorySize, LDS_BYTES) != hipSuccess) { fprintf(stderr, "kernel_launch: hipFuncSetAttribute failed\n"); grid = -1; return; }
        if (hipOccupancyMaxActiveBlocksPerMultiprocessor(&per_cu, (const void*)fwd_kernel, NWAVES * 64, LDS_BYTES) != hipSuccess || per_cu < 1)
            fprintf(stderr, "kernel_launch: note: occupancy query reports %d workgroups per CU\n", per_cu);
        (void)hipGetLastError();
        grid = cus;
    }
    if (grid < 0) return;
    if (hipMemsetAsync((char*)d_ws + WS_CTL, 0, CTL_ZERO_BYTES, stream) != hipSuccess) { fprintf(stderr, "kernel_launch: memset failed\n"); return; }
    Args a{};
    for (int i = 0; i < 16; ++i) a.in[i] = (const float*)d_in[i];
    a.out = (float*)d_out; a.ws = (unsigned char*)d_ws;
#ifdef PROBE_MASK
    {
#ifndef PROBE_PAD
#define PROBE_PAD 0
#endif
        a.mask = PROBE_MASK; a.pad = PROBE_PAD;
        hipLaunchKernelGGL(fwd_kernel, dim3(grid), dim3(NWAVES * 64), LDS_BYTES, stream, a);
        (void)hipMemsetAsync((char*)d_ws + WS_CTL, 0, CTL_ZERO_BYTES, stream);
    }
#endif
    for (int li = 0; li < MK_N_LAUNCHES; ++li) {
        a.mask = (MK_N_LAUNCHES == PER_PHASE) ? (1u << li) : ((1u << PER_PHASE) - 1u); a.pad = 0;
        hipLaunchKernelGGL(fwd_kernel, dim3(grid), dim3(NWAVES * 64), LDS_BYTES, stream, a);
        const hipError_t le = hipPeekAtLastError();
        if (le != hipSuccess) { fprintf(stderr, "kernel_launch: launch %d failed: %s\n", li, hipGetErrorName(le)); break; }
    }
}
```

```cpp
#include <hip/hip_runtime.h>
#include <cstdio>
#include <cstdint>

#ifndef MK_N_LAUNCHES
#define MK_N_LAUNCHES 1
#endif

#define GAS __attribute__((address_space(1)))
#define LAS __attribute__((address_space(3)))
typedef unsigned short bf16;
typedef unsigned v4u __attribute__((ext_vector_type(4)));
typedef unsigned v2u __attribute__((ext_vector_type(2)));
typedef float f32x4 __attribute__((ext_vector_type(4)));
typedef float f32x2 __attribute__((ext_vector_type(2)));
typedef _Float16 h2_t __attribute__((ext_vector_type(2)));
typedef float f32x16 __attribute__((ext_vector_type(16)));
typedef short bf16x8 __attribute__((ext_vector_type(8)));
typedef short s16x4 __attribute__((ext_vector_type(4)));
typedef __bf16 bf2_t __attribute__((ext_vector_type(2)));

constexpr int BATCH = 2, SEQ = 8192, DM = 4096, M = BATCH * SEQ;
constexpr int NH = 16, HD = 128, ATTW = 2048, POOLW = 2048, INW = 8192;
constexpr int NMOD = 6 * DM;
constexpr int PQ = 2048;
constexpr int NEXP = 16384;
constexpr float RMS_EPS = 1e-6f;
constexpr float LOG2E = 1.4426950408889634f;
constexpr float QSCALE = 0.08838834764831845f * LOG2E;
constexpr float H8SCALE = 16.f, W8SCALE = 2048.f;
constexpr float A8SCALE = 128.f, P8SCALE = 24.f, WOA8SCALE = 256.f, WOP8SCALE = (A8SCALE * WOA8SCALE) / P8SCALE;
constexpr float WQ8SCALE = 1024.f;
constexpr int KS_ADA = 64;

constexpr size_t MiB = 1u << 20;
constexpr float O8MUL = 16.0f;
constexpr float V8MUL = 4.0f, P8MUL = 256.0f;
constexpr float Q8MUL = 16.0f, K8MUL = 2.0f;
constexpr size_t WS_CTL = 0, CTL_ZERO_BYTES = 1 * MiB;
constexpr size_t WS_MODV = 1 * MiB;
constexpr size_t WS_SCL = 2 * MiB;
constexpr size_t WS_MODP = 4 * MiB;
constexpr size_t WS_SKT = 20 * MiB;
constexpr size_t WS_PWS = 22 * MiB;
constexpr size_t WS_WQST = 24 * MiB;
constexpr size_t WS_WOUT2 = 40 * MiB;
constexpr size_t WS_WIN8 = 72 * MiB;
constexpr size_t WS_H8 = 1100 * MiB;
constexpr size_t WS_UB = 136 * MiB;
constexpr size_t WS_VB = 264 * MiB;
constexpr size_t WS_H = 392 * MiB;
constexpr size_t WS_PROJ = 520 * MiB;
constexpr size_t WS_QKVH = 1292 * MiB;
constexpr size_t WS_MIXIN = 776 * MiB;
constexpr size_t WS_WOPT = 904 * MiB;
constexpr size_t WS_WQB = 936 * MiB;
constexpr size_t WS_O0 = 968 * MiB, WS_O1 = 1032 * MiB;
constexpr size_t WS_LSE = 1096 * MiB;
constexpr size_t WS_SC = 1164 * MiB;
constexpr size_t WS_END = 1484 * MiB;

constexpr int RING_OFF = 0, RING_BYTES = 131072;
constexpr int ATT_WAVE_BYTES = 17408;
constexpr int SHARED_OFF = 139264;
constexpr int LDSCTL_OFF = 139264 + 4096, MISC_OFF = LDSCTL_OFF + 320;
constexpr int LDS_BYTES = 147456;
constexpr int NWAVES = 8;
constexpr int CW_BAR = 4096;

#define LDS_WAIT() asm volatile("s_waitcnt lgkmcnt(0)" ::: "memory")
#define VM_WAIT() asm volatile("s_waitcnt vmcnt(0)" ::: "memory")

__device__ __forceinline__ unsigned cvt_pk_bf16(float lo, float hi) { unsigned r; asm volatile("v_cvt_pk_bf16_f32 %0, %1, %2" : "=v"(r) : "v"(lo), "v"(hi)); return r; }
__device__ __forceinline__ float bf_lo(unsigned u) { return __uint_as_float(u << 16); }
__device__ __forceinline__ float bf_hi(unsigned u) { return __uint_as_float(u & 0xffff0000u); }
#define WAVE_BFLY(OP) \
    v = OP(v, __uint_as_float((unsigned)__builtin_amdgcn_update_dpp(0, (int)__float_as_uint(v), 0xB1, 0xF, 0xF, true))); \
    v = OP(v, __uint_as_float((unsigned)__builtin_amdgcn_update_dpp(0, (int)__float_as_uint(v), 0x4E, 0xF, 0xF, true))); \
    { const int y_ = __builtin_amdgcn_update_dpp(0, (int)__float_as_uint(v), 0x141, 0xF, 0xF, true); v = OP(v, __uint_as_float((unsigned)__builtin_amdgcn_update_dpp(0, y_, 0x1B, 0xF, 0xF, true))); } \
    v = OP(v, __uint_as_float((unsigned)__builtin_amdgcn_update_dpp(0, (int)__float_as_uint(v), 0x128, 0xF, 0xF, true))); \
    { const auto r_ = __builtin_amdgcn_permlane16_swap(__float_as_uint(v), __float_as_uint(v), false, false); unsigned r0_ = r_[0], r1_ = r_[1]; asm volatile("" : "+v"(r0_), "+v"(r1_)); v = OP(__uint_as_float(r0_), __uint_as_float(r1_)); } \
    { const auto r_ = __builtin_amdgcn_permlane32_swap(__float_as_uint(v), __float_as_uint(v), false, false); unsigned r0_ = r_[0], r1_ = r_[1]; asm volatile("" : "+v"(r0_), "+v"(r1_)); v = OP(__uint_as_float(r0_), __uint_as_float(r1_)); }
__device__ __forceinline__ float wb_add_(float a, float b) { return a + b; }
__device__ __forceinline__ float wave_sum(float v) { WAVE_BFLY(wb_add_) return v; }
__device__ __forceinline__ float wave_max(float v) { WAVE_BFLY(fmaxf) return v; }
#undef WAVE_BFLY

__device__ __forceinline__ unsigned q8x4c(f32x4 v, float s) {
    const unsigned b0 = __float_as_uint(__builtin_amdgcn_fmed3f(v[0] * s, -127.f, 127.f) + 12582912.0f), b1 = __float_as_uint(__builtin_amdgcn_fmed3f(v[1] * s, -127.f, 127.f) + 12582912.0f);
    const unsigned b2 = __float_as_uint(__builtin_amdgcn_fmed3f(v[2] * s, -127.f, 127.f) + 12582912.0f), b3 = __float_as_uint(__builtin_amdgcn_fmed3f(v[3] * s, -127.f, 127.f) + 12582912.0f);
    return (b0 & 0xffu) | ((b1 & 0xffu) << 8) | ((b2 & 0xffu) << 16) | (b3 << 24);
}
__device__ __forceinline__ unsigned q8x4(f32x4 v, float s) {
    const unsigned b0 = __float_as_uint(v[0] * s + 12582912.0f), b1 = __float_as_uint(v[1] * s + 12582912.0f), b2 = __float_as_uint(v[2] * s + 12582912.0f), b3 = __float_as_uint(v[3] * s + 12582912.0f);
    return (b0 & 0xffu) | ((b1 & 0xffu) << 8) | ((b2 & 0xffu) << 16) | (b3 << 24);
}
__device__ __forceinline__ int hw_lane() { int l; asm volatile("v_mbcnt_lo_u32_b32 %0, -1, 0\n\tv_mbcnt_hi_u32_b32 %0, -1, %0" : "=v"(l)); return l; }
__device__ __forceinline__ unsigned q4x4(f32x4 v, float s) {
    const unsigned b0 = __float_as_uint(__builtin_amdgcn_fmed3f(v[0] * s, -8.f, 7.f) + 12582912.0f), b1 = __float_as_uint(__builtin_amdgcn_fmed3f(v[1] * s, -8.f, 7.f) + 12582912.0f);
    const unsigned b2 = __float_as_uint(__builtin_amdgcn_fmed3f(v[2] * s, -8.f, 7.f) + 12582912.0f), b3 = __float_as_uint(__builtin_amdgcn_fmed3f(v[3] * s, -8.f, 7.f) + 12582912.0f);
    return (b0 & 15u) | ((b1 & 15u) << 4) | ((b2 & 15u) << 8) | ((b3 & 15u) << 12);
}
__device__ __forceinline__ unsigned nibs16(unsigned x) { x = (x | (x >> 4)) & 0x00ff00ffu; return (x | (x >> 8)) & 0xffffu; }
namespace pg8 {
typedef unsigned short bf16_t;
typedef int v4i_t __attribute__((ext_vector_type(4)));
typedef int v8i_t __attribute__((ext_vector_type(8)));
constexpr int BM = 256, BK = 64, HALF = 128, HTB = HALF * BK * 2, STAGE_BYTES = 8 * HTB, NXCD = 8, WGM = 8;

__host__ __device__ __forceinline__ int lds_byte(int r, int c) { const int st = (r >> 4) * 2 + (c >> 5), rr = r & 15, cc = c & 31, ob = rr * 64 + cc * 2; return st * 1024 + (ob ^ (((ob >> 9) & 1) << 5)); }
__host__ __device__ __forceinline__ void stage_rc(int b, int& R, int& C) { const int st = b / 1024, sb = b % 1024, swz = sb ^ (((sb >> 9) & 1) << 5); R = (st >> 1) * 16 + swz / 64; C = (st & 1) * 32 + (swz % 64) / 2; }
__host__ __device__ __forceinline__ int perm32(int rho) { const int n = rho >> 4, i = rho & 15; return 8 * (i >> 2) + 4 * n + (i & 3); }

template <int NF> __device__ __forceinline__ void pg8_ldfrag16(bf16x8 (&dst)[NF][2], const LAS unsigned char* base, int off) {
#pragma unroll
    for (int m = 0; m < NF; ++m)
#pragma unroll
        for (int k = 0; k < 2; ++k) dst[m][k] = *(const LAS bf16x8*)(base + off + m * 2048 + k * 1024);
}
__device__ __forceinline__ void pg8_mma16(f32x4 (&acc)[4][2], const bf16x8 (&At)[4][2], const bf16x8 (&Bt)[2][2]) {
#pragma unroll
    for (int m = 0; m < 4; ++m)
#pragma unroll
        for (int n = 0; n < 2; ++n)
#pragma unroll
            for (int k = 0; k < 2; ++k) acc[m][n] = __builtin_amdgcn_mfma_f32_16x16x32_bf16(Bt[n][k], At[m][k], acc[m][n], 0, 0, 0);
}
__device__ __forceinline__ void pg8_mma8(v4i_t (&acc)[4][2], const bf16x8 (&At)[4][2], const bf16x8 (&Bt)[2][2]) {
#pragma unroll
    for (int m = 0; m < 4; ++m)
#pragma unroll
        for (int n = 0; n < 2; ++n)
#pragma unroll
            for (int k = 0; k < 2; ++k) acc[m][n] = __builtin_amdgcn_mfma_i32_16x16x64_i8(__builtin_bit_cast(v4i_t, Bt[n][k]), __builtin_bit_cast(v4i_t, At[m][k]), acc[m][n], 0, 0, 0);
}
struct Unit { int pm, pn; };
struct Gemm { const bf16_t* A; const bf16_t* Bt; int M, N, K, lda, ldb, agrp_div, agrp_cols, bgrp_div, bgrp_cols; };

struct StaticOrder {
    int nM, nN, nwg, G, c;
    __host__ __device__ void init(int M_, int N_, int G_, int c_) { nM = M_ / BM; nN = N_ / BM; nwg = nM * nN; G = G_; c = c_; }
    __host__ __device__ bool next(int i, Unit& u) const {
        const long L = (long)i * G + c; if (L >= nwg) return false;
        int wgid = (int)L; { const int q = nwg / NXCD, r = nwg % NXCD, xcd = wgid % NXCD, off = wgid / NXCD; wgid = (xcd < r ? xcd * (q + 1) : r * (q + 1) + (xcd - r) * q) + off; }
        const int nig = WGM * nN, gid = wgid / nig, fm = gid * WGM, gsz = (nM - fm) < WGM ? (nM - fm) : WGM;
        u.pm = fm + ((wgid % nig) % gsz); u.pn = (wgid % nig) / gsz; return true;
    }
    __device__ __forceinline__ void a_ready(const Unit&) const {}
    __device__ __forceinline__ void done(const Unit&) const {}
};

struct EpiBf16 {
    static constexpr bool PERM = true, AFTER_DRAIN = false;
    bf16_t* O; int ldc; int scale_cols; float scale0; bf16_t* HM; int hm_cols; int hm_rows; float scale1 = 1.0f;
    int f8_cols = 0;
    __device__ __forceinline__ void operator()(const f32x4 (&acc)[2][2][4][2], const Unit& u, int wr, int wc, int fr, int fq) const {
        const int row0 = u.pm * BM + wr * 64 + fr; const int colt = u.pn * BM;
        const float sc = (colt < scale_cols) ? scale0 : scale1;
        const bool hm = colt < hm_cols;
        const int cw = wc * 32 + 8 * fq;
        bf16_t* base = hm ? HM + (size_t)(colt / HALF) * hm_rows * HALF + cw : O + (colt - hm_cols) + cw;
        const size_t rpitch = hm ? (size_t)HALF : (size_t)ldc, hstep = hm ? (size_t)hm_rows * HALF : (size_t)HALF;
        if (colt < f8_cols) {
            const float s8 = sc * ((colt < scale_cols) ? Q8MUL : (colt < 2 * scale_cols ? K8MUL : V8MUL));
            unsigned char* b8 = (unsigned char*)HM + (size_t)(colt / HALF) * hm_rows * HALF + cw;
#pragma unroll
            for (int ai = 0; ai < 2; ++ai)
#pragma unroll
                for (int m = 0; m < 4; ++m) { unsigned char* rowp = b8 + (size_t)(row0 + ai * HALF + m * 16) * HALF;
#pragma unroll
                    for (int bj = 0; bj < 2; ++bj) { const f32x4 v0 = acc[ai][bj][m][0] * s8, v1 = acc[ai][bj][m][1] * s8;
                        int lo = 0, hi = 0;
                        lo = __builtin_amdgcn_cvt_pk_fp8_f32(v0[0], v0[1], lo, false); lo = __builtin_amdgcn_cvt_pk_fp8_f32(v0[2], v0[3], lo, true);
                        hi = __builtin_amdgcn_cvt_pk_fp8_f32(v1[0], v1[1], hi, false); hi = __builtin_amdgcn_cvt_pk_fp8_f32(v1[2], v1[3], hi, true);
                        *(v2u*)(rowp + (size_t)bj * hm_rows * HALF) = (v2u){(unsigned)lo, (unsigned)hi}; } }
            return;
        }
#pragma unroll
        for (int ai = 0; ai < 2; ++ai)
#pragma unroll
            for (int m = 0; m < 4; ++m) { bf16_t* rowp = base + (size_t)(row0 + ai * HALF + m * 16) * rpitch;
#pragma unroll
                for (int bj = 0; bj < 2; ++bj) { f32x4 v0 = acc[ai][bj][m][0] * sc, v1 = acc[ai][bj][m][1] * sc;
                    v4u w; w.x = cvt_pk_bf16(v0[0], v0[1]); w.y = cvt_pk_bf16(v0[2], v0[3]); w.z = cvt_pk_bf16(v1[0], v1[1]); w.w = cvt_pk_bf16(v1[2], v1[3]);
                    *(v4u*)(rowp + bj * hstep) = w; } }
    }
};
struct EpiBf16ColScale {
    static constexpr bool PERM = true, AFTER_DRAIN = false;
    bf16_t* O; int ldc; int coff; const float* cs;
    __device__ __forceinline__ void operator()(const f32x4 (&acc)[2][2][4][2], const Unit& u, int wr, int wc, int fr, int fq) const {
        const int row0 = u.pm * BM + wr * 64 + fr; const int col0 = u.pn * BM + wc * 32 + 8 * fq;
        f32x4 sv[2][2];
#pragma unroll
        for (int bj = 0; bj < 2; ++bj)
#pragma unroll
            for (int n = 0; n < 2; ++n) sv[bj][n] = *(const f32x4*)(cs + col0 + bj * HALF + 4 * n);
#pragma unroll
        for (int ai = 0; ai < 2; ++ai)
#pragma unroll
            for (int m = 0; m < 4; ++m) { bf16_t* rowp = O + (size_t)(row0 + ai * HALF + m * 16) * ldc + coff + col0;
#pragma unroll
                for (int bj = 0; bj < 2; ++bj) { f32x4 v0 = acc[ai][bj][m][0] * sv[bj][0], v1 = acc[ai][bj][m][1] * sv[bj][1];
                    v4u w; w.x = cvt_pk_bf16(v0[0], v0[1]); w.y = cvt_pk_bf16(v0[2], v0[3]); w.z = cvt_pk_bf16(v1[0], v1[1]); w.w = cvt_pk_bf16(v1[2], v1[3]);
                    *(v4u*)(rowp + bj * HALF) = w; } }
    }
};
struct EpiI8 {
    static constexpr bool PERM = true, AFTER_DRAIN = false;
    unsigned char* O; int ldc; int coff; float scale;
    __device__ __forceinline__ void operator()(const f32x4 (&acc)[2][2][4][2], const Unit& u, int wr, int wc, int fr, int fq) const {
        const int row0 = u.pm * BM + wr * 64 + fr; const int col0 = u.pn * BM + wc * 32 + 8 * fq;
#pragma unroll
        for (int ai = 0; ai < 2; ++ai)
#pragma unroll
            for (int m = 0; m < 4; ++m) { unsigned char* rowp = O + (size_t)(row0 + ai * HALF + m * 16) * ldc + coff + col0;
#pragma unroll
                for (int bj = 0; bj < 2; ++bj) *(v2u*)(rowp + bj * HALF) = (v2u){q8x4c(acc[ai][bj][m][0], scale), q8x4c(acc[ai][bj][m][1], scale)}; }
    }
};
struct EpiF32RowScale {
    static constexpr bool PERM = false, AFTER_DRAIN = false;
    float* O; int ldc; const float* rs; const float* cs;
    __device__ __forceinline__ void operator()(const f32x4 (&acc)[2][2][4][2], const Unit& u, int wr, int wc, int fr, int fq) const {
        const int row0 = u.pm * BM + wr * 64 + fr; const int col0 = u.pn * BM + wc * 32 + 4 * fq;
        f32x4 cv[2][2];
#pragma unroll
        for (int bj = 0; bj < 2; ++bj)
#pragma unroll
            for (int n = 0; n < 2; ++n) cv[bj][n] = *(const f32x4*)(cs + col0 + bj * HALF + n * 16);
#pragma unroll
        for (int ai = 0; ai < 2; ++ai)
#pragma unroll
            for (int m = 0; m < 4; ++m) { const int row = row0 + ai * HALF + m * 16; const float r = rs[row]; const size_t off = (size_t)row * ldc + col0;
#pragma unroll
                for (int bj = 0; bj < 2; ++bj)
#pragma unroll
                    for (int n = 0; n < 2; ++n) *(f32x4*)(O + off + bj * HALF + n * 16) = acc[ai][bj][m][n] * cv[bj][n] * r; }
    }
};
struct EpiResBf16 {
    static constexpr bool PERM = true, AFTER_DRAIN = false;
    const float* X; const float* gate; bf16_t* O; int ldc; float ascale;
    __device__ __forceinline__ void operator()(const f32x4 (&acc)[2][2][4][2], const Unit& u, int wr, int wc, int fr, int fq) const {
        const int row0 = u.pm * BM + wr * 64 + fr; const int col0 = u.pn * BM + wc * 32 + 8 * fq; const int b = (u.pm * BM) / SEQ;
        f32x4 gv[2][2];
#pragma unroll
        for (int bj = 0; bj < 2; ++bj)
#pragma unroll
            for (int n = 0; n < 2; ++n) gv[bj][n] = *(const f32x4*)(gate + (size_t)b * DM + col0 + bj * HALF + 4 * n) * ascale;
#pragma unroll
        for (int ai = 0; ai < 2; ++ai)
#pragma unroll
            for (int m = 0; m < 4; ++m) { const size_t off = (size_t)(row0 + ai * HALF + m * 16) * ldc + col0;
#pragma unroll
                for (int bj = 0; bj < 2; ++bj) { const f32x4 x0 = *(const f32x4*)(X + off + bj * HALF), x1 = *(const f32x4*)(X + off + bj * HALF + 4);
                    const f32x4 v0 = x0 + gv[bj][0] * acc[ai][bj][m][0], v1 = x1 + gv[bj][1] * acc[ai][bj][m][1];
                    v4u w; w.x = cvt_pk_bf16(v0[0], v0[1]); w.y = cvt_pk_bf16(v0[2], v0[3]); w.z = cvt_pk_bf16(v1[0], v1[1]); w.w = cvt_pk_bf16(v1[2], v1[3]);
                    *(v4u*)(O + off + bj * HALF) = w; } }
    }
};
struct EpiResF32 {
    static constexpr bool PERM = false, AFTER_DRAIN = false;
    const float* X; const float* gate; float* O; int ldc;
    __device__ __forceinline__ void operator()(const f32x4 (&acc)[2][2][4][2], const Unit& u, int wr, int wc, int fr, int fq) const {
        const int row0 = u.pm * BM + wr * 64 + fr; const int col0 = u.pn * BM + wc * 32 + 4 * fq; const int b = (u.pm * BM) / SEQ;
        f32x4 gv[2][2];
#pragma unroll
        for (int bj = 0; bj < 2; ++bj)
#pragma unroll
            for (int n = 0; n < 2; ++n) gv[bj][n] = *(const f32x4*)(gate + (size_t)b * DM + col0 + bj * HALF + n * 16);
#pragma unroll
        for (int ai = 0; ai < 2; ++ai)
#pragma unroll
            for (int m = 0; m < 4; ++m) { const size_t off = (size_t)(row0 + ai * HALF + m * 16) * ldc + col0;
#pragma unroll
                for (int bj = 0; bj < 2; ++bj)
#pragma unroll
                    for (int n = 0; n < 2; ++n) { const f32x4 xv = *(const f32x4*)(X + off + bj * HALF + n * 16);
                        *(f32x4*)(O + off + bj * HALF + n * 16) = xv + gv[bj][n] * acc[ai][bj][m][n]; } }
    }
};
struct EpiF32 {
    static constexpr bool PERM = false, AFTER_DRAIN = false;
    float* O; int ldc;
    __device__ __forceinline__ void operator()(const f32x4 (&acc)[2][2][4][2], const Unit& u, int wr, int wc, int fr, int fq) const {
        const int row0 = u.pm * BM + wr * 64 + fr; const int col0 = u.pn * BM + wc * 32 + 4 * fq;
#pragma unroll
        for (int ai = 0; ai < 2; ++ai)
#pragma unroll
            for (int m = 0; m < 4; ++m) { const size_t off = (size_t)(row0 + ai * HALF + m * 16) * ldc + col0;
#pragma unroll
                for (int bj = 0; bj < 2; ++bj)
#pragma unroll
                    for (int n = 0; n < 2; ++n) *(f32x4*)(O + off + bj * HALF + n * 16) = acc[ai][bj][m][n]; }
    }
};

template <class Epi, class Sched, bool ALIGN_EPI, bool I8 = false>
__device__ __forceinline__ void gemm_phase(LAS unsigned char* lds, const Gemm g, const Sched& S, const Epi& E, const int wave_id) {
    const int wid = wave_id, lane = hw_lane(), tid = wid * 64 + lane,
              wr = wid >> 2, wc = wid & 3, fr = lane & 15, fq = lane >> 4;
    const int K = g.K, nt = K / BK;
    unsigned voffA, voffB;
    { int R, C; stage_rc(tid * 16, R, C); const int Rb = Epi::PERM ? ((R & ~31) + perm32(R & 31)) : R;
      voffA = (unsigned)(R * g.lda + C) * 2u; voffB = (unsigned)(Rb * g.ldb + C) * 2u; }
    const size_t pstepA = (size_t)64 * g.lda * 2, pstepB = (size_t)64 * g.ldb * 2;
    const size_t kstep = (size_t)(BK * 2);
    const size_t hstepA = (size_t)HALF * g.lda * 2, hstepB = (size_t)HALF * g.ldb * 2;
    const size_t tstepA = 2 * hstepA, tstepB = 2 * hstepB;
    const unsigned ldsw = (unsigned)wid * 1024u;
    const int aoff = lds_byte(wr * 64 + fr, fq * 8), boff = lds_byte(wc * 32 + fr, fq * 8);
#define PG8_SA(b, h) (((b) * 2 + (h)) * HTB)
#define PG8_SB(b, h) ((4 + (b) * 2 + (h)) * HTB)
#define PG8_STAGE(bufoff, gbase, voff) do { _Pragma("unroll") for (int _i = 0; _i < 2; ++_i) \
        __builtin_amdgcn_global_load_lds((const unsigned*)((const char*)(gbase) + (size_t)_i * pstep_##voff + (voff)), (LAS unsigned*)(lds + (bufoff) + ldsw + _i * 8192), 16, 0, 0); } while (0)
#define pstep_voffA pstepA
#define pstep_voffB pstepB
#define PG8_LDA(dst, b, h) pg8_ldfrag16<4>(dst, lds + PG8_SA(b, h), aoff)
#define PG8_LDB(dst, b, h) pg8_ldfrag16<2>(dst, lds + PG8_SB(b, h), boff)
#define PG8_MMA(ai, bj, At, Bt) do { __builtin_amdgcn_s_setprio(1); if constexpr (I8) pg8_mma8(acci[ai][bj], At, Bt); else pg8_mma16(acc[ai][bj], At, Bt); __builtin_amdgcn_s_setprio(0); } while (0)
#define PG8_WAIT_V(n) asm volatile("s_waitcnt vmcnt(" #n ")" ::: "memory")
#define PG8_WAIT_L(n) asm volatile("s_waitcnt lgkmcnt(" #n ")" ::: "memory")
#define PG8_BAR __builtin_amdgcn_s_barrier()
#define PG8_SCHED __builtin_amdgcn_sched_barrier(0)
#define PG8_ABASE(u) ((const char*)g.A + (size_t)(u).pm * tstepA + (size_t)((u).pn / g.agrp_div) * (size_t)g.agrp_cols * 2)
#define PG8_BBASE(u) ((const char*)g.Bt + (size_t)(u).pn * tstepB + (size_t)((u).pm / g.bgrp_div) * (size_t)g.bgrp_cols * 2)
    Unit cur, nxt; int ui = 0;
    if (!S.next(0, cur)) return;
    f32x4 acc[2][2][4][2]; v4i_t acci[2][2][4][2];
#pragma unroll
    for (int a = 0; a < 2; ++a)
#pragma unroll
        for (int b = 0; b < 2; ++b)
#pragma unroll
            for (int m = 0; m < 4; ++m)
#pragma unroll
                for (int n = 0; n < 2; ++n) { acc[a][b][m][n] = (f32x4){0.f, 0.f, 0.f, 0.f}; acci[a][b][m][n] = (v4i_t){0, 0, 0, 0}; }
    bf16x8 At[4][2], B0[2][2], B1[2][2];
    const char* cA = PG8_ABASE(cur); const char* cB = PG8_BBASE(cur);
    S.a_ready(cur);
    PG8_STAGE(PG8_SB(0, 0), cB, voffB); PG8_STAGE(PG8_SB(0, 1), cB + hstepB, voffB); PG8_STAGE(PG8_SA(0, 0), cA, voffA); PG8_STAGE(PG8_SA(0, 1), cA + hstepA, voffA);
    if (wr == 1) PG8_BAR;
    PG8_WAIT_V(2); PG8_BAR;
    PG8_STAGE(PG8_SB(1, 0), cB + kstep, voffB); PG8_STAGE(PG8_SA(1, 0), cA + kstep, voffA); PG8_STAGE(PG8_SB(1, 1), cB + hstepB + kstep, voffB);
    PG8_WAIT_V(6); PG8_BAR;
    for (;;) {
        const bool has_next = S.next(ui + 1, nxt);
        const char* nA = has_next ? PG8_ABASE(nxt) : cA; const char* nB = has_next ? PG8_BBASE(nxt) : cB;
        for (int t = 0; t < nt; t += 2) {
            const bool last = (t == nt - 2);
            const char* a1 = cA + (size_t)(t + 1) * kstep;
            const char* a2 = last ? nA : cA + (size_t)(t + 2) * kstep; const char* b2 = last ? nB : cB + (size_t)(t + 2) * kstep;
            const char* a3 = a2 + kstep; const char* b3 = b2 + kstep;
            if (last && has_next) S.a_ready(nxt);
            PG8_LDB(B0, 0, 0); PG8_LDB(B1, 0, 1); PG8_SCHED; PG8_LDA(At, 0, 0); PG8_STAGE(PG8_SA(1, 1), a1 + hstepA, voffA);
            PG8_WAIT_V(8); PG8_WAIT_L(0); PG8_BAR; PG8_MMA(0, 0, At, B0); PG8_MMA(0, 1, At, B1); PG8_BAR; PG8_SCHED;
            PG8_LDA(At, 0, 1); PG8_STAGE(PG8_SB(0, 0), b2, voffB); PG8_STAGE(PG8_SB(0, 1), b2 + hstepB, voffB); PG8_STAGE(PG8_SA(0, 0), a2, voffA);
            PG8_WAIT_V(8); PG8_WAIT_L(0); PG8_BAR; PG8_MMA(1, 0, At, B0); PG8_MMA(1, 1, At, B1); PG8_BAR; PG8_SCHED;
            PG8_LDB(B0, 1, 0); PG8_LDB(B1, 1, 1); PG8_SCHED; PG8_LDA(At, 1, 0); PG8_STAGE(PG8_SA(0, 1), a2 + hstepA, voffA);
            PG8_WAIT_V(8); PG8_WAIT_L(0); PG8_BAR; PG8_MMA(0, 0, At, B0); PG8_MMA(0, 1, At, B1); PG8_BAR; PG8_SCHED;
            PG8_LDA(At, 1, 1); PG8_STAGE(PG8_SB(1, 0), b3, voffB); PG8_STAGE(PG8_SB(1, 1), b3 + hstepB, voffB); PG8_STAGE(PG8_SA(1, 0), a3, voffA);
            PG8_WAIT_V(8); PG8_WAIT_L(0); PG8_BAR; PG8_MMA(1, 0, At, B0); PG8_MMA(1, 1, At, B1); PG8_BAR; PG8_SCHED;
        }
        if constexpr (ALIGN_EPI) { if (wr == 0) PG8_BAR; }
        if constexpr (I8) {
#pragma unroll
            for (int a = 0; a < 2; ++a)
#pragma unroll
                for (int b = 0; b < 2; ++b)
#pragma unroll
                    for (int m = 0; m < 4; ++m)
#pragma unroll
                        for (int n = 0; n < 2; ++n) acc[a][b][m][n] = __builtin_convertvector(acci[a][b][m][n], f32x4);
        }
        E(acc, cur, wr, wc, fr, fq);
        S.done(cur);
        if (!has_next) break;
#pragma unroll
        for (int a = 0; a < 2; ++a)
#pragma unroll
            for (int b = 0; b < 2; ++b)
#pragma unroll
                for (int m = 0; m < 4; ++m)
#pragma unroll
                    for (int n = 0; n < 2; ++n) { acc[a][b][m][n] = (f32x4){0.f, 0.f, 0.f, 0.f}; acci[a][b][m][n] = (v4i_t){0, 0, 0, 0}; }
        cur = nxt; cA = nA; cB = nB; ++ui;
        if constexpr (ALIGN_EPI) { if (wr == 1) PG8_BAR; }
    }
    PG8_WAIT_V(0);
    if constexpr (!ALIGN_EPI) { if (wr == 0) PG8_BAR; }
    PG8_BAR;
#undef PG8_SA
#undef PG8_SB
#undef PG8_STAGE
#undef pstep_voffA
#undef pstep_voffB
#undef PG8_LDA
#undef PG8_LDB
#undef PG8_MMA
#undef PG8_WAIT_V
#undef PG8_WAIT_L
#undef PG8_BAR
#undef PG8_SCHED
#undef PG8_ABASE
#undef PG8_BBASE
}
}

#define XB_TMO      128
#define XB_XCNT(j)  (256  + 64 * (j))
#define XB_XSUB(j)  (1280 + 64 * (j))
#define XB_XGEN(j)  (2304 + 64 * (j))
#define XB_TOP      3328
#define XB_TOPGEN   3392
#define XCD_BAR_WORDS 3456
#define XB_SPIN_CAP (1u << 18)

__device__ __forceinline__ unsigned xb_ld(unsigned* p)              { return __hip_atomic_load(p, __ATOMIC_RELAXED, __HIP_MEMORY_SCOPE_AGENT); }
__device__ __forceinline__ unsigned xb_add(unsigned* p, unsigned v) { return __hip_atomic_fetch_add(p, v, __ATOMIC_RELAXED, __HIP_MEMORY_SCOPE_AGENT); }
__device__ __forceinline__ unsigned xb_xcc_id() { return (unsigned)__builtin_amdgcn_s_getreg((3 << 11) | 20) & 0xFu; }
#define XB_SPIN(cond, bar) do { unsigned _sp = 0; while (cond) { __builtin_amdgcn_s_sleep(1); \
    if ((++_sp & 255u) == 0u) { if (xb_ld(&(bar)[XB_TMO])) break; if (_sp > XB_SPIN_CAP) { atomicAdd(&(bar)[XB_TMO], 1u); break; } } } } while (0)

struct XcdBarrier { unsigned* bar; unsigned x; volatile LAS unsigned* st; };

__device__ __forceinline__ XcdBarrier xcd_barrier_post(unsigned* bar, volatile LAS unsigned* st, const int wave_id) {
    XcdBarrier b; b.bar = bar; b.x = xb_xcc_id(); b.st = st;
    if (wave_id == 0 && hw_lane() == 0) (void)xb_add(&bar[XB_XCNT(b.x)], 1u);
    return b;
}
__device__ __forceinline__ void xcd_barrier_complete(unsigned* bar, unsigned x, unsigned& nloc, unsigned& nx) {
    const unsigned G = gridDim.x * gridDim.y * gridDim.z;
    unsigned sum, cnt, mine, sp = 0u;
    for (;;) {
        sum = 0u; cnt = 0u; mine = 0u;
#pragma unroll
        for (unsigned j = 0; j < 16; ++j) { const unsigned c = xb_ld(&bar[XB_XCNT(j)]); sum += c; cnt += (c > 0u) ? 1u : 0u; mine = (j == x) ? c : mine; }
        if (sum == G) break;
        __builtin_amdgcn_s_sleep(1);
        if ((++sp & 255u) == 0u) { if (xb_ld(&bar[XB_TMO])) break; if (sp > XB_SPIN_CAP) { atomicAdd(&bar[XB_TMO], 1u); break; } }
    }
    nloc = mine > 0u ? mine : 1u; nx = cnt > 0u ? cnt : 1u;
}
__device__ __forceinline__ void xcd_barrier(const XcdBarrier& b, const int wave_id) {
    asm volatile("s_waitcnt vmcnt(0)" ::: "memory");
    __syncthreads();
    if (wave_id == 0 && hw_lane() == 0) {
        unsigned* bar = b.bar;
        __builtin_amdgcn_s_waitcnt(0);
        unsigned nloc = b.st[0], nx = b.st[1];
        if (nloc == 0u) { xcd_barrier_complete(bar, b.x, nloc, nx); b.st[0] = nloc; b.st[1] = nx; }
        const unsigned old = xb_add(&bar[XB_XSUB(b.x)], 1u);
        const unsigned gen = old / nloc;
        if (old + 1u == (gen + 1u) * nloc) {
            __builtin_amdgcn_fence(__ATOMIC_RELEASE, "agent");
            asm volatile("s_waitcnt vmcnt(0)" ::: "memory");
            const unsigned og = xb_add(&bar[XB_TOP], 1u);
            const unsigned tg = og / nx;
            if (og + 1u == (tg + 1u) * nx) xb_add(&bar[XB_TOPGEN], 1u);
            else XB_SPIN(xb_ld(&bar[XB_TOPGEN]) == tg, bar);
            __builtin_amdgcn_fence(__ATOMIC_ACQUIRE, "agent");
            xb_add(&bar[XB_XGEN(b.x)], 1u);
            asm volatile("s_waitcnt vmcnt(0)" ::: "memory");
        } else {
            XB_SPIN(xb_ld(&bar[XB_XGEN(b.x)]) == gen, bar);
            __builtin_amdgcn_fence(__ATOMIC_ACQUIRE, "agent");
            asm volatile("s_waitcnt vmcnt(0)" ::: "memory");
        }
    }
    __syncthreads();
}

template <bool F8>
__device__ __forceinline__ void p0_transpose_item(const float* W, int ldw, int N, void* WTv, int ldt, float scale, LAS float* scr, int item, int lane) {
    const int nblk = N / 32, kb = item / nblk, nb = item % nblk, k0 = 64 * kb, n0 = 32 * nb;
#pragma unroll 8
    for (int i = 0; i < 32; ++i) { const int kk = 2 * i + (lane >> 5); scr[kk * 33 + (lane & 31)] = W[(size_t)(k0 + kk) * ldw + n0 + (lane & 31)]; }
    LDS_WAIT(); asm volatile("" ::: "memory");
    const int c = lane & 7;
#pragma unroll
    for (int j = 0; j < 4; ++j) { const int n = (lane >> 3) + 8 * j; const LAS float* s = scr + (8 * c) * 33 + n;
        if constexpr (F8) {
            const f32x4 lo4 = {s[0 * 33], s[1 * 33], s[2 * 33], s[3 * 33]}, hi4 = {s[4 * 33], s[5 * 33], s[6 * 33], s[7 * 33]};
            *(GAS v2u*)((unsigned char*)WTv + (size_t)(n0 + n) * ldt + k0 + 8 * c) = (v2u){q8x4c(lo4, scale), q8x4c(hi4, scale)};
        } else {
            v4u o; o.x = cvt_pk_bf16(s[0 * 33], s[1 * 33]); o.y = cvt_pk_bf16(s[2 * 33], s[3 * 33]); o.z = cvt_pk_bf16(s[4 * 33], s[5 * 33]); o.w = cvt_pk_bf16(s[6 * 33], s[7 * 33]);
            *(GAS v4u*)((bf16*)WTv + (size_t)(n0 + n) * ldt + k0 + 8 * c) = o; } }
    LDS_WAIT(); asm volatile("" ::: "memory");
}

__device__ __forceinline__ int t5_bucket(int rel) {
    int n = -rel; const int ret = n < 0 ? 16 : 0; n = n < 0 ? -n : n;
    if (n < 8) return ret + n;
    const float v = logf((float)n / 8.0f) / logf(128.0f) * 8.0f;
    int large = 8 + (int)v; large = large < 15 ? large : 15;
    return ret + large;
}
__device__ __forceinline__ float gelu_tanh(float x) {
    const float z = 0.7978845608028654f * (x + 0.044715f * x * x * x);
    const float e = __expf(2.0f * z);
    const float t = 1.0f - 2.0f / (e + 1.0f);
    return 0.5f * x * (1.0f + t);
}
__device__ __forceinline__ unsigned fkey(float v) { const unsigned u = __float_as_uint(v); return (u >> 31) ? ~u : (u | 0x80000000u); }
__device__ __forceinline__ float fdec(unsigned key) { const unsigned k2 = key & ~127u; const unsigned u = (k2 >> 31) ? (k2 & 0x7fffffffu) : (~k2 & ~127u); return __uint_as_float(u); }
template <int LJ> __device__ __forceinline__ unsigned xshfl(unsigned x, const int lane) {
    if constexpr (LJ == 1) return (unsigned)__builtin_amdgcn_update_dpp(0, (int)x, 0xB1, 0xF, 0xF, true);
    else if constexpr (LJ == 2) return (unsigned)__builtin_amdgcn_update_dpp(0, (int)x, 0x4E, 0xF, 0xF, true);
    else if constexpr (LJ == 4) { const int y = __builtin_amdgcn_update_dpp(0, (int)x, 0x141, 0xF, 0xF, true); return (unsigned)__builtin_amdgcn_update_dpp(0, y, 0x1B, 0xF, 0xF, true); }
    else if constexpr (LJ == 8) return (unsigned)__builtin_amdgcn_update_dpp(0, (int)x, 0x128, 0xF, 0xF, true);
    else if constexpr (LJ == 16) return (unsigned)__builtin_amdgcn_ds_swizzle((int)x, 0x401F);
    else { const auto rr = __builtin_amdgcn_permlane32_swap(x, x, false, false); return lane < 32 ? rr[1] : rr[0]; }
}
template <int K, int J> __device__ __forceinline__ void bitonic_step(unsigned& a0, unsigned& a1, unsigned& b0, unsigned& b1, const int lane) {
    const bool asc = (K == 128) ? true : ((lane & (K >> 1)) == 0);
    if constexpr (J == 1) {
        const unsigned la = a0 < a1 ? a0 : a1, ha = a0 < a1 ? a1 : a0, lb = b0 < b1 ? b0 : b1, hb = b0 < b1 ? b1 : b0;
        a0 = asc ? la : ha; a1 = asc ? ha : la; b0 = asc ? lb : hb; b1 = asc ? hb : lb;
    } else {
        constexpr int LJ = J >> 1; const bool tmin = (((lane & LJ) == 0) == asc);
        const unsigned pa0 = xshfl<LJ>(a0, lane), pa1 = xshfl<LJ>(a1, lane), pb0 = xshfl<LJ>(b0, lane), pb1 = xshfl<LJ>(b1, lane);
        a0 = tmin ? (a0 < pa0 ? a0 : pa0) : (a0 < pa0 ? pa0 : a0); a1 = tmin ? (a1 < pa1 ? a1 : pa1) : (a1 < pa1 ? pa1 : a1);
        b0 = tmin ? (b0 < pb0 ? b0 : pb0) : (b0 < pb0 ? pb0 : b0); b1 = tmin ? (b1 < pb1 ? b1 : pb1) : (b1 < pb1 ? pb1 : b1);
    }
    if constexpr (J > 1) bitonic_step<K, (J >> 1)>(a0, a1, b0, b1, lane);
}
template <int K> __device__ __forceinline__ void bitonic_stage(unsigned& a0, unsigned& a1, unsigned& b0, unsigned& b1, const int lane) {
    bitonic_step<K, (K >> 1)>(a0, a1, b0, b1, lane);
    if constexpr (K < 128) bitonic_stage<(K << 1)>(a0, a1, b0, b1, lane);
}
template <int K, int J> __device__ __forceinline__ void bitonic_step_f(float& a0, float& a1, float& b0, float& b1, const int lane) {
    const bool asc = (K == 128) ? true : ((lane & (K >> 1)) == 0);
    if constexpr (J == 1) {
        const float lo_ = asc ? -__builtin_inff() : __builtin_inff(), hi_ = asc ? __builtin_inff() : -__builtin_inff();
        const float na0 = __builtin_amdgcn_fmed3f(a0, a1, lo_), na1 = __builtin_amdgcn_fmed3f(a0, a1, hi_), nb0 = __builtin_amdgcn_fmed3f(b0, b1, lo_), nb1 = __builtin_amdgcn_fmed3f(b0, b1, hi_);
        a0 = na0; a1 = na1; b0 = nb0; b1 = nb1;
    } else {
        constexpr int LJ = J >> 1; const bool tmin = (((lane & LJ) == 0) == asc);
        const float bnd = tmin ? -__builtin_inff() : __builtin_inff();
        const float pa0 = __uint_as_float(xshfl<LJ>(__float_as_uint(a0), lane)), pa1 = __uint_as_float(xshfl<LJ>(__float_as_uint(a1), lane)), pb0 = __uint_as_float(xshfl<LJ>(__float_as_uint(b0), lane)), pb1 = __uint_as_float(xshfl<LJ>(__float_as_uint(b1), lane));
        a0 = __builtin_amdgcn_fmed3f(a0, pa0, bnd); a1 = __builtin_amdgcn_fmed3f(a1, pa1, bnd); b0 = __builtin_amdgcn_fmed3f(b0, pb0, bnd); b1 = __builtin_amdgcn_fmed3f(b1, pb1, bnd);
    }
    if constexpr (J > 1) bitonic_step_f<K, (J >> 1)>(a0, a1, b0, b1, lane);
}
template <int K> __device__ __forceinline__ void bitonic_stage_f(float& a0, float& a1, float& b0, float& b1, const int lane) {
    bitonic_step_f<K, (K >> 1)>(a0, a1, b0, b1, lane);
    if constexpr (K < 128) bitonic_stage_f<(K << 1)>(a0, a1, b0, b1, lane);
}
__device__ __forceinline__ void bitonic128x2f(float& a0, float& a1, float& b0, float& b1, const int lane) { bitonic_stage_f<2>(a0, a1, b0, b1, lane); }
__device__ __forceinline__ void bitonic128x2(unsigned& a0, unsigned& a1, unsigned& b0, unsigned& b1, const int lane) { bitonic_stage<2>(a0, a1, b0, b1, lane); }
__device__ __forceinline__ float dot2bf(unsigned a, unsigned b, float c) { return __builtin_amdgcn_fdot2_f32_bf16(__builtin_bit_cast(bf2_t, a), __builtin_bit_cast(bf2_t, b), c, false); }

__device__ __forceinline__ int clampi(int x, int hi) { x = x < 0 ? 0 : x; return x > hi ? hi : x; }
constexpr int ATT_SLOT4 = 4352;
constexpr int ATT_SLOT = 8704;
__device__ __forceinline__ int crow(int r, int hi) { return (r & 3) + 8 * (r >> 2) + 4 * hi; }

__device__ __forceinline__ void attn_task(const int G, const bf16* QKVH, bf16* O0, bf16* O1, float* LSE0, float* LSE1, unsigned char* MIX8,
                                          const LAS float* btab, LAS unsigned char* wl, int b, int h, int mtile, int tk, int lane) {
    const int SH = 2 * G;
    const int L = SEQ >> SH, TPR = 32 >> SH;
    const int r32 = lane & 31, hi = lane >> 5;
    const int res = tk >> (5 - SH), l0 = ((mtile * 1024) >> SH) + 32 * (tk & (TPR - 1));
    const size_t rowbase = (size_t)b * SEQ;
    const int srow = lane >> 4, sch = lane & 15;
    const int rot = (tk & 1) ? 4 : 0;
#define ATT_JR(j) (((j) + rot) >= 5 ? ((j) + rot - 5) : ((j) + rot))
#define ATT_WAITV(n) asm volatile("s_waitcnt vmcnt(" #n ")" ::: "memory")
      \
#define ATT_ISSUE(n) do { LAS unsigned char* sl_ = wl + ((n) & 3) * ATT_SLOT4; const int jt_ = ATT_JR((n) - 5); \
        _Pragma("unroll") for (int i_ = 0; i_ < 4; ++i_) { \
            const int lk_ = clampi(vlk0 + i_ + 32 * jt_, L - 1); \
            const unsigned char* src_ = vhb_ + (((unsigned)lk_ << (SH + 7)) + 16u * (unsigned)kch8); \
            __builtin_amdgcn_global_load_lds((const unsigned*)src_, (LAS unsigned*)(sl_ + i_ * 1056), 16, 0, 0); } } while (0)
    const int krow8 = lane >> 3, kch8 = lane & 7;
#define ATT_ISSUEK(n) do { LAS unsigned char* sl_ = wl + ((n) & 3) * ATT_SLOT4; const int jt_ = ATT_JR(n); \
        _Pragma("unroll") for (int i_ = 0; i_ < 4; ++i_) { \
            const int lk_ = clampi(klk0 + 8 * i_ + 32 * jt_, L - 1); \
            const unsigned char* src_ = khb_ + (((unsigned)lk_ << (SH + 7)) + kof_[i_]); \
            __builtin_amdgcn_global_load_lds((const unsigned*)src_, (LAS unsigned*)(sl_ + i_ * 1024), 16, 0, 0); } } while (0)
    const size_t qrow = rowbase + ((size_t)(l0 + r32) << SH) + res;
    const unsigned char* QK8 = (const unsigned char*)QKVH;
    const unsigned char* khb_ = QK8 + (((size_t)(NH + h) * M + rowbase + res) << 7); const unsigned char* vhb_ = QK8 + (((size_t)(2 * NH + h) * M + rowbase + res) << 7);
    const int klk0 = l0 - 64 + krow8, vlk0 = l0 - 64 + 4 * ((krow8 >> 1) & 1) + 8 * (krow8 & 1) + 16 * (krow8 >> 2);
    unsigned kof_[4];
#pragma unroll
    for (int i_ = 0; i_ < 4; ++i_) { const int key_ = 8 * i_ + krow8; kof_[i_] = 16u * (unsigned)(kch8 ^ ((key_ ^ (key_ >> 3)) & 7)); }
    long qr[8];
    { const unsigned char* qp = QK8 + ((size_t)h * M + qrow) * HD + hi * 8;
#pragma unroll
      for (int d0 = 0; d0 < 8; ++d0) qr[d0] = *(const long*)(qp + d0 * 16); }
    ATT_ISSUEK(0); ATT_ISSUEK(1); ATT_ISSUEK(2); ATT_ISSUEK(3);
    f32x16 p[5];
    const int ksw = (r32 ^ (r32 >> 3)) & 7;
#define ATT_KTILE(n) do { LAS unsigned char* sl_ = wl + ((n) & 3) * ATT_SLOT4 + r32 * 128 + 8 * hi; f32x16 s_ = {}; \
        _Pragma("unroll") for (int d0 = 0; d0 < 8; ++d0) { const long a_ = *(const LAS long*)(sl_ + ((d0 ^ ksw) << 4)); s_ = __builtin_amdgcn_mfma_f32_32x32x16_fp8_fp8(a_, qr[d0], s_, 0, 0, 0); } \
        p[n] = s_; asm volatile("" ::: "memory"); } while (0)
    ATT_WAITV(12); ATT_KTILE(0); ATT_ISSUEK(4);
    ATT_WAITV(12); ATT_KTILE(1); ATT_ISSUE(5);
    ATT_WAITV(12); ATT_KTILE(2); ATT_ISSUE(6);
    ATT_WAITV(12); ATT_KTILE(3); ATT_ISSUE(7);
    ATT_WAITV(12); ATT_KTILE(4); ATT_ISSUE(8);
    float mx = -1e30f;
    const bool edge = (l0 - 64 < 0) || (l0 + 96 > L);
    const LAS float* bt = btab + G * 256 + 32 + 4 * hi - r32;
    if (!edge) {
#pragma unroll
        for (int j = 0; j < 5; ++j) {
            const int jr = ATT_JR(j); const LAS float* btj = bt + 32 * jr;
#pragma unroll
            for (int r = 0; r < 16; ++r) { const float v = p[j][r] * (1.0f / (Q8MUL * K8MUL)) + btj[(r & 3) + 8 * (r >> 2)]; p[j][r] = v; mx = fmaxf(mx, v); }
            asm volatile("" ::: "memory");
        }
    } else {
#pragma unroll
        for (int j = 0; j < 5; ++j) {
            const int jr = ATT_JR(j); const LAS float* btj = bt + 32 * jr;
#pragma unroll
            for (int r = 0; r < 16; ++r) {
                const int kc = 32 * jr + (r & 3) + 8 * (r >> 2);
                float v = p[j][r] * (1.0f / (Q8MUL * K8MUL)) + btj[(r & 3) + 8 * (r >> 2)];
                const int lk = l0 - 64 + kc + 4 * hi; v = ((unsigned)lk < (unsigned)L) ? v : -1e30f;
                p[j][r] = v; mx = fmaxf(mx, v);
            }
            asm volatile("" ::: "memory");
        }
    }
    mx = fmaxf(mx, __shfl_xor(mx, 32)) - 8.0f;
    float ls = 0.f;
    long pb[5][2];
#pragma unroll
    for (int j = 0; j < 5; ++j) {
        float e[16];
#pragma unroll
        for (int r = 0; r < 16; ++r) { e[r] = __builtin_amdgcn_exp2f(p[j][r] - mx); ls += e[r]; }
#pragma unroll
        for (int s = 0; s < 2; ++s) { int lo_ = 0, hi_ = 0;
            lo_ = __builtin_amdgcn_cvt_pk_fp8_f32(e[8 * s + 0], e[8 * s + 1], lo_, false); lo_ = __builtin_amdgcn_cvt_pk_fp8_f32(e[8 * s + 2], e[8 * s + 3], lo_, true);
            hi_ = __builtin_amdgcn_cvt_pk_fp8_f32(e[8 * s + 4], e[8 * s + 5], hi_, false); hi_ = __builtin_amdgcn_cvt_pk_fp8_f32(e[8 * s + 6], e[8 * s + 7], hi_, true);
            pb[j][s] = (long)(((unsigned long)(unsigned)hi_ << 32) | (unsigned long)(unsigned)lo_); }
    }
    ls += __shfl_xor(ls, 32);
    asm volatile("" ::: "memory");
    f32x16 o[4] = {};
    const int i16 = lane & 15, g16 = lane >> 4;
    const int tr_ = i16 >> 1;
    const unsigned vbase = (unsigned)(uintptr_t)wl + (unsigned)((tr_ & 3) * 1056 + (2 * hi + (tr_ >> 2)) * 128 + 16 * (g16 & 1) + 8 * (i16 & 1));
#define ATT_VTILE(n) do { const unsigned va_ = vbase + ((n) & 3) * ATT_SLOT4; \
        _Pragma("unroll") for (int dt = 0; dt < 4; ++dt) { long af0, af1; \
            asm volatile("ds_read_b64_tr_b8 %0, %2 offset:%3\n\tds_read_b64_tr_b8 %1, %2 offset:%4\n\ts_waitcnt lgkmcnt(0)" \
                         : "=&v"(af0), "=&v"(af1) : "v"(va_), "i"(dt * 32), "i"(512 + dt * 32) : "memory"); \
            o[dt] = __builtin_amdgcn_mfma_f32_32x32x16_fp8_fp8(af0, pb[(n) - 5][0], o[dt], 0, 0, 0); \
            o[dt] = __builtin_amdgcn_mfma_f32_32x32x16_fp8_fp8(af1, pb[(n) - 5][1], o[dt], 0, 0, 0); } } while (0)
    ATT_WAITV(12); ATT_VTILE(5); ATT_ISSUE(9);
    ATT_WAITV(12); ATT_VTILE(6);
    ATT_WAITV(8);  ATT_VTILE(7);
    ATT_WAITV(4);  ATT_VTILE(8);
    ATT_WAITV(0);  ATT_VTILE(9);
#undef ATT_WAITV
#undef ATT_ISSUE
#undef ATT_ISSUEK
#undef ATT_KTILE
#undef ATT_VTILE
#undef ATT_JR
    const float inv = 1.0f / (ls * V8MUL);
    const float lse2 = mx + __builtin_amdgcn_logf(ls);
    const size_t orow = qrow;
    LAS unsigned char* T0 = wl;
    LAS unsigned char* T1 = T0 + ATT_SLOT;
    int ln_ = lane; asm volatile("" : "+v"(ln_));
    const int erow = ln_ >> 4, echk = ln_ & 15;
    const unsigned pofs = (unsigned)(r32 * 272 + 8 * hi);
    if (G < 2) {
        const float inv8 = inv * O8MUL;
#pragma unroll
        for (int dt = 0; dt < 4; ++dt)
#pragma unroll
            for (int rg = 0; rg < 4; ++rg) { int pk = 0; pk = __builtin_amdgcn_cvt_pk_fp8_f32(o[dt][4 * rg] * inv8, o[dt][4 * rg + 1] * inv8, pk, false); pk = __builtin_amdgcn_cvt_pk_fp8_f32(o[dt][4 * rg + 2] * inv8, o[dt][4 * rg + 3] * inv8, pk, true);
                *(LAS unsigned*)(T0 + r32 * 144 + 4 * hi + 32 * dt + 8 * rg) = (unsigned)pk; }
        LDS_WAIT();
        unsigned char* ob = (unsigned char*)(G == 0 ? O0 : O1) + ((size_t)h * M + rowbase) * HD + (ln_ & 7) * 16;
#pragma unroll
        for (int i = 0; i < 4; ++i) { const int qi = (ln_ >> 3) + 8 * i; const v4u w = *(const LAS v4u*)(T0 + qi * 144 + (ln_ & 7) * 16);
            *(v4u*)(ob + (((size_t)(l0 + qi) << SH) + res) * HD) = w; }
        if (hi == 0) (G == 0 ? LSE0 : LSE1)[orow * NH + h] = lse2;
    } else {
        const float l0v = LSE0[orow * NH + h], l1v = LSE1[orow * NH + h];
        const unsigned char* ib0 = (const unsigned char*)O0 + ((size_t)h * M + rowbase) * HD + (ln_ & 7) * 16; const unsigned char* ib1 = (const unsigned char*)O1 + ((size_t)h * M + rowbase) * HD + (ln_ & 7) * 16;
        {
            v4u t0[4], t1[4];
#pragma unroll
            for (int i = 0; i < 4; ++i) { const size_t ro = (((size_t)(l0 + (ln_ >> 3) + 8 * i) << SH) + res) * HD; t0[i] = *(const v4u*)(ib0 + ro); t1[i] = *(const v4u*)(ib1 + ro); }
#pragma unroll
            for (int i = 0; i < 4; ++i) { const int qi = (ln_ >> 3) + 8 * i; *(LAS v4u*)(T0 + qi * 144 + (ln_ & 7) * 16) = t0[i]; *(LAS v4u*)(T1 + qi * 144 + (ln_ & 7) * 16) = t1[i]; }
            asm volatile("" ::: "memory");
        }
        const float mm = fmaxf(fmaxf(l0v, l1v), lse2);
        const float w0 = __builtin_amdgcn_exp2f(l0v - mm), w1 = __builtin_amdgcn_exp2f(l1v - mm), w2 = __builtin_amdgcn_exp2f(lse2 - mm);
        const float wi = 1.0f / (w0 + w1 + w2);
        const float c0 = w0 * wi * (1.0f / O8MUL), c1 = w1 * wi * (1.0f / O8MUL), c2 = w2 * wi * inv;
        LDS_WAIT();
        unsigned y8[16];
#pragma unroll
        for (int dt = 0; dt < 4; ++dt)
#pragma unroll
            for (int rg = 0; rg < 4; ++rg) { const int a = (int)*(const LAS unsigned*)(T0 + r32 * 144 + 4 * hi + 32 * dt + 8 * rg), c = (int)*(const LAS unsigned*)(T1 + r32 * 144 + 4 * hi + 32 * dt + 8 * rg);
                const f32x2 a01 = __builtin_amdgcn_cvt_pk_f32_fp8(a, false), a23 = __builtin_amdgcn_cvt_pk_f32_fp8(a, true), c01 = __builtin_amdgcn_cvt_pk_f32_fp8(c, false), c23 = __builtin_amdgcn_cvt_pk_f32_fp8(c, true);
                const float y0 = c0 * a01.x + c1 * c01.x + c2 * o[dt][4 * rg], y1 = c0 * a01.y + c1 * c01.y + c2 * o[dt][4 * rg + 1];
                const float y2 = c0 * a23.x + c1 * c23.x + c2 * o[dt][4 * rg + 2], y3 = c0 * a23.y + c1 * c23.y + c2 * o[dt][4 * rg + 3];
                y8[4 * dt + rg] = q8x4c((f32x4){y0, y1, y2, y3}, A8SCALE); }
        LDS_WAIT();
#pragma unroll
        for (int dt = 0; dt < 4; ++dt)
#pragma unroll
            for (int rg = 0; rg < 4; ++rg) *(LAS unsigned*)(T0 + r32 * 144 + 4 * hi + 32 * dt + 8 * rg) = y8[4 * dt + rg];
        LDS_WAIT();
        unsigned char* ob = MIX8 + rowbase * DM + h * HD + (ln_ & 7) * 16;
#pragma unroll
        for (int i = 0; i < 4; ++i) { const int qi = (ln_ >> 3) + 8 * i; const v4u w = *(const LAS v4u*)(T0 + qi * 144 + (ln_ & 7) * 16);
            *(v4u*)(ob + (((size_t)(l0 + qi) << SH) + res) * DM) = w; }
    }
    LDS_WAIT();
}

constexpr int PER_PHASE = 9;
struct Args { const float* in[16]; float* out; unsigned char* ws; unsigned mask; unsigned pad; };

__constant__ unsigned char CAND_I[64] = {0,0,0,0,0,0,0,0,0,0,0,0,0,0,0,0, 1,1,1,1,1,1,1,1, 2,2,2,2,2, 3,3,3,3, 4,4,4, 5,5, 6,6, 7,7, 8,9,10,11,12,13,14,15, 0,0,0,0,0,0,0,0,0,0,0,0,0,0};
__constant__ unsigned char CAND_J[64] = {0,1,2,3,4,5,6,7,8,9,10,11,12,13,14,15, 0,1,2,3,4,5,6,7, 0,1,2,3,4, 0,1,2,3, 0,1,2, 0,1, 0,1, 0,1, 0,0,0,0,0,0,0,0, 0,0,0,0,0,0,0,0,0,0,0,0,0,0};

__global__ void __launch_bounds__(NWAVES * 64, 2) fwd_kernel(Args args) {
    extern __shared__ __attribute__((aligned(16))) unsigned char lds_raw[];
    LAS unsigned char* lds = (LAS unsigned char*)lds_raw;
    volatile LAS unsigned* MISC = (volatile LAS unsigned*)(lds + MISC_OFF);
    const int tid0 = threadIdx.x, lane0 = tid0 & 63, wave = __builtin_amdgcn_readfirstlane(tid0 >> 6);
#define PHASE_LANES() int lane; asm volatile("v_mbcnt_lo_u32_b32 %0, -1, 0\n\tv_mbcnt_hi_u32_b32 %0, -1, %0" : "=v"(lane)); const int tid = wave * 64 + lane
    const int G = gridDim.x; const int bx = blockIdx.x;
    const int vcu = (G % 8 == 0) ? (bx % 8) * (G / 8) + bx / 8 : bx;
    const int gw = vcu * NWAVES + wave, NGW = G * NWAVES;
    unsigned char* ws = args.ws;
    unsigned* ctl = (unsigned*)(ws + WS_CTL);
    const float* x = args.in[0]; const float* cvec = args.in[1]; const float* w_ada = args.in[2]; const float* b_ada = args.in[3]; const float* g_mix = args.in[4];
    const float* w_in = args.in[5]; const float* rel_bias = args.in[6]; const float* pool_w = args.in[7]; const float* pool_scale = args.in[8]; const float* w_out = args.in[9];
    const float* g_ffn = args.in[10]; const float* peer_wq = args.in[11]; const float* peer_sk = args.in[12]; const float* peer_u = args.in[13]; const float* peer_v = args.in[14];
    const float* g_final = args.in[15];
    float* out = args.out;
    float* MODV = (float*)(ws + WS_MODV); float* MODP = (float*)(ws + WS_MODP);
    bf16* SKT = (bf16*)(ws + WS_SKT); bf16* PWS = (bf16*)(ws + WS_PWS); bf16* WQSTB = (bf16*)(ws + WS_WQST);     unsigned char* WQST8 = ws + 104 * MiB;     unsigned char* WOUT8 = ws + WS_WOUT2;     unsigned char* WIN8 = ws + WS_WIN8; unsigned char* H8 = ws + WS_H8;
    bf16* WOPT = (bf16*)(ws + WS_WOPT); bf16* WQB = (bf16*)(ws + WS_WQB);
    unsigned char* UB = ws + WS_UB; unsigned char* VB = ws + WS_VB; float* SCL = (float*)(ws + WS_SCL); float* TSC = SCL + 2 * NEXP; float* WQS = TSC + M;         unsigned char* HHI = ws + WS_H; unsigned char* HLO = ws + WS_H + 32 * MiB;     bf16* PIN = (bf16*)(ws + WS_PROJ); bf16* QKVH = (bf16*)(ws + WS_QKVH); unsigned char* MIX8 = ws + WS_MIXIN;
    bf16* O0 = (bf16*)(ws + WS_O0); bf16* O1 = (bf16*)(ws + WS_O1); float* LSE = (float*)(ws + WS_LSE);
    float* SC = (float*)(ws + WS_SC);
    bf16* X1B = (bf16*)(ws + WS_O0);
    bf16* YB = (bf16*)(ws + WS_PROJ + 64 * MiB);

    for (int u = tid0; u < (LDS_BYTES - LDSCTL_OFF) / 4; u += NWAVES * 64) ((LAS unsigned*)(lds + LDSCTL_OFF))[u] = 0u;
    __syncthreads();
    XcdBarrier bar; bar.bar = ctl + CW_BAR; bar.x = 0; bar.st = nullptr;
    if (MK_N_LAUNCHES != PER_PHASE) bar = xcd_barrier_post(ctl + CW_BAR, MISC + 8, wave);
#define GRID_BAR() do { if (MK_N_LAUNCHES != PER_PHASE) xcd_barrier(bar, wave); } while (0)
    const unsigned phmask = args.mask;
#ifndef PH_MASK
#define PH_MASK 0x1ff
#endif
#define IN(k) ((((PH_MASK) >> (k)) & 1) && ((phmask >> (k)) & 1u))
#define BOTH(k) (IN(k) && IN((k) + 1))

    if (IN(0)) {
        PHASE_LANES();
        LAS float* silu = (LAS float*)(lds + RING_OFF);
        for (int i = tid; i < BATCH * DM; i += NWAVES * 64) { const float v = cvec[i]; silu[i] = v / (1.0f + __expf(-v)); }
        __syncthreads();
        for (int task = gw; task < (NMOD / 256) * KS_ADA; task += NGW) {
            const int cg = task % (NMOD / 256), ks = task / (NMOD / 256); const int k0 = ks * (DM / KS_ADA), n0 = cg * 256 + 4 * lane;
            f32x4 a0 = {0.f, 0.f, 0.f, 0.f}, a1 = {0.f, 0.f, 0.f, 0.f};
            const float* wp = w_ada + (size_t)k0 * NMOD + n0;
            static_assert(DM / KS_ADA == 64, "four 16-row batches");
            f32x4 wA[16], wB[16];
#define ADA_LD(W_, b_) _Pragma("unroll") for (int q_ = 0; q_ < 16; ++q_) W_[q_] = *(const f32x4*)(wp + (size_t)(16 * (b_) + q_) * NMOD)
#define ADA_FMA(W_, b_) _Pragma("unroll") for (int q_ = 0; q_ < 16; ++q_) { const float s0 = silu[k0 + 16 * (b_) + q_], s1 = silu[DM + k0 + 16 * (b_) + q_]; a0 += W_[q_] * s0; a1 += W_[q_] * s1; }
            ADA_LD(wA, 0); ADA_LD(wB, 1); ADA_FMA(wA, 0); ADA_LD(wA, 2); ADA_FMA(wB, 1); ADA_LD(wB, 3); ADA_FMA(wA, 2); ADA_FMA(wB, 3);
#undef ADA_LD
#undef ADA_FMA
            *(f32x4*)(MODP + ((size_t)(ks * 2 + 0)) * NMOD + n0) = a0; *(f32x4*)(MODP + ((size_t)(ks * 2 + 1)) * NMOD + n0) = a1;
        }
        __syncthreads();
        {
            LAS float* scr = (LAS float*)(lds + RING_OFF + wave * 16384);
            constexpr int I_QKV = (DM / 64) * (3 * ATTW / 32), I_PIN = (DM / 64) * (POOLW / 32), I_OUTH = (ATTW / 64) * (DM / 32);
            constexpr int NITEMS = I_QKV + I_PIN + 2 * I_OUTH;
            for (int it = gw; it < NITEMS; it += NGW) {
                int r = it;
                if (r < I_QKV + I_PIN) { p0_transpose_item<true>(w_in, INW, INW, WIN8, DM, W8SCALE, scr, r, lane); continue; } r -= I_QKV + I_PIN;
                if (r < I_OUTH) { p0_transpose_item<true>(w_out, DM, DM, WOUT8, DM, WOA8SCALE, scr, r, lane); continue; } r -= I_OUTH;
                p0_transpose_item<false>(w_out + (size_t)ATTW * DM, DM, DM, WOPT, POOLW, 1.f, scr, r, lane);
            }
        }
        for (int i0 = gw * 64 + lane; i0 < (DM * PQ + 4 * 512 * 512) / 8; i0 += 3 * NGW * 64) {
            f32x4 a4[3], c4[3];
#pragma unroll
            for (int u = 0; u < 3; ++u) { const int i = i0 + u * NGW * 64; if (i < (DM * PQ + 4 * 512 * 512) / 8) { const bool isQ = i < DM * PQ / 8; const int j = isQ ? i : i - DM * PQ / 8;
                const float* src = (isQ ? peer_wq : pool_w) + (size_t)j * 8; a4[u] = *(const f32x4*)src; c4[u] = *(const f32x4*)(src + 4); } }
#pragma unroll
            for (int u = 0; u < 3; ++u) { const int i = i0 + u * NGW * 64; if (i < (DM * PQ + 4 * 512 * 512) / 8) { const bool isQ = i < DM * PQ / 8; const int j = isQ ? i : i - DM * PQ / 8;
                f32x4 a = a4[u], c = c4[u];
                if (!isQ) { const int e0 = j * 8; const int gi = e0 >> 18, d0 = e0 & 511; const float* ps = pool_scale + gi * 512 + d0; a = a * *(const f32x4*)ps; c = c * *(const f32x4*)(ps + 4); }
                v4u w; w.x = cvt_pk_bf16(a[0], a[1]); w.y = cvt_pk_bf16(a[2], a[3]); w.z = cvt_pk_bf16(c[0], c[1]); w.w = cvt_pk_bf16(c[2], c[3]);
                *(v4u*)((isQ ? WQB : PWS) + (size_t)j * 8) = w; } }
        }
        f32x4 vnx[4][4];
#define PEER_LD(r_) do { const float* s_ = ((r_) < NEXP ? peer_u + (size_t)(r_) * DM : peer_v + (size_t)((r_) - NEXP) * DM) + 16 * lane; \
            _Pragma("unroll") for (int i = 0; i < 4; ++i) _Pragma("unroll") for (int q = 0; q < 4; ++q) vnx[i][q] = *(const f32x4*)(s_ + 1024 * i + 4 * q); } while (0)
        if (gw < 2 * NEXP) PEER_LD(gw);
        for (int r = gw; r < 2 * NEXP; r += NGW) {
            const bool isU = r < NEXP; const int e = isU ? r : r - NEXP;
            f32x4 v[4][4]; float mx = 0.f, ss = 0.f;
#pragma unroll
            for (int i = 0; i < 4; ++i)
#pragma unroll
                for (int q = 0; q < 4; ++q) { v[i][q] = vnx[i][q];
                    mx = fmaxf(mx, fmaxf(fmaxf(fabsf(v[i][q][0]), fabsf(v[i][q][1])), fmaxf(fabsf(v[i][q][2]), fabsf(v[i][q][3]))));
                    ss += (v[i][q][0] * v[i][q][0] + v[i][q][1] * v[i][q][1]) + (v[i][q][2] * v[i][q][2] + v[i][q][3] * v[i][q][3]); }
            if (r + NGW < 2 * NEXP) PEER_LD(r + NGW);
            mx = wave_max(mx);
            const int ex = (int)((__float_as_uint(mx) >> 23) & 0xffu);
            float scale = 1.0f, inv = 1.0f;
            if (ex >= 32 && ex <= 230) { const float rms = sqrtf(wave_sum(ss) * (1.0f / DM));
                if (isU) { inv = 0.3352f * rms; scale = 1.0f / inv; }
                else { inv = 0.5f * rms; scale = 1.0f / inv; } }
            if (isU) {
                unsigned char* dst = UB + ((size_t)(lane >> 4) * NEXP + e) * 128 + 8 * (lane & 15);
#pragma unroll
                for (int i = 0; i < 4; ++i) { const unsigned lo = q4x4(v[i][0], scale) | (q4x4(v[i][1], scale) << 16), hi = q4x4(v[i][2], scale) | (q4x4(v[i][3], scale) << 16);
                    *(v2u*)(dst + (size_t)(4 * i) * NEXP * 128) = (v2u){lo, hi}; }
            } else {
                unsigned char* dst = VB + ((size_t)(lane >> 4) * NEXP + e) * 128 + 8 * (lane & 15);
#pragma unroll
                for (int i = 0; i < 4; ++i) { unsigned lo = 0u, hi = 0u;
                    lo = __builtin_amdgcn_cvt_scalef32_pk_fp4_f32(lo, v[i][0][0] * scale, v[i][0][1] * scale, 1.0f, 0); lo = __builtin_amdgcn_cvt_scalef32_pk_fp4_f32(lo, v[i][0][2] * scale, v[i][0][3] * scale, 1.0f, 1);
                    lo = __builtin_amdgcn_cvt_scalef32_pk_fp4_f32(lo, v[i][1][0] * scale, v[i][1][1] * scale, 1.0f, 2); lo = __builtin_amdgcn_cvt_scalef32_pk_fp4_f32(lo, v[i][1][2] * scale, v[i][1][3] * scale, 1.0f, 3);
                    hi = __builtin_amdgcn_cvt_scalef32_pk_fp4_f32(hi, v[i][2][0] * scale, v[i][2][1] * scale, 1.0f, 0); hi = __builtin_amdgcn_cvt_scalef32_pk_fp4_f32(hi, v[i][2][2] * scale, v[i][2][3] * scale, 1.0f, 1);
                    hi = __builtin_amdgcn_cvt_scalef32_pk_fp4_f32(hi, v[i][3][0] * scale, v[i][3][1] * scale, 1.0f, 2); hi = __builtin_amdgcn_cvt_scalef32_pk_fp4_f32(hi, v[i][3][2] * scale, v[i][3][3] * scale, 1.0f, 3);
                    *(v2u*)(dst + (size_t)(4 * i) * NEXP * 128) = (v2u){lo, hi}; }
            }
            if (lane == 0) SCL[r] = inv;
        }
#undef PEER_LD
        for (int i = gw * 64 + lane; i < 2048 * 32; i += NGW * 64) {
            const int n = i >> 5, kc = (i & 31) * 8; const int p = (n >> 7) & 1, pp = kc >> 7;
            v4u w = {0u, 0u, 0u, 0u};
            if (p == pp) { const float* src = peer_sk + (size_t)n * 128 + (kc & 127); const f32x4 a = *(const f32x4*)src, c = *(const f32x4*)(src + 4);
                w.x = cvt_pk_bf16(a[0], a[1]); w.y = cvt_pk_bf16(a[2], a[3]); w.z = cvt_pk_bf16(c[0], c[1]); w.w = cvt_pk_bf16(c[2], c[3]); }
            *(v4u*)(SKT + (size_t)n * 256 + kc) = w;
        }
        if (BOTH(0)) GRID_BAR();
    }

    if (IN(1)) {
        PHASE_LANES();
        for (int i = bx * (NWAVES * 64) + tid; i < BATCH * NMOD; i += G * NWAVES * 64) {
            const int b = i / NMOD, n = i % NMOD; float s = b_ada[n];
#pragma unroll 8
            for (int ks = 0; ks < KS_ADA; ++ks) s += MODP[(size_t)(ks * 2 + b) * NMOD + n];
            const int j = n / DM, c = n % DM;
            MODV[(size_t)(j * 2 + b) * DM + c] = s;
        }
        if (bx < G / 2) {
            pg8::Gemm g{WOPT, PWS, DM, POOLW, 512, POOLW, 512, 2, 512, 1 << 30, 0}; pg8::StaticOrder S; S.init(DM, POOLW, G / 2, bx);
            pg8::EpiI8 E{WOUT8, DM, ATTW, WOP8SCALE};
            pg8::gemm_phase<pg8::EpiI8, pg8::StaticOrder, true>(lds + RING_OFF, g, S, E, wave);
        }
        else {
            pg8::Gemm g{SKT, WQB, PQ, DM, 256, 256, PQ, 1 << 30, 0, 1, 256}; pg8::StaticOrder S; S.init(PQ, DM, G - G / 2, bx - G / 2);
            pg8::EpiBf16 E{WQSTB, DM, 0, 1.0f, nullptr, 0, 0};
            pg8::gemm_phase<pg8::EpiBf16, pg8::StaticOrder, true>(lds + RING_OFF, g, S, E, wave);
        }
        if (BOTH(1)) GRID_BAR();
    }

    if (IN(2)) {
        PHASE_LANES();
        f32x4 xnx[16];
        if (gw < M) { const f32x4* xr0 = (const f32x4*)(x + (size_t)gw * DM) + lane;
#pragma unroll
            for (int j = 0; j < 16; ++j) xnx[j] = xr0[64 * j]; }
        for (int row = gw; row < M; row += NGW) {
            const int b = row / SEQ;
            f32x4 v[16]; float ss = 0.f;
#pragma unroll
            for (int j = 0; j < 16; ++j) { v[j] = xnx[j]; ss += (v[j][0] * v[j][0] + v[j][1] * v[j][1]) + (v[j][2] * v[j][2] + v[j][3] * v[j][3]); }
            if (row + NGW < M) { const f32x4* xr1 = (const f32x4*)(x + (size_t)(row + NGW) * DM) + lane;
#pragma unroll
                for (int j = 0; j < 16; ++j) xnx[j] = xr1[64 * j]; }
            const float rstd = 1.0f / sqrtf(wave_sum(ss) * (1.0f / DM) + RMS_EPS);
            const f32x4* gp = (const f32x4*)g_mix + lane; const f32x4* shp = (const f32x4*)(MODV + (size_t)(0 * 2 + b) * DM) + lane; const f32x4* scp = (const f32x4*)(MODV + (size_t)(1 * 2 + b) * DM) + lane;
            unsigned* op8 = (unsigned*)(H8 + (size_t)row * DM) + lane;
#pragma unroll
            for (int j = 0; j < 16; ++j) { const f32x4 g4 = gp[64 * j], sh = shp[64 * j], sc = scp[64 * j];
                const f32x4 y = (v[j] * rstd) * g4 * (sc + 1.0f) + sh;
                op8[64 * j] = q8x4c(y, H8SCALE); }
        }
        for (int n = gw; n < PQ; n += NGW) {
            const v2u* wr_ = (const v2u*)(WQSTB + (size_t)n * DM) + lane;
            f32x4 v[16]; float mx = 0.f;
#pragma unroll
            for (int j = 0; j < 16; ++j) { const v2u xw = wr_[64 * j]; v[j] = (f32x4){bf_lo(xw.x), bf_hi(xw.x), bf_lo(xw.y), bf_hi(xw.y)};
                mx = fmaxf(mx, fmaxf(fmaxf(fabsf(v[j][0]), fabsf(v[j][1])), fmaxf(fabsf(v[j][2]), fabsf(v[j][3])))); }
            mx = wave_max(mx);
            mx = fmaxf(mx, 1e-20f);
            const float qs = 127.0f / mx; unsigned* op8 = (unsigned*)(WQST8 + (size_t)n * DM) + lane;
#pragma unroll
            for (int j = 0; j < 16; ++j) op8[64 * j] = q8x4(v[j], qs);
            if (lane == 0) WQS[n] = mx * (1.0f / 127.0f);
        }
        if (BOTH(2)) GRID_BAR();
    }

    if (IN(3)) {
        PHASE_LANES();
        {
            pg8::Gemm g{(const bf16*)H8, (const bf16*)WIN8, M, INW, DM / 2, DM / 2, DM / 2, 1 << 30, 0, 1 << 30, 0}; pg8::StaticOrder S; S.init(M, INW, G, bx);
            pg8::EpiBf16 E{PIN, POOLW, ATTW, QSCALE / (H8SCALE * W8SCALE), QKVH, 3 * ATTW, M, 1.0f / (H8SCALE * W8SCALE), 3 * ATTW};
            pg8::gemm_phase<pg8::EpiBf16, pg8::StaticOrder, true, true>(lds + RING_OFF, g, S, E, wave);
        }
        if (BOTH(3)) GRID_BAR();
    }

    if (IN(4)) {
        PHASE_LANES();
        LAS float* btab = (LAS float*)(lds + SHARED_OFF);
        LAS unsigned char* vt = lds + RING_OFF + wave * ATT_WAVE_BYTES;
        if (!(args.pad & 1u))
        for (int unit = bx; unit < BATCH * NH * (SEQ / 1024); unit += G) {
            const int b = unit >> 7, h = (unit >> 3) & 15, mt = unit & 7;
            __syncthreads();
            for (int i = tid; i < 3 * 256; i += NWAVES * 64) { const int gi = i >> 8, ri = (i & 255) - 32; const int dil = gi == 0 ? 1 : (gi == 1 ? 4 : 16);
                btab[i] = (ri >= 0 && ri <= 128) ? rel_bias[t5_bucket((ri - 64) * dil) * NH + h] * LOG2E : -1e30f; }
            __syncthreads();
            for (int g = 0; g < 3; ++g) {
                if (g == 2) { VM_WAIT(); __syncthreads(); }
                for (int tk = wave; tk < 32; tk += NWAVES) attn_task(g, QKVH, O0, O1, LSE, LSE + (size_t)M * NH, MIX8, btab, vt, b, h, mt, tk, lane);
            }
        }
        if (!(args.pad & 2u))
        for (int i = bx * (NWAVES * 64) + tid; i < BATCH * (SEQ / 8) * (POOLW / 8); i += G * NWAVES * 64) {
            const int cc = ((i & 255) + 64 * (i / (G * NWAVES * 64))) & 255, run = (i >> 8) & (SEQ / 8 - 1), b = i >> 18; const int gi = __builtin_amdgcn_readfirstlane(cc >> 6);
            const int pos0 = run * 8;
            const bf16* base = PIN + (size_t)b * SEQ * POOLW + cc * 8;
            unsigned char* obase = MIX8 + ((size_t)b * SEQ + pos0) * DM + ATTW + cc * 8;
#define POOL_RUN(HW) do { constexpr int NR = 8 + 2 * (HW) - 1; v4u w_[NR]; \
                _Pragma("unroll") for (int q = 0; q < NR; ++q) { const int pp = pos0 - (HW) + q; const int pc = pp < 0 ? 0 : (pp > SEQ - 1 ? SEQ - 1 : pp); w_[q] = *(const v4u*)(base + (size_t)pc * POOLW); } \
                _Pragma("unroll") for (int q = 0; q < NR; ++q) { const int pp = pos0 - (HW) + q; if (pp < 0 || pp >= SEQ) w_[q] = (v4u){0u, 0u, 0u, 0u}; } \
                float s_[8] = {0.f, 0.f, 0.f, 0.f, 0.f, 0.f, 0.f, 0.f}; \
                _Pragma("unroll") for (int q = 0; q < 2 * (HW) - 1; ++q) { s_[0] += bf_lo(w_[q].x); s_[1] += bf_hi(w_[q].x); s_[2] += bf_lo(w_[q].y); s_[3] += bf_hi(w_[q].y); s_[4] += bf_lo(w_[q].z); s_[5] += bf_hi(w_[q].z); s_[6] += bf_lo(w_[q].w); s_[7] += bf_hi(w_[q].w); } \
                _Pragma("unroll") for (int k = 0; k < 8; ++k) { const v4u in_ = w_[k + 2 * (HW) - 1]; \
                    s_[0] += bf_lo(in_.x); s_[1] += bf_hi(in_.x); s_[2] += bf_lo(in_.y); s_[3] += bf_hi(in_.y); s_[4] += bf_lo(in_.z); s_[5] += bf_hi(in_.z); s_[6] += bf_lo(in_.w); s_[7] += bf_hi(in_.w); \
                    const int pos = pos0 + k; const int lo_ = pos - (HW) < 0 ? 0 : pos - (HW), hi_ = pos + (HW) > SEQ ? SEQ : pos + (HW); const float inv = 1.0f / (float)(hi_ - lo_); \
                    const v4u me = w_[k + (HW)]; \
                    const f32x4 lo4_ = {s_[0] * inv - bf_lo(me.x), s_[1] * inv - bf_hi(me.x), s_[2] * inv - bf_lo(me.y), s_[3] * inv - bf_hi(me.y)}, hi4_ = {s_[4] * inv - bf_lo(me.z), s_[5] * inv - bf_hi(me.z), s_[6] * inv - bf_lo(me.w), s_[7] * inv - bf_hi(me.w)}; \
                    const unsigned lo8_ = q8x4c(lo4_, P8SCALE), hi8_ = q8x4c(hi4_, P8SCALE); \
                    *(v2u*)(obase + (size_t)k * DM) = (v2u){lo8_, hi8_}; \
                    const v4u out_ = w_[k]; \
                    s_[0] -= bf_lo(out_.x); s_[1] -= bf_hi(out_.x); s_[2] -= bf_lo(out_.y); s_[3] -= bf_hi(out_.y); s_[4] -= bf_lo(out_.z); s_[5] -= bf_hi(out_.z); s_[6] -= bf_lo(out_.w); s_[7] -= bf_hi(out_.w); } } while (0)
            if (gi == 0) POOL_RUN(1); else if (gi == 1) POOL_RUN(2); else if (gi == 2) POOL_RUN(4); else POOL_RUN(8);
#undef POOL_RUN
        }
        if (BOTH(4)) GRID_BAR();
    }

    if (IN(5)) {
        PHASE_LANES();
        pg8::Gemm g{(const bf16*)MIX8, (const bf16*)WOUT8, M, DM, DM / 2, DM / 2, DM / 2, 1 << 30, 0, 1 << 30, 0}; pg8::StaticOrder S; S.init(M, DM, G, bx);
        pg8::EpiResBf16 E{x, MODV + (size_t)(2 * 2) * DM, X1B, DM, 1.0f / (A8SCALE * WOA8SCALE)};
        pg8::gemm_phase<pg8::EpiResBf16, pg8::StaticOrder, true, true>(lds + RING_OFF, g, S, E, wave);
        if (BOTH(5)) GRID_BAR();
    }

    if (IN(6)) {
        PHASE_LANES();
        v4u x1nx[8];
        if (gw < M) { const v4u* xr0 = (const v4u*)(X1B + (size_t)gw * DM) + lane;
#pragma unroll
            for (int j = 0; j < 8; ++j) x1nx[j] = xr0[64 * j]; }
        for (int row = gw; row < M; row += NGW) {
            const int b = row / SEQ;
            v4u xcur[8];
#pragma unroll
            for (int j = 0; j < 8; ++j) xcur[j] = x1nx[j];
            if (row + NGW < M) { const v4u* xr1 = (const v4u*)(X1B + (size_t)(row + NGW) * DM) + lane;
#pragma unroll
                for (int j = 0; j < 8; ++j) x1nx[j] = xr1[64 * j]; }
            f32x4 v[16]; float ss = 0.f;
#pragma unroll
            for (int j = 0; j < 8; ++j) { const v4u xw = xcur[j]; v[2 * j] = (f32x4){bf_lo(xw.x), bf_hi(xw.x), bf_lo(xw.y), bf_hi(xw.y)}; v[2 * j + 1] = (f32x4){bf_lo(xw.z), bf_hi(xw.z), bf_lo(xw.w), bf_hi(xw.w)};
                ss += (v[2 * j][0] * v[2 * j][0] + v[2 * j][1] * v[2 * j][1]) + (v[2 * j][2] * v[2 * j][2] + v[2 * j][3] * v[2 * j][3]);
                ss += (v[2 * j + 1][0] * v[2 * j + 1][0] + v[2 * j + 1][1] * v[2 * j + 1][1]) + (v[2 * j + 1][2] * v[2 * j + 1][2] + v[2 * j + 1][3] * v[2 * j + 1][3]); }
            const float rstd = 1.0f / sqrtf(wave_sum(ss) * (1.0f / DM) + RMS_EPS);
            const f32x4* gp = (const f32x4*)g_ffn + 2 * lane; const f32x4* shp = (const f32x4*)(MODV + (size_t)(3 * 2 + b) * DM) + 2 * lane; const f32x4* scp = (const f32x4*)(MODV + (size_t)(4 * 2 + b) * DM) + 2 * lane;
            v2u* op8 = (v2u*)(H8 + (size_t)row * DM) + lane;
            unsigned* hip = (unsigned*)(HHI + (size_t)row * (DM / 2)) + lane; unsigned* lop = (unsigned*)(HLO + (size_t)row * (DM / 2)) + lane;
            float ymx = 0.f;
#pragma unroll
            for (int j = 0; j < 16; ++j) { const int o_ = 128 * (j >> 1) + (j & 1); const f32x4 g4 = gp[o_], sh = shp[o_], sc = scp[o_];
                const f32x4 y = (v[j] * rstd) * g4 * (sc + 1.0f) + sh; v[j] = y;
                ymx = fmaxf(ymx, fmaxf(fmaxf(fabsf(y[0]), fabsf(y[1])), fmaxf(fabsf(y[2]), fabsf(y[3])))); }
            ymx = wave_max(ymx);
            ymx = fmaxf(ymx, 1e-20f);
            const float qs = 119.0f / ymx;
#pragma unroll
            for (int j = 0; j < 8; ++j) { const unsigned w0 = q8x4(v[2 * j], qs), w1 = q8x4(v[2 * j + 1], qs);
                op8[64 * j] = (v2u){w0, w1};
                const unsigned t0 = (w0 ^ 0x80808080u) + 0x08080808u, t1 = (w1 ^ 0x80808080u) + 0x08080808u;
                hip[64 * j] = nibs16(((t0 >> 4) & 0x0f0f0f0fu) ^ 0x08080808u) | (nibs16(((t1 >> 4) & 0x0f0f0f0fu) ^ 0x08080808u) << 16);
                lop[64 * j] = nibs16(w0 & 0x0f0f0f0fu) | (nibs16(w1 & 0x0f0f0f0fu) << 16); }
            if (lane == 0) TSC[row] = ymx * (1.0f / 119.0f);
        }
        if (BOTH(6)) GRID_BAR();
    }

    if (IN(7)) {
        PHASE_LANES();
        pg8::Gemm g{(const bf16*)H8, (const bf16*)WQST8, M, PQ, DM / 2, DM / 2, DM / 2, 1 << 30, 0, 1 << 30, 0}; pg8::StaticOrder S; S.init(M, PQ, G, bx);
        pg8::EpiF32RowScale E{SC, PQ, TSC, WQS};
        pg8::gemm_phase<pg8::EpiF32RowScale, pg8::StaticOrder, true, true>(lds + RING_OFF, g, S, E, wave);
        if (BOTH(7)) GRID_BAR();
    }

    if (IN(8)) {
        PHASE_LANES();
        LAS unsigned short* EXPW = (LAS unsigned short*)(lds + RING_OFF);
        LAS float* GACT = (LAS float*)(lds + RING_OFF + 16384);
        LAS unsigned* W = (LAS unsigned*)(lds + RING_OFF + 49152 + wave * 4096);
        LAS unsigned* K1 = W; LAS unsigned* K2 = W + 128;
        LAS float* TV1 = (LAS float*)(W + 256); LAS int* TI1 = (LAS int*)(W + 272); LAS float* TV2 = (LAS float*)(W + 288); LAS int* TI2 = (LAS int*)(W + 304);
        LAS unsigned* CK = W + 320; LAS float* SV = (LAS float*)(W + 384); LAS int* SE = (LAS int*)(W + 400);
        const int c8 = lane & 7, r8 = lane >> 3;
        for (int blk = vcu; blk < M / 64; blk += G) {
            const int tok0 = blk * 64; const int b = tok0 / SEQ;
            const int ph = 0;
            for (int pass = 0; pass < 1 + ph; ++pass) {
            const int lt = ph ? 2 : 3;
            const int jb = 4 * pass;
            const int nt = 1 << lt;
            const float* sp0 = SC + (size_t)(tok0 + wave * 8 + jb) * PQ + lane;
            float na0 = sp0[0], na1 = sp0[64], nb0 = sp0[128], nb1 = sp0[192];
#pragma unroll 1
            for (int rec = 0; rec < 8 * nt; ++rec) {
                const int tl = wave * 8 + jb + (rec >> 3);
                { const int h = rec & 7;
                    const float a0 = na0, a1 = na1, b0 = nb0, b1 = nb1;
                    { const int nx = rec + 1 < 8 * nt ? rec + 1 : 0; const float* sp = sp0 + (size_t)nx * 256; na0 = sp[0]; na1 = sp[64]; nb0 = sp[128]; nb1 = sp[192]; }
                    float ka0 = __uint_as_float((__float_as_uint(a0) & ~127u) | (unsigned)(127 - lane)), ka1 = __uint_as_float((__float_as_uint(a1) & ~127u) | (unsigned)(63 - lane));
                    float kb0 = __uint_as_float((__float_as_uint(b0) & ~127u) | (unsigned)(127 - lane)), kb1 = __uint_as_float((__float_as_uint(b1) & ~127u) | (unsigned)(63 - lane));
                    bitonic128x2f(ka0, ka1, kb0, kb1, lane);
                    if (lane >= 56) { K1[127 - 2 * lane] = __float_as_uint(ka0); K1[126 - 2 * lane] = __float_as_uint(ka1); K2[127 - 2 * lane] = __float_as_uint(kb0); K2[126 - 2 * lane] = __float_as_uint(kb1); }
                    LDS_WAIT();
                    const int ci_i = CAND_I[lane], ci_j = CAND_J[lane];
                    const unsigned kA = K1[ci_i], kB = K2[ci_j];
                    const float cv = __uint_as_float(kA & ~127u) + __uint_as_float(kB & ~127u);
                    const unsigned ck = lane < 50 ? ((fkey(cv) & ~255u) | (unsigned)(255 - (ci_i * 16 + ci_j))) : 0u;
                    CK[lane] = ck;
                    LDS_WAIT();
                    int rc = 0;
#pragma unroll
                    for (int kk = 0; kk < 13; ++kk) { const v4u q = ((const LAS v4u*)CK)[kk];     rc += (q.x > ck) + (q.y > ck) + (q.z > ck) + (q.w > ck); }
                    if (lane < 50 && rc < 16) { SV[rc] = cv; SE[rc] = (int)((127u - (kA & 127u)) * 128u + (127u - (kB & 127u))); }
                    LDS_WAIT();
                    const float top0 = SV[0], myv = SV[lane & 15]; const int mye = SE[lane & 15];
                    const float e = __expf(myv - top0);
                    float ssum = e; ssum += __uint_as_float(xshfl<1>(__float_as_uint(ssum), lane)); ssum += __uint_as_float(xshfl<2>(__float_as_uint(ssum), lane)); ssum += __uint_as_float(xshfl<4>(__float_as_uint(ssum), lane)); ssum += __uint_as_float(xshfl<8>(__float_as_uint(ssum), lane));
                    if (lane < 16) { EXPW[tl * 128 + h * 16 + lane] = (unsigned short)mye; GACT[tl * 128 + h * 16 + lane] = e / ssum; }
                    LDS_WAIT();
                }
            }
            LAS float* ACC = (LAS float*)(lds + RING_OFF + 81920);
            for (int i = lane; i < nt * 128; i += 64) ACC[(wave * 8 + jb) * 128 + i] = 0.f;
            LDS_WAIT();
            if (!(args.pad & 8u)) {
                v4u gA[16], gB[16]; v4u hA, hB, lA, lB;
#define P10_LOADU(idx, G_, H_, L_) do { const int s_ = (idx) >> lt, j_ = jb + ((idx) & (nt - 1)); const int tl_ = wave * 8 + j_; \
                    const unsigned char* tb_ = UB + (size_t)s_ * NEXP * 128 + 16 * c8; \
                    H_ = *(const v4u*)(HHI + (size_t)(tok0 + tl_) * (DM / 2) + 128 * s_ + 16 * c8); L_ = *(const v4u*)(HLO + (size_t)(tok0 + tl_) * (DM / 2) + 128 * s_ + 16 * c8); \
                    _Pragma("unroll") for (int i = 0; i < 16; ++i) { const unsigned e_ = EXPW[tl_ * 128 + r8 + 8 * i]; G_[i] = *(const v4u*)(tb_ + (size_t)e_ * 128); } } while (0)
#define P10_COMPU(idx, G_, H_, L_) do { const int tl = wave * 8 + jb + ((idx) & (nt - 1)); int p[16]; \
                    _Pragma("unroll") for (int i = 0; i < 16; ++i) { int a_ = 0, b_ = 0; \
                        a_ = __builtin_amdgcn_sdot8((int)G_[i].x, (int)H_.x, a_, false); a_ = __builtin_amdgcn_sdot8((int)G_[i].y, (int)H_.y, a_, false); \
                        a_ = __builtin_amdgcn_sdot8((int)G_[i].z, (int)H_.z, a_, false); a_ = __builtin_amdgcn_sdot8((int)G_[i].w, (int)H_.w, a_, false); \
                        b_ = __builtin_amdgcn_sdot8((int)G_[i].x, (int)L_.x, b_, false); b_ = __builtin_amdgcn_sdot8((int)G_[i].y, (int)L_.y, b_, false); \
                        b_ = __builtin_amdgcn_sdot8((int)G_[i].z, (int)L_.z, b_, false); b_ = __builtin_amdgcn_sdot8((int)G_[i].w, (int)L_.w, b_, false); p[i] = a_ * 16 + b_; } \
                    int q8[8], q4[4], q2[2]; \
                      \
                    _Pragma("unroll") for (int m = 0; m < 8; ++m) { const int kp = (c8 & 4) ? p[m + 8] : p[m]; \
                        unsigned rv_ = __builtin_amdgcn_update_dpp(0u, (unsigned)p[m], 0x104, 0xf, 0x5, false); rv_ = __builtin_amdgcn_update_dpp(rv_, (unsigned)p[m + 8], 0x114, 0xf, 0xa, false); q8[m] = kp + (int)rv_; } \
                    _Pragma("unroll") for (int m = 0; m < 4; ++m) { const int snd = (c8 & 2) ? q8[m] : q8[m + 4], kp = (c8 & 2) ? q8[m + 4] : q8[m]; q4[m] = kp + (int)__builtin_amdgcn_update_dpp(0u, (unsigned)snd, 0x4e, 0xf, 0xf, true); } \
                    _Pragma("unroll") for (int m = 0; m < 2; ++m) { const int snd = (c8 & 1) ? q4[m] : q4[m + 2], kp = (c8 & 1) ? q4[m + 2] : q4[m]; q2[m] = kp + (int)__builtin_amdgcn_update_dpp(0u, (unsigned)snd, 0xb1, 0xf, 0xf, true); } \
                    LAS float* ap = ACC + tl * 128 + r8 + 16 * c8;         \
                    ap[0] += (float)q2[0]; ap[8] += (float)q2[1]; } while (0)
                P10_LOADU(0, gA, hA, lA);
#pragma unroll 1
                for (int idx = 0; idx < 16 * nt; idx += 2) {
                    P10_LOADU(idx + 1, gB, hB, lB);
                    P10_COMPU(idx, gA, hA, lA);
                    if (idx + 2 < 16 * nt) P10_LOADU(idx + 2, gA, hA, lA);
                    P10_COMPU(idx + 1, gB, hB, lB);
                }
#undef P10_LOADU
#undef P10_COMPU
            }
            LDS_WAIT();
#pragma unroll 8
            for (int i = lane; i < nt * 128; i += 64) { const int o_ = (wave * 8 + jb) * 128 + i; const unsigned e = EXPW[o_];
                const float a = ACC[o_] * SCL[e] * TSC[tok0 + (o_ >> 7)]; const h2_t ah_ = {(_Float16)(gelu_tanh(a) * GACT[o_] * SCL[NEXP + e]), (_Float16)0.f}; GACT[o_] = __builtin_bit_cast(float, ah_); }
            LDS_WAIT();
            LAS float* SSQ = ACC;
            for (int j = 0; j < nt; ++j) SSQ[(wave * 8 + jb + j) * 128 + lane] = 0.f;
            LDS_WAIT();
            const float* gtp = MODV + (size_t)(5 * 2 + b) * DM;
            if (!(args.pad & 16u)) {
                v4u gA[16], gB[16]; float aA[16], aB[16];
#define P10_LOADV(idx, G_, A_) do { const int s_ = (idx) >> lt, j_ = jb + ((idx) & (nt - 1)); const int tl_ = wave * 8 + j_; \
                    const unsigned char* tb_ = VB + (size_t)s_ * NEXP * 128 + 16 * c8; \
                    _Pragma("unroll") for (int i = 0; i < 16; ++i) { const int k_ = tl_ * 128 + r8 + 8 * i; const unsigned e_ = EXPW[k_]; A_[i] = GACT[k_]; G_[i] = *(const v4u*)(tb_ + (size_t)e_ * 128); } } while (0)
#define P10_COMPV(idx, G_, A_) do { const int s_c = (idx) >> lt; const int tl = wave * 8 + jb + ((idx) & (nt - 1)); const int t = tok0 + tl; \
                    const int d = 256 * s_c + 32 * c8 + 2 * r8; \
                    const unsigned xw0 = __builtin_nontemporal_load((const unsigned*)(X1B + (size_t)t * DM + d)), xw1 = __builtin_nontemporal_load((const unsigned*)(X1B + (size_t)t * DM + d + 16)); \
                    const f32x2 gv0 = *(const f32x2*)(gtp + d), gv1 = *(const f32x2*)(gtp + d + 16);     \
                    float ssq = SSQ[tl * 128 + lane]; \
                    _Pragma("unroll") for (int hf = 0; hf < 2; ++hf) {     \
                          \
                        h2_t o8[8]; \
                        _Pragma("unroll") for (int q = 0; q < 8; ++q) o8[q] = (h2_t){(_Float16)0.f, (_Float16)0.f}; \
                        _Pragma("unroll") for (int i = 0; i < 16; ++i) { const _Float16 ah_ = __builtin_bit_cast(h2_t, A_[i])[0]; const h2_t a2_ = {ah_, ah_}; \
                            _Pragma("unroll") for (int q = 0; q < 2; ++q) { const unsigned w_ = G_[i][2 * hf + q]; \
                                o8[4 * q] = __builtin_amdgcn_cvt_scalef32_pk_f16_fp4(w_, 1.0f, 0) * a2_ + o8[4 * q]; o8[4 * q + 1] = __builtin_amdgcn_cvt_scalef32_pk_f16_fp4(w_, 1.0f, 1) * a2_ + o8[4 * q + 1]; \
                                o8[4 * q + 2] = __builtin_amdgcn_cvt_scalef32_pk_f16_fp4(w_, 1.0f, 2) * a2_ + o8[4 * q + 2]; o8[4 * q + 3] = __builtin_amdgcn_cvt_scalef32_pk_f16_fp4(w_, 1.0f, 3) * a2_ + o8[4 * q + 3]; } } \
                          \
                        h2_t q8[4], q4[2], q2h; \
                        _Pragma("unroll") for (int j = 0; j < 4; ++j) { const auto r_ = __builtin_amdgcn_permlane32_swap(__builtin_bit_cast(unsigned, o8[j]), __builtin_bit_cast(unsigned, o8[j + 4]), false, false); unsigned r0_ = r_[0], r1_ = r_[1]; asm volatile("" : "+v"(r0_), "+v"(r1_));     q8[j] = __builtin_bit_cast(h2_t, r0_) + __builtin_bit_cast(h2_t, r1_); } \
                        _Pragma("unroll") for (int j = 0; j < 2; ++j) { const auto r_ = __builtin_amdgcn_permlane16_swap(__builtin_bit_cast(unsigned, q8[j]), __builtin_bit_cast(unsigned, q8[j + 2]), false, false); unsigned r0_ = r_[0], r1_ = r_[1]; asm volatile("" : "+v"(r0_), "+v"(r1_)); q4[j] = __builtin_bit_cast(h2_t, r0_) + __builtin_bit_cast(h2_t, r1_); } \
                        { const unsigned snd = __builtin_bit_cast(unsigned, (r8 & 1) ? q4[0] : q4[1]); const h2_t kp = (r8 & 1) ? q4[1] : q4[0]; q2h = kp + __builtin_bit_cast(h2_t, __builtin_amdgcn_update_dpp(0u, snd, 0x128, 0xf, 0xf, true)); } \
                        float q2[2]; q2[0] = (float)q2h[0]; q2[1] = (float)q2h[1]; \
                        const unsigned xw = hf ? xw1 : xw0; const f32x2 gv = hf ? gv1 : gv0; \
                        f32x2 y; y.x = bf_lo(xw) + gv.x * q2[0]; y.y = bf_hi(xw) + gv.y * q2[1]; \
                        __builtin_nontemporal_store(cvt_pk_bf16(y.x, y.y), (unsigned*)(YB + (size_t)t * DM + d + 16 * hf)); \
                        ssq += (y.x * y.x + y.y * y.y); } \
                    SSQ[tl * 128 + lane] = ssq; } while (0)
                P10_LOADV(0, gA, aA);
#pragma unroll 1
                for (int idx = 0; idx < 16 * nt; idx += 2) {
                    P10_LOADV(idx + 1, gB, aB);
                    P10_COMPV(idx, gA, aA);
                    if (idx + 2 < 16 * nt) P10_LOADV(idx + 2, gA, aA);
                    P10_COMPV(idx + 1, gB, aB);
                }
#undef P10_LOADV
#undef P10_COMPV
            }
            VM_WAIT(); LDS_WAIT();
            __builtin_amdgcn_fence(__ATOMIC_ACQUIRE, "agent");
            VM_WAIT();
            for (int j = 0; j < nt; ++j) {
                const int tl = wave * 8 + jb + j; const int t = tok0 + tl;
                const float rstd = 1.0f / sqrtf(wave_sum(SSQ[tl * 128 + lane]) * (1.0f / DM) + RMS_EPS);
                f32x4* op = (f32x4*)(out + (size_t)t * DM) + lane; const f32x4* gp = (const f32x4*)g_final + lane; const v2u* yp = (const v2u*)(YB + (size_t)t * DM) + lane;
#pragma unroll 4
                for (int i = 0; i < 16; ++i) { const v2u yw = __builtin_nontemporal_load(yp + 64 * i); const f32x4 y = {bf_lo(yw.x), bf_hi(yw.x), bf_lo(yw.y), bf_hi(yw.y)}; __builtin_nontemporal_store(y * rstd * gp[64 * i], op + 64 * i); }
            }
            LDS_WAIT();
            }
        }
    }
#undef IN
#undef BOTH
#undef GRID_BAR
}

extern "C" void kernel_launch(void* const* d_in, const int* in_sizes, int n_in, void* d_out, int out_size, void* d_ws, size_t ws_size, hipStream_t stream) {
    static int grid = 0;
    if (grid == 0) {
        if (n_in != 16 || in_sizes[0] != M * DM || out_size != M * DM || ws_size < WS_END) {
            fprintf(stderr, "kernel_launch: shape/workspace mismatch: n_in %d in0 %d out %d ws %zu (need %zu)\n", n_in, n_in > 0 ? in_sizes[0] : -1, out_size, ws_size, (size_t)WS_END); grid = -1; return; }
        int dev = 0, cus = 0, per_cu = 0;
        if (hipGetDevice(&dev) != hipSuccess || hipDeviceGetAttribute(&cus, hipDeviceAttributeMultiprocessorCount, dev) != hipSuccess) { grid = -1; return; }
        if (hipFuncSetAttribute((const void*)fwd_kernel, hipFuncAttributeMaxDynamicSharedMemorySize, LDS_BYTES) != hipSuccess) { fprintf(stderr, "kernel_launch: hipFuncSetAttribute failed\n"); grid = -1; return; }
        if (hipOccupancyMaxActiveBlocksPerMultiprocessor(&per_cu, (const void*)fwd_kernel, NWAVES * 64, LDS_BYTES) != hipSuccess || per_cu < 1)
            fprintf(stderr, "kernel_launch: note: occupancy query reports %d workgroups per CU\n", per_cu);
        (void)hipGetLastError();
        grid = cus;
    }
    if (grid < 0) return;
    if (hipMemsetAsync((char*)d_ws + WS_CTL, 0, CTL_ZERO_BYTES, stream) != hipSuccess) { fprintf(stderr, "kernel_launch: memset failed\n"); return; }
    Args a{};
    for (int i = 0; i < 16; ++i) a.in[i] = (const float*)d_in[i];
    a.out = (float*)d_out; a.ws = (unsigned char*)d_ws;
#ifdef PROBE_MASK
    {
#ifndef PROBE_PAD
#define PROBE_PAD 0
#endif
        a.mask = PROBE_MASK; a.pad = PROBE_PAD;
        hipLaunchKernelGGL(fwd_kernel, dim3(grid), dim3(NWAVES * 64), LDS_BYTES, stream, a);
        (void)hipMemsetAsync((char*)d_ws + WS_CTL, 0, CTL_ZERO_BYTES, stream);
    }
#endif
    for (int li = 0; li < MK_N_LAUNCHES; ++li) {
        a.mask = (MK_N_LAUNCHES == PER_PHASE) ? (1u << li) : ((1u << PER_PHASE) - 1u); a.pad = 0;
        hipLaunchKernelGGL(fwd_kernel, dim3(grid), dim3(NWAVES * 64), LDS_BYTES, stream, a);
        const hipError_t le = hipPeekAtLastError();
        if (le != hipSuccess) { fprintf(stderr, "kernel_launch: launch %d failed: %s\n", li, hipGetErrorName(le)); break; }
    }
}
```
